# Optimizing an MI355X kernel written in HIP

```python
import math
import jax, jax.numpy as jnp
from jax import lax
import numpy as np

D_MODEL = 1024
BATCH = 16
SEQ = 2048
DEPTH = 1

CHUNK = 64
Q_BLOCK = 128
HEAD_DIM_A = 64
N_HEADS_A = D_MODEL // (2 * HEAD_DIM_A)
ATTN_WIDTH = N_HEADS_A * 2 * HEAD_DIM_A
ROPE_THETA = 10000.0
POOL_WINDOWS = (2, 4, 8, 16)
POOL_GROUPS = len(POOL_WINDOWS)
POOL_WIDTH = D_MODEL // 2
POOL_GROUP_DIM = POOL_WIDTH // POOL_GROUPS
N_BRANCHES = 2
IN_WIDTH = 3 * ATTN_WIDTH + POOL_WIDTH + N_BRANCHES * D_MODEL
SPLIT_POINTS = (ATTN_WIDTH, 2 * ATTN_WIDTH, 3 * ATTN_WIDTH, 3 * ATTN_WIDTH + POOL_WIDTH)
N_GROUPS = 4
EXPERTS_PER_GROUP = 8
N_EXPERTS = N_GROUPS * EXPERTS_PER_GROUP
TOP_K = 2
EXPERT_FF = D_MODEL // 2
MOE_BLOCK = 256
LN_EPS = 1e-5
RMS_EPS = 1e-5
ALPHA = (2.0 * DEPTH) ** 0.25
BETA = (8.0 * DEPTH) ** -0.25
NEG_INF = -1e30

kernel_name = 'hybrid_diffattn_pool_hmoe_deepnorm'


def _layer_norm(x, gain, bias):
    xf = x.astype(jnp.float32)
    mu = jnp.mean(xf, axis=-1, keepdims=True)
    var = jnp.mean(jnp.square(xf - mu), axis=-1, keepdims=True)
    y = (xf - mu) * lax.rsqrt(var + LN_EPS)
    return (y * gain.astype(jnp.float32) + bias.astype(jnp.float32)).astype(x.dtype)


def _rope(t, positions):
    half = HEAD_DIM_A // 2
    inv_freq = ROPE_THETA ** (-jnp.arange(half, dtype=jnp.float32) * (2.0 / HEAD_DIM_A))
    ang = positions.astype(jnp.float32)[..., None] * inv_freq
    cos = jnp.cos(ang)[:, :, None, None, :].astype(t.dtype)
    sin = jnp.sin(ang)[:, :, None, None, :].astype(t.dtype)
    t1, t2 = t[..., :half], t[..., half:]
    return jnp.concatenate([t1 * cos - t2 * sin, t2 * cos + t1 * sin], axis=-1)


def _diff_attention(q, k, v, lam):
    B, S = q.shape[0], q.shape[1]
    nb = S // Q_BLOCK
    scale = HEAD_DIM_A ** -0.5
    q_blocks = q.reshape(B, nb, Q_BLOCK, N_HEADS_A, 2, HEAD_DIM_A).transpose(1, 0, 3, 4, 2, 5)
    k_t = k.transpose(0, 2, 3, 1, 4)
    v_t = v.transpose(0, 2, 1, 3)
    key_chunk = jnp.arange(S) // CHUNK

    def one_block(args):
        q_blk, blk = args
        s = jnp.einsum('bhmqd,bhmkd->bhmqk', q_blk, k_t).astype(jnp.float32) * scale
        q_chunk = (blk * Q_BLOCK + jnp.arange(Q_BLOCK)) // CHUNK
        allowed = key_chunk[None, :] <= q_chunk[:, None]
        p = jax.nn.softmax(jnp.where(allowed, s, NEG_INF), axis=-1)
        a = p[:, :, 0] - lam * p[:, :, 1]
        return jnp.einsum('bhqk,bhkv->bhqv', a.astype(v_t.dtype), v_t)

    o = lax.map(one_block, (q_blocks, jnp.arange(nb)))
    return o.transpose(1, 0, 3, 2, 4).reshape(B, S, N_HEADS_A, 2 * HEAD_DIM_A)


def _multiscale_pool(u, w_pool, pool_scale):
    B, S = u.shape[0], u.shape[1]
    groups = u.astype(jnp.float32).reshape(B, S, POOL_GROUPS, POOL_GROUP_DIM)
    cs = jnp.cumsum(groups, axis=1)
    t = jnp.arange(S)
    means = []
    for g, w in enumerate(POOL_WINDOWS):
        c = cs[:, :, g]
        lagged = jnp.pad(c, ((0, 0), (w, 0), (0, 0)))[:, :S]
        count = jnp.minimum(t + 1, w).astype(jnp.float32)[None, :, None]
        means.append((c - lagged) / count)
    pooled = (jnp.stack(means, axis=2) - groups).astype(u.dtype)
    mixed = jnp.einsum('bsgc,gcd->bsgd', pooled, w_pool)
    return mixed.reshape(B, S, POOL_WIDTH) * pool_scale


def _token_mixer(h, positions, w_in, gate_bias, lam_vecs, subln_gain, lambda_init,
                 w_pool, pool_scale, w_branch_a, w_branch_b, w_out):
    B, S = h.shape[0], h.shape[1]
    proj = h @ w_in
    q, k, v, u, gates = jnp.split(proj, SPLIT_POINTS, axis=-1)
    q = _rope(q.reshape(B, S, N_HEADS_A, 2, HEAD_DIM_A), positions)
    k = _rope(k.reshape(B, S, N_HEADS_A, 2, HEAD_DIM_A), positions)
    v = v.reshape(B, S, N_HEADS_A, 2 * HEAD_DIM_A)
    lv = lam_vecs.astype(jnp.float32)
    lam = jnp.exp(jnp.sum(lv[0] * lv[1])) - jnp.exp(jnp.sum(lv[2] * lv[3])) + lambda_init
    o = _diff_attention(q, k, v, lam).astype(jnp.float32)
    o = o * lax.rsqrt(jnp.mean(jnp.square(o), axis=-1, keepdims=True) + RMS_EPS)
    o = o * subln_gain.astype(jnp.float32) * (1.0 - lambda_init)
    y_a = o.astype(h.dtype).reshape(B, S, ATTN_WIDTH) @ w_branch_a
    y_b = _multiscale_pool(u, w_pool, pool_scale) @ w_branch_b
    g = jax.nn.sigmoid((gates + gate_bias).astype(jnp.float32)).reshape(B, S, N_BRANCHES, D_MODEL)
    merged = g[:, :, 0] * y_a.astype(jnp.float32) + g[:, :, 1] * y_b.astype(jnp.float32)
    return merged.astype(h.dtype) @ w_out


def _hierarchical_moe(h, w_router_group, b_router_group, w_router_expert, b_router_expert,
                      w_gate_up, w_down):
    B, S, D = h.shape
    T = B * S
    x2 = h.reshape(T, D)
    g_prob = jax.nn.softmax((x2 @ w_router_group + b_router_group).astype(jnp.float32), axis=-1)
    g_p, g_idx = lax.top_k(g_prob, 1)
    e_logit = (x2 @ w_router_expert + b_router_expert).astype(jnp.float32)
    e_logit = e_logit.reshape(T, N_GROUPS, EXPERTS_PER_GROUP)
    e_logit = jnp.take_along_axis(e_logit, g_idx[:, :, None], axis=1)[:, 0]
    e_p, e_local = lax.top_k(jax.nn.softmax(e_logit, axis=-1), TOP_K)
    e_p = e_p / jnp.sum(e_p, axis=-1, keepdims=True)
    weights = g_p * e_p
    experts = g_idx * EXPERTS_PER_GROUP + e_local

    A = T * TOP_K
    n_blocks = -(-A // MOE_BLOCK) + N_EXPERTS
    P = n_blocks * MOE_BLOCK
    flat_e = experts.reshape(A)
    flat_w = weights.reshape(A)
    flat_tok = jnp.repeat(jnp.arange(T, dtype=jnp.int32), TOP_K)
    order = jnp.argsort(flat_e)
    sorted_e = flat_e[order]
    counts = jnp.bincount(flat_e, length=N_EXPERTS)
    padded = ((counts + MOE_BLOCK - 1) // MOE_BLOCK) * MOE_BLOCK
    ends = jnp.cumsum(padded)
    start_padded = ends - padded
    start = jnp.cumsum(counts) - counts
    dest = start_padded[sorted_e] + (jnp.arange(A) - start[sorted_e])
    row_tok = jnp.full((P,), T, dtype=jnp.int32).at[dest].set(flat_tok[order])
    row_w = jnp.zeros((P,), jnp.float32).at[dest].set(flat_w[order])
    block_expert = jnp.minimum(
        jnp.searchsorted(ends, jnp.arange(n_blocks) * MOE_BLOCK, side='right'), N_EXPERTS - 1)
    x_pad = jnp.concatenate([x2, jnp.zeros((1, D), x2.dtype)], axis=0)
    xb = x_pad[row_tok].reshape(n_blocks, MOE_BLOCK, D)

    def run_block(args):
        xs, e = args
        gate, up = jnp.split(xs @ w_gate_up[e], 2, axis=-1)
        return (jax.nn.silu(gate) * up) @ w_down[e]

    yb = lax.map(run_block, (xb, block_expert)).reshape(P, D)
    out = jax.ops.segment_sum(yb.astype(jnp.float32) * row_w[:, None], row_tok, num_segments=T + 1)
    return out[:T].astype(h.dtype).reshape(B, S, D)


def setup_inputs(seed: int = 0) -> dict:
    key = jax.random.key(seed)
    ks = jax.random.split(key, 24)
    nrm = lambda k, shape, s: jax.random.normal(k, shape, jnp.float32) * s
    L, D = DEPTH, D_MODEL
    x = jax.random.normal(ks[0], (BATCH, SEQ, D), jnp.float32)
    offset = jax.random.randint(ks[1], (BATCH, 1), 0, 4096, dtype=jnp.int32)
    positions = offset + jnp.arange(SEQ, dtype=jnp.int32)[None, :]
    w_q = nrm(ks[2], (L, D, ATTN_WIDTH), D ** -0.5)
    w_k = nrm(ks[3], (L, D, ATTN_WIDTH), D ** -0.5)
    w_v = nrm(ks[4], (L, D, ATTN_WIDTH), BETA * D ** -0.5)
    w_u = nrm(ks[5], (L, D, POOL_WIDTH), D ** -0.5)
    w_g = nrm(ks[6], (L, D, N_BRANCHES * D), D ** -0.5)
    w_in = jnp.concatenate([w_q, w_k, w_v, w_u, w_g], axis=-1)
    return {
        'x': x,
        'positions': positions,
        'w_in': w_in,
        'gate_bias': nrm(ks[7], (L, N_BRANCHES * D), 0.01),
        'lam_vecs': nrm(ks[8], (L, 4, HEAD_DIM_A), 0.1),
        'subln_gain': 1.0 + nrm(ks[9], (L, 2 * HEAD_DIM_A), 0.02),
        'w_pool': nrm(ks[10], (L, POOL_GROUPS, POOL_GROUP_DIM, POOL_GROUP_DIM), POOL_GROUP_DIM ** -0.5),
        'pool_scale': 1.0 + nrm(ks[11], (L, POOL_WIDTH), 0.02),
        'w_branch_a': nrm(ks[12], (L, ATTN_WIDTH, D), BETA * ATTN_WIDTH ** -0.5),
        'w_branch_b': nrm(ks[13], (L, POOL_WIDTH, D), BETA * POOL_WIDTH ** -0.5),
        'w_out': nrm(ks[14], (L, D, D), BETA * D ** -0.5),
        'ln1_gain': 1.0 + nrm(ks[15], (L, D), 0.02),
        'ln1_bias': nrm(ks[16], (L, D), 0.01),
        'w_router_group': nrm(ks[17], (L, D, N_GROUPS), D ** -0.5),
        'b_router_group': nrm(ks[18], (L, N_GROUPS), 0.01),
        'w_router_expert': nrm(ks[19], (L, D, N_EXPERTS), D ** -0.5),
        'b_router_expert': nrm(ks[20], (L, N_EXPERTS), 0.01),
        'w_gate_up': nrm(ks[21], (L, N_EXPERTS, D, 2 * EXPERT_FF), D ** -0.5),
        'w_down': nrm(ks[22], (L, N_EXPERTS, EXPERT_FF, D), BETA * EXPERT_FF ** -0.5),
        'ln2_gain': 1.0 + nrm(ks[23], (L, D), 0.02),
        'ln2_bias': nrm(jax.random.fold_in(ks[23], 1), (L, D), 0.01),
    }


def reference(x, positions, w_in, gate_bias, lam_vecs, subln_gain, w_pool, pool_scale,
              w_branch_a, w_branch_b, w_out, ln1_gain, ln1_bias, w_router_group,
              b_router_group, w_router_expert, b_router_expert, w_gate_up, w_down,
              ln2_gain, ln2_bias):
    for layer in range(DEPTH):
        lambda_init = 0.8 - 0.6 * math.exp(-0.3 * layer)
        mix = _token_mixer(x, positions, w_in[layer], gate_bias[layer], lam_vecs[layer],
                           subln_gain[layer], lambda_init, w_pool[layer], pool_scale[layer],
                           w_branch_a[layer], w_branch_b[layer], w_out[layer])
        x = _layer_norm(ALPHA * x + mix, ln1_gain[layer], ln1_bias[layer])
        ffn = _hierarchical_moe(x, w_router_group[layer], b_router_group[layer],
                                w_router_expert[layer], b_router_expert[layer],
                                w_gate_up[layer], w_down[layer])
        x = _layer_norm(ALPHA * x + ffn, ln2_gain[layer], ln2_bias[layer])
    return x
```

```cpp
#include <hip/hip_runtime.h>
#include <cstdio>
#include <cstdint>
#include <cmath>

typedef unsigned short bf16_t;
typedef float f32x4 __attribute__((ext_vector_type(4)));

constexpr int NB = 16, SEQ = 2048, DM = 1024, T = NB * SEQ;
constexpr int NHEAD = 8, HD = 64, NHM = 16;
constexpr int INW = 5632;
constexpr int PW = 512, PG = 4, PGD = 128;
constexpr int NE = 32, NGRP = 4, EPG = 8, FF = 512;
constexpr float LN_EPS = 1e-5f, RMS_EPS = 1e-5f;
constexpr float ALPHA = 1.189207115002721f;
constexpr float LAMBDA_INIT = 0.2f;
constexpr float QSCALE = 0.125f * 1.4426950408889634f;

constexpr size_t MiB = 1u << 20;
constexpr size_t WS_WT    = 0;
constexpr size_t WS_XB    = 112 * MiB;
constexpr size_t WS_ON    = 112 * MiB;
constexpr size_t WS_YBUF  = 112 * MiB;
constexpr size_t WS_Q     = 176 * MiB;
constexpr size_t WS_MERGED= 176 * MiB;
constexpr size_t WS_K     = 240 * MiB;
constexpr size_t WS_X1B   = 240 * MiB;
constexpr size_t WS_V     = 304 * MiB;
constexpr size_t WS_H     = 304 * MiB;
constexpr size_t WS_U     = 368 * MiB;
constexpr size_t WS_MIXED = 400 * MiB;
constexpr size_t WS_ROPE  = 432 * MiB;
constexpr size_t WS_MISC  = 440 * MiB;
constexpr size_t WS_TEMP  = 448 * MiB;
constexpr size_t WS_END   = 512 * MiB;
constexpr size_t MS_CTL   = 0;
constexpr size_t MS_STATS = 64 * 1024;
constexpr size_t MS_ROUTE = 512 * 1024;
constexpr size_t MS_LIST  = 1 * MiB;
constexpr size_t MS_SCAL  = 6 * MiB;

__device__ __forceinline__ float bf2f(bf16_t v) { return __uint_as_float((unsigned)v << 16); }
__device__ __forceinline__ bf16_t f2bf(float f) { unsigned u = __float_as_uint(f); return (bf16_t)((u + 0x7fffu + ((u >> 16) & 1u)) >> 16); }
__host__ __device__ __forceinline__ int qk_pos_of_d(int d) { return ((d >> 4) & 1) * 32 + ((d >> 2) & 3) * 8 + (d >> 5) * 4 + (d & 3); }

struct AL_F32  { const float* p; int ld;  __device__ __forceinline__ float operator()(int r, int k) const { return p[(size_t)r * ld + k]; } };
struct AL_BF16 { const bf16_t* p; int ld; __device__ __forceinline__ float operator()(int r, int k) const { return bf2f(p[(size_t)r * ld + k]); } };
struct AL_POOL { const bf16_t* u; int g;
    __device__ __forceinline__ float operator()(int r, int k) const {
        const int w = 2 << g, s = r & (SEQ - 1); const int n = (s + 1 < w) ? s + 1 : w; float acc = 0.f;
        for (int i = 0; i < n; ++i) acc += bf2f(u[(size_t)(r - i) * PW + g * PGD + k]);
        return acc / (float)n - bf2f(u[(size_t)r * PW + g * PGD + k]); } };

template <class AL>
__global__ __launch_bounds__(256) void ngemm(AL al, const float* __restrict__ Bm, int ldb, float* __restrict__ C, int ldc, int M, int N, int K) {
    __shared__ float As[16][68]; __shared__ float Bs[16][68];
    const int tid = threadIdx.x, tx = tid & 15, ty = tid >> 4; const int m0 = blockIdx.y * 64, n0 = blockIdx.x * 64;
    float acc[4][4] = {};
    for (int k0 = 0; k0 < K; k0 += 16) {
#pragma unroll
        for (int i = 0; i < 4; ++i) { const int e = tid + i * 256; const int r = e >> 4, kk = e & 15; As[kk][r] = (m0 + r < M) ? al(m0 + r, k0 + kk) : 0.f; }
#pragma unroll
        for (int i = 0; i < 4; ++i) { const int e = tid + i * 256; const int kk = e >> 6, c = e & 63; Bs[kk][c] = (n0 + c < N) ? Bm[(size_t)(k0 + kk) * ldb + n0 + c] : 0.f; }
        __syncthreads();
#pragma unroll
        for (int kk = 0; kk < 16; ++kk) { float a[4], b[4];
#pragma unroll
            for (int i = 0; i < 4; ++i) { a[i] = As[kk][ty * 4 + i]; b[i] = Bs[kk][tx * 4 + i]; }
#pragma unroll
            for (int i = 0; i < 4; ++i)
#pragma unroll
                for (int j = 0; j < 4; ++j) acc[i][j] = fmaf(a[i], b[j], acc[i][j]); }
        __syncthreads();
    }
#pragma unroll
    for (int i = 0; i < 4; ++i)
#pragma unroll
        for (int j = 0; j < 4; ++j) { const int r = m0 + ty * 4 + i, c = n0 + tx * 4 + j; if (r < M && c < N) C[(size_t)r * ldc + c] = acc[i][j]; }
}

__global__ void k_prep(const int* __restrict__ positions, const float* __restrict__ lam_vecs, float2* __restrict__ rope, float* __restrict__ scal, unsigned* __restrict__ ctl) {
    const int gid = blockIdx.x * blockDim.x + threadIdx.x;
    if (gid < T * 32) { const int t = gid >> 5, i = gid & 31;
        const float inv = powf(10000.0f, -(float)i * (2.0f / 64.0f)); const float ang = (float)positions[t] * inv;
        const double a = (double)ang; rope[gid] = make_float2((float)cos(a), (float)sin(a)); }
    if (gid < 16384) ctl[gid] = 0u;
    if (gid == 0) { float s01 = 0.f, s23 = 0.f; for (int i = 0; i < 64; ++i) { s01 += lam_vecs[i] * lam_vecs[64 + i]; s23 += lam_vecs[128 + i] * lam_vecs[192 + i]; }
        scal[0] = expf(s01) - expf(s23) + LAMBDA_INIT; }
}
__global__ void post_qk(const float* __restrict__ tmp, const float2* __restrict__ rope, bf16_t* __restrict__ out, int m0, int Mc, float scale) {
    const int gid = blockIdx.x * blockDim.x + threadIdx.x; if (gid >= Mc * 512) return;
    const int r = gid >> 9, p = gid & 511, hm = p >> 5, i = p & 31; const int t = m0 + r;
    const float t1 = tmp[(size_t)r * 1024 + hm * 64 + i], t2 = tmp[(size_t)r * 1024 + hm * 64 + i + 32]; const float2 cs = rope[t * 32 + i];
    out[(size_t)t * 1024 + hm * 64 + qk_pos_of_d(i)] = f2bf((t1 * cs.x - t2 * cs.y) * scale);
    out[(size_t)t * 1024 + hm * 64 + qk_pos_of_d(i + 32)] = f2bf((t2 * cs.x + t1 * cs.y) * scale);
}
__global__ void post_plain(const float* __restrict__ tmp, bf16_t* __restrict__ out, int ldo, int coloff, int m0, int Mc, int N, const float* __restrict__ colscale) {
    const int gid = blockIdx.x * blockDim.x + threadIdx.x; if (gid >= Mc * N) return;
    const int r = gid / N, c = gid % N; float v = tmp[(size_t)r * N + c]; if (colscale) v *= colscale[c];
    out[(size_t)(m0 + r) * ldo + coloff + c] = f2bf(v);
}
__global__ void post_gate(const float* __restrict__ tmp, const float* __restrict__ bias, bf16_t* __restrict__ gates, int coloff, int m0, int Mc) {
    const int gid = blockIdx.x * blockDim.x + threadIdx.x; if (gid >= Mc * 1024) return;
    const int r = gid >> 10, c = gid & 1023; const float v = tmp[(size_t)r * 1024 + c] + bias[coloff + c];
    gates[(size_t)(m0 + r) * 2048 + coloff + c] = f2bf(1.f / (1.f + expf(-v)));
}
__global__ __launch_bounds__(64) void nattn(const bf16_t* __restrict__ q, const bf16_t* __restrict__ k, const bf16_t* __restrict__ v, const float* __restrict__ scal, float* __restrict__ tmp, int m0) {
    const int lane = threadIdx.x; const int blk = blockIdx.x;
    const int half = blk & 1, head = (blk >> 1) & 7, cg = blk >> 4; const int t0 = m0 + cg * 64, t = t0 + lane; const int b = t0 / SEQ, s0 = t0 % SEQ; const int nkeys = ((s0 >> 6) + 1) * 64;
    const float lam = scal[0];
    float res[64];
    for (int mp = 0; mp < 2; ++mp) {
        const int hm = head * 2 + mp; float qv[64];
#pragma unroll
        for (int d = 0; d < 64; ++d) qv[d] = bf2f(q[(size_t)t * 1024 + hm * 64 + d]);
        float mx = -1e30f, l = 0.f; float o[64];
#pragma unroll
        for (int d = 0; d < 64; ++d) o[d] = 0.f;
        for (int j = 0; j < nkeys; ++j) { const size_t kr = (size_t)(b * SEQ + j) * 1024; float sc = 0.f;
            const uint4* kp = (const uint4*)(k + kr + hm * 64); const uint4* vp = (const uint4*)(v + kr + head * 128 + half * 64);
#pragma unroll
            for (int c = 0; c < 8; ++c) { const uint4 w = kp[c]; const unsigned ww[4] = {w.x, w.y, w.z, w.w};
#pragma unroll
                for (int e = 0; e < 4; ++e) { sc = fmaf(qv[c * 8 + 2 * e], __uint_as_float(ww[e] << 16), sc); sc = fmaf(qv[c * 8 + 2 * e + 1], __uint_as_float(ww[e] & 0xffff0000u), sc); } }
            const float mn = fmaxf(mx, sc), al = exp2f(mx - mn), p = exp2f(sc - mn); mx = mn; l = l * al + p;
#pragma unroll
            for (int c = 0; c < 8; ++c) { const uint4 w = vp[c]; const unsigned ww[4] = {w.x, w.y, w.z, w.w};
#pragma unroll
                for (int e = 0; e < 4; ++e) { o[c * 8 + 2 * e] = fmaf(p, __uint_as_float(ww[e] << 16), o[c * 8 + 2 * e] * al); o[c * 8 + 2 * e + 1] = fmaf(p, __uint_as_float(ww[e] & 0xffff0000u), o[c * 8 + 2 * e + 1] * al); } } }
        const float il = 1.f / l;
#pragma unroll
        for (int d = 0; d < 64; ++d) res[d] = (mp == 0) ? o[d] * il : res[d] - lam * o[d] * il;
    }
#pragma unroll
    for (int d = 0; d < 64; ++d) tmp[(size_t)(t - m0) * 1024 + head * 128 + half * 64 + d] = res[d];
}
__global__ void post_rms(const float* __restrict__ tmp, const float* __restrict__ gain, bf16_t* __restrict__ on, int m0, int Mc) {
    const int gid = blockIdx.x * blockDim.x + threadIdx.x; if (gid >= Mc * 8) return;
    const int r = gid >> 3, head = gid & 7; const float* p = tmp + (size_t)r * 1024 + head * 128; float ss = 0.f;
    for (int d = 0; d < 128; ++d) ss += p[d] * p[d];
    const float rs = 1.0f / sqrtf(ss * (1.f / 128.f) + RMS_EPS);
    for (int d = 0; d < 128; ++d) on[(size_t)(m0 + r) * 1024 + head * 128 + d] = f2bf(p[d] * rs * gain[d] * (1.f - LAMBDA_INIT));
}
__global__ void post_merge(const float* __restrict__ tmp, const bf16_t* __restrict__ gates, bf16_t* __restrict__ merged, int br, int m0, int Mc) {
    const int gid = blockIdx.x * blockDim.x + threadIdx.x; if (gid >= Mc * 1024) return;
    const int r = gid >> 10, c = gid & 1023; const size_t t = m0 + r; const float g = bf2f(gates[t * 2048 + br * 1024 + c]);
    float val = g * tmp[(size_t)r * 1024 + c]; if (br) val += bf2f(merged[t * 1024 + c]);
    merged[t * 1024 + c] = f2bf(val);
}
__global__ void post_y(const float* __restrict__ tmp, const float* __restrict__ x, float* __restrict__ y, int m0, int Mc) {
    const int gid = blockIdx.x * blockDim.x + threadIdx.x; if (gid >= Mc * 1024) return;
    const size_t o = (size_t)m0 * 1024 + gid; y[o] = ALPHA * x[o] + tmp[gid];
}
__device__ __forceinline__ float wave_sum(float v) {
#pragma unroll
    for (int o = 1; o < 64; o <<= 1) v += __shfl_xor(v, o);
    return v;
}
__global__ __launch_bounds__(256) void k_router(const float* __restrict__ y, const float* __restrict__ g1, const float* __restrict__ b1, const float* __restrict__ wrg, const float* __restrict__ brg,
                                                const float* __restrict__ wre, const float* __restrict__ bre, bf16_t* __restrict__ x1b, float2* __restrict__ stats, int2* __restrict__ rexp, float2* __restrict__ rw,
                                                int* __restrict__ list, unsigned* __restrict__ cnt) {
    const int lane = threadIdx.x & 63; const int t = blockIdx.x * 4 + (threadIdx.x >> 6);
    const float* yr = y + (size_t)t * 1024; float xv[16]; float s = 0.f;
#pragma unroll
    for (int j = 0; j < 4; ++j) { const f32x4 vv = *(const f32x4*)(yr + j * 256 + lane * 4); xv[4 * j] = vv.x; xv[4 * j + 1] = vv.y; xv[4 * j + 2] = vv.z; xv[4 * j + 3] = vv.w; s += (vv.x + vv.y) + (vv.z + vv.w); }
    const float mu = wave_sum(s) * (1.f / 1024.f); float s2 = 0.f;
#pragma unroll
    for (int i = 0; i < 16; ++i) { const float d = xv[i] - mu; s2 += d * d; }
    const float rstd = 1.0f / sqrtf(wave_sum(s2) * (1.f / 1024.f) + LN_EPS);
    if (lane == 0) stats[t] = make_float2(mu, rstd);
#pragma unroll
    for (int j = 0; j < 4; ++j)
#pragma unroll
        for (int i = 0; i < 4; ++i) { const int c = j * 256 + lane * 4 + i; xv[4 * j + i] = (xv[4 * j + i] - mu) * rstd * g1[c] + b1[c]; }
#pragma unroll
    for (int j = 0; j < 4; ++j) { uint2 w; w.x = (unsigned)f2bf(xv[4 * j]) | ((unsigned)f2bf(xv[4 * j + 1]) << 16); w.y = (unsigned)f2bf(xv[4 * j + 2]) | ((unsigned)f2bf(xv[4 * j + 3]) << 16);
        *(uint2*)(x1b + (size_t)t * 1024 + j * 256 + lane * 4) = w; }
    float lg[4], le[32];
#pragma unroll
    for (int o = 0; o < 4; ++o) { float a = 0.f;
#pragma unroll
        for (int j = 0; j < 4; ++j)
#pragma unroll
            for (int i = 0; i < 4; ++i) a = fmaf(xv[4 * j + i], wrg[(size_t)(j * 256 + lane * 4 + i) * 4 + o], a);
        lg[o] = wave_sum(a) + brg[o]; }
#pragma unroll
    for (int o = 0; o < 32; ++o) { float a = 0.f;
#pragma unroll
        for (int j = 0; j < 4; ++j)
#pragma unroll
            for (int i = 0; i < 4; ++i) a = fmaf(xv[4 * j + i], wre[(size_t)(j * 256 + lane * 4 + i) * 32 + o], a);
        le[o] = wave_sum(a) + bre[o]; }
    if (lane == 0) {
        int gi = 0; float gm = lg[0];
#pragma unroll
        for (int o = 1; o < 4; ++o) if (lg[o] > gm) { gm = lg[o]; gi = o; }
        float gs = 0.f;
#pragma unroll
        for (int o = 0; o < 4; ++o) gs += expf(lg[o] - gm);
        const float gp = 1.f / gs;
        float ev[8];
#pragma unroll
        for (int o = 0; o < 8; ++o) { float vsel = le[o];
#pragma unroll
            for (int g = 1; g < 4; ++g) vsel = (gi == g) ? le[g * 8 + o] : vsel;
            ev[o] = vsel; }
        int i0 = 0; float m0v = ev[0];
#pragma unroll
        for (int o = 1; o < 8; ++o) if (ev[o] > m0v) { m0v = ev[o]; i0 = o; }
        int i1 = -1; float m1v = -3.4e38f;
#pragma unroll
        for (int o = 0; o < 8; ++o) if (o != i0 && ev[o] > m1v) { m1v = ev[o]; i1 = o; }
        const float e1 = expf(m1v - m0v); const float w0 = gp / (1.f + e1), w1 = gp * e1 / (1.f + e1);
        const int ex0 = gi * 8 + i0, ex1 = gi * 8 + i1;
        rexp[t] = make_int2(ex0, ex1); rw[t] = make_float2(w0, w1);
        const unsigned p0 = atomicAdd(&cnt[ex0], 1u); list[(size_t)ex0 * T + p0] = t * 2;
        const unsigned p1 = atomicAdd(&cnt[ex1], 1u); list[(size_t)ex1 * T + p1] = t * 2 + 1;
    }
}
__global__ __launch_bounds__(256) void nmoe_gu(const bf16_t* __restrict__ x1b, const int* __restrict__ list, const unsigned* __restrict__ cnt, const float* __restrict__ wgu, bf16_t* __restrict__ h) {
    __shared__ float As[16][68]; __shared__ float Bg[16][68]; __shared__ float Bu[16][68]; __shared__ int toks[64];
    const int e = blockIdx.z; const int M = (int)cnt[e]; const int m0 = blockIdx.y * 64, n0 = blockIdx.x * 64; if (m0 >= M) return;
    int tb = 0; for (int i = 0; i < e; ++i) tb += ((int)cnt[i] + 255) >> 8;
    const int tid = threadIdx.x, tx = tid & 15, ty = tid >> 4;
    if (tid < 64) toks[tid] = (m0 + tid < M) ? (list[(size_t)e * T + m0 + tid] >> 1) : 0;
    __syncthreads();
    const float* W = wgu + (size_t)e * 1024 * 1024; float ag[4][4] = {}, au[4][4] = {};
    for (int k0 = 0; k0 < 1024; k0 += 16) {
#pragma unroll
        for (int i = 0; i < 4; ++i) { const int el = tid + i * 256; const int r = el >> 4, kk = el & 15; As[kk][r] = bf2f(x1b[(size_t)toks[r] * 1024 + k0 + kk]); }
#pragma unroll
        for (int i = 0; i < 4; ++i) { const int el = tid + i * 256; const int kk = el >> 6, c = el & 63; Bg[kk][c] = W[(size_t)(k0 + kk) * 1024 + n0 + c]; Bu[kk][c] = W[(size_t)(k0 + kk) * 1024 + 512 + n0 + c]; }
        __syncthreads();
#pragma unroll
        for (int kk = 0; kk < 16; ++kk) { float a[4], bg[4], bu[4];
#pragma unroll
            for (int i = 0; i < 4; ++i) { a[i] = As[kk][ty * 4 + i]; bg[i] = Bg[kk][tx * 4 + i]; bu[i] = Bu[kk][tx * 4 + i]; }
#pragma unroll
            for (int i = 0; i < 4; ++i)
#pragma unroll
                for (int j = 0; j < 4; ++j) { ag[i][j] = fmaf(a[i], bg[j], ag[i][j]); au[i][j] = fmaf(a[i], bu[j], au[i][j]); } }
        __syncthreads();
    }
#pragma unroll
    for (int i = 0; i < 4; ++i)
#pragma unroll
        for (int j = 0; j < 4; ++j) { const int r = m0 + ty * 4 + i, c = n0 + tx * 4 + j; if (r < M) { const float g = ag[i][j]; h[((size_t)tb * 256 + r) * 512 + c] = f2bf(g / (1.f + expf(-g)) * au[i][j]); } }
}
__global__ __launch_bounds__(256) void nmoe_dn(const bf16_t* __restrict__ h, const int* __restrict__ list, const unsigned* __restrict__ cnt, const float2* __restrict__ rw, const float* __restrict__ wdn, bf16_t* __restrict__ ybuf) {
    __shared__ float As[16][68]; __shared__ float Bs[16][68];
    const int e = blockIdx.z; const int M = (int)cnt[e]; const int m0 = blockIdx.y * 64, n0 = blockIdx.x * 64; if (m0 >= M) return;
    int tb = 0; for (int i = 0; i < e; ++i) tb += ((int)cnt[i] + 255) >> 8;
    const int tid = threadIdx.x, tx = tid & 15, ty = tid >> 4;
    const float* W = wdn + (size_t)e * 512 * 1024; float acc[4][4] = {};
    for (int k0 = 0; k0 < 512; k0 += 16) {
#pragma unroll
        for (int i = 0; i < 4; ++i) { const int el = tid + i * 256; const int r = el >> 4, kk = el & 15; As[kk][r] = (m0 + r < M) ? bf2f(h[((size_t)tb * 256 + m0 + r) * 512 + k0 + kk]) : 0.f; }
#pragma unroll
        for (int i = 0; i < 4; ++i) { const int el = tid + i * 256; const int kk = el >> 6, c = el & 63; Bs[kk][c] = W[(size_t)(k0 + kk) * 1024 + n0 + c]; }
        __syncthreads();
#pragma unroll
        for (int kk = 0; kk < 16; ++kk) { float a[4], b[4];
#pragma unroll
            for (int i = 0; i < 4; ++i) { a[i] = As[kk][ty * 4 + i]; b[i] = Bs[kk][tx * 4 + i]; }
#pragma unroll
            for (int i = 0; i < 4; ++i)
#pragma unroll
                for (int j = 0; j < 4; ++j) acc[i][j] = fmaf(a[i], b[j], acc[i][j]); }
        __syncthreads();
    }
#pragma unroll
    for (int i = 0; i < 4; ++i) { const int r = m0 + ty * 4 + i; if (r < M) { const int ent = list[(size_t)e * T + r]; const float2 w2 = rw[ent >> 1]; const float w = (ent & 1) ? w2.y : w2.x;
#pragma unroll
        for (int j = 0; j < 4; ++j) ybuf[(size_t)ent * 1024 + n0 + tx * 4 + j] = f2bf(w * acc[i][j]); } }
}
__global__ __launch_bounds__(256) void k_final(float* __restrict__ yout, const float2* __restrict__ stats, const float* __restrict__ g1, const float* __restrict__ b1, const bf16_t* __restrict__ ybuf,
                                               const float* __restrict__ g2, const float* __restrict__ b2) {
    const int lane = threadIdx.x & 63; const int t = blockIdx.x * 4 + (threadIdx.x >> 6);
    float* yr = yout + (size_t)t * 1024; const float2 st = stats[t]; float xv[16]; float s = 0.f;
#pragma unroll
    for (int j = 0; j < 4; ++j) { const int c0 = j * 256 + lane * 4; const f32x4 vv = *(const f32x4*)(yr + c0); const f32x4 gg = *(const f32x4*)(g1 + c0); const f32x4 bb = *(const f32x4*)(b1 + c0);
        const uint2 a = *(const uint2*)(ybuf + (size_t)(2 * t) * 1024 + c0); const uint2 b = *(const uint2*)(ybuf + (size_t)(2 * t + 1) * 1024 + c0);
        const float ya[4] = {__uint_as_float(a.x << 16), __uint_as_float(a.x & 0xffff0000u), __uint_as_float(a.y << 16), __uint_as_float(a.y & 0xffff0000u)};
        const float yb[4] = {__uint_as_float(b.x << 16), __uint_as_float(b.x & 0xffff0000u), __uint_as_float(b.y << 16), __uint_as_float(b.y & 0xffff0000u)};
#pragma unroll
        for (int i = 0; i < 4; ++i) { const float x1 = (vv[i] - st.x) * st.y * gg[i] + bb[i]; const float val = ALPHA * x1 + (ya[i] + yb[i]); xv[4 * j + i] = val; s += val; } }
    const float mu = wave_sum(s) * (1.f / 1024.f); float s2 = 0.f;
#pragma unroll
    for (int i = 0; i < 16; ++i) { const float d = xv[i] - mu; s2 += d * d; }
    const float rstd = 1.0f / sqrtf(wave_sum(s2) * (1.f / 1024.f) + LN_EPS);
#pragma unroll
    for (int j = 0; j < 4; ++j) { const int c0 = j * 256 + lane * 4; const f32x4 gg = *(const f32x4*)(g2 + c0); const f32x4 bb = *(const f32x4*)(b2 + c0); f32x4 o;
#pragma unroll
        for (int i = 0; i < 4; ++i) o[i] = (xv[4 * j + i] - mu) * rstd * gg[i] + bb[i];
        *(f32x4*)(yr + c0) = o; }
}

extern "C" void kernel_launch(void* const* d_in, const int* in_sizes, int n_in, void* d_out, int out_size, void* d_ws, size_t ws_size, hipStream_t stream) {
    if (n_in != 21 || in_sizes[0] != T * DM || out_size != T * DM || ws_size < WS_END) { fprintf(stderr, "kernel_launch: unexpected shapes (n_in %d, x %d, out %d, ws %zu)\n", n_in, n_in > 0 ? in_sizes[0] : -1, out_size, ws_size); return; }
    const float* x = (const float*)d_in[0]; const int* positions = (const int*)d_in[1]; const float* w_in = (const float*)d_in[2]; const float* gate_bias = (const float*)d_in[3];
    const float* lam_vecs = (const float*)d_in[4]; const float* subln_gain = (const float*)d_in[5]; const float* w_pool = (const float*)d_in[6]; const float* pool_scale = (const float*)d_in[7];
    const float* w_branch_a = (const float*)d_in[8]; const float* w_branch_b = (const float*)d_in[9]; const float* w_out = (const float*)d_in[10]; const float* ln1_g = (const float*)d_in[11];
    const float* ln1_b = (const float*)d_in[12]; const float* wrg = (const float*)d_in[13]; const float* brg = (const float*)d_in[14]; const float* wre = (const float*)d_in[15];
    const float* bre = (const float*)d_in[16]; const float* wgu = (const float*)d_in[17]; const float* wdn = (const float*)d_in[18]; const float* ln2_g = (const float*)d_in[19]; const float* ln2_b = (const float*)d_in[20];
    char* ws = (char*)d_ws; float* out = (float*)d_out;
    bf16_t* qb = (bf16_t*)(ws + WS_Q); bf16_t* kb = (bf16_t*)(ws + WS_K); bf16_t* vb = (bf16_t*)(ws + WS_V); bf16_t* ub = (bf16_t*)(ws + WS_U); bf16_t* gb = (bf16_t*)d_out;
    bf16_t* on = (bf16_t*)(ws + WS_ON); bf16_t* mixed = (bf16_t*)(ws + WS_MIXED); bf16_t* merged = (bf16_t*)(ws + WS_MERGED); bf16_t* x1b = (bf16_t*)(ws + WS_X1B);
    bf16_t* hb = (bf16_t*)(ws + WS_H); bf16_t* ybuf = (bf16_t*)(ws + WS_YBUF); float2* rope = (float2*)(ws + WS_ROPE); float* tmp = (float*)(ws + WS_TEMP);
    char* misc = ws + WS_MISC; unsigned* ctl = (unsigned*)(misc + MS_CTL); float2* stats = (float2*)(misc + MS_STATS); int2* rexp = (int2*)(misc + MS_ROUTE); float2* rw = (float2*)(misc + MS_ROUTE + (size_t)T * 8);
    int* list = (int*)(misc + MS_LIST); float* scal = (float*)(misc + MS_SCAL); unsigned* cnt = ctl;

    k_prep<<<T * 32 / 256, 256, 0, stream>>>(positions, lam_vecs, rope, scal, ctl);
    constexpr int MC = 16384;
    for (int mh = 0; mh < 2; ++mh) {
        const int m0 = mh * MC; AL_F32 ax{x + (size_t)m0 * DM, DM};
        for (int qk = 0; qk < 2; ++qk) {
            ngemm<AL_F32><<<dim3(16, MC / 64), 256, 0, stream>>>(ax, w_in + qk * 1024, INW, tmp, 1024, MC, 1024, DM);
            post_qk<<<MC * 512 / 256, 256, 0, stream>>>(tmp, rope, qk ? kb : qb, m0, MC, qk ? 1.f : QSCALE);
        }
        ngemm<AL_F32><<<dim3(16, MC / 64), 256, 0, stream>>>(ax, w_in + 2048, INW, tmp, 1024, MC, 1024, DM);
        post_plain<<<MC * 1024 / 256, 256, 0, stream>>>(tmp, vb, 1024, 0, m0, MC, 1024, nullptr);
        ngemm<AL_F32><<<dim3(8, MC / 64), 256, 0, stream>>>(ax, w_in + 3072, INW, tmp, 512, MC, 512, DM);
        post_plain<<<MC * 512 / 256, 256, 0, stream>>>(tmp, ub, 512, 0, m0, MC, 512, nullptr);
        for (int br = 0; br < 2; ++br) {
            ngemm<AL_F32><<<dim3(16, MC / 64), 256, 0, stream>>>(ax, w_in + 3584 + br * 1024, INW, tmp, 1024, MC, 1024, DM);
            post_gate<<<MC * 1024 / 256, 256, 0, stream>>>(tmp, gate_bias, gb, br * 1024, m0, MC);
        }
    }
    for (int mh = 0; mh < 2; ++mh) {
        const int m0 = mh * MC;
        nattn<<<(MC / 64) * 16, 64, 0, stream>>>(qb, kb, vb, scal, tmp, m0);
        post_rms<<<MC * 8 / 256, 256, 0, stream>>>(tmp, subln_gain, on, m0, MC);
        for (int g = 0; g < 4; ++g) { AL_POOL ap{ub + (size_t)m0 * PW, g};
            ngemm<AL_POOL><<<dim3(2, MC / 64), 256, 0, stream>>>(ap, w_pool + (size_t)g * 128 * 128, 128, tmp + g * 128, 512, MC, 128, 128); }
        post_plain<<<MC * 512 / 256, 256, 0, stream>>>(tmp, mixed, 512, 0, m0, MC, 512, pool_scale);
    }
    for (int mh = 0; mh < 2; ++mh) {
        const int m0 = mh * MC;
        { AL_BF16 a{on + (size_t)m0 * 1024, 1024}; ngemm<AL_BF16><<<dim3(16, MC / 64), 256, 0, stream>>>(a, w_branch_a, 1024, tmp, 1024, MC, 1024, 1024); }
        post_merge<<<MC * 1024 / 256, 256, 0, stream>>>(tmp, gb, merged, 0, m0, MC);
        { AL_BF16 a{mixed + (size_t)m0 * 512, 512}; ngemm<AL_BF16><<<dim3(16, MC / 64), 256, 0, stream>>>(a, w_branch_b, 1024, tmp, 1024, MC, 1024, 512); }
        post_merge<<<MC * 1024 / 256, 256, 0, stream>>>(tmp, gb, merged, 1, m0, MC);
    }
    for (int mh = 0; mh < 2; ++mh) {
        const int m0 = mh * MC;
        { AL_BF16 a{merged + (size_t)m0 * 1024, 1024}; ngemm<AL_BF16><<<dim3(16, MC / 64), 256, 0, stream>>>(a, w_out, 1024, tmp, 1024, MC, 1024, 1024); }
        post_y<<<MC * 1024 / 256, 256, 0, stream>>>(tmp, x, out, m0, MC);
    }
    k_router<<<T / 4, 256, 0, stream>>>(out, ln1_g, ln1_b, wrg, brg, wre, bre, x1b, stats, rexp, rw, list, cnt);
    nmoe_gu<<<dim3(8, T / 64, NE), 256, 0, stream>>>(x1b, list, cnt, wgu, hb);
    nmoe_dn<<<dim3(16, T / 64, NE), 256, 0, stream>>>(hb, list, cnt, rw, wdn, ybuf);
    k_final<<<T / 4, 256, 0, stream>>>(out, stats, ln1_g, ln1_b, ybuf, ln2_g, ln2_b);
}
```

```cpp
#define MK_OPT 0xff7u
#define MK_ONE 2
#include <hip/hip_runtime.h>
#include <cstdio>
#include <cstdint>
#include <cmath>

typedef unsigned short bf16_t;
typedef float f32x4 __attribute__((ext_vector_type(4)));

constexpr int NB = 16, SEQ = 2048, DM = 1024, T = NB * SEQ;
constexpr int NHEAD = 8, HD = 64, NHM = 16;
constexpr int INW = 5632;
constexpr int PW = 512, PG = 4, PGD = 128;
constexpr int NE = 32, NGRP = 4, EPG = 8, FF = 512;
constexpr float LN_EPS = 1e-5f, RMS_EPS = 1e-5f;
constexpr float ALPHA = 1.189207115002721f;
constexpr float LAMBDA_INIT = 0.2f;
constexpr float QSCALE = 0.125f * 1.4426950408889634f;

constexpr size_t MiB = 1u << 20;
constexpr size_t WS_WT    = 0;
constexpr size_t WS_XB    = 112 * MiB;
constexpr size_t WS_ON    = 112 * MiB;
constexpr size_t WS_YBUF  = 112 * MiB;
constexpr size_t WS_Q     = 176 * MiB;
constexpr size_t WS_MERGED= 176 * MiB;
constexpr size_t WS_K     = 240 * MiB;
constexpr size_t WS_X1B   = 240 * MiB;
constexpr size_t WS_V     = 304 * MiB;
constexpr size_t WS_H     = 304 * MiB;
constexpr size_t WS_U     = 368 * MiB;
constexpr size_t WS_MIXED = 400 * MiB;
constexpr size_t WS_ROPE  = 432 * MiB;
constexpr size_t WS_MISC  = 440 * MiB;
constexpr size_t WS_TEMP  = 448 * MiB;
constexpr size_t WS_END   = 512 * MiB;
constexpr size_t MS_CTL   = 0;
constexpr size_t MS_STATS = 64 * 1024;
constexpr size_t MS_ROUTE = 512 * 1024;
constexpr size_t MS_LIST  = 1 * MiB;
constexpr size_t MS_SCAL  = 6 * MiB;

__device__ __forceinline__ float bf2f(bf16_t v) { return __uint_as_float((unsigned)v << 16); }
__device__ __forceinline__ bf16_t f2bf(float f) { unsigned u = __float_as_uint(f); return (bf16_t)((u + 0x7fffu + ((u >> 16) & 1u)) >> 16); }
__host__ __device__ __forceinline__ int qk_pos_of_d(int d) { return ((d >> 4) & 1) * 32 + ((d >> 2) & 3) * 8 + (d >> 5) * 4 + (d & 3); }

struct AL_F32  { const float* p; int ld; int pad;  __device__ __forceinline__ float operator()(int r, int k) const { return p[(size_t)r * ld + k]; } };
struct AL_BF16 { const bf16_t* p; int ld; int pad; __device__ __forceinline__ float operator()(int r, int k) const { return bf2f(p[(size_t)r * ld + k]); } };
struct AL_POOL { const bf16_t* u; int g; int pad;
    __device__ __forceinline__ float operator()(int r, int k) const {
        const int w = 2 << g, s = r & (SEQ - 1); const int n = (s + 1 < w) ? s + 1 : w; float acc = 0.f;
        for (int i = 0; i < n; ++i) acc += bf2f(u[(size_t)(r - i) * PW + g * PGD + k]);
        return acc / (float)n - bf2f(u[(size_t)r * PW + g * PGD + k]); } };

template <class AL>
__global__ __launch_bounds__(256) void ngemm(AL al, const float* __restrict__ Bm, int ldb, float* __restrict__ C, int ldc, int M, int N, int K) {
    __shared__ float As[16][68]; __shared__ float Bs[16][68];
    const int tid = threadIdx.x, tx = tid & 15, ty = tid >> 4; const int m0 = blockIdx.y * 64, n0 = blockIdx.x * 64;
    float acc[4][4] = {};
    for (int k0 = 0; k0 < K; k0 += 16) {
#pragma unroll
        for (int i = 0; i < 4; ++i) { const int e = tid + i * 256; const int r = e >> 4, kk = e & 15; As[kk][r] = (m0 + r < M) ? al(m0 + r, k0 + kk) : 0.f; }
#pragma unroll
        for (int i = 0; i < 4; ++i) { const int e = tid + i * 256; const int kk = e >> 6, c = e & 63; Bs[kk][c] = (n0 + c < N) ? Bm[(size_t)(k0 + kk) * ldb + n0 + c] : 0.f; }
        __syncthreads();
#pragma unroll
        for (int kk = 0; kk < 16; ++kk) { float a[4], b[4];
#pragma unroll
            for (int i = 0; i < 4; ++i) { a[i] = As[kk][ty * 4 + i]; b[i] = Bs[kk][tx * 4 + i]; }
#pragma unroll
            for (int i = 0; i < 4; ++i)
#pragma unroll
                for (int j = 0; j < 4; ++j) acc[i][j] = fmaf(a[i], b[j], acc[i][j]); }
        __syncthreads();
    }
#pragma unroll
    for (int i = 0; i < 4; ++i)
#pragma unroll
        for (int j = 0; j < 4; ++j) { const int r = m0 + ty * 4 + i, c = n0 + tx * 4 + j; if (r < M && c < N) C[(size_t)r * ldc + c] = acc[i][j]; }
}

__global__ void k_prep(const int* __restrict__ positions, const float* __restrict__ lam_vecs, float2* __restrict__ rope, float* __restrict__ scal, unsigned* __restrict__ ctl) {
    const int gid = blockIdx.x * blockDim.x + threadIdx.x;
    if (gid < T * 32) { const int t = gid >> 5, i = gid & 31;
        const float inv = powf(10000.0f, -(float)i * (2.0f / 64.0f)); const float ang = (float)positions[t] * inv;
        const double a = (double)ang; rope[gid] = make_float2((float)cos(a), (float)sin(a)); }
    if (gid < 16384) ctl[gid] = 0u;
    if (gid == 0) { float s01 = 0.f, s23 = 0.f; for (int i = 0; i < 64; ++i) { s01 += lam_vecs[i] * lam_vecs[64 + i]; s23 += lam_vecs[128 + i] * lam_vecs[192 + i]; }
        scal[0] = expf(s01) - expf(s23) + LAMBDA_INIT; }
}
__global__ void post_qk(const float* __restrict__ tmp, const float2* __restrict__ rope, bf16_t* __restrict__ out, int m0, int Mc, float scale) {
    const int gid = blockIdx.x * blockDim.x + threadIdx.x; if (gid >= Mc * 512) return;
    const int r = gid >> 9, p = gid & 511, hm = p >> 5, i = p & 31; const int t = m0 + r;
    const float t1 = tmp[(size_t)r * 1024 + hm * 64 + i], t2 = tmp[(size_t)r * 1024 + hm * 64 + i + 32]; const float2 cs = rope[t * 32 + i];
    out[(size_t)t * 1024 + hm * 64 + qk_pos_of_d(i)] = f2bf((t1 * cs.x - t2 * cs.y) * scale);
    out[(size_t)t * 1024 + hm * 64 + qk_pos_of_d(i + 32)] = f2bf((t2 * cs.x + t1 * cs.y) * scale);
}
__global__ void post_plain(const float* __restrict__ tmp, bf16_t* __restrict__ out, int ldo, int coloff, int m0, int Mc, int N, const float* __restrict__ colscale) {
    const int gid = blockIdx.x * blockDim.x + threadIdx.x; if (gid >= Mc * N) return;
    const int r = gid / N, c = gid % N; float v = tmp[(size_t)r * N + c]; if (colscale) v *= colscale[c];
    out[(size_t)(m0 + r) * ldo + coloff + c] = f2bf(v);
}
__global__ void post_gate(const float* __restrict__ tmp, const float* __restrict__ bias, bf16_t* __restrict__ gates, int coloff, int m0, int Mc) {
    const int gid = blockIdx.x * blockDim.x + threadIdx.x; if (gid >= Mc * 1024) return;
    const int r = gid >> 10, c = gid & 1023; const float v = tmp[(size_t)r * 1024 + c] + bias[coloff + c];
    gates[(size_t)(m0 + r) * 2048 + coloff + c] = f2bf(1.f / (1.f + expf(-v)));
}
__global__ __launch_bounds__(64) void nattn(const bf16_t* __restrict__ q, const bf16_t* __restrict__ k, const bf16_t* __restrict__ v, const float* __restrict__ scal, float* __restrict__ tmp, int m0) {
    const int lane = threadIdx.x; const int blk = blockIdx.x;
    const int half = blk & 1, head = (blk >> 1) & 7, cg = blk >> 4; const int t0 = m0 + cg * 64, t = t0 + lane; const int b = t0 / SEQ, s0 = t0 % SEQ; const int nkeys = ((s0 >> 6) + 1) * 64;
    const float lam = scal[0];
    float res[64];
    for (int mp = 0; mp < 2; ++mp) {
        const int hm = head * 2 + mp; float qv[64];
#pragma unroll
        for (int d = 0; d < 64; ++d) qv[d] = bf2f(q[(size_t)t * 1024 + hm * 64 + d]);
        float mx = -1e30f, l = 0.f; float o[64];
#pragma unroll
        for (int d = 0; d < 64; ++d) o[d] = 0.f;
        for (int j = 0; j < nkeys; ++j) { const size_t kr = (size_t)(b * SEQ + j) * 1024; float sc = 0.f;
            const uint4* kp = (const uint4*)(k + kr + hm * 64); const uint4* vp = (const uint4*)(v + kr + head * 128 + half * 64);
#pragma unroll
            for (int c = 0; c < 8; ++c) { const uint4 w = kp[c]; const unsigned ww[4] = {w.x, w.y, w.z, w.w};
#pragma unroll
                for (int e = 0; e < 4; ++e) { sc = fmaf(qv[c * 8 + 2 * e], __uint_as_float(ww[e] << 16), sc); sc = fmaf(qv[c * 8 + 2 * e + 1], __uint_as_float(ww[e] & 0xffff0000u), sc); } }
            const float mn = fmaxf(mx, sc), al = exp2f(mx - mn), p = exp2f(sc - mn); mx = mn; l = l * al + p;
#pragma unroll
            for (int c = 0; c < 8; ++c) { const uint4 w = vp[c]; const unsigned ww[4] = {w.x, w.y, w.z, w.w};
#pragma unroll
                for (int e = 0; e < 4; ++e) { o[c * 8 + 2 * e] = fmaf(p, __uint_as_float(ww[e] << 16), o[c * 8 + 2 * e] * al); o[c * 8 + 2 * e + 1] = fmaf(p, __uint_as_float(ww[e] & 0xffff0000u), o[c * 8 + 2 * e + 1] * al); } } }
        const float il = 1.f / l;
#pragma unroll
        for (int d = 0; d < 64; ++d) res[d] = (mp == 0) ? o[d] * il : res[d] - lam * o[d] * il;
    }
#pragma unroll
    for (int d = 0; d < 64; ++d) tmp[(size_t)(t - m0) * 1024 + head * 128 + half * 64 + d] = res[d];
}
__global__ void post_rms(const float* __restrict__ tmp, const float* __restrict__ gain, bf16_t* __restrict__ on, int m0, int Mc) {
    const int gid = blockIdx.x * blockDim.x + threadIdx.x; if (gid >= Mc * 8) return;
    const int r = gid >> 3, head = gid & 7; const float* p = tmp + (size_t)r * 1024 + head * 128; float ss = 0.f;
    for (int d = 0; d < 128; ++d) ss += p[d] * p[d];
    const float rs = 1.0f / sqrtf(ss * (1.f / 128.f) + RMS_EPS);
    for (int d = 0; d < 128; ++d) on[(size_t)(m0 + r) * 1024 + head * 128 + d] = f2bf(p[d] * rs * gain[d] * (1.f - LAMBDA_INIT));
}
__global__ void post_merge(const float* __restrict__ tmp, const bf16_t* __restrict__ gates, bf16_t* __restrict__ merged, int br, int m0, int Mc) {
    const int gid = blockIdx.x * blockDim.x + threadIdx.x; if (gid >= Mc * 1024) return;
    const int r = gid >> 10, c = gid & 1023; const size_t t = m0 + r; const float g = bf2f(gates[t * 2048 + br * 1024 + c]);
    float val = g * tmp[(size_t)r * 1024 + c]; if (br) val += bf2f(merged[t * 1024 + c]);
    merged[t * 1024 + c] = f2bf(val);
}
__global__ void post_y(const float* __restrict__ tmp, const float* __restrict__ x, float* __restrict__ y, int m0, int Mc) {
    const int gid = blockIdx.x * blockDim.x + threadIdx.x; if (gid >= Mc * 1024) return;
    const size_t o = (size_t)m0 * 1024 + gid; y[o] = ALPHA * x[o] + tmp[gid];
}
__device__ __forceinline__ float wave_sum(float v) {
#pragma unroll
    for (int o = 1; o < 64; o <<= 1) v += __shfl_xor(v, o);
    return v;
}
__global__ __launch_bounds__(256) void k_router(const float* __restrict__ y, const float* __restrict__ g1, const float* __restrict__ b1, const float* __restrict__ wrg, const float* __restrict__ brg,
                                                const float* __restrict__ wre, const float* __restrict__ bre, bf16_t* __restrict__ x1b, float2* __restrict__ stats, int2* __restrict__ rexp, float2* __restrict__ rw,
                                                int* __restrict__ list, unsigned* __restrict__ cnt) {
    const int lane = threadIdx.x & 63; const int t = blockIdx.x * 4 + (threadIdx.x >> 6);
    const float* yr = y + (size_t)t * 1024; float xv[16]; float s = 0.f;
#pragma unroll
    for (int j = 0; j < 4; ++j) { const f32x4 vv = *(const f32x4*)(yr + j * 256 + lane * 4); xv[4 * j] = vv.x; xv[4 * j + 1] = vv.y; xv[4 * j + 2] = vv.z; xv[4 * j + 3] = vv.w; s += (vv.x + vv.y) + (vv.z + vv.w); }
    const float mu = wave_sum(s) * (1.f / 1024.f); float s2 = 0.f;
#pragma unroll
    for (int i = 0; i < 16; ++i) { const float d = xv[i] - mu; s2 += d * d; }
    const float rstd = 1.0f / sqrtf(wave_sum(s2) * (1.f / 1024.f) + LN_EPS);
    if (lane == 0) stats[t] = make_float2(mu, rstd);
#pragma unroll
    for (int j = 0; j < 4; ++j)
#pragma unroll
        for (int i = 0; i < 4; ++i) { const int c = j * 256 + lane * 4 + i; xv[4 * j + i] = (xv[4 * j + i] - mu) * rstd * g1[c] + b1[c]; }
#pragma unroll
    for (int j = 0; j < 4; ++j) { uint2 w; w.x = (unsigned)f2bf(xv[4 * j]) | ((unsigned)f2bf(xv[4 * j + 1]) << 16); w.y = (unsigned)f2bf(xv[4 * j + 2]) | ((unsigned)f2bf(xv[4 * j + 3]) << 16);
        *(uint2*)(x1b + (size_t)t * 1024 + j * 256 + lane * 4) = w; }
    float lg[4], le[32];
#pragma unroll
    for (int o = 0; o < 4; ++o) { float a = 0.f;
#pragma unroll
        for (int j = 0; j < 4; ++j)
#pragma unroll
            for (int i = 0; i < 4; ++i) a = fmaf(xv[4 * j + i], wrg[(size_t)(j * 256 + lane * 4 + i) * 4 + o], a);
        lg[o] = wave_sum(a) + brg[o]; }
#pragma unroll
    for (int o = 0; o < 32; ++o) { float a = 0.f;
#pragma unroll
        for (int j = 0; j < 4; ++j)
#pragma unroll
            for (int i = 0; i < 4; ++i) a = fmaf(xv[4 * j + i], wre[(size_t)(j * 256 + lane * 4 + i) * 32 + o], a);
        le[o] = wave_sum(a) + bre[o]; }
    if (lane == 0) {
        int gi = 0; float gm = lg[0];
#pragma unroll
        for (int o = 1; o < 4; ++o) if (lg[o] > gm) { gm = lg[o]; gi = o; }
        float gs = 0.f;
#pragma unroll
        for (int o = 0; o < 4; ++o) gs += expf(lg[o] - gm);
        const float gp = 1.f / gs;
        float ev[8];
#pragma unroll
        for (int o = 0; o < 8; ++o) { float vsel = le[o];
#pragma unroll
            for (int g = 1; g < 4; ++g) vsel = (gi == g) ? le[g * 8 + o] : vsel;
            ev[o] = vsel; }
        int i0 = 0; float m0v = ev[0];
#pragma unroll
        for (int o = 1; o < 8; ++o) if (ev[o] > m0v) { m0v = ev[o]; i0 = o; }
        int i1 = (i0 == 0) ? 1 : 0; float m1v = -3.4e38f;
#pragma unroll
        for (int o = 0; o < 8; ++o) if (o != i0 && ev[o] > m1v) { m1v = ev[o]; i1 = o; }
        const float e1 = expf(m1v - m0v); const float w0 = gp / (1.f + e1), w1 = gp * e1 / (1.f + e1);
        const int ex0 = gi * 8 + i0, ex1 = gi * 8 + i1;
        rexp[t] = make_int2(ex0, ex1); rw[t] = make_float2(w0, w1);
        const unsigned p0 = atomicAdd(&cnt[ex0], 1u); list[(size_t)ex0 * T + p0] = t * 2;
        const unsigned p1 = atomicAdd(&cnt[ex1], 1u); list[(size_t)ex1 * T + p1] = t * 2 + 1;
    }
}
__global__ __launch_bounds__(256) void nmoe_gu(const bf16_t* __restrict__ x1b, const int* __restrict__ list, const unsigned* __restrict__ cnt, const float* __restrict__ wgu, bf16_t* __restrict__ h) {
    __shared__ float As[16][68]; __shared__ float Bg[16][68]; __shared__ float Bu[16][68]; __shared__ int toks[64];
    const int e = blockIdx.z; const int M = (int)cnt[e]; const int m0 = blockIdx.y * 64, n0 = blockIdx.x * 64; if (m0 >= M) return;
    int tb = 0; for (int i = 0; i < e; ++i) tb += ((int)cnt[i] + 255) >> 8;
    const int tid = threadIdx.x, tx = tid & 15, ty = tid >> 4;
    if (tid < 64) toks[tid] = (m0 + tid < M) ? (list[(size_t)e * T + m0 + tid] >> 1) : 0;
    __syncthreads();
    const float* W = wgu + (size_t)e * 1024 * 1024; float ag[4][4] = {}, au[4][4] = {};
    for (int k0 = 0; k0 < 1024; k0 += 16) {
#pragma unroll
        for (int i = 0; i < 4; ++i) { const int el = tid + i * 256; const int r = el >> 4, kk = el & 15; As[kk][r] = bf2f(x1b[(size_t)toks[r] * 1024 + k0 + kk]); }
#pragma unroll
        for (int i = 0; i < 4; ++i) { const int el = tid + i * 256; const int kk = el >> 6, c = el & 63; Bg[kk][c] = W[(size_t)(k0 + kk) * 1024 + n0 + c]; Bu[kk][c] = W[(size_t)(k0 + kk) * 1024 + 512 + n0 + c]; }
        __syncthreads();
#pragma unroll
        for (int kk = 0; kk < 16; ++kk) { float a[4], bg[4], bu[4];
#pragma unroll
            for (int i = 0; i < 4; ++i) { a[i] = As[kk][ty * 4 + i]; bg[i] = Bg[kk][tx * 4 + i]; bu[i] = Bu[kk][tx * 4 + i]; }
#pragma unroll
            for (int i = 0; i < 4; ++i)
#pragma unroll
                for (int j = 0; j < 4; ++j) { ag[i][j] = fmaf(a[i], bg[j], ag[i][j]); au[i][j] = fmaf(a[i], bu[j], au[i][j]); } }
        __syncthreads();
    }
#pragma unroll
    for (int i = 0; i < 4; ++i)
#pragma unroll
        for (int j = 0; j < 4; ++j) { const int r = m0 + ty * 4 + i, c = n0 + tx * 4 + j; if (r < M) { const float g = ag[i][j]; h[((size_t)tb * 256 + r) * 512 + c] = f2bf(g / (1.f + expf(-g)) * au[i][j]); } }
}
__global__ __launch_bounds__(256) void nmoe_dn(const bf16_t* __restrict__ h, const int* __restrict__ list, const unsigned* __restrict__ cnt, const float2* __restrict__ rw, const float* __restrict__ wdn, bf16_t* __restrict__ ybuf) {
    __shared__ float As[16][68]; __shared__ float Bs[16][68];
    const int e = blockIdx.z; const int M = (int)cnt[e]; const int m0 = blockIdx.y * 64, n0 = blockIdx.x * 64; if (m0 >= M) return;
    int tb = 0; for (int i = 0; i < e; ++i) tb += ((int)cnt[i] + 255) >> 8;
    const int tid = threadIdx.x, tx = tid & 15, ty = tid >> 4;
    const float* W = wdn + (size_t)e * 512 * 1024; float acc[4][4] = {};
    for (int k0 = 0; k0 < 512; k0 += 16) {
#pragma unroll
        for (int i = 0; i < 4; ++i) { const int el = tid + i * 256; const int r = el >> 4, kk = el & 15; As[kk][r] = (m0 + r < M) ? bf2f(h[((size_t)tb * 256 + m0 + r) * 512 + k0 + kk]) : 0.f; }
#pragma unroll
        for (int i = 0; i < 4; ++i) { const int el = tid + i * 256; const int kk = el >> 6, c = el & 63; Bs[kk][c] = W[(size_t)(k0 + kk) * 1024 + n0 + c]; }
        __syncthreads();
#pragma unroll
        for (int kk = 0; kk < 16; ++kk) { float a[4], b[4];
#pragma unroll
            for (int i = 0; i < 4; ++i) { a[i] = As[kk][ty * 4 + i]; b[i] = Bs[kk][tx * 4 + i]; }
#pragma unroll
            for (int i = 0; i < 4; ++i)
#pragma unroll
                for (int j = 0; j < 4; ++j) acc[i][j] = fmaf(a[i], b[j], acc[i][j]); }
        __syncthreads();
    }
#pragma unroll
    for (int i = 0; i < 4; ++i) { const int r = m0 + ty * 4 + i; if (r < M) { const int ent = list[(size_t)e * T + r]; const float2 w2 = rw[ent >> 1]; const float w = (ent & 1) ? w2.y : w2.x;
#pragma unroll
        for (int j = 0; j < 4; ++j) ybuf[(size_t)ent * 1024 + n0 + tx * 4 + j] = f2bf(w * acc[i][j]); } }
}
__global__ __launch_bounds__(256) void k_final(float* __restrict__ yout, const float2* __restrict__ stats, const float* __restrict__ g1, const float* __restrict__ b1, const bf16_t* __restrict__ ybuf,
                                               const float* __restrict__ g2, const float* __restrict__ b2) {
    const int lane = threadIdx.x & 63; const int t = blockIdx.x * 4 + (threadIdx.x >> 6);
    float* yr = yout + (size_t)t * 1024; const float2 st = stats[t]; float xv[16]; float s = 0.f;
#pragma unroll
    for (int j = 0; j < 4; ++j) { const int c0 = j * 256 + lane * 4; const f32x4 vv = *(const f32x4*)(yr + c0); const f32x4 gg = *(const f32x4*)(g1 + c0); const f32x4 bb = *(const f32x4*)(b1 + c0);
        const uint2 a = *(const uint2*)(ybuf + (size_t)(2 * t) * 1024 + c0); const uint2 b = *(const uint2*)(ybuf + (size_t)(2 * t + 1) * 1024 + c0);
        const float ya[4] = {__uint_as_float(a.x << 16), __uint_as_float(a.x & 0xffff0000u), __uint_as_float(a.y << 16), __uint_as_float(a.y & 0xffff0000u)};
        const float yb[4] = {__uint_as_float(b.x << 16), __uint_as_float(b.x & 0xffff0000u), __uint_as_float(b.y << 16), __uint_as_float(b.y & 0xffff0000u)};
#pragma unroll
        for (int i = 0; i < 4; ++i) { const float x1 = (vv[i] - st.x) * st.y * gg[i] + bb[i]; const float val = ALPHA * x1 + (ya[i] + yb[i]); xv[4 * j + i] = val; s += val; } }
    const float mu = wave_sum(s) * (1.f / 1024.f); float s2 = 0.f;
#pragma unroll
    for (int i = 0; i < 16; ++i) { const float d = xv[i] - mu; s2 += d * d; }
    const float rstd = 1.0f / sqrtf(wave_sum(s2) * (1.f / 1024.f) + LN_EPS);
#pragma unroll
    for (int j = 0; j < 4; ++j) { const int c0 = j * 256 + lane * 4; const f32x4 gg = *(const f32x4*)(g2 + c0); const f32x4 bb = *(const f32x4*)(b2 + c0); f32x4 o;
#pragma unroll
        for (int i = 0; i < 4; ++i) o[i] = (xv[4 * j + i] - mu) * rstd * gg[i] + bb[i];
        *(f32x4*)(yr + c0) = o; }
}

#define LAS __attribute__((address_space(3)))
#define GAS __attribute__((address_space(1)))
typedef short bf16x8 __attribute__((ext_vector_type(8)));
typedef unsigned u32x4 __attribute__((ext_vector_type(4)));
typedef unsigned u32x2 __attribute__((ext_vector_type(2)));
typedef GAS unsigned gu32;
#define RLX_AGENT __ATOMIC_RELAXED, __HIP_MEMORY_SCOPE_AGENT
#define LDS_WAIT() asm volatile("s_waitcnt lgkmcnt(0)" ::: "memory")
#define VM_WAIT() asm volatile("s_waitcnt vmcnt(0)" ::: "memory")

constexpr size_t WT_IN = 0;
constexpr size_t WT_A  = WT_IN + (size_t)INW * 1024;
constexpr size_t WT_B  = WT_A + 1024 * 1024;
constexpr size_t WT_O  = WT_B + 1024 * 512;
constexpr size_t WT_GU = WT_O + 1024 * 1024;
constexpr size_t WT_DN = WT_GU + (size_t)NE * 1024 * 1024;
constexpr size_t WT_END = WT_DN + (size_t)NE * 1024 * 512;
static_assert(WT_END * 2 <= 112 * MiB, "weight copies fit");
constexpr size_t MS_WPOOL = 7 * MiB;
constexpr size_t WS_POOLED = 448 * MiB;

constexpr int CW_CNT = 0;
constexpr int CW_BAR = 1024;

constexpr int NWAVES = 8, NTHREADS = 512;
constexpr int RING_BYTES = 131072, MISC_OFF = RING_BYTES + 320, LDS_BYTES = 147456;

typedef float f32x2_t __attribute__((ext_vector_type(2))); typedef __bf16 bf16x2_t __attribute__((ext_vector_type(2)));
__device__ __forceinline__ unsigned cvt_pk_bf16(float lo, float hi) { f32x2_t v = {lo, hi}; bf16x2_t b = __builtin_convertvector(v, bf16x2_t); return __builtin_bit_cast(unsigned, b); }
__device__ __forceinline__ float bflo(unsigned w) { return __uint_as_float(w << 16); }
__device__ __forceinline__ float bfhi(unsigned w) { return __uint_as_float(w & 0xffff0000u); }

#define XB_TMO      128
#define XB_XCNT(j)  (256  + 64 * (j))
#define XB_XSUB(j)  (1280 + 64 * (j))
#define XB_XGEN(j)  (2304 + 64 * (j))
#define XB_TOP      3328
#define XB_TOPGEN   3392
#define XCD_BAR_WORDS 3456
#define XB_SPIN_CAP (1u << 22)
__device__ __forceinline__ unsigned xb_ld(unsigned* p)              { return __hip_atomic_load(p, __ATOMIC_RELAXED, __HIP_MEMORY_SCOPE_AGENT); }
__device__ __forceinline__ unsigned xb_add(unsigned* p, unsigned v) { return __hip_atomic_fetch_add(p, v, __ATOMIC_RELAXED, __HIP_MEMORY_SCOPE_AGENT); }
__device__ __forceinline__ unsigned xb_xcc_id() { return (unsigned)__builtin_amdgcn_s_getreg((3 << 11) | 20) & 0xFu; }
#define XB_SPIN(cond, bar) do { unsigned _sp = 0; while (cond) { __builtin_amdgcn_s_sleep(1); \
    if ((++_sp & 255u) == 0u) { if (xb_ld(&(bar)[XB_TMO])) break; if (_sp > XB_SPIN_CAP) { atomicAdd(&(bar)[XB_TMO], 1u); break; } } } } while (0)
struct XcdBarrier { unsigned* bar; unsigned x; volatile LAS unsigned* st; };
__device__ __forceinline__ XcdBarrier xcd_barrier_post(unsigned* bar, volatile LAS unsigned* st) {
    XcdBarrier b; b.bar = bar; b.x = xb_xcc_id(); b.st = st;
    if (threadIdx.x == 0) (void)xb_add(&bar[XB_XCNT(b.x)], 1u);
    return b;
}
__device__ __forceinline__ void xcd_barrier_complete(unsigned* bar, unsigned x, unsigned& nloc, unsigned& nx) {
    const unsigned G = gridDim.x * gridDim.y * gridDim.z;
    unsigned sum, cnt, mine, sp = 0u;
    for (;;) {
        sum = 0u; cnt = 0u; mine = 0u;
#pragma unroll
        for (unsigned j = 0; j < 16; ++j) { const unsigned c = xb_ld(&bar[XB_XCNT(j)]); sum += c; cnt += (c > 0u) ? 1u : 0u; mine = (j == x) ? c : mine; }
        if (sum == G) break;
        __builtin_amdgcn_s_sleep(1);
        if ((++sp & 255u) == 0u) { if (xb_ld(&bar[XB_TMO])) break; if (sp > XB_SPIN_CAP) { atomicAdd(&bar[XB_TMO], 1u); break; } }
    }
    nloc = mine > 0u ? mine : 1u; nx = cnt > 0u ? cnt : 1u;
}
__device__ __forceinline__ void xcd_barrier(const XcdBarrier& b) {
    asm volatile("s_waitcnt vmcnt(0)" ::: "memory");
    __syncthreads();
    if (threadIdx.x == 0) {
        unsigned* bar = b.bar;
        __builtin_amdgcn_s_waitcnt(0);
        unsigned nloc = b.st[0], nx = b.st[1];
        if (nloc == 0u) { xcd_barrier_complete(bar, b.x, nloc, nx); b.st[0] = nloc; b.st[1] = nx; }
        const unsigned old = xb_add(&bar[XB_XSUB(b.x)], 1u);
        const unsigned gen = old / nloc;
        if (old + 1u == (gen + 1u) * nloc) {
            __builtin_amdgcn_fence(__ATOMIC_RELEASE, "agent");
            asm volatile("s_waitcnt vmcnt(0)" ::: "memory");
            const unsigned og = xb_add(&bar[XB_TOP], 1u);
            const unsigned tg = og / nx;
            if (og + 1u == (tg + 1u) * nx) xb_add(&bar[XB_TOPGEN], 1u);
            else XB_SPIN(xb_ld(&bar[XB_TOPGEN]) == tg, bar);
            __builtin_amdgcn_fence(__ATOMIC_ACQUIRE, "agent");
            xb_add(&bar[XB_XGEN(b.x)], 1u);
            asm volatile("s_waitcnt vmcnt(0)" ::: "memory");
        } else {
            XB_SPIN(xb_ld(&bar[XB_XGEN(b.x)]) == gen, bar);
            __builtin_amdgcn_fence(__ATOMIC_ACQUIRE, "agent");
            asm volatile("s_waitcnt vmcnt(0)" ::: "memory");
        }
    }
    __syncthreads();
}

namespace g8 {
constexpr int BM = 256, BK = 64, HALF = 128, HTB = HALF * BK * 2, NXCD = 8, WGM = 8;
__host__ __device__ __forceinline__ int lds_byte(int r, int c) { const int st = (r >> 4) * 2 + (c >> 5), rr = r & 15, cc = c & 31, ob = rr * 64 + cc * 2; return st * 1024 + (ob ^ (((ob >> 9) & 1) << 5)); }
__host__ __device__ __forceinline__ void stage_rc(int b, int& R, int& C) { const int st = b / 1024, sb = b % 1024, swz = sb ^ (((sb >> 9) & 1) << 5); R = (st >> 1) * 16 + swz / 64; C = (st & 1) * 32 + (swz % 64) / 2; }
__host__ __device__ __forceinline__ int perm32(int rho) { const int n = rho >> 4, i = rho & 15; return 8 * (i >> 2) + 4 * n + (i & 3); }

struct GUnit { const char* A; const char* B; int pm, pn, e, r0; };

struct DenseOrder {
    const char* Abase; const char* Bbase; int nM, nN, nwg, G, c; size_t tstep;
    __device__ void init(const void* A, const void* Bt, int M, int N, int K, int G_, int c_) { Abase = (const char*)A; Bbase = (const char*)Bt; nM = M / BM; nN = N / BM; nwg = nM * nN; G = G_; c = c_; tstep = (size_t)BM * K * 2; }
    __device__ bool next(int i, GUnit& u) const {
        const long L = (long)i * G + c; if (L >= nwg) return false;
        int wgid = (int)L; { const int q = nwg / NXCD, r = nwg % NXCD, xcd = wgid % NXCD, off = wgid / NXCD; wgid = (xcd < r ? xcd * (q + 1) : r * (q + 1) + (xcd - r) * q) + off; }
        const int nig = WGM * nN, gid = wgid / nig, fm = gid * WGM, gsz = (nM - fm) < WGM ? (nM - fm) : WGM;
        u.pm = fm + ((wgid % nig) % gsz); u.pn = (wgid % nig) / gsz; u.e = 0; u.r0 = 0;
        u.A = Abase + (size_t)u.pm * tstep; u.B = Bbase + (size_t)u.pn * tstep; return true;
    }
    __device__ __forceinline__ unsigned rowoff(const GUnit&, int) const { return 0u; }
};
struct MoeOrder {
    const char* Abase; const char* Bbase; const int* list; const volatile LAS unsigned* tb; const volatile LAS unsigned* cntl; int nwg, G, c; size_t atile, bexp, btile; int gather;
    __device__ bool next(int i, GUnit& u) const {
        const long L = (long)i * G + c; if (L >= nwg) return false;
        int wgid = (int)L; { const int q = nwg / NXCD, r = nwg % NXCD, xcd = wgid % NXCD, off = wgid / NXCD; wgid = (xcd < r ? xcd * (q + 1) : r * (q + 1) + (xcd - r) * q) + off; }
        const int tile = wgid >> 2; u.pn = wgid & 3; u.pm = tile;
        int e = 0; for (int j = 1; j < NE; ++j) e = ((int)tb[j] <= tile) ? j : e;
        e = __builtin_amdgcn_readfirstlane(e); u.e = e; u.r0 = __builtin_amdgcn_readfirstlane((tile - (int)tb[e]) * 256);
        u.A = gather ? Abase : Abase + (size_t)tile * atile; u.B = Bbase + (size_t)e * bexp + (size_t)u.pn * btile; return true;
    }
    __device__ __forceinline__ unsigned rowoff(const GUnit& u, int rr) const {
        const int p = u.r0 + rr; const int tok = (p < (int)cntl[u.e]) ? (list[(size_t)u.e * T + p] >> 1) : 0; return (unsigned)tok * 2048u; }
};

template <class Epi, class Sched, bool ALIGN_EPI, bool GATHER>
__device__ __forceinline__ void gemm_phase(LAS unsigned char* lds, const int K, const Sched& S, const Epi& E) {
    const int tid = threadIdx.x, wid = __builtin_amdgcn_readfirstlane(tid >> 6), lane = tid & 63, wr = wid >> 2, wc = wid & 3, fr = lane & 15, fq = lane >> 4;
    const int nt = K / BK;
    unsigned voffA[2], voffB[2]; int RA[2], CA[2];
#pragma unroll
    for (int i = 0; i < 2; ++i) { int R, C; stage_rc(tid * 16 + i * 8192, R, C); const int Rb = Epi::PERM ? ((R & ~31) + perm32(R & 31)) : R;
        voffA[i] = (unsigned)(R * K + C) * 2u; voffB[i] = (unsigned)(Rb * K + C) * 2u; RA[i] = R; CA[i] = C; }
    const size_t kstep = (size_t)(BK * 2);
    const size_t hstep = (size_t)HALF * K * 2;
    const unsigned ldsw = (unsigned)wid * 1024u;
    const int aoff = lds_byte(wr * 64 + fr, fq * 8), boff = lds_byte(wc * 32 + fr, fq * 8);
#define G8_SA(b, h) (((b) * 2 + (h)) * HTB)
#define G8_SB(b, h) ((4 + (b) * 2 + (h)) * HTB)
#define G8_STAGE(bufoff, gbase, o0, o1) do { \
        __builtin_amdgcn_global_load_lds((const unsigned*)((const char*)(gbase) + (o0)), (LAS unsigned*)(lds + (bufoff) + ldsw), 16, 0, 0); \
        __builtin_amdgcn_global_load_lds((const unsigned*)((const char*)(gbase) + (o1)), (LAS unsigned*)(lds + (bufoff) + ldsw + 8192), 16, 0, 0); } while (0)
#define G8_STAGE_B(bufoff, gbase) G8_STAGE(bufoff, gbase, voffB[0], voffB[1])
#define G8_LDA(dst, b, h) do { _Pragma("unroll") for (int m = 0; m < 4; ++m) _Pragma("unroll") for (int k = 0; k < 2; ++k) dst[m][k] = *(const LAS bf16x8*)(lds + G8_SA(b, h) + aoff + m * 2048 + k * 1024); } while (0)
#define G8_LDB(dst, b, h) do { _Pragma("unroll") for (int n = 0; n < 2; ++n) _Pragma("unroll") for (int k = 0; k < 2; ++k) dst[n][k] = *(const LAS bf16x8*)(lds + G8_SB(b, h) + boff + n * 2048 + k * 1024); } while (0)
#define G8_MMA(ai, bj, At, Bt) do { __builtin_amdgcn_s_setprio(1); _Pragma("unroll") for (int m = 0; m < 4; ++m) _Pragma("unroll") for (int n = 0; n < 2; ++n) _Pragma("unroll") for (int k = 0; k < 2; ++k) \
        acc[ai][bj][m][n] = __builtin_amdgcn_mfma_f32_16x16x32_bf16(Bt[n][k], At[m][k], acc[ai][bj][m][n], 0, 0, 0); __builtin_amdgcn_s_setprio(0); } while (0)
#ifdef G8_DRAIN
#define G8_WAIT_V(n) asm volatile("s_waitcnt vmcnt(0)" ::: "memory")
#else
#define G8_WAIT_V(n) asm volatile("s_waitcnt vmcnt(" #n ")" ::: "memory")
#endif
#define G8_WAIT_L(n) asm volatile("s_waitcnt lgkmcnt(" #n ")" ::: "memory")
#define G8_BAR __builtin_amdgcn_s_barrier()
#define G8_SCHED __builtin_amdgcn_sched_barrier(0)
    GUnit cur, nxt; int ui = 0;
    if (!S.next(0, cur)) return;
    unsigned cao[2][2], nao[2][2];
#pragma unroll
    for (int h = 0; h < 2; ++h)
#pragma unroll
        for (int i = 0; i < 2; ++i) { cao[h][i] = GATHER ? S.rowoff(cur, h * HALF + RA[i]) + (unsigned)CA[i] * 2u : voffA[i] + (unsigned)(h * hstep); nao[h][i] = cao[h][i]; }
    f32x4 acc[2][2][4][2];
#pragma unroll
    for (int a = 0; a < 2; ++a)
#pragma unroll
        for (int b = 0; b < 2; ++b)
#pragma unroll
            for (int m = 0; m < 4; ++m)
#pragma unroll
                for (int n = 0; n < 2; ++n) acc[a][b][m][n] = (f32x4){0.f, 0.f, 0.f, 0.f};
    bf16x8 At[4][2], B0[2][2], B1[2][2];
    const char* cA = cur.A; const char* cB = cur.B;
    G8_STAGE_B(G8_SB(0, 0), cB); G8_STAGE_B(G8_SB(0, 1), cB + hstep); G8_STAGE(G8_SA(0, 0), cA, cao[0][0], cao[0][1]); G8_STAGE(G8_SA(0, 1), cA, cao[1][0], cao[1][1]);
    if (wr == 1) G8_BAR;
    G8_WAIT_V(2); G8_BAR;
    G8_STAGE_B(G8_SB(1, 0), cB + kstep); G8_STAGE(G8_SA(1, 0), cA + kstep, cao[0][0], cao[0][1]); G8_STAGE_B(G8_SB(1, 1), cB + hstep + kstep);
    G8_WAIT_V(6); G8_BAR;
    for (;;) {
        const bool has_next = S.next(ui + 1, nxt);
        if (GATHER && has_next) {
#pragma unroll
            for (int h = 0; h < 2; ++h)
#pragma unroll
                for (int i = 0; i < 2; ++i) nao[h][i] = S.rowoff(nxt, h * HALF + RA[i]) + (unsigned)CA[i] * 2u;
        }
        const char* nA = has_next ? nxt.A : cA; const char* nB = has_next ? nxt.B : cB;
        for (int t = 0; t < nt; t += 2) {
            const bool last = (t == nt - 2);
            const char* a1 = cA + (size_t)(t + 1) * kstep;
            const char* a2 = last ? nA : cA + (size_t)(t + 2) * kstep; const char* b2 = last ? nB : cB + (size_t)(t + 2) * kstep;
            const char* a3 = a2 + kstep; const char* b3 = b2 + kstep;
            asm volatile("" : "+s"(a1), "+s"(a2), "+s"(b2), "+s"(a3), "+s"(b3));
            unsigned o2[2][2];
#pragma unroll
            for (int h = 0; h < 2; ++h)
#pragma unroll
                for (int i = 0; i < 2; ++i) o2[h][i] = (GATHER && last && has_next) ? nao[h][i] : cao[h][i];
            G8_LDB(B0, 0, 0); G8_LDB(B1, 0, 1); G8_SCHED; G8_LDA(At, 0, 0); G8_STAGE(G8_SA(1, 1), a1, cao[1][0], cao[1][1]);
            G8_WAIT_V(8); G8_WAIT_L(0); G8_BAR; G8_MMA(0, 0, At, B0); G8_MMA(0, 1, At, B1); G8_BAR; G8_SCHED;
            G8_LDA(At, 0, 1); G8_STAGE_B(G8_SB(0, 0), b2); G8_STAGE_B(G8_SB(0, 1), b2 + hstep); G8_STAGE(G8_SA(0, 0), a2, o2[0][0], o2[0][1]);
            G8_WAIT_V(8); G8_WAIT_L(0); G8_BAR; G8_MMA(1, 0, At, B0); G8_MMA(1, 1, At, B1); G8_BAR; G8_SCHED;
            G8_LDB(B0, 1, 0); G8_LDB(B1, 1, 1); G8_SCHED; G8_LDA(At, 1, 0); G8_STAGE(G8_SA(0, 1), a2, o2[1][0], o2[1][1]);
            G8_WAIT_V(8); G8_WAIT_L(0); G8_BAR; G8_MMA(0, 0, At, B0); G8_MMA(0, 1, At, B1); G8_BAR; G8_SCHED;
            G8_LDA(At, 1, 1); G8_STAGE_B(G8_SB(1, 0), b3); G8_STAGE_B(G8_SB(1, 1), b3 + hstep); G8_STAGE(G8_SA(1, 0), a3, o2[0][0], o2[0][1]);
            G8_WAIT_V(8); G8_WAIT_L(0); G8_BAR; G8_MMA(1, 0, At, B0); G8_MMA(1, 1, At, B1); G8_BAR; G8_SCHED;
        }
        if constexpr (ALIGN_EPI) { if (wr == 0) G8_BAR; }
        {
          GUnit eu = cur; int fr_ = fr, fq_ = fq; asm volatile("" : "+s"(eu.pm), "+s"(eu.pn), "+s"(eu.e), "+s"(eu.r0)); asm volatile("" : "+v"(fr_), "+v"(fq_));
          E(acc, eu, wr, wc, fr_, fq_); }
        if (!has_next) break;
#pragma unroll
        for (int a = 0; a < 2; ++a)
#pragma unroll
            for (int b = 0; b < 2; ++b)
#pragma unroll
                for (int m = 0; m < 4; ++m)
#pragma unroll
                    for (int n = 0; n < 2; ++n) acc[a][b][m][n] = (f32x4){0.f, 0.f, 0.f, 0.f};
        cur = nxt; cA = nA; cB = nB; ++ui;
#pragma unroll
        for (int h = 0; h < 2; ++h)
#pragma unroll
            for (int i = 0; i < 2; ++i) cao[h][i] = nao[h][i];
        if constexpr (ALIGN_EPI) { if (wr == 1) G8_BAR; }
    }
    G8_WAIT_V(0);
    if constexpr (!ALIGN_EPI) { if (wr == 0) G8_BAR; }
    G8_BAR;
#undef G8_SA
#undef G8_SB
#undef G8_STAGE
#undef G8_STAGE_B
#undef G8_LDA
#undef G8_LDB
#undef G8_MMA
#undef G8_WAIT_V
#undef G8_WAIT_L
#undef G8_BAR
#undef G8_SCHED
}

__device__ __forceinline__ u32x4 pack8(const f32x4 v0, const f32x4 v1) { u32x4 w; w.x = cvt_pk_bf16(v0[0], v0[1]); w.y = cvt_pk_bf16(v0[2], v0[3]); w.z = cvt_pk_bf16(v1[0], v1[1]); w.w = cvt_pk_bf16(v1[2], v1[3]); return w; }
__device__ __forceinline__ float sigmoidf_(float v) { return __builtin_amdgcn_rcpf(1.f + __builtin_amdgcn_exp2f(-1.4426950408889634f * v)); }

struct EpiProj {
    static constexpr bool PERM = true;
    bf16_t *qb, *kb, *vb, *ub, *gb; const float* rope; const float* gate_bias;
    __device__ __forceinline__ void operator()(const f32x4 (&acc)[2][2][4][2], const GUnit& u, int wr, int wc, int fr, int fq) const {
        const int row0 = u.pm * BM + wr * 64 + fr; const int cw = wc * 32 + 8 * fq; const int pn = u.pn;
#ifdef DBG_PLAIN_EPI
        if (pn < 8) { bf16_t* base = (pn < 4 ? qb : kb) + (pn & 3) * 256 + cw;
            for (int ai = 0; ai < 2; ++ai) for (int m = 0; m < 4; ++m) { const int t = row0 + ai * HALF + m * 16; for (int bj = 0; bj < 2; ++bj) *(u32x4*)(base + (size_t)t * 1024 + bj * HALF) = pack8(acc[ai][bj][m][0], acc[ai][bj][m][1]); } }
        else
#endif
        if (pn < 8) {
            bf16_t* base = (pn < 4 ? qb : kb) + (pn & 3) * 256 + cw; const float sc = pn < 4 ? QSCALE : 1.f; const int fi = 16 * (wc & 1) + 4 * fq;
#pragma unroll
            for (int ai = 0; ai < 2; ++ai)
#pragma unroll
                for (int m = 0; m < 4; ++m) { const int t = row0 + ai * HALF + m * 16; const f32x4 cs0 = *(const f32x4*)(rope + ((size_t)t * 32 + fi) * 2), cs1 = *(const f32x4*)(rope + ((size_t)t * 32 + fi) * 2 + 4);
                    const f32x4 c = {cs0[0], cs0[2], cs1[0], cs1[2]}, s = {cs0[1], cs0[3], cs1[1], cs1[3]};
#pragma unroll
                    for (int bj = 0; bj < 2; ++bj) { const f32x4 t1 = acc[ai][bj][m][0], t2 = acc[ai][bj][m][1]; const f32x4 o1 = (t1 * c - t2 * s) * sc, o2 = (t2 * c + t1 * s) * sc;
                        *(u32x4*)(base + (size_t)t * 1024 + bj * HALF) = pack8(o1, o2); } }
        } else if (pn < 14) {
            bf16_t* base; int ld; if (pn < 12) { base = vb + (pn - 8) * 256 + cw; ld = 1024; } else { base = ub + (pn - 12) * 256 + cw; ld = 512; }
#pragma unroll
            for (int ai = 0; ai < 2; ++ai)
#pragma unroll
                for (int m = 0; m < 4; ++m) { const int t = row0 + ai * HALF + m * 16;
#pragma unroll
                    for (int bj = 0; bj < 2; ++bj) *(u32x4*)(base + (size_t)t * ld + bj * HALF) = pack8(acc[ai][bj][m][0], acc[ai][bj][m][1]); }
        }
#ifdef DBG_PLAIN_EPI
        else { const int col0 = (pn - 14) * 256 + cw;
            for (int ai = 0; ai < 2; ++ai) for (int m = 0; m < 4; ++m) { const int t = row0 + ai * HALF + m * 16; for (int bj = 0; bj < 2; ++bj) *(u32x4*)(gb + (size_t)t * 2048 + col0 + bj * HALF) = pack8(acc[ai][bj][m][0], acc[ai][bj][m][1]); } }
#else
        else {
            const int col0 = (pn - 14) * 256 + cw; f32x4 bv[2][2];
#pragma unroll
            for (int bj = 0; bj < 2; ++bj)
#pragma unroll
                for (int n = 0; n < 2; ++n) bv[bj][n] = *(const f32x4*)(gate_bias + col0 + bj * HALF + 4 * n);
#pragma unroll
            for (int ai = 0; ai < 2; ++ai)
#pragma unroll
                for (int m = 0; m < 4; ++m) { const int t = row0 + ai * HALF + m * 16;
#pragma unroll
                    for (int bj = 0; bj < 2; ++bj) { f32x4 v0 = acc[ai][bj][m][0] + bv[bj][0], v1 = acc[ai][bj][m][1] + bv[bj][1];
#pragma unroll
                        for (int j = 0; j < 4; ++j) { v0[j] = sigmoidf_(v0[j]); v1[j] = sigmoidf_(v1[j]); }
                        *(u32x4*)(gb + (size_t)t * 2048 + col0 + bj * HALF) = pack8(v0, v1); } }
        }
#endif
    }
};
struct EpiScaleBf16 {
    static constexpr bool PERM = true;
    bf16_t* O; int ldc; const float* colscale;
    __device__ __forceinline__ void operator()(const f32x4 (&acc)[2][2][4][2], const GUnit& u, int wr, int wc, int fr, int fq) const {
        const int row0 = u.pm * BM + wr * 64 + fr, col0 = u.pn * BM + wc * 32 + 8 * fq; f32x4 sv[2][2];
#pragma unroll
        for (int bj = 0; bj < 2; ++bj)
#pragma unroll
            for (int n = 0; n < 2; ++n) sv[bj][n] = *(const f32x4*)(colscale + col0 + bj * HALF + 4 * n);
#pragma unroll
        for (int ai = 0; ai < 2; ++ai)
#pragma unroll
            for (int m = 0; m < 4; ++m) { bf16_t* rowp = O + (size_t)(row0 + ai * HALF + m * 16) * ldc + col0;
#pragma unroll
                for (int bj = 0; bj < 2; ++bj) *(u32x4*)(rowp + bj * HALF) = pack8(acc[ai][bj][m][0] * sv[bj][0], acc[ai][bj][m][1] * sv[bj][1]); }
    }
};
template <int BR> struct EpiMerge {
    static constexpr bool PERM = true;
    const bf16_t* gates; bf16_t* merged;
    __device__ __forceinline__ void operator()(const f32x4 (&acc)[2][2][4][2], const GUnit& u, int wr, int wc, int fr, int fq) const {
        const int row0 = u.pm * BM + wr * 64 + fr, col0 = u.pn * BM + wc * 32 + 8 * fq;
#pragma unroll
        for (int ai = 0; ai < 2; ++ai)
#pragma unroll
            for (int m = 0; m < 4; ++m) { const size_t t = row0 + ai * HALF + m * 16;
#pragma unroll
                for (int bj = 0; bj < 2; ++bj) { const u32x4 g = *(const u32x4*)(gates + t * 2048 + BR * 1024 + col0 + bj * HALF); bf16_t* mp = merged + t * 1024 + col0 + bj * HALF;
                    f32x4 v0 = acc[ai][bj][m][0], v1 = acc[ai][bj][m][1];
                    v0 = v0 * (f32x4){bflo(g.x), bfhi(g.x), bflo(g.y), bfhi(g.y)}; v1 = v1 * (f32x4){bflo(g.z), bfhi(g.z), bflo(g.w), bfhi(g.w)};
                    if (BR) { const u32x4 p = *(const u32x4*)mp; v0 = v0 + (f32x4){bflo(p.x), bfhi(p.x), bflo(p.y), bfhi(p.y)}; v1 = v1 + (f32x4){bflo(p.z), bfhi(p.z), bflo(p.w), bfhi(p.w)}; }
                    *(u32x4*)mp = pack8(v0, v1); } }
    }
};
struct EpiResid {
    static constexpr bool PERM = false;
    const float* x; float* y;
    __device__ __forceinline__ void operator()(const f32x4 (&acc)[2][2][4][2], const GUnit& u, int wr, int wc, int fr, int fq) const {
        const int row0 = u.pm * BM + wr * 64 + fr, col0 = u.pn * BM + wc * 32 + 4 * fq;
#pragma unroll
        for (int ai = 0; ai < 2; ++ai)
#pragma unroll
            for (int m = 0; m < 4; ++m) { const size_t off = (size_t)(row0 + ai * HALF + m * 16) * 1024 + col0;
#pragma unroll
                for (int bj = 0; bj < 2; ++bj)
#pragma unroll
                    for (int n = 0; n < 2; ++n) { const f32x4 xv = *(const f32x4*)(x + off + bj * HALF + n * 16); *(f32x4*)(y + off + bj * HALF + n * 16) = xv * ALPHA + acc[ai][bj][m][n]; } }
    }
};
struct EpiGateUp {
    static constexpr bool PERM = true;
    bf16_t* h;
    __device__ __forceinline__ void operator()(const f32x4 (&acc)[2][2][4][2], const GUnit& u, int wr, int wc, int fr, int fq) const {
        const int row0 = u.pm * BM + wr * 64 + fr, col0 = u.pn * 128 + wc * 16 + 4 * fq;
#pragma unroll
        for (int ai = 0; ai < 2; ++ai)
#pragma unroll
            for (int m = 0; m < 4; ++m) { bf16_t* rowp = h + (size_t)(row0 + ai * HALF + m * 16) * 512 + col0;
#pragma unroll
                for (int bj = 0; bj < 2; ++bj) { const f32x4 g = acc[ai][bj][m][0], up = acc[ai][bj][m][1]; f32x4 o;
#pragma unroll
                    for (int j = 0; j < 4; ++j) o[j] = g[j] * sigmoidf_(g[j]) * up[j];
                    u32x2 w; w.x = cvt_pk_bf16(o[0], o[1]); w.y = cvt_pk_bf16(o[2], o[3]); *(u32x2*)(rowp + bj * 64) = w; } }
    }
};
struct EpiDown {
    static constexpr bool PERM = true;
    bf16_t* ybuf; const int* list; const float* rw; const volatile LAS unsigned* cntl;
    __device__ __forceinline__ void operator()(const f32x4 (&acc)[2][2][4][2], const GUnit& u, int wr, int wc, int fr, int fq) const {
        const int p0 = u.r0 + wr * 64 + fr, col0 = u.pn * BM + wc * 32 + 8 * fq; const int cn = (int)cntl[u.e];
#pragma unroll
        for (int ai = 0; ai < 2; ++ai)
#pragma unroll
            for (int m = 0; m < 4; ++m) { const int p = p0 + ai * HALF + m * 16;
                if (p < cn) { const int ent = list[(size_t)u.e * T + p]; const float w = rw[ent]; bf16_t* rowp = ybuf + (size_t)ent * 1024 + col0;
#pragma unroll
                    for (int bj = 0; bj < 2; ++bj) *(u32x4*)(rowp + bj * HALF) = pack8(acc[ai][bj][m][0] * w, acc[ai][bj][m][1] * w); } }
    }
};
}

struct MKArgs { const void* in[21]; float* out; unsigned char* ws; unsigned mask; unsigned li; };
enum { PH_PRO = 0, PH_G1, PH_POOLA, PH_ATT, PH_POOLG, PH_G4A, PH_G4B, PH_G5, PH_ROUTER, PH_G7, PH_G8, PH_FINAL, PH_N };

template <int MODE> __device__ __forceinline__ int dest_row(int n) {
    if (MODE == 1) return n < 2048 ? (n & ~63) + qk_pos_of_d(n & 63) : n;
    if (MODE == 2) { const int nn = n >> 9, hc = n & 511; return (hc >> 7) * 256 + ((hc >> 6) & 1) * 128 + ((hc >> 4) & 3) * 32 + ((hc >> 2) & 3) * 8 + nn * 4 + (hc & 3); }
    return n;
}
template <int MODE> __device__ __forceinline__ void transpose_item(const float* __restrict__ W, int ldw, int N, bf16_t* __restrict__ WT, int ldt, int coloff, int rowoff, LAS float* scr, int item, int lane) {
    const int nblk = N / 32, kb = item / nblk, nb = item % nblk, k0 = 64 * kb, n0 = 32 * nb;
#pragma unroll 8
    for (int i = 0; i < 32; ++i) { const int kk = 2 * i + (lane >> 5); scr[kk * 33 + (lane & 31)] = W[(size_t)(k0 + kk) * ldw + n0 + (lane & 31)]; }
    LDS_WAIT(); asm volatile("" ::: "memory");
    const int c = lane & 7;
#pragma unroll
    for (int j = 0; j < 4; ++j) { const int n = (lane >> 3) + 8 * j; const LAS float* s = scr + (8 * c) * 33 + n;
        u32x4 o; o.x = cvt_pk_bf16(s[0 * 33], s[1 * 33]); o.y = cvt_pk_bf16(s[2 * 33], s[3 * 33]); o.z = cvt_pk_bf16(s[4 * 33], s[5 * 33]); o.w = cvt_pk_bf16(s[6 * 33], s[7 * 33]);
        *(u32x4*)(WT + (size_t)(rowoff + dest_row<MODE>(n0 + n)) * ldt + coloff + k0 + 8 * c) = o; }
    LDS_WAIT(); asm volatile("" ::: "memory");
}

__global__ void __launch_bounds__(NTHREADS, 2) mk_fwd(MKArgs args) {
    __shared__ __attribute__((aligned(16))) unsigned char lds_raw[LDS_BYTES];
    LAS unsigned char* lds = (LAS unsigned char*)lds_raw;
    volatile LAS unsigned* MISC = (volatile LAS unsigned*)(lds + MISC_OFF);
    const int tid = threadIdx.x, lane = tid & 63, wave = __builtin_amdgcn_readfirstlane(tid >> 6);
    const int G = gridDim.x; const int bx = blockIdx.x; const int vcu = (G % 8 == 0) ? (bx % 8) * (G / 8) + bx / 8 : bx;
    const unsigned mask = args.mask;
    unsigned char* const ws = args.ws; float* const out = args.out;
#define IN_F(k) ((const float*)args.in[k])
#define x_ IN_F(0)
#define positions ((const int*)args.in[1])
#define w_in IN_F(2)
#define gate_bias IN_F(3)
#define lam_vecs IN_F(4)
#define subln_gain IN_F(5)
#define w_pool IN_F(6)
#define pool_scale IN_F(7)
#define w_branch_a IN_F(8)
#define w_branch_b IN_F(9)
#define w_out IN_F(10)
#define ln1_g IN_F(11)
#define ln1_b IN_F(12)
#define wrg IN_F(13)
#define brg IN_F(14)
#define wre IN_F(15)
#define bre IN_F(16)
#define wgu IN_F(17)
#define wdn IN_F(18)
#define ln2_g IN_F(19)
#define ln2_b IN_F(20)
#define wt ((bf16_t*)(ws + WS_WT))
#define xb ((bf16_t*)(ws + WS_XB))
#define qb ((bf16_t*)(ws + WS_Q))
#define kb ((bf16_t*)(ws + WS_K))
#define vb ((bf16_t*)(ws + WS_V))
#define ub ((bf16_t*)(ws + WS_U))
#define gb ((bf16_t*)out)
#define on ((bf16_t*)(ws + WS_ON))
#define mixed ((bf16_t*)(ws + WS_MIXED))
#define merged ((bf16_t*)(ws + WS_MERGED))
#define x1b ((bf16_t*)(ws + WS_X1B))
#define hb ((bf16_t*)(ws + WS_H))
#define ybuf ((bf16_t*)(ws + WS_YBUF))
#define rope ((float*)(ws + WS_ROPE))
#define pooled ((bf16_t*)(ws + WS_POOLED))
#define misc (ws + WS_MISC)
#define ctl ((unsigned*)(misc + MS_CTL))
#define stats ((float2*)(misc + MS_STATS))
#define rw ((float*)(misc + MS_ROUTE + (size_t)T * 8))
#define list ((int*)(misc + MS_LIST))
#define scal ((float*)(misc + MS_SCAL))
#define cnt (ctl + CW_CNT)
#define wpool_bd ((bf16_t*)(misc + MS_WPOOL))

    for (int u = tid; u < (LDS_BYTES - RING_BYTES) / 4; u += NTHREADS) ((LAS unsigned*)(lds + RING_BYTES))[u] = 0u;
    __syncthreads();
    XcdBarrier bar; bar.bar = ctl + CW_BAR + args.li * XCD_BAR_WORDS; bar.x = 0; bar.st = nullptr;
    const bool multi = (mask & (mask - 1u)) != 0u;
    if (multi) bar = xcd_barrier_post(ctl + CW_BAR + args.li * XCD_BAR_WORDS, MISC + 8);
#ifndef MK_CT
#define MK_CT 0xfffu
#endif
#define HAS(p) (((MK_CT >> (p)) & 1u) && ((mask >> (p)) & 1u))
#define SEAM(p) do { if (multi && (mask >> ((p) + 1)) != 0u) xcd_barrier(bar); } while (0)
    const int gw = vcu * NWAVES + wave, NGW = G * NWAVES;

    if (HAS(PH_PRO)) {
        LAS float* scr = (LAS float*)(lds + wave * 16384);
        constexpr int I_IN = 16 * (INW / 32), I_A = 16 * 32, I_B = 8 * 32, I_O = 16 * 32, I_GU = 16 * 32, I_DN = 8 * 32, I_P = 2 * 4;
        constexpr int NITEMS = I_IN + I_A + I_B + I_O + NE * I_GU + NE * I_DN + PG * I_P;
        for (int it = gw; it < NITEMS; it += NGW) {
            int r = it;
            if (r < I_IN) { transpose_item<1>(w_in, INW, INW, wt + WT_IN, 1024, 0, 0, scr, r, lane); continue; } r -= I_IN;
            if (r < I_A) { transpose_item<0>(w_branch_a, 1024, 1024, wt + WT_A, 1024, 0, 0, scr, r, lane); continue; } r -= I_A;
            if (r < I_B) { transpose_item<0>(w_branch_b, 1024, 1024, wt + WT_B, 512, 0, 0, scr, r, lane); continue; } r -= I_B;
            if (r < I_O) { transpose_item<0>(w_out, 1024, 1024, wt + WT_O, 1024, 0, 0, scr, r, lane); continue; } r -= I_O;
            if (r < NE * I_GU) { const int e = r / I_GU; transpose_item<2>(wgu + (size_t)e * 1024 * 1024, 1024, 1024, wt + WT_GU + (size_t)e * 1024 * 1024, 1024, 0, 0, scr, r % I_GU, lane); continue; } r -= NE * I_GU;
            if (r < NE * I_DN) { const int e = r / I_DN; transpose_item<0>(wdn + (size_t)e * 512 * 1024, 1024, 1024, wt + WT_DN + (size_t)e * 1024 * 512, 512, 0, 0, scr, r % I_DN, lane); continue; } r -= NE * I_DN;
            { const int g = r / I_P; transpose_item<0>(w_pool + (size_t)g * 128 * 128, 128, 128, wpool_bd, 512, g * 128, g * 128, scr, r % I_P, lane); }
        }
        for (int ch = gw * 64 + lane; ch < 512 * 64; ch += NGW * 64) { const int row = ch >> 6, c8 = (ch & 63) * 8; if ((row >> 7) != (c8 >> 7)) *(u32x4*)(wpool_bd + (size_t)row * 512 + c8) = (u32x4){0u, 0u, 0u, 0u}; }
        for (int m = gw; m < T; m += NGW) { const f32x4* xr = (const f32x4*)(x_ + (size_t)m * 1024) + lane; u32x2* o8 = (u32x2*)(xb + (size_t)m * 1024) + lane;
#pragma unroll
            for (int j = 0; j < 4; ++j) { const f32x4 v = xr[64 * j]; u32x2 w; w.x = cvt_pk_bf16(v[0], v[1]); w.y = cvt_pk_bf16(v[2], v[3]); o8[64 * j] = w; } }
        for (int e = gw * 64 + lane; e < T * 32; e += NGW * 64) { const int t = e >> 5, i = e & 31; const float inv = powf(10000.0f, -(float)i * (2.0f / 64.0f)); const float ang = (float)positions[t] * inv; const double a = (double)ang;
            rope[2 * e] = (float)cos(a); rope[2 * e + 1] = (float)sin(a); }
        if (gw == 0 && lane == 0) { float s01 = 0.f, s23 = 0.f; for (int i = 0; i < 64; ++i) { s01 += lam_vecs[i] * lam_vecs[64 + i]; s23 += lam_vecs[128 + i] * lam_vecs[192 + i]; } scal[0] = expf(s01) - expf(s23) + LAMBDA_INIT; }
        __syncthreads();
        SEAM(PH_PRO);
    }
    if (HAS(PH_G1)) {
        g8::DenseOrder S; S.init(xb, wt + WT_IN, T, INW, 1024, G, bx);
        g8::EpiProj E{qb, kb, vb, ub, gb, rope, gate_bias};
        g8::gemm_phase<g8::EpiProj, g8::DenseOrder, true, false>(lds, 1024, S, E);
        SEAM(PH_G1);
    }
    if (HAS(PH_POOLA)) {
        for (int e = (gw * 64 + lane); e < T * 64; e += NGW * 64) { const int t = e >> 6, c8 = (e & 63) * 8; const int g = c8 >> 7, w = 2 << g, s = t & (SEQ - 1); const int n = (s + 1 < w) ? s + 1 : w;
            float a[8] = {0.f, 0.f, 0.f, 0.f, 0.f, 0.f, 0.f, 0.f}; float u0[8];
            for (int i = 0; i < n; ++i) { const u32x4 v = *(const u32x4*)(ub + (size_t)(t - i) * 512 + c8); const float f[8] = {bflo(v.x), bfhi(v.x), bflo(v.y), bfhi(v.y), bflo(v.z), bfhi(v.z), bflo(v.w), bfhi(v.w)};
#pragma unroll
                for (int j = 0; j < 8; ++j) { a[j] += f[j]; if (i == 0) u0[j] = f[j]; } }
            const float inv = 1.f / (float)n; u32x4 o; o.x = cvt_pk_bf16(a[0] * inv - u0[0], a[1] * inv - u0[1]); o.y = cvt_pk_bf16(a[2] * inv - u0[2], a[3] * inv - u0[3]);
            o.z = cvt_pk_bf16(a[4] * inv - u0[4], a[5] * inv - u0[5]); o.w = cvt_pk_bf16(a[6] * inv - u0[6], a[7] * inv - u0[7]);
            *(u32x4*)(pooled + (size_t)t * 512 + c8) = o; }
    }
    if (HAS(PH_ATT)) { SEAM(PH_ATT); }
    else if (HAS(PH_POOLA)) { SEAM(PH_ATT); }
    if (HAS(PH_POOLG)) {
        g8::DenseOrder S; S.init(pooled, wpool_bd, T, 512, 512, G, bx);
        g8::EpiScaleBf16 E{mixed, 512, pool_scale};
        g8::gemm_phase<g8::EpiScaleBf16, g8::DenseOrder, true, false>(lds, 512, S, E);
    }
    if (HAS(PH_G4A)) {
        g8::DenseOrder S; S.init(on, wt + WT_A, T, 1024, 1024, G, bx);
        g8::EpiMerge<0> E{gb, merged};
        g8::gemm_phase<g8::EpiMerge<0>, g8::DenseOrder, true, false>(lds, 1024, S, E);
        SEAM(PH_G4A);
    } else if (HAS(PH_POOLG)) { SEAM(PH_G4A); }
    if (HAS(PH_G4B)) {
        g8::DenseOrder S; S.init(mixed, wt + WT_B, T, 1024, 512, G, bx);
        g8::EpiMerge<1> E{gb, merged};
        g8::gemm_phase<g8::EpiMerge<1>, g8::DenseOrder, true, false>(lds, 512, S, E);
        SEAM(PH_G4B);
    }
    if (HAS(PH_G5)) {
        g8::DenseOrder S; S.init(merged, wt + WT_O, T, 1024, 1024, G, bx);
        g8::EpiResid E{x_, out};
        g8::gemm_phase<g8::EpiResid, g8::DenseOrder, true, false>(lds, 1024, S, E);
        SEAM(PH_G5);
    }
    if (HAS(PH_ROUTER)) {
        for (int t = gw; t < T; t += NGW) {
            const float* yr = out + (size_t)t * 1024 + lane * 16; float xv[16]; float s = 0.f;
#pragma unroll
            for (int j = 0; j < 4; ++j) { const f32x4 vv = *(const f32x4*)(yr + j * 4); xv[4 * j] = vv.x; xv[4 * j + 1] = vv.y; xv[4 * j + 2] = vv.z; xv[4 * j + 3] = vv.w; s += (vv.x + vv.y) + (vv.z + vv.w); }
            const float mu = wave_sum(s) * (1.f / 1024.f); float s2 = 0.f;
#pragma unroll
            for (int i = 0; i < 16; ++i) { const float d = xv[i] - mu; s2 += d * d; }
            const float rstd = 1.0f / sqrtf(wave_sum(s2) * (1.f / 1024.f) + LN_EPS);
            if (lane == 0) stats[t] = make_float2(mu, rstd);
            { const float* gp = ln1_g + lane * 16; const float* bp = ln1_b + lane * 16;
#pragma unroll
            for (int j = 0; j < 4; ++j) { const f32x4 gg = *(const f32x4*)(gp + j * 4), bb = *(const f32x4*)(bp + j * 4);
#pragma unroll
                for (int i = 0; i < 4; ++i) xv[4 * j + i] = (xv[4 * j + i] - mu) * rstd * gg[i] + bb[i]; } }
            { u32x4 w0, w1; w0.x = cvt_pk_bf16(xv[0], xv[1]); w0.y = cvt_pk_bf16(xv[2], xv[3]); w0.z = cvt_pk_bf16(xv[4], xv[5]); w0.w = cvt_pk_bf16(xv[6], xv[7]);
              w1.x = cvt_pk_bf16(xv[8], xv[9]); w1.y = cvt_pk_bf16(xv[10], xv[11]); w1.z = cvt_pk_bf16(xv[12], xv[13]); w1.w = cvt_pk_bf16(xv[14], xv[15]);
              u32x4* xo = (u32x4*)(x1b + (size_t)t * 1024 + lane * 16); xo[0] = w0; xo[1] = w1; }
            float lg[4], le[32];
#pragma unroll
            for (int o = 0; o < 4; ++o) lg[o] = 0.f;
#pragma unroll
            for (int o = 0; o < 32; ++o) le[o] = 0.f;
            { const float* wgp = wrg + (size_t)lane * 16 * 4; const float* wep = wre + (size_t)lane * 16 * 32;
              LAS float* xl = (LAS float*)(lds + wave * 4352) + lane * 17;
#pragma unroll
              for (int i = 0; i < 16; ++i) xl[i] = xv[i];
              LDS_WAIT();
#pragma unroll 2
              for (int i = 0; i < 16; ++i) { const float xc = xl[i]; const f32x4 wg = *(const f32x4*)(wgp + i * 4);
#pragma unroll
                for (int o = 0; o < 4; ++o) lg[o] = fmaf(xc, wg[o], lg[o]);
#pragma unroll
                for (int o4 = 0; o4 < 8; ++o4) { const f32x4 we = *(const f32x4*)(wep + i * 32 + o4 * 4);
#pragma unroll
                    for (int o = 0; o < 4; ++o) le[o4 * 4 + o] = fmaf(xc, we[o], le[o4 * 4 + o]); } } }
#pragma unroll
            for (int o = 0; o < 4; ++o) lg[o] = wave_sum(lg[o]) + brg[o];
#pragma unroll
            for (int o = 0; o < 32; ++o) le[o] = wave_sum(le[o]) + bre[o];
            if (lane == 0) {
                int gi = 0; float gm = lg[0];
#pragma unroll
                for (int o = 1; o < 4; ++o) if (lg[o] > gm) { gm = lg[o]; gi = o; }
                float gs = 0.f;
#pragma unroll
                for (int o = 0; o < 4; ++o) gs += expf(lg[o] - gm);
                const float gp = 1.f / gs; float ev[8];
#pragma unroll
                for (int o = 0; o < 8; ++o) { float vsel = le[o];
#pragma unroll
                    for (int g = 1; g < 4; ++g) vsel = (gi == g) ? le[g * 8 + o] : vsel;
                    ev[o] = vsel; }
                int i0 = 0; float m0v = ev[0];
#pragma unroll
                for (int o = 1; o < 8; ++o) if (ev[o] > m0v) { m0v = ev[o]; i0 = o; }
                int i1 = (i0 == 0) ? 1 : 0; float m1v = -3.4e38f;
#pragma unroll
                for (int o = 0; o < 8; ++o) if (o != i0 && ev[o] > m1v) { m1v = ev[o]; i1 = o; }
                const float e1 = expf(m1v - m0v); const float w0 = gp / (1.f + e1), w1 = gp * e1 / (1.f + e1);
                const int ex0 = gi * 8 + i0, ex1 = gi * 8 + i1;
                rw[2 * t] = w0; rw[2 * t + 1] = w1;
                const unsigned p0 = atomicAdd(&cnt[ex0], 1u); list[(size_t)ex0 * T + p0] = t * 2;
                const unsigned p1 = atomicAdd(&cnt[ex1], 1u); list[(size_t)ex1 * T + p1] = t * 2 + 1;
            }
        }
        SEAM(PH_ROUTER);
    }
    if (HAS(PH_G7) || HAS(PH_G8)) {
        if (tid < NE) MISC[64 + tid] = __hip_atomic_load(cnt + tid, RLX_AGENT);
        __syncthreads();
        if (tid == 0) { unsigned acc = 0u; for (int e = 0; e < NE; ++e) { MISC[16 + e] = acc; acc += (MISC[64 + e] + 255u) >> 8; } MISC[16 + NE] = acc; }
        __syncthreads();
        const int ntiles = (int)MISC[16 + NE];
        if (HAS(PH_G7)) {
            g8::MoeOrder S{(const char*)x1b, (const char*)(wt + WT_GU), list, MISC + 16, MISC + 64, ntiles * 4, G, bx, 0, (size_t)1024 * 1024 * 2, (size_t)256 * 1024 * 2, 1};
            g8::EpiGateUp E{hb};
            g8::gemm_phase<g8::EpiGateUp, g8::MoeOrder, true, true>(lds, 1024, S, E);
            SEAM(PH_G7);
        }
        if (HAS(PH_G8)) {
            g8::MoeOrder S{(const char*)hb, (const char*)(wt + WT_DN), list, MISC + 16, MISC + 64, ntiles * 4, G, bx, (size_t)256 * 512 * 2, (size_t)1024 * 512 * 2, (size_t)256 * 512 * 2, 0};
            g8::EpiDown E{ybuf, list, rw, MISC + 64};
            g8::gemm_phase<g8::EpiDown, g8::MoeOrder, true, false>(lds, 512, S, E);
            SEAM(PH_G8);
        }
    }
    if (HAS(PH_FINAL)) {
        for (int t = gw; t < T; t += NGW) {
            float* yr = out + (size_t)t * 1024; const float2 st = stats[t]; float xv[16]; float s = 0.f;
#pragma unroll
            for (int j = 0; j < 4; ++j) { const int c0 = j * 256 + lane * 4; const f32x4 vv = *(const f32x4*)(yr + c0); const f32x4 gg = *(const f32x4*)(ln1_g + c0); const f32x4 bb = *(const f32x4*)(ln1_b + c0);
                const u32x2 a = *(const u32x2*)(ybuf + (size_t)(2 * t) * 1024 + c0); const u32x2 b = *(const u32x2*)(ybuf + (size_t)(2 * t + 1) * 1024 + c0);
                const float ya[4] = {bflo(a.x), bfhi(a.x), bflo(a.y), bfhi(a.y)}; const float yb[4] = {bflo(b.x), bfhi(b.x), bflo(b.y), bfhi(b.y)};
#pragma unroll
                for (int i = 0; i < 4; ++i) { const float x1 = (vv[i] - st.x) * st.y * gg[i] + bb[i]; const float val = ALPHA * x1 + (ya[i] + yb[i]); xv[4 * j + i] = val; s += val; } }
            const float mu = wave_sum(s) * (1.f / 1024.f); float s2 = 0.f;
#pragma unroll
            for (int i = 0; i < 16; ++i) { const float d = xv[i] - mu; s2 += d * d; }
            const float rstd = 1.0f / sqrtf(wave_sum(s2) * (1.f / 1024.f) + LN_EPS);
#pragma unroll
            for (int j = 0; j < 4; ++j) { const int c0 = j * 256 + lane * 4; const f32x4 gg = *(const f32x4*)(ln2_g + c0); const f32x4 bb = *(const f32x4*)(ln2_b + c0); f32x4 o;
#pragma unroll
                for (int i = 0; i < 4; ++i) o[i] = (xv[4 * j + i] - mu) * rstd * gg[i] + bb[i];
                *(f32x4*)(yr + c0) = o; }
        }
    }
#undef HAS
#undef SEAM
}
#undef IN_F
#undef x_
#undef positions
#undef w_in
#undef gate_bias
#undef lam_vecs
#undef subln_gain
#undef w_pool
#undef pool_scale
#undef w_branch_a
#undef w_branch_b
#undef w_out
#undef ln1_g
#undef ln1_b
#undef wrg
#undef brg
#undef wre
#undef bre
#undef wgu
#undef wdn
#undef ln2_g
#undef ln2_b
#undef wt
#undef xb
#undef qb
#undef kb
#undef vb
#undef ub
#undef gb
#undef on
#undef mixed
#undef merged
#undef x1b
#undef hb
#undef ybuf
#undef rope
#undef pooled
#undef misc
#undef ctl
#undef stats
#undef rw
#undef list
#undef scal
#undef cnt
#undef wpool_bd


#ifndef MK_OPT
#define MK_OPT 0x003u
#endif
#ifndef MK_M2A
#define MK_M2A 0xff4u
#define MK_M2B 0u
#define MK_M2C 0u
#endif
#ifndef MK_ONE
#define MK_ONE 0
#endif
constexpr unsigned OPT = MK_OPT;
#define OPTP(p) ((OPT >> (p)) & 1u)


#ifdef MK_DEBUG_HASH
__global__ void k_hash(const uint4* __restrict__ p, size_t n16, unsigned long long* __restrict__ outh) {
    unsigned long long h = 0ull;
    for (size_t i = blockIdx.x * (size_t)blockDim.x + threadIdx.x; i < n16; i += (size_t)gridDim.x * blockDim.x) { const uint4 w = p[i];
        const unsigned long long m = (unsigned long long)(i * 2654435761ull + 12345ull) | 1ull;
        h += ((unsigned long long)w.x * 0x9E3779B1ull + (unsigned long long)w.y * 0x85EBCA77ull + (unsigned long long)w.z * 0xC2B2AE3Dull + (unsigned long long)w.w * 0x27D4EB2Full) * m; }
    for (int o = 32; o > 0; o >>= 1) h += __shfl_xor(h, o);
    if ((threadIdx.x & 63) == 0) atomicAdd(outh, h);
}
__global__ void k_poison(float* __restrict__ out, const unsigned long long* __restrict__ hs) {
    float code = 0.f; for (int r = 1; r < 10; ++r) if (hs[r] != hs[0]) code = 1.f;
    if (code == 0.f) return;
    for (size_t i = blockIdx.x * (size_t)blockDim.x + threadIdx.x; i < (size_t)T * DM; i += (size_t)gridDim.x * blockDim.x) out[i] = __builtin_nanf("") * code;
}
#endif
extern "C" void kernel_launch(void* const* d_in, const int* in_sizes, int n_in, void* d_out, int out_size, void* d_ws, size_t ws_size, hipStream_t stream) {
    static int grid = 0;
    if (grid == 0) {
        if (n_in != 21 || in_sizes[0] != T * DM || out_size != T * DM || ws_size < WS_END) { fprintf(stderr, "kernel_launch: unexpected shapes (n_in %d, x %d, out %d, ws %zu)\n", n_in, n_in > 0 ? in_sizes[0] : -1, out_size, ws_size); grid = -1; return; }
        int dev = 0, cus = 0;
        if (hipGetDevice(&dev) != hipSuccess || hipDeviceGetAttribute(&cus, hipDeviceAttributeMultiprocessorCount, dev) != hipSuccess) { fprintf(stderr, "kernel_launch: device query failed\n"); grid = -1; return; }
        int per_cu = 0;
        if (hipOccupancyMaxActiveBlocksPerMultiprocessor(&per_cu, (const void*)mk_fwd, NTHREADS, 0) != hipSuccess || per_cu < 1) fprintf(stderr, "kernel_launch: note: occupancy query reports %d blocks per CU\n", per_cu);
        (void)hipGetLastError();
        grid = cus;
    }
    if (grid < 0) return;
    const float* x = (const float*)d_in[0]; const int* positions = (const int*)d_in[1]; const float* w_in = (const float*)d_in[2]; const float* gate_bias = (const float*)d_in[3];
    const float* lam_vecs = (const float*)d_in[4]; const float* subln_gain = (const float*)d_in[5]; const float* w_pool = (const float*)d_in[6]; const float* pool_scale = (const float*)d_in[7];
    const float* w_branch_a = (const float*)d_in[8]; const float* w_branch_b = (const float*)d_in[9]; const float* w_out = (const float*)d_in[10]; const float* ln1_g = (const float*)d_in[11];
    const float* ln1_b = (const float*)d_in[12]; const float* wrg = (const float*)d_in[13]; const float* brg = (const float*)d_in[14]; const float* wre = (const float*)d_in[15];
    const float* bre = (const float*)d_in[16]; const float* wgu = (const float*)d_in[17]; const float* wdn = (const float*)d_in[18]; const float* ln2_g = (const float*)d_in[19]; const float* ln2_b = (const float*)d_in[20];
    char* ws = (char*)d_ws; float* out = (float*)d_out;
    bf16_t* qb = (bf16_t*)(ws + WS_Q); bf16_t* kb = (bf16_t*)(ws + WS_K); bf16_t* vb = (bf16_t*)(ws + WS_V); bf16_t* ub = (bf16_t*)(ws + WS_U); bf16_t* gb = (bf16_t*)d_out;
    bf16_t* on = (bf16_t*)(ws + WS_ON); bf16_t* mixed = (bf16_t*)(ws + WS_MIXED); bf16_t* merged = (bf16_t*)(ws + WS_MERGED); bf16_t* x1b = (bf16_t*)(ws + WS_X1B);
    bf16_t* hb = (bf16_t*)(ws + WS_H); bf16_t* ybuf = (bf16_t*)(ws + WS_YBUF); float2* rope = (float2*)(ws + WS_ROPE); float* tmp = (float*)(ws + WS_TEMP);
    char* misc = ws + WS_MISC; unsigned* ctl = (unsigned*)(misc + MS_CTL); float2* stats = (float2*)(misc + MS_STATS); int2* rexp = (int2*)(misc + MS_ROUTE); float2* rw = (float2*)(misc + MS_ROUTE + (size_t)T * 8);
    int* list = (int*)(misc + MS_LIST); float* scal = (float*)(misc + MS_SCAL); unsigned* cnt = ctl;

    MKArgs a{}; int nlaunch = 0;
    for (int i = 0; i < 21; ++i) a.in[i] = d_in[i];
    a.out = out; a.ws = (unsigned char*)d_ws;
    if (hipMemsetAsync(ctl, 0, 65536, stream) != hipSuccess) { fprintf(stderr, "kernel_launch: memset failed\n"); return; }
#define MK(maskv) do { a.mask = (maskv); a.li = (unsigned)(nlaunch++ % 3); hipLaunchKernelGGL(mk_fwd, dim3(grid), dim3(NTHREADS), 0, stream, a); } while (0)
    if (MK_ONE == 1) { MK((1u << PH_N) - 1u); return; }
    if (MK_ONE == 2) {
        MK(0x003u);
        for (int mh = 0; mh < 2; ++mh) { const int m0 = mh * 16384; nattn<<<(16384 / 64) * 16, 64, 0, stream>>>(qb, kb, vb, scal, tmp, m0); post_rms<<<16384 * 8 / 256, 256, 0, stream>>>(tmp, subln_gain, on, m0, 16384); }
        MK(MK_M2A); if (MK_M2B) MK(MK_M2B); if (MK_M2C) MK(MK_M2C); return; }

    constexpr int MC = 16384;
#if 0
#else
#ifdef MK_TEST_BAR
    MK(0x003u);
#else
    if (OPTP(PH_PRO)) MK(1u << PH_PRO); else k_prep<<<T * 32 / 256, 256, 0, stream>>>(positions, lam_vecs, rope, scal, ctl);
    if (OPTP(PH_G1)) MK(1u << PH_G1);
#endif
#endif
#ifndef MK_OVR
#define MK_OVR 0
#endif
    const int ovr = OPTP(PH_G1) ? MK_OVR : 15;
    for (int mh = 0; mh < 2; ++mh) {
        const int m0 = mh * MC; AL_F32 ax{x + (size_t)m0 * DM, DM, 0};
        if (ovr & 1) for (int qk = 0; qk < 2; ++qk) {
            ngemm<AL_F32><<<dim3(16, MC / 64), 256, 0, stream>>>(ax, w_in + qk * 1024, INW, tmp, 1024, MC, 1024, DM);
            post_qk<<<MC * 512 / 256, 256, 0, stream>>>(tmp, rope, qk ? kb : qb, m0, MC, qk ? 1.f : QSCALE);
        }
        if (ovr & 2) { ngemm<AL_F32><<<dim3(16, MC / 64), 256, 0, stream>>>(ax, w_in + 2048, INW, tmp, 1024, MC, 1024, DM);
        post_plain<<<MC * 1024 / 256, 256, 0, stream>>>(tmp, vb, 1024, 0, m0, MC, 1024, nullptr); }
        if (ovr & 4) { ngemm<AL_F32><<<dim3(8, MC / 64), 256, 0, stream>>>(ax, w_in + 3072, INW, tmp, 512, MC, 512, DM);
        post_plain<<<MC * 512 / 256, 256, 0, stream>>>(tmp, ub, 512, 0, m0, MC, 512, nullptr); }
        if (ovr & 8) for (int br = 0; br < 2; ++br) {
            ngemm<AL_F32><<<dim3(16, MC / 64), 256, 0, stream>>>(ax, w_in + 3584 + br * 1024, INW, tmp, 1024, MC, 1024, DM);
            post_gate<<<MC * 1024 / 256, 256, 0, stream>>>(tmp, gate_bias, gb, br * 1024, m0, MC);
        }
    }
    if (OPTP(PH_ATT)) MK(1u << PH_ATT);
    else for (int mh = 0; mh < 2; ++mh) {
        const int m0 = mh * MC;
        nattn<<<(MC / 64) * 16, 64, 0, stream>>>(qb, kb, vb, scal, tmp, m0);
        post_rms<<<MC * 8 / 256, 256, 0, stream>>>(tmp, subln_gain, on, m0, MC);
    }
    if (OPTP(PH_POOLA)) { MK(1u << PH_POOLA); MK(1u << PH_POOLG); }
    else for (int mh = 0; mh < 2; ++mh) {
        const int m0 = mh * MC;
        for (int g = 0; g < 4; ++g) { AL_POOL ap{ub + (size_t)m0 * PW, g, 0};
            ngemm<AL_POOL><<<dim3(2, MC / 64), 256, 0, stream>>>(ap, w_pool + (size_t)g * 128 * 128, 128, tmp + g * 128, 512, MC, 128, 128); }
        post_plain<<<MC * 512 / 256, 256, 0, stream>>>(tmp, mixed, 512, 0, m0, MC, 512, pool_scale);
    }
    if (OPTP(PH_G4A)) MK(1u << PH_G4A);
    else for (int mh = 0; mh < 2; ++mh) {
        const int m0 = mh * MC;
        { AL_BF16 al{on + (size_t)m0 * 1024, 1024, 0}; ngemm<AL_BF16><<<dim3(16, MC / 64), 256, 0, stream>>>(al, w_branch_a, 1024, tmp, 1024, MC, 1024, 1024); }
        post_merge<<<MC * 1024 / 256, 256, 0, stream>>>(tmp, gb, merged, 0, m0, MC);
    }
    if (OPTP(PH_G4B)) MK(1u << PH_G4B);
    else for (int mh = 0; mh < 2; ++mh) {
        const int m0 = mh * MC;
        { AL_BF16 al{mixed + (size_t)m0 * 512, 512, 0}; ngemm<AL_BF16><<<dim3(16, MC / 64), 256, 0, stream>>>(al, w_branch_b, 1024, tmp, 1024, MC, 1024, 512); }
        post_merge<<<MC * 1024 / 256, 256, 0, stream>>>(tmp, gb, merged, 1, m0, MC);
    }
    if (OPTP(PH_G5)) MK(1u << PH_G5);
    else for (int mh = 0; mh < 2; ++mh) {
        const int m0 = mh * MC;
        { AL_BF16 al{merged + (size_t)m0 * 1024, 1024, 0}; ngemm<AL_BF16><<<dim3(16, MC / 64), 256, 0, stream>>>(al, w_out, 1024, tmp, 1024, MC, 1024, 1024); }
        post_y<<<MC * 1024 / 256, 256, 0, stream>>>(tmp, x, out, m0, MC);
    }
    if (OPTP(PH_ROUTER)) MK(1u << PH_ROUTER); else k_router<<<T / 4, 256, 0, stream>>>(out, ln1_g, ln1_b, wrg, brg, wre, bre, x1b, stats, rexp, rw, list, cnt);
    if (OPTP(PH_G7)) MK(1u << PH_G7); else nmoe_gu<<<dim3(8, T / 64, NE), 256, 0, stream>>>(x1b, list, cnt, wgu, hb);
    if (OPTP(PH_G8)) MK(1u << PH_G8); else nmoe_dn<<<dim3(16, T / 64, NE), 256, 0, stream>>>(hb, list, cnt, rw, wdn, ybuf);
    if (OPTP(PH_FINAL)) MK(1u << PH_FINAL); else k_final<<<T / 4, 256, 0, stream>>>(out, stats, ln1_g, ln1_b, ybuf, ln2_g, ln2_b);
#undef MK
}
```

```cpp
#define MK_OPT 0xfffu
#define MK_ONE 1
#include <hip/hip_runtime.h>
#include <cstdio>
#include <cstdint>
#include <cmath>

typedef unsigned short bf16_t;
typedef float f32x4 __attribute__((ext_vector_type(4)));

constexpr int NB = 16, SEQ = 2048, DM = 1024, T = NB * SEQ;
constexpr int NHEAD = 8, HD = 64, NHM = 16;
constexpr int INW = 5632;
constexpr int PW = 512, PG = 4, PGD = 128;
constexpr int NE = 32, NGRP = 4, EPG = 8, FF = 512;
constexpr float LN_EPS = 1e-5f, RMS_EPS = 1e-5f;
constexpr float ALPHA = 1.189207115002721f;
constexpr float LAMBDA_INIT = 0.2f;
constexpr float QSCALE = 0.125f * 1.4426950408889634f;

constexpr size_t MiB = 1u << 20;
constexpr size_t WS_WT    = 0;
constexpr size_t WS_XB    = 112 * MiB;
constexpr size_t WS_ON    = 112 * MiB;
constexpr size_t WS_YBUF  = 112 * MiB;
constexpr size_t WS_Q     = 176 * MiB;
constexpr size_t WS_MERGED= 176 * MiB;
constexpr size_t WS_K     = 240 * MiB;
constexpr size_t WS_X1B   = 240 * MiB;
constexpr size_t WS_V     = 304 * MiB;
constexpr size_t WS_H     = 304 * MiB;
constexpr size_t WS_U     = 368 * MiB;
constexpr size_t WS_MIXED = 400 * MiB;
constexpr size_t WS_ROPE  = 432 * MiB;
constexpr size_t WS_MISC  = 440 * MiB;
constexpr size_t WS_TEMP  = 448 * MiB;
constexpr size_t WS_END   = 512 * MiB;
constexpr size_t MS_CTL   = 0;
constexpr size_t MS_STATS = 64 * 1024;
constexpr size_t MS_ROUTE = 512 * 1024;
constexpr size_t MS_LIST  = 1 * MiB;
constexpr size_t MS_SCAL  = 6 * MiB;

__device__ __forceinline__ float bf2f(bf16_t v) { return __uint_as_float((unsigned)v << 16); }
__device__ __forceinline__ bf16_t f2bf(float f) { unsigned u = __float_as_uint(f); return (bf16_t)((u + 0x7fffu + ((u >> 16) & 1u)) >> 16); }
__host__ __device__ __forceinline__ int qk_pos_of_d(int d) { return ((d >> 4) & 1) * 32 + ((d >> 2) & 3) * 8 + (d >> 5) * 4 + (d & 3); }

struct AL_F32  { const float* p; int ld; int pad;  __device__ __forceinline__ float operator()(int r, int k) const { return p[(size_t)r * ld + k]; } };
struct AL_BF16 { const bf16_t* p; int ld; int pad; __device__ __forceinline__ float operator()(int r, int k) const { return bf2f(p[(size_t)r * ld + k]); } };
struct AL_POOL { const bf16_t* u; int g; int pad;
    __device__ __forceinline__ float operator()(int r, int k) const {
        const int w = 2 << g, s = r & (SEQ - 1); const int n = (s + 1 < w) ? s + 1 : w; float acc = 0.f;
        for (int i = 0; i < n; ++i) acc += bf2f(u[(size_t)(r - i) * PW + g * PGD + k]);
        return acc / (float)n - bf2f(u[(size_t)r * PW + g * PGD + k]); } };

template <class AL>
__global__ __launch_bounds__(256) void ngemm(AL al, const float* __restrict__ Bm, int ldb, float* __restrict__ C, int ldc, int M, int N, int K) {
    __shared__ float As[16][68]; __shared__ float Bs[16][68];
    const int tid = threadIdx.x, tx = tid & 15, ty = tid >> 4; const int m0 = blockIdx.y * 64, n0 = blockIdx.x * 64;
    float acc[4][4] = {};
    for (int k0 = 0; k0 < K; k0 += 16) {
#pragma unroll
        for (int i = 0; i < 4; ++i) { const int e = tid + i * 256; const int r = e >> 4, kk = e & 15; As[kk][r] = (m0 + r < M) ? al(m0 + r, k0 + kk) : 0.f; }
#pragma unroll
        for (int i = 0; i < 4; ++i) { const int e = tid + i * 256; const int kk = e >> 6, c = e & 63; Bs[kk][c] = (n0 + c < N) ? Bm[(size_t)(k0 + kk) * ldb + n0 + c] : 0.f; }
        __syncthreads();
#pragma unroll
        for (int kk = 0; kk < 16; ++kk) { float a[4], b[4];
#pragma unroll
            for (int i = 0; i < 4; ++i) { a[i] = As[kk][ty * 4 + i]; b[i] = Bs[kk][tx * 4 + i]; }
#pragma unroll
            for (int i = 0; i < 4; ++i)
#pragma unroll
                for (int j = 0; j < 4; ++j) acc[i][j] = fmaf(a[i], b[j], acc[i][j]); }
        __syncthreads();
    }
#pragma unroll
    for (int i = 0; i < 4; ++i)
#pragma unroll
        for (int j = 0; j < 4; ++j) { const int r = m0 + ty * 4 + i, c = n0 + tx * 4 + j; if (r < M && c < N) C[(size_t)r * ldc + c] = acc[i][j]; }
}

__global__ void k_prep(const int* __restrict__ positions, const float* __restrict__ lam_vecs, float2* __restrict__ rope, float* __restrict__ scal, unsigned* __restrict__ ctl) {
    const int gid = blockIdx.x * blockDim.x + threadIdx.x;
    if (gid < T * 32) { const int t = gid >> 5, i = gid & 31;
        const float inv = powf(10000.0f, -(float)i * (2.0f / 64.0f)); const float ang = (float)positions[t] * inv;
        const double a = (double)ang; rope[gid] = make_float2((float)cos(a), (float)sin(a)); }
    if (gid < 16384) ctl[gid] = 0u;
    if (gid == 0) { float s01 = 0.f, s23 = 0.f; for (int i = 0; i < 64; ++i) { s01 += lam_vecs[i] * lam_vecs[64 + i]; s23 += lam_vecs[128 + i] * lam_vecs[192 + i]; }
        scal[0] = expf(s01) - expf(s23) + LAMBDA_INIT; }
}
__global__ void post_qk(const float* __restrict__ tmp, const float2* __restrict__ rope, bf16_t* __restrict__ out, int m0, int Mc, float scale) {
    const int gid = blockIdx.x * blockDim.x + threadIdx.x; if (gid >= Mc * 512) return;
    const int r = gid >> 9, p = gid & 511, hm = p >> 5, i = p & 31; const int t = m0 + r;
    const float t1 = tmp[(size_t)r * 1024 + hm * 64 + i], t2 = tmp[(size_t)r * 1024 + hm * 64 + i + 32]; const float2 cs = rope[t * 32 + i];
    out[(size_t)t * 1024 + hm * 64 + qk_pos_of_d(i)] = f2bf((t1 * cs.x - t2 * cs.y) * scale);
    out[(size_t)t * 1024 + hm * 64 + qk_pos_of_d(i + 32)] = f2bf((t2 * cs.x + t1 * cs.y) * scale);
}
__global__ void post_plain(const float* __restrict__ tmp, bf16_t* __restrict__ out, int ldo, int coloff, int m0, int Mc, int N, const float* __restrict__ colscale) {
    const int gid = blockIdx.x * blockDim.x + threadIdx.x; if (gid >= Mc * N) return;
    const int r = gid / N, c = gid % N; float v = tmp[(size_t)r * N + c]; if (colscale) v *= colscale[c];
    out[(size_t)(m0 + r) * ldo + coloff + c] = f2bf(v);
}
__global__ void post_gate(const float* __restrict__ tmp, const float* __restrict__ bias, bf16_t* __restrict__ gates, int coloff, int m0, int Mc) {
    const int gid = blockIdx.x * blockDim.x + threadIdx.x; if (gid >= Mc * 1024) return;
    const int r = gid >> 10, c = gid & 1023; const float v = tmp[(size_t)r * 1024 + c] + bias[coloff + c];
    gates[(size_t)(m0 + r) * 2048 + coloff + c] = f2bf(1.f / (1.f + expf(-v)));
}
__global__ __launch_bounds__(64) void nattn(const bf16_t* __restrict__ q, const bf16_t* __restrict__ k, const bf16_t* __restrict__ v, const float* __restrict__ scal, float* __restrict__ tmp, int m0) {
    const int lane = threadIdx.x; const int blk = blockIdx.x;
    const int half = blk & 1, head = (blk >> 1) & 7, cg = blk >> 4; const int t0 = m0 + cg * 64, t = t0 + lane; const int b = t0 / SEQ, s0 = t0 % SEQ; const int nkeys = ((s0 >> 6) + 1) * 64;
    const float lam = scal[0];
    float res[64];
    for (int mp = 0; mp < 2; ++mp) {
        const int hm = head * 2 + mp; float qv[64];
#pragma unroll
        for (int d = 0; d < 64; ++d) qv[d] = bf2f(q[(size_t)t * 1024 + hm * 64 + d]);
        float mx = -1e30f, l = 0.f; float o[64];
#pragma unroll
        for (int d = 0; d < 64; ++d) o[d] = 0.f;
        for (int j = 0; j < nkeys; ++j) { const size_t kr = (size_t)(b * SEQ + j) * 1024; float sc = 0.f;
            const uint4* kp = (const uint4*)(k + kr + hm * 64); const uint4* vp = (const uint4*)(v + kr + head * 128 + half * 64);
#pragma unroll
            for (int c = 0; c < 8; ++c) { const uint4 w = kp[c]; const unsigned ww[4] = {w.x, w.y, w.z, w.w};
#pragma unroll
                for (int e = 0; e < 4; ++e) { sc = fmaf(qv[c * 8 + 2 * e], __uint_as_float(ww[e] << 16), sc); sc = fmaf(qv[c * 8 + 2 * e + 1], __uint_as_float(ww[e] & 0xffff0000u), sc); } }
            const float mn = fmaxf(mx, sc), al = exp2f(mx - mn), p = exp2f(sc - mn); mx = mn; l = l * al + p;
#pragma unroll
            for (int c = 0; c < 8; ++c) { const uint4 w = vp[c]; const unsigned ww[4] = {w.x, w.y, w.z, w.w};
#pragma unroll
                for (int e = 0; e < 4; ++e) { o[c * 8 + 2 * e] = fmaf(p, __uint_as_float(ww[e] << 16), o[c * 8 + 2 * e] * al); o[c * 8 + 2 * e + 1] = fmaf(p, __uint_as_float(ww[e] & 0xffff0000u), o[c * 8 + 2 * e + 1] * al); } } }
        const float il = 1.f / l;
#pragma unroll
        for (int d = 0; d < 64; ++d) res[d] = (mp == 0) ? o[d] * il : res[d] - lam * o[d] * il;
    }
#pragma unroll
    for (int d = 0; d < 64; ++d) tmp[(size_t)(t - m0) * 1024 + head * 128 + half * 64 + d] = res[d];
}
__global__ void post_rms(const float* __restrict__ tmp, const float* __restrict__ gain, bf16_t* __restrict__ on, int m0, int Mc) {
    const int gid = blockIdx.x * blockDim.x + threadIdx.x; if (gid >= Mc * 8) return;
    const int r = gid >> 3, head = gid & 7; const float* p = tmp + (size_t)r * 1024 + head * 128; float ss = 0.f;
    for (int d = 0; d < 128; ++d) ss += p[d] * p[d];
    const float rs = 1.0f / sqrtf(ss * (1.f / 128.f) + RMS_EPS);
    for (int d = 0; d < 128; ++d) on[(size_t)(m0 + r) * 1024 + head * 128 + d] = f2bf(p[d] * rs * gain[d] * (1.f - LAMBDA_INIT));
}
__global__ void post_merge(const float* __restrict__ tmp, const bf16_t* __restrict__ gates, bf16_t* __restrict__ merged, int br, int m0, int Mc) {
    const int gid = blockIdx.x * blockDim.x + threadIdx.x; if (gid >= Mc * 1024) return;
    const int r = gid >> 10, c = gid & 1023; const size_t t = m0 + r; const float g = bf2f(gates[t * 2048 + br * 1024 + c]);
    float val = g * tmp[(size_t)r * 1024 + c]; if (br) val += bf2f(merged[t * 1024 + c]);
    merged[t * 1024 + c] = f2bf(val);
}
__global__ void post_y(const float* __restrict__ tmp, const float* __restrict__ x, float* __restrict__ y, int m0, int Mc) {
    const int gid = blockIdx.x * blockDim.x + threadIdx.x; if (gid >= Mc * 1024) return;
    const size_t o = (size_t)m0 * 1024 + gid; y[o] = ALPHA * x[o] + tmp[gid];
}
__device__ __forceinline__ float wave_sum(float v) {
#pragma unroll
    for (int o = 1; o < 64; o <<= 1) v += __shfl_xor(v, o);
    return v;
}
__global__ __launch_bounds__(256) void k_router(const float* __restrict__ y, const float* __restrict__ g1, const float* __restrict__ b1, const float* __restrict__ wrg, const float* __restrict__ brg,
                                                const float* __restrict__ wre, const float* __restrict__ bre, bf16_t* __restrict__ x1b, float2* __restrict__ stats, int2* __restrict__ rexp, float2* __restrict__ rw,
                                                int* __restrict__ list, unsigned* __restrict__ cnt) {
    const int lane = threadIdx.x & 63; const int t = blockIdx.x * 4 + (threadIdx.x >> 6);
    const float* yr = y + (size_t)t * 1024; float xv[16]; float s = 0.f;
#pragma unroll
    for (int j = 0; j < 4; ++j) { const f32x4 vv = *(const f32x4*)(yr + j * 256 + lane * 4); xv[4 * j] = vv.x; xv[4 * j + 1] = vv.y; xv[4 * j + 2] = vv.z; xv[4 * j + 3] = vv.w; s += (vv.x + vv.y) + (vv.z + vv.w); }
    const float mu = wave_sum(s) * (1.f / 1024.f); float s2 = 0.f;
#pragma unroll
    for (int i = 0; i < 16; ++i) { const float d = xv[i] - mu; s2 += d * d; }
    const float rstd = 1.0f / sqrtf(wave_sum(s2) * (1.f / 1024.f) + LN_EPS);
    if (lane == 0) stats[t] = make_float2(mu, rstd);
#pragma unroll
    for (int j = 0; j < 4; ++j)
#pragma unroll
        for (int i = 0; i < 4; ++i) { const int c = j * 256 + lane * 4 + i; xv[4 * j + i] = (xv[4 * j + i] - mu) * rstd * g1[c] + b1[c]; }
#pragma unroll
    for (int j = 0; j < 4; ++j) { uint2 w; w.x = (unsigned)f2bf(xv[4 * j]) | ((unsigned)f2bf(xv[4 * j + 1]) << 16); w.y = (unsigned)f2bf(xv[4 * j + 2]) | ((unsigned)f2bf(xv[4 * j + 3]) << 16);
        *(uint2*)(x1b + (size_t)t * 1024 + j * 256 + lane * 4) = w; }
    float lg[4], le[32];
#pragma unroll
    for (int o = 0; o < 4; ++o) { float a = 0.f;
#pragma unroll
        for (int j = 0; j < 4; ++j)
#pragma unroll
            for (int i = 0; i < 4; ++i) a = fmaf(xv[4 * j + i], wrg[(size_t)(j * 256 + lane * 4 + i) * 4 + o], a);
        lg[o] = wave_sum(a) + brg[o]; }
#pragma unroll
    for (int o = 0; o < 32; ++o) { float a = 0.f;
#pragma unroll
        for (int j = 0; j < 4; ++j)
#pragma unroll
            for (int i = 0; i < 4; ++i) a = fmaf(xv[4 * j + i], wre[(size_t)(j * 256 + lane * 4 + i) * 32 + o], a);
        le[o] = wave_sum(a) + bre[o]; }
    if (lane == 0) {
        int gi = 0; float gm = lg[0];
#pragma unroll
        for (int o = 1; o < 4; ++o) if (lg[o] > gm) { gm = lg[o]; gi = o; }
        float gs = 0.f;
#pragma unroll
        for (int o = 0; o < 4; ++o) gs += expf(lg[o] - gm);
        const float gp = 1.f / gs;
        float ev[8];
#pragma unroll
        for (int o = 0; o < 8; ++o) { float vsel = le[o];
#pragma unroll
            for (int g = 1; g < 4; ++g) vsel = (gi == g) ? le[g * 8 + o] : vsel;
            ev[o] = vsel; }
        int i0 = 0; float m0v = ev[0];
#pragma unroll
        for (int o = 1; o < 8; ++o) if (ev[o] > m0v) { m0v = ev[o]; i0 = o; }
        int i1 = (i0 == 0) ? 1 : 0; float m1v = -3.4e38f;
#pragma unroll
        for (int o = 0; o < 8; ++o) if (o != i0 && ev[o] > m1v) { m1v = ev[o]; i1 = o; }
        const float e1 = expf(m1v - m0v); const float w0 = gp / (1.f + e1), w1 = gp * e1 / (1.f + e1);
        const int ex0 = gi * 8 + i0, ex1 = gi * 8 + i1;
        rexp[t] = make_int2(ex0, ex1); rw[t] = make_float2(w0, w1);
        const unsigned p0 = atomicAdd(&cnt[ex0], 1u); list[(size_t)ex0 * T + p0] = t * 2;
        const unsigned p1 = atomicAdd(&cnt[ex1], 1u); list[(size_t)ex1 * T + p1] = t * 2 + 1;
    }
}
__global__ __launch_bounds__(256) void nmoe_gu(const bf16_t* __restrict__ x1b, const int* __restrict__ list, const unsigned* __restrict__ cnt, const float* __restrict__ wgu, bf16_t* __restrict__ h) {
    __shared__ float As[16][68]; __shared__ float Bg[16][68]; __shared__ float Bu[16][68]; __shared__ int toks[64];
    const int e = blockIdx.z; const int M = (int)cnt[e]; const int m0 = blockIdx.y * 64, n0 = blockIdx.x * 64; if (m0 >= M) return;
    int tb = 0; for (int i = 0; i < e; ++i) tb += ((int)cnt[i] + 255) >> 8;
    const int tid = threadIdx.x, tx = tid & 15, ty = tid >> 4;
    if (tid < 64) toks[tid] = (m0 + tid < M) ? (list[(size_t)e * T + m0 + tid] >> 1) : 0;
    __syncthreads();
    const float* W = wgu + (size_t)e * 1024 * 1024; float ag[4][4] = {}, au[4][4] = {};
    for (int k0 = 0; k0 < 1024; k0 += 16) {
#pragma unroll
        for (int i = 0; i < 4; ++i) { const int el = tid + i * 256; const int r = el >> 4, kk = el & 15; As[kk][r] = bf2f(x1b[(size_t)toks[r] * 1024 + k0 + kk]); }
#pragma unroll
        for (int i = 0; i < 4; ++i) { const int el = tid + i * 256; const int kk = el >> 6, c = el & 63; Bg[kk][c] = W[(size_t)(k0 + kk) * 1024 + n0 + c]; Bu[kk][c] = W[(size_t)(k0 + kk) * 1024 + 512 + n0 + c]; }
        __syncthreads();
#pragma unroll
        for (int kk = 0; kk < 16; ++kk) { float a[4], bg[4], bu[4];
#pragma unroll
            for (int i = 0; i < 4; ++i) { a[i] = As[kk][ty * 4 + i]; bg[i] = Bg[kk][tx * 4 + i]; bu[i] = Bu[kk][tx * 4 + i]; }
#pragma unroll
            for (int i = 0; i < 4; ++i)
#pragma unroll
                for (int j = 0; j < 4; ++j) { ag[i][j] = fmaf(a[i], bg[j], ag[i][j]); au[i][j] = fmaf(a[i], bu[j], au[i][j]); } }
        __syncthreads();
    }
#pragma unroll
    for (int i = 0; i < 4; ++i)
#pragma unroll
        for (int j = 0; j < 4; ++j) { const int r = m0 + ty * 4 + i, c = n0 + tx * 4 + j; if (r < M) { const float g = ag[i][j]; h[((size_t)tb * 256 + r) * 512 + c] = f2bf(g / (1.f + expf(-g)) * au[i][j]); } }
}
__global__ __launch_bounds__(256) void nmoe_dn(const bf16_t* __restrict__ h, const int* __restrict__ list, const unsigned* __restrict__ cnt, const float2* __restrict__ rw, const float* __restrict__ wdn, bf16_t* __restrict__ ybuf) {
    __shared__ float As[16][68]; __shared__ float Bs[16][68];
    const int e = blockIdx.z; const int M = (int)cnt[e]; const int m0 = blockIdx.y * 64, n0 = blockIdx.x * 64; if (m0 >= M) return;
    int tb = 0; for (int i = 0; i < e; ++i) tb += ((int)cnt[i] + 255) >> 8;
    const int tid = threadIdx.x, tx = tid & 15, ty = tid >> 4;
    const float* W = wdn + (size_t)e * 512 * 1024; float acc[4][4] = {};
    for (int k0 = 0; k0 < 512; k0 += 16) {
#pragma unroll
        for (int i = 0; i < 4; ++i) { const int el = tid + i * 256; const int r = el >> 4, kk = el & 15; As[kk][r] = (m0 + r < M) ? bf2f(h[((size_t)tb * 256 + m0 + r) * 512 + k0 + kk]) : 0.f; }
#pragma unroll
        for (int i = 0; i < 4; ++i) { const int el = tid + i * 256; const int kk = el >> 6, c = el & 63; Bs[kk][c] = W[(size_t)(k0 + kk) * 1024 + n0 + c]; }
        __syncthreads();
#pragma unroll
        for (int kk = 0; kk < 16; ++kk) { float a[4], b[4];
#pragma unroll
            for (int i = 0; i < 4; ++i) { a[i] = As[kk][ty * 4 + i]; b[i] = Bs[kk][tx * 4 + i]; }
#pragma unroll
            for (int i = 0; i < 4; ++i)
#pragma unroll
                for (int j = 0; j < 4; ++j) acc[i][j] = fmaf(a[i], b[j], acc[i][j]); }
        __syncthreads();
    }
#pragma unroll
    for (int i = 0; i < 4; ++i) { const int r = m0 + ty * 4 + i; if (r < M) { const int ent = list[(size_t)e * T + r]; const float2 w2 = rw[ent >> 1]; const float w = (ent & 1) ? w2.y : w2.x;
#pragma unroll
        for (int j = 0; j < 4; ++j) ybuf[(size_t)ent * 1024 + n0 + tx * 4 + j] = f2bf(w * acc[i][j]); } }
}
__global__ __launch_bounds__(256) void k_final(float* __restrict__ yout, const float2* __restrict__ stats, const float* __restrict__ g1, const float* __restrict__ b1, const bf16_t* __restrict__ ybuf,
                                               const float* __restrict__ g2, const float* __restrict__ b2) {
    const int lane = threadIdx.x & 63; const int t = blockIdx.x * 4 + (threadIdx.x >> 6);
    float* yr = yout + (size_t)t * 1024; const float2 st = stats[t]; float xv[16]; float s = 0.f;
#pragma unroll
    for (int j = 0; j < 4; ++j) { const int c0 = j * 256 + lane * 4; const f32x4 vv = *(const f32x4*)(yr + c0); const f32x4 gg = *(const f32x4*)(g1 + c0); const f32x4 bb = *(const f32x4*)(b1 + c0);
        const uint2 a = *(const uint2*)(ybuf + (size_t)(2 * t) * 1024 + c0); const uint2 b = *(const uint2*)(ybuf + (size_t)(2 * t + 1) * 1024 + c0);
        const float ya[4] = {__uint_as_float(a.x << 16), __uint_as_float(a.x & 0xffff0000u), __uint_as_float(a.y << 16), __uint_as_float(a.y & 0xffff0000u)};
        const float yb[4] = {__uint_as_float(b.x << 16), __uint_as_float(b.x & 0xffff0000u), __uint_as_float(b.y << 16), __uint_as_float(b.y & 0xffff0000u)};
#pragma unroll
        for (int i = 0; i < 4; ++i) { const float x1 = (vv[i] - st.x) * st.y * gg[i] + bb[i]; const float val = ALPHA * x1 + (ya[i] + yb[i]); xv[4 * j + i] = val; s += val; } }
    const float mu = wave_sum(s) * (1.f / 1024.f); float s2 = 0.f;
#pragma unroll
    for (int i = 0; i < 16; ++i) { const float d = xv[i] - mu; s2 += d * d; }
    const float rstd = 1.0f / sqrtf(wave_sum(s2) * (1.f / 1024.f) + LN_EPS);
#pragma unroll
    for (int j = 0; j < 4; ++j) { const int c0 = j * 256 + lane * 4; const f32x4 gg = *(const f32x4*)(g2 + c0); const f32x4 bb = *(const f32x4*)(b2 + c0); f32x4 o;
#pragma unroll
        for (int i = 0; i < 4; ++i) o[i] = (xv[4 * j + i] - mu) * rstd * gg[i] + bb[i];
        *(f32x4*)(yr + c0) = o; }
}

#define LAS __attribute__((address_space(3)))
#define GAS __attribute__((address_space(1)))
typedef short bf16x8 __attribute__((ext_vector_type(8)));
typedef unsigned u32x4 __attribute__((ext_vector_type(4)));
typedef unsigned u32x2 __attribute__((ext_vector_type(2)));
typedef GAS unsigned gu32;
#define RLX_AGENT __ATOMIC_RELAXED, __HIP_MEMORY_SCOPE_AGENT
#define LDS_WAIT() asm volatile("s_waitcnt lgkmcnt(0)" ::: "memory")
#define VM_WAIT() asm volatile("s_waitcnt vmcnt(0)" ::: "memory")

constexpr size_t WT_IN = 0;
constexpr size_t WT_A  = WT_IN + (size_t)INW * 1024;
constexpr size_t WT_B  = WT_A + 1024 * 1024;
constexpr size_t WT_O  = WT_B + 1024 * 512;
constexpr size_t WT_GU = WT_O + 1024 * 1024;
constexpr size_t WT_DN = WT_GU + (size_t)NE * 1024 * 1024;
constexpr size_t WT_END = WT_DN + (size_t)NE * 1024 * 512;
static_assert(WT_END * 2 <= 112 * MiB, "weight copies fit");
constexpr size_t MS_WPOOL = 7 * MiB;
constexpr size_t WS_POOLED = 448 * MiB;

constexpr int CW_CNT = 0;
constexpr int CW_BAR = 1024;

constexpr int NWAVES = 8, NTHREADS = 512;
constexpr int RING_BYTES = 131072, MISC_OFF = RING_BYTES + 320, LDS_BYTES = 147456;

typedef float f32x2_t __attribute__((ext_vector_type(2))); typedef __bf16 bf16x2_t __attribute__((ext_vector_type(2)));
__device__ __forceinline__ unsigned cvt_pk_bf16(float lo, float hi) { f32x2_t v = {lo, hi}; bf16x2_t b = __builtin_convertvector(v, bf16x2_t); return __builtin_bit_cast(unsigned, b); }
__device__ __forceinline__ float bflo(unsigned w) { return __uint_as_float(w << 16); }
__device__ __forceinline__ float bfhi(unsigned w) { return __uint_as_float(w & 0xffff0000u); }

#define XB_TMO      128
#define XB_XCNT(j)  (256  + 64 * (j))
#define XB_XSUB(j)  (1280 + 64 * (j))
#define XB_XGEN(j)  (2304 + 64 * (j))
#define XB_TOP      3328
#define XB_TOPGEN   3392
#define XCD_BAR_WORDS 3456
#define XB_SPIN_CAP (1u << 22)
__device__ __forceinline__ unsigned xb_ld(unsigned* p)              { return __hip_atomic_load(p, __ATOMIC_RELAXED, __HIP_MEMORY_SCOPE_AGENT); }
__device__ __forceinline__ unsigned xb_add(unsigned* p, unsigned v) { return __hip_atomic_fetch_add(p, v, __ATOMIC_RELAXED, __HIP_MEMORY_SCOPE_AGENT); }
__device__ __forceinline__ unsigned xb_xcc_id() { return (unsigned)__builtin_amdgcn_s_getreg((3 << 11) | 20) & 0xFu; }
#define XB_SPIN(cond, bar) do { unsigned _sp = 0; while (cond) { __builtin_amdgcn_s_sleep(1); \
    if ((++_sp & 255u) == 0u) { if (xb_ld(&(bar)[XB_TMO])) break; if (_sp > XB_SPIN_CAP) { atomicAdd(&(bar)[XB_TMO], 1u); break; } } } } while (0)
struct XcdBarrier { unsigned* bar; unsigned x; volatile LAS unsigned* st; };
__device__ __forceinline__ XcdBarrier xcd_barrier_post(unsigned* bar, volatile LAS unsigned* st) {
    XcdBarrier b; b.bar = bar; b.x = xb_xcc_id(); b.st = st;
    if (threadIdx.x == 0) (void)xb_add(&bar[XB_XCNT(b.x)], 1u);
    return b;
}
__device__ __forceinline__ void xcd_barrier_complete(unsigned* bar, unsigned x, unsigned& nloc, unsigned& nx) {
    const unsigned G = gridDim.x * gridDim.y * gridDim.z;
    unsigned sum, cnt, mine, sp = 0u;
    for (;;) {
        sum = 0u; cnt = 0u; mine = 0u;
#pragma unroll
        for (unsigned j = 0; j < 16; ++j) { const unsigned c = xb_ld(&bar[XB_XCNT(j)]); sum += c; cnt += (c > 0u) ? 1u : 0u; mine = (j == x) ? c : mine; }
        if (sum == G) break;
        __builtin_amdgcn_s_sleep(1);
        if ((++sp & 255u) == 0u) { if (xb_ld(&bar[XB_TMO])) break; if (sp > XB_SPIN_CAP) { atomicAdd(&bar[XB_TMO], 1u); break; } }
    }
    nloc = mine > 0u ? mine : 1u; nx = cnt > 0u ? cnt : 1u;
}
__device__ __forceinline__ void xcd_barrier(const XcdBarrier& b) {
    asm volatile("s_waitcnt vmcnt(0)" ::: "memory");
    __syncthreads();
    if (threadIdx.x == 0) {
        unsigned* bar = b.bar;
        __builtin_amdgcn_s_waitcnt(0);
        unsigned nloc = b.st[0], nx = b.st[1];
        if (nloc == 0u) { xcd_barrier_complete(bar, b.x, nloc, nx); b.st[0] = nloc; b.st[1] = nx; }
        const unsigned old = xb_add(&bar[XB_XSUB(b.x)], 1u);
        const unsigned gen = old / nloc;
        if (old + 1u == (gen + 1u) * nloc) {
            __builtin_amdgcn_fence(__ATOMIC_RELEASE, "agent");
            asm volatile("s_waitcnt vmcnt(0)" ::: "memory");
            const unsigned og = xb_add(&bar[XB_TOP], 1u);
            const unsigned tg = og / nx;
            if (og + 1u == (tg + 1u) * nx) xb_add(&bar[XB_TOPGEN], 1u);
            else XB_SPIN(xb_ld(&bar[XB_TOPGEN]) == tg, bar);
            __builtin_amdgcn_fence(__ATOMIC_ACQUIRE, "agent");
            xb_add(&bar[XB_XGEN(b.x)], 1u);
            asm volatile("s_waitcnt vmcnt(0)" ::: "memory");
        } else {
            XB_SPIN(xb_ld(&bar[XB_XGEN(b.x)]) == gen, bar);
            __builtin_amdgcn_fence(__ATOMIC_ACQUIRE, "agent");
            asm volatile("s_waitcnt vmcnt(0)" ::: "memory");
        }
    }
    __syncthreads();
}

namespace g8 {
constexpr int BM = 256, BK = 64, HALF = 128, HTB = HALF * BK * 2, NXCD = 8, WGM = 8;
__host__ __device__ __forceinline__ int lds_byte(int r, int c) { const int st = (r >> 4) * 2 + (c >> 5), rr = r & 15, cc = c & 31, ob = rr * 64 + cc * 2; return st * 1024 + (ob ^ (((ob >> 9) & 1) << 5)); }
__host__ __device__ __forceinline__ void stage_rc(int b, int& R, int& C) { const int st = b / 1024, sb = b % 1024, swz = sb ^ (((sb >> 9) & 1) << 5); R = (st >> 1) * 16 + swz / 64; C = (st & 1) * 32 + (swz % 64) / 2; }
__host__ __device__ __forceinline__ int perm32(int rho) { const int n = rho >> 4, i = rho & 15; return 8 * (i >> 2) + 4 * n + (i & 3); }

struct GUnit { const char* A; const char* B; int pm, pn, e, r0; };

struct DenseOrder {
    const char* Abase; const char* Bbase; int nM, nN, nwg, G, c; size_t tstep;
    __device__ void init(const void* A, const void* Bt, int M, int N, int K, int G_, int c_) { Abase = (const char*)A; Bbase = (const char*)Bt; nM = M / BM; nN = N / BM; nwg = nM * nN; G = G_; c = c_; tstep = (size_t)BM * K * 2; }
    __device__ bool next(int i, GUnit& u) const {
        const long L = (long)i * G + c; if (L >= nwg) return false;
        int wgid = (int)L; { const int q = nwg / NXCD, r = nwg % NXCD, xcd = wgid % NXCD, off = wgid / NXCD; wgid = (xcd < r ? xcd * (q + 1) : r * (q + 1) + (xcd - r) * q) + off; }
        const int nig = WGM * nN, gid = wgid / nig, fm = gid * WGM, gsz = (nM - fm) < WGM ? (nM - fm) : WGM;
        u.pm = fm + ((wgid % nig) % gsz); u.pn = (wgid % nig) / gsz; u.e = 0; u.r0 = 0;
        u.A = Abase + (size_t)u.pm * tstep; u.B = Bbase + (size_t)u.pn * tstep; return true;
    }
    __device__ __forceinline__ unsigned rowoff(const GUnit&, int) const { return 0u; }
};
struct MoeOrder {
    const char* Abase; const char* Bbase; const int* list; const volatile LAS unsigned* tb; const volatile LAS unsigned* cntl; int nwg, G, c; size_t atile, bexp, btile; int gather;
    __device__ bool next(int i, GUnit& u) const {
        const long L = (long)i * G + c; if (L >= nwg) return false;
        int wgid = (int)L; { const int q = nwg / NXCD, r = nwg % NXCD, xcd = wgid % NXCD, off = wgid / NXCD; wgid = (xcd < r ? xcd * (q + 1) : r * (q + 1) + (xcd - r) * q) + off; }
        const int tile = wgid >> 2; u.pn = wgid & 3; u.pm = tile;
        int e = 0; for (int j = 1; j < NE; ++j) e = ((int)tb[j] <= tile) ? j : e;
        e = __builtin_amdgcn_readfirstlane(e); u.e = e; u.r0 = __builtin_amdgcn_readfirstlane((tile - (int)tb[e]) * 256);
        u.A = gather ? Abase : Abase + (size_t)tile * atile; u.B = Bbase + (size_t)e * bexp + (size_t)u.pn * btile; return true;
    }
    __device__ __forceinline__ unsigned rowoff(const GUnit& u, int rr) const {
        const int p = u.r0 + rr; const int tok = (p < (int)cntl[u.e]) ? (list[(size_t)u.e * T + p] >> 1) : 0; return (unsigned)tok * 2048u; }
};

template <class Epi, class Sched, bool ALIGN_EPI, bool GATHER>
__device__ __forceinline__ void gemm_phase(LAS unsigned char* lds, const int K, const Sched& S, const Epi& E) {
    const int tid = threadIdx.x, wid = __builtin_amdgcn_readfirstlane(tid >> 6), lane = tid & 63, wr = wid >> 2, wc = wid & 3, fr = lane & 15, fq = lane >> 4;
    const int nt = K / BK;
    unsigned voffA[2], voffB[2]; int RA[2], CA[2];
#pragma unroll
    for (int i = 0; i < 2; ++i) { int R, C; stage_rc(tid * 16 + i * 8192, R, C); const int Rb = Epi::PERM ? ((R & ~31) + perm32(R & 31)) : R;
        voffA[i] = (unsigned)(R * K + C) * 2u; voffB[i] = (unsigned)(Rb * K + C) * 2u; RA[i] = R; CA[i] = C; }
    const size_t kstep = (size_t)(BK * 2);
    const size_t hstep = (size_t)HALF * K * 2;
    const unsigned ldsw = (unsigned)wid * 1024u;
    const int aoff = lds_byte(wr * 64 + fr, fq * 8), boff = lds_byte(wc * 32 + fr, fq * 8);
#define G8_SA(b, h) (((b) * 2 + (h)) * HTB)
#define G8_SB(b, h) ((4 + (b) * 2 + (h)) * HTB)
#define G8_STAGE(bufoff, gbase, o0, o1) do { \
        __builtin_amdgcn_global_load_lds((const unsigned*)((const char*)(gbase) + (o0)), (LAS unsigned*)(lds + (bufoff) + ldsw), 16, 0, 0); \
        __builtin_amdgcn_global_load_lds((const unsigned*)((const char*)(gbase) + (o1)), (LAS unsigned*)(lds + (bufoff) + ldsw + 8192), 16, 0, 0); } while (0)
#define G8_STAGE_B(bufoff, gbase) G8_STAGE(bufoff, gbase, voffB[0], voffB[1])
#define G8_LDA(dst, b, h) do { _Pragma("unroll") for (int m = 0; m < 4; ++m) _Pragma("unroll") for (int k = 0; k < 2; ++k) dst[m][k] = *(const LAS bf16x8*)(lds + G8_SA(b, h) + aoff + m * 2048 + k * 1024); } while (0)
#define G8_LDB(dst, b, h) do { _Pragma("unroll") for (int n = 0; n < 2; ++n) _Pragma("unroll") for (int k = 0; k < 2; ++k) dst[n][k] = *(const LAS bf16x8*)(lds + G8_SB(b, h) + boff + n * 2048 + k * 1024); } while (0)
#define G8_MMA(ai, bj, At, Bt) do { __builtin_amdgcn_s_setprio(1); _Pragma("unroll") for (int m = 0; m < 4; ++m) _Pragma("unroll") for (int n = 0; n < 2; ++n) _Pragma("unroll") for (int k = 0; k < 2; ++k) \
        acc[ai][bj][m][n] = __builtin_amdgcn_mfma_f32_16x16x32_bf16(Bt[n][k], At[m][k], acc[ai][bj][m][n], 0, 0, 0); __builtin_amdgcn_s_setprio(0); } while (0)
#ifdef G8_DRAIN
#define G8_WAIT_V(n) asm volatile("s_waitcnt vmcnt(0)" ::: "memory")
#else
#define G8_WAIT_V(n) asm volatile("s_waitcnt vmcnt(" #n ")" ::: "memory")
#endif
#define G8_WAIT_L(n) asm volatile("s_waitcnt lgkmcnt(" #n ")" ::: "memory")
#define G8_BAR __builtin_amdgcn_s_barrier()
#define G8_SCHED __builtin_amdgcn_sched_barrier(0)
    GUnit cur, nxt; int ui = 0;
    if (!S.next(0, cur)) return;
    unsigned cao[2][2], nao[2][2];
#pragma unroll
    for (int h = 0; h < 2; ++h)
#pragma unroll
        for (int i = 0; i < 2; ++i) { cao[h][i] = GATHER ? S.rowoff(cur, h * HALF + RA[i]) + (unsigned)CA[i] * 2u : voffA[i] + (unsigned)(h * hstep); nao[h][i] = cao[h][i]; }
    f32x4 acc[2][2][4][2];
#pragma unroll
    for (int a = 0; a < 2; ++a)
#pragma unroll
        for (int b = 0; b < 2; ++b)
#pragma unroll
            for (int m = 0; m < 4; ++m)
#pragma unroll
                for (int n = 0; n < 2; ++n) acc[a][b][m][n] = (f32x4){0.f, 0.f, 0.f, 0.f};
    bf16x8 At[4][2], B0[2][2], B1[2][2];
    const char* cA = cur.A; const char* cB = cur.B;
    G8_STAGE_B(G8_SB(0, 0), cB); G8_STAGE_B(G8_SB(0, 1), cB + hstep); G8_STAGE(G8_SA(0, 0), cA, cao[0][0], cao[0][1]); G8_STAGE(G8_SA(0, 1), cA, cao[1][0], cao[1][1]);
    if (wr == 1) G8_BAR;
    G8_WAIT_V(2); G8_BAR;
    G8_STAGE_B(G8_SB(1, 0), cB + kstep); G8_STAGE(G8_SA(1, 0), cA + kstep, cao[0][0], cao[0][1]); G8_STAGE_B(G8_SB(1, 1), cB + hstep + kstep);
    G8_WAIT_V(6); G8_BAR;
    for (;;) {
        const bool has_next = S.next(ui + 1, nxt);
        if (GATHER && has_next) {
#pragma unroll
            for (int h = 0; h < 2; ++h)
#pragma unroll
                for (int i = 0; i < 2; ++i) nao[h][i] = S.rowoff(nxt, h * HALF + RA[i]) + (unsigned)CA[i] * 2u;
        }
        const char* nA = has_next ? nxt.A : cA; const char* nB = has_next ? nxt.B : cB;
        for (int t = 0; t < nt; t += 2) {
            const bool last = (t == nt - 2);
            const char* a1 = cA + (size_t)(t + 1) * kstep;
            const char* a2 = last ? nA : cA + (size_t)(t + 2) * kstep; const char* b2 = last ? nB : cB + (size_t)(t + 2) * kstep;
            const char* a3 = a2 + kstep; const char* b3 = b2 + kstep;
            asm volatile("" : "+s"(a1), "+s"(a2), "+s"(b2), "+s"(a3), "+s"(b3));
            unsigned o2[2][2];
#pragma unroll
            for (int h = 0; h < 2; ++h)
#pragma unroll
                for (int i = 0; i < 2; ++i) o2[h][i] = (GATHER && last && has_next) ? nao[h][i] : cao[h][i];
            G8_LDB(B0, 0, 0); G8_LDB(B1, 0, 1); G8_SCHED; G8_LDA(At, 0, 0); G8_STAGE(G8_SA(1, 1), a1, cao[1][0], cao[1][1]);
            G8_WAIT_V(8); G8_WAIT_L(0); G8_BAR; G8_MMA(0, 0, At, B0); G8_MMA(0, 1, At, B1); G8_BAR; G8_SCHED;
            G8_LDA(At, 0, 1); G8_STAGE_B(G8_SB(0, 0), b2); G8_STAGE_B(G8_SB(0, 1), b2 + hstep); G8_STAGE(G8_SA(0, 0), a2, o2[0][0], o2[0][1]);
            G8_WAIT_V(8); G8_WAIT_L(0); G8_BAR; G8_MMA(1, 0, At, B0); G8_MMA(1, 1, At, B1); G8_BAR; G8_SCHED;
            G8_LDB(B0, 1, 0); G8_LDB(B1, 1, 1); G8_SCHED; G8_LDA(At, 1, 0); G8_STAGE(G8_SA(0, 1), a2, o2[1][0], o2[1][1]);
            G8_WAIT_V(8); G8_WAIT_L(0); G8_BAR; G8_MMA(0, 0, At, B0); G8_MMA(0, 1, At, B1); G8_BAR; G8_SCHED;
            G8_LDA(At, 1, 1); G8_STAGE_B(G8_SB(1, 0), b3); G8_STAGE_B(G8_SB(1, 1), b3 + hstep); G8_STAGE(G8_SA(1, 0), a3, o2[0][0], o2[0][1]);
            G8_WAIT_V(8); G8_WAIT_L(0); G8_BAR; G8_MMA(1, 0, At, B0); G8_MMA(1, 1, At, B1); G8_BAR; G8_SCHED;
        }
        if constexpr (ALIGN_EPI) { if (wr == 0) G8_BAR; }
        {
          GUnit eu = cur; int fr_ = fr, fq_ = fq; asm volatile("" : "+s"(eu.pm), "+s"(eu.pn), "+s"(eu.e), "+s"(eu.r0)); asm volatile("" : "+v"(fr_), "+v"(fq_));
          E(acc, eu, wr, wc, fr_, fq_); }
        if (!has_next) break;
#pragma unroll
        for (int a = 0; a < 2; ++a)
#pragma unroll
            for (int b = 0; b < 2; ++b)
#pragma unroll
                for (int m = 0; m < 4; ++m)
#pragma unroll
                    for (int n = 0; n < 2; ++n) acc[a][b][m][n] = (f32x4){0.f, 0.f, 0.f, 0.f};
        cur = nxt; cA = nA; cB = nB; ++ui;
#pragma unroll
        for (int h = 0; h < 2; ++h)
#pragma unroll
            for (int i = 0; i < 2; ++i) cao[h][i] = nao[h][i];
        if constexpr (ALIGN_EPI) { if (wr == 1) G8_BAR; }
    }
    G8_WAIT_V(0);
    if constexpr (!ALIGN_EPI) { if (wr == 0) G8_BAR; }
    G8_BAR;
#undef G8_SA
#undef G8_SB
#undef G8_STAGE
#undef G8_STAGE_B
#undef G8_LDA
#undef G8_LDB
#undef G8_MMA
#undef G8_WAIT_V
#undef G8_WAIT_L
#undef G8_BAR
#undef G8_SCHED
}

__device__ __forceinline__ u32x4 pack8(const f32x4 v0, const f32x4 v1) { u32x4 w; w.x = cvt_pk_bf16(v0[0], v0[1]); w.y = cvt_pk_bf16(v0[2], v0[3]); w.z = cvt_pk_bf16(v1[0], v1[1]); w.w = cvt_pk_bf16(v1[2], v1[3]); return w; }
__device__ __forceinline__ float sigmoidf_(float v) { return __builtin_amdgcn_rcpf(1.f + __builtin_amdgcn_exp2f(-1.4426950408889634f * v)); }

struct EpiProj {
    static constexpr bool PERM = true;
    bf16_t *qb, *kb, *vb, *ub, *gb; const float* rope; const float* gate_bias;
    __device__ __forceinline__ void operator()(const f32x4 (&acc)[2][2][4][2], const GUnit& u, int wr, int wc, int fr, int fq) const {
        const int row0 = u.pm * BM + wr * 64 + fr; const int cw = wc * 32 + 8 * fq; const int pn = u.pn;
#ifdef DBG_PLAIN_EPI
        if (pn < 8) { bf16_t* base = (pn < 4 ? qb : kb) + (pn & 3) * 256 + cw;
            for (int ai = 0; ai < 2; ++ai) for (int m = 0; m < 4; ++m) { const int t = row0 + ai * HALF + m * 16; for (int bj = 0; bj < 2; ++bj) *(u32x4*)(base + (size_t)t * 1024 + bj * HALF) = pack8(acc[ai][bj][m][0], acc[ai][bj][m][1]); } }
        else
#endif
        if (pn < 8) {
            bf16_t* base = (pn < 4 ? qb : kb) + (pn & 3) * 256 + cw; const float sc = pn < 4 ? QSCALE : 1.f; const int fi = 16 * (wc & 1) + 4 * fq;
#pragma unroll
            for (int ai = 0; ai < 2; ++ai)
#pragma unroll
                for (int m = 0; m < 4; ++m) { const int t = row0 + ai * HALF + m * 16; const f32x4 cs0 = *(const f32x4*)(rope + ((size_t)t * 32 + fi) * 2), cs1 = *(const f32x4*)(rope + ((size_t)t * 32 + fi) * 2 + 4);
                    const f32x4 c = {cs0[0], cs0[2], cs1[0], cs1[2]}, s = {cs0[1], cs0[3], cs1[1], cs1[3]};
#pragma unroll
                    for (int bj = 0; bj < 2; ++bj) { const f32x4 t1 = acc[ai][bj][m][0], t2 = acc[ai][bj][m][1]; const f32x4 o1 = (t1 * c - t2 * s) * sc, o2 = (t2 * c + t1 * s) * sc;
                        *(u32x4*)(base + (size_t)t * 1024 + bj * HALF) = pack8(o1, o2); } }
        } else if (pn < 14) {
            bf16_t* base; int ld; if (pn < 12) { base = vb + (pn - 8) * 256 + cw; ld = 1024; } else { base = ub + (pn - 12) * 256 + cw; ld = 512; }
#pragma unroll
            for (int ai = 0; ai < 2; ++ai)
#pragma unroll
                for (int m = 0; m < 4; ++m) { const int t = row0 + ai * HALF + m * 16;
#pragma unroll
                    for (int bj = 0; bj < 2; ++bj) *(u32x4*)(base + (size_t)t * ld + bj * HALF) = pack8(acc[ai][bj][m][0], acc[ai][bj][m][1]); }
        }
#ifdef DBG_PLAIN_EPI
        else { const int col0 = (pn - 14) * 256 + cw;
            for (int ai = 0; ai < 2; ++ai) for (int m = 0; m < 4; ++m) { const int t = row0 + ai * HALF + m * 16; for (int bj = 0; bj < 2; ++bj) *(u32x4*)(gb + (size_t)t * 2048 + col0 + bj * HALF) = pack8(acc[ai][bj][m][0], acc[ai][bj][m][1]); } }
#else
        else {
            const int col0 = (pn - 14) * 256 + cw; f32x4 bv[2][2];
#pragma unroll
            for (int bj = 0; bj < 2; ++bj)
#pragma unroll
                for (int n = 0; n < 2; ++n) bv[bj][n] = *(const f32x4*)(gate_bias + col0 + bj * HALF + 4 * n);
#pragma unroll
            for (int ai = 0; ai < 2; ++ai)
#pragma unroll
                for (int m = 0; m < 4; ++m) { const int t = row0 + ai * HALF + m * 16;
#pragma unroll
                    for (int bj = 0; bj < 2; ++bj) { f32x4 v0 = acc[ai][bj][m][0] + bv[bj][0], v1 = acc[ai][bj][m][1] + bv[bj][1];
#pragma unroll
                        for (int j = 0; j < 4; ++j) { v0[j] = sigmoidf_(v0[j]); v1[j] = sigmoidf_(v1[j]); }
                        *(u32x4*)(gb + (size_t)t * 2048 + col0 + bj * HALF) = pack8(v0, v1); } }
        }
#endif
    }
};
struct EpiScaleBf16 {
    static constexpr bool PERM = true;
    bf16_t* O; int ldc; const float* colscale;
    __device__ __forceinline__ void operator()(const f32x4 (&acc)[2][2][4][2], const GUnit& u, int wr, int wc, int fr, int fq) const {
        const int row0 = u.pm * BM + wr * 64 + fr, col0 = u.pn * BM + wc * 32 + 8 * fq; f32x4 sv[2][2];
#pragma unroll
        for (int bj = 0; bj < 2; ++bj)
#pragma unroll
            for (int n = 0; n < 2; ++n) sv[bj][n] = *(const f32x4*)(colscale + col0 + bj * HALF + 4 * n);
#pragma unroll
        for (int ai = 0; ai < 2; ++ai)
#pragma unroll
            for (int m = 0; m < 4; ++m) { bf16_t* rowp = O + (size_t)(row0 + ai * HALF + m * 16) * ldc + col0;
#pragma unroll
                for (int bj = 0; bj < 2; ++bj) *(u32x4*)(rowp + bj * HALF) = pack8(acc[ai][bj][m][0] * sv[bj][0], acc[ai][bj][m][1] * sv[bj][1]); }
    }
};
template <int BR> struct EpiMerge {
    static constexpr bool PERM = true;
    const bf16_t* gates; bf16_t* merged;
    __device__ __forceinline__ void operator()(const f32x4 (&acc)[2][2][4][2], const GUnit& u, int wr, int wc, int fr, int fq) const {
        const int row0 = u.pm * BM + wr * 64 + fr, col0 = u.pn * BM + wc * 32 + 8 * fq;
#pragma unroll
        for (int ai = 0; ai < 2; ++ai)
#pragma unroll
            for (int m = 0; m < 4; ++m) { const size_t t = row0 + ai * HALF + m * 16;
#pragma unroll
                for (int bj = 0; bj < 2; ++bj) { const u32x4 g = *(const u32x4*)(gates + t * 2048 + BR * 1024 + col0 + bj * HALF); bf16_t* mp = merged + t * 1024 + col0 + bj * HALF;
                    f32x4 v0 = acc[ai][bj][m][0], v1 = acc[ai][bj][m][1];
                    v0 = v0 * (f32x4){bflo(g.x), bfhi(g.x), bflo(g.y), bfhi(g.y)}; v1 = v1 * (f32x4){bflo(g.z), bfhi(g.z), bflo(g.w), bfhi(g.w)};
                    if (BR) { const u32x4 p = *(const u32x4*)mp; v0 = v0 + (f32x4){bflo(p.x), bfhi(p.x), bflo(p.y), bfhi(p.y)}; v1 = v1 + (f32x4){bflo(p.z), bfhi(p.z), bflo(p.w), bfhi(p.w)}; }
                    *(u32x4*)mp = pack8(v0, v1); } }
    }
};
struct EpiResid {
    static constexpr bool PERM = false;
    const float* x; float* y;
    __device__ __forceinline__ void operator()(const f32x4 (&acc)[2][2][4][2], const GUnit& u, int wr, int wc, int fr, int fq) const {
        const int row0 = u.pm * BM + wr * 64 + fr, col0 = u.pn * BM + wc * 32 + 4 * fq;
#pragma unroll
        for (int ai = 0; ai < 2; ++ai)
#pragma unroll
            for (int m = 0; m < 4; ++m) { const size_t off = (size_t)(row0 + ai * HALF + m * 16) * 1024 + col0;
#pragma unroll
                for (int bj = 0; bj < 2; ++bj)
#pragma unroll
                    for (int n = 0; n < 2; ++n) { const f32x4 xv = *(const f32x4*)(x + off + bj * HALF + n * 16); *(f32x4*)(y + off + bj * HALF + n * 16) = xv * ALPHA + acc[ai][bj][m][n]; } }
    }
};
struct EpiGateUp {
    static constexpr bool PERM = true;
    bf16_t* h;
    __device__ __forceinline__ void operator()(const f32x4 (&acc)[2][2][4][2], const GUnit& u, int wr, int wc, int fr, int fq) const {
        const int row0 = u.pm * BM + wr * 64 + fr, col0 = u.pn * 128 + wc * 16 + 4 * fq;
#pragma unroll
        for (int ai = 0; ai < 2; ++ai)
#pragma unroll
            for (int m = 0; m < 4; ++m) { bf16_t* rowp = h + (size_t)(row0 + ai * HALF + m * 16) * 512 + col0;
#pragma unroll
                for (int bj = 0; bj < 2; ++bj) { const f32x4 g = acc[ai][bj][m][0], up = acc[ai][bj][m][1]; f32x4 o;
#pragma unroll
                    for (int j = 0; j < 4; ++j) o[j] = g[j] * sigmoidf_(g[j]) * up[j];
                    u32x2 w; w.x = cvt_pk_bf16(o[0], o[1]); w.y = cvt_pk_bf16(o[2], o[3]); *(u32x2*)(rowp + bj * 64) = w; } }
    }
};
struct EpiDown {
    static constexpr bool PERM = true;
    bf16_t* ybuf; const int* list; const float* rw; const volatile LAS unsigned* cntl;
    __device__ __forceinline__ void operator()(const f32x4 (&acc)[2][2][4][2], const GUnit& u, int wr, int wc, int fr, int fq) const {
        const int p0 = u.r0 + wr * 64 + fr, col0 = u.pn * BM + wc * 32 + 8 * fq; const int cn = (int)cntl[u.e];
#pragma unroll
        for (int ai = 0; ai < 2; ++ai)
#pragma unroll
            for (int m = 0; m < 4; ++m) { const int p = p0 + ai * HALF + m * 16;
                if (p < cn) { const int ent = list[(size_t)u.e * T + p]; const float w = rw[ent]; bf16_t* rowp = ybuf + (size_t)ent * 1024 + col0;
#pragma unroll
                    for (int bj = 0; bj < 2; ++bj) *(u32x4*)(rowp + bj * HALF) = pack8(acc[ai][bj][m][0] * w, acc[ai][bj][m][1] * w); } }
    }
};
}

namespace at2 {
using f32x16 = __attribute__((ext_vector_type(16))) float;
using s16x4  = __attribute__((ext_vector_type(4))) short;
constexpr int KB_BYTES = 8192, VB_BYTES = 16384, BUF_BYTES = 2 * KB_BYTES + VB_BYTES;
constexpr int OFF_WS = 69632;
#define AT_SBAR() __builtin_amdgcn_sched_barrier(0)
__device__ __forceinline__ int crow(int r, int hi) { return (r & 3) + 8 * (r >> 2) + 4 * hi; }
__device__ __forceinline__ int v_st(int k, int c) { const int kk = (k & ~0xC) | ((k & 4) << 1) | ((k & 8) >> 1); return ((kk >> 3) * 4 + (c >> 5)) * 512 + ((kk & 7) * 32 + (c & 31)) * 2; }
__device__ __forceinline__ int v_rd_base(int lane) { return ((lane & 3) << 3) | (((lane >> 2) & 3) << 6) | (((lane >> 4) & 1) << 5) | (((lane >> 5) & 1) << 8); }
constexpr int v_rd_off(int d0, int ks, int half) { return d0 * 512 + ks * 4096 + half * 2048; }
template <int OFF> __device__ __forceinline__ s16x4 tr_read(int vb) { s16x4 r; asm volatile("ds_read_b64_tr_b16 %0, %1 offset:%2" : "=&v"(r) : "v"(vb), "i"(OFF) : "memory"); return r; }
template <int D0> __device__ __forceinline__ void pv_one(f32x16& od, int vb, bf16x8 pa0, bf16x8 pa1, bf16x8 pa2, bf16x8 pa3) {
    const s16x4 l0 = tr_read<v_rd_off(D0, 0, 0)>(vb), h0 = tr_read<v_rd_off(D0, 0, 1)>(vb), l1 = tr_read<v_rd_off(D0, 1, 0)>(vb), h1 = tr_read<v_rd_off(D0, 1, 1)>(vb);
    const s16x4 l2 = tr_read<v_rd_off(D0, 2, 0)>(vb), h2 = tr_read<v_rd_off(D0, 2, 1)>(vb), l3 = tr_read<v_rd_off(D0, 3, 0)>(vb), h3 = tr_read<v_rd_off(D0, 3, 1)>(vb);
    asm volatile("s_waitcnt lgkmcnt(0)" ::: "memory"); AT_SBAR();
#define AT_PK(L, H) (bf16x8){L[0], L[1], L[2], L[3], H[0], H[1], H[2], H[3]}
    od = __builtin_amdgcn_mfma_f32_32x32x16_bf16(pa0, AT_PK(l0, h0), od, 0, 0, 0);
    od = __builtin_amdgcn_mfma_f32_32x32x16_bf16(pa1, AT_PK(l1, h1), od, 0, 0, 0);
    od = __builtin_amdgcn_mfma_f32_32x32x16_bf16(pa2, AT_PK(l2, h2), od, 0, 0, 0);
    od = __builtin_amdgcn_mfma_f32_32x32x16_bf16(pa3, AT_PK(l3, h3), od, 0, 0, 0);
#undef AT_PK
}
__device__ __forceinline__ void qkt(f32x16& p0, f32x16& p1, const LAS unsigned char* Ks, const bf16x8* qr, int r32, int hi) {
    p0 = f32x16{}; p1 = f32x16{};
#pragma unroll
    for (int d0 = 0; d0 < 4; ++d0) { const LAS unsigned char* kp = Ks + (2 * d0 + hi) * 1024 + r32 * 16;
        const bf16x8 b0 = *(const LAS bf16x8*)(kp), b1 = *(const LAS bf16x8*)(kp + 512);
        p0 = __builtin_amdgcn_mfma_f32_32x32x16_bf16(b0, qr[d0], p0, 0, 0, 0);
        p1 = __builtin_amdgcn_mfma_f32_32x32x16_bf16(b1, qr[d0], p1, 0, 0, 0); }
}
__device__ __forceinline__ float hswap_max(float v) { auto rr = __builtin_amdgcn_permlane32_swap(__float_as_uint(v), __float_as_uint(v), false, false); return fmaxf(__uint_as_float(rr[0]), __uint_as_float(rr[1])); }
__device__ __forceinline__ float hswap_sum(float v) { auto rr = __builtin_amdgcn_permlane32_swap(__float_as_uint(v), __float_as_uint(v), false, false); return __uint_as_float(rr[0]) + __uint_as_float(rr[1]); }

__device__ __forceinline__ void attn_unit(LAS unsigned char* lds, int b, int head, int qblk, const bf16_t* __restrict__ Q, const bf16_t* __restrict__ K, const bf16_t* __restrict__ V,
                                          bf16_t* __restrict__ O, const float lam, const float* __restrict__ gain) {
    const int tid = threadIdx.x, lane = tid & 63, r32 = lane & 31, hi = lane >> 5; const int wid = __builtin_amdgcn_readfirstlane(tid >> 6); const int mp = wid >> 2, wq = wid & 3;
    const int hm = head * 2 + mp; const size_t rowbase = (size_t)b * SEQ; const int q0 = qblk * 128;
    const int mychunk = 2 * qblk + (wq >> 1); const int NT = 2 * qblk + 2;
    LAS float* wsf = (LAS float*)(lds + OFF_WS) + wid * 64;
    bf16x8 qr[4];
    { const bf16_t* qp = Q + (rowbase + q0 + wq * 32 + r32) * 1024 + hm * 64 + hi * 8;
#pragma unroll
      for (int d0 = 0; d0 < 4; ++d0) qr[d0] = *(const bf16x8*)(qp + d0 * 16); }
    const int kr = tid >> 3, kc = tid & 7, vr = tid >> 4, vc = (tid & 15) * 8;
    const bf16_t* k0p = K + (rowbase + kr) * 1024 + (head * 2 + 0) * 64 + kc * 8; const bf16_t* k1p = k0p + 64;
    const bf16_t* v0p = V + (rowbase + vr) * 1024 + head * 128 + vc; const bf16_t* v1p = v0p + (size_t)32 * 1024;
    const int kst = kc * 1024 + kr * 16, vst0 = v_st(vr, vc), vst1 = v_st(32 + vr, vc);
    bf16x8 sk0, sk1, sv0, sv1;
#define AT_LOAD(j) do { const size_t o_ = (size_t)(j) * 64 * 1024; sk0 = *(const bf16x8*)(k0p + o_); sk1 = *(const bf16x8*)(k1p + o_); sv0 = *(const bf16x8*)(v0p + o_); sv1 = *(const bf16x8*)(v1p + o_); } while (0)
#define AT_WRITE(s) do { LAS unsigned char* bs_ = lds + (s) * BUF_BYTES; *(LAS bf16x8*)(bs_ + kst) = sk0; *(LAS bf16x8*)(bs_ + KB_BYTES + kst) = sk1; \
        *(LAS bf16x8*)(bs_ + 2 * KB_BYTES + vst0) = sv0; *(LAS bf16x8*)(bs_ + 2 * KB_BYTES + vst1) = sv1; } while (0)
    float m_reg = -1e30f, l_reg = 0.f; f32x16 o[4] = {};
    const int vb0 = (int)(uintptr_t)(lds + 2 * KB_BYTES) + v_rd_base(lane);
    AT_LOAD(0); AT_WRITE(0); __syncthreads();
    for (int j = 0; j < NT; ++j) {
        const int slot = j & 1;
        if (j + 1 < NT) AT_LOAD(j + 1);
        if (j <= mychunk) {
            f32x16 p0, p1;
            qkt(p0, p1, lds + slot * BUF_BYTES + mp * KB_BYTES, qr, r32, hi);
            float pmax = p0[0];
#pragma unroll
            for (int r = 1; r < 16; ++r) pmax = fmaxf(pmax, p0[r]);
#pragma unroll
            for (int r = 0; r < 16; ++r) pmax = fmaxf(pmax, p1[r]);
            pmax = hswap_max(pmax);
            const float mn = fmaxf(m_reg, pmax); const float alpha = __builtin_amdgcn_exp2f(m_reg - mn); m_reg = mn;
            float ps = 0.f;
#pragma unroll
            for (int r = 0; r < 16; ++r) { p0[r] = __builtin_amdgcn_exp2f(p0[r] - mn); ps += p0[r]; }
#pragma unroll
            for (int r = 0; r < 16; ++r) { p1[r] = __builtin_amdgcn_exp2f(p1[r] - mn); ps += p1[r]; }
            ps = hswap_sum(ps); l_reg = l_reg * alpha + ps;
            if (hi == 0) wsf[r32] = alpha;
            asm volatile("s_waitcnt lgkmcnt(0)" ::: "memory");
#pragma unroll
            for (int r = 0; r < 16; ++r) { const float a = wsf[crow(r, hi)];
#pragma unroll
                for (int d = 0; d < 4; ++d) o[d][r] *= a; }
            bf16x8 pa0, pa1, pa2, pa3;
#define AT_PK4(P, BASE, OUT) do { const unsigned a0 = cvt_pk_bf16(P[BASE + 0], P[BASE + 1]), a1 = cvt_pk_bf16(P[BASE + 2], P[BASE + 3]); \
        const unsigned b0 = cvt_pk_bf16(P[BASE + 4], P[BASE + 5]), b1 = cvt_pk_bf16(P[BASE + 6], P[BASE + 7]); \
        auto r0_ = __builtin_amdgcn_permlane32_swap(a0, b0, false, false); auto r1_ = __builtin_amdgcn_permlane32_swap(a1, b1, false, false); \
        u32x4 w_ = {r0_[0], r1_[0], r0_[1], r1_[1]}; OUT = __builtin_bit_cast(bf16x8, w_); } while (0)
            AT_PK4(p0, 0, pa0); AT_PK4(p0, 8, pa1); AT_PK4(p1, 0, pa2); AT_PK4(p1, 8, pa3);
#undef AT_PK4
            const int vb = vb0 + slot * BUF_BYTES;
            pv_one<0>(o[0], vb, pa0, pa1, pa2, pa3); pv_one<1>(o[1], vb, pa0, pa1, pa2, pa3); pv_one<2>(o[2], vb, pa0, pa1, pa2, pa3); pv_one<3>(o[3], vb, pa0, pa1, pa2, pa3);
        }
        if (j + 1 < NT) AT_WRITE(slot ^ 1);
        __syncthreads();
    }
#undef AT_LOAD
#undef AT_WRITE
    if (hi == 0) wsf[r32] = 1.f / l_reg;
    asm volatile("s_waitcnt lgkmcnt(0)" ::: "memory");
    float rli[16];
#pragma unroll
    for (int r = 0; r < 16; ++r) rli[r] = wsf[crow(r, hi)];
    LAS float* xch = (LAS float*)lds + wq * 4096;
    if (mp == 1) {
#pragma unroll
        for (int d = 0; d < 4; ++d)
#pragma unroll
            for (int r = 0; r < 16; ++r) xch[(d * 16 + r) * 64 + lane] = o[d][r] * rli[r];
    }
    __syncthreads();
    if (mp == 0) {
#pragma unroll
        for (int d = 0; d < 4; ++d)
#pragma unroll
            for (int r = 0; r < 16; ++r) { const float v2 = xch[(d * 16 + r) * 64 + lane]; o[d][r] = o[d][r] * rli[r] - lam * v2; }
    }
    __syncthreads();
    LAS float* stg = (LAS float*)lds + wq * 4224;
    if (mp == 0) {
#pragma unroll
        for (int d = 0; d < 4; ++d)
#pragma unroll
            for (int r = 0; r < 16; ++r) stg[crow(r, hi) * 132 + d * 32 + r32] = o[d][r];
        asm volatile("s_waitcnt lgkmcnt(0)" ::: "memory");
        const int row = lane >> 1, ch = (lane & 1) * 64; const LAS float* sp = stg + row * 132 + ch; float vv[64]; float ss = 0.f;
#pragma unroll
        for (int i = 0; i < 16; ++i) { const f32x4 t4 = *(const LAS f32x4*)(sp + 4 * i); vv[4 * i] = t4[0]; vv[4 * i + 1] = t4[1]; vv[4 * i + 2] = t4[2]; vv[4 * i + 3] = t4[3]; ss += (t4[0] * t4[0] + t4[1] * t4[1]) + (t4[2] * t4[2] + t4[3] * t4[3]); }
        ss += __shfl_xor(ss, 1);
        const float rs = (1.0f / sqrtf(ss * (1.f / 128.f) + RMS_EPS)) * (1.f - LAMBDA_INIT);
        bf16_t* op = O + (rowbase + q0 + wq * 32 + row) * 1024 + head * 128 + ch; const float* gp = gain + ch;
#pragma unroll
        for (int i = 0; i < 8; ++i) { const f32x4 g0 = *(const f32x4*)(gp + 8 * i), g1 = *(const f32x4*)(gp + 8 * i + 4); u32x4 w;
            w.x = cvt_pk_bf16(vv[8 * i] * rs * g0[0], vv[8 * i + 1] * rs * g0[1]); w.y = cvt_pk_bf16(vv[8 * i + 2] * rs * g0[2], vv[8 * i + 3] * rs * g0[3]);
            w.z = cvt_pk_bf16(vv[8 * i + 4] * rs * g1[0], vv[8 * i + 5] * rs * g1[1]); w.w = cvt_pk_bf16(vv[8 * i + 6] * rs * g1[2], vv[8 * i + 7] * rs * g1[3]);
            *(u32x4*)(op + 8 * i) = w; }
    }
    __syncthreads();
}
__device__ __forceinline__ void attn_phase(LAS unsigned char* lds, int vcu, int ncu, const bf16_t* Q, const bf16_t* K, const bf16_t* V, bf16_t* O, const float* scal, const float* gain) {
    const float lam = scal[0];
    for (int bh = vcu >> 1; bh < NB * NHEAD; bh += (ncu >> 1)) {
        const int b = bh >> 3, head = bh & 7;
        for (int i = 0; i < 8; ++i) { const int s = (vcu & 1) + 2 * (i >> 1); const int qblk = (i & 1) ? 15 - s : s;
            attn_unit(lds, b, head, qblk, Q, K, V, O, lam, gain); }
    }
}
#undef AT_SBAR
}

struct MKArgs { const void* in[21]; float* out; unsigned char* ws; unsigned mask; unsigned li; };
enum { PH_PRO = 0, PH_G1, PH_POOLA, PH_ATT, PH_POOLG, PH_G4A, PH_G4B, PH_G5, PH_ROUTER, PH_G7, PH_G8, PH_FINAL, PH_N };

template <int MODE> __device__ __forceinline__ int dest_row(int n) {
    if (MODE == 1) return n < 2048 ? (n & ~63) + qk_pos_of_d(n & 63) : n;
    if (MODE == 2) { const int nn = n >> 9, hc = n & 511; return (hc >> 7) * 256 + ((hc >> 6) & 1) * 128 + ((hc >> 4) & 3) * 32 + ((hc >> 2) & 3) * 8 + nn * 4 + (hc & 3); }
    return n;
}
template <int MODE> __device__ __forceinline__ void transpose_item(const float* __restrict__ W, int ldw, int N, bf16_t* __restrict__ WT, int ldt, int coloff, int rowoff, LAS float* scr, int item, int lane) {
    const int nblk = N / 32, kb = item / nblk, nb = item % nblk, k0 = 64 * kb, n0 = 32 * nb;
#pragma unroll 8
    for (int i = 0; i < 32; ++i) { const int kk = 2 * i + (lane >> 5); scr[kk * 33 + (lane & 31)] = W[(size_t)(k0 + kk) * ldw + n0 + (lane & 31)]; }
    LDS_WAIT(); asm volatile("" ::: "memory");
    const int c = lane & 7;
#pragma unroll
    for (int j = 0; j < 4; ++j) { const int n = (lane >> 3) + 8 * j; const LAS float* s = scr + (8 * c) * 33 + n;
        u32x4 o; o.x = cvt_pk_bf16(s[0 * 33], s[1 * 33]); o.y = cvt_pk_bf16(s[2 * 33], s[3 * 33]); o.z = cvt_pk_bf16(s[4 * 33], s[5 * 33]); o.w = cvt_pk_bf16(s[6 * 33], s[7 * 33]);
        *(u32x4*)(WT + (size_t)(rowoff + dest_row<MODE>(n0 + n)) * ldt + coloff + k0 + 8 * c) = o; }
    LDS_WAIT(); asm volatile("" ::: "memory");
}

__global__ void __launch_bounds__(NTHREADS, 2) mk_fwd(MKArgs args) {
    __shared__ __attribute__((aligned(16))) unsigned char lds_raw[LDS_BYTES];
    LAS unsigned char* lds = (LAS unsigned char*)lds_raw;
    volatile LAS unsigned* MISC = (volatile LAS unsigned*)(lds + MISC_OFF);
    const int tid = threadIdx.x, lane = tid & 63, wave = __builtin_amdgcn_readfirstlane(tid >> 6);
    const int G = gridDim.x; const int bx = blockIdx.x; const int vcu = (G % 8 == 0) ? (bx % 8) * (G / 8) + bx / 8 : bx;
    const unsigned mask = args.mask;
    unsigned char* const ws = args.ws; float* const out = args.out;
#define IN_F(k) ((const float*)args.in[k])
#define x_ IN_F(0)
#define positions ((const int*)args.in[1])
#define w_in IN_F(2)
#define gate_bias IN_F(3)
#define lam_vecs IN_F(4)
#define subln_gain IN_F(5)
#define w_pool IN_F(6)
#define pool_scale IN_F(7)
#define w_branch_a IN_F(8)
#define w_branch_b IN_F(9)
#define w_out IN_F(10)
#define ln1_g IN_F(11)
#define ln1_b IN_F(12)
#define wrg IN_F(13)
#define brg IN_F(14)
#define wre IN_F(15)
#define bre IN_F(16)
#define wgu IN_F(17)
#define wdn IN_F(18)
#define ln2_g IN_F(19)
#define ln2_b IN_F(20)
#define wt ((bf16_t*)(ws + WS_WT))
#define xb ((bf16_t*)(ws + WS_XB))
#define qb ((bf16_t*)(ws + WS_Q))
#define kb ((bf16_t*)(ws + WS_K))
#define vb ((bf16_t*)(ws + WS_V))
#define ub ((bf16_t*)(ws + WS_U))
#define gb ((bf16_t*)out)
#define on ((bf16_t*)(ws + WS_ON))
#define mixed ((bf16_t*)(ws + WS_MIXED))
#define merged ((bf16_t*)(ws + WS_MERGED))
#define x1b ((bf16_t*)(ws + WS_X1B))
#define hb ((bf16_t*)(ws + WS_H))
#define ybuf ((bf16_t*)(ws + WS_YBUF))
#define rope ((float*)(ws + WS_ROPE))
#define pooled ((bf16_t*)(ws + WS_POOLED))
#define misc (ws + WS_MISC)
#define ctl ((unsigned*)(misc + MS_CTL))
#define stats ((float2*)(misc + MS_STATS))
#define rw ((float*)(misc + MS_ROUTE + (size_t)T * 8))
#define list ((int*)(misc + MS_LIST))
#define scal ((float*)(misc + MS_SCAL))
#define cnt (ctl + CW_CNT)
#define wpool_bd ((bf16_t*)(misc + MS_WPOOL))

    for (int u = tid; u < (LDS_BYTES - RING_BYTES) / 4; u += NTHREADS) ((LAS unsigned*)(lds + RING_BYTES))[u] = 0u;
    __syncthreads();
    XcdBarrier bar; bar.bar = ctl + CW_BAR + args.li * XCD_BAR_WORDS; bar.x = 0; bar.st = nullptr;
    const bool multi = (mask & (mask - 1u)) != 0u;
    if (multi) bar = xcd_barrier_post(ctl + CW_BAR + args.li * XCD_BAR_WORDS, MISC + 8);
#ifndef MK_CT
#define MK_CT 0xfffu
#endif
#define HAS(p) (((MK_CT >> (p)) & 1u) && ((mask >> (p)) & 1u))
#define SEAM(p) do { if (multi && (mask >> ((p) + 1)) != 0u) xcd_barrier(bar); } while (0)
    const int gw = vcu * NWAVES + wave, NGW = G * NWAVES;

    if (HAS(PH_PRO)) {
        LAS float* scr = (LAS float*)(lds + wave * 16384);
        constexpr int I_IN = 16 * (INW / 32), I_A = 16 * 32, I_B = 8 * 32, I_O = 16 * 32, I_GU = 16 * 32, I_DN = 8 * 32, I_P = 2 * 4;
        constexpr int NITEMS = I_IN + I_A + I_B + I_O + NE * I_GU + NE * I_DN + PG * I_P;
        for (int it = gw; it < NITEMS; it += NGW) {
            int r = it;
            if (r < I_IN) { transpose_item<1>(w_in, INW, INW, wt + WT_IN, 1024, 0, 0, scr, r, lane); continue; } r -= I_IN;
            if (r < I_A) { transpose_item<0>(w_branch_a, 1024, 1024, wt + WT_A, 1024, 0, 0, scr, r, lane); continue; } r -= I_A;
            if (r < I_B) { transpose_item<0>(w_branch_b, 1024, 1024, wt + WT_B, 512, 0, 0, scr, r, lane); continue; } r -= I_B;
            if (r < I_O) { transpose_item<0>(w_out, 1024, 1024, wt + WT_O, 1024, 0, 0, scr, r, lane); continue; } r -= I_O;
            if (r < NE * I_GU) { const int e = r / I_GU; transpose_item<2>(wgu + (size_t)e * 1024 * 1024, 1024, 1024, wt + WT_GU + (size_t)e * 1024 * 1024, 1024, 0, 0, scr, r % I_GU, lane); continue; } r -= NE * I_GU;
            if (r < NE * I_DN) { const int e = r / I_DN; transpose_item<0>(wdn + (size_t)e * 512 * 1024, 1024, 1024, wt + WT_DN + (size_t)e * 1024 * 512, 512, 0, 0, scr, r % I_DN, lane); continue; } r -= NE * I_DN;
            { const int g = r / I_P; transpose_item<0>(w_pool + (size_t)g * 128 * 128, 128, 128, wpool_bd, 512, g * 128, g * 128, scr, r % I_P, lane); }
        }
        for (int ch = gw * 64 + lane; ch < 512 * 64; ch += NGW * 64) { const int row = ch >> 6, c8 = (ch & 63) * 8; if ((row >> 7) != (c8 >> 7)) *(u32x4*)(wpool_bd + (size_t)row * 512 + c8) = (u32x4){0u, 0u, 0u, 0u}; }
        for (int m = gw; m < T; m += NGW) { const f32x4* xr = (const f32x4*)(x_ + (size_t)m * 1024) + lane; u32x2* o8 = (u32x2*)(xb + (size_t)m * 1024) + lane;
#pragma unroll
            for (int j = 0; j < 4; ++j) { const f32x4 v = xr[64 * j]; u32x2 w; w.x = cvt_pk_bf16(v[0], v[1]); w.y = cvt_pk_bf16(v[2], v[3]); o8[64 * j] = w; } }
        for (int e = gw * 64 + lane; e < T * 32; e += NGW * 64) { const int t = e >> 5, i = e & 31; const float inv = powf(10000.0f, -(float)i * (2.0f / 64.0f)); const float ang = (float)positions[t] * inv; const double a = (double)ang;
            rope[2 * e] = (float)cos(a); rope[2 * e + 1] = (float)sin(a); }
        if (gw == 0 && lane == 0) { float s01 = 0.f, s23 = 0.f; for (int i = 0; i < 64; ++i) { s01 += lam_vecs[i] * lam_vecs[64 + i]; s23 += lam_vecs[128 + i] * lam_vecs[192 + i]; } scal[0] = expf(s01) - expf(s23) + LAMBDA_INIT; }
        __syncthreads();
        SEAM(PH_PRO);
    }
    if (HAS(PH_G1)) {
        g8::DenseOrder S; S.init(xb, wt + WT_IN, T, INW, 1024, G, bx);
        g8::EpiProj E{qb, kb, vb, ub, gb, rope, gate_bias};
        g8::gemm_phase<g8::EpiProj, g8::DenseOrder, true, false>(lds, 1024, S, E);
        SEAM(PH_G1);
    }
    if (HAS(PH_POOLA)) {
        for (int e = (gw * 64 + lane); e < T * 64; e += NGW * 64) { const int t = e >> 6, c8 = (e & 63) * 8; const int g = c8 >> 7, w = 2 << g, s = t & (SEQ - 1); const int n = (s + 1 < w) ? s + 1 : w;
            float a[8] = {0.f, 0.f, 0.f, 0.f, 0.f, 0.f, 0.f, 0.f}; float u0[8];
            for (int i = 0; i < n; ++i) { const u32x4 v = *(const u32x4*)(ub + (size_t)(t - i) * 512 + c8); const float f[8] = {bflo(v.x), bfhi(v.x), bflo(v.y), bfhi(v.y), bflo(v.z), bfhi(v.z), bflo(v.w), bfhi(v.w)};
#pragma unroll
                for (int j = 0; j < 8; ++j) { a[j] += f[j]; if (i == 0) u0[j] = f[j]; } }
            const float inv = 1.f / (float)n; u32x4 o; o.x = cvt_pk_bf16(a[0] * inv - u0[0], a[1] * inv - u0[1]); o.y = cvt_pk_bf16(a[2] * inv - u0[2], a[3] * inv - u0[3]);
            o.z = cvt_pk_bf16(a[4] * inv - u0[4], a[5] * inv - u0[5]); o.w = cvt_pk_bf16(a[6] * inv - u0[6], a[7] * inv - u0[7]);
            *(u32x4*)(pooled + (size_t)t * 512 + c8) = o; }
    }
    if (HAS(PH_ATT)) { at2::attn_phase(lds, vcu, G, qb, kb, vb, on, scal, subln_gain); SEAM(PH_ATT); }
    else if (HAS(PH_POOLA)) { SEAM(PH_ATT); }
    if (HAS(PH_POOLG)) {
        g8::DenseOrder S; S.init(pooled, wpool_bd, T, 512, 512, G, bx);
        g8::EpiScaleBf16 E{mixed, 512, pool_scale};
        g8::gemm_phase<g8::EpiScaleBf16, g8::DenseOrder, true, false>(lds, 512, S, E);
    }
    if (HAS(PH_G4A)) {
        g8::DenseOrder S; S.init(on, wt + WT_A, T, 1024, 1024, G, bx);
        g8::EpiMerge<0> E{gb, merged};
        g8::gemm_phase<g8::EpiMerge<0>, g8::DenseOrder, true, false>(lds, 1024, S, E);
        SEAM(PH_G4A);
    } else if (HAS(PH_POOLG)) { SEAM(PH_G4A); }
    if (HAS(PH_G4B)) {
        g8::DenseOrder S; S.init(mixed, wt + WT_B, T, 1024, 512, G, bx);
        g8::EpiMerge<1> E{gb, merged};
        g8::gemm_phase<g8::EpiMerge<1>, g8::DenseOrder, true, false>(lds, 512, S, E);
        SEAM(PH_G4B);
    }
    if (HAS(PH_G5)) {
        g8::DenseOrder S; S.init(merged, wt + WT_O, T, 1024, 1024, G, bx);
        g8::EpiResid E{x_, out};
        g8::gemm_phase<g8::EpiResid, g8::DenseOrder, true, false>(lds, 1024, S, E);
        SEAM(PH_G5);
    }
    if (HAS(PH_ROUTER)) {
        for (int t = gw; t < T; t += NGW) {
            const float* yr = out + (size_t)t * 1024 + lane * 16; float xv[16]; float s = 0.f;
#pragma unroll
            for (int j = 0; j < 4; ++j) { const f32x4 vv = *(const f32x4*)(yr + j * 4); xv[4 * j] = vv.x; xv[4 * j + 1] = vv.y; xv[4 * j + 2] = vv.z; xv[4 * j + 3] = vv.w; s += (vv.x + vv.y) + (vv.z + vv.w); }
            const float mu = wave_sum(s) * (1.f / 1024.f); float s2 = 0.f;
#pragma unroll
            for (int i = 0; i < 16; ++i) { const float d = xv[i] - mu; s2 += d * d; }
            const float rstd = 1.0f / sqrtf(wave_sum(s2) * (1.f / 1024.f) + LN_EPS);
            if (lane == 0) stats[t] = make_float2(mu, rstd);
            { const float* gp = ln1_g + lane * 16; const float* bp = ln1_b + lane * 16;
#pragma unroll
            for (int j = 0; j < 4; ++j) { const f32x4 gg = *(const f32x4*)(gp + j * 4), bb = *(const f32x4*)(bp + j * 4);
#pragma unroll
                for (int i = 0; i < 4; ++i) xv[4 * j + i] = (xv[4 * j + i] - mu) * rstd * gg[i] + bb[i]; } }
            { u32x4 w0, w1; w0.x = cvt_pk_bf16(xv[0], xv[1]); w0.y = cvt_pk_bf16(xv[2], xv[3]); w0.z = cvt_pk_bf16(xv[4], xv[5]); w0.w = cvt_pk_bf16(xv[6], xv[7]);
              w1.x = cvt_pk_bf16(xv[8], xv[9]); w1.y = cvt_pk_bf16(xv[10], xv[11]); w1.z = cvt_pk_bf16(xv[12], xv[13]); w1.w = cvt_pk_bf16(xv[14], xv[15]);
              u32x4* xo = (u32x4*)(x1b + (size_t)t * 1024 + lane * 16); xo[0] = w0; xo[1] = w1; }
            float lg[4], le[32];
#pragma unroll
            for (int o = 0; o < 4; ++o) lg[o] = 0.f;
#pragma unroll
            for (int o = 0; o < 32; ++o) le[o] = 0.f;
            { const float* wgp = wrg + (size_t)lane * 16 * 4; const float* wep = wre + (size_t)lane * 16 * 32;
              LAS float* xl = (LAS float*)(lds + wave * 4352) + lane * 17;
#pragma unroll
              for (int i = 0; i < 16; ++i) xl[i] = xv[i];
              LDS_WAIT();
#pragma unroll 2
              for (int i = 0; i < 16; ++i) { const float xc = xl[i]; const f32x4 wg = *(const f32x4*)(wgp + i * 4);
#pragma unroll
                for (int o = 0; o < 4; ++o) lg[o] = fmaf(xc, wg[o], lg[o]);
#pragma unroll
                for (int o4 = 0; o4 < 8; ++o4) { const f32x4 we = *(const f32x4*)(wep + i * 32 + o4 * 4);
#pragma unroll
                    for (int o = 0; o < 4; ++o) le[o4 * 4 + o] = fmaf(xc, we[o], le[o4 * 4 + o]); } } }
#pragma unroll
            for (int o = 0; o < 4; ++o) lg[o] = wave_sum(lg[o]) + brg[o];
#pragma unroll
            for (int o = 0; o < 32; ++o) le[o] = wave_sum(le[o]) + bre[o];
            if (lane == 0) {
                int gi = 0; float gm = lg[0];
#pragma unroll
                for (int o = 1; o < 4; ++o) if (lg[o] > gm) { gm = lg[o]; gi = o; }
                float gs = 0.f;
#pragma unroll
                for (int o = 0; o < 4; ++o) gs += expf(lg[o] - gm);
                const float gp = 1.f / gs; float ev[8];
#pragma unroll
                for (int o = 0; o < 8; ++o) { float vsel = le[o];
#pragma unroll
                    for (int g = 1; g < 4; ++g) vsel = (gi == g) ? le[g * 8 + o] : vsel;
                    ev[o] = vsel; }
                int i0 = 0; float m0v = ev[0];
#pragma unroll
                for (int o = 1; o < 8; ++o) if (ev[o] > m0v) { m0v = ev[o]; i0 = o; }
                int i1 = (i0 == 0) ? 1 : 0; float m1v = -3.4e38f;
#pragma unroll
                for (int o = 0; o < 8; ++o) if (o != i0 && ev[o] > m1v) { m1v = ev[o]; i1 = o; }
                const float e1 = expf(m1v - m0v); const float w0 = gp / (1.f + e1), w1 = gp * e1 / (1.f + e1);
                const int ex0 = gi * 8 + i0, ex1 = gi * 8 + i1;
                rw[2 * t] = w0; rw[2 * t + 1] = w1;
                const unsigned p0 = atomicAdd(&cnt[ex0], 1u); list[(size_t)ex0 * T + p0] = t * 2;
                const unsigned p1 = atomicAdd(&cnt[ex1], 1u); list[(size_t)ex1 * T + p1] = t * 2 + 1;
            }
        }
        SEAM(PH_ROUTER);
    }
    if (HAS(PH_G7) || HAS(PH_G8)) {
        if (tid < NE) MISC[64 + tid] = __hip_atomic_load(cnt + tid, RLX_AGENT);
        __syncthreads();
        if (tid == 0) { unsigned acc = 0u; for (int e = 0; e < NE; ++e) { MISC[16 + e] = acc; acc += (MISC[64 + e] + 255u) >> 8; } MISC[16 + NE] = acc; }
        __syncthreads();
        const int ntiles = (int)MISC[16 + NE];
        if (HAS(PH_G7)) {
            g8::MoeOrder S{(const char*)x1b, (const char*)(wt + WT_GU), list, MISC + 16, MISC + 64, ntiles * 4, G, bx, 0, (size_t)1024 * 1024 * 2, (size_t)256 * 1024 * 2, 1};
            g8::EpiGateUp E{hb};
            g8::gemm_phase<g8::EpiGateUp, g8::MoeOrder, true, true>(lds, 1024, S, E);
            SEAM(PH_G7);
        }
        if (HAS(PH_G8)) {
            g8::MoeOrder S{(const char*)hb, (const char*)(wt + WT_DN), list, MISC + 16, MISC + 64, ntiles * 4, G, bx, (size_t)256 * 512 * 2, (size_t)1024 * 512 * 2, (size_t)256 * 512 * 2, 0};
            g8::EpiDown E{ybuf, list, rw, MISC + 64};
            g8::gemm_phase<g8::EpiDown, g8::MoeOrder, true, false>(lds, 512, S, E);
            SEAM(PH_G8);
        }
    }
    if (HAS(PH_FINAL)) {
        for (int t = gw; t < T; t += NGW) {
            float* yr = out + (size_t)t * 1024; const float2 st = stats[t]; float xv[16]; float s = 0.f;
#pragma unroll
            for (int j = 0; j < 4; ++j) { const int c0 = j * 256 + lane * 4; const f32x4 vv = *(const f32x4*)(yr + c0); const f32x4 gg = *(const f32x4*)(ln1_g + c0); const f32x4 bb = *(const f32x4*)(ln1_b + c0);
                const u32x2 a = *(const u32x2*)(ybuf + (size_t)(2 * t) * 1024 + c0); const u32x2 b = *(const u32x2*)(ybuf + (size_t)(2 * t + 1) * 1024 + c0);
                const float ya[4] = {bflo(a.x), bfhi(a.x), bflo(a.y), bfhi(a.y)}; const float yb[4] = {bflo(b.x), bfhi(b.x), bflo(b.y), bfhi(b.y)};
#pragma unroll
                for (int i = 0; i < 4; ++i) { const float x1 = (vv[i] - st.x) * st.y * gg[i] + bb[i]; const float val = ALPHA * x1 + (ya[i] + yb[i]); xv[4 * j + i] = val; s += val; } }
            const float mu = wave_sum(s) * (1.f / 1024.f); float s2 = 0.f;
#pragma unroll
            for (int i = 0; i < 16; ++i) { const float d = xv[i] - mu; s2 += d * d; }
            const float rstd = 1.0f / sqrtf(wave_sum(s2) * (1.f / 1024.f) + LN_EPS);
#pragma unroll
            for (int j = 0; j < 4; ++j) { const int c0 = j * 256 + lane * 4; const f32x4 gg = *(const f32x4*)(ln2_g + c0); const f32x4 bb = *(const f32x4*)(ln2_b + c0); f32x4 o;
#pragma unroll
                for (int i = 0; i < 4; ++i) o[i] = (xv[4 * j + i] - mu) * rstd * gg[i] + bb[i];
                *(f32x4*)(yr + c0) = o; }
        }
    }
#undef HAS
#undef SEAM
}
#undef IN_F
#undef x_
#undef positions
#undef w_in
#undef gate_bias
#undef lam_vecs
#undef subln_gain
#undef w_pool
#undef pool_scale
#undef w_branch_a
#undef w_branch_b
#undef w_out
#undef ln1_g
#undef ln1_b
#undef wrg
#undef brg
#undef wre
#undef bre
#undef wgu
#undef wdn
#undef ln2_g
#undef ln2_b
#undef wt
#undef xb
#undef qb
#undef kb
#undef vb
#undef ub
#undef gb
#undef on
#undef mixed
#undef merged
#undef x1b
#undef hb
#undef ybuf
#undef rope
#undef pooled
#undef misc
#undef ctl
#undef stats
#undef rw
#undef list
#undef scal
#undef cnt
#undef wpool_bd


#ifndef MK_OPT
#define MK_OPT 0x003u
#endif
#ifndef MK_M2A
#define MK_M2A 0xff4u
#define MK_M2B 0u
#define MK_M2C 0u
#endif
#ifndef MK_ONE
#define MK_ONE 0
#endif
constexpr unsigned OPT = MK_OPT;
#define OPTP(p) ((OPT >> (p)) & 1u)


#ifdef MK_DEBUG_HASH
__global__ void k_hash(const uint4* __restrict__ p, size_t n16, unsigned long long* __restrict__ outh) {
    unsigned long long h = 0ull;
    for (size_t i = blockIdx.x * (size_t)blockDim.x + threadIdx.x; i < n16; i += (size_t)gridDim.x * blockDim.x) { const uint4 w = p[i];
        const unsigned long long m = (unsigned long long)(i * 2654435761ull + 12345ull) | 1ull;
        h += ((unsigned long long)w.x * 0x9E3779B1ull + (unsigned long long)w.y * 0x85EBCA77ull + (unsigned long long)w.z * 0xC2B2AE3Dull + (unsigned long long)w.w * 0x27D4EB2Full) * m; }
    for (int o = 32; o > 0; o >>= 1) h += __shfl_xor(h, o);
    if ((threadIdx.x & 63) == 0) atomicAdd(outh, h);
}
__global__ void k_poison(float* __restrict__ out, const unsigned long long* __restrict__ hs) {
    float code = 0.f; for (int r = 1; r < 10; ++r) if (hs[r] != hs[0]) code = 1.f;
    if (code == 0.f) return;
    for (size_t i = blockIdx.x * (size_t)blockDim.x + threadIdx.x; i < (size_t)T * DM; i += (size_t)gridDim.x * blockDim.x) out[i] = __builtin_nanf("") * code;
}
#endif
extern "C" void kernel_launch(void* const* d_in, const int* in_sizes, int n_in, void* d_out, int out_size, void* d_ws, size_t ws_size, hipStream_t stream) {
    static int grid = 0;
    if (grid == 0) {
        if (n_in != 21 || in_sizes[0] != T * DM || out_size != T * DM || ws_size < WS_END) { fprintf(stderr, "kernel_launch: unexpected shapes (n_in %d, x %d, out %d, ws %zu)\n", n_in, n_in > 0 ? in_sizes[0] : -1, out_size, ws_size); grid = -1; return; }
        int dev = 0, cus = 0;
        if (hipGetDevice(&dev) != hipSuccess || hipDeviceGetAttribute(&cus, hipDeviceAttributeMultiprocessorCount, dev) != hipSuccess) { fprintf(stderr, "kernel_launch: device query failed\n"); grid = -1; return; }
        int per_cu = 0;
        if (hipOccupancyMaxActiveBlocksPerMultiprocessor(&per_cu, (const void*)mk_fwd, NTHREADS, 0) != hipSuccess || per_cu < 1) fprintf(stderr, "kernel_launch: note: occupancy query reports %d blocks per CU\n", per_cu);
        (void)hipGetLastError();
        grid = cus;
    }
    if (grid < 0) return;
    const float* x = (const float*)d_in[0]; const int* positions = (const int*)d_in[1]; const float* w_in = (const float*)d_in[2]; const float* gate_bias = (const float*)d_in[3];
    const float* lam_vecs = (const float*)d_in[4]; const float* subln_gain = (const float*)d_in[5]; const float* w_pool = (const float*)d_in[6]; const float* pool_scale = (const float*)d_in[7];
    const float* w_branch_a = (const float*)d_in[8]; const float* w_branch_b = (const float*)d_in[9]; const float* w_out = (const float*)d_in[10]; const float* ln1_g = (const float*)d_in[11];
    const float* ln1_b = (const float*)d_in[12]; const float* wrg = (const float*)d_in[13]; const float* brg = (const float*)d_in[14]; const float* wre = (const float*)d_in[15];
    const float* bre = (const float*)d_in[16]; const float* wgu = (const float*)d_in[17]; const float* wdn = (const float*)d_in[18]; const float* ln2_g = (const float*)d_in[19]; const float* ln2_b = (const float*)d_in[20];
    char* ws = (char*)d_ws; float* out = (float*)d_out;
    bf16_t* qb = (bf16_t*)(ws + WS_Q); bf16_t* kb = (bf16_t*)(ws + WS_K); bf16_t* vb = (bf16_t*)(ws + WS_V); bf16_t* ub = (bf16_t*)(ws + WS_U); bf16_t* gb = (bf16_t*)d_out;
    bf16_t* on = (bf16_t*)(ws + WS_ON); bf16_t* mixed = (bf16_t*)(ws + WS_MIXED); bf16_t* merged = (bf16_t*)(ws + WS_MERGED); bf16_t* x1b = (bf16_t*)(ws + WS_X1B);
    bf16_t* hb = (bf16_t*)(ws + WS_H); bf16_t* ybuf = (bf16_t*)(ws + WS_YBUF); float2* rope = (float2*)(ws + WS_ROPE); float* tmp = (float*)(ws + WS_TEMP);
    char* misc = ws + WS_MISC; unsigned* ctl = (unsigned*)(misc + MS_CTL); float2* stats = (float2*)(misc + MS_STATS); int2* rexp = (int2*)(misc + MS_ROUTE); float2* rw = (float2*)(misc + MS_ROUTE + (size_t)T * 8);
    int* list = (int*)(misc + MS_LIST); float* scal = (float*)(misc + MS_SCAL); unsigned* cnt = ctl;

    MKArgs a{}; int nlaunch = 0;
    for (int i = 0; i < 21; ++i) a.in[i] = d_in[i];
    a.out = out; a.ws = (unsigned char*)d_ws;
    if (hipMemsetAsync(ctl, 0, 65536, stream) != hipSuccess) { fprintf(stderr, "kernel_launch: memset failed\n"); return; }
#define MK(maskv) do { a.mask = (maskv); a.li = (unsigned)(nlaunch++ % 3); hipLaunchKernelGGL(mk_fwd, dim3(grid), dim3(NTHREADS), 0, stream, a); } while (0)
    if (MK_ONE == 1) { MK((1u << PH_N) - 1u); return; }
    if (MK_ONE == 2) {
        MK(0x003u);
        for (int mh = 0; mh < 2; ++mh) { const int m0 = mh * 16384; nattn<<<(16384 / 64) * 16, 64, 0, stream>>>(qb, kb, vb, scal, tmp, m0); post_rms<<<16384 * 8 / 256, 256, 0, stream>>>(tmp, subln_gain, on, m0, 16384); }
        MK(MK_M2A); if (MK_M2B) MK(MK_M2B); if (MK_M2C) MK(MK_M2C); return; }

    constexpr int MC = 16384;
#if 0
#else
#ifdef MK_TEST_BAR
    MK(0x003u);
#else
    if (OPTP(PH_PRO)) MK(1u << PH_PRO); else k_prep<<<T * 32 / 256, 256, 0, stream>>>(positions, lam_vecs, rope, scal, ctl);
    if (OPTP(PH_G1)) MK(1u << PH_G1);
#endif
#endif
#ifndef MK_OVR
#define MK_OVR 0
#endif
    const int ovr = OPTP(PH_G1) ? MK_OVR : 15;
    for (int mh = 0; mh < 2; ++mh) {
        const int m0 = mh * MC; AL_F32 ax{x + (size_t)m0 * DM, DM, 0};
        if (ovr & 1) for (int qk = 0; qk < 2; ++qk) {
            ngemm<AL_F32><<<dim3(16, MC / 64), 256, 0, stream>>>(ax, w_in + qk * 1024, INW, tmp, 1024, MC, 1024, DM);
            post_qk<<<MC * 512 / 256, 256, 0, stream>>>(tmp, rope, qk ? kb : qb, m0, MC, qk ? 1.f : QSCALE);
        }
        if (ovr & 2) { ngemm<AL_F32><<<dim3(16, MC / 64), 256, 0, stream>>>(ax, w_in + 2048, INW, tmp, 1024, MC, 1024, DM);
        post_plain<<<MC * 1024 / 256, 256, 0, stream>>>(tmp, vb, 1024, 0, m0, MC, 1024, nullptr); }
        if (ovr & 4) { ngemm<AL_F32><<<dim3(8, MC / 64), 256, 0, stream>>>(ax, w_in + 3072, INW, tmp, 512, MC, 512, DM);
        post_plain<<<MC * 512 / 256, 256, 0, stream>>>(tmp, ub, 512, 0, m0, MC, 512, nullptr); }
        if (ovr & 8) for (int br = 0; br < 2; ++br) {
            ngemm<AL_F32><<<dim3(16, MC / 64), 256, 0, stream>>>(ax, w_in + 3584 + br * 1024, INW, tmp, 1024, MC, 1024, DM);
            post_gate<<<MC * 1024 / 256, 256, 0, stream>>>(tmp, gate_bias, gb, br * 1024, m0, MC);
        }
    }
    if (OPTP(PH_ATT)) MK(1u << PH_ATT);
    else for (int mh = 0; mh < 2; ++mh) {
        const int m0 = mh * MC;
        nattn<<<(MC / 64) * 16, 64, 0, stream>>>(qb, kb, vb, scal, tmp, m0);
        post_rms<<<MC * 8 / 256, 256, 0, stream>>>(tmp, subln_gain, on, m0, MC);
    }
    if (OPTP(PH_POOLA)) { MK(1u << PH_POOLA); MK(1u << PH_POOLG); }
    else for (int mh = 0; mh < 2; ++mh) {
        const int m0 = mh * MC;
        for (int g = 0; g < 4; ++g) { AL_POOL ap{ub + (size_t)m0 * PW, g, 0};
            ngemm<AL_POOL><<<dim3(2, MC / 64), 256, 0, stream>>>(ap, w_pool + (size_t)g * 128 * 128, 128, tmp + g * 128, 512, MC, 128, 128); }
        post_plain<<<MC * 512 / 256, 256, 0, stream>>>(tmp, mixed, 512, 0, m0, MC, 512, pool_scale);
    }
    if (OPTP(PH_G4A)) MK(1u << PH_G4A);
    else for (int mh = 0; mh < 2; ++mh) {
        const int m0 = mh * MC;
        { AL_BF16 al{on + (size_t)m0 * 1024, 1024, 0}; ngemm<AL_BF16><<<dim3(16, MC / 64), 256, 0, stream>>>(al, w_branch_a, 1024, tmp, 1024, MC, 1024, 1024); }
        post_merge<<<MC * 1024 / 256, 256, 0, stream>>>(tmp, gb, merged, 0, m0, MC);
    }
    if (OPTP(PH_G4B)) MK(1u << PH_G4B);
    else for (int mh = 0; mh < 2; ++mh) {
        const int m0 = mh * MC;
        { AL_BF16 al{mixed + (size_t)m0 * 512, 512, 0}; ngemm<AL_BF16><<<dim3(16, MC / 64), 256, 0, stream>>>(al, w_branch_b, 1024, tmp, 1024, MC, 1024, 512); }
        post_merge<<<MC * 1024 / 256, 256, 0, stream>>>(tmp, gb, merged, 1, m0, MC);
    }
    if (OPTP(PH_G5)) MK(1u << PH_G5);
    else for (int mh = 0; mh < 2; ++mh) {
        const int m0 = mh * MC;
        { AL_BF16 al{merged + (size_t)m0 * 1024, 1024, 0}; ngemm<AL_BF16><<<dim3(16, MC / 64), 256, 0, stream>>>(al, w_out, 1024, tmp, 1024, MC, 1024, 1024); }
        post_y<<<MC * 1024 / 256, 256, 0, stream>>>(tmp, x, out, m0, MC);
    }
    if (OPTP(PH_ROUTER)) MK(1u << PH_ROUTER); else k_router<<<T / 4, 256, 0, stream>>>(out, ln1_g, ln1_b, wrg, brg, wre, bre, x1b, stats, rexp, rw, list, cnt);
    if (OPTP(PH_G7)) MK(1u << PH_G7); else nmoe_gu<<<dim3(8, T / 64, NE), 256, 0, stream>>>(x1b, list, cnt, wgu, hb);
    if (OPTP(PH_G8)) MK(1u << PH_G8); else nmoe_dn<<<dim3(16, T / 64, NE), 256, 0, stream>>>(hb, list, cnt, rw, wdn, ybuf);
    if (OPTP(PH_FINAL)) MK(1u << PH_FINAL); else k_final<<<T / 4, 256, 0, stream>>>(out, stats, ln1_g, ln1_b, ybuf, ln2_g, ln2_b);
#undef MK
}
```

```cpp
#define MK_OPT 0xfffu
#define MK_ONE 1
#include <hip/hip_runtime.h>
#include <cstdio>
#include <cstdint>
#include <cmath>

typedef unsigned short bf16_t;
typedef float f32x4 __attribute__((ext_vector_type(4)));

constexpr int NB = 16, SEQ = 2048, DM = 1024, T = NB * SEQ;
constexpr int NHEAD = 8, HD = 64, NHM = 16;
constexpr int INW = 5632;
constexpr int PW = 512, PG = 4, PGD = 128;
constexpr int NE = 32, NGRP = 4, EPG = 8, FF = 512;
constexpr float LN_EPS = 1e-5f, RMS_EPS = 1e-5f;
constexpr float ALPHA = 1.189207115002721f;
constexpr float LAMBDA_INIT = 0.2f;
constexpr float QSCALE = 0.125f * 1.4426950408889634f;

constexpr size_t MiB = 1u << 20;
constexpr size_t WS_WT    = 0;
constexpr size_t WS_XB    = 112 * MiB;
constexpr size_t WS_ON    = 112 * MiB;
constexpr size_t WS_YBUF  = 112 * MiB;
constexpr size_t WS_Q     = 176 * MiB;
constexpr size_t WS_MERGED= 176 * MiB;
constexpr size_t WS_K     = 240 * MiB;
constexpr size_t WS_X1B   = 240 * MiB;
constexpr size_t WS_V     = 304 * MiB;
constexpr size_t WS_H     = 304 * MiB;
constexpr size_t WS_U     = 368 * MiB;
constexpr size_t WS_MIXED = 400 * MiB;
constexpr size_t WS_ROPE  = 432 * MiB;
constexpr size_t WS_MISC  = 440 * MiB;
constexpr size_t WS_TEMP  = 448 * MiB;
constexpr size_t WS_END   = 512 * MiB;
constexpr size_t MS_CTL   = 0;
constexpr size_t MS_STATS = 64 * 1024;
constexpr size_t MS_ROUTE = 512 * 1024;
constexpr size_t MS_LIST  = 1 * MiB;
constexpr size_t MS_SCAL  = 6 * MiB;

__device__ __forceinline__ float bf2f(bf16_t v) { return __uint_as_float((unsigned)v << 16); }
__device__ __forceinline__ bf16_t f2bf(float f) { unsigned u = __float_as_uint(f); return (bf16_t)((u + 0x7fffu + ((u >> 16) & 1u)) >> 16); }
__host__ __device__ __forceinline__ int qk_pos_of_d(int d) { return ((d >> 4) & 1) * 32 + ((d >> 2) & 3) * 8 + (d >> 5) * 4 + (d & 3); }

struct AL_F32  { const float* p; int ld; int pad;  __device__ __forceinline__ float operator()(int r, int k) const { return p[(size_t)r * ld + k]; } };
struct AL_BF16 { const bf16_t* p; int ld; int pad; __device__ __forceinline__ float operator()(int r, int k) const { return bf2f(p[(size_t)r * ld + k]); } };
struct AL_POOL { const bf16_t* u; int g; int pad;
    __device__ __forceinline__ float operator()(int r, int k) const {
        const int w = 2 << g, s = r & (SEQ - 1); const int n = (s + 1 < w) ? s + 1 : w; float acc = 0.f;
        for (int i = 0; i < n; ++i) acc += bf2f(u[(size_t)(r - i) * PW + g * PGD + k]);
        return acc / (float)n - bf2f(u[(size_t)r * PW + g * PGD + k]); } };

template <class AL>
__global__ __launch_bounds__(256) void ngemm(AL al, const float* __restrict__ Bm, int ldb, float* __restrict__ C, int ldc, int M, int N, int K) {
    __shared__ float As[16][68]; __shared__ float Bs[16][68];
    const int tid = threadIdx.x, tx = tid & 15, ty = tid >> 4; const int m0 = blockIdx.y * 64, n0 = blockIdx.x * 64;
    float acc[4][4] = {};
    for (int k0 = 0; k0 < K; k0 += 16) {
#pragma unroll
        for (int i = 0; i < 4; ++i) { const int e = tid + i * 256; const int r = e >> 4, kk = e & 15; As[kk][r] = (m0 + r < M) ? al(m0 + r, k0 + kk) : 0.f; }
#pragma unroll
        for (int i = 0; i < 4; ++i) { const int e = tid + i * 256; const int kk = e >> 6, c = e & 63; Bs[kk][c] = (n0 + c < N) ? Bm[(size_t)(k0 + kk) * ldb + n0 + c] : 0.f; }
        __syncthreads();
#pragma unroll
        for (int kk = 0; kk < 16; ++kk) { float a[4], b[4];
#pragma unroll
            for (int i = 0; i < 4; ++i) { a[i] = As[kk][ty * 4 + i]; b[i] = Bs[kk][tx * 4 + i]; }
#pragma unroll
            for (int i = 0; i < 4; ++i)
#pragma unroll
                for (int j = 0; j < 4; ++j) acc[i][j] = fmaf(a[i], b[j], acc[i][j]); }
        __syncthreads();
    }
#pragma unroll
    for (int i = 0; i < 4; ++i)
#pragma unroll
        for (int j = 0; j < 4; ++j) { const int r = m0 + ty * 4 + i, c = n0 + tx * 4 + j; if (r < M && c < N) C[(size_t)r * ldc + c] = acc[i][j]; }
}

__global__ void k_prep(const int* __restrict__ positions, const float* __restrict__ lam_vecs, float2* __restrict__ rope, float* __restrict__ scal, unsigned* __restrict__ ctl) {
    const int gid = blockIdx.x * blockDim.x + threadIdx.x;
    if (gid < T * 32) { const int t = gid >> 5, i = gid & 31;
        const float inv = powf(10000.0f, -(float)i * (2.0f / 64.0f)); const float ang = (float)positions[t] * inv;
        const double a = (double)ang; rope[gid] = make_float2((float)cos(a), (float)sin(a)); }
    if (gid < 16384) ctl[gid] = 0u;
    if (gid == 0) { float s01 = 0.f, s23 = 0.f; for (int i = 0; i < 64; ++i) { s01 += lam_vecs[i] * lam_vecs[64 + i]; s23 += lam_vecs[128 + i] * lam_vecs[192 + i]; }
        scal[0] = expf(s01) - expf(s23) + LAMBDA_INIT; }
}
__global__ void post_qk(const float* __restrict__ tmp, const float2* __restrict__ rope, bf16_t* __restrict__ out, int m0, int Mc, float scale) {
    const int gid = blockIdx.x * blockDim.x + threadIdx.x; if (gid >= Mc * 512) return;
    const int r = gid >> 9, p = gid & 511, hm = p >> 5, i = p & 31; const int t = m0 + r;
    const float t1 = tmp[(size_t)r * 1024 + hm * 64 + i], t2 = tmp[(size_t)r * 1024 + hm * 64 + i + 32]; const float2 cs = rope[t * 32 + i];
    out[(size_t)t * 1024 + hm * 64 + qk_pos_of_d(i)] = f2bf((t1 * cs.x - t2 * cs.y) * scale);
    out[(size_t)t * 1024 + hm * 64 + qk_pos_of_d(i + 32)] = f2bf((t2 * cs.x + t1 * cs.y) * scale);
}
__global__ void post_plain(const float* __restrict__ tmp, bf16_t* __restrict__ out, int ldo, int coloff, int m0, int Mc, int N, const float* __restrict__ colscale) {
    const int gid = blockIdx.x * blockDim.x + threadIdx.x; if (gid >= Mc * N) return;
    const int r = gid / N, c = gid % N; float v = tmp[(size_t)r * N + c]; if (colscale) v *= colscale[c];
    out[(size_t)(m0 + r) * ldo + coloff + c] = f2bf(v);
}
__global__ void post_gate(const float* __restrict__ tmp, const float* __restrict__ bias, bf16_t* __restrict__ gates, int coloff, int m0, int Mc) {
    const int gid = blockIdx.x * blockDim.x + threadIdx.x; if (gid >= Mc * 1024) return;
    const int r = gid >> 10, c = gid & 1023; const float v = tmp[(size_t)r * 1024 + c] + bias[coloff + c];
    gates[(size_t)(m0 + r) * 2048 + coloff + c] = f2bf(1.f / (1.f + expf(-v)));
}
__global__ __launch_bounds__(64) void nattn(const bf16_t* __restrict__ q, const bf16_t* __restrict__ k, const bf16_t* __restrict__ v, const float* __restrict__ scal, float* __restrict__ tmp, int m0) {
    const int lane = threadIdx.x; const int blk = blockIdx.x;
    const int half = blk & 1, head = (blk >> 1) & 7, cg = blk >> 4; const int t0 = m0 + cg * 64, t = t0 + lane; const int b = t0 / SEQ, s0 = t0 % SEQ; const int nkeys = ((s0 >> 6) + 1) * 64;
    const float lam = scal[0];
    float res[64];
    for (int mp = 0; mp < 2; ++mp) {
        const int hm = head * 2 + mp; float qv[64];
#pragma unroll
        for (int d = 0; d < 64; ++d) qv[d] = bf2f(q[(size_t)t * 1024 + hm * 64 + d]);
        float mx = -1e30f, l = 0.f; float o[64];
#pragma unroll
        for (int d = 0; d < 64; ++d) o[d] = 0.f;
        for (int j = 0; j < nkeys; ++j) { const size_t kr = (size_t)(b * SEQ + j) * 1024; float sc = 0.f;
            const uint4* kp = (const uint4*)(k + kr + hm * 64); const uint4* vp = (const uint4*)(v + kr + head * 128 + half * 64);
#pragma unroll
            for (int c = 0; c < 8; ++c) { const uint4 w = kp[c]; const unsigned ww[4] = {w.x, w.y, w.z, w.w};
#pragma unroll
                for (int e = 0; e < 4; ++e) { sc = fmaf(qv[c * 8 + 2 * e], __uint_as_float(ww[e] << 16), sc); sc = fmaf(qv[c * 8 + 2 * e + 1], __uint_as_float(ww[e] & 0xffff0000u), sc); } }
            const float mn = fmaxf(mx, sc), al = exp2f(mx - mn), p = exp2f(sc - mn); mx = mn; l = l * al + p;
#pragma unroll
            for (int c = 0; c < 8; ++c) { const uint4 w = vp[c]; const unsigned ww[4] = {w.x, w.y, w.z, w.w};
#pragma unroll
                for (int e = 0; e < 4; ++e) { o[c * 8 + 2 * e] = fmaf(p, __uint_as_float(ww[e] << 16), o[c * 8 + 2 * e] * al); o[c * 8 + 2 * e + 1] = fmaf(p, __uint_as_float(ww[e] & 0xffff0000u), o[c * 8 + 2 * e + 1] * al); } } }
        const float il = 1.f / l;
#pragma unroll
        for (int d = 0; d < 64; ++d) res[d] = (mp == 0) ? o[d] * il : res[d] - lam * o[d] * il;
    }
#pragma unroll
    for (int d = 0; d < 64; ++d) tmp[(size_t)(t - m0) * 1024 + head * 128 + half * 64 + d] = res[d];
}
__global__ void post_rms(const float* __restrict__ tmp, const float* __restrict__ gain, bf16_t* __restrict__ on, int m0, int Mc) {
    const int gid = blockIdx.x * blockDim.x + threadIdx.x; if (gid >= Mc * 8) return;
    const int r = gid >> 3, head = gid & 7; const float* p = tmp + (size_t)r * 1024 + head * 128; float ss = 0.f;
    for (int d = 0; d < 128; ++d) ss += p[d] * p[d];
    const float rs = 1.0f / sqrtf(ss * (1.f / 128.f) + RMS_EPS);
    for (int d = 0; d < 128; ++d) on[(size_t)(m0 + r) * 1024 + head * 128 + d] = f2bf(p[d] * rs * gain[d] * (1.f - LAMBDA_INIT));
}
__global__ void post_merge(const float* __restrict__ tmp, const bf16_t* __restrict__ gates, bf16_t* __restrict__ merged, int br, int m0, int Mc) {
    const int gid = blockIdx.x * blockDim.x + threadIdx.x; if (gid >= Mc * 1024) return;
    const int r = gid >> 10, c = gid & 1023; const size_t t = m0 + r; const float g = bf2f(gates[t * 2048 + br * 1024 + c]);
    float val = g * tmp[(size_t)r * 1024 + c]; if (br) val += bf2f(merged[t * 1024 + c]);
    merged[t * 1024 + c] = f2bf(val);
}
__global__ void post_y(const float* __restrict__ tmp, const float* __restrict__ x, float* __restrict__ y, int m0, int Mc) {
    const int gid = blockIdx.x * blockDim.x + threadIdx.x; if (gid >= Mc * 1024) return;
    const size_t o = (size_t)m0 * 1024 + gid; y[o] = ALPHA * x[o] + tmp[gid];
}
__device__ __forceinline__ float wave_sum(float v) {
#pragma unroll
    for (int o = 1; o < 64; o <<= 1) v += __shfl_xor(v, o);
    return v;
}
__global__ __launch_bounds__(256) void k_router(const float* __restrict__ y, const float* __restrict__ g1, const float* __restrict__ b1, const float* __restrict__ wrg, const float* __restrict__ brg,
                                                const float* __restrict__ wre, const float* __restrict__ bre, bf16_t* __restrict__ x1b, float2* __restrict__ stats, int2* __restrict__ rexp, float2* __restrict__ rw,
                                                int* __restrict__ list, unsigned* __restrict__ cnt) {
    const int lane = threadIdx.x & 63; const int t = blockIdx.x * 4 + (threadIdx.x >> 6);
    const float* yr = y + (size_t)t * 1024; float xv[16]; float s = 0.f;
#pragma unroll
    for (int j = 0; j < 4; ++j) { const f32x4 vv = *(const f32x4*)(yr + j * 256 + lane * 4); xv[4 * j] = vv.x; xv[4 * j + 1] = vv.y; xv[4 * j + 2] = vv.z; xv[4 * j + 3] = vv.w; s += (vv.x + vv.y) + (vv.z + vv.w); }
    const float mu = wave_sum(s) * (1.f / 1024.f); float s2 = 0.f;
#pragma unroll
    for (int i = 0; i < 16; ++i) { const float d = xv[i] - mu; s2 += d * d; }
    const float rstd = 1.0f / sqrtf(wave_sum(s2) * (1.f / 1024.f) + LN_EPS);
    if (lane == 0) stats[t] = make_float2(mu, rstd);
#pragma unroll
    for (int j = 0; j < 4; ++j)
#pragma unroll
        for (int i = 0; i < 4; ++i) { const int c = j * 256 + lane * 4 + i; xv[4 * j + i] = (xv[4 * j + i] - mu) * rstd * g1[c] + b1[c]; }
#pragma unroll
    for (int j = 0; j < 4; ++j) { uint2 w; w.x = (unsigned)f2bf(xv[4 * j]) | ((unsigned)f2bf(xv[4 * j + 1]) << 16); w.y = (unsigned)f2bf(xv[4 * j + 2]) | ((unsigned)f2bf(xv[4 * j + 3]) << 16);
        *(uint2*)(x1b + (size_t)t * 1024 + j * 256 + lane * 4) = w; }
    float lg[4], le[32];
#pragma unroll
    for (int o = 0; o < 4; ++o) { float a = 0.f;
#pragma unroll
        for (int j = 0; j < 4; ++j)
#pragma unroll
            for (int i = 0; i < 4; ++i) a = fmaf(xv[4 * j + i], wrg[(size_t)(j * 256 + lane * 4 + i) * 4 + o], a);
        lg[o] = wave_sum(a) + brg[o]; }
#pragma unroll
    for (int o = 0; o < 32; ++o) { float a = 0.f;
#pragma unroll
        for (int j = 0; j < 4; ++j)
#pragma unroll
            for (int i = 0; i < 4; ++i) a = fmaf(xv[4 * j + i], wre[(size_t)(j * 256 + lane * 4 + i) * 32 + o], a);
        le[o] = wave_sum(a) + bre[o]; }
    if (lane == 0) {
        int gi = 0; float gm = lg[0];
#pragma unroll
        for (int o = 1; o < 4; ++o) if (lg[o] > gm) { gm = lg[o]; gi = o; }
        float gs = 0.f;
#pragma unroll
        for (int o = 0; o < 4; ++o) gs += expf(lg[o] - gm);
        const float gp = 1.f / gs;
        float ev[8];
#pragma unroll
        for (int o = 0; o < 8; ++o) { float vsel = le[o];
#pragma unroll
            for (int g = 1; g < 4; ++g) vsel = (gi == g) ? le[g * 8 + o] : vsel;
            ev[o] = vsel; }
        int i0 = 0; float m0v = ev[0];
#pragma unroll
        for (int o = 1; o < 8; ++o) if (ev[o] > m0v) { m0v = ev[o]; i0 = o; }
        int i1 = (i0 == 0) ? 1 : 0; float m1v = -3.4e38f;
#pragma unroll
        for (int o = 0; o < 8; ++o) if (o != i0 && ev[o] > m1v) { m1v = ev[o]; i1 = o; }
        const float e1 = expf(m1v - m0v); const float w0 = gp / (1.f + e1), w1 = gp * e1 / (1.f + e1);
        const int ex0 = gi * 8 + i0, ex1 = gi * 8 + i1;
        rexp[t] = make_int2(ex0, ex1); rw[t] = make_float2(w0, w1);
        const unsigned p0 = atomicAdd(&cnt[ex0], 1u); list[(size_t)ex0 * T + p0] = t * 2;
        const unsigned p1 = atomicAdd(&cnt[ex1], 1u); list[(size_t)ex1 * T + p1] = t * 2 + 1;
    }
}
__global__ __launch_bounds__(256) void nmoe_gu(const bf16_t* __restrict__ x1b, const int* __restrict__ list, const unsigned* __restrict__ cnt, const float* __restrict__ wgu, bf16_t* __restrict__ h) {
    __shared__ float As[16][68]; __shared__ float Bg[16][68]; __shared__ float Bu[16][68]; __shared__ int toks[64];
    const int e = blockIdx.z; const int M = (int)cnt[e]; const int m0 = blockIdx.y * 64, n0 = blockIdx.x * 64; if (m0 >= M) return;
    int tb = 0; for (int i = 0; i < e; ++i) tb += ((int)cnt[i] + 255) >> 8;
    const int tid = threadIdx.x, tx = tid & 15, ty = tid >> 4;
    if (tid < 64) toks[tid] = (m0 + tid < M) ? (list[(size_t)e * T + m0 + tid] >> 1) : 0;
    __syncthreads();
    const float* W = wgu + (size_t)e * 1024 * 1024; float ag[4][4] = {}, au[4][4] = {};
    for (int k0 = 0; k0 < 1024; k0 += 16) {
#pragma unroll
        for (int i = 0; i < 4; ++i) { const int el = tid + i * 256; const int r = el >> 4, kk = el & 15; As[kk][r] = bf2f(x1b[(size_t)toks[r] * 1024 + k0 + kk]); }
#pragma unroll
        for (int i = 0; i < 4; ++i) { const int el = tid + i * 256; const int kk = el >> 6, c = el & 63; Bg[kk][c] = W[(size_t)(k0 + kk) * 1024 + n0 + c]; Bu[kk][c] = W[(size_t)(k0 + kk) * 1024 + 512 + n0 + c]; }
        __syncthreads();
#pragma unroll
        for (int kk = 0; kk < 16; ++kk) { float a[4], bg[4], bu[4];
#pragma unroll
            for (int i = 0; i < 4; ++i) { a[i] = As[kk][ty * 4 + i]; bg[i] = Bg[kk][tx * 4 + i]; bu[i] = Bu[kk][tx * 4 + i]; }
#pragma unroll
            for (int i = 0; i < 4; ++i)
#pragma unroll
                for (int j = 0; j < 4; ++j) { ag[i][j] = fmaf(a[i], bg[j], ag[i][j]); au[i][j] = fmaf(a[i], bu[j], au[i][j]); } }
        __syncthreads();
    }
#pragma unroll
    for (int i = 0; i < 4; ++i)
#pragma unroll
        for (int j = 0; j < 4; ++j) { const int r = m0 + ty * 4 + i, c = n0 + tx * 4 + j; if (r < M) { const float g = ag[i][j]; h[((size_t)tb * 256 + r) * 512 + c] = f2bf(g / (1.f + expf(-g)) * au[i][j]); } }
}
__global__ __launch_bounds__(256) void nmoe_dn(const bf16_t* __restrict__ h, const int* __restrict__ list, const unsigned* __restrict__ cnt, const float2* __restrict__ rw, const float* __restrict__ wdn, bf16_t* __restrict__ ybuf) {
    __shared__ float As[16][68]; __shared__ float Bs[16][68];
    const int e = blockIdx.z; const int M = (int)cnt[e]; const int m0 = blockIdx.y * 64, n0 = blockIdx.x * 64; if (m0 >= M) return;
    int tb = 0; for (int i = 0; i < e; ++i) tb += ((int)cnt[i] + 255) >> 8;
    const int tid = threadIdx.x, tx = tid & 15, ty = tid >> 4;
    const float* W = wdn + (size_t)e * 512 * 1024; float acc[4][4] = {};
    for (int k0 = 0; k0 < 512; k0 += 16) {
#pragma unroll
        for (int i = 0; i < 4; ++i) { const int el = tid + i * 256; const int r = el >> 4, kk = el & 15; As[kk][r] = (m0 + r < M) ? bf2f(h[((size_t)tb * 256 + m0 + r) * 512 + k0 + kk]) : 0.f; }
#pragma unroll
        for (int i = 0; i < 4; ++i) { const int el = tid + i * 256; const int kk = el >> 6, c = el & 63; Bs[kk][c] = W[(size_t)(k0 + kk) * 1024 + n0 + c]; }
        __syncthreads();
#pragma unroll
        for (int kk = 0; kk < 16; ++kk) { float a[4], b[4];
#pragma unroll
            for (int i = 0; i < 4; ++i) { a[i] = As[kk][ty * 4 + i]; b[i] = Bs[kk][tx * 4 + i]; }
#pragma unroll
            for (int i = 0; i < 4; ++i)
#pragma unroll
                for (int j = 0; j < 4; ++j) acc[i][j] = fmaf(a[i], b[j], acc[i][j]); }
        __syncthreads();
    }
#pragma unroll
    for (int i = 0; i < 4; ++i) { const int r = m0 + ty * 4 + i; if (r < M) { const int ent = list[(size_t)e * T + r]; const float2 w2 = rw[ent >> 1]; const float w = (ent & 1) ? w2.y : w2.x;
#pragma unroll
        for (int j = 0; j < 4; ++j) ybuf[(size_t)ent * 1024 + n0 + tx * 4 + j] = f2bf(w * acc[i][j]); } }
}
__global__ __launch_bounds__(256) void k_final(float* __restrict__ yout, const float2* __restrict__ stats, const float* __restrict__ g1, const float* __restrict__ b1, const bf16_t* __restrict__ ybuf,
                                               const float* __restrict__ g2, const float* __restrict__ b2) {
    const int lane = threadIdx.x & 63; const int t = blockIdx.x * 4 + (threadIdx.x >> 6);
    float* yr = yout + (size_t)t * 1024; const float2 st = stats[t]; float xv[16]; float s = 0.f;
#pragma unroll
    for (int j = 0; j < 4; ++j) { const int c0 = j * 256 + lane * 4; const f32x4 vv = *(const f32x4*)(yr + c0); const f32x4 gg = *(const f32x4*)(g1 + c0); const f32x4 bb = *(const f32x4*)(b1 + c0);
        const uint2 a = *(const uint2*)(ybuf + (size_t)(2 * t) * 1024 + c0); const uint2 b = *(const uint2*)(ybuf + (size_t)(2 * t + 1) * 1024 + c0);
        const float ya[4] = {__uint_as_float(a.x << 16), __uint_as_float(a.x & 0xffff0000u), __uint_as_float(a.y << 16), __uint_as_float(a.y & 0xffff0000u)};
        const float yb[4] = {__uint_as_float(b.x << 16), __uint_as_float(b.x & 0xffff0000u), __uint_as_float(b.y << 16), __uint_as_float(b.y & 0xffff0000u)};
#pragma unroll
        for (int i = 0; i < 4; ++i) { const float x1 = (vv[i] - st.x) * st.y * gg[i] + bb[i]; const float val = ALPHA * x1 + (ya[i] + yb[i]); xv[4 * j + i] = val; s += val; } }
    const float mu = wave_sum(s) * (1.f / 1024.f); float s2 = 0.f;
#pragma unroll
    for (int i = 0; i < 16; ++i) { const float d = xv[i] - mu; s2 += d * d; }
    const float rstd = 1.0f / sqrtf(wave_sum(s2) * (1.f / 1024.f) + LN_EPS);
#pragma unroll
    for (int j = 0; j < 4; ++j) { const int c0 = j * 256 + lane * 4; const f32x4 gg = *(const f32x4*)(g2 + c0); const f32x4 bb = *(const f32x4*)(b2 + c0); f32x4 o;
#pragma unroll
        for (int i = 0; i < 4; ++i) o[i] = (xv[4 * j + i] - mu) * rstd * gg[i] + bb[i];
        *(f32x4*)(yr + c0) = o; }
}

#define LAS __attribute__((address_space(3)))
#define GAS __attribute__((address_space(1)))
typedef short bf16x8 __attribute__((ext_vector_type(8)));
typedef unsigned u32x4 __attribute__((ext_vector_type(4)));
typedef unsigned u32x2 __attribute__((ext_vector_type(2)));
typedef GAS unsigned gu32;
#define RLX_AGENT __ATOMIC_RELAXED, __HIP_MEMORY_SCOPE_AGENT
#define LDS_WAIT() asm volatile("s_waitcnt lgkmcnt(0)" ::: "memory")
#define VM_WAIT() asm volatile("s_waitcnt vmcnt(0)" ::: "memory")

constexpr size_t WT_IN = 0;
constexpr size_t WT_A  = WT_IN + (size_t)INW * 1024;
constexpr size_t WT_B  = WT_A + 1024 * 1024;
constexpr size_t WT_O  = WT_B + 1024 * 512;
constexpr size_t WT_GU = WT_O + 1024 * 1024;
constexpr size_t WT_DN = WT_GU + (size_t)NE * 1024 * 1024;
constexpr size_t WT_END = WT_DN + (size_t)NE * 1024 * 512;
static_assert(WT_END * 2 <= 112 * MiB, "weight copies fit");
constexpr size_t MS_WPOOL = 7 * MiB;
constexpr size_t MS_WP = 7 * MiB + 512 * 1024;
constexpr size_t MS_CSBW = 6 * MiB + 1024;
constexpr size_t WS_POOLED = 448 * MiB;

constexpr int CW_CNT = 0;
constexpr int CW_BAR = 1024;

constexpr int NWAVES = 8, NTHREADS = 512;
constexpr int RING_BYTES = 131072, MISC_OFF = RING_BYTES + 320, LDS_BYTES = 147456;

typedef float f32x2_t __attribute__((ext_vector_type(2))); typedef __bf16 bf16x2_t __attribute__((ext_vector_type(2)));
__device__ __forceinline__ unsigned cvt_pk_bf16(float lo, float hi) { f32x2_t v = {lo, hi}; bf16x2_t b = __builtin_convertvector(v, bf16x2_t); return __builtin_bit_cast(unsigned, b); }
__device__ __forceinline__ float bflo(unsigned w) { return __uint_as_float(w << 16); }
__device__ __forceinline__ float bfhi(unsigned w) { return __uint_as_float(w & 0xffff0000u); }

#define XB_TMO      128
#define XB_XCNT(j)  (256  + 64 * (j))
#define XB_XSUB(j)  (1280 + 64 * (j))
#define XB_XGEN(j)  (2304 + 64 * (j))
#define XB_TOP      3328
#define XB_TOPGEN   3392
#define XCD_BAR_WORDS 3456
#define XB_SPIN_CAP (1u << 22)
__device__ __forceinline__ unsigned xb_ld(unsigned* p)              { return __hip_atomic_load(p, __ATOMIC_RELAXED, __HIP_MEMORY_SCOPE_AGENT); }
__device__ __forceinline__ unsigned xb_add(unsigned* p, unsigned v) { return __hip_atomic_fetch_add(p, v, __ATOMIC_RELAXED, __HIP_MEMORY_SCOPE_AGENT); }
__device__ __forceinline__ unsigned xb_xcc_id() { return (unsigned)__builtin_amdgcn_s_getreg((3 << 11) | 20) & 0xFu; }
#define XB_SPIN(cond, bar) do { unsigned _sp = 0; while (cond) { __builtin_amdgcn_s_sleep(1); \
    if ((++_sp & 255u) == 0u) { if (xb_ld(&(bar)[XB_TMO])) break; if (_sp > XB_SPIN_CAP) { atomicAdd(&(bar)[XB_TMO], 1u); break; } } } } while (0)
struct XcdBarrier { unsigned* bar; unsigned x; volatile LAS unsigned* st; };
__device__ __forceinline__ XcdBarrier xcd_barrier_post(unsigned* bar, volatile LAS unsigned* st) {
    XcdBarrier b; b.bar = bar; b.x = xb_xcc_id(); b.st = st;
    if (threadIdx.x == 0) (void)xb_add(&bar[XB_XCNT(b.x)], 1u);
    return b;
}
__device__ __forceinline__ void xcd_barrier_complete(unsigned* bar, unsigned x, unsigned& nloc, unsigned& nx) {
    const unsigned G = gridDim.x * gridDim.y * gridDim.z;
    unsigned sum, cnt, mine, sp = 0u;
    for (;;) {
        sum = 0u; cnt = 0u; mine = 0u;
#pragma unroll
        for (unsigned j = 0; j < 16; ++j) { const unsigned c = xb_ld(&bar[XB_XCNT(j)]); sum += c; cnt += (c > 0u) ? 1u : 0u; mine = (j == x) ? c : mine; }
        if (sum == G) break;
        __builtin_amdgcn_s_sleep(1);
        if ((++sp & 255u) == 0u) { if (xb_ld(&bar[XB_TMO])) break; if (sp > XB_SPIN_CAP) { atomicAdd(&bar[XB_TMO], 1u); break; } }
    }
    nloc = mine > 0u ? mine : 1u; nx = cnt > 0u ? cnt : 1u;
}
__device__ __forceinline__ void xcd_barrier(const XcdBarrier& b) {
    asm volatile("s_waitcnt vmcnt(0)" ::: "memory");
    __syncthreads();
    if (threadIdx.x == 0) {
        unsigned* bar = b.bar;
        __builtin_amdgcn_s_waitcnt(0);
        unsigned nloc = b.st[0], nx = b.st[1];
        if (nloc == 0u) { xcd_barrier_complete(bar, b.x, nloc, nx); b.st[0] = nloc; b.st[1] = nx; }
        const unsigned old = xb_add(&bar[XB_XSUB(b.x)], 1u);
        const unsigned gen = old / nloc;
        if (old + 1u == (gen + 1u) * nloc) {
            __builtin_amdgcn_fence(__ATOMIC_RELEASE, "agent");
            asm volatile("s_waitcnt vmcnt(0)" ::: "memory");
            const unsigned og = xb_add(&bar[XB_TOP], 1u);
            const unsigned tg = og / nx;
            if (og + 1u == (tg + 1u) * nx) xb_add(&bar[XB_TOPGEN], 1u);
            else XB_SPIN(xb_ld(&bar[XB_TOPGEN]) == tg, bar);
            __builtin_amdgcn_fence(__ATOMIC_ACQUIRE, "agent");
            xb_add(&bar[XB_XGEN(b.x)], 1u);
            asm volatile("s_waitcnt vmcnt(0)" ::: "memory");
        } else {
            XB_SPIN(xb_ld(&bar[XB_XGEN(b.x)]) == gen, bar);
            __builtin_amdgcn_fence(__ATOMIC_ACQUIRE, "agent");
            asm volatile("s_waitcnt vmcnt(0)" ::: "memory");
        }
    }
    __syncthreads();
}

namespace g8 {
constexpr int BM = 256, BK = 64, HALF = 128, HTB = HALF * BK * 2, NXCD = 8, WGM = 8;
__host__ __device__ __forceinline__ int lds_byte(int r, int c) { const int st = (r >> 4) * 2 + (c >> 5), rr = r & 15, cc = c & 31, ob = rr * 64 + cc * 2; return st * 1024 + (ob ^ (((ob >> 9) & 1) << 5)); }
__host__ __device__ __forceinline__ void stage_rc(int b, int& R, int& C) { const int st = b / 1024, sb = b % 1024, swz = sb ^ (((sb >> 9) & 1) << 5); R = (st >> 1) * 16 + swz / 64; C = (st & 1) * 32 + (swz % 64) / 2; }
__host__ __device__ __forceinline__ int perm32(int rho) { const int n = rho >> 4, i = rho & 15; return 8 * (i >> 2) + 4 * n + (i & 3); }

struct GUnit { const char* A; const char* B; int pm, pn, e, r0; };

struct DenseOrder {
    const char* Abase; const char* Bbase; int nM, nN, nwg, G, c; size_t tstep;
    __device__ void init(const void* A, const void* Bt, int M, int N, int K, int G_, int c_) { Abase = (const char*)A; Bbase = (const char*)Bt; nM = M / BM; nN = N / BM; nwg = nM * nN; G = G_; c = c_; tstep = (size_t)BM * K * 2; }
    __device__ bool next(int i, GUnit& u) const {
        const long L = (long)i * G + c; if (L >= nwg) return false;
        int wgid = (int)L; { const int q = nwg / NXCD, r = nwg % NXCD, xcd = wgid % NXCD, off = wgid / NXCD; wgid = (xcd < r ? xcd * (q + 1) : r * (q + 1) + (xcd - r) * q) + off; }
        const int nig = WGM * nN, gid = wgid / nig, fm = gid * WGM, gsz = (nM - fm) < WGM ? (nM - fm) : WGM;
        u.pm = fm + ((wgid % nig) % gsz); u.pn = (wgid % nig) / gsz; u.e = 0; u.r0 = 0;
        u.A = Abase + (size_t)u.pm * tstep; u.B = Bbase + (size_t)u.pn * tstep; return true;
    }
    __device__ __forceinline__ unsigned rowoff(const GUnit&, int) const { return 0u; }
};
struct MoeOrder {
    const char* Abase; const char* Bbase; const int* list; const volatile LAS unsigned* tb; const volatile LAS unsigned* cntl; int nwg, G, c; size_t atile, bexp, btile; int gather;
    __device__ bool next(int i, GUnit& u) const {
        const long L = (long)i * G + c; if (L >= nwg) return false;
        int wgid = (int)L; { const int q = nwg / NXCD, r = nwg % NXCD, xcd = wgid % NXCD, off = wgid / NXCD; wgid = (xcd < r ? xcd * (q + 1) : r * (q + 1) + (xcd - r) * q) + off; }
        const int tile = wgid >> 2; u.pn = wgid & 3; u.pm = tile;
        int e = 0; for (int j = 1; j < NE; ++j) e = ((int)tb[j] <= tile) ? j : e;
        e = __builtin_amdgcn_readfirstlane(e); u.e = e; u.r0 = __builtin_amdgcn_readfirstlane((tile - (int)tb[e]) * 256);
        u.A = gather ? Abase : Abase + (size_t)tile * atile; u.B = Bbase + (size_t)e * bexp + (size_t)u.pn * btile; return true;
    }
    __device__ __forceinline__ unsigned rowoff(const GUnit& u, int rr) const {
        const int p = u.r0 + rr; const int tok = (p < (int)cntl[u.e]) ? (list[(size_t)u.e * T + p] >> 1) : 0; return (unsigned)tok * 2048u; }
};

template <class Epi, class Sched, bool ALIGN_EPI, bool GATHER>
__device__ __forceinline__ void gemm_phase(LAS unsigned char* lds, const int K, const Sched& S, const Epi& E) {
    const int tid = threadIdx.x, wid = __builtin_amdgcn_readfirstlane(tid >> 6), lane = tid & 63, wr = wid >> 2, wc = wid & 3, fr = lane & 15, fq = lane >> 4;
    const int nt = K / BK;
    unsigned voffA[2], voffB[2]; int RA[2], CA[2];
#pragma unroll
    for (int i = 0; i < 2; ++i) { int R, C; stage_rc(tid * 16 + i * 8192, R, C); const int Rb = Epi::PERM ? ((R & ~31) + perm32(R & 31)) : R;
        voffA[i] = (unsigned)(R * K + C) * 2u; voffB[i] = (unsigned)(Rb * K + C) * 2u; RA[i] = R; CA[i] = C; }
    const size_t kstep = (size_t)(BK * 2);
    const size_t hstep = (size_t)HALF * K * 2;
    const unsigned ldsw = (unsigned)wid * 1024u;
    const int aoff = lds_byte(wr * 64 + fr, fq * 8), boff = lds_byte(wc * 32 + fr, fq * 8);
#define G8_SA(b, h) (((b) * 2 + (h)) * HTB)
#define G8_SB(b, h) ((4 + (b) * 2 + (h)) * HTB)
#define G8_STAGE(bufoff, gbase, o0, o1) do { \
        __builtin_amdgcn_global_load_lds((const unsigned*)((const char*)(gbase) + (o0)), (LAS unsigned*)(lds + (bufoff) + ldsw), 16, 0, 0); \
        __builtin_amdgcn_global_load_lds((const unsigned*)((const char*)(gbase) + (o1)), (LAS unsigned*)(lds + (bufoff) + ldsw + 8192), 16, 0, 0); } while (0)
#define G8_STAGE_B(bufoff, gbase) G8_STAGE(bufoff, gbase, voffB[0], voffB[1])
#define G8_LDA(dst, b, h) do { _Pragma("unroll") for (int m = 0; m < 4; ++m) _Pragma("unroll") for (int k = 0; k < 2; ++k) dst[m][k] = *(const LAS bf16x8*)(lds + G8_SA(b, h) + aoff + m * 2048 + k * 1024); } while (0)
#define G8_LDB(dst, b, h) do { _Pragma("unroll") for (int n = 0; n < 2; ++n) _Pragma("unroll") for (int k = 0; k < 2; ++k) dst[n][k] = *(const LAS bf16x8*)(lds + G8_SB(b, h) + boff + n * 2048 + k * 1024); } while (0)
#define G8_MMA(ai, bj, At, Bt) do { __builtin_amdgcn_s_setprio(1); _Pragma("unroll") for (int m = 0; m < 4; ++m) _Pragma("unroll") for (int n = 0; n < 2; ++n) _Pragma("unroll") for (int k = 0; k < 2; ++k) \
        acc[ai][bj][m][n] = __builtin_amdgcn_mfma_f32_16x16x32_bf16(Bt[n][k], At[m][k], acc[ai][bj][m][n], 0, 0, 0); __builtin_amdgcn_s_setprio(0); } while (0)
#ifdef G8_DRAIN
#define G8_WAIT_V(n) asm volatile("s_waitcnt vmcnt(0)" ::: "memory")
#else
#define G8_WAIT_V(n) asm volatile("s_waitcnt vmcnt(" #n ")" ::: "memory")
#endif
#define G8_WAIT_L(n) asm volatile("s_waitcnt lgkmcnt(" #n ")" ::: "memory")
#define G8_BAR __builtin_amdgcn_s_barrier()
#define G8_SCHED __builtin_amdgcn_sched_barrier(0)
    GUnit cur, nxt; int ui = 0;
    if (!S.next(0, cur)) return;
    unsigned cao[2][2], nao[2][2];
#pragma unroll
    for (int h = 0; h < 2; ++h)
#pragma unroll
        for (int i = 0; i < 2; ++i) { cao[h][i] = GATHER ? S.rowoff(cur, h * HALF + RA[i]) + (unsigned)CA[i] * 2u : voffA[i] + (unsigned)(h * hstep); nao[h][i] = cao[h][i]; }
    f32x4 acc[2][2][4][2];
#pragma unroll
    for (int a = 0; a < 2; ++a)
#pragma unroll
        for (int b = 0; b < 2; ++b)
#pragma unroll
            for (int m = 0; m < 4; ++m)
#pragma unroll
                for (int n = 0; n < 2; ++n) acc[a][b][m][n] = (f32x4){0.f, 0.f, 0.f, 0.f};
    bf16x8 At[4][2], B0[2][2], B1[2][2];
    const char* cA = cur.A; const char* cB = cur.B;
    G8_STAGE_B(G8_SB(0, 0), cB); G8_STAGE_B(G8_SB(0, 1), cB + hstep); G8_STAGE(G8_SA(0, 0), cA, cao[0][0], cao[0][1]); G8_STAGE(G8_SA(0, 1), cA, cao[1][0], cao[1][1]);
    if (wr == 1) G8_BAR;
    G8_WAIT_V(2); G8_BAR;
    G8_STAGE_B(G8_SB(1, 0), cB + kstep); G8_STAGE(G8_SA(1, 0), cA + kstep, cao[0][0], cao[0][1]); G8_STAGE_B(G8_SB(1, 1), cB + hstep + kstep);
    G8_WAIT_V(6); G8_BAR;
    for (;;) {
        const bool has_next = S.next(ui + 1, nxt);
        if (GATHER && has_next) {
#pragma unroll
            for (int h = 0; h < 2; ++h)
#pragma unroll
                for (int i = 0; i < 2; ++i) nao[h][i] = S.rowoff(nxt, h * HALF + RA[i]) + (unsigned)CA[i] * 2u;
        }
        const char* nA = has_next ? nxt.A : cA; const char* nB = has_next ? nxt.B : cB;
        for (int t = 0; t < nt; t += 2) {
            const bool last = (t == nt - 2);
            const char* a1 = cA + (size_t)(t + 1) * kstep;
            const char* a2 = last ? nA : cA + (size_t)(t + 2) * kstep; const char* b2 = last ? nB : cB + (size_t)(t + 2) * kstep;
            const char* a3 = a2 + kstep; const char* b3 = b2 + kstep;
            asm volatile("" : "+s"(a1), "+s"(a2), "+s"(b2), "+s"(a3), "+s"(b3));
            unsigned o2[2][2];
#pragma unroll
            for (int h = 0; h < 2; ++h)
#pragma unroll
                for (int i = 0; i < 2; ++i) o2[h][i] = (GATHER && last && has_next) ? nao[h][i] : cao[h][i];
            G8_LDB(B0, 0, 0); G8_LDB(B1, 0, 1); G8_SCHED; G8_LDA(At, 0, 0); G8_STAGE(G8_SA(1, 1), a1, cao[1][0], cao[1][1]);
            G8_WAIT_V(8); G8_WAIT_L(0); G8_BAR; G8_MMA(0, 0, At, B0); G8_MMA(0, 1, At, B1); G8_BAR; G8_SCHED;
            G8_LDA(At, 0, 1); G8_STAGE_B(G8_SB(0, 0), b2); G8_STAGE_B(G8_SB(0, 1), b2 + hstep); G8_STAGE(G8_SA(0, 0), a2, o2[0][0], o2[0][1]);
            G8_WAIT_V(8); G8_WAIT_L(0); G8_BAR; G8_MMA(1, 0, At, B0); G8_MMA(1, 1, At, B1); G8_BAR; G8_SCHED;
            G8_LDB(B0, 1, 0); G8_LDB(B1, 1, 1); G8_SCHED; G8_LDA(At, 1, 0); G8_STAGE(G8_SA(0, 1), a2, o2[1][0], o2[1][1]);
            G8_WAIT_V(8); G8_WAIT_L(0); G8_BAR; G8_MMA(0, 0, At, B0); G8_MMA(0, 1, At, B1); G8_BAR; G8_SCHED;
            G8_LDA(At, 1, 1); G8_STAGE_B(G8_SB(1, 0), b3); G8_STAGE_B(G8_SB(1, 1), b3 + hstep); G8_STAGE(G8_SA(1, 0), a3, o2[0][0], o2[0][1]);
            G8_WAIT_V(8); G8_WAIT_L(0); G8_BAR; G8_MMA(1, 0, At, B0); G8_MMA(1, 1, At, B1); G8_BAR; G8_SCHED;
        }
        if constexpr (ALIGN_EPI) { if (wr == 0) G8_BAR; }
        {
          GUnit eu = cur; int fr_ = fr, fq_ = fq; asm volatile("" : "+s"(eu.pm), "+s"(eu.pn), "+s"(eu.e), "+s"(eu.r0)); asm volatile("" : "+v"(fr_), "+v"(fq_));
          E(acc, eu, wr, wc, fr_, fq_); }
        if (!has_next) break;
#pragma unroll
        for (int a = 0; a < 2; ++a)
#pragma unroll
            for (int b = 0; b < 2; ++b)
#pragma unroll
                for (int m = 0; m < 4; ++m)
#pragma unroll
                    for (int n = 0; n < 2; ++n) acc[a][b][m][n] = (f32x4){0.f, 0.f, 0.f, 0.f};
        cur = nxt; cA = nA; cB = nB; ++ui;
#pragma unroll
        for (int h = 0; h < 2; ++h)
#pragma unroll
            for (int i = 0; i < 2; ++i) cao[h][i] = nao[h][i];
        if constexpr (ALIGN_EPI) { if (wr == 1) G8_BAR; }
    }
    G8_WAIT_V(0);
    if constexpr (!ALIGN_EPI) { if (wr == 0) G8_BAR; }
    G8_BAR;
#undef G8_SA
#undef G8_SB
#undef G8_STAGE
#undef G8_STAGE_B
#undef G8_LDA
#undef G8_LDB
#undef G8_MMA
#undef G8_WAIT_V
#undef G8_WAIT_L
#undef G8_BAR
#undef G8_SCHED
}

__device__ __forceinline__ u32x4 pack8(const f32x4 v0, const f32x4 v1) { u32x4 w; w.x = cvt_pk_bf16(v0[0], v0[1]); w.y = cvt_pk_bf16(v0[2], v0[3]); w.z = cvt_pk_bf16(v1[0], v1[1]); w.w = cvt_pk_bf16(v1[2], v1[3]); return w; }
__device__ __forceinline__ float sigmoidf_(float v) { return __builtin_amdgcn_rcpf(1.f + __builtin_amdgcn_exp2f(-1.4426950408889634f * v)); }

struct EpiProj {
    static constexpr bool PERM = true;
    bf16_t *qb, *kb, *vb, *ub, *gb; const float* rope; const float* gate_bias;
    __device__ __forceinline__ void operator()(const f32x4 (&acc)[2][2][4][2], const GUnit& u, int wr, int wc, int fr, int fq) const {
        const int row0 = u.pm * BM + wr * 64 + fr; const int cw = wc * 32 + 8 * fq; const int pn = u.pn;
#ifdef DBG_PLAIN_EPI
        if (pn < 8) { bf16_t* base = (pn < 4 ? qb : kb) + (pn & 3) * 256 + cw;
            for (int ai = 0; ai < 2; ++ai) for (int m = 0; m < 4; ++m) { const int t = row0 + ai * HALF + m * 16; for (int bj = 0; bj < 2; ++bj) *(u32x4*)(base + (size_t)t * 1024 + bj * HALF) = pack8(acc[ai][bj][m][0], acc[ai][bj][m][1]); } }
        else
#endif
        if (pn < 8) {
            bf16_t* base = (pn < 4 ? qb : kb) + (pn & 3) * 256 + cw; const float sc = pn < 4 ? QSCALE : 1.f; const int fi = 16 * (wc & 1) + 4 * fq;
#pragma unroll
            for (int ai = 0; ai < 2; ++ai)
#pragma unroll
                for (int m = 0; m < 4; ++m) { const int t = row0 + ai * HALF + m * 16; const f32x4 cs0 = *(const f32x4*)(rope + ((size_t)t * 32 + fi) * 2), cs1 = *(const f32x4*)(rope + ((size_t)t * 32 + fi) * 2 + 4);
                    const f32x4 c = {cs0[0], cs0[2], cs1[0], cs1[2]}, s = {cs0[1], cs0[3], cs1[1], cs1[3]};
#pragma unroll
                    for (int bj = 0; bj < 2; ++bj) { const f32x4 t1 = acc[ai][bj][m][0], t2 = acc[ai][bj][m][1]; const f32x4 o1 = (t1 * c - t2 * s) * sc, o2 = (t2 * c + t1 * s) * sc;
                        *(u32x4*)(base + (size_t)t * 1024 + bj * HALF) = pack8(o1, o2); } }
        } else if (pn < 14) {
            bf16_t* base; int ld; if (pn < 12) { base = vb + (pn - 8) * 256 + cw; ld = 1024; } else { base = ub + (pn - 12) * 256 + cw; ld = 512; }
#pragma unroll
            for (int ai = 0; ai < 2; ++ai)
#pragma unroll
                for (int m = 0; m < 4; ++m) { const int t = row0 + ai * HALF + m * 16;
#pragma unroll
                    for (int bj = 0; bj < 2; ++bj) *(u32x4*)(base + (size_t)t * ld + bj * HALF) = pack8(acc[ai][bj][m][0], acc[ai][bj][m][1]); }
        }
#ifdef DBG_PLAIN_EPI
        else { const int col0 = (pn - 14) * 256 + cw;
            for (int ai = 0; ai < 2; ++ai) for (int m = 0; m < 4; ++m) { const int t = row0 + ai * HALF + m * 16; for (int bj = 0; bj < 2; ++bj) *(u32x4*)(gb + (size_t)t * 2048 + col0 + bj * HALF) = pack8(acc[ai][bj][m][0], acc[ai][bj][m][1]); } }
#else
        else {
            const int col0 = (pn - 14) * 256 + cw; f32x4 bv[2][2];
#pragma unroll
            for (int bj = 0; bj < 2; ++bj)
#pragma unroll
                for (int n = 0; n < 2; ++n) bv[bj][n] = *(const f32x4*)(gate_bias + col0 + bj * HALF + 4 * n);
#pragma unroll
            for (int ai = 0; ai < 2; ++ai)
#pragma unroll
                for (int m = 0; m < 4; ++m) { const int t = row0 + ai * HALF + m * 16;
#pragma unroll
                    for (int bj = 0; bj < 2; ++bj) { f32x4 v0 = acc[ai][bj][m][0] + bv[bj][0], v1 = acc[ai][bj][m][1] + bv[bj][1];
#pragma unroll
                        for (int j = 0; j < 4; ++j) { v0[j] = sigmoidf_(v0[j]); v1[j] = sigmoidf_(v1[j]); }
                        *(u32x4*)(gb + (size_t)t * 2048 + col0 + bj * HALF) = pack8(v0, v1); } }
        }
#endif
    }
};
struct EpiScaleBf16 {
    static constexpr bool PERM = true;
    bf16_t* O; int ldc; const float* colscale;
    __device__ __forceinline__ void operator()(const f32x4 (&acc)[2][2][4][2], const GUnit& u, int wr, int wc, int fr, int fq) const {
        const int row0 = u.pm * BM + wr * 64 + fr, col0 = u.pn * BM + wc * 32 + 8 * fq; f32x4 sv[2][2];
#pragma unroll
        for (int bj = 0; bj < 2; ++bj)
#pragma unroll
            for (int n = 0; n < 2; ++n) sv[bj][n] = *(const f32x4*)(colscale + col0 + bj * HALF + 4 * n);
#pragma unroll
        for (int ai = 0; ai < 2; ++ai)
#pragma unroll
            for (int m = 0; m < 4; ++m) { bf16_t* rowp = O + (size_t)(row0 + ai * HALF + m * 16) * ldc + col0;
#pragma unroll
                for (int bj = 0; bj < 2; ++bj) *(u32x4*)(rowp + bj * HALF) = pack8(acc[ai][bj][m][0] * sv[bj][0], acc[ai][bj][m][1] * sv[bj][1]); }
    }
};
template <int BR> struct EpiMerge {
    static constexpr bool PERM = true;
    const bf16_t* gates; bf16_t* merged;
    __device__ __forceinline__ void operator()(const f32x4 (&acc)[2][2][4][2], const GUnit& u, int wr, int wc, int fr, int fq) const {
        const int row0 = u.pm * BM + wr * 64 + fr, col0 = u.pn * BM + wc * 32 + 8 * fq;
#pragma unroll
        for (int ai = 0; ai < 2; ++ai)
#pragma unroll
            for (int m = 0; m < 4; ++m) { const size_t t = row0 + ai * HALF + m * 16;
#pragma unroll
                for (int bj = 0; bj < 2; ++bj) { const u32x4 g = *(const u32x4*)(gates + t * 2048 + BR * 1024 + col0 + bj * HALF); bf16_t* mp = merged + t * 1024 + col0 + bj * HALF;
                    f32x4 v0 = acc[ai][bj][m][0], v1 = acc[ai][bj][m][1];
                    v0 = v0 * (f32x4){bflo(g.x), bfhi(g.x), bflo(g.y), bfhi(g.y)}; v1 = v1 * (f32x4){bflo(g.z), bfhi(g.z), bflo(g.w), bfhi(g.w)};
                    if (BR) { const u32x4 p = *(const u32x4*)mp; v0 = v0 + (f32x4){bflo(p.x), bfhi(p.x), bflo(p.y), bfhi(p.y)}; v1 = v1 + (f32x4){bflo(p.z), bfhi(p.z), bflo(p.w), bfhi(p.w)}; }
                    *(u32x4*)mp = pack8(v0, v1); } }
    }
};
struct EpiResid {
    static constexpr bool PERM = false;
    const float* x; float* y;
    __device__ __forceinline__ void operator()(const f32x4 (&acc)[2][2][4][2], const GUnit& u, int wr, int wc, int fr, int fq) const {
        const int row0 = u.pm * BM + wr * 64 + fr, col0 = u.pn * BM + wc * 32 + 4 * fq;
#pragma unroll
        for (int ai = 0; ai < 2; ++ai)
#pragma unroll
            for (int m = 0; m < 4; ++m) { const size_t off = (size_t)(row0 + ai * HALF + m * 16) * 1024 + col0;
#pragma unroll
                for (int bj = 0; bj < 2; ++bj)
#pragma unroll
                    for (int n = 0; n < 2; ++n) { const f32x4 xv = *(const f32x4*)(x + off + bj * HALF + n * 16); *(f32x4*)(y + off + bj * HALF + n * 16) = xv * ALPHA + acc[ai][bj][m][n]; } }
    }
};
struct EpiGateUp {
    static constexpr bool PERM = true;
    bf16_t* h;
    __device__ __forceinline__ void operator()(const f32x4 (&acc)[2][2][4][2], const GUnit& u, int wr, int wc, int fr, int fq) const {
        const int row0 = u.pm * BM + wr * 64 + fr, col0 = u.pn * 128 + wc * 16 + 4 * fq;
#pragma unroll
        for (int ai = 0; ai < 2; ++ai)
#pragma unroll
            for (int m = 0; m < 4; ++m) { bf16_t* rowp = h + (size_t)(row0 + ai * HALF + m * 16) * 512 + col0;
#pragma unroll
                for (int bj = 0; bj < 2; ++bj) { const f32x4 g = acc[ai][bj][m][0], up = acc[ai][bj][m][1]; f32x4 o;
#pragma unroll
                    for (int j = 0; j < 4; ++j) o[j] = g[j] * sigmoidf_(g[j]) * up[j];
                    u32x2 w; w.x = cvt_pk_bf16(o[0], o[1]); w.y = cvt_pk_bf16(o[2], o[3]); *(u32x2*)(rowp + bj * 64) = w; } }
    }
};
struct EpiDown {
    static constexpr bool PERM = true;
    bf16_t* ybuf; const int* list; const float* rw; const volatile LAS unsigned* cntl;
    __device__ __forceinline__ void operator()(const f32x4 (&acc)[2][2][4][2], const GUnit& u, int wr, int wc, int fr, int fq) const {
        const int p0 = u.r0 + wr * 64 + fr, col0 = u.pn * BM + wc * 32 + 8 * fq; const int cn = (int)cntl[u.e];
#pragma unroll
        for (int ai = 0; ai < 2; ++ai)
#pragma unroll
            for (int m = 0; m < 4; ++m) { const int p = p0 + ai * HALF + m * 16;
                if (p < cn) { const int ent = list[(size_t)u.e * T + p]; const float w = rw[ent]; bf16_t* rowp = ybuf + (size_t)ent * 1024 + col0;
#pragma unroll
                    for (int bj = 0; bj < 2; ++bj) *(u32x4*)(rowp + bj * HALF) = pack8(acc[ai][bj][m][0] * w, acc[ai][bj][m][1] * w); } }
    }
};
}

namespace at2 {
using f32x16 = __attribute__((ext_vector_type(16))) float;
using s16x4  = __attribute__((ext_vector_type(4))) short;
constexpr int KB_BYTES = 8192, VB_BYTES = 16384, BUF_BYTES = 2 * KB_BYTES + VB_BYTES;
constexpr int OFF_Q = 3 * BUF_BYTES, OFF_WS = 133120;
#define AT_SBAR() __builtin_amdgcn_sched_barrier(0)
__device__ __forceinline__ int crow(int r, int hi) { return (r & 3) + 8 * (r >> 2) + 4 * hi; }
__device__ __forceinline__ int v_st(int k, int c) { const int kk = (k & ~0xC) | ((k & 4) << 1) | ((k & 8) >> 1); return ((kk >> 3) * 4 + (c >> 5)) * 512 + ((kk & 7) * 32 + (c & 31)) * 2; }
__device__ __forceinline__ int v_rd_base(int lane) { return ((lane & 3) << 3) | (((lane >> 2) & 3) << 6) | (((lane >> 4) & 1) << 5) | (((lane >> 5) & 1) << 8); }
constexpr int v_rd_off(int d0, int ks, int half) { return d0 * 512 + ks * 4096 + half * 2048; }
template <int OFF> __device__ __forceinline__ s16x4 tr_read(int vb) { s16x4 r; asm volatile("ds_read_b64_tr_b16 %0, %1 offset:%2" : "=&v"(r) : "v"(vb), "i"(OFF) : "memory"); return r; }
template <int D0> __device__ __forceinline__ void pv_one(f32x16& od, int vb, bf16x8 pa0, bf16x8 pa1, bf16x8 pa2, bf16x8 pa3) {
    const s16x4 l0 = tr_read<v_rd_off(D0, 0, 0)>(vb), h0 = tr_read<v_rd_off(D0, 0, 1)>(vb), l1 = tr_read<v_rd_off(D0, 1, 0)>(vb), h1 = tr_read<v_rd_off(D0, 1, 1)>(vb);
    const s16x4 l2 = tr_read<v_rd_off(D0, 2, 0)>(vb), h2 = tr_read<v_rd_off(D0, 2, 1)>(vb), l3 = tr_read<v_rd_off(D0, 3, 0)>(vb), h3 = tr_read<v_rd_off(D0, 3, 1)>(vb);
    asm volatile("s_waitcnt lgkmcnt(0)" ::: "memory"); AT_SBAR();
#define AT_PK(L, H) (bf16x8){L[0], L[1], L[2], L[3], H[0], H[1], H[2], H[3]}
    od = __builtin_amdgcn_mfma_f32_32x32x16_bf16(pa0, AT_PK(l0, h0), od, 0, 0, 0);
    od = __builtin_amdgcn_mfma_f32_32x32x16_bf16(pa1, AT_PK(l1, h1), od, 0, 0, 0);
    od = __builtin_amdgcn_mfma_f32_32x32x16_bf16(pa2, AT_PK(l2, h2), od, 0, 0, 0);
    od = __builtin_amdgcn_mfma_f32_32x32x16_bf16(pa3, AT_PK(l3, h3), od, 0, 0, 0);
#undef AT_PK
}
__device__ __forceinline__ void qkt(f32x16& p0, f32x16& p1, const LAS unsigned char* Ks, const bf16x8* qr, int r32, int hi) {
    p0 = f32x16{}; p1 = f32x16{};
#pragma unroll
    for (int d0 = 0; d0 < 4; ++d0) { const LAS unsigned char* kp = Ks + (2 * d0 + hi) * 1024 + r32 * 16;
        const bf16x8 b0 = *(const LAS bf16x8*)(kp), b1 = *(const LAS bf16x8*)(kp + 512);
        p0 = __builtin_amdgcn_mfma_f32_32x32x16_bf16(b0, qr[d0], p0, 0, 0, 0);
        p1 = __builtin_amdgcn_mfma_f32_32x32x16_bf16(b1, qr[d0], p1, 0, 0, 0); }
}
__device__ __forceinline__ float hswap_max(float v) { auto rr = __builtin_amdgcn_permlane32_swap(__float_as_uint(v), __float_as_uint(v), false, false); return fmaxf(__uint_as_float(rr[0]), __uint_as_float(rr[1])); }
__device__ __forceinline__ float hswap_sum(float v) { auto rr = __builtin_amdgcn_permlane32_swap(__float_as_uint(v), __float_as_uint(v), false, false); return __uint_as_float(rr[0]) + __uint_as_float(rr[1]); }

__device__ __forceinline__ void attn_unit(LAS unsigned char* lds, int b, int head, int qblk, const bf16_t* __restrict__ Q, const bf16_t* __restrict__ K, const bf16_t* __restrict__ V,
                                          bf16_t* __restrict__ O, const float lam, const float* __restrict__ gain) {
    const int tid = threadIdx.x, lane = tid & 63, r32 = lane & 31, hi = lane >> 5; const int wid = __builtin_amdgcn_readfirstlane(tid >> 6); const int mp = wid >> 2, wq = wid & 3;
    const int hm = head * 2 + mp; const size_t rowbase = (size_t)b * SEQ; const int q0 = qblk * 128;
    const int mychunk = 2 * qblk + (wq >> 1); const int NT = 2 * qblk + 2;
    LAS float* wsf = (LAS float*)(lds + OFF_WS) + wid * 64;
    LAS unsigned char* qlds = lds + OFF_Q + wid * 4096 + hi * 512 + r32 * 16;
    { const bf16_t* qp = Q + (rowbase + q0 + wq * 32 + r32) * 1024 + hm * 64 + hi * 8;
#pragma unroll
      for (int d0 = 0; d0 < 4; ++d0) *(LAS bf16x8*)(qlds + d0 * 1024) = *(const bf16x8*)(qp + d0 * 16); }
    const int kr = tid >> 3, kc = tid & 7, vr = tid >> 4, vc = (tid & 15) * 8;
    const char* Kb = (const char*)(K + rowbase * 1024); const char* Vb = (const char*)(V + rowbase * 1024);
    const unsigned koff = (unsigned)(kr * 2048 + head * 256 + kc * 16), voff = (unsigned)(vr * 2048 + head * 256 + vc * 2);
    const int kst = kc * 1024 + kr * 16, vst0 = v_st(vr, vc), vst1 = v_st(32 + vr, vc);
    bf16x8 sk0, sk1, sv0, sv1;
#define AT_LOAD(j) do { const char* kj_ = Kb + (size_t)(j) * 131072; const char* vj_ = Vb + (size_t)(j) * 131072; sk0 = *(const bf16x8*)(kj_ + koff); sk1 = *(const bf16x8*)(kj_ + 128 + koff); \
        sv0 = *(const bf16x8*)(vj_ + voff); sv1 = *(const bf16x8*)(vj_ + 65536 + voff); } while (0)
#define AT_WRITE(s) do { LAS unsigned char* bs_ = lds + (s) * BUF_BYTES; *(LAS bf16x8*)(bs_ + kst) = sk0; *(LAS bf16x8*)(bs_ + KB_BYTES + kst) = sk1; \
        *(LAS bf16x8*)(bs_ + 2 * KB_BYTES + vst0) = sv0; *(LAS bf16x8*)(bs_ + 2 * KB_BYTES + vst1) = sv1; } while (0)
    float mhat = 0.f, l_reg = 0.f; f32x16 o[4] = {};
    const int vb0 = (int)(uintptr_t)(lds + 2 * KB_BYTES) + v_rd_base(lane);
    const LAS unsigned char* kb0 = lds + mp * KB_BYTES;
    constexpr float THR = 8.f;
    f32x16 pA0, pA1, pB0, pB1; float alA = 1.f, alB = 1.f; bool rsA = false, rsB = false;
    int sl_prev = 0, sl_cur = 0, sl_next = BUF_BYTES;
#define AT_ROT() do { sl_prev = sl_cur; sl_cur = sl_next; sl_next = (sl_next == 2 * BUF_BYTES) ? 0 : sl_next + BUF_BYTES; } while (0)
#define AT_QKT(P0, P1, SL) do { const LAS unsigned char* kp_ = kb0 + (SL) + hi * 1024 + r32 * 16; P0 = f32x16{}; P1 = f32x16{}; \
        _Pragma("unroll") for (int d0 = 0; d0 < 4; ++d0) { const bf16x8 b0_ = *(const LAS bf16x8*)(kp_ + d0 * 2048), b1_ = *(const LAS bf16x8*)(kp_ + d0 * 2048 + 512), q_ = *(const LAS bf16x8*)(qlds + d0 * 1024); \
            P0 = __builtin_amdgcn_mfma_f32_32x32x16_bf16(b0_, q_, P0, 0, 0, 0); P1 = __builtin_amdgcn_mfma_f32_32x32x16_bf16(b1_, q_, P1, 0, 0, 0); } } while (0)
#define AT_PSM(P0, P1, AL, RS, FIRST) do { float pm_ = P0[0]; _Pragma("unroll") for (int r = 1; r < 16; ++r) pm_ = fmaxf(pm_, P0[r]); _Pragma("unroll") for (int r = 0; r < 16; ++r) pm_ = fmaxf(pm_, P1[r]); \
        pm_ = hswap_max(pm_) - mhat; RS = (FIRST) || __any(pm_ > THR); AL = 1.f; \
        if (RS) { const float dl_ = (FIRST) ? pm_ : fmaxf(pm_, 0.f); mhat += dl_; AL = __builtin_amdgcn_exp2f(-dl_); } \
        _Pragma("unroll") for (int r = 0; r < 16; ++r) { P0[r] = __builtin_amdgcn_exp2f(P0[r] - mhat); P1[r] = __builtin_amdgcn_exp2f(P1[r] - mhat); } } while (0)
#define AT_PK4(P, BASE, OUT) do { const unsigned a0 = cvt_pk_bf16(P[BASE + 0], P[BASE + 1]), a1 = cvt_pk_bf16(P[BASE + 2], P[BASE + 3]); \
        const unsigned b0 = cvt_pk_bf16(P[BASE + 4], P[BASE + 5]), b1 = cvt_pk_bf16(P[BASE + 6], P[BASE + 7]); \
        auto r0_ = __builtin_amdgcn_permlane32_swap(a0, b0, false, false); auto r1_ = __builtin_amdgcn_permlane32_swap(a1, b1, false, false); \
        u32x4 w_ = {r0_[0], r1_[0], r0_[1], r1_[1]}; OUT = __builtin_bit_cast(bf16x8, w_); } while (0)
#define AT_FIN_PV(P0, P1, AL, SL) do { float ps_ = 0.f; _Pragma("unroll") for (int r = 0; r < 16; ++r) ps_ += P0[r]; _Pragma("unroll") for (int r = 0; r < 16; ++r) ps_ += P1[r]; \
        ps_ = hswap_sum(ps_); l_reg = l_reg * (AL) + ps_; bf16x8 pa0, pa1, pa2, pa3; AT_PK4(P0, 0, pa0); AT_PK4(P0, 8, pa1); AT_PK4(P1, 0, pa2); AT_PK4(P1, 8, pa3); const int vb_ = vb0 + (SL); \
        pv_one<0>(o[0], vb_, pa0, pa1, pa2, pa3); pv_one<1>(o[1], vb_, pa0, pa1, pa2, pa3); pv_one<2>(o[2], vb_, pa0, pa1, pa2, pa3); pv_one<3>(o[3], vb_, pa0, pa1, pa2, pa3); } while (0)
#define AT_RESC(AL, RS) do { if (RS) { if (hi == 0) wsf[r32] = (AL); asm volatile("s_waitcnt lgkmcnt(0)" ::: "memory"); \
        _Pragma("unroll") for (int r = 0; r < 16; ++r) { const float a_ = wsf[crow(r, hi)]; _Pragma("unroll") for (int d = 0; d < 4; ++d) o[d][r] *= a_; } } } while (0)
#define AT_ITER(t, PC0, PC1, ALC, RSC, PP0, PP1, ALP, RSP) do { const bool nx_ = (t) + 1 < NT; if (nx_) AT_LOAD((t) + 1); \
        const bool actA_ = (t) <= mychunk, actB_ = (t) - 1 <= mychunk; \
        if (actA_) AT_QKT(PC0, PC1, sl_cur); \
        if (actB_) AT_FIN_PV(PP0, PP1, ALP, sl_prev); \
        if (actA_) { AT_PSM(PC0, PC1, ALC, RSC, false); AT_RESC(ALC, RSC); } \
        if (nx_) AT_WRITE_AT(sl_next); __syncthreads(); AT_ROT(); } while (0)
#define AT_WRITE_AT(OFFB) do { LAS unsigned char* bs_ = lds + (OFFB); *(LAS bf16x8*)(bs_ + kst) = sk0; *(LAS bf16x8*)(bs_ + KB_BYTES + kst) = sk1; \
        *(LAS bf16x8*)(bs_ + 2 * KB_BYTES + vst0) = sv0; *(LAS bf16x8*)(bs_ + 2 * KB_BYTES + vst1) = sv1; } while (0)
    AT_LOAD(0); AT_WRITE_AT(0); __syncthreads();
    { AT_LOAD(1); AT_QKT(pA0, pA1, sl_cur); AT_PSM(pA0, pA1, alA, rsA, true); alA = 1.f; rsA = false; AT_WRITE_AT(sl_next); __syncthreads(); AT_ROT(); }
    int t = 1;
    for (; t + 1 < NT; t += 2) {
        AT_ITER(t, pB0, pB1, alB, rsB, pA0, pA1, alA, rsA);
        AT_ITER(t + 1, pA0, pA1, alA, rsA, pB0, pB1, alB, rsB);
    }
    AT_ITER(t, pB0, pB1, alB, rsB, pA0, pA1, alA, rsA);
    if (NT - 1 <= mychunk) AT_FIN_PV(pB0, pB1, alB, sl_prev);
    __syncthreads();
#undef AT_LOAD
#undef AT_WRITE
#undef AT_ROT
#undef AT_QKT
#undef AT_PSM
#undef AT_PK4
#undef AT_FIN_PV
#undef AT_RESC
#undef AT_ITER
#undef AT_WRITE_AT
    if (hi == 0) wsf[r32] = 1.f / l_reg;
    asm volatile("s_waitcnt lgkmcnt(0)" ::: "memory");
    float rli[16];
#pragma unroll
    for (int r = 0; r < 16; ++r) rli[r] = wsf[crow(r, hi)];
    LAS float* xch = (LAS float*)lds + wq * 4096;
    if (mp == 1) {
#pragma unroll
        for (int d = 0; d < 4; ++d)
#pragma unroll
            for (int r = 0; r < 16; ++r) xch[(d * 16 + r) * 64 + lane] = o[d][r] * rli[r];
    }
    __syncthreads();
    if (mp == 0) {
#pragma unroll
        for (int d = 0; d < 4; ++d)
#pragma unroll
            for (int r = 0; r < 16; ++r) { const float v2 = xch[(d * 16 + r) * 64 + lane]; o[d][r] = o[d][r] * rli[r] - lam * v2; }
    }
    __syncthreads();
    LAS float* stg = (LAS float*)lds + wq * 4224;
    if (mp == 0) {
#pragma unroll
        for (int d = 0; d < 4; ++d)
#pragma unroll
            for (int r = 0; r < 16; ++r) stg[crow(r, hi) * 132 + d * 32 + r32] = o[d][r];
        asm volatile("s_waitcnt lgkmcnt(0)" ::: "memory");
        const int row = lane >> 1, ch = (lane & 1) * 64; const LAS float* sp = stg + row * 132 + ch; float vv[64]; float ss = 0.f;
#pragma unroll
        for (int i = 0; i < 16; ++i) { const f32x4 t4 = *(const LAS f32x4*)(sp + 4 * i); vv[4 * i] = t4[0]; vv[4 * i + 1] = t4[1]; vv[4 * i + 2] = t4[2]; vv[4 * i + 3] = t4[3]; ss += (t4[0] * t4[0] + t4[1] * t4[1]) + (t4[2] * t4[2] + t4[3] * t4[3]); }
        ss += __shfl_xor(ss, 1);
        const float rs = (1.0f / sqrtf(ss * (1.f / 128.f) + RMS_EPS)) * (1.f - LAMBDA_INIT);
        bf16_t* op = O + (rowbase + q0 + wq * 32 + row) * 1024 + head * 128 + ch; const float* gp = gain + ch;
#pragma unroll
        for (int i = 0; i < 8; ++i) { const f32x4 g0 = *(const f32x4*)(gp + 8 * i), g1 = *(const f32x4*)(gp + 8 * i + 4); u32x4 w;
            w.x = cvt_pk_bf16(vv[8 * i] * rs * g0[0], vv[8 * i + 1] * rs * g0[1]); w.y = cvt_pk_bf16(vv[8 * i + 2] * rs * g0[2], vv[8 * i + 3] * rs * g0[3]);
            w.z = cvt_pk_bf16(vv[8 * i + 4] * rs * g1[0], vv[8 * i + 5] * rs * g1[1]); w.w = cvt_pk_bf16(vv[8 * i + 6] * rs * g1[2], vv[8 * i + 7] * rs * g1[3]);
            *(u32x4*)(op + 8 * i) = w; }
    }
    __syncthreads();
}
__device__ __forceinline__ void attn_phase(LAS unsigned char* lds, int vcu, int ncu, const bf16_t* Q, const bf16_t* K, const bf16_t* V, bf16_t* O, const float* scal, const float* gain) {
    const float lam = scal[0];
    for (int bh = vcu >> 1; bh < NB * NHEAD; bh += (ncu >> 1)) {
        const int b = bh >> 3, head = bh & 7;
        for (int i = 0; i < 8; ++i) { const int s = (vcu & 1) + 2 * (i >> 1); const int qblk = (i & 1) ? 15 - s : s;
            attn_unit(lds, b, head, qblk, Q, K, V, O, lam, gain); }
    }
}
#undef AT_SBAR
}

struct MKArgs { const void* in[21]; float* out; unsigned char* ws; unsigned mask; unsigned li; };
enum { PH_PRO = 0, PH_G1, PH_POOLA, PH_ATT, PH_POOLG, PH_G4A, PH_G4B, PH_G5, PH_ROUTER, PH_G7, PH_G8, PH_FINAL, PH_N };

template <int MODE> __device__ __forceinline__ int dest_row(int n) {
    if (MODE == 1) return n < 2048 ? (n & ~63) + qk_pos_of_d(n & 63) : n;
    if (MODE == 2) { const int nn = n >> 9, hc = n & 511; return (hc >> 7) * 256 + ((hc >> 6) & 1) * 128 + ((hc >> 4) & 3) * 32 + ((hc >> 2) & 3) * 8 + nn * 4 + (hc & 3); }
    return n;
}
template <int MODE> __device__ __forceinline__ void transpose_item(const float* __restrict__ W, int ldw, int N, bf16_t* __restrict__ WT, int ldt, int coloff, int rowoff, LAS float* scr, int item, int lane) {
    const int nblk = N / 32, kb = item / nblk, nb = item % nblk, k0 = 64 * kb, n0 = 32 * nb;
#pragma unroll 8
    for (int i = 0; i < 32; ++i) { const int kk = 2 * i + (lane >> 5); scr[kk * 33 + (lane & 31)] = W[(size_t)(k0 + kk) * ldw + n0 + (lane & 31)]; }
    LDS_WAIT(); asm volatile("" ::: "memory");
    const int c = lane & 7;
#pragma unroll
    for (int j = 0; j < 4; ++j) { const int n = (lane >> 3) + 8 * j; const LAS float* s = scr + (8 * c) * 33 + n;
        u32x4 o; o.x = cvt_pk_bf16(s[0 * 33], s[1 * 33]); o.y = cvt_pk_bf16(s[2 * 33], s[3 * 33]); o.z = cvt_pk_bf16(s[4 * 33], s[5 * 33]); o.w = cvt_pk_bf16(s[6 * 33], s[7 * 33]);
        *(u32x4*)(WT + (size_t)(rowoff + dest_row<MODE>(n0 + n)) * ldt + coloff + k0 + 8 * c) = o; }
    LDS_WAIT(); asm volatile("" ::: "memory");
}

__global__ void __launch_bounds__(NTHREADS, 2) mk_fwd(MKArgs args) {
    __shared__ __attribute__((aligned(16))) unsigned char lds_raw[LDS_BYTES];
    LAS unsigned char* lds = (LAS unsigned char*)lds_raw;
    volatile LAS unsigned* MISC = (volatile LAS unsigned*)(lds + MISC_OFF);
    const int tid = threadIdx.x, lane = tid & 63, wave = __builtin_amdgcn_readfirstlane(tid >> 6);
    const int G = gridDim.x; const int bx = blockIdx.x; const int vcu = (G % 8 == 0) ? (bx % 8) * (G / 8) + bx / 8 : bx;
    const unsigned mask = args.mask;
    unsigned char* const ws = args.ws; float* const out = args.out;
#define IN_F(k) ((const float*)args.in[k])
#define x_ IN_F(0)
#define positions ((const int*)args.in[1])
#define w_in IN_F(2)
#define gate_bias IN_F(3)
#define lam_vecs IN_F(4)
#define subln_gain IN_F(5)
#define w_pool IN_F(6)
#define pool_scale IN_F(7)
#define w_branch_a IN_F(8)
#define w_branch_b IN_F(9)
#define w_out IN_F(10)
#define ln1_g IN_F(11)
#define ln1_b IN_F(12)
#define wrg IN_F(13)
#define brg IN_F(14)
#define wre IN_F(15)
#define bre IN_F(16)
#define wgu IN_F(17)
#define wdn IN_F(18)
#define ln2_g IN_F(19)
#define ln2_b IN_F(20)
#define wt ((bf16_t*)(ws + WS_WT))
#define xb ((bf16_t*)(ws + WS_XB))
#define qb ((bf16_t*)(ws + WS_Q))
#define kb ((bf16_t*)(ws + WS_K))
#define vb ((bf16_t*)(ws + WS_V))
#define ub ((bf16_t*)(ws + WS_U))
#define gb ((bf16_t*)out)
#define on ((bf16_t*)(ws + WS_ON))
#define mixed ((bf16_t*)(ws + WS_MIXED))
#define merged ((bf16_t*)(ws + WS_MERGED))
#define x1b ((bf16_t*)(ws + WS_X1B))
#define hb ((bf16_t*)(ws + WS_H))
#define ybuf ((bf16_t*)(ws + WS_YBUF))
#define rope ((float*)(ws + WS_ROPE))
#define pooled ((bf16_t*)(ws + WS_POOLED))
#define misc (ws + WS_MISC)
#define ctl ((unsigned*)(misc + MS_CTL))
#define stats ((float2*)(misc + MS_STATS))
#define rw ((float*)(misc + MS_ROUTE + (size_t)T * 8))
#define list ((int*)(misc + MS_LIST))
#define scal ((float*)(misc + MS_SCAL))
#define cnt (ctl + CW_CNT)
#define wpool_bd ((bf16_t*)(misc + MS_WPOOL))

    for (int u = tid; u < (LDS_BYTES - RING_BYTES) / 4; u += NTHREADS) ((LAS unsigned*)(lds + RING_BYTES))[u] = 0u;
    __syncthreads();
    XcdBarrier bar; bar.bar = ctl + CW_BAR + args.li * XCD_BAR_WORDS; bar.x = 0; bar.st = nullptr;
    const bool multi = (mask & (mask - 1u)) != 0u;
    if (multi) bar = xcd_barrier_post(ctl + CW_BAR + args.li * XCD_BAR_WORDS, MISC + 8);
#ifndef MK_CT
#define MK_CT 0xfffu
#endif
#define HAS(p) (((MK_CT >> (p)) & 1u) && ((mask >> (p)) & 1u))
#ifndef MK_REP
#define MK_REP 0u
#endif
#define REPS(p) for (int rep_ = 0; rep_ < ((((MK_REP) >> (p)) & 1u) ? 2 : 1); ++rep_)
#define SEAM(p) do { if (multi && (mask >> ((p) + 1)) != 0u) xcd_barrier(bar); } while (0)
    const int gw = vcu * NWAVES + wave, NGW = G * NWAVES;

    if (HAS(PH_PRO)) {
        LAS float* scr = (LAS float*)(lds + wave * 16384);
        constexpr int I_IN = 16 * (INW / 32), I_A = 16 * 32, I_B = 8 * 32, I_O = 16 * 32, I_GU = 16 * 32, I_DN = 8 * 32, I_P = 2 * 4;
        constexpr int NITEMS = I_IN + I_A + I_B + I_O + NE * I_GU + NE * I_DN + PG * I_P;
        for (int it = gw; it < NITEMS; it += NGW) {
            int r = it;
            if (r < I_IN) { transpose_item<1>(w_in, INW, INW, wt + WT_IN, 1024, 0, 0, scr, r, lane); continue; } r -= I_IN;
            if (r < I_A) { transpose_item<0>(w_branch_a, 1024, 1024, wt + WT_A, 1024, 0, 0, scr, r, lane); continue; } r -= I_A;
            if (r < I_B) { transpose_item<0>(w_branch_b, 1024, 1024, wt + WT_B, 512, 0, 0, scr, r, lane); continue; } r -= I_B;
            if (r < I_O) { transpose_item<0>(w_out, 1024, 1024, wt + WT_O, 1024, 0, 0, scr, r, lane); continue; } r -= I_O;
            if (r < NE * I_GU) { const int e = r / I_GU; transpose_item<2>(wgu + (size_t)e * 1024 * 1024, 1024, 1024, wt + WT_GU + (size_t)e * 1024 * 1024, 1024, 0, 0, scr, r % I_GU, lane); continue; } r -= NE * I_GU;
            if (r < NE * I_DN) { const int e = r / I_DN; transpose_item<0>(wdn + (size_t)e * 512 * 1024, 1024, 1024, wt + WT_DN + (size_t)e * 1024 * 512, 512, 0, 0, scr, r % I_DN, lane); continue; } r -= NE * I_DN;
            { const int g = r / I_P; transpose_item<0>(w_pool + (size_t)g * 128 * 128, 128, 128, wpool_bd, 512, g * 128, g * 128, scr, r % I_P, lane); }
        }
        for (int ch = gw * 64 + lane; ch < 512 * 64; ch += NGW * 64) { const int row = ch >> 6, c8 = (ch & 63) * 8; if ((row >> 7) != (c8 >> 7)) *(u32x4*)(wpool_bd + (size_t)row * 512 + c8) = (u32x4){0u, 0u, 0u, 0u}; }
        for (int m = gw; m < T; m += NGW) { const f32x4* xr = (const f32x4*)(x_ + (size_t)m * 1024) + lane; u32x2* o8 = (u32x2*)(xb + (size_t)m * 1024) + lane;
#pragma unroll
            for (int j = 0; j < 4; ++j) { const f32x4 v = xr[64 * j]; u32x2 w; w.x = cvt_pk_bf16(v[0], v[1]); w.y = cvt_pk_bf16(v[2], v[3]); o8[64 * j] = w; } }
        for (int e = gw * 64 + lane; e < T * 32; e += NGW * 64) { const int t = e >> 5, i = e & 31; const float inv = powf(10000.0f, -(float)i * (2.0f / 64.0f)); const float ang = (float)positions[t] * inv; const double a = (double)ang;
            rope[2 * e] = (float)cos(a); rope[2 * e + 1] = (float)sin(a); }
        if (gw == 0 && lane == 0) { float s01 = 0.f, s23 = 0.f; for (int i = 0; i < 64; ++i) { s01 += lam_vecs[i] * lam_vecs[64 + i]; s23 += lam_vecs[128 + i] * lam_vecs[192 + i]; } scal[0] = expf(s01) - expf(s23) + LAMBDA_INIT; }
        { f32x4* wp = (f32x4*)(misc + MS_WP);
          for (int e = gw * 64 + lane; e < 16 * 3 * 4 * 64; e += NGW * 64) { const int l = e & 63, sg = (e >> 6) & 3, ob = (e >> 8) % 3, chunk = (e >> 8) / 3; const int o = ob * 16 + (l & 15); f32x4 v = {0.f, 0.f, 0.f, 0.f};
              if (o < 36) {
#pragma unroll
                  for (int j = 0; j < 4; ++j) { const int c = chunk * 64 + (l >> 4) * 16 + 4 * sg + j; v[j] = ln1_g[c] * (o < 4 ? wrg[c * 4 + o] : wre[c * 32 + (o - 4)]); } }
              wp[e] = v; }
          float* csbw = (float*)(misc + MS_CSBW);
          if (gw < 48) { const int o = gw; float cs = 0.f, bw = 0.f;
              if (o < 36) { for (int i = 0; i < 16; ++i) { const int c = lane + 64 * i; const float w = (o < 4 ? wrg[c * 4 + o] : wre[c * 32 + (o - 4)]); cs += ln1_g[c] * w; bw += ln1_b[c] * w; }
                  cs = wave_sum(cs); bw = wave_sum(bw) + (o < 4 ? brg[o] : bre[o - 4]); }
              if (lane == 0) { csbw[o] = cs; csbw[48 + o] = bw; } } }
        __syncthreads();
        SEAM(PH_PRO);
    }
    if (HAS(PH_G1)) {
        g8::DenseOrder S; S.init(xb, wt + WT_IN, T, INW, 1024, G, bx);
        g8::EpiProj E{qb, kb, vb, ub, gb, rope, gate_bias};
        g8::gemm_phase<g8::EpiProj, g8::DenseOrder, true, false>(lds, 1024, S, E);
        SEAM(PH_G1);
    }
    if (HAS(PH_POOLA)) {
        for (int e = (gw * 64 + lane); e < T * 64; e += NGW * 64) { const int t = e >> 6, c8 = (e & 63) * 8; const int g = c8 >> 7, w = 2 << g, s = t & (SEQ - 1); const int n = (s + 1 < w) ? s + 1 : w;
            float a[8] = {0.f, 0.f, 0.f, 0.f, 0.f, 0.f, 0.f, 0.f}; float u0[8];
            for (int i = 0; i < n; ++i) { const u32x4 v = *(const u32x4*)(ub + (size_t)(t - i) * 512 + c8); const float f[8] = {bflo(v.x), bfhi(v.x), bflo(v.y), bfhi(v.y), bflo(v.z), bfhi(v.z), bflo(v.w), bfhi(v.w)};
#pragma unroll
                for (int j = 0; j < 8; ++j) { a[j] += f[j]; if (i == 0) u0[j] = f[j]; } }
            const float inv = 1.f / (float)n; u32x4 o; o.x = cvt_pk_bf16(a[0] * inv - u0[0], a[1] * inv - u0[1]); o.y = cvt_pk_bf16(a[2] * inv - u0[2], a[3] * inv - u0[3]);
            o.z = cvt_pk_bf16(a[4] * inv - u0[4], a[5] * inv - u0[5]); o.w = cvt_pk_bf16(a[6] * inv - u0[6], a[7] * inv - u0[7]);
            *(u32x4*)(pooled + (size_t)t * 512 + c8) = o; }
    }
    if (HAS(PH_ATT)) { at2::attn_phase(lds, vcu, G, qb, kb, vb, on, scal, subln_gain); SEAM(PH_ATT); }
    else if (HAS(PH_POOLA)) { SEAM(PH_ATT); }
    if (HAS(PH_POOLG)) {
        g8::DenseOrder S; S.init(pooled, wpool_bd, T, 512, 512, G, bx);
        g8::EpiScaleBf16 E{mixed, 512, pool_scale};
        g8::gemm_phase<g8::EpiScaleBf16, g8::DenseOrder, true, false>(lds, 512, S, E);
    }
    if (HAS(PH_G4A)) {
        g8::DenseOrder S; S.init(on, wt + WT_A, T, 1024, 1024, G, bx);
        g8::EpiMerge<0> E{gb, merged};
        g8::gemm_phase<g8::EpiMerge<0>, g8::DenseOrder, true, false>(lds, 1024, S, E);
        SEAM(PH_G4A);
    } else if (HAS(PH_POOLG)) { SEAM(PH_G4A); }
    if (HAS(PH_G4B)) {
        g8::DenseOrder S; S.init(mixed, wt + WT_B, T, 1024, 512, G, bx);
        g8::EpiMerge<1> E{gb, merged};
        g8::gemm_phase<g8::EpiMerge<1>, g8::DenseOrder, true, false>(lds, 512, S, E);
        SEAM(PH_G4B);
    }
    if (HAS(PH_G5)) {
        g8::DenseOrder S; S.init(merged, wt + WT_O, T, 1024, 1024, G, bx);
        g8::EpiResid E{x_, out};
        g8::gemm_phase<g8::EpiResid, g8::DenseOrder, true, false>(lds, 1024, S, E);
        SEAM(PH_G5);
    }
    if (HAS(PH_ROUTER)) {
        LAS float* lgs = (LAS float*)(lds + 0) + wave * (16 * 49);
        LAS float* tst = (LAS float*)(lds + 32768) + wave * 32;
        LAS int*   tex = (LAS int*)(lds + 36864) + wave * 64;
        LAS unsigned* lcnt = (LAS unsigned*)(lds + 40960);
        const f32x4* wp = (const f32x4*)(misc + MS_WP); const float* csbw = (const float*)(misc + MS_CSBW);
        for (int t0 = vcu * 128; t0 < T; t0 += G * 128) {
            if (tid < 64) lcnt[tid] = 0u;
            __syncthreads();
            const int tw = t0 + wave * 16; const int tk = lane & 15, q = lane >> 4;
            { const float* yr = out + (size_t)(tw + tk) * 1024 + q * 16; float s1 = 0.f, s2 = 0.f;
              f32x4 acc0 = {0.f, 0.f, 0.f, 0.f}, acc1 = {0.f, 0.f, 0.f, 0.f}, acc2 = {0.f, 0.f, 0.f, 0.f};
#pragma unroll 2
              for (int chunk = 0; chunk < 16; ++chunk) { f32x4 yv[4];
#pragma unroll
                  for (int j = 0; j < 4; ++j) yv[j] = *(const f32x4*)(yr + chunk * 64 + 4 * j);
#pragma unroll
                  for (int sg = 0; sg < 4; ++sg) { const f32x4 b0 = wp[((chunk * 3 + 0) * 4 + sg) * 64 + lane], b1 = wp[((chunk * 3 + 1) * 4 + sg) * 64 + lane], b2 = wp[((chunk * 3 + 2) * 4 + sg) * 64 + lane];
#pragma unroll
                      for (int j = 0; j < 4; ++j) { const float a = yv[sg][j]; s1 += a; s2 = fmaf(a, a, s2);
                          acc0 = __builtin_amdgcn_mfma_f32_16x16x4f32(a, b0[j], acc0, 0, 0, 0); acc1 = __builtin_amdgcn_mfma_f32_16x16x4f32(a, b1[j], acc1, 0, 0, 0); acc2 = __builtin_amdgcn_mfma_f32_16x16x4f32(a, b2[j], acc2, 0, 0, 0); } } }
              s1 += __shfl_xor(s1, 16); s1 += __shfl_xor(s1, 32); s2 += __shfl_xor(s2, 16); s2 += __shfl_xor(s2, 32);
              const float mu = s1 * (1.f / 1024.f); const float var = fmaxf(s2 * (1.f / 1024.f) - mu * mu, 0.f); const float rstd = 1.0f / sqrtf(var + LN_EPS);
              if (q == 0) { tst[2 * tk] = mu; tst[2 * tk + 1] = rstd; stats[tw + tk] = make_float2(mu, rstd); }
#pragma unroll
              for (int r = 0; r < 4; ++r) { lgs[(4 * q + r) * 49 + tk] = acc0[r]; lgs[(4 * q + r) * 49 + 16 + tk] = acc1[r]; lgs[(4 * q + r) * 49 + 32 + tk] = acc2[r]; } }
            LDS_WAIT();
            if (lane < 16) { const int t = tw + lane; const float mu = tst[2 * lane], rstd = tst[2 * lane + 1]; const LAS float* lr = lgs + lane * 49;
                float lg[4], le[32];
#pragma unroll
                for (int o = 0; o < 4; ++o) lg[o] = rstd * (lr[o] - mu * csbw[o]) + csbw[48 + o];
#pragma unroll
                for (int o = 0; o < 32; ++o) le[o] = rstd * (lr[4 + o] - mu * csbw[4 + o]) + csbw[48 + 4 + o];
                int gi = 0; float gm = lg[0];
#pragma unroll
                for (int o = 1; o < 4; ++o) if (lg[o] > gm) { gm = lg[o]; gi = o; }
                float gs = 0.f;
#pragma unroll
                for (int o = 0; o < 4; ++o) gs += expf(lg[o] - gm);
                const float gp = 1.f / gs; float ev[8];
#pragma unroll
                for (int o = 0; o < 8; ++o) { float vsel = le[o];
#pragma unroll
                    for (int g = 1; g < 4; ++g) vsel = (gi == g) ? le[g * 8 + o] : vsel;
                    ev[o] = vsel; }
                int i0 = 0; float m0v = ev[0];
#pragma unroll
                for (int o = 1; o < 8; ++o) if (ev[o] > m0v) { m0v = ev[o]; i0 = o; }
                int i1 = (i0 == 0) ? 1 : 0; float m1v = -3.4e38f;
#pragma unroll
                for (int o = 0; o < 8; ++o) if (o != i0 && ev[o] > m1v) { m1v = ev[o]; i1 = o; }
                const float e1 = expf(m1v - m0v); const float w0 = gp / (1.f + e1), w1 = gp * e1 / (1.f + e1);
                const int ex0 = gi * 8 + i0, ex1 = gi * 8 + i1;
                rw[2 * t] = w0; rw[2 * t + 1] = w1;
                const unsigned r0 = __hip_atomic_fetch_add(lcnt + ex0, 1u, __ATOMIC_RELAXED, __HIP_MEMORY_SCOPE_WORKGROUP); const unsigned r1 = __hip_atomic_fetch_add(lcnt + ex1, 1u, __ATOMIC_RELAXED, __HIP_MEMORY_SCOPE_WORKGROUP);
                tex[4 * lane] = ex0; tex[4 * lane + 1] = ex1; tex[4 * lane + 2] = (int)r0; tex[4 * lane + 3] = (int)r1; }
            __syncthreads();
            if (tid < NE) { const unsigned c = lcnt[tid]; lcnt[32 + tid] = c ? atomicAdd(cnt + tid, c) : 0u; }
            __syncthreads();
            if (lane < 16) { const int t = tw + lane; const int ex0 = tex[4 * lane], ex1 = tex[4 * lane + 1];
                list[(size_t)ex0 * T + lcnt[32 + ex0] + (unsigned)tex[4 * lane + 2]] = t * 2; list[(size_t)ex1 * T + lcnt[32 + ex1] + (unsigned)tex[4 * lane + 3]] = t * 2 + 1; }
            for (int i = 0; i < 16; ++i) { const int t = tw + i; const float mu = tst[2 * i], rstd = tst[2 * i + 1]; const float* yr = out + (size_t)t * 1024;
#pragma unroll
                for (int j = 0; j < 4; ++j) { const int c0 = j * 256 + lane * 4; const f32x4 v = *(const f32x4*)(yr + c0), gg = *(const f32x4*)(ln1_g + c0), bb = *(const f32x4*)(ln1_b + c0);
                    u32x2 w; w.x = cvt_pk_bf16((v[0] - mu) * rstd * gg[0] + bb[0], (v[1] - mu) * rstd * gg[1] + bb[1]); w.y = cvt_pk_bf16((v[2] - mu) * rstd * gg[2] + bb[2], (v[3] - mu) * rstd * gg[3] + bb[3]);
                    *(u32x2*)(x1b + (size_t)t * 1024 + c0) = w; } }
            __syncthreads();
        }
        SEAM(PH_ROUTER);
    }
    if (HAS(PH_G7) || HAS(PH_G8)) {
        if (tid < NE) MISC[64 + tid] = __hip_atomic_load(cnt + tid, RLX_AGENT);
        __syncthreads();
        if (tid == 0) { unsigned acc = 0u; for (int e = 0; e < NE; ++e) { MISC[16 + e] = acc; acc += (MISC[64 + e] + 255u) >> 8; } MISC[16 + NE] = acc; }
        __syncthreads();
        const int ntiles = (int)MISC[16 + NE];
        if (HAS(PH_G7)) {
            g8::MoeOrder S{(const char*)x1b, (const char*)(wt + WT_GU), list, MISC + 16, MISC + 64, ntiles * 4, G, bx, 0, (size_t)1024 * 1024 * 2, (size_t)256 * 1024 * 2, 1};
            g8::EpiGateUp E{hb};
            g8::gemm_phase<g8::EpiGateUp, g8::MoeOrder, true, true>(lds, 1024, S, E);
            SEAM(PH_G7);
        }
        if (HAS(PH_G8)) {
            g8::MoeOrder S{(const char*)hb, (const char*)(wt + WT_DN), list, MISC + 16, MISC + 64, ntiles * 4, G, bx, (size_t)256 * 512 * 2, (size_t)1024 * 512 * 2, (size_t)256 * 512 * 2, 0};
            g8::EpiDown E{ybuf, list, rw, MISC + 64};
            g8::gemm_phase<g8::EpiDown, g8::MoeOrder, true, false>(lds, 512, S, E);
            SEAM(PH_G8);
        }
    }
    if (HAS(PH_FINAL)) {
        for (int t = gw; t < T; t += NGW) {
            float* yr = out + (size_t)t * 1024; const float2 st = stats[t]; float xv[16]; float s = 0.f;
#pragma unroll
            for (int j = 0; j < 4; ++j) { const int c0 = j * 256 + lane * 4; const f32x4 vv = *(const f32x4*)(yr + c0); const f32x4 gg = *(const f32x4*)(ln1_g + c0); const f32x4 bb = *(const f32x4*)(ln1_b + c0);
                const u32x2 a = *(const u32x2*)(ybuf + (size_t)(2 * t) * 1024 + c0); const u32x2 b = *(const u32x2*)(ybuf + (size_t)(2 * t + 1) * 1024 + c0);
                const float ya[4] = {bflo(a.x), bfhi(a.x), bflo(a.y), bfhi(a.y)}; const float yb[4] = {bflo(b.x), bfhi(b.x), bflo(b.y), bfhi(b.y)};
#pragma unroll
                for (int i = 0; i < 4; ++i) { const float x1 = (vv[i] - st.x) * st.y * gg[i] + bb[i]; const float val = ALPHA * x1 + (ya[i] + yb[i]); xv[4 * j + i] = val; s += val; } }
            const float mu = wave_sum(s) * (1.f / 1024.f); float s2 = 0.f;
#pragma unroll
            for (int i = 0; i < 16; ++i) { const float d = xv[i] - mu; s2 += d * d; }
            const float rstd = 1.0f / sqrtf(wave_sum(s2) * (1.f / 1024.f) + LN_EPS);
#pragma unroll
            for (int j = 0; j < 4; ++j) { const int c0 = j * 256 + lane * 4; const f32x4 gg = *(const f32x4*)(ln2_g + c0); const f32x4 bb = *(const f32x4*)(ln2_b + c0); f32x4 o;
#pragma unroll
                for (int i = 0; i < 4; ++i) o[i] = (xv[4 * j + i] - mu) * rstd * gg[i] + bb[i];
                *(f32x4*)(yr + c0) = o; }
        }
    }
#undef HAS
#undef SEAM
}
#undef IN_F
#undef x_
#undef positions
#undef w_in
#undef gate_bias
#undef lam_vecs
#undef subln_gain
#undef w_pool
#undef pool_scale
#undef w_branch_a
#undef w_branch_b
#undef w_out
#undef ln1_g
#undef ln1_b
#undef wrg
#undef brg
#undef wre
#undef bre
#undef wgu
#undef wdn
#undef ln2_g
#undef ln2_b
#undef wt
#undef xb
#undef qb
#undef kb
#undef vb
#undef ub
#undef gb
#undef on
#undef mixed
#undef merged
#undef x1b
#undef hb
#undef ybuf
#undef rope
#undef pooled
#undef misc
#undef ctl
#undef stats
#undef rw
#undef list
#undef scal
#undef cnt
#undef wpool_bd


#ifndef MK_OPT
#define MK_OPT 0x003u
#endif
#ifndef MK_M2A
#define MK_M2A 0xff4u
#define MK_M2B 0u
#define MK_M2C 0u
#endif
#ifndef MK_ONE
#define MK_ONE 0
#endif
constexpr unsigned OPT = MK_OPT;
#define OPTP(p) ((OPT >> (p)) & 1u)


#ifdef MK_DEBUG_HASH
__global__ void k_hash(const uint4* __restrict__ p, size_t n16, unsigned long long* __restrict__ outh) {
    unsigned long long h = 0ull;
    for (size_t i = blockIdx.x * (size_t)blockDim.x + threadIdx.x; i < n16; i += (size_t)gridDim.x * blockDim.x) { const uint4 w = p[i];
        const unsigned long long m = (unsigned long long)(i * 2654435761ull + 12345ull) | 1ull;
        h += ((unsigned long long)w.x * 0x9E3779B1ull + (unsigned long long)w.y * 0x85EBCA77ull + (unsigned long long)w.z * 0xC2B2AE3Dull + (unsigned long long)w.w * 0x27D4EB2Full) * m; }
    for (int o = 32; o > 0; o >>= 1) h += __shfl_xor(h, o);
    if ((threadIdx.x & 63) == 0) atomicAdd(outh, h);
}
__global__ void k_poison(float* __restrict__ out, const unsigned long long* __restrict__ hs) {
    float code = 0.f; for (int r = 1; r < 10; ++r) if (hs[r] != hs[0]) code = 1.f;
    if (code == 0.f) return;
    for (size_t i = blockIdx.x * (size_t)blockDim.x + threadIdx.x; i < (size_t)T * DM; i += (size_t)gridDim.x * blockDim.x) out[i] = __builtin_nanf("") * code;
}
#endif
extern "C" void kernel_launch(void* const* d_in, const int* in_sizes, int n_in, void* d_out, int out_size, void* d_ws, size_t ws_size, hipStream_t stream) {
    static int grid = 0;
    if (grid == 0) {
        if (n_in != 21 || in_sizes[0] != T * DM || out_size != T * DM || ws_size < WS_END) { fprintf(stderr, "kernel_launch: unexpected shapes (n_in %d, x %d, out %d, ws %zu)\n", n_in, n_in > 0 ? in_sizes[0] : -1, out_size, ws_size); grid = -1; return; }
        int dev = 0, cus = 0;
        if (hipGetDevice(&dev) != hipSuccess || hipDeviceGetAttribute(&cus, hipDeviceAttributeMultiprocessorCount, dev) != hipSuccess) { fprintf(stderr, "kernel_launch: device query failed\n"); grid = -1; return; }
        int per_cu = 0;
        if (hipOccupancyMaxActiveBlocksPerMultiprocessor(&per_cu, (const void*)mk_fwd, NTHREADS, 0) != hipSuccess || per_cu < 1) fprintf(stderr, "kernel_launch: note: occupancy query reports %d blocks per CU\n", per_cu);
        (void)hipGetLastError();
        grid = cus;
    }
    if (grid < 0) return;
    const float* x = (const float*)d_in[0]; const int* positions = (const int*)d_in[1]; const float* w_in = (const float*)d_in[2]; const float* gate_bias = (const float*)d_in[3];
    const float* lam_vecs = (const float*)d_in[4]; const float* subln_gain = (const float*)d_in[5]; const float* w_pool = (const float*)d_in[6]; const float* pool_scale = (const float*)d_in[7];
    const float* w_branch_a = (const float*)d_in[8]; const float* w_branch_b = (const float*)d_in[9]; const float* w_out = (const float*)d_in[10]; const float* ln1_g = (const float*)d_in[11];
    const float* ln1_b = (const float*)d_in[12]; const float* wrg = (const float*)d_in[13]; const float* brg = (const float*)d_in[14]; const float* wre = (const float*)d_in[15];
    const float* bre = (const float*)d_in[16]; const float* wgu = (const float*)d_in[17]; const float* wdn = (const float*)d_in[18]; const float* ln2_g = (const float*)d_in[19]; const float* ln2_b = (const float*)d_in[20];
    char* ws = (char*)d_ws; float* out = (float*)d_out;
    bf16_t* qb = (bf16_t*)(ws + WS_Q); bf16_t* kb = (bf16_t*)(ws + WS_K); bf16_t* vb = (bf16_t*)(ws + WS_V); bf16_t* ub = (bf16_t*)(ws + WS_U); bf16_t* gb = (bf16_t*)d_out;
    bf16_t* on = (bf16_t*)(ws + WS_ON); bf16_t* mixed = (bf16_t*)(ws + WS_MIXED); bf16_t* merged = (bf16_t*)(ws + WS_MERGED); bf16_t* x1b = (bf16_t*)(ws + WS_X1B);
    bf16_t* hb = (bf16_t*)(ws + WS_H); bf16_t* ybuf = (bf16_t*)(ws + WS_YBUF); float2* rope = (float2*)(ws + WS_ROPE); float* tmp = (float*)(ws + WS_TEMP);
    char* misc = ws + WS_MISC; unsigned* ctl = (unsigned*)(misc + MS_CTL); float2* stats = (float2*)(misc + MS_STATS); int2* rexp = (int2*)(misc + MS_ROUTE); float2* rw = (float2*)(misc + MS_ROUTE + (size_t)T * 8);
    int* list = (int*)(misc + MS_LIST); float* scal = (float*)(misc + MS_SCAL); unsigned* cnt = ctl;

    MKArgs a{}; int nlaunch = 0;
    for (int i = 0; i < 21; ++i) a.in[i] = d_in[i];
    a.out = out; a.ws = (unsigned char*)d_ws;
    if (hipMemsetAsync(ctl, 0, 65536, stream) != hipSuccess) { fprintf(stderr, "kernel_launch: memset failed\n"); return; }
#ifndef MK_REPH
#define MK_REPH 0u
#endif
#define MK(maskv) do { a.mask = (maskv); for (int rr_ = 0; rr_ < (((maskv) & (MK_REPH)) ? 2 : 1); ++rr_) { a.li = (unsigned)(nlaunch++ % 3); hipLaunchKernelGGL(mk_fwd, dim3(grid), dim3(NTHREADS), 0, stream, a); } } while (0)
    if (MK_ONE == 1) { MK((1u << PH_N) - 1u); return; }
    if (MK_ONE == 2) {
        MK(0x003u);
        for (int mh = 0; mh < 2; ++mh) { const int m0 = mh * 16384; nattn<<<(16384 / 64) * 16, 64, 0, stream>>>(qb, kb, vb, scal, tmp, m0); post_rms<<<16384 * 8 / 256, 256, 0, stream>>>(tmp, subln_gain, on, m0, 16384); }
        MK(MK_M2A); if (MK_M2B) MK(MK_M2B); if (MK_M2C) MK(MK_M2C); return; }

    constexpr int MC = 16384;
#if 0
#else
#ifdef MK_TEST_BAR
    MK(0x003u);
#else
    if (OPTP(PH_PRO)) MK(1u << PH_PRO); else k_prep<<<T * 32 / 256, 256, 0, stream>>>(positions, lam_vecs, rope, scal, ctl);
    if (OPTP(PH_G1)) MK(1u << PH_G1);
#endif
#endif
#ifndef MK_OVR
#define MK_OVR 0
#endif
    const int ovr = OPTP(PH_G1) ? MK_OVR : 15;
    for (int mh = 0; mh < 2; ++mh) {
        const int m0 = mh * MC; AL_F32 ax{x + (size_t)m0 * DM, DM, 0};
        if (ovr & 1) for (int qk = 0; qk < 2; ++qk) {
            ngemm<AL_F32><<<dim3(16, MC / 64), 256, 0, stream>>>(ax, w_in + qk * 1024, INW, tmp, 1024, MC, 1024, DM);
            post_qk<<<MC * 512 / 256, 256, 0, stream>>>(tmp, rope, qk ? kb : qb, m0, MC, qk ? 1.f : QSCALE);
        }
        if (ovr & 2) { ngemm<AL_F32><<<dim3(16, MC / 64), 256, 0, stream>>>(ax, w_in + 2048, INW, tmp, 1024, MC, 1024, DM);
        post_plain<<<MC * 1024 / 256, 256, 0, stream>>>(tmp, vb, 1024, 0, m0, MC, 1024, nullptr); }
        if (ovr & 4) { ngemm<AL_F32><<<dim3(8, MC / 64), 256, 0, stream>>>(ax, w_in + 3072, INW, tmp, 512, MC, 512, DM);
        post_plain<<<MC * 512 / 256, 256, 0, stream>>>(tmp, ub, 512, 0, m0, MC, 512, nullptr); }
        if (ovr & 8) for (int br = 0; br < 2; ++br) {
            ngemm<AL_F32><<<dim3(16, MC / 64), 256, 0, stream>>>(ax, w_in + 3584 + br * 1024, INW, tmp, 1024, MC, 1024, DM);
            post_gate<<<MC * 1024 / 256, 256, 0, stream>>>(tmp, gate_bias, gb, br * 1024, m0, MC);
        }
    }
    if (OPTP(PH_ATT)) MK(1u << PH_ATT);
    else for (int mh = 0; mh < 2; ++mh) {
        const int m0 = mh * MC;
        nattn<<<(MC / 64) * 16, 64, 0, stream>>>(qb, kb, vb, scal, tmp, m0);
        post_rms<<<MC * 8 / 256, 256, 0, stream>>>(tmp, subln_gain, on, m0, MC);
    }
    if (OPTP(PH_POOLA)) { MK(1u << PH_POOLA); MK(1u << PH_POOLG); }
    else for (int mh = 0; mh < 2; ++mh) {
        const int m0 = mh * MC;
        for (int g = 0; g < 4; ++g) { AL_POOL ap{ub + (size_t)m0 * PW, g, 0};
            ngemm<AL_POOL><<<dim3(2, MC / 64), 256, 0, stream>>>(ap, w_pool + (size_t)g * 128 * 128, 128, tmp + g * 128, 512, MC, 128, 128); }
        post_plain<<<MC * 512 / 256, 256, 0, stream>>>(tmp, mixed, 512, 0, m0, MC, 512, pool_scale);
    }
    if (OPTP(PH_G4A)) MK(1u << PH_G4A);
    else for (int mh = 0; mh < 2; ++mh) {
        const int m0 = mh * MC;
        { AL_BF16 al{on + (size_t)m0 * 1024, 1024, 0}; ngemm<AL_BF16><<<dim3(16, MC / 64), 256, 0, stream>>>(al, w_branch_a, 1024, tmp, 1024, MC, 1024, 1024); }
        post_merge<<<MC * 1024 / 256, 256, 0, stream>>>(tmp, gb, merged, 0, m0, MC);
    }
    if (OPTP(PH_G4B)) MK(1u << PH_G4B);
    else for (int mh = 0; mh < 2; ++mh) {
        const int m0 = mh * MC;
        { AL_BF16 al{mixed + (size_t)m0 * 512, 512, 0}; ngemm<AL_BF16><<<dim3(16, MC / 64), 256, 0, stream>>>(al, w_branch_b, 1024, tmp, 1024, MC, 1024, 512); }
        post_merge<<<MC * 1024 / 256, 256, 0, stream>>>(tmp, gb, merged, 1, m0, MC);
    }
    if (OPTP(PH_G5)) MK(1u << PH_G5);
    else for (int mh = 0; mh < 2; ++mh) {
        const int m0 = mh * MC;
        { AL_BF16 al{merged + (size_t)m0 * 1024, 1024, 0}; ngemm<AL_BF16><<<dim3(16, MC / 64), 256, 0, stream>>>(al, w_out, 1024, tmp, 1024, MC, 1024, 1024); }
        post_y<<<MC * 1024 / 256, 256, 0, stream>>>(tmp, x, out, m0, MC);
    }
    if (OPTP(PH_ROUTER)) MK(1u << PH_ROUTER); else k_router<<<T / 4, 256, 0, stream>>>(out, ln1_g, ln1_b, wrg, brg, wre, bre, x1b, stats, rexp, rw, list, cnt);
    if (OPTP(PH_G7)) MK(1u << PH_G7); else nmoe_gu<<<dim3(8, T / 64, NE), 256, 0, stream>>>(x1b, list, cnt, wgu, hb);
    if (OPTP(PH_G8)) MK(1u << PH_G8); else nmoe_dn<<<dim3(16, T / 64, NE), 256, 0, stream>>>(hb, list, cnt, rw, wdn, ybuf);
    if (OPTP(PH_FINAL)) MK(1u << PH_FINAL); else k_final<<<T / 4, 256, 0, stream>>>(out, stats, ln1_g, ln1_b, ybuf, ln2_g, ln2_b);
#undef MK
}
```

```cpp
#define MK_OPT 0xfffu
#define MK_ONE 1
#include <hip/hip_runtime.h>
#include <cstdio>
#include <cstdint>
#include <cmath>

typedef unsigned short bf16_t;
typedef float f32x4 __attribute__((ext_vector_type(4)));

constexpr int NB = 16, SEQ = 2048, DM = 1024, T = NB * SEQ;
constexpr int NHEAD = 8, HD = 64, NHM = 16;
constexpr int INW = 5632;
constexpr int PW = 512, PG = 4, PGD = 128;
constexpr int NE = 32, NGRP = 4, EPG = 8, FF = 512;
constexpr float LN_EPS = 1e-5f, RMS_EPS = 1e-5f;
constexpr float ALPHA = 1.189207115002721f;
constexpr float LAMBDA_INIT = 0.2f;
constexpr float QSCALE = 0.125f * 1.4426950408889634f;

constexpr size_t MiB = 1u << 20;
constexpr size_t WS_WT    = 0;
constexpr size_t WS_XB    = 112 * MiB;
constexpr size_t WS_ON    = 112 * MiB;
constexpr size_t WS_YBUF  = 112 * MiB;
constexpr size_t WS_Q     = 176 * MiB;
constexpr size_t WS_MERGED= 176 * MiB;
constexpr size_t WS_K     = 240 * MiB;
constexpr size_t WS_X1B   = 240 * MiB;
constexpr size_t WS_V     = 304 * MiB;
constexpr size_t WS_H     = 304 * MiB;
constexpr size_t WS_U     = 368 * MiB;
constexpr size_t WS_MIXED = 400 * MiB;
constexpr size_t WS_ROPE  = 432 * MiB;
constexpr size_t WS_MISC  = 440 * MiB;
constexpr size_t WS_TEMP  = 448 * MiB;
constexpr size_t WS_END   = 512 * MiB;
constexpr size_t MS_CTL   = 0;
constexpr size_t MS_STATS = 64 * 1024;
constexpr size_t MS_ROUTE = 512 * 1024;
constexpr size_t MS_LIST  = 1 * MiB;
constexpr size_t MS_SCAL  = 6 * MiB;

__device__ __forceinline__ float bf2f(bf16_t v) { return __uint_as_float((unsigned)v << 16); }
__device__ __forceinline__ bf16_t f2bf(float f) { unsigned u = __float_as_uint(f); return (bf16_t)((u + 0x7fffu + ((u >> 16) & 1u)) >> 16); }
__host__ __device__ __forceinline__ int qk_pos_of_d(int d) { return ((d >> 4) & 1) * 32 + ((d >> 2) & 3) * 8 + (d >> 5) * 4 + (d & 3); }

struct AL_F32  { const float* p; int ld; int pad;  __device__ __forceinline__ float operator()(int r, int k) const { return p[(size_t)r * ld + k]; } };
struct AL_BF16 { const bf16_t* p; int ld; int pad; __device__ __forceinline__ float operator()(int r, int k) const { return bf2f(p[(size_t)r * ld + k]); } };
struct AL_POOL { const bf16_t* u; int g; int pad;
    __device__ __forceinline__ float operator()(int r, int k) const {
        const int w = 2 << g, s = r & (SEQ - 1); const int n = (s + 1 < w) ? s + 1 : w; float acc = 0.f;
        for (int i = 0; i < n; ++i) acc += bf2f(u[(size_t)(r - i) * PW + g * PGD + k]);
        return acc / (float)n - bf2f(u[(size_t)r * PW + g * PGD + k]); } };

template <class AL>
__global__ __launch_bounds__(256) void ngemm(AL al, const float* __restrict__ Bm, int ldb, float* __restrict__ C, int ldc, int M, int N, int K) {
    __shared__ float As[16][68]; __shared__ float Bs[16][68];
    const int tid = threadIdx.x, tx = tid & 15, ty = tid >> 4; const int m0 = blockIdx.y * 64, n0 = blockIdx.x * 64;
    float acc[4][4] = {};
    for (int k0 = 0; k0 < K; k0 += 16) {
#pragma unroll
        for (int i = 0; i < 4; ++i) { const int e = tid + i * 256; const int r = e >> 4, kk = e & 15; As[kk][r] = (m0 + r < M) ? al(m0 + r, k0 + kk) : 0.f; }
#pragma unroll
        for (int i = 0; i < 4; ++i) { const int e = tid + i * 256; const int kk = e >> 6, c = e & 63; Bs[kk][c] = (n0 + c < N) ? Bm[(size_t)(k0 + kk) * ldb + n0 + c] : 0.f; }
        __syncthreads();
#pragma unroll
        for (int kk = 0; kk < 16; ++kk) { float a[4], b[4];
#pragma unroll
            for (int i = 0; i < 4; ++i) { a[i] = As[kk][ty * 4 + i]; b[i] = Bs[kk][tx * 4 + i]; }
#pragma unroll
            for (int i = 0; i < 4; ++i)
#pragma unroll
                for (int j = 0; j < 4; ++j) acc[i][j] = fmaf(a[i], b[j], acc[i][j]); }
        __syncthreads();
    }
#pragma unroll
    for (int i = 0; i < 4; ++i)
#pragma unroll
        for (int j = 0; j < 4; ++j) { const int r = m0 + ty * 4 + i, c = n0 + tx * 4 + j; if (r < M && c < N) C[(size_t)r * ldc + c] = acc[i][j]; }
}

__global__ void k_prep(const int* __restrict__ positions, const float* __restrict__ lam_vecs, float2* __restrict__ rope, float* __restrict__ scal, unsigned* __restrict__ ctl) {
    const int gid = blockIdx.x * blockDim.x + threadIdx.x;
    if (gid < T * 32) { const int t = gid >> 5, i = gid & 31;
        const float inv = powf(10000.0f, -(float)i * (2.0f / 64.0f)); const float ang = (float)positions[t] * inv;
        const double a = (double)ang; rope[gid] = make_float2((float)cos(a), (float)sin(a)); }
    if (gid < 16384) ctl[gid] = 0u;
    if (gid == 0) { float s01 = 0.f, s23 = 0.f; for (int i = 0; i < 64; ++i) { s01 += lam_vecs[i] * lam_vecs[64 + i]; s23 += lam_vecs[128 + i] * lam_vecs[192 + i]; }
        scal[0] = expf(s01) - expf(s23) + LAMBDA_INIT; }
}
__global__ void post_qk(const float* __restrict__ tmp, const float2* __restrict__ rope, bf16_t* __restrict__ out, int m0, int Mc, float scale) {
    const int gid = blockIdx.x * blockDim.x + threadIdx.x; if (gid >= Mc * 512) return;
    const int r = gid >> 9, p = gid & 511, hm = p >> 5, i = p & 31; const int t = m0 + r;
    const float t1 = tmp[(size_t)r * 1024 + hm * 64 + i], t2 = tmp[(size_t)r * 1024 + hm * 64 + i + 32]; const float2 cs = rope[t * 32 + i];
    out[(size_t)t * 1024 + hm * 64 + qk_pos_of_d(i)] = f2bf((t1 * cs.x - t2 * cs.y) * scale);
    out[(size_t)t * 1024 + hm * 64 + qk_pos_of_d(i + 32)] = f2bf((t2 * cs.x + t1 * cs.y) * scale);
}
__global__ void post_plain(const float* __restrict__ tmp, bf16_t* __restrict__ out, int ldo, int coloff, int m0, int Mc, int N, const float* __restrict__ colscale) {
    const int gid = blockIdx.x * blockDim.x + threadIdx.x; if (gid >= Mc * N) return;
    const int r = gid / N, c = gid % N; float v = tmp[(size_t)r * N + c]; if (colscale) v *= colscale[c];
    out[(size_t)(m0 + r) * ldo + coloff + c] = f2bf(v);
}
__global__ void post_gate(const float* __restrict__ tmp, const float* __restrict__ bias, bf16_t* __restrict__ gates, int coloff, int m0, int Mc) {
    const int gid = blockIdx.x * blockDim.x + threadIdx.x; if (gid >= Mc * 1024) return;
    const int r = gid >> 10, c = gid & 1023; const float v = tmp[(size_t)r * 1024 + c] + bias[coloff + c];
    gates[(size_t)(m0 + r) * 2048 + coloff + c] = f2bf(1.f / (1.f + expf(-v)));
}
__global__ __launch_bounds__(64) void nattn(const bf16_t* __restrict__ q, const bf16_t* __restrict__ k, const bf16_t* __restrict__ v, const float* __restrict__ scal, float* __restrict__ tmp, int m0) {
    const int lane = threadIdx.x; const int blk = blockIdx.x;
    const int half = blk & 1, head = (blk >> 1) & 7, cg = blk >> 4; const int t0 = m0 + cg * 64, t = t0 + lane; const int b = t0 / SEQ, s0 = t0 % SEQ; const int nkeys = ((s0 >> 6) + 1) * 64;
    const float lam = scal[0];
    float res[64];
    for (int mp = 0; mp < 2; ++mp) {
        const int hm = head * 2 + mp; float qv[64];
#pragma unroll
        for (int d = 0; d < 64; ++d) qv[d] = bf2f(q[(size_t)t * 1024 + hm * 64 + d]);
        float mx = -1e30f, l = 0.f; float o[64];
#pragma unroll
        for (int d = 0; d < 64; ++d) o[d] = 0.f;
        for (int j = 0; j < nkeys; ++j) { const size_t kr = (size_t)(b * SEQ + j) * 1024; float sc = 0.f;
            const uint4* kp = (const uint4*)(k + kr + hm * 64); const uint4* vp = (const uint4*)(v + kr + head * 128 + half * 64);
#pragma unroll
            for (int c = 0; c < 8; ++c) { const uint4 w = kp[c]; const unsigned ww[4] = {w.x, w.y, w.z, w.w};
#pragma unroll
                for (int e = 0; e < 4; ++e) { sc = fmaf(qv[c * 8 + 2 * e], __uint_as_float(ww[e] << 16), sc); sc = fmaf(qv[c * 8 + 2 * e + 1], __uint_as_float(ww[e] & 0xffff0000u), sc); } }
            const float mn = fmaxf(mx, sc), al = exp2f(mx - mn), p = exp2f(sc - mn); mx = mn; l = l * al + p;
#pragma unroll
            for (int c = 0; c < 8; ++c) { const uint4 w = vp[c]; const unsigned ww[4] = {w.x, w.y, w.z, w.w};
#pragma unroll
                for (int e = 0; e < 4; ++e) { o[c * 8 + 2 * e] = fmaf(p, __uint_as_float(ww[e] << 16), o[c * 8 + 2 * e] * al); o[c * 8 + 2 * e + 1] = fmaf(p, __uint_as_float(ww[e] & 0xffff0000u), o[c * 8 + 2 * e + 1] * al); } } }
        const float il = 1.f / l;
#pragma unroll
        for (int d = 0; d < 64; ++d) res[d] = (mp == 0) ? o[d] * il : res[d] - lam * o[d] * il;
    }
#pragma unroll
    for (int d = 0; d < 64; ++d) tmp[(size_t)(t - m0) * 1024 + head * 128 + half * 64 + d] = res[d];
}
__global__ void post_rms(const float* __restrict__ tmp, const float* __restrict__ gain, bf16_t* __restrict__ on, int m0, int Mc) {
    const int gid = blockIdx.x * blockDim.x + threadIdx.x; if (gid >= Mc * 8) return;
    const int r = gid >> 3, head = gid & 7; const float* p = tmp + (size_t)r * 1024 + head * 128; float ss = 0.f;
    for (int d = 0; d < 128; ++d) ss += p[d] * p[d];
    const float rs = 1.0f / sqrtf(ss * (1.f / 128.f) + RMS_EPS);
    for (int d = 0; d < 128; ++d) on[(size_t)(m0 + r) * 1024 + head * 128 + d] = f2bf(p[d] * rs * gain[d] * (1.f - LAMBDA_INIT));
}
__global__ void post_merge(const float* __restrict__ tmp, const bf16_t* __restrict__ gates, bf16_t* __restrict__ merged, int br, int m0, int Mc) {
    const int gid = blockIdx.x * blockDim.x + threadIdx.x; if (gid >= Mc * 1024) return;
    const int r = gid >> 10, c = gid & 1023; const size_t t = m0 + r; const float g = bf2f(gates[t * 2048 + br * 1024 + c]);
    float val = g * tmp[(size_t)r * 1024 + c]; if (br) val += bf2f(merged[t * 1024 + c]);
    merged[t * 1024 + c] = f2bf(val);
}
__global__ void post_y(const float* __restrict__ tmp, const float* __restrict__ x, float* __restrict__ y, int m0, int Mc) {
    const int gid = blockIdx.x * blockDim.x + threadIdx.x; if (gid >= Mc * 1024) return;
    const size_t o = (size_t)m0 * 1024 + gid; y[o] = ALPHA * x[o] + tmp[gid];
}
__device__ __forceinline__ float wave_sum(float v) {
#pragma unroll
    for (int o = 1; o < 64; o <<= 1) v += __shfl_xor(v, o);
    return v;
}
__global__ __launch_bounds__(256) void k_router(const float* __restrict__ y, const float* __restrict__ g1, const float* __restrict__ b1, const float* __restrict__ wrg, const float* __restrict__ brg,
                                                const float* __restrict__ wre, const float* __restrict__ bre, bf16_t* __restrict__ x1b, float2* __restrict__ stats, int2* __restrict__ rexp, float2* __restrict__ rw,
                                                int* __restrict__ list, unsigned* __restrict__ cnt) {
    const int lane = threadIdx.x & 63; const int t = blockIdx.x * 4 + (threadIdx.x >> 6);
    const float* yr = y + (size_t)t * 1024; float xv[16]; float s = 0.f;
#pragma unroll
    for (int j = 0; j < 4; ++j) { const f32x4 vv = *(const f32x4*)(yr + j * 256 + lane * 4); xv[4 * j] = vv.x; xv[4 * j + 1] = vv.y; xv[4 * j + 2] = vv.z; xv[4 * j + 3] = vv.w; s += (vv.x + vv.y) + (vv.z + vv.w); }
    const float mu = wave_sum(s) * (1.f / 1024.f); float s2 = 0.f;
#pragma unroll
    for (int i = 0; i < 16; ++i) { const float d = xv[i] - mu; s2 += d * d; }
    const float rstd = 1.0f / sqrtf(wave_sum(s2) * (1.f / 1024.f) + LN_EPS);
    if (lane == 0) stats[t] = make_float2(mu, rstd);
#pragma unroll
    for (int j = 0; j < 4; ++j)
#pragma unroll
        for (int i = 0; i < 4; ++i) { const int c = j * 256 + lane * 4 + i; xv[4 * j + i] = (xv[4 * j + i] - mu) * rstd * g1[c] + b1[c]; }
#pragma unroll
    for (int j = 0; j < 4; ++j) { uint2 w; w.x = (unsigned)f2bf(xv[4 * j]) | ((unsigned)f2bf(xv[4 * j + 1]) << 16); w.y = (unsigned)f2bf(xv[4 * j + 2]) | ((unsigned)f2bf(xv[4 * j + 3]) << 16);
        *(uint2*)(x1b + (size_t)t * 1024 + j * 256 + lane * 4) = w; }
    float lg[4], le[32];
#pragma unroll
    for (int o = 0; o < 4; ++o) { float a = 0.f;
#pragma unroll
        for (int j = 0; j < 4; ++j)
#pragma unroll
            for (int i = 0; i < 4; ++i) a = fmaf(xv[4 * j + i], wrg[(size_t)(j * 256 + lane * 4 + i) * 4 + o], a);
        lg[o] = wave_sum(a) + brg[o]; }
#pragma unroll
    for (int o = 0; o < 32; ++o) { float a = 0.f;
#pragma unroll
        for (int j = 0; j < 4; ++j)
#pragma unroll
            for (int i = 0; i < 4; ++i) a = fmaf(xv[4 * j + i], wre[(size_t)(j * 256 + lane * 4 + i) * 32 + o], a);
        le[o] = wave_sum(a) + bre[o]; }
    if (lane == 0) {
        int gi = 0; float gm = lg[0];
#pragma unroll
        for (int o = 1; o < 4; ++o) if (lg[o] > gm) { gm = lg[o]; gi = o; }
        float gs = 0.f;
#pragma unroll
        for (int o = 0; o < 4; ++o) gs += expf(lg[o] - gm);
        const float gp = 1.f / gs;
        float ev[8];
#pragma unroll
        for (int o = 0; o < 8; ++o) { float vsel = le[o];
#pragma unroll
            for (int g = 1; g < 4; ++g) vsel = (gi == g) ? le[g * 8 + o] : vsel;
            ev[o] = vsel; }
        int i0 = 0; float m0v = ev[0];
#pragma unroll
        for (int o = 1; o < 8; ++o) if (ev[o] > m0v) { m0v = ev[o]; i0 = o; }
        int i1 = (i0 == 0) ? 1 : 0; float m1v = -3.4e38f;
#pragma unroll
        for (int o = 0; o < 8; ++o) if (o != i0 && ev[o] > m1v) { m1v = ev[o]; i1 = o; }
        const float e1 = expf(m1v - m0v); const float w0 = gp / (1.f + e1), w1 = gp * e1 / (1.f + e1);
        const int ex0 = gi * 8 + i0, ex1 = gi * 8 + i1;
        rexp[t] = make_int2(ex0, ex1); rw[t] = make_float2(w0, w1);
        const unsigned p0 = atomicAdd(&cnt[ex0], 1u); list[(size_t)ex0 * T + p0] = t * 2;
        const unsigned p1 = atomicAdd(&cnt[ex1], 1u); list[(size_t)ex1 * T + p1] = t * 2 + 1;
    }
}
__global__ __launch_bounds__(256) void nmoe_gu(const bf16_t* __restrict__ x1b, const int* __restrict__ list, const unsigned* __restrict__ cnt, const float* __restrict__ wgu, bf16_t* __restrict__ h) {
    __shared__ float As[16][68]; __shared__ float Bg[16][68]; __shared__ float Bu[16][68]; __shared__ int toks[64];
    const int e = blockIdx.z; const int M = (int)cnt[e]; const int m0 = blockIdx.y * 64, n0 = blockIdx.x * 64; if (m0 >= M) return;
    int tb = 0; for (int i = 0; i < e; ++i) tb += ((int)cnt[i] + 255) >> 8;
    const int tid = threadIdx.x, tx = tid & 15, ty = tid >> 4;
    if (tid < 64) toks[tid] = (m0 + tid < M) ? (list[(size_t)e * T + m0 + tid] >> 1) : 0;
    __syncthreads();
    const float* W = wgu + (size_t)e * 1024 * 1024; float ag[4][4] = {}, au[4][4] = {};
    for (int k0 = 0; k0 < 1024; k0 += 16) {
#pragma unroll
        for (int i = 0; i < 4; ++i) { const int el = tid + i * 256; const int r = el >> 4, kk = el & 15; As[kk][r] = bf2f(x1b[(size_t)toks[r] * 1024 + k0 + kk]); }
#pragma unroll
        for (int i = 0; i < 4; ++i) { const int el = tid + i * 256; const int kk = el >> 6, c = el & 63; Bg[kk][c] = W[(size_t)(k0 + kk) * 1024 + n0 + c]; Bu[kk][c] = W[(size_t)(k0 + kk) * 1024 + 512 + n0 + c]; }
        __syncthreads();
#pragma unroll
        for (int kk = 0; kk < 16; ++kk) { float a[4], bg[4], bu[4];
#pragma unroll
            for (int i = 0; i < 4; ++i) { a[i] = As[kk][ty * 4 + i]; bg[i] = Bg[kk][tx * 4 + i]; bu[i] = Bu[kk][tx * 4 + i]; }
#pragma unroll
            for (int i = 0; i < 4; ++i)
#pragma unroll
                for (int j = 0; j < 4; ++j) { ag[i][j] = fmaf(a[i], bg[j], ag[i][j]); au[i][j] = fmaf(a[i], bu[j], au[i][j]); } }
        __syncthreads();
    }
#pragma unroll
    for (int i = 0; i < 4; ++i)
#pragma unroll
        for (int j = 0; j < 4; ++j) { const int r = m0 + ty * 4 + i, c = n0 + tx * 4 + j; if (r < M) { const float g = ag[i][j]; h[((size_t)tb * 256 + r) * 512 + c] = f2bf(g / (1.f + expf(-g)) * au[i][j]); } }
}
__global__ __launch_bounds__(256) void nmoe_dn(const bf16_t* __restrict__ h, const int* __restrict__ list, const unsigned* __restrict__ cnt, const float2* __restrict__ rw, const float* __restrict__ wdn, bf16_t* __restrict__ ybuf) {
    __shared__ float As[16][68]; __shared__ float Bs[16][68];
    const int e = blockIdx.z; const int M = (int)cnt[e]; const int m0 = blockIdx.y * 64, n0 = blockIdx.x * 64; if (m0 >= M) return;
    int tb = 0; for (int i = 0; i < e; ++i) tb += ((int)cnt[i] + 255) >> 8;
    const int tid = threadIdx.x, tx = tid & 15, ty = tid >> 4;
    const float* W = wdn + (size_t)e * 512 * 1024; float acc[4][4] = {};
    for (int k0 = 0; k0 < 512; k0 += 16) {
#pragma unroll
        for (int i = 0; i < 4; ++i) { const int el = tid + i * 256; const int r = el >> 4, kk = el & 15; As[kk][r] = (m0 + r < M) ? bf2f(h[((size_t)tb * 256 + m0 + r) * 512 + k0 + kk]) : 0.f; }
#pragma unroll
        for (int i = 0; i < 4; ++i) { const int el = tid + i * 256; const int kk = el >> 6, c = el & 63; Bs[kk][c] = W[(size_t)(k0 + kk) * 1024 + n0 + c]; }
        __syncthreads();
#pragma unroll
        for (int kk = 0; kk < 16; ++kk) { float a[4], b[4];
#pragma unroll
            for (int i = 0; i < 4; ++i) { a[i] = As[kk][ty * 4 + i]; b[i] = Bs[kk][tx * 4 + i]; }
#pragma unroll
            for (int i = 0; i < 4; ++i)
#pragma unroll
                for (int j = 0; j < 4; ++j) acc[i][j] = fmaf(a[i], b[j], acc[i][j]); }
        __syncthreads();
    }
#pragma unroll
    for (int i = 0; i < 4; ++i) { const int r = m0 + ty * 4 + i; if (r < M) { const int ent = list[(size_t)e * T + r]; const float2 w2 = rw[ent >> 1]; const float w = (ent & 1) ? w2.y : w2.x;
#pragma unroll
        for (int j = 0; j < 4; ++j) ybuf[(size_t)ent * 1024 + n0 + tx * 4 + j] = f2bf(w * acc[i][j]); } }
}
__global__ __launch_bounds__(256) void k_final(float* __restrict__ yout, const float2* __restrict__ stats, const float* __restrict__ g1, const float* __restrict__ b1, const bf16_t* __restrict__ ybuf,
                                               const float* __restrict__ g2, const float* __restrict__ b2) {
    const int lane = threadIdx.x & 63; const int t = blockIdx.x * 4 + (threadIdx.x >> 6);
    float* yr = yout + (size_t)t * 1024; const float2 st = stats[t]; float xv[16]; float s = 0.f;
#pragma unroll
    for (int j = 0; j < 4; ++j) { const int c0 = j * 256 + lane * 4; const f32x4 vv = *(const f32x4*)(yr + c0); const f32x4 gg = *(const f32x4*)(g1 + c0); const f32x4 bb = *(const f32x4*)(b1 + c0);
        const uint2 a = *(const uint2*)(ybuf + (size_t)(2 * t) * 1024 + c0); const uint2 b = *(const uint2*)(ybuf + (size_t)(2 * t + 1) * 1024 + c0);
        const float ya[4] = {__uint_as_float(a.x << 16), __uint_as_float(a.x & 0xffff0000u), __uint_as_float(a.y << 16), __uint_as_float(a.y & 0xffff0000u)};
        const float yb[4] = {__uint_as_float(b.x << 16), __uint_as_float(b.x & 0xffff0000u), __uint_as_float(b.y << 16), __uint_as_float(b.y & 0xffff0000u)};
#pragma unroll
        for (int i = 0; i < 4; ++i) { const float x1 = (vv[i] - st.x) * st.y * gg[i] + bb[i]; const float val = ALPHA * x1 + (ya[i] + yb[i]); xv[4 * j + i] = val; s += val; } }
    const float mu = wave_sum(s) * (1.f / 1024.f); float s2 = 0.f;
#pragma unroll
    for (int i = 0; i < 16; ++i) { const float d = xv[i] - mu; s2 += d * d; }
    const float rstd = 1.0f / sqrtf(wave_sum(s2) * (1.f / 1024.f) + LN_EPS);
#pragma unroll
    for (int j = 0; j < 4; ++j) { const int c0 = j * 256 + lane * 4; const f32x4 gg = *(const f32x4*)(g2 + c0); const f32x4 bb = *(const f32x4*)(b2 + c0); f32x4 o;
#pragma unroll
        for (int i = 0; i < 4; ++i) o[i] = (xv[4 * j + i] - mu) * rstd * gg[i] + bb[i];
        *(f32x4*)(yr + c0) = o; }
}

#define LAS __attribute__((address_space(3)))
#define GAS __attribute__((address_space(1)))
typedef short bf16x8 __attribute__((ext_vector_type(8)));
typedef unsigned u32x4 __attribute__((ext_vector_type(4)));
typedef unsigned u32x2 __attribute__((ext_vector_type(2)));
typedef GAS unsigned gu32;
#define RLX_AGENT __ATOMIC_RELAXED, __HIP_MEMORY_SCOPE_AGENT
#define LDS_WAIT() asm volatile("s_waitcnt lgkmcnt(0)" ::: "memory")
#define VM_WAIT() asm volatile("s_waitcnt vmcnt(0)" ::: "memory")

constexpr size_t WT_IN = 0;
constexpr size_t WT_A  = WT_IN + (size_t)INW * 1024;
constexpr size_t WT_B  = WT_A + 1024 * 1024;
constexpr size_t WT_O  = WT_B + 1024 * 512;
constexpr size_t WT_GU = WT_O + 1024 * 1024;
constexpr size_t WT_DN = WT_GU + (size_t)NE * 1024 * 1024;
constexpr size_t WT_END = WT_DN + (size_t)NE * 1024 * 512;
static_assert(WT_END * 2 <= 112 * MiB, "weight copies fit");
constexpr size_t MS_WPOOL = 7 * MiB;
constexpr size_t MS_WP = 7 * MiB + 512 * 1024;
constexpr size_t MS_CSBW = 6 * MiB + 1024;
constexpr size_t WS_POOLED = 448 * MiB;

constexpr int CW_CNT = 0;
constexpr int CW_BAR = 1024;

constexpr int NWAVES = 8, NTHREADS = 512;
constexpr int RING_BYTES = 131072, LDS_CTL_OFF = 147456, MISC_OFF = LDS_CTL_OFF + 320, LDS_BYTES = 163840;

typedef float f32x2_t __attribute__((ext_vector_type(2))); typedef __bf16 bf16x2_t __attribute__((ext_vector_type(2)));
__device__ __forceinline__ unsigned cvt_pk_bf16(float lo, float hi) { f32x2_t v = {lo, hi}; bf16x2_t b = __builtin_convertvector(v, bf16x2_t); return __builtin_bit_cast(unsigned, b); }
__device__ __forceinline__ float bflo(unsigned w) { return __uint_as_float(w << 16); }
__device__ __forceinline__ float bfhi(unsigned w) { return __uint_as_float(w & 0xffff0000u); }

#define XB_TMO      128
#define XB_XCNT(j)  (256  + 64 * (j))
#define XB_XSUB(j)  (1280 + 64 * (j))
#define XB_XGEN(j)  (2304 + 64 * (j))
#define XB_TOP      3328
#define XB_TOPGEN   3392
#define XCD_BAR_WORDS 3456
#define XB_SPIN_CAP (1u << 22)
__device__ __forceinline__ unsigned xb_ld(unsigned* p)              { return __hip_atomic_load(p, __ATOMIC_RELAXED, __HIP_MEMORY_SCOPE_AGENT); }
__device__ __forceinline__ unsigned xb_add(unsigned* p, unsigned v) { return __hip_atomic_fetch_add(p, v, __ATOMIC_RELAXED, __HIP_MEMORY_SCOPE_AGENT); }
__device__ __forceinline__ unsigned xb_xcc_id() { return (unsigned)__builtin_amdgcn_s_getreg((3 << 11) | 20) & 0xFu; }
#define XB_SPIN(cond, bar) do { unsigned _sp = 0; while (cond) { __builtin_amdgcn_s_sleep(1); \
    if ((++_sp & 255u) == 0u) { if (xb_ld(&(bar)[XB_TMO])) break; if (_sp > XB_SPIN_CAP) { atomicAdd(&(bar)[XB_TMO], 1u); break; } } } } while (0)
struct XcdBarrier { unsigned* bar; unsigned x; volatile LAS unsigned* st; };
__device__ __forceinline__ XcdBarrier xcd_barrier_post(unsigned* bar, volatile LAS unsigned* st) {
    XcdBarrier b; b.bar = bar; b.x = xb_xcc_id(); b.st = st;
    if (threadIdx.x == 0) (void)xb_add(&bar[XB_XCNT(b.x)], 1u);
    return b;
}
__device__ __forceinline__ void xcd_barrier_complete(unsigned* bar, unsigned x, unsigned& nloc, unsigned& nx) {
    const unsigned G = gridDim.x * gridDim.y * gridDim.z;
    unsigned sum, cnt, mine, sp = 0u;
    for (;;) {
        sum = 0u; cnt = 0u; mine = 0u;
#pragma unroll
        for (unsigned j = 0; j < 16; ++j) { const unsigned c = xb_ld(&bar[XB_XCNT(j)]); sum += c; cnt += (c > 0u) ? 1u : 0u; mine = (j == x) ? c : mine; }
        if (sum == G) break;
        __builtin_amdgcn_s_sleep(1);
        if ((++sp & 255u) == 0u) { if (xb_ld(&bar[XB_TMO])) break; if (sp > XB_SPIN_CAP) { atomicAdd(&bar[XB_TMO], 1u); break; } }
    }
    nloc = mine > 0u ? mine : 1u; nx = cnt > 0u ? cnt : 1u;
}
__device__ __forceinline__ void xcd_barrier(const XcdBarrier& b) {
    asm volatile("s_waitcnt vmcnt(0)" ::: "memory");
    __syncthreads();
    if (threadIdx.x == 0) {
        unsigned* bar = b.bar;
        __builtin_amdgcn_s_waitcnt(0);
        unsigned nloc = b.st[0], nx = b.st[1];
        if (nloc == 0u) { xcd_barrier_complete(bar, b.x, nloc, nx); b.st[0] = nloc; b.st[1] = nx; }
        const unsigned old = xb_add(&bar[XB_XSUB(b.x)], 1u);
        const unsigned gen = old / nloc;
        if (old + 1u == (gen + 1u) * nloc) {
            __builtin_amdgcn_fence(__ATOMIC_RELEASE, "agent");
            asm volatile("s_waitcnt vmcnt(0)" ::: "memory");
            const unsigned og = xb_add(&bar[XB_TOP], 1u);
            const unsigned tg = og / nx;
            if (og + 1u == (tg + 1u) * nx) xb_add(&bar[XB_TOPGEN], 1u);
            else XB_SPIN(xb_ld(&bar[XB_TOPGEN]) == tg, bar);
            __builtin_amdgcn_fence(__ATOMIC_ACQUIRE, "agent");
            xb_add(&bar[XB_XGEN(b.x)], 1u);
            asm volatile("s_waitcnt vmcnt(0)" ::: "memory");
        } else {
            XB_SPIN(xb_ld(&bar[XB_XGEN(b.x)]) == gen, bar);
            __builtin_amdgcn_fence(__ATOMIC_ACQUIRE, "agent");
            asm volatile("s_waitcnt vmcnt(0)" ::: "memory");
        }
    }
    __syncthreads();
}

namespace g8 {
constexpr int BM = 256, BK = 64, HALF = 128, HTB = HALF * BK * 2, NXCD = 8, WGM = 8;
__host__ __device__ __forceinline__ int lds_byte(int r, int c) { const int st = (r >> 4) * 2 + (c >> 5), rr = r & 15, cc = c & 31, ob = rr * 64 + cc * 2; return st * 1024 + (ob ^ (((ob >> 9) & 1) << 5)); }
__host__ __device__ __forceinline__ void stage_rc(int b, int& R, int& C) { const int st = b / 1024, sb = b % 1024, swz = sb ^ (((sb >> 9) & 1) << 5); R = (st >> 1) * 16 + swz / 64; C = (st & 1) * 32 + (swz % 64) / 2; }
__host__ __device__ __forceinline__ int perm32(int rho) { const int n = rho >> 4, i = rho & 15; return 8 * (i >> 2) + 4 * n + (i & 3); }

struct GUnit { const char* A; const char* B; int pm, pn, e, r0; };

struct DenseOrder {
    const char* Abase; const char* Bbase; int nM, nN, nwg, G, c; size_t tstep;
    __device__ void init(const void* A, const void* Bt, int M, int N, int K, int G_, int c_) { Abase = (const char*)A; Bbase = (const char*)Bt; nM = M / BM; nN = N / BM; nwg = nM * nN; G = G_; c = c_; tstep = (size_t)BM * K * 2; }
    __device__ bool next(int i, GUnit& u) const {
        const long L = (long)i * G + c; if (L >= nwg) return false;
        int wgid = (int)L; { const int q = nwg / NXCD, r = nwg % NXCD, xcd = wgid % NXCD, off = wgid / NXCD; wgid = (xcd < r ? xcd * (q + 1) : r * (q + 1) + (xcd - r) * q) + off; }
        const int nig = WGM * nN, gid = wgid / nig, fm = gid * WGM, gsz = (nM - fm) < WGM ? (nM - fm) : WGM;
        u.pm = fm + ((wgid % nig) % gsz); u.pn = (wgid % nig) / gsz; u.e = 0; u.r0 = 0;
        u.A = Abase + (size_t)u.pm * tstep; u.B = Bbase + (size_t)u.pn * tstep; return true;
    }
    __device__ __forceinline__ unsigned rowoff(const GUnit&, int) const { return 0u; }
};
struct MoeOrder {
    const char* Abase; const char* Bbase; const int* list; const volatile LAS unsigned* tb; const volatile LAS unsigned* cntl; int nwg, G, c; size_t atile, bexp, btile; int gather;
    __device__ bool next(int i, GUnit& u) const {
        const long L = (long)i * G + c; if (L >= nwg) return false;
        int wgid = (int)L; { const int q = nwg / NXCD, r = nwg % NXCD, xcd = wgid % NXCD, off = wgid / NXCD; wgid = (xcd < r ? xcd * (q + 1) : r * (q + 1) + (xcd - r) * q) + off; }
        const int tile = wgid >> 2; u.pn = wgid & 3; u.pm = tile;
        int e = 0; for (int j = 1; j < NE; ++j) e = ((int)tb[j] <= tile) ? j : e;
        e = __builtin_amdgcn_readfirstlane(e); u.e = e; u.r0 = __builtin_amdgcn_readfirstlane((tile - (int)tb[e]) * 256);
        u.A = gather ? Abase : Abase + (size_t)tile * atile; u.B = Bbase + (size_t)e * bexp + (size_t)u.pn * btile; return true;
    }
    __device__ __forceinline__ unsigned rowoff(const GUnit& u, int rr) const {
        const int p = u.r0 + rr; const int tok = (p < (int)cntl[u.e]) ? (list[(size_t)u.e * T + p] >> 1) : 0; return (unsigned)tok * 2048u; }
};

template <class Epi, class Sched, bool ALIGN_EPI, bool GATHER>
__device__ __forceinline__ void gemm_phase(LAS unsigned char* lds, const int K, const Sched& S, const Epi& E) {
    const int tid = threadIdx.x, wid = __builtin_amdgcn_readfirstlane(tid >> 6), lane = tid & 63, wr = wid >> 2, wc = wid & 3, fr = lane & 15, fq = lane >> 4;
    const int nt = K / BK;
    unsigned voffA[2], voffB[2]; int RA[2], CA[2];
#pragma unroll
    for (int i = 0; i < 2; ++i) { int R, C; stage_rc(tid * 16 + i * 8192, R, C); const int Rb = Epi::PERM ? ((R & ~31) + perm32(R & 31)) : R;
        voffA[i] = (unsigned)(R * K + C) * 2u; voffB[i] = (unsigned)(Rb * K + C) * 2u; RA[i] = R; CA[i] = C; }
    const size_t kstep = (size_t)(BK * 2);
    const size_t hstep = (size_t)HALF * K * 2;
    const unsigned ldsw = (unsigned)wid * 1024u;
    const int aoff = lds_byte(wr * 64 + fr, fq * 8), boff = lds_byte(wc * 32 + fr, fq * 8);
#define G8_SA(b, h) (((b) * 2 + (h)) * HTB)
#define G8_SB(b, h) ((4 + (b) * 2 + (h)) * HTB)
#define G8_STAGE(bufoff, gbase, o0, o1) do { \
        __builtin_amdgcn_global_load_lds((const unsigned*)((const char*)(gbase) + (o0)), (LAS unsigned*)(lds + (bufoff) + ldsw), 16, 0, 0); \
        __builtin_amdgcn_global_load_lds((const unsigned*)((const char*)(gbase) + (o1)), (LAS unsigned*)(lds + (bufoff) + ldsw + 8192), 16, 0, 0); } while (0)
#define G8_STAGE_B(bufoff, gbase) G8_STAGE(bufoff, gbase, voffB[0], voffB[1])
#define G8_LDA(dst, b, h) do { _Pragma("unroll") for (int m = 0; m < 4; ++m) _Pragma("unroll") for (int k = 0; k < 2; ++k) dst[m][k] = *(const LAS bf16x8*)(lds + G8_SA(b, h) + aoff + m * 2048 + k * 1024); } while (0)
#define G8_LDB(dst, b, h) do { _Pragma("unroll") for (int n = 0; n < 2; ++n) _Pragma("unroll") for (int k = 0; k < 2; ++k) dst[n][k] = *(const LAS bf16x8*)(lds + G8_SB(b, h) + boff + n * 2048 + k * 1024); } while (0)
#define G8_MMA(ai, bj, At, Bt) do { __builtin_amdgcn_s_setprio(1); _Pragma("unroll") for (int m = 0; m < 4; ++m) _Pragma("unroll") for (int n = 0; n < 2; ++n) _Pragma("unroll") for (int k = 0; k < 2; ++k) \
        acc[ai][bj][m][n] = __builtin_amdgcn_mfma_f32_16x16x32_bf16(Bt[n][k], At[m][k], acc[ai][bj][m][n], 0, 0, 0); __builtin_amdgcn_s_setprio(0); } while (0)
#ifdef G8_DRAIN
#define G8_WAIT_V(n) asm volatile("s_waitcnt vmcnt(0)" ::: "memory")
#else
#define G8_WAIT_V(n) asm volatile("s_waitcnt vmcnt(" #n ")" ::: "memory")
#endif
#define G8_WAIT_L(n) asm volatile("s_waitcnt lgkmcnt(" #n ")" ::: "memory")
#define G8_BAR __builtin_amdgcn_s_barrier()
#define G8_SCHED __builtin_amdgcn_sched_barrier(0)
    GUnit cur, nxt; int ui = 0;
    if (!S.next(0, cur)) return;
    unsigned cao[2][2], nao[2][2];
#pragma unroll
    for (int h = 0; h < 2; ++h)
#pragma unroll
        for (int i = 0; i < 2; ++i) { cao[h][i] = GATHER ? S.rowoff(cur, h * HALF + RA[i]) + (unsigned)CA[i] * 2u : voffA[i] + (unsigned)(h * hstep); nao[h][i] = cao[h][i]; }
    f32x4 acc[2][2][4][2];
#pragma unroll
    for (int a = 0; a < 2; ++a)
#pragma unroll
        for (int b = 0; b < 2; ++b)
#pragma unroll
            for (int m = 0; m < 4; ++m)
#pragma unroll
                for (int n = 0; n < 2; ++n) acc[a][b][m][n] = (f32x4){0.f, 0.f, 0.f, 0.f};
    bf16x8 At[4][2], B0[2][2], B1[2][2];
    const char* cA = cur.A; const char* cB = cur.B;
    G8_STAGE_B(G8_SB(0, 0), cB); G8_STAGE_B(G8_SB(0, 1), cB + hstep); G8_STAGE(G8_SA(0, 0), cA, cao[0][0], cao[0][1]); G8_STAGE(G8_SA(0, 1), cA, cao[1][0], cao[1][1]);
    if (wr == 1) G8_BAR;
    G8_WAIT_V(2); G8_BAR;
    G8_STAGE_B(G8_SB(1, 0), cB + kstep); G8_STAGE(G8_SA(1, 0), cA + kstep, cao[0][0], cao[0][1]); G8_STAGE_B(G8_SB(1, 1), cB + hstep + kstep);
    G8_WAIT_V(6); G8_BAR;
    for (;;) {
        const bool has_next = S.next(ui + 1, nxt);
        if (GATHER && has_next) {
#pragma unroll
            for (int h = 0; h < 2; ++h)
#pragma unroll
                for (int i = 0; i < 2; ++i) nao[h][i] = S.rowoff(nxt, h * HALF + RA[i]) + (unsigned)CA[i] * 2u;
        }
        const char* nA = has_next ? nxt.A : cA; const char* nB = has_next ? nxt.B : cB;
        for (int t = 0; t < nt; t += 2) {
            const bool last = (t == nt - 2);
            const char* a1 = cA + (size_t)(t + 1) * kstep;
            const char* a2 = last ? nA : cA + (size_t)(t + 2) * kstep; const char* b2 = last ? nB : cB + (size_t)(t + 2) * kstep;
            const char* a3 = a2 + kstep; const char* b3 = b2 + kstep;
            asm volatile("" : "+s"(a1), "+s"(a2), "+s"(b2), "+s"(a3), "+s"(b3));
            unsigned o2[2][2];
#pragma unroll
            for (int h = 0; h < 2; ++h)
#pragma unroll
                for (int i = 0; i < 2; ++i) o2[h][i] = (GATHER && last && has_next) ? nao[h][i] : cao[h][i];
            G8_LDB(B0, 0, 0); G8_LDB(B1, 0, 1); G8_SCHED; G8_LDA(At, 0, 0); G8_STAGE(G8_SA(1, 1), a1, cao[1][0], cao[1][1]);
            G8_WAIT_V(8); G8_WAIT_L(0); G8_BAR; G8_MMA(0, 0, At, B0); G8_MMA(0, 1, At, B1); G8_BAR; G8_SCHED;
            G8_LDA(At, 0, 1); G8_STAGE_B(G8_SB(0, 0), b2); G8_STAGE_B(G8_SB(0, 1), b2 + hstep); G8_STAGE(G8_SA(0, 0), a2, o2[0][0], o2[0][1]);
            G8_WAIT_V(8); G8_WAIT_L(0); G8_BAR; G8_MMA(1, 0, At, B0); G8_MMA(1, 1, At, B1); G8_BAR; G8_SCHED;
            G8_LDB(B0, 1, 0); G8_LDB(B1, 1, 1); G8_SCHED; G8_LDA(At, 1, 0); G8_STAGE(G8_SA(0, 1), a2, o2[1][0], o2[1][1]);
            G8_WAIT_V(8); G8_WAIT_L(0); G8_BAR; G8_MMA(0, 0, At, B0); G8_MMA(0, 1, At, B1); G8_BAR; G8_SCHED;
            G8_LDA(At, 1, 1); G8_STAGE_B(G8_SB(1, 0), b3); G8_STAGE_B(G8_SB(1, 1), b3 + hstep); G8_STAGE(G8_SA(1, 0), a3, o2[0][0], o2[0][1]);
            G8_WAIT_V(8); G8_WAIT_L(0); G8_BAR; G8_MMA(1, 0, At, B0); G8_MMA(1, 1, At, B1); G8_BAR; G8_SCHED;
        }
        if constexpr (ALIGN_EPI) { if (wr == 0) G8_BAR; }
        {
          GUnit eu = cur; int fr_ = fr, fq_ = fq; asm volatile("" : "+s"(eu.pm), "+s"(eu.pn), "+s"(eu.e), "+s"(eu.r0)); asm volatile("" : "+v"(fr_), "+v"(fq_));
          E(acc, eu, wr, wc, fr_, fq_); }
        if (!has_next) break;
#pragma unroll
        for (int a = 0; a < 2; ++a)
#pragma unroll
            for (int b = 0; b < 2; ++b)
#pragma unroll
                for (int m = 0; m < 4; ++m)
#pragma unroll
                    for (int n = 0; n < 2; ++n) acc[a][b][m][n] = (f32x4){0.f, 0.f, 0.f, 0.f};
        cur = nxt; cA = nA; cB = nB; ++ui;
#pragma unroll
        for (int h = 0; h < 2; ++h)
#pragma unroll
            for (int i = 0; i < 2; ++i) cao[h][i] = nao[h][i];
        if constexpr (ALIGN_EPI) { if (wr == 1) G8_BAR; }
    }
    G8_WAIT_V(0);
    if constexpr (!ALIGN_EPI) { if (wr == 0) G8_BAR; }
    G8_BAR;
#undef G8_SA
#undef G8_SB
#undef G8_STAGE
#undef G8_STAGE_B
#undef G8_LDA
#undef G8_LDB
#undef G8_MMA
#undef G8_WAIT_V
#undef G8_WAIT_L
#undef G8_BAR
#undef G8_SCHED
}

__device__ __forceinline__ u32x4 pack8(const f32x4 v0, const f32x4 v1) { u32x4 w; w.x = cvt_pk_bf16(v0[0], v0[1]); w.y = cvt_pk_bf16(v0[2], v0[3]); w.z = cvt_pk_bf16(v1[0], v1[1]); w.w = cvt_pk_bf16(v1[2], v1[3]); return w; }
__device__ __forceinline__ float sigmoidf_(float v) { return __builtin_amdgcn_rcpf(1.f + __builtin_amdgcn_exp2f(-1.4426950408889634f * v)); }

struct EpiProj {
    static constexpr bool PERM = true;
    bf16_t *qb, *kb, *vb, *ub, *gb; const float* rope; const float* gate_bias;
    __device__ __forceinline__ void operator()(const f32x4 (&acc)[2][2][4][2], const GUnit& u, int wr, int wc, int fr, int fq) const {
        const int row0 = u.pm * BM + wr * 64 + fr; const int cw = wc * 32 + 8 * fq; const int pn = u.pn;
#ifdef DBG_PLAIN_EPI
        if (pn < 8) { bf16_t* base = (pn < 4 ? qb : kb) + (pn & 3) * 256 + cw;
            for (int ai = 0; ai < 2; ++ai) for (int m = 0; m < 4; ++m) { const int t = row0 + ai * HALF + m * 16; for (int bj = 0; bj < 2; ++bj) *(u32x4*)(base + (size_t)t * 1024 + bj * HALF) = pack8(acc[ai][bj][m][0], acc[ai][bj][m][1]); } }
        else
#endif
        if (pn < 8) {
            bf16_t* base = (pn < 4 ? qb : kb) + (pn & 3) * 256 + cw; const float sc = pn < 4 ? QSCALE : 1.f; const int fi = 16 * (wc & 1) + 4 * fq;
#pragma unroll
            for (int ai = 0; ai < 2; ++ai)
#pragma unroll
                for (int m = 0; m < 4; ++m) { const int t = row0 + ai * HALF + m * 16; const f32x4 cs0 = *(const f32x4*)(rope + ((size_t)t * 32 + fi) * 2), cs1 = *(const f32x4*)(rope + ((size_t)t * 32 + fi) * 2 + 4);
                    const f32x4 c = {cs0[0], cs0[2], cs1[0], cs1[2]}, s = {cs0[1], cs0[3], cs1[1], cs1[3]};
#pragma unroll
                    for (int bj = 0; bj < 2; ++bj) { const f32x4 t1 = acc[ai][bj][m][0], t2 = acc[ai][bj][m][1]; const f32x4 o1 = (t1 * c - t2 * s) * sc, o2 = (t2 * c + t1 * s) * sc;
                        *(u32x4*)(base + (size_t)t * 1024 + bj * HALF) = pack8(o1, o2); } }
        } else if (pn < 14) {
            bf16_t* base; int ld; if (pn < 12) { base = vb + (pn - 8) * 256 + cw; ld = 1024; } else { base = ub + (pn - 12) * 256 + cw; ld = 512; }
#pragma unroll
            for (int ai = 0; ai < 2; ++ai)
#pragma unroll
                for (int m = 0; m < 4; ++m) { const int t = row0 + ai * HALF + m * 16;
#pragma unroll
                    for (int bj = 0; bj < 2; ++bj) *(u32x4*)(base + (size_t)t * ld + bj * HALF) = pack8(acc[ai][bj][m][0], acc[ai][bj][m][1]); }
        }
#ifdef DBG_PLAIN_EPI
        else { const int col0 = (pn - 14) * 256 + cw;
            for (int ai = 0; ai < 2; ++ai) for (int m = 0; m < 4; ++m) { const int t = row0 + ai * HALF + m * 16; for (int bj = 0; bj < 2; ++bj) *(u32x4*)(gb + (size_t)t * 2048 + col0 + bj * HALF) = pack8(acc[ai][bj][m][0], acc[ai][bj][m][1]); } }
#else
        else {
            const int col0 = (pn - 14) * 256 + cw; f32x4 bv[2][2];
#pragma unroll
            for (int bj = 0; bj < 2; ++bj)
#pragma unroll
                for (int n = 0; n < 2; ++n) bv[bj][n] = *(const f32x4*)(gate_bias + col0 + bj * HALF + 4 * n);
#pragma unroll
            for (int ai = 0; ai < 2; ++ai)
#pragma unroll
                for (int m = 0; m < 4; ++m) { const int t = row0 + ai * HALF + m * 16;
#pragma unroll
                    for (int bj = 0; bj < 2; ++bj) { f32x4 v0 = acc[ai][bj][m][0] + bv[bj][0], v1 = acc[ai][bj][m][1] + bv[bj][1];
#pragma unroll
                        for (int j = 0; j < 4; ++j) { v0[j] = sigmoidf_(v0[j]); v1[j] = sigmoidf_(v1[j]); }
                        *(u32x4*)(gb + (size_t)t * 2048 + col0 + bj * HALF) = pack8(v0, v1); } }
        }
#endif
    }
};
struct EpiScaleBf16 {
    static constexpr bool PERM = true;
    bf16_t* O; int ldc; const float* colscale;
    __device__ __forceinline__ void operator()(const f32x4 (&acc)[2][2][4][2], const GUnit& u, int wr, int wc, int fr, int fq) const {
        const int row0 = u.pm * BM + wr * 64 + fr, col0 = u.pn * BM + wc * 32 + 8 * fq; f32x4 sv[2][2];
#pragma unroll
        for (int bj = 0; bj < 2; ++bj)
#pragma unroll
            for (int n = 0; n < 2; ++n) sv[bj][n] = *(const f32x4*)(colscale + col0 + bj * HALF + 4 * n);
#pragma unroll
        for (int ai = 0; ai < 2; ++ai)
#pragma unroll
            for (int m = 0; m < 4; ++m) { bf16_t* rowp = O + (size_t)(row0 + ai * HALF + m * 16) * ldc + col0;
#pragma unroll
                for (int bj = 0; bj < 2; ++bj) *(u32x4*)(rowp + bj * HALF) = pack8(acc[ai][bj][m][0] * sv[bj][0], acc[ai][bj][m][1] * sv[bj][1]); }
    }
};
template <int BR> struct EpiMerge {
    static constexpr bool PERM = true;
    const bf16_t* gates; bf16_t* merged;
    __device__ __forceinline__ void operator()(const f32x4 (&acc)[2][2][4][2], const GUnit& u, int wr, int wc, int fr, int fq) const {
        const int row0 = u.pm * BM + wr * 64 + fr, col0 = u.pn * BM + wc * 32 + 8 * fq;
#pragma unroll
        for (int ai = 0; ai < 2; ++ai)
#pragma unroll
            for (int m = 0; m < 4; ++m) { const size_t t = row0 + ai * HALF + m * 16;
#pragma unroll
                for (int bj = 0; bj < 2; ++bj) { const u32x4 g = *(const u32x4*)(gates + t * 2048 + BR * 1024 + col0 + bj * HALF); bf16_t* mp = merged + t * 1024 + col0 + bj * HALF;
                    f32x4 v0 = acc[ai][bj][m][0], v1 = acc[ai][bj][m][1];
                    v0 = v0 * (f32x4){bflo(g.x), bfhi(g.x), bflo(g.y), bfhi(g.y)}; v1 = v1 * (f32x4){bflo(g.z), bfhi(g.z), bflo(g.w), bfhi(g.w)};
                    if (BR) { const u32x4 p = *(const u32x4*)mp; v0 = v0 + (f32x4){bflo(p.x), bfhi(p.x), bflo(p.y), bfhi(p.y)}; v1 = v1 + (f32x4){bflo(p.z), bfhi(p.z), bflo(p.w), bfhi(p.w)}; }
                    *(u32x4*)mp = pack8(v0, v1); } }
    }
};
struct EpiResid {
    static constexpr bool PERM = false;
    const float* x; float* y;
    __device__ __forceinline__ void operator()(const f32x4 (&acc)[2][2][4][2], const GUnit& u, int wr, int wc, int fr, int fq) const {
        const int row0 = u.pm * BM + wr * 64 + fr, col0 = u.pn * BM + wc * 32 + 4 * fq;
#pragma unroll
        for (int ai = 0; ai < 2; ++ai)
#pragma unroll
            for (int m = 0; m < 4; ++m) { const size_t off = (size_t)(row0 + ai * HALF + m * 16) * 1024 + col0;
#pragma unroll
                for (int bj = 0; bj < 2; ++bj)
#pragma unroll
                    for (int n = 0; n < 2; ++n) { const f32x4 xv = *(const f32x4*)(x + off + bj * HALF + n * 16); *(f32x4*)(y + off + bj * HALF + n * 16) = xv * ALPHA + acc[ai][bj][m][n]; } }
    }
};
struct EpiGateUp {
    static constexpr bool PERM = true;
    bf16_t* h;
    __device__ __forceinline__ void operator()(const f32x4 (&acc)[2][2][4][2], const GUnit& u, int wr, int wc, int fr, int fq) const {
        const int row0 = u.pm * BM + wr * 64 + fr, col0 = u.pn * 128 + wc * 16 + 4 * fq;
#pragma unroll
        for (int ai = 0; ai < 2; ++ai)
#pragma unroll
            for (int m = 0; m < 4; ++m) { bf16_t* rowp = h + (size_t)(row0 + ai * HALF + m * 16) * 512 + col0;
#pragma unroll
                for (int bj = 0; bj < 2; ++bj) { const f32x4 g = acc[ai][bj][m][0], up = acc[ai][bj][m][1]; f32x4 o;
#pragma unroll
                    for (int j = 0; j < 4; ++j) o[j] = g[j] * sigmoidf_(g[j]) * up[j];
                    u32x2 w; w.x = cvt_pk_bf16(o[0], o[1]); w.y = cvt_pk_bf16(o[2], o[3]); *(u32x2*)(rowp + bj * 64) = w; } }
    }
};
struct EpiDown {
    static constexpr bool PERM = true;
    bf16_t* ybuf; const int* list; const float* rw; const volatile LAS unsigned* cntl;
    __device__ __forceinline__ void operator()(const f32x4 (&acc)[2][2][4][2], const GUnit& u, int wr, int wc, int fr, int fq) const {
        const int p0 = u.r0 + wr * 64 + fr, col0 = u.pn * BM + wc * 32 + 8 * fq; const int cn = (int)cntl[u.e];
#pragma unroll
        for (int ai = 0; ai < 2; ++ai)
#pragma unroll
            for (int m = 0; m < 4; ++m) { const int p = p0 + ai * HALF + m * 16;
                if (p < cn) { const int ent = list[(size_t)u.e * T + p]; const float w = rw[ent]; bf16_t* rowp = ybuf + (size_t)ent * 1024 + col0;
#pragma unroll
                    for (int bj = 0; bj < 2; ++bj) *(u32x4*)(rowp + bj * HALF) = pack8(acc[ai][bj][m][0] * w, acc[ai][bj][m][1] * w); } }
    }
};
}

namespace at2 {
using f32x16 = __attribute__((ext_vector_type(16))) float;
using s16x4  = __attribute__((ext_vector_type(4))) short;
constexpr int KB_BYTES = 8192, VB_BYTES = 16384, KSLOT = 2 * KB_BYTES, NKS = 4, NVS = 3, OFF_V = NKS * KSLOT;
constexpr int OFF_Q = OFF_V + NVS * VB_BYTES, OFF_WS = 151552;
#define AT_SBAR() __builtin_amdgcn_sched_barrier(0)
__device__ __forceinline__ int crow(int r, int hi) { return (r & 3) + 8 * (r >> 2) + 4 * hi; }
__device__ __forceinline__ int v_st(int k, int c) { const int kk = (k & ~0xC) | ((k & 4) << 1) | ((k & 8) >> 1); return ((kk >> 3) * 4 + (c >> 5)) * 512 + ((kk & 7) * 32 + (c & 31)) * 2; }
__device__ __forceinline__ int v_rd_base(int lane) { return ((lane & 3) << 3) | (((lane >> 2) & 3) << 6) | (((lane >> 4) & 1) << 5) | (((lane >> 5) & 1) << 8); }
constexpr int v_rd_off(int d0, int ks, int half) { return d0 * 512 + ks * 4096 + half * 2048; }
template <int OFF> __device__ __forceinline__ s16x4 tr_read(int vb) { s16x4 r; asm volatile("ds_read_b64_tr_b16 %0, %1 offset:%2" : "=&v"(r) : "v"(vb), "i"(OFF) : "memory"); return r; }
template <int D0> __device__ __forceinline__ void pv_one(f32x16& od, int vb, bf16x8 pa0, bf16x8 pa1, bf16x8 pa2, bf16x8 pa3) {
    const s16x4 l0 = tr_read<v_rd_off(D0, 0, 0)>(vb), h0 = tr_read<v_rd_off(D0, 0, 1)>(vb), l1 = tr_read<v_rd_off(D0, 1, 0)>(vb), h1 = tr_read<v_rd_off(D0, 1, 1)>(vb);
    const s16x4 l2 = tr_read<v_rd_off(D0, 2, 0)>(vb), h2 = tr_read<v_rd_off(D0, 2, 1)>(vb), l3 = tr_read<v_rd_off(D0, 3, 0)>(vb), h3 = tr_read<v_rd_off(D0, 3, 1)>(vb);
    asm volatile("s_waitcnt lgkmcnt(0)" ::: "memory"); AT_SBAR();
#define AT_PK(L, H) (bf16x8){L[0], L[1], L[2], L[3], H[0], H[1], H[2], H[3]}
    od = __builtin_amdgcn_mfma_f32_32x32x16_bf16(pa0, AT_PK(l0, h0), od, 0, 0, 0);
    od = __builtin_amdgcn_mfma_f32_32x32x16_bf16(pa1, AT_PK(l1, h1), od, 0, 0, 0);
    od = __builtin_amdgcn_mfma_f32_32x32x16_bf16(pa2, AT_PK(l2, h2), od, 0, 0, 0);
    od = __builtin_amdgcn_mfma_f32_32x32x16_bf16(pa3, AT_PK(l3, h3), od, 0, 0, 0);
#undef AT_PK
}
__device__ __forceinline__ void qkt(f32x16& p0, f32x16& p1, const LAS unsigned char* Ks, const bf16x8* qr, int r32, int hi) {
    p0 = f32x16{}; p1 = f32x16{};
#pragma unroll
    for (int d0 = 0; d0 < 4; ++d0) { const LAS unsigned char* kp = Ks + (2 * d0 + hi) * 1024 + r32 * 16;
        const bf16x8 b0 = *(const LAS bf16x8*)(kp), b1 = *(const LAS bf16x8*)(kp + 512);
        p0 = __builtin_amdgcn_mfma_f32_32x32x16_bf16(b0, qr[d0], p0, 0, 0, 0);
        p1 = __builtin_amdgcn_mfma_f32_32x32x16_bf16(b1, qr[d0], p1, 0, 0, 0); }
}
__device__ __forceinline__ float hswap_max(float v) { auto rr = __builtin_amdgcn_permlane32_swap(__float_as_uint(v), __float_as_uint(v), false, false); return fmaxf(__uint_as_float(rr[0]), __uint_as_float(rr[1])); }
__device__ __forceinline__ float hswap_sum(float v) { auto rr = __builtin_amdgcn_permlane32_swap(__float_as_uint(v), __float_as_uint(v), false, false); return __uint_as_float(rr[0]) + __uint_as_float(rr[1]); }

template <unsigned var> __device__ __forceinline__ void attn_unit(LAS unsigned char* lds, int b, int head, int qblk, const bf16_t* __restrict__ Q, const bf16_t* __restrict__ K, const bf16_t* __restrict__ V,
                                          bf16_t* __restrict__ O, const float lam, const float* __restrict__ gain) {
    const int tid = threadIdx.x, lane = tid & 63, r32 = lane & 31, hi = lane >> 5; const int wid = __builtin_amdgcn_readfirstlane(tid >> 6); const int mp = wid >> 2, wq = wid & 3;
    const int hm = head * 2 + mp; const size_t rowbase = (size_t)b * SEQ; const int q0 = qblk * 128;
    const int mychunk = 2 * qblk + (wq >> 1); const int NT = 2 * qblk + 2;
    LAS float* wsf = (LAS float*)(lds + OFF_WS) + wid * 64;
    LAS unsigned char* qlds = lds + OFF_Q + wid * 4096 + hi * 512 + r32 * 16;
    { const bf16_t* qp = Q + (rowbase + q0 + wq * 32 + r32) * 1024 + hm * 64 + hi * 8;
#pragma unroll
      for (int d0 = 0; d0 < 4; ++d0) *(LAS bf16x8*)(qlds + d0 * 1024) = *(const bf16x8*)(qp + d0 * 16); }
    const char* Kb = (const char*)(K + rowbase * 1024); const char* Vb = (const char*)(V + rowbase * 1024);
    unsigned kofs[2], vofs[2];
#pragma unroll
    for (int i = 0; i < 2; ++i) { const int ch = 2 * wq + i; kofs[i] = (unsigned)(lane * 2048 + hm * 128 + ch * 16);
        const int p = 2 * wid + i; const int kk = (p >> 1) * 8 + ((lane & 31) >> 2); const int k = (kk & ~0xC) | ((kk & 4) << 1) | ((kk & 8) >> 1); const int c = (2 * (p & 1) + (lane >> 5)) * 32 + (lane & 3) * 8;
        vofs[i] = (unsigned)(k * 2048 + head * 256 + c * 2); }
    const unsigned kdst = (unsigned)(mp * KB_BYTES + (2 * wq) * 1024), vdst = (unsigned)(OFF_V + (2 * wid) * 1024);
#define AT_DMA_K(j, KO) do { const char* kj_ = Kb + (size_t)(j) * 131072; \
        __builtin_amdgcn_global_load_lds((const unsigned*)(kj_ + kofs[0]), (LAS unsigned*)(lds + (KO) + kdst), 16, 0, 0); __builtin_amdgcn_global_load_lds((const unsigned*)(kj_ + kofs[1]), (LAS unsigned*)(lds + (KO) + kdst + 1024), 16, 0, 0); } while (0)
#define AT_DMA_V(j, VO) do { const char* vj_ = Vb + (size_t)(j) * 131072; \
        __builtin_amdgcn_global_load_lds((const unsigned*)(vj_ + vofs[0]), (LAS unsigned*)(lds + (VO) + vdst), 16, 0, 0); __builtin_amdgcn_global_load_lds((const unsigned*)(vj_ + vofs[1]), (LAS unsigned*)(lds + (VO) + vdst + 1024), 16, 0, 0); } while (0)
    float mhat = 0.f, l_reg = 0.f; f32x16 o[4] = {};
    const int vb0 = (int)(uintptr_t)(lds + OFF_V) + v_rd_base(lane);
    const LAS unsigned char* kb0 = lds + mp * KB_BYTES;
    constexpr float THR = 8.f;
    f32x16 pA0 = {}, pA1 = {}, pB0 = {}, pB1 = {}; float alA = 1.f, alB = 1.f; bool rsA = false, rsB = false;
    int kcur = 0, k1 = KSLOT, k2 = 2 * KSLOT;
    int vprev = 2 * VB_BYTES, vcur = 0, vnext = VB_BYTES;
#define AT_ROT() do { kcur = k1; k1 = k2; k2 = (k2 == (NKS - 1) * KSLOT) ? 0 : k2 + KSLOT; vprev = vcur; vcur = vnext; vnext = (vnext == (NVS - 1) * VB_BYTES) ? 0 : vnext + VB_BYTES; } while (0)
#define AT_QKT(P0, P1, SL) do { const LAS unsigned char* kp_ = kb0 + (SL) + hi * 1024 + r32 * 16; P0 = f32x16{}; P1 = f32x16{}; \
        _Pragma("unroll") for (int d0 = 0; d0 < 4; ++d0) { const bf16x8 b0_ = *(const LAS bf16x8*)(kp_ + d0 * 2048), b1_ = *(const LAS bf16x8*)(kp_ + d0 * 2048 + 512), q_ = *(const LAS bf16x8*)(qlds + d0 * 1024); \
            P0 = __builtin_amdgcn_mfma_f32_32x32x16_bf16(b0_, q_, P0, 0, 0, 0); P1 = __builtin_amdgcn_mfma_f32_32x32x16_bf16(b1_, q_, P1, 0, 0, 0); } } while (0)
#define AT_PSM(P0, P1, AL, RS, FIRST) do { float pm_ = P0[0]; _Pragma("unroll") for (int r = 1; r < 16; ++r) pm_ = fmaxf(pm_, P0[r]); _Pragma("unroll") for (int r = 0; r < 16; ++r) pm_ = fmaxf(pm_, P1[r]); \
        pm_ = hswap_max(pm_) - mhat; RS = (FIRST) || __any(pm_ > THR); AL = 1.f; \
        if (RS) { const float dl_ = (FIRST) ? pm_ : fmaxf(pm_, 0.f); mhat += dl_; AL = __builtin_amdgcn_exp2f(-dl_); } \
        _Pragma("unroll") for (int r = 0; r < 16; ++r) { P0[r] = __builtin_amdgcn_exp2f(P0[r] - mhat); P1[r] = __builtin_amdgcn_exp2f(P1[r] - mhat); } } while (0)
#define AT_PK4(P, BASE, OUT) do { const unsigned a0 = cvt_pk_bf16(P[BASE + 0], P[BASE + 1]), a1 = cvt_pk_bf16(P[BASE + 2], P[BASE + 3]); \
        const unsigned b0 = cvt_pk_bf16(P[BASE + 4], P[BASE + 5]), b1 = cvt_pk_bf16(P[BASE + 6], P[BASE + 7]); \
        auto r0_ = __builtin_amdgcn_permlane32_swap(a0, b0, false, false); auto r1_ = __builtin_amdgcn_permlane32_swap(a1, b1, false, false); \
        u32x4 w_ = {r0_[0], r1_[0], r0_[1], r1_[1]}; OUT = __builtin_bit_cast(bf16x8, w_); } while (0)
#define AT_FIN_PV(P0, P1, AL, SL) do { float ps_ = 0.f; _Pragma("unroll") for (int r = 0; r < 16; ++r) ps_ += P0[r]; _Pragma("unroll") for (int r = 0; r < 16; ++r) ps_ += P1[r]; \
        ps_ = hswap_sum(ps_); l_reg = l_reg * (AL) + ps_; bf16x8 pa0, pa1, pa2, pa3; AT_PK4(P0, 0, pa0); AT_PK4(P0, 8, pa1); AT_PK4(P1, 0, pa2); AT_PK4(P1, 8, pa3); const int vb_ = vb0 + (SL); \
        pv_one<0>(o[0], vb_, pa0, pa1, pa2, pa3); pv_one<1>(o[1], vb_, pa0, pa1, pa2, pa3); pv_one<2>(o[2], vb_, pa0, pa1, pa2, pa3); pv_one<3>(o[3], vb_, pa0, pa1, pa2, pa3); } while (0)
#define AT_RESC(AL, RS) do { if (RS) { if (hi == 0) wsf[r32] = (AL); asm volatile("s_waitcnt lgkmcnt(0)" ::: "memory"); \
        _Pragma("unroll") for (int r = 0; r < 16; ++r) { const float a_ = wsf[crow(r, hi)]; _Pragma("unroll") for (int d = 0; d < 4; ++d) o[d][r] *= a_; } } } while (0)
#define AT_STEP0(u, PC0, PC1, ALC, RSC, PP0, PP1, ALP) do { const bool nk_ = (u) + 2 < NT && !(var & 2u), nv_ = (u) + 1 < NT && !(var & 2u); if (nk_) AT_DMA_K((u) + 2, k2); if (nv_) AT_DMA_V((u) + 1, vnext); \
        const bool aX_ = (u) < NT && (u) <= mychunk, aF_ = (u) >= 1 && (u) - 1 <= mychunk; \
        if (aX_ && !(var & 16u)) AT_QKT(PC0, PC1, kcur); \
        if (aF_ && !(var & 4u)) AT_FIN_PV(PP0, PP1, ALP, vprev); \
        if (aX_ && !(var & 8u)) { AT_PSM(PC0, PC1, ALC, RSC, (u) == 0); AT_RESC(ALC, RSC); } \
        if (nk_) asm volatile("s_waitcnt vmcnt(4)" ::: "memory"); else if (nv_) asm volatile("s_waitcnt vmcnt(2)" ::: "memory"); else asm volatile("s_waitcnt vmcnt(0)" ::: "memory"); \
        __syncthreads(); AT_ROT(); } while (0)
    AT_DMA_K(0, 0); AT_DMA_V(0, 0); if (!(var & 2u) || true) AT_DMA_K(1, KSLOT); asm volatile("s_waitcnt vmcnt(0)" ::: "memory"); __syncthreads();
    for (int u = 0; u < NT + 2; u += 2) { AT_STEP0(u, pA0, pA1, alA, rsA, pB0, pB1, alB); AT_STEP0(u + 1, pB0, pB1, alB, rsB, pA0, pA1, alA); }
#undef AT_DMA_K
#undef AT_DMA_V
#undef AT_ROT
#undef AT_QKT
#undef AT_PSM
#undef AT_PK4
#undef AT_FIN_PV
#undef AT_RESC
#undef AT_STEP0
    if (hi == 0) wsf[r32] = 1.f / l_reg;
    asm volatile("s_waitcnt lgkmcnt(0)" ::: "memory");
    float rli[16];
#pragma unroll
    for (int r = 0; r < 16; ++r) rli[r] = wsf[crow(r, hi)];
    LAS float* xch = (LAS float*)lds + wq * 4096;
    if (mp == 1) {
#pragma unroll
        for (int d = 0; d < 4; ++d)
#pragma unroll
            for (int r = 0; r < 16; ++r) xch[(d * 16 + r) * 64 + lane] = o[d][r] * rli[r];
    }
    __syncthreads();
    if (mp == 0) {
#pragma unroll
        for (int d = 0; d < 4; ++d)
#pragma unroll
            for (int r = 0; r < 16; ++r) { const float v2 = xch[(d * 16 + r) * 64 + lane]; o[d][r] = o[d][r] * rli[r] - lam * v2; }
    }
    __syncthreads();
    LAS float* stg = (LAS float*)lds + wq * 4224;
    if (mp == 0) {
#pragma unroll
        for (int d = 0; d < 4; ++d)
#pragma unroll
            for (int r = 0; r < 16; ++r) stg[crow(r, hi) * 132 + d * 32 + r32] = o[d][r];
        asm volatile("s_waitcnt lgkmcnt(0)" ::: "memory");
        const int row = lane >> 1, ch = (lane & 1) * 64; const LAS float* sp = stg + row * 132 + ch; float vv[64]; float ss = 0.f;
#pragma unroll
        for (int i = 0; i < 16; ++i) { const f32x4 t4 = *(const LAS f32x4*)(sp + 4 * i); vv[4 * i] = t4[0]; vv[4 * i + 1] = t4[1]; vv[4 * i + 2] = t4[2]; vv[4 * i + 3] = t4[3]; ss += (t4[0] * t4[0] + t4[1] * t4[1]) + (t4[2] * t4[2] + t4[3] * t4[3]); }
        ss += __shfl_xor(ss, 1);
        const float rs = (1.0f / sqrtf(ss * (1.f / 128.f) + RMS_EPS)) * (1.f - LAMBDA_INIT);
        bf16_t* op = O + (rowbase + q0 + wq * 32 + row) * 1024 + head * 128 + ch; const float* gp = gain + ch;
#pragma unroll
        for (int i = 0; i < 8; ++i) { const f32x4 g0 = *(const f32x4*)(gp + 8 * i), g1 = *(const f32x4*)(gp + 8 * i + 4); u32x4 w;
            w.x = cvt_pk_bf16(vv[8 * i] * rs * g0[0], vv[8 * i + 1] * rs * g0[1]); w.y = cvt_pk_bf16(vv[8 * i + 2] * rs * g0[2], vv[8 * i + 3] * rs * g0[3]);
            w.z = cvt_pk_bf16(vv[8 * i + 4] * rs * g1[0], vv[8 * i + 5] * rs * g1[1]); w.w = cvt_pk_bf16(vv[8 * i + 6] * rs * g1[2], vv[8 * i + 7] * rs * g1[3]);
            *(u32x4*)(op + 8 * i) = w; }
    }
    __syncthreads();
}
template <unsigned var> __device__ __forceinline__ void attn_phase(LAS unsigned char* lds, int vcu, int ncu, const bf16_t* Q, const bf16_t* K, const bf16_t* V, bf16_t* O, const float* scal, const float* gain) {
    const float lam = scal[0];
    for (int bh = vcu >> 1; bh < NB * NHEAD; bh += (ncu >> 1)) {
        const int b = bh >> 3, head = bh & 7;
        for (int i = 0; i < 8; ++i) { const int s = (vcu & 1) + 2 * (i >> 1); const int qblk = (i & 1) ? 15 - s : s;
            attn_unit<var>(lds, b, head, qblk, Q, K, V, O, lam, gain); }
    }
}
#undef AT_SBAR
}

struct MKArgs { const void* in[21]; float* out; unsigned char* ws; unsigned mask; unsigned li; };
enum { PH_PRO = 0, PH_G1, PH_POOLA, PH_ATT, PH_POOLG, PH_G4A, PH_G4B, PH_G5, PH_ROUTER, PH_G7, PH_G8, PH_FINAL, PH_N };

template <int MODE> __device__ __forceinline__ int dest_row(int n) {
    if (MODE == 1) return n < 2048 ? (n & ~63) + qk_pos_of_d(n & 63) : n;
    if (MODE == 2) { const int nn = n >> 9, hc = n & 511; return (hc >> 7) * 256 + ((hc >> 6) & 1) * 128 + ((hc >> 4) & 3) * 32 + ((hc >> 2) & 3) * 8 + nn * 4 + (hc & 3); }
    return n;
}
template <int MODE> __device__ __forceinline__ void transpose_item(const float* __restrict__ W, int ldw, int N, bf16_t* __restrict__ WT, int ldt, int coloff, int rowoff, LAS float* scr, int item, int lane) {
    const int nblk = N / 64, kb = item / nblk, nb = item % nblk, k0 = 64 * kb, n0 = 64 * nb;
    const int lr = lane >> 4, n4 = (lane & 15) * 4;
#pragma unroll 4
    for (int i = 0; i < 16; ++i) { const int kk = 4 * i + lr; const f32x4 v = *(const f32x4*)(W + (size_t)(k0 + kk) * ldw + n0 + n4); *(LAS f32x4*)(scr + kk * 64 + (n4 ^ ((kk >> 3) << 2))) = v; }
    LDS_WAIT(); asm volatile("" ::: "memory");
    const int c = lane & 7;
#pragma unroll 2
    for (int jj = 0; jj < 8; ++jj) { const int n = 8 * jj + (lane >> 3); const LAS float* sp = scr + (8 * c) * 64 + (n ^ (c << 2));
        u32x4 o; o.x = cvt_pk_bf16(sp[0 * 64], sp[1 * 64]); o.y = cvt_pk_bf16(sp[2 * 64], sp[3 * 64]); o.z = cvt_pk_bf16(sp[4 * 64], sp[5 * 64]); o.w = cvt_pk_bf16(sp[6 * 64], sp[7 * 64]);
        *(u32x4*)(WT + (size_t)(rowoff + dest_row<MODE>(n0 + n)) * ldt + coloff + k0 + 8 * c) = o; }
    LDS_WAIT(); asm volatile("" ::: "memory");
}

__global__ void __launch_bounds__(NTHREADS, 2) mk_fwd(MKArgs args) {
    __shared__ __attribute__((aligned(16))) unsigned char lds_raw[LDS_BYTES];
    LAS unsigned char* lds = (LAS unsigned char*)lds_raw;
    volatile LAS unsigned* MISC = (volatile LAS unsigned*)(lds + MISC_OFF);
    const int tid = threadIdx.x, lane = tid & 63, wave = __builtin_amdgcn_readfirstlane(tid >> 6);
    const int G = gridDim.x; const int bx = blockIdx.x; const int vcu = (G % 8 == 0) ? (bx % 8) * (G / 8) + bx / 8 : bx;
    const unsigned mask = args.mask;
    unsigned char* const ws = args.ws; float* const out = args.out;
#define IN_F(k) ((const float*)args.in[k])
#define x_ IN_F(0)
#define positions ((const int*)args.in[1])
#define w_in IN_F(2)
#define gate_bias IN_F(3)
#define lam_vecs IN_F(4)
#define subln_gain IN_F(5)
#define w_pool IN_F(6)
#define pool_scale IN_F(7)
#define w_branch_a IN_F(8)
#define w_branch_b IN_F(9)
#define w_out IN_F(10)
#define ln1_g IN_F(11)
#define ln1_b IN_F(12)
#define wrg IN_F(13)
#define brg IN_F(14)
#define wre IN_F(15)
#define bre IN_F(16)
#define wgu IN_F(17)
#define wdn IN_F(18)
#define ln2_g IN_F(19)
#define ln2_b IN_F(20)
#define wt ((bf16_t*)(ws + WS_WT))
#define xb ((bf16_t*)(ws + WS_XB))
#define qb ((bf16_t*)(ws + WS_Q))
#define kb ((bf16_t*)(ws + WS_K))
#define vb ((bf16_t*)(ws + WS_V))
#define ub ((bf16_t*)(ws + WS_U))
#define gb ((bf16_t*)out)
#define on ((bf16_t*)(ws + WS_ON))
#define mixed ((bf16_t*)(ws + WS_MIXED))
#define merged ((bf16_t*)(ws + WS_MERGED))
#define x1b ((bf16_t*)(ws + WS_X1B))
#define hb ((bf16_t*)(ws + WS_H))
#define ybuf ((bf16_t*)(ws + WS_YBUF))
#define rope ((float*)(ws + WS_ROPE))
#define pooled ((bf16_t*)(ws + WS_POOLED))
#define misc (ws + WS_MISC)
#define ctl ((unsigned*)(misc + MS_CTL))
#define stats ((float2*)(misc + MS_STATS))
#define rw ((float*)(misc + MS_ROUTE + (size_t)T * 8))
#define list ((int*)(misc + MS_LIST))
#define scal ((float*)(misc + MS_SCAL))
#define cnt (ctl + CW_CNT)
#define wpool_bd ((bf16_t*)(misc + MS_WPOOL))

    for (int u = tid; u < (LDS_BYTES - LDS_CTL_OFF) / 4; u += NTHREADS) ((LAS unsigned*)(lds + LDS_CTL_OFF))[u] = 0u;
    __syncthreads();
    XcdBarrier bar; bar.bar = ctl + CW_BAR + (args.li & 255u) * XCD_BAR_WORDS; bar.x = 0; bar.st = nullptr;
    const bool multi = (mask & (mask - 1u)) != 0u;
    if (multi) bar = xcd_barrier_post(ctl + CW_BAR + (args.li & 255u) * XCD_BAR_WORDS, MISC + 8);
#ifndef MK_CT
#define MK_CT 0xfffu
#endif
#define HAS(p) (((MK_CT >> (p)) & 1u) && ((mask >> (p)) & 1u))
#ifndef MK_REP
#define MK_REP 0u
#endif
#define REPS(p) for (int rep_ = 0; rep_ < ((((MK_REP) >> (p)) & 1u) ? 2 : 1); ++rep_)
#define SEAM(p) do { if (multi && (mask >> ((p) + 1)) != 0u) xcd_barrier(bar); } while (0)
    const int gw = vcu * NWAVES + wave, NGW = G * NWAVES;

    if (HAS(PH_PRO)) {
        LAS float* scr = (LAS float*)(lds + wave * 16384);
        constexpr int I_IN = 16 * (INW / 64), I_A = 16 * 16, I_O = 16 * 16, I_GU = 16 * 16, I_DN = 8 * 16;
        constexpr int NITEMS = I_IN + I_A + I_O + NE * I_GU + NE * I_DN;
        for (int it = gw; it < NITEMS; it += NGW) {
            int r = it;
            if (r < I_IN) { transpose_item<1>(w_in, INW, INW, wt + WT_IN, 1024, 0, 0, scr, r, lane); continue; } r -= I_IN;
            if (r < I_A) { transpose_item<0>(w_branch_a, 1024, 1024, wt + WT_A, 1024, 0, 0, scr, r, lane); continue; } r -= I_A;
            if (r < I_O) { transpose_item<0>(w_out, 1024, 1024, wt + WT_O, 1024, 0, 0, scr, r, lane); continue; } r -= I_O;
            if (r < NE * I_GU) { const int e = r / I_GU; transpose_item<2>(wgu + (size_t)e * 1024 * 1024, 1024, 1024, wt + WT_GU + (size_t)e * 1024 * 1024, 1024, 0, 0, scr, r % I_GU, lane); continue; } r -= NE * I_GU;
            { const int e = r / I_DN; transpose_item<0>(wdn + (size_t)e * 512 * 1024, 1024, 1024, wt + WT_DN + (size_t)e * 1024 * 512, 512, 0, 0, scr, r % I_DN, lane); }
        }
        for (int it = gw; it < 64 * 16; it += NGW) { const int kc = it >> 4, n = (it & 15) * 64 + lane; const int g = kc >> 4, c0 = (kc & 15) * 8; float a8[8] = {0.f, 0.f, 0.f, 0.f, 0.f, 0.f, 0.f, 0.f};
            const float* wpg = w_pool + (size_t)(g * 128 + c0) * 128; const float* wbp = w_branch_b + (size_t)(g * 128) * 1024 + n; const float* psp = pool_scale + g * 128;
            for (int d = 0; d < 128; ++d) { const float bv = wbp[(size_t)d * 1024] * psp[d];
#pragma unroll
                for (int i = 0; i < 8; ++i) a8[i] = fmaf(wpg[i * 128 + d], bv, a8[i]); }
            u32x4 o; o.x = cvt_pk_bf16(a8[0], a8[1]); o.y = cvt_pk_bf16(a8[2], a8[3]); o.z = cvt_pk_bf16(a8[4], a8[5]); o.w = cvt_pk_bf16(a8[6], a8[7]);
            *(u32x4*)(wt + WT_B + (size_t)n * 512 + kc * 8) = o; }
        for (int m = gw; m < T; m += NGW) { const f32x4* xr = (const f32x4*)(x_ + (size_t)m * 1024) + lane; u32x2* o8 = (u32x2*)(xb + (size_t)m * 1024) + lane;
#pragma unroll
            for (int j = 0; j < 4; ++j) { const f32x4 v = xr[64 * j]; u32x2 w; w.x = cvt_pk_bf16(v[0], v[1]); w.y = cvt_pk_bf16(v[2], v[3]); o8[64 * j] = w; } }
        for (int e = gw * 64 + lane; e < T * 32; e += NGW * 64) { const int t = e >> 5, i = e & 31; const float inv = powf(10000.0f, -(float)i * (2.0f / 64.0f)); const float ang = (float)positions[t] * inv; const double a = (double)ang;
            rope[2 * e] = (float)cos(a); rope[2 * e + 1] = (float)sin(a); }
        if (gw == 0 && lane == 0) { float s01 = 0.f, s23 = 0.f; for (int i = 0; i < 64; ++i) { s01 += lam_vecs[i] * lam_vecs[64 + i]; s23 += lam_vecs[128 + i] * lam_vecs[192 + i]; } scal[0] = expf(s01) - expf(s23) + LAMBDA_INIT; }
        { f32x4* wp = (f32x4*)(misc + MS_WP);
          for (int e = gw * 64 + lane; e < 16 * 3 * 4 * 64; e += NGW * 64) { const int l = e & 63, sg = (e >> 6) & 3, ob = (e >> 8) % 3, chunk = (e >> 8) / 3; const int o = ob * 16 + (l & 15); f32x4 v = {0.f, 0.f, 0.f, 0.f};
              if (o < 36) {
#pragma unroll
                  for (int j = 0; j < 4; ++j) { const int c = chunk * 64 + (l >> 4) * 16 + 4 * sg + j; v[j] = ln1_g[c] * (o < 4 ? wrg[c * 4 + o] : wre[c * 32 + (o - 4)]); } }
              wp[e] = v; }
          float* csbw = (float*)(misc + MS_CSBW);
          if (gw < 48) { const int o = gw; float cs = 0.f, bw = 0.f;
              if (o < 36) { for (int i = 0; i < 16; ++i) { const int c = lane + 64 * i; const float w = (o < 4 ? wrg[c * 4 + o] : wre[c * 32 + (o - 4)]); cs += ln1_g[c] * w; bw += ln1_b[c] * w; }
                  cs = wave_sum(cs); bw = wave_sum(bw) + (o < 4 ? brg[o] : bre[o - 4]); }
              if (lane == 0) { csbw[o] = cs; csbw[48 + o] = bw; } } }
        __syncthreads();
        SEAM(PH_PRO);
    }
    if (HAS(PH_G1)) {
        g8::DenseOrder S; S.init(xb, wt + WT_IN, T, INW, 1024, G, bx);
        g8::EpiProj E{qb, kb, vb, ub, gb, rope, gate_bias};
        g8::gemm_phase<g8::EpiProj, g8::DenseOrder, true, false>(lds, 1024, S, E);
        SEAM(PH_G1);
    }
    if (HAS(PH_POOLA)) {
        for (int e = (gw * 64 + lane); e < T * 64; e += NGW * 64) { const int t = e >> 6, c8 = (e & 63) * 8; const int g = c8 >> 7, w = 2 << g, s = t & (SEQ - 1); const int n = (s + 1 < w) ? s + 1 : w;
            float a[8] = {0.f, 0.f, 0.f, 0.f, 0.f, 0.f, 0.f, 0.f}; float u0[8];
            for (int i = 0; i < n; ++i) { const u32x4 v = *(const u32x4*)(ub + (size_t)(t - i) * 512 + c8); const float f[8] = {bflo(v.x), bfhi(v.x), bflo(v.y), bfhi(v.y), bflo(v.z), bfhi(v.z), bflo(v.w), bfhi(v.w)};
#pragma unroll
                for (int j = 0; j < 8; ++j) { a[j] += f[j]; if (i == 0) u0[j] = f[j]; } }
            const float inv = 1.f / (float)n; u32x4 o; o.x = cvt_pk_bf16(a[0] * inv - u0[0], a[1] * inv - u0[1]); o.y = cvt_pk_bf16(a[2] * inv - u0[2], a[3] * inv - u0[3]);
            o.z = cvt_pk_bf16(a[4] * inv - u0[4], a[5] * inv - u0[5]); o.w = cvt_pk_bf16(a[6] * inv - u0[6], a[7] * inv - u0[7]);
            *(u32x4*)(pooled + (size_t)t * 512 + c8) = o; }
    }
    if (HAS(PH_ATT)) {
#ifdef MK_VAR
        if (args.li >> 8) at2::attn_phase<MK_VAR>(lds, vcu, G, qb, kb, vb, (bf16_t*)(ws + WS_POOLED), scal, subln_gain); else
#endif
        at2::attn_phase<0u>(lds, vcu, G, qb, kb, vb, on, scal, subln_gain);
        SEAM(PH_ATT); }
    else if (HAS(PH_POOLA)) { SEAM(PH_ATT); }
    if (HAS(PH_G4A)) {
        g8::DenseOrder S; S.init(on, wt + WT_A, T, 1024, 1024, G, bx);
        g8::EpiMerge<0> E{gb, merged};
        g8::gemm_phase<g8::EpiMerge<0>, g8::DenseOrder, true, false>(lds, 1024, S, E);
    }
    if (HAS(PH_G4B)) {
        g8::DenseOrder S; S.init(pooled, wt + WT_B, T, 1024, 512, G, bx);
        g8::EpiMerge<1> E{gb, merged};
        g8::gemm_phase<g8::EpiMerge<1>, g8::DenseOrder, true, false>(lds, 512, S, E);
        SEAM(PH_G4B);
    } else if (HAS(PH_G4A)) { SEAM(PH_G4B); }
    if (HAS(PH_G5)) {
        g8::DenseOrder S; S.init(merged, wt + WT_O, T, 1024, 1024, G, bx);
        g8::EpiResid E{x_, out};
        g8::gemm_phase<g8::EpiResid, g8::DenseOrder, true, false>(lds, 1024, S, E);
        SEAM(PH_G5);
    }
    if (HAS(PH_ROUTER)) {
        LAS float* lgs = (LAS float*)(lds + 0) + wave * (16 * 49);
        LAS float* tst = (LAS float*)(lds + 32768) + wave * 32;
        LAS int*   tex = (LAS int*)(lds + 36864) + wave * 64;
        LAS unsigned* lcnt = (LAS unsigned*)(lds + 40960);
        const f32x4* wp = (const f32x4*)(misc + MS_WP); const float* csbw = (const float*)(misc + MS_CSBW);
        for (int t0 = vcu * 128; t0 < T; t0 += G * 128) {
            if (tid < 64) lcnt[tid] = 0u;
            __syncthreads();
            const int tw = t0 + wave * 16; const int tk = lane & 15, q = lane >> 4;
            { const float* yr = out + (size_t)(tw + tk) * 1024 + q * 16; float s1 = 0.f, s2 = 0.f;
              f32x4 acc0 = {0.f, 0.f, 0.f, 0.f}, acc1 = {0.f, 0.f, 0.f, 0.f}, acc2 = {0.f, 0.f, 0.f, 0.f};
#pragma unroll 2
              for (int chunk = 0; chunk < 16; ++chunk) { f32x4 yv[4];
#pragma unroll
                  for (int j = 0; j < 4; ++j) yv[j] = *(const f32x4*)(yr + chunk * 64 + 4 * j);
#pragma unroll
                  for (int sg = 0; sg < 4; ++sg) { const f32x4 b0 = wp[((chunk * 3 + 0) * 4 + sg) * 64 + lane], b1 = wp[((chunk * 3 + 1) * 4 + sg) * 64 + lane], b2 = wp[((chunk * 3 + 2) * 4 + sg) * 64 + lane];
#pragma unroll
                      for (int j = 0; j < 4; ++j) { const float a = yv[sg][j]; s1 += a; s2 = fmaf(a, a, s2);
                          acc0 = __builtin_amdgcn_mfma_f32_16x16x4f32(a, b0[j], acc0, 0, 0, 0); acc1 = __builtin_amdgcn_mfma_f32_16x16x4f32(a, b1[j], acc1, 0, 0, 0); acc2 = __builtin_amdgcn_mfma_f32_16x16x4f32(a, b2[j], acc2, 0, 0, 0); } } }
              s1 += __shfl_xor(s1, 16); s1 += __shfl_xor(s1, 32); s2 += __shfl_xor(s2, 16); s2 += __shfl_xor(s2, 32);
              const float mu = s1 * (1.f / 1024.f); const float var = fmaxf(s2 * (1.f / 1024.f) - mu * mu, 0.f); const float rstd = 1.0f / sqrtf(var + LN_EPS);
              if (q == 0) { tst[2 * tk] = mu; tst[2 * tk + 1] = rstd; stats[tw + tk] = make_float2(mu, rstd); }
#pragma unroll
              for (int r = 0; r < 4; ++r) { lgs[(4 * q + r) * 49 + tk] = acc0[r]; lgs[(4 * q + r) * 49 + 16 + tk] = acc1[r]; lgs[(4 * q + r) * 49 + 32 + tk] = acc2[r]; } }
            LDS_WAIT();
            if (lane < 16) { const int t = tw + lane; const float mu = tst[2 * lane], rstd = tst[2 * lane + 1]; const LAS float* lr = lgs + lane * 49;
                float lg[4], le[32];
#pragma unroll
                for (int o = 0; o < 4; ++o) lg[o] = rstd * (lr[o] - mu * csbw[o]) + csbw[48 + o];
#pragma unroll
                for (int o = 0; o < 32; ++o) le[o] = rstd * (lr[4 + o] - mu * csbw[4 + o]) + csbw[48 + 4 + o];
                int gi = 0; float gm = lg[0];
#pragma unroll
                for (int o = 1; o < 4; ++o) if (lg[o] > gm) { gm = lg[o]; gi = o; }
                float gs = 0.f;
#pragma unroll
                for (int o = 0; o < 4; ++o) gs += expf(lg[o] - gm);
                const float gp = 1.f / gs; float ev[8];
#pragma unroll
                for (int o = 0; o < 8; ++o) { float vsel = le[o];
#pragma unroll
                    for (int g = 1; g < 4; ++g) vsel = (gi == g) ? le[g * 8 + o] : vsel;
                    ev[o] = vsel; }
                int i0 = 0; float m0v = ev[0];
#pragma unroll
                for (int o = 1; o < 8; ++o) if (ev[o] > m0v) { m0v = ev[o]; i0 = o; }
                int i1 = (i0 == 0) ? 1 : 0; float m1v = -3.4e38f;
#pragma unroll
                for (int o = 0; o < 8; ++o) if (o != i0 && ev[o] > m1v) { m1v = ev[o]; i1 = o; }
                const float e1 = expf(m1v - m0v); const float w0 = gp / (1.f + e1), w1 = gp * e1 / (1.f + e1);
                const int ex0 = gi * 8 + i0, ex1 = gi * 8 + i1;
                rw[2 * t] = w0; rw[2 * t + 1] = w1;
                const unsigned r0 = __hip_atomic_fetch_add(lcnt + ex0, 1u, __ATOMIC_RELAXED, __HIP_MEMORY_SCOPE_WORKGROUP); const unsigned r1 = __hip_atomic_fetch_add(lcnt + ex1, 1u, __ATOMIC_RELAXED, __HIP_MEMORY_SCOPE_WORKGROUP);
                tex[4 * lane] = ex0; tex[4 * lane + 1] = ex1; tex[4 * lane + 2] = (int)r0; tex[4 * lane + 3] = (int)r1; }
            __syncthreads();
            if (tid < NE) { const unsigned c = lcnt[tid]; lcnt[32 + tid] = c ? atomicAdd(cnt + tid, c) : 0u; }
            __syncthreads();
            if (lane < 16) { const int t = tw + lane; const int ex0 = tex[4 * lane], ex1 = tex[4 * lane + 1];
                list[(size_t)ex0 * T + lcnt[32 + ex0] + (unsigned)tex[4 * lane + 2]] = t * 2; list[(size_t)ex1 * T + lcnt[32 + ex1] + (unsigned)tex[4 * lane + 3]] = t * 2 + 1; }
            for (int i = 0; i < 16; ++i) { const int t = tw + i; const float mu = tst[2 * i], rstd = tst[2 * i + 1]; const float* yr = out + (size_t)t * 1024;
#pragma unroll
                for (int j = 0; j < 4; ++j) { const int c0 = j * 256 + lane * 4; const f32x4 v = *(const f32x4*)(yr + c0), gg = *(const f32x4*)(ln1_g + c0), bb = *(const f32x4*)(ln1_b + c0);
                    u32x2 w; w.x = cvt_pk_bf16((v[0] - mu) * rstd * gg[0] + bb[0], (v[1] - mu) * rstd * gg[1] + bb[1]); w.y = cvt_pk_bf16((v[2] - mu) * rstd * gg[2] + bb[2], (v[3] - mu) * rstd * gg[3] + bb[3]);
                    *(u32x2*)(x1b + (size_t)t * 1024 + c0) = w; } }
            __syncthreads();
        }
        SEAM(PH_ROUTER);
    }
    if (HAS(PH_G7) || HAS(PH_G8)) {
        if (tid < NE) MISC[64 + tid] = __hip_atomic_load(cnt + tid, RLX_AGENT);
        __syncthreads();
        if (tid == 0) { unsigned acc = 0u; for (int e = 0; e < NE; ++e) { MISC[16 + e] = acc; acc += (MISC[64 + e] + 255u) >> 8; } MISC[16 + NE] = acc; }
        __syncthreads();
        const int ntiles = (int)MISC[16 + NE];
        if (HAS(PH_G7)) {
            g8::MoeOrder S{(const char*)x1b, (const char*)(wt + WT_GU), list, MISC + 16, MISC + 64, ntiles * 4, G, bx, 0, (size_t)1024 * 1024 * 2, (size_t)256 * 1024 * 2, 1};
            g8::EpiGateUp E{hb};
            g8::gemm_phase<g8::EpiGateUp, g8::MoeOrder, true, true>(lds, 1024, S, E);
            SEAM(PH_G7);
        }
        if (HAS(PH_G8)) {
            g8::MoeOrder S{(const char*)hb, (const char*)(wt + WT_DN), list, MISC + 16, MISC + 64, ntiles * 4, G, bx, (size_t)256 * 512 * 2, (size_t)1024 * 512 * 2, (size_t)256 * 512 * 2, 0};
            g8::EpiDown E{ybuf, list, rw, MISC + 64};
            g8::gemm_phase<g8::EpiDown, g8::MoeOrder, true, false>(lds, 512, S, E);
            SEAM(PH_G8);
        }
    }
    if (HAS(PH_FINAL)) {
        for (int t = gw; t < T; t += NGW) {
            float* yr = out + (size_t)t * 1024; const float2 st = stats[t]; float xv[16]; float s = 0.f;
#pragma unroll
            for (int j = 0; j < 4; ++j) { const int c0 = j * 256 + lane * 4; const f32x4 vv = *(const f32x4*)(yr + c0); const f32x4 gg = *(const f32x4*)(ln1_g + c0); const f32x4 bb = *(const f32x4*)(ln1_b + c0);
                const u32x2 a = *(const u32x2*)(ybuf + (size_t)(2 * t) * 1024 + c0); const u32x2 b = *(const u32x2*)(ybuf + (size_t)(2 * t + 1) * 1024 + c0);
                const float ya[4] = {bflo(a.x), bfhi(a.x), bflo(a.y), bfhi(a.y)}; const float yb[4] = {bflo(b.x), bfhi(b.x), bflo(b.y), bfhi(b.y)};
#pragma unroll
                for (int i = 0; i < 4; ++i) { const float x1 = (vv[i] - st.x) * st.y * gg[i] + bb[i]; const float val = ALPHA * x1 + (ya[i] + yb[i]); xv[4 * j + i] = val; s += val; } }
            const float mu = wave_sum(s) * (1.f / 1024.f); float s2 = 0.f;
#pragma unroll
            for (int i = 0; i < 16; ++i) { const float d = xv[i] - mu; s2 += d * d; }
            const float rstd = 1.0f / sqrtf(wave_sum(s2) * (1.f / 1024.f) + LN_EPS);
#pragma unroll
            for (int j = 0; j < 4; ++j) { const int c0 = j * 256 + lane * 4; const f32x4 gg = *(const f32x4*)(ln2_g + c0); const f32x4 bb = *(const f32x4*)(ln2_b + c0); f32x4 o;
#pragma unroll
                for (int i = 0; i < 4; ++i) o[i] = (xv[4 * j + i] - mu) * rstd * gg[i] + bb[i];
                *(f32x4*)(yr + c0) = o; }
        }
    }
#undef HAS
#undef SEAM
}
#undef IN_F
#undef x_
#undef positions
#undef w_in
#undef gate_bias
#undef lam_vecs
#undef subln_gain
#undef w_pool
#undef pool_scale
#undef w_branch_a
#undef w_branch_b
#undef w_out
#undef ln1_g
#undef ln1_b
#undef wrg
#undef brg
#undef wre
#undef bre
#undef wgu
#undef wdn
#undef ln2_g
#undef ln2_b
#undef wt
#undef xb
#undef qb
#undef kb
#undef vb
#undef ub
#undef gb
#undef on
#undef mixed
#undef merged
#undef x1b
#undef hb
#undef ybuf
#undef rope
#undef pooled
#undef misc
#undef ctl
#undef stats
#undef rw
#undef list
#undef scal
#undef cnt
#undef wpool_bd


#ifndef MK_OPT
#define MK_OPT 0x003u
#endif
#ifndef MK_M2A
#define MK_M2A 0xff4u
#define MK_M2B 0u
#define MK_M2C 0u
#endif
#ifndef MK_ONE
#define MK_ONE 0
#endif
constexpr unsigned OPT = MK_OPT;
#define OPTP(p) ((OPT >> (p)) & 1u)


#ifdef MK_DEBUG_HASH
__global__ void k_hash(const uint4* __restrict__ p, size_t n16, unsigned long long* __restrict__ outh) {
    unsigned long long h = 0ull;
    for (size_t i = blockIdx.x * (size_t)blockDim.x + threadIdx.x; i < n16; i += (size_t)gridDim.x * blockDim.x) { const uint4 w = p[i];
        const unsigned long long m = (unsigned long long)(i * 2654435761ull + 12345ull) | 1ull;
        h += ((unsigned long long)w.x * 0x9E3779B1ull + (unsigned long long)w.y * 0x85EBCA77ull + (unsigned long long)w.z * 0xC2B2AE3Dull + (unsigned long long)w.w * 0x27D4EB2Full) * m; }
    for (int o = 32; o > 0; o >>= 1) h += __shfl_xor(h, o);
    if ((threadIdx.x & 63) == 0) atomicAdd(outh, h);
}
__global__ void k_poison(float* __restrict__ out, const unsigned long long* __restrict__ hs) {
    float code = 0.f; for (int r = 1; r < 10; ++r) if (hs[r] != hs[0]) code = 1.f;
    if (code == 0.f) return;
    for (size_t i = blockIdx.x * (size_t)blockDim.x + threadIdx.x; i < (size_t)T * DM; i += (size_t)gridDim.x * blockDim.x) out[i] = __builtin_nanf("") * code;
}
#endif
extern "C" void kernel_launch(void* const* d_in, const int* in_sizes, int n_in, void* d_out, int out_size, void* d_ws, size_t ws_size, hipStream_t stream) {
    static int grid = 0;
    if (grid == 0) {
        if (n_in != 21 || in_sizes[0] != T * DM || out_size != T * DM || ws_size < WS_END) { fprintf(stderr, "kernel_launch: unexpected shapes (n_in %d, x %d, out %d, ws %zu)\n", n_in, n_in > 0 ? in_sizes[0] : -1, out_size, ws_size); grid = -1; return; }
        int dev = 0, cus = 0;
        if (hipGetDevice(&dev) != hipSuccess || hipDeviceGetAttribute(&cus, hipDeviceAttributeMultiprocessorCount, dev) != hipSuccess) { fprintf(stderr, "kernel_launch: device query failed\n"); grid = -1; return; }
        int per_cu = 0;
        if (hipOccupancyMaxActiveBlocksPerMultiprocessor(&per_cu, (const void*)mk_fwd, NTHREADS, 0) != hipSuccess || per_cu < 1) fprintf(stderr, "kernel_launch: note: occupancy query reports %d blocks per CU\n", per_cu);
        (void)hipGetLastError();
        grid = cus;
    }
    if (grid < 0) return;
    const float* x = (const float*)d_in[0]; const int* positions = (const int*)d_in[1]; const float* w_in = (const float*)d_in[2]; const float* gate_bias = (const float*)d_in[3];
    const float* lam_vecs = (const float*)d_in[4]; const float* subln_gain = (const float*)d_in[5]; const float* w_pool = (const float*)d_in[6]; const float* pool_scale = (const float*)d_in[7];
    const float* w_branch_a = (const float*)d_in[8]; const float* w_branch_b = (const float*)d_in[9]; const float* w_out = (const float*)d_in[10]; const float* ln1_g = (const float*)d_in[11];
    const float* ln1_b = (const float*)d_in[12]; const float* wrg = (const float*)d_in[13]; const float* brg = (const float*)d_in[14]; const float* wre = (const float*)d_in[15];
    const float* bre = (const float*)d_in[16]; const float* wgu = (const float*)d_in[17]; const float* wdn = (const float*)d_in[18]; const float* ln2_g = (const float*)d_in[19]; const float* ln2_b = (const float*)d_in[20];
    char* ws = (char*)d_ws; float* out = (float*)d_out;
    bf16_t* qb = (bf16_t*)(ws + WS_Q); bf16_t* kb = (bf16_t*)(ws + WS_K); bf16_t* vb = (bf16_t*)(ws + WS_V); bf16_t* ub = (bf16_t*)(ws + WS_U); bf16_t* gb = (bf16_t*)d_out;
    bf16_t* on = (bf16_t*)(ws + WS_ON); bf16_t* mixed = (bf16_t*)(ws + WS_MIXED); bf16_t* merged = (bf16_t*)(ws + WS_MERGED); bf16_t* x1b = (bf16_t*)(ws + WS_X1B);
    bf16_t* hb = (bf16_t*)(ws + WS_H); bf16_t* ybuf = (bf16_t*)(ws + WS_YBUF); float2* rope = (float2*)(ws + WS_ROPE); float* tmp = (float*)(ws + WS_TEMP);
    char* misc = ws + WS_MISC; unsigned* ctl = (unsigned*)(misc + MS_CTL); float2* stats = (float2*)(misc + MS_STATS); int2* rexp = (int2*)(misc + MS_ROUTE); float2* rw = (float2*)(misc + MS_ROUTE + (size_t)T * 8);
    int* list = (int*)(misc + MS_LIST); float* scal = (float*)(misc + MS_SCAL); unsigned* cnt = ctl;

    MKArgs a{}; int nlaunch = 0;
    for (int i = 0; i < 21; ++i) a.in[i] = d_in[i];
    a.out = out; a.ws = (unsigned char*)d_ws;
    if (hipMemsetAsync(ctl, 0, 65536, stream) != hipSuccess) { fprintf(stderr, "kernel_launch: memset failed\n"); return; }
#ifndef MK_REPH
#define MK_REPH 0u
#endif
#define MK(maskv) do { a.mask = (maskv); for (int rr_ = 0; rr_ < (((maskv) & (MK_REPH)) ? 2 : 1); ++rr_) { a.li = (unsigned)(nlaunch++ % 3) | (rr_ ? (1u << 8) : 0u); hipLaunchKernelGGL(mk_fwd, dim3(grid), dim3(NTHREADS), 0, stream, a); } } while (0)
    if (MK_ONE == 1) { MK((1u << PH_N) - 1u); return; }
    if (MK_ONE == 2) {
        MK(0x003u);
        for (int mh = 0; mh < 2; ++mh) { const int m0 = mh * 16384; nattn<<<(16384 / 64) * 16, 64, 0, stream>>>(qb, kb, vb, scal, tmp, m0); post_rms<<<16384 * 8 / 256, 256, 0, stream>>>(tmp, subln_gain, on, m0, 16384); }
        MK(MK_M2A); if (MK_M2B) MK(MK_M2B); if (MK_M2C) MK(MK_M2C); return; }

    constexpr int MC = 16384;
#if 0
#else
#ifdef MK_TEST_BAR
    MK(0x003u);
#else
    if (OPTP(PH_PRO)) MK(1u << PH_PRO); else k_prep<<<T * 32 / 256, 256, 0, stream>>>(positions, lam_vecs, rope, scal, ctl);
    if (OPTP(PH_G1)) MK(1u << PH_G1);
#endif
#endif
#ifndef MK_OVR
#define MK_OVR 0
#endif
    const int ovr = OPTP(PH_G1) ? MK_OVR : 15;
    for (int mh = 0; mh < 2; ++mh) {
        const int m0 = mh * MC; AL_F32 ax{x + (size_t)m0 * DM, DM, 0};
        if (ovr & 1) for (int qk = 0; qk < 2; ++qk) {
            ngemm<AL_F32><<<dim3(16, MC / 64), 256, 0, stream>>>(ax, w_in + qk * 1024, INW, tmp, 1024, MC, 1024, DM);
            post_qk<<<MC * 512 / 256, 256, 0, stream>>>(tmp, rope, qk ? kb : qb, m0, MC, qk ? 1.f : QSCALE);
        }
        if (ovr & 2) { ngemm<AL_F32><<<dim3(16, MC / 64), 256, 0, stream>>>(ax, w_in + 2048, INW, tmp, 1024, MC, 1024, DM);
        post_plain<<<MC * 1024 / 256, 256, 0, stream>>>(tmp, vb, 1024, 0, m0, MC, 1024, nullptr); }
        if (ovr & 4) { ngemm<AL_F32><<<dim3(8, MC / 64), 256, 0, stream>>>(ax, w_in + 3072, INW, tmp, 512, MC, 512, DM);
        post_plain<<<MC * 512 / 256, 256, 0, stream>>>(tmp, ub, 512, 0, m0, MC, 512, nullptr); }
        if (ovr & 8) for (int br = 0; br < 2; ++br) {
            ngemm<AL_F32><<<dim3(16, MC / 64), 256, 0, stream>>>(ax, w_in + 3584 + br * 1024, INW, tmp, 1024, MC, 1024, DM);
            post_gate<<<MC * 1024 / 256, 256, 0, stream>>>(tmp, gate_bias, gb, br * 1024, m0, MC);
        }
    }
    if (OPTP(PH_ATT)) MK(1u << PH_ATT);
    else for (int mh = 0; mh < 2; ++mh) {
        const int m0 = mh * MC;
        nattn<<<(MC / 64) * 16, 64, 0, stream>>>(qb, kb, vb, scal, tmp, m0);
        post_rms<<<MC * 8 / 256, 256, 0, stream>>>(tmp, subln_gain, on, m0, MC);
    }
    if (OPTP(PH_POOLA)) { MK(1u << PH_POOLA); MK(1u << PH_POOLG); }
    else for (int mh = 0; mh < 2; ++mh) {
        const int m0 = mh * MC;
        for (int g = 0; g < 4; ++g) { AL_POOL ap{ub + (size_t)m0 * PW, g, 0};
            ngemm<AL_POOL><<<dim3(2, MC / 64), 256, 0, stream>>>(ap, w_pool + (size_t)g * 128 * 128, 128, tmp + g * 128, 512, MC, 128, 128); }
        post_plain<<<MC * 512 / 256, 256, 0, stream>>>(tmp, mixed, 512, 0, m0, MC, 512, pool_scale);
    }
    if (OPTP(PH_G4A)) MK(1u << PH_G4A);
    else for (int mh = 0; mh < 2; ++mh) {
        const int m0 = mh * MC;
        { AL_BF16 al{on + (size_t)m0 * 1024, 1024, 0}; ngemm<AL_BF16><<<dim3(16, MC / 64), 256, 0, stream>>>(al, w_branch_a, 1024, tmp, 1024, MC, 1024, 1024); }
        post_merge<<<MC * 1024 / 256, 256, 0, stream>>>(tmp, gb, merged, 0, m0, MC);
    }
    if (OPTP(PH_G4B)) MK(1u << PH_G4B);
    else for (int mh = 0; mh < 2; ++mh) {
        const int m0 = mh * MC;
        { AL_BF16 al{mixed + (size_t)m0 * 512, 512, 0}; ngemm<AL_BF16><<<dim3(16, MC / 64), 256, 0, stream>>>(al, w_branch_b, 1024, tmp, 1024, MC, 1024, 512); }
        post_merge<<<MC * 1024 / 256, 256, 0, stream>>>(tmp, gb, merged, 1, m0, MC);
    }
    if (OPTP(PH_G5)) MK(1u << PH_G5);
    else for (int mh = 0; mh < 2; ++mh) {
        const int m0 = mh * MC;
        { AL_BF16 al{merged + (size_t)m0 * 1024, 1024, 0}; ngemm<AL_BF16><<<dim3(16, MC / 64), 256, 0, stream>>>(al, w_out, 1024, tmp, 1024, MC, 1024, 1024); }
        post_y<<<MC * 1024 / 256, 256, 0, stream>>>(tmp, x, out, m0, MC);
    }
    if (OPTP(PH_ROUTER)) MK(1u << PH_ROUTER); else k_router<<<T / 4, 256, 0, stream>>>(out, ln1_g, ln1_b, wrg, brg, wre, bre, x1b, stats, rexp, rw, list, cnt);
    if (OPTP(PH_G7)) MK(1u << PH_G7); else nmoe_gu<<<dim3(8, T / 64, NE), 256, 0, stream>>>(x1b, list, cnt, wgu, hb);
    if (OPTP(PH_G8)) MK(1u << PH_G8); else nmoe_dn<<<dim3(16, T / 64, NE), 256, 0, stream>>>(hb, list, cnt, rw, wdn, ybuf);
    if (OPTP(PH_FINAL)) MK(1u << PH_FINAL); else k_final<<<T / 4, 256, 0, stream>>>(out, stats, ln1_g, ln1_b, ybuf, ln2_g, ln2_b);
#undef MK
}
```

```cpp
#define MK_OPT 0xfffu
#define MK_ONE 1
#include <hip/hip_runtime.h>
#include <cstdio>
#include <cstdint>
#include <cmath>

typedef unsigned short bf16_t;
typedef float f32x4 __attribute__((ext_vector_type(4)));

constexpr int NB = 16, SEQ = 2048, DM = 1024, T = NB * SEQ;
constexpr int NHEAD = 8, HD = 64, NHM = 16;
constexpr int INW = 5632;
constexpr int PW = 512, PG = 4, PGD = 128;
constexpr int NE = 32, NGRP = 4, EPG = 8, FF = 512;
constexpr float LN_EPS = 1e-5f, RMS_EPS = 1e-5f;
constexpr float ALPHA = 1.189207115002721f;
constexpr float LAMBDA_INIT = 0.2f;
constexpr float QSCALE = 0.125f * 1.4426950408889634f;

constexpr size_t MiB = 1u << 20;
constexpr size_t WS_WT    = 0;
constexpr size_t WS_XB    = 112 * MiB;
constexpr size_t WS_ON    = 112 * MiB;
constexpr size_t WS_YBUF  = 112 * MiB;
constexpr size_t WS_Q     = 176 * MiB;
constexpr size_t WS_MERGED= 176 * MiB;
constexpr size_t WS_K     = 240 * MiB;
constexpr size_t WS_X1B   = 240 * MiB;
constexpr size_t WS_V     = 304 * MiB;
constexpr size_t WS_H     = 304 * MiB;
constexpr size_t WS_U     = 368 * MiB;
constexpr size_t WS_MIXED = 400 * MiB;
constexpr size_t WS_ROPE  = 432 * MiB;
constexpr size_t WS_MISC  = 440 * MiB;
constexpr size_t WS_TEMP  = 448 * MiB;
constexpr size_t WS_END   = 512 * MiB;
constexpr size_t MS_CTL   = 0;
constexpr size_t MS_STATS = 64 * 1024;
constexpr size_t MS_ROUTE = 512 * 1024;
constexpr size_t MS_LIST  = 1 * MiB;
constexpr size_t MS_SCAL  = 6 * MiB;

__device__ __forceinline__ float bf2f(bf16_t v) { return __uint_as_float((unsigned)v << 16); }
__device__ __forceinline__ bf16_t f2bf(float f) { unsigned u = __float_as_uint(f); return (bf16_t)((u + 0x7fffu + ((u >> 16) & 1u)) >> 16); }
__host__ __device__ __forceinline__ int qk_pos_of_d(int d) { return ((d >> 4) & 1) * 32 + ((d >> 2) & 3) * 8 + (d >> 5) * 4 + (d & 3); }

struct AL_F32  { const float* p; int ld; int pad;  __device__ __forceinline__ float operator()(int r, int k) const { return p[(size_t)r * ld + k]; } };
struct AL_BF16 { const bf16_t* p; int ld; int pad; __device__ __forceinline__ float operator()(int r, int k) const { return bf2f(p[(size_t)r * ld + k]); } };
struct AL_POOL { const bf16_t* u; int g; int pad;
    __device__ __forceinline__ float operator()(int r, int k) const {
        const int w = 2 << g, s = r & (SEQ - 1); const int n = (s + 1 < w) ? s + 1 : w; float acc = 0.f;
        for (int i = 0; i < n; ++i) acc += bf2f(u[(size_t)(r - i) * PW + g * PGD + k]);
        return acc / (float)n - bf2f(u[(size_t)r * PW + g * PGD + k]); } };

template <class AL>
__global__ __launch_bounds__(256) void ngemm(AL al, const float* __restrict__ Bm, int ldb, float* __restrict__ C, int ldc, int M, int N, int K) {
    __shared__ float As[16][68]; __shared__ float Bs[16][68];
    const int tid = threadIdx.x, tx = tid & 15, ty = tid >> 4; const int m0 = blockIdx.y * 64, n0 = blockIdx.x * 64;
    float acc[4][4] = {};
    for (int k0 = 0; k0 < K; k0 += 16) {
#pragma unroll
        for (int i = 0; i < 4; ++i) { const int e = tid + i * 256; const int r = e >> 4, kk = e & 15; As[kk][r] = (m0 + r < M) ? al(m0 + r, k0 + kk) : 0.f; }
#pragma unroll
        for (int i = 0; i < 4; ++i) { const int e = tid + i * 256; const int kk = e >> 6, c = e & 63; Bs[kk][c] = (n0 + c < N) ? Bm[(size_t)(k0 + kk) * ldb + n0 + c] : 0.f; }
        __syncthreads();
#pragma unroll
        for (int kk = 0; kk < 16; ++kk) { float a[4], b[4];
#pragma unroll
            for (int i = 0; i < 4; ++i) { a[i] = As[kk][ty * 4 + i]; b[i] = Bs[kk][tx * 4 + i]; }
#pragma unroll
            for (int i = 0; i < 4; ++i)
#pragma unroll
                for (int j = 0; j < 4; ++j) acc[i][j] = fmaf(a[i], b[j], acc[i][j]); }
        __syncthreads();
    }
#pragma unroll
    for (int i = 0; i < 4; ++i)
#pragma unroll
        for (int j = 0; j < 4; ++j) { const int r = m0 + ty * 4 + i, c = n0 + tx * 4 + j; if (r < M && c < N) C[(size_t)r * ldc + c] = acc[i][j]; }
}

__global__ void k_prep(const int* __restrict__ positions, const float* __restrict__ lam_vecs, float2* __restrict__ rope, float* __restrict__ scal, unsigned* __restrict__ ctl) {
    const int gid = blockIdx.x * blockDim.x + threadIdx.x;
    if (gid < T * 32) { const int t = gid >> 5, i = gid & 31;
        const float inv = powf(10000.0f, -(float)i * (2.0f / 64.0f)); const float ang = (float)positions[t] * inv;
        const double a = (double)ang; rope[gid] = make_float2((float)cos(a), (float)sin(a)); }
    if (gid < 16384) ctl[gid] = 0u;
    if (gid == 0) { float s01 = 0.f, s23 = 0.f; for (int i = 0; i < 64; ++i) { s01 += lam_vecs[i] * lam_vecs[64 + i]; s23 += lam_vecs[128 + i] * lam_vecs[192 + i]; }
        scal[0] = expf(s01) - expf(s23) + LAMBDA_INIT; }
}
__global__ void post_qk(const float* __restrict__ tmp, const float2* __restrict__ rope, bf16_t* __restrict__ out, int m0, int Mc, float scale) {
    const int gid = blockIdx.x * blockDim.x + threadIdx.x; if (gid >= Mc * 512) return;
    const int r = gid >> 9, p = gid & 511, hm = p >> 5, i = p & 31; const int t = m0 + r;
    const float t1 = tmp[(size_t)r * 1024 + hm * 64 + i], t2 = tmp[(size_t)r * 1024 + hm * 64 + i + 32]; const float2 cs = rope[t * 32 + i];
    out[(size_t)t * 1024 + hm * 64 + qk_pos_of_d(i)] = f2bf((t1 * cs.x - t2 * cs.y) * scale);
    out[(size_t)t * 1024 + hm * 64 + qk_pos_of_d(i + 32)] = f2bf((t2 * cs.x + t1 * cs.y) * scale);
}
__global__ void post_plain(const float* __restrict__ tmp, bf16_t* __restrict__ out, int ldo, int coloff, int m0, int Mc, int N, const float* __restrict__ colscale) {
    const int gid = blockIdx.x * blockDim.x + threadIdx.x; if (gid >= Mc * N) return;
    const int r = gid / N, c = gid % N; float v = tmp[(size_t)r * N + c]; if (colscale) v *= colscale[c];
    out[(size_t)(m0 + r) * ldo + coloff + c] = f2bf(v);
}
__global__ void post_gate(const float* __restrict__ tmp, const float* __restrict__ bias, bf16_t* __restrict__ gates, int coloff, int m0, int Mc) {
    const int gid = blockIdx.x * blockDim.x + threadIdx.x; if (gid >= Mc * 1024) return;
    const int r = gid >> 10, c = gid & 1023; const float v = tmp[(size_t)r * 1024 + c] + bias[coloff + c];
    gates[(size_t)(m0 + r) * 2048 + coloff + c] = f2bf(1.f / (1.f + expf(-v)));
}
__global__ __launch_bounds__(64) void nattn(const bf16_t* __restrict__ q, const bf16_t* __restrict__ k, const bf16_t* __restrict__ v, const float* __restrict__ scal, float* __restrict__ tmp, int m0) {
    const int lane = threadIdx.x; const int blk = blockIdx.x;
    const int half = blk & 1, head = (blk >> 1) & 7, cg = blk >> 4; const int t0 = m0 + cg * 64, t = t0 + lane; const int b = t0 / SEQ, s0 = t0 % SEQ; const int nkeys = ((s0 >> 6) + 1) * 64;
    const float lam = scal[0];
    float res[64];
    for (int mp = 0; mp < 2; ++mp) {
        const int hm = head * 2 + mp; float qv[64];
#pragma unroll
        for (int d = 0; d < 64; ++d) qv[d] = bf2f(q[(size_t)t * 1024 + hm * 64 + d]);
        float mx = -1e30f, l = 0.f; float o[64];
#pragma unroll
        for (int d = 0; d < 64; ++d) o[d] = 0.f;
        for (int j = 0; j < nkeys; ++j) { const size_t kr = (size_t)(b * SEQ + j) * 1024; float sc = 0.f;
            const uint4* kp = (const uint4*)(k + kr + hm * 64); const uint4* vp = (const uint4*)(v + kr + head * 128 + half * 64);
#pragma unroll
            for (int c = 0; c < 8; ++c) { const uint4 w = kp[c]; const unsigned ww[4] = {w.x, w.y, w.z, w.w};
#pragma unroll
                for (int e = 0; e < 4; ++e) { sc = fmaf(qv[c * 8 + 2 * e], __uint_as_float(ww[e] << 16), sc); sc = fmaf(qv[c * 8 + 2 * e + 1], __uint_as_float(ww[e] & 0xffff0000u), sc); } }
            const float mn = fmaxf(mx, sc), al = exp2f(mx - mn), p = exp2f(sc - mn); mx = mn; l = l * al + p;
#pragma unroll
            for (int c = 0; c < 8; ++c) { const uint4 w = vp[c]; const unsigned ww[4] = {w.x, w.y, w.z, w.w};
#pragma unroll
                for (int e = 0; e < 4; ++e) { o[c * 8 + 2 * e] = fmaf(p, __uint_as_float(ww[e] << 16), o[c * 8 + 2 * e] * al); o[c * 8 + 2 * e + 1] = fmaf(p, __uint_as_float(ww[e] & 0xffff0000u), o[c * 8 + 2 * e + 1] * al); } } }
        const float il = 1.f / l;
#pragma unroll
        for (int d = 0; d < 64; ++d) res[d] = (mp == 0) ? o[d] * il : res[d] - lam * o[d] * il;
    }
#pragma unroll
    for (int d = 0; d < 64; ++d) tmp[(size_t)(t - m0) * 1024 + head * 128 + half * 64 + d] = res[d];
}
__global__ void post_rms(const float* __restrict__ tmp, const float* __restrict__ gain, bf16_t* __restrict__ on, int m0, int Mc) {
    const int gid = blockIdx.x * blockDim.x + threadIdx.x; if (gid >= Mc * 8) return;
    const int r = gid >> 3, head = gid & 7; const float* p = tmp + (size_t)r * 1024 + head * 128; float ss = 0.f;
    for (int d = 0; d < 128; ++d) ss += p[d] * p[d];
    const float rs = 1.0f / sqrtf(ss * (1.f / 128.f) + RMS_EPS);
    for (int d = 0; d < 128; ++d) on[(size_t)(m0 + r) * 1024 + head * 128 + d] = f2bf(p[d] * rs * gain[d] * (1.f - LAMBDA_INIT));
}
__global__ void post_merge(const float* __restrict__ tmp, const bf16_t* __restrict__ gates, bf16_t* __restrict__ merged, int br, int m0, int Mc) {
    const int gid = blockIdx.x * blockDim.x + threadIdx.x; if (gid >= Mc * 1024) return;
    const int r = gid >> 10, c = gid & 1023; const size_t t = m0 + r; const float g = bf2f(gates[t * 2048 + br * 1024 + c]);
    float val = g * tmp[(size_t)r * 1024 + c]; if (br) val += bf2f(merged[t * 1024 + c]);
    merged[t * 1024 + c] = f2bf(val);
}
__global__ void post_y(const float* __restrict__ tmp, const float* __restrict__ x, float* __restrict__ y, int m0, int Mc) {
    const int gid = blockIdx.x * blockDim.x + threadIdx.x; if (gid >= Mc * 1024) return;
    const size_t o = (size_t)m0 * 1024 + gid; y[o] = ALPHA * x[o] + tmp[gid];
}
__device__ __forceinline__ float wave_sum(float v) {
#pragma unroll
    for (int o = 1; o < 64; o <<= 1) v += __shfl_xor(v, o);
    return v;
}
__global__ __launch_bounds__(256) void k_router(const float* __restrict__ y, const float* __restrict__ g1, const float* __restrict__ b1, const float* __restrict__ wrg, const float* __restrict__ brg,
                                                const float* __restrict__ wre, const float* __restrict__ bre, bf16_t* __restrict__ x1b, float2* __restrict__ stats, int2* __restrict__ rexp, float2* __restrict__ rw,
                                                int* __restrict__ list, unsigned* __restrict__ cnt) {
    const int lane = threadIdx.x & 63; const int t = blockIdx.x * 4 + (threadIdx.x >> 6);
    const float* yr = y + (size_t)t * 1024; float xv[16]; float s = 0.f;
#pragma unroll
    for (int j = 0; j < 4; ++j) { const f32x4 vv = *(const f32x4*)(yr + j * 256 + lane * 4); xv[4 * j] = vv.x; xv[4 * j + 1] = vv.y; xv[4 * j + 2] = vv.z; xv[4 * j + 3] = vv.w; s += (vv.x + vv.y) + (vv.z + vv.w); }
    const float mu = wave_sum(s) * (1.f / 1024.f); float s2 = 0.f;
#pragma unroll
    for (int i = 0; i < 16; ++i) { const float d = xv[i] - mu; s2 += d * d; }
    const float rstd = 1.0f / sqrtf(wave_sum(s2) * (1.f / 1024.f) + LN_EPS);
    if (lane == 0) stats[t] = make_float2(mu, rstd);
#pragma unroll
    for (int j = 0; j < 4; ++j)
#pragma unroll
        for (int i = 0; i < 4; ++i) { const int c = j * 256 + lane * 4 + i; xv[4 * j + i] = (xv[4 * j + i] - mu) * rstd * g1[c] + b1[c]; }
#pragma unroll
    for (int j = 0; j < 4; ++j) { uint2 w; w.x = (unsigned)f2bf(xv[4 * j]) | ((unsigned)f2bf(xv[4 * j + 1]) << 16); w.y = (unsigned)f2bf(xv[4 * j + 2]) | ((unsigned)f2bf(xv[4 * j + 3]) << 16);
        *(uint2*)(x1b + (size_t)t * 1024 + j * 256 + lane * 4) = w; }
    float lg[4], le[32];
#pragma unroll
    for (int o = 0; o < 4; ++o) { float a = 0.f;
#pragma unroll
        for (int j = 0; j < 4; ++j)
#pragma unroll
            for (int i = 0; i < 4; ++i) a = fmaf(xv[4 * j + i], wrg[(size_t)(j * 256 + lane * 4 + i) * 4 + o], a);
        lg[o] = wave_sum(a) + brg[o]; }
#pragma unroll
    for (int o = 0; o < 32; ++o) { float a = 0.f;
#pragma unroll
        for (int j = 0; j < 4; ++j)
#pragma unroll
            for (int i = 0; i < 4; ++i) a = fmaf(xv[4 * j + i], wre[(size_t)(j * 256 + lane * 4 + i) * 32 + o], a);
        le[o] = wave_sum(a) + bre[o]; }
    if (lane == 0) {
        int gi = 0; float gm = lg[0];
#pragma unroll
        for (int o = 1; o < 4; ++o) if (lg[o] > gm) { gm = lg[o]; gi = o; }
        float gs = 0.f;
#pragma unroll
        for (int o = 0; o < 4; ++o) gs += expf(lg[o] - gm);
        const float gp = 1.f / gs;
        float ev[8];
#pragma unroll
        for (int o = 0; o < 8; ++o) { float vsel = le[o];
#pragma unroll
            for (int g = 1; g < 4; ++g) vsel = (gi == g) ? le[g * 8 + o] : vsel;
            ev[o] = vsel; }
        int i0 = 0; float m0v = ev[0];
#pragma unroll
        for (int o = 1; o < 8; ++o) if (ev[o] > m0v) { m0v = ev[o]; i0 = o; }
        int i1 = (i0 == 0) ? 1 : 0; float m1v = -3.4e38f;
#pragma unroll
        for (int o = 0; o < 8; ++o) if (o != i0 && ev[o] > m1v) { m1v = ev[o]; i1 = o; }
        const float e1 = expf(m1v - m0v); const float w0 = gp / (1.f + e1), w1 = gp * e1 / (1.f + e1);
        const int ex0 = gi * 8 + i0, ex1 = gi * 8 + i1;
        rexp[t] = make_int2(ex0, ex1); rw[t] = make_float2(w0, w1);
        const unsigned p0 = atomicAdd(&cnt[ex0], 1u); list[(size_t)ex0 * T + p0] = t * 2;
        const unsigned p1 = atomicAdd(&cnt[ex1], 1u); list[(size_t)ex1 * T + p1] = t * 2 + 1;
    }
}
__global__ __launch_bounds__(256) void nmoe_gu(const bf16_t* __restrict__ x1b, const int* __restrict__ list, const unsigned* __restrict__ cnt, const float* __restrict__ wgu, bf16_t* __restrict__ h) {
    __shared__ float As[16][68]; __shared__ float Bg[16][68]; __shared__ float Bu[16][68]; __shared__ int toks[64];
    const int e = blockIdx.z; const int M = (int)cnt[e]; const int m0 = blockIdx.y * 64, n0 = blockIdx.x * 64; if (m0 >= M) return;
    int tb = 0; for (int i = 0; i < e; ++i) tb += ((int)cnt[i] + 255) >> 8;
    const int tid = threadIdx.x, tx = tid & 15, ty = tid >> 4;
    if (tid < 64) toks[tid] = (m0 + tid < M) ? (list[(size_t)e * T + m0 + tid] >> 1) : 0;
    __syncthreads();
    const float* W = wgu + (size_t)e * 1024 * 1024; float ag[4][4] = {}, au[4][4] = {};
    for (int k0 = 0; k0 < 1024; k0 += 16) {
#pragma unroll
        for (int i = 0; i < 4; ++i) { const int el = tid + i * 256; const int r = el >> 4, kk = el & 15; As[kk][r] = bf2f(x1b[(size_t)toks[r] * 1024 + k0 + kk]); }
#pragma unroll
        for (int i = 0; i < 4; ++i) { const int el = tid + i * 256; const int kk = el >> 6, c = el & 63; Bg[kk][c] = W[(size_t)(k0 + kk) * 1024 + n0 + c]; Bu[kk][c] = W[(size_t)(k0 + kk) * 1024 + 512 + n0 + c]; }
        __syncthreads();
#pragma unroll
        for (int kk = 0; kk < 16; ++kk) { float a[4], bg[4], bu[4];
#pragma unroll
            for (int i = 0; i < 4; ++i) { a[i] = As[kk][ty * 4 + i]; bg[i] = Bg[kk][tx * 4 + i]; bu[i] = Bu[kk][tx * 4 + i]; }
#pragma unroll
            for (int i = 0; i < 4; ++i)
#pragma unroll
                for (int j = 0; j < 4; ++j) { ag[i][j] = fmaf(a[i], bg[j], ag[i][j]); au[i][j] = fmaf(a[i], bu[j], au[i][j]); } }
        __syncthreads();
    }
#pragma unroll
    for (int i = 0; i < 4; ++i)
#pragma unroll
        for (int j = 0; j < 4; ++j) { const int r = m0 + ty * 4 + i, c = n0 + tx * 4 + j; if (r < M) { const float g = ag[i][j]; h[((size_t)tb * 256 + r) * 512 + c] = f2bf(g / (1.f + expf(-g)) * au[i][j]); } }
}
__global__ __launch_bounds__(256) void nmoe_dn(const bf16_t* __restrict__ h, const int* __restrict__ list, const unsigned* __restrict__ cnt, const float2* __restrict__ rw, const float* __restrict__ wdn, bf16_t* __restrict__ ybuf) {
    __shared__ float As[16][68]; __shared__ float Bs[16][68];
    const int e = blockIdx.z; const int M = (int)cnt[e]; const int m0 = blockIdx.y * 64, n0 = blockIdx.x * 64; if (m0 >= M) return;
    int tb = 0; for (int i = 0; i < e; ++i) tb += ((int)cnt[i] + 255) >> 8;
    const int tid = threadIdx.x, tx = tid & 15, ty = tid >> 4;
    const float* W = wdn + (size_t)e * 512 * 1024; float acc[4][4] = {};
    for (int k0 = 0; k0 < 512; k0 += 16) {
#pragma unroll
        for (int i = 0; i < 4; ++i) { const int el = tid + i * 256; const int r = el >> 4, kk = el & 15; As[kk][r] = (m0 + r < M) ? bf2f(h[((size_t)tb * 256 + m0 + r) * 512 + k0 + kk]) : 0.f; }
#pragma unroll
        for (int i = 0; i < 4; ++i) { const int el = tid + i * 256; const int kk = el >> 6, c = el & 63; Bs[kk][c] = W[(size_t)(k0 + kk) * 1024 + n0 + c]; }
        __syncthreads();
#pragma unroll
        for (int kk = 0; kk < 16; ++kk) { float a[4], b[4];
#pragma unroll
            for (int i = 0; i < 4; ++i) { a[i] = As[kk][ty * 4 + i]; b[i] = Bs[kk][tx * 4 + i]; }
#pragma unroll
            for (int i = 0; i < 4; ++i)
#pragma unroll
                for (int j = 0; j < 4; ++j) acc[i][j] = fmaf(a[i], b[j], acc[i][j]); }
        __syncthreads();
    }
#pragma unroll
    for (int i = 0; i < 4; ++i) { const int r = m0 + ty * 4 + i; if (r < M) { const int ent = list[(size_t)e * T + r]; const float2 w2 = rw[ent >> 1]; const float w = (ent & 1) ? w2.y : w2.x;
#pragma unroll
        for (int j = 0; j < 4; ++j) ybuf[(size_t)ent * 1024 + n0 + tx * 4 + j] = f2bf(w * acc[i][j]); } }
}
__global__ __launch_bounds__(256) void k_final(float* __restrict__ yout, const float2* __restrict__ stats, const float* __restrict__ g1, const float* __restrict__ b1, const bf16_t* __restrict__ ybuf,
                                               const float* __restrict__ g2, const float* __restrict__ b2) {
    const int lane = threadIdx.x & 63; const int t = blockIdx.x * 4 + (threadIdx.x >> 6);
    float* yr = yout + (size_t)t * 1024; const float2 st = stats[t]; float xv[16]; float s = 0.f;
#pragma unroll
    for (int j = 0; j < 4; ++j) { const int c0 = j * 256 + lane * 4; const f32x4 vv = *(const f32x4*)(yr + c0); const f32x4 gg = *(const f32x4*)(g1 + c0); const f32x4 bb = *(const f32x4*)(b1 + c0);
        const uint2 a = *(const uint2*)(ybuf + (size_t)(2 * t) * 1024 + c0); const uint2 b = *(const uint2*)(ybuf + (size_t)(2 * t + 1) * 1024 + c0);
        const float ya[4] = {__uint_as_float(a.x << 16), __uint_as_float(a.x & 0xffff0000u), __uint_as_float(a.y << 16), __uint_as_float(a.y & 0xffff0000u)};
        const float yb[4] = {__uint_as_float(b.x << 16), __uint_as_float(b.x & 0xffff0000u), __uint_as_float(b.y << 16), __uint_as_float(b.y & 0xffff0000u)};
#pragma unroll
        for (int i = 0; i < 4; ++i) { const float x1 = (vv[i] - st.x) * st.y * gg[i] + bb[i]; const float val = ALPHA * x1 + (ya[i] + yb[i]); xv[4 * j + i] = val; s += val; } }
    const float mu = wave_sum(s) * (1.f / 1024.f); float s2 = 0.f;
#pragma unroll
    for (int i = 0; i < 16; ++i) { const float d = xv[i] - mu; s2 += d * d; }
    const float rstd = 1.0f / sqrtf(wave_sum(s2) * (1.f / 1024.f) + LN_EPS);
#pragma unroll
    for (int j = 0; j < 4; ++j) { const int c0 = j * 256 + lane * 4; const f32x4 gg = *(const f32x4*)(g2 + c0); const f32x4 bb = *(const f32x4*)(b2 + c0); f32x4 o;
#pragma unroll
        for (int i = 0; i < 4; ++i) o[i] = (xv[4 * j + i] - mu) * rstd * gg[i] + bb[i];
        *(f32x4*)(yr + c0) = o; }
}

#define LAS __attribute__((address_space(3)))
#define GAS __attribute__((address_space(1)))
typedef short bf16x8 __attribute__((ext_vector_type(8)));
typedef unsigned u32x4 __attribute__((ext_vector_type(4)));
typedef unsigned u32x2 __attribute__((ext_vector_type(2)));
typedef GAS unsigned gu32;
#define RLX_AGENT __ATOMIC_RELAXED, __HIP_MEMORY_SCOPE_AGENT
#define LDS_WAIT() asm volatile("s_waitcnt lgkmcnt(0)" ::: "memory")
#define VM_WAIT() asm volatile("s_waitcnt vmcnt(0)" ::: "memory")

constexpr size_t WT_IN = 0;
constexpr size_t WT_A  = WT_IN + (size_t)INW * 1024;
constexpr size_t WT_B  = WT_A + 1024 * 1024;
constexpr size_t WT_O  = WT_B + 1024 * 512;
constexpr size_t WT_GU = WT_O + 1024 * 1024;
constexpr size_t WT_DN = WT_GU + (size_t)NE * 1024 * 1024;
constexpr size_t WT_END = WT_DN + (size_t)NE * 1024 * 512;
static_assert(WT_END * 2 <= 112 * MiB, "weight copies fit");
constexpr size_t MS_WPOOL = 7 * MiB;
constexpr size_t MS_WP = 7 * MiB + 512 * 1024;
constexpr size_t MS_CSBW = 6 * MiB + 1024;
constexpr size_t WS_POOLED = 448 * MiB;

constexpr int CW_CNT = 0;
constexpr int CW_BAR = 1024;
constexpr int CW_TDONE = 12288;

constexpr int NWAVES = 8, NTHREADS = 512;
constexpr int RING_BYTES = 131072, LDS_CTL_OFF = 147456, MISC_OFF = LDS_CTL_OFF + 320, LDS_BYTES = 163840;

typedef float f32x2_t __attribute__((ext_vector_type(2))); typedef __bf16 bf16x2_t __attribute__((ext_vector_type(2)));
__device__ __forceinline__ unsigned cvt_pk_bf16(float lo, float hi) { f32x2_t v = {lo, hi}; bf16x2_t b = __builtin_convertvector(v, bf16x2_t); return __builtin_bit_cast(unsigned, b); }
__device__ __forceinline__ float bflo(unsigned w) { return __uint_as_float(w << 16); }
__device__ __forceinline__ float bfhi(unsigned w) { return __uint_as_float(w & 0xffff0000u); }

#define XB_TMO      128
#define XB_XCNT(j)  (256  + 64 * (j))
#define XB_XSUB(j)  (1280 + 64 * (j))
#define XB_XGEN(j)  (2304 + 64 * (j))
#define XB_TOP      3328
#define XB_TOPGEN   3392
#define XCD_BAR_WORDS 3456
#define XB_SPIN_CAP (1u << 22)
__device__ __forceinline__ unsigned xb_ld(unsigned* p)              { return __hip_atomic_load(p, __ATOMIC_RELAXED, __HIP_MEMORY_SCOPE_AGENT); }
__device__ __forceinline__ unsigned xb_add(unsigned* p, unsigned v) { return __hip_atomic_fetch_add(p, v, __ATOMIC_RELAXED, __HIP_MEMORY_SCOPE_AGENT); }
__device__ __forceinline__ unsigned xb_xcc_id() { return (unsigned)__builtin_amdgcn_s_getreg((3 << 11) | 20) & 0xFu; }
#define XB_SPIN(cond, bar) do { unsigned _sp = 0; while (cond) { __builtin_amdgcn_s_sleep(1); \
    if ((++_sp & 255u) == 0u) { if (xb_ld(&(bar)[XB_TMO])) break; if (_sp > XB_SPIN_CAP) { atomicAdd(&(bar)[XB_TMO], 1u); break; } } } } while (0)
struct XcdBarrier { unsigned* bar; unsigned x; volatile LAS unsigned* st; };
__device__ __forceinline__ XcdBarrier xcd_barrier_post(unsigned* bar, volatile LAS unsigned* st) {
    XcdBarrier b; b.bar = bar; b.x = xb_xcc_id(); b.st = st;
    if (threadIdx.x == 0) (void)xb_add(&bar[XB_XCNT(b.x)], 1u);
    return b;
}
__device__ __forceinline__ void xcd_barrier_complete(unsigned* bar, unsigned x, unsigned& nloc, unsigned& nx) {
    const unsigned G = gridDim.x * gridDim.y * gridDim.z;
    unsigned sum, cnt, mine, sp = 0u;
    for (;;) {
        sum = 0u; cnt = 0u; mine = 0u;
#pragma unroll
        for (unsigned j = 0; j < 16; ++j) { const unsigned c = xb_ld(&bar[XB_XCNT(j)]); sum += c; cnt += (c > 0u) ? 1u : 0u; mine = (j == x) ? c : mine; }
        if (sum == G) break;
        __builtin_amdgcn_s_sleep(1);
        if ((++sp & 255u) == 0u) { if (xb_ld(&bar[XB_TMO])) break; if (sp > XB_SPIN_CAP) { atomicAdd(&bar[XB_TMO], 1u); break; } }
    }
    nloc = mine > 0u ? mine : 1u; nx = cnt > 0u ? cnt : 1u;
}
__device__ __forceinline__ void xcd_barrier(const XcdBarrier& b) {
    asm volatile("s_waitcnt vmcnt(0)" ::: "memory");
    __syncthreads();
    if (threadIdx.x == 0) {
        unsigned* bar = b.bar;
        __builtin_amdgcn_s_waitcnt(0);
        unsigned nloc = b.st[0], nx = b.st[1];
        if (nloc == 0u) { xcd_barrier_complete(bar, b.x, nloc, nx); b.st[0] = nloc; b.st[1] = nx; }
        const unsigned old = xb_add(&bar[XB_XSUB(b.x)], 1u);
        const unsigned gen = old / nloc;
        if (old + 1u == (gen + 1u) * nloc) {
            __builtin_amdgcn_fence(__ATOMIC_RELEASE, "agent");
            asm volatile("s_waitcnt vmcnt(0)" ::: "memory");
            const unsigned og = xb_add(&bar[XB_TOP], 1u);
            const unsigned tg = og / nx;
            if (og + 1u == (tg + 1u) * nx) xb_add(&bar[XB_TOPGEN], 1u);
            else XB_SPIN(xb_ld(&bar[XB_TOPGEN]) == tg, bar);
            __builtin_amdgcn_fence(__ATOMIC_ACQUIRE, "agent");
            xb_add(&bar[XB_XGEN(b.x)], 1u);
            asm volatile("s_waitcnt vmcnt(0)" ::: "memory");
        } else {
            XB_SPIN(xb_ld(&bar[XB_XGEN(b.x)]) == gen, bar);
            __builtin_amdgcn_fence(__ATOMIC_ACQUIRE, "agent");
            asm volatile("s_waitcnt vmcnt(0)" ::: "memory");
        }
    }
    __syncthreads();
}

namespace g8 {
constexpr int BM = 256, BK = 64, HALF = 128, HTB = HALF * BK * 2, NXCD = 8, WGM = 8;
__host__ __device__ __forceinline__ int lds_byte(int r, int c) { const int st = (r >> 4) * 2 + (c >> 5), rr = r & 15, cc = c & 31, ob = rr * 64 + cc * 2; return st * 1024 + (ob ^ (((ob >> 9) & 1) << 5)); }
__host__ __device__ __forceinline__ void stage_rc(int b, int& R, int& C) { const int st = b / 1024, sb = b % 1024, swz = sb ^ (((sb >> 9) & 1) << 5); R = (st >> 1) * 16 + swz / 64; C = (st & 1) * 32 + (swz % 64) / 2; }
__host__ __device__ __forceinline__ int perm32(int rho) { const int n = rho >> 4, i = rho & 15; return 8 * (i >> 2) + 4 * n + (i & 3); }

struct GUnit { const char* A; const char* B; int pm, pn, e, r0; };

struct DenseOrder {
    const char* Abase; const char* Bbase; int nM, nN, nwg, G, c; size_t tstep;
    __device__ void init(const void* A, const void* Bt, int M, int N, int K, int G_, int c_) { Abase = (const char*)A; Bbase = (const char*)Bt; nM = M / BM; nN = N / BM; nwg = nM * nN; G = G_; c = c_; tstep = (size_t)BM * K * 2; }
    __device__ bool next(int i, GUnit& u) const {
        const long L = (long)i * G + c; if (L >= nwg) return false;
        int wgid = (int)L; { const int q = nwg / NXCD, r = nwg % NXCD, xcd = wgid % NXCD, off = wgid / NXCD; wgid = (xcd < r ? xcd * (q + 1) : r * (q + 1) + (xcd - r) * q) + off; }
        const int nig = WGM * nN, gid = wgid / nig, fm = gid * WGM, gsz = (nM - fm) < WGM ? (nM - fm) : WGM;
        u.pm = fm + ((wgid % nig) % gsz); u.pn = (wgid % nig) / gsz; u.e = 0; u.r0 = 0;
        u.A = Abase + (size_t)u.pm * tstep; u.B = Bbase + (size_t)u.pn * tstep; return true;
    }
    __device__ __forceinline__ unsigned rowoff(const GUnit&, int) const { return 0u; }
    __device__ __forceinline__ void a_ready(const GUnit&) const {}
    __device__ __forceinline__ void done(const GUnit&) const {}
};
struct MoeOrder {
    const char* Abase; const char* Bbase; const int* list; const volatile LAS unsigned* tb; const volatile LAS unsigned* cntl; int nwg, G, c; size_t atile, bexp, btile; int gather;
    unsigned* tdone; int mode;
    __device__ bool next(int i, GUnit& u) const {
        const long L = (long)i * G + c; if (L >= nwg) return false;
        int wgid = (int)L; { const int q = nwg / NXCD, r = nwg % NXCD, xcd = wgid % NXCD, off = wgid / NXCD; wgid = (xcd < r ? xcd * (q + 1) : r * (q + 1) + (xcd - r) * q) + off; }
        const int tile = wgid >> 2; u.pn = wgid & 3; u.pm = tile;
        int e = 0; for (int j = 1; j < NE; ++j) e = ((int)tb[j] <= tile) ? j : e;
        e = __builtin_amdgcn_readfirstlane(e); u.e = e; u.r0 = __builtin_amdgcn_readfirstlane((tile - (int)tb[e]) * 256);
        u.A = gather ? Abase : Abase + (size_t)tile * atile; u.B = Bbase + (size_t)e * bexp + (size_t)u.pn * btile; return true;
    }
    __device__ __forceinline__ unsigned rowoff(const GUnit& u, int rr) const {
        const int p = u.r0 + rr; const int tok = (p < (int)cntl[u.e]) ? (list[(size_t)u.e * T + p] >> 1) : 0; return (unsigned)tok * 2048u; }
    __device__ __forceinline__ void done(const GUnit& u) const {
        if (mode == 1) { asm volatile("s_waitcnt vmcnt(0)" ::: "memory"); if ((threadIdx.x & 63) == 0) __hip_atomic_fetch_add(tdone + u.pm, 1u, __ATOMIC_RELAXED, __HIP_MEMORY_SCOPE_AGENT); } }
    __device__ __forceinline__ void a_ready(const GUnit& u) const {
        if (mode == 2) {
            if (threadIdx.x < 64) { unsigned sp = 0;
                while ((unsigned)__builtin_amdgcn_readfirstlane(__hip_atomic_load(tdone + u.pm, __ATOMIC_RELAXED, __HIP_MEMORY_SCOPE_AGENT)) < 32u) { __builtin_amdgcn_s_sleep(2); if (++sp > (1u << 22)) break; }
                __builtin_amdgcn_fence(__ATOMIC_ACQUIRE, "agent"); asm volatile("s_waitcnt vmcnt(0)" ::: "memory"); }
            asm volatile("" ::: "memory"); __builtin_amdgcn_s_barrier(); asm volatile("" ::: "memory"); } }
};

template <class Epi, class Sched, bool ALIGN_EPI, bool GATHER>
__device__ __forceinline__ void gemm_phase(LAS unsigned char* lds, const int K, const Sched& S, const Epi& E) {
    const int tid = threadIdx.x, wid = __builtin_amdgcn_readfirstlane(tid >> 6), lane = tid & 63, wr = wid >> 2, wc = wid & 3, fr = lane & 15, fq = lane >> 4;
    const int nt = K / BK;
    unsigned voffA[2], voffB[2]; int RA[2], CA[2];
#pragma unroll
    for (int i = 0; i < 2; ++i) { int R, C; stage_rc(tid * 16 + i * 8192, R, C); const int Rb = Epi::PERM ? ((R & ~31) + perm32(R & 31)) : R;
        voffA[i] = (unsigned)(R * K + C) * 2u; voffB[i] = (unsigned)(Rb * K + C) * 2u; RA[i] = R; CA[i] = C; }
    const size_t kstep = (size_t)(BK * 2);
    const size_t hstep = (size_t)HALF * K * 2;
    const unsigned ldsw = (unsigned)wid * 1024u;
    const int aoff = lds_byte(wr * 64 + fr, fq * 8), boff = lds_byte(wc * 32 + fr, fq * 8);
#define G8_SA(b, h) (((b) * 2 + (h)) * HTB)
#define G8_SB(b, h) ((4 + (b) * 2 + (h)) * HTB)
#define G8_STAGE(bufoff, gbase, o0, o1) do { \
        __builtin_amdgcn_global_load_lds((const unsigned*)((const char*)(gbase) + (o0)), (LAS unsigned*)(lds + (bufoff) + ldsw), 16, 0, 0); \
        __builtin_amdgcn_global_load_lds((const unsigned*)((const char*)(gbase) + (o1)), (LAS unsigned*)(lds + (bufoff) + ldsw + 8192), 16, 0, 0); } while (0)
#define G8_STAGE_B(bufoff, gbase) G8_STAGE(bufoff, gbase, voffB[0], voffB[1])
#define G8_LDA(dst, b, h) do { _Pragma("unroll") for (int m = 0; m < 4; ++m) _Pragma("unroll") for (int k = 0; k < 2; ++k) dst[m][k] = *(const LAS bf16x8*)(lds + G8_SA(b, h) + aoff + m * 2048 + k * 1024); } while (0)
#define G8_LDB(dst, b, h) do { _Pragma("unroll") for (int n = 0; n < 2; ++n) _Pragma("unroll") for (int k = 0; k < 2; ++k) dst[n][k] = *(const LAS bf16x8*)(lds + G8_SB(b, h) + boff + n * 2048 + k * 1024); } while (0)
#define G8_MMA(ai, bj, At, Bt) do { __builtin_amdgcn_s_setprio(1); _Pragma("unroll") for (int m = 0; m < 4; ++m) _Pragma("unroll") for (int n = 0; n < 2; ++n) _Pragma("unroll") for (int k = 0; k < 2; ++k) \
        acc[ai][bj][m][n] = __builtin_amdgcn_mfma_f32_16x16x32_bf16(Bt[n][k], At[m][k], acc[ai][bj][m][n], 0, 0, 0); __builtin_amdgcn_s_setprio(0); } while (0)
#ifdef G8_DRAIN
#define G8_WAIT_V(n) asm volatile("s_waitcnt vmcnt(0)" ::: "memory")
#else
#define G8_WAIT_V(n) asm volatile("s_waitcnt vmcnt(" #n ")" ::: "memory")
#endif
#define G8_WAIT_L(n) asm volatile("s_waitcnt lgkmcnt(" #n ")" ::: "memory")
#define G8_BAR __builtin_amdgcn_s_barrier()
#define G8_SCHED __builtin_amdgcn_sched_barrier(0)
    GUnit cur, nxt; int ui = 0;
    if (!S.next(0, cur)) return;
    unsigned cao[2][2], nao[2][2];
#pragma unroll
    for (int h = 0; h < 2; ++h)
#pragma unroll
        for (int i = 0; i < 2; ++i) { cao[h][i] = GATHER ? S.rowoff(cur, h * HALF + RA[i]) + (unsigned)CA[i] * 2u : voffA[i] + (unsigned)(h * hstep); nao[h][i] = cao[h][i]; }
    f32x4 acc[2][2][4][2];
#pragma unroll
    for (int a = 0; a < 2; ++a)
#pragma unroll
        for (int b = 0; b < 2; ++b)
#pragma unroll
            for (int m = 0; m < 4; ++m)
#pragma unroll
                for (int n = 0; n < 2; ++n) acc[a][b][m][n] = (f32x4){0.f, 0.f, 0.f, 0.f};
    bf16x8 At[4][2], B0[2][2], B1[2][2];
    const char* cA = cur.A; const char* cB = cur.B;
    S.a_ready(cur);
    G8_STAGE_B(G8_SB(0, 0), cB); G8_STAGE_B(G8_SB(0, 1), cB + hstep); G8_STAGE(G8_SA(0, 0), cA, cao[0][0], cao[0][1]); G8_STAGE(G8_SA(0, 1), cA, cao[1][0], cao[1][1]);
    if (wr == 1) G8_BAR;
    G8_WAIT_V(2); G8_BAR;
    G8_STAGE_B(G8_SB(1, 0), cB + kstep); G8_STAGE(G8_SA(1, 0), cA + kstep, cao[0][0], cao[0][1]); G8_STAGE_B(G8_SB(1, 1), cB + hstep + kstep);
    G8_WAIT_V(6); G8_BAR;
    for (;;) {
        const bool has_next = S.next(ui + 1, nxt);
        if (GATHER && has_next) {
#pragma unroll
            for (int h = 0; h < 2; ++h)
#pragma unroll
                for (int i = 0; i < 2; ++i) nao[h][i] = S.rowoff(nxt, h * HALF + RA[i]) + (unsigned)CA[i] * 2u;
        }
        const char* nA = has_next ? nxt.A : cA; const char* nB = has_next ? nxt.B : cB;
        for (int t = 0; t < nt; t += 2) {
            const bool last = (t == nt - 2);
            if (last && has_next) S.a_ready(nxt);
            const char* a1 = cA + (size_t)(t + 1) * kstep;
            const char* a2 = last ? nA : cA + (size_t)(t + 2) * kstep; const char* b2 = last ? nB : cB + (size_t)(t + 2) * kstep;
            const char* a3 = a2 + kstep; const char* b3 = b2 + kstep;
            asm volatile("" : "+s"(a1), "+s"(a2), "+s"(b2), "+s"(a3), "+s"(b3));
            unsigned o2[2][2];
#pragma unroll
            for (int h = 0; h < 2; ++h)
#pragma unroll
                for (int i = 0; i < 2; ++i) o2[h][i] = (GATHER && last && has_next) ? nao[h][i] : cao[h][i];
            G8_LDB(B0, 0, 0); G8_LDB(B1, 0, 1); G8_SCHED; G8_LDA(At, 0, 0); G8_STAGE(G8_SA(1, 1), a1, cao[1][0], cao[1][1]);
            G8_WAIT_V(8); G8_WAIT_L(0); G8_BAR; G8_MMA(0, 0, At, B0); G8_MMA(0, 1, At, B1); G8_BAR; G8_SCHED;
            G8_LDA(At, 0, 1); G8_STAGE_B(G8_SB(0, 0), b2); G8_STAGE_B(G8_SB(0, 1), b2 + hstep); G8_STAGE(G8_SA(0, 0), a2, o2[0][0], o2[0][1]);
            G8_WAIT_V(8); G8_WAIT_L(0); G8_BAR; G8_MMA(1, 0, At, B0); G8_MMA(1, 1, At, B1); G8_BAR; G8_SCHED;
            G8_LDB(B0, 1, 0); G8_LDB(B1, 1, 1); G8_SCHED; G8_LDA(At, 1, 0); G8_STAGE(G8_SA(0, 1), a2, o2[1][0], o2[1][1]);
            G8_WAIT_V(8); G8_WAIT_L(0); G8_BAR; G8_MMA(0, 0, At, B0); G8_MMA(0, 1, At, B1); G8_BAR; G8_SCHED;
            G8_LDA(At, 1, 1); G8_STAGE_B(G8_SB(1, 0), b3); G8_STAGE_B(G8_SB(1, 1), b3 + hstep); G8_STAGE(G8_SA(1, 0), a3, o2[0][0], o2[0][1]);
            G8_WAIT_V(8); G8_WAIT_L(0); G8_BAR; G8_MMA(1, 0, At, B0); G8_MMA(1, 1, At, B1); G8_BAR; G8_SCHED;
        }
        if constexpr (ALIGN_EPI) { if (wr == 0) G8_BAR; }
        {
          GUnit eu = cur; int fr_ = fr, fq_ = fq; asm volatile("" : "+s"(eu.pm), "+s"(eu.pn), "+s"(eu.e), "+s"(eu.r0)); asm volatile("" : "+v"(fr_), "+v"(fq_));
          E(acc, eu, wr, wc, fr_, fq_); S.done(cur); }
        if (!has_next) break;
#pragma unroll
        for (int a = 0; a < 2; ++a)
#pragma unroll
            for (int b = 0; b < 2; ++b)
#pragma unroll
                for (int m = 0; m < 4; ++m)
#pragma unroll
                    for (int n = 0; n < 2; ++n) acc[a][b][m][n] = (f32x4){0.f, 0.f, 0.f, 0.f};
        cur = nxt; cA = nA; cB = nB; ++ui;
#pragma unroll
        for (int h = 0; h < 2; ++h)
#pragma unroll
            for (int i = 0; i < 2; ++i) cao[h][i] = nao[h][i];
        if constexpr (ALIGN_EPI) { if (wr == 1) G8_BAR; }
    }
    G8_WAIT_V(0);
    if constexpr (!ALIGN_EPI) { if (wr == 0) G8_BAR; }
    G8_BAR;
#undef G8_SA
#undef G8_SB
#undef G8_STAGE
#undef G8_STAGE_B
#undef G8_LDA
#undef G8_LDB
#undef G8_MMA
#undef G8_WAIT_V
#undef G8_WAIT_L
#undef G8_BAR
#undef G8_SCHED
}

__device__ __forceinline__ u32x4 pack8(const f32x4 v0, const f32x4 v1) { u32x4 w; w.x = cvt_pk_bf16(v0[0], v0[1]); w.y = cvt_pk_bf16(v0[2], v0[3]); w.z = cvt_pk_bf16(v1[0], v1[1]); w.w = cvt_pk_bf16(v1[2], v1[3]); return w; }
__device__ __forceinline__ float sigmoidf_(float v) { return __builtin_amdgcn_rcpf(1.f + __builtin_amdgcn_exp2f(-1.4426950408889634f * v)); }

struct EpiProj {
    static constexpr bool PERM = true;
    bf16_t *qb, *kb, *vb, *ub, *gb; const float* rope; const float* gate_bias;
    __device__ __forceinline__ void operator()(const f32x4 (&acc)[2][2][4][2], const GUnit& u, int wr, int wc, int fr, int fq) const {
        const int row0 = u.pm * BM + wr * 64 + fr; const int cw = wc * 32 + 8 * fq; const int pn = u.pn;
#ifdef DBG_PLAIN_EPI
        if (pn < 8) { bf16_t* base = (pn < 4 ? qb : kb) + (pn & 3) * 256 + cw;
            for (int ai = 0; ai < 2; ++ai) for (int m = 0; m < 4; ++m) { const int t = row0 + ai * HALF + m * 16; for (int bj = 0; bj < 2; ++bj) *(u32x4*)(base + (size_t)t * 1024 + bj * HALF) = pack8(acc[ai][bj][m][0], acc[ai][bj][m][1]); } }
        else
#endif
        if (pn < 8) {
            bf16_t* base = (pn < 4 ? qb : kb) + (pn & 3) * 256 + cw; const float sc = pn < 4 ? QSCALE : 1.f; const int fi = 16 * (wc & 1) + 4 * fq;
#pragma unroll
            for (int ai = 0; ai < 2; ++ai)
#pragma unroll
                for (int m = 0; m < 4; ++m) { const int t = row0 + ai * HALF + m * 16; const f32x4 cs0 = *(const f32x4*)(rope + ((size_t)t * 32 + fi) * 2), cs1 = *(const f32x4*)(rope + ((size_t)t * 32 + fi) * 2 + 4);
                    const f32x4 c = {cs0[0], cs0[2], cs1[0], cs1[2]}, s = {cs0[1], cs0[3], cs1[1], cs1[3]};
#pragma unroll
                    for (int bj = 0; bj < 2; ++bj) { const f32x4 t1 = acc[ai][bj][m][0], t2 = acc[ai][bj][m][1]; const f32x4 o1 = (t1 * c - t2 * s) * sc, o2 = (t2 * c + t1 * s) * sc;
                        *(u32x4*)(base + (size_t)t * 1024 + bj * HALF) = pack8(o1, o2); } }
        } else if (pn < 14) {
            bf16_t* base; int ld; if (pn < 12) { base = vb + (pn - 8) * 256 + cw; ld = 1024; } else { base = ub + (pn - 12) * 256 + cw; ld = 512; }
#pragma unroll
            for (int ai = 0; ai < 2; ++ai)
#pragma unroll
                for (int m = 0; m < 4; ++m) { const int t = row0 + ai * HALF + m * 16;
#pragma unroll
                    for (int bj = 0; bj < 2; ++bj) *(u32x4*)(base + (size_t)t * ld + bj * HALF) = pack8(acc[ai][bj][m][0], acc[ai][bj][m][1]); }
        }
#ifdef DBG_PLAIN_EPI
        else { const int col0 = (pn - 14) * 256 + cw;
            for (int ai = 0; ai < 2; ++ai) for (int m = 0; m < 4; ++m) { const int t = row0 + ai * HALF + m * 16; for (int bj = 0; bj < 2; ++bj) *(u32x4*)(gb + (size_t)t * 2048 + col0 + bj * HALF) = pack8(acc[ai][bj][m][0], acc[ai][bj][m][1]); } }
#else
        else {
            const int col0 = (pn - 14) * 256 + cw; f32x4 bv[2][2];
#pragma unroll
            for (int bj = 0; bj < 2; ++bj)
#pragma unroll
                for (int n = 0; n < 2; ++n) bv[bj][n] = *(const f32x4*)(gate_bias + col0 + bj * HALF + 4 * n);
#pragma unroll
            for (int ai = 0; ai < 2; ++ai)
#pragma unroll
                for (int m = 0; m < 4; ++m) { const int t = row0 + ai * HALF + m * 16;
#pragma unroll
                    for (int bj = 0; bj < 2; ++bj) { f32x4 v0 = acc[ai][bj][m][0] + bv[bj][0], v1 = acc[ai][bj][m][1] + bv[bj][1];
#pragma unroll
                        for (int j = 0; j < 4; ++j) { v0[j] = sigmoidf_(v0[j]); v1[j] = sigmoidf_(v1[j]); }
                        *(u32x4*)(gb + (size_t)t * 2048 + col0 + bj * HALF) = pack8(v0, v1); } }
        }
#endif
    }
};
struct EpiScaleBf16 {
    static constexpr bool PERM = true;
    bf16_t* O; int ldc; const float* colscale;
    __device__ __forceinline__ void operator()(const f32x4 (&acc)[2][2][4][2], const GUnit& u, int wr, int wc, int fr, int fq) const {
        const int row0 = u.pm * BM + wr * 64 + fr, col0 = u.pn * BM + wc * 32 + 8 * fq; f32x4 sv[2][2];
#pragma unroll
        for (int bj = 0; bj < 2; ++bj)
#pragma unroll
            for (int n = 0; n < 2; ++n) sv[bj][n] = *(const f32x4*)(colscale + col0 + bj * HALF + 4 * n);
#pragma unroll
        for (int ai = 0; ai < 2; ++ai)
#pragma unroll
            for (int m = 0; m < 4; ++m) { bf16_t* rowp = O + (size_t)(row0 + ai * HALF + m * 16) * ldc + col0;
#pragma unroll
                for (int bj = 0; bj < 2; ++bj) *(u32x4*)(rowp + bj * HALF) = pack8(acc[ai][bj][m][0] * sv[bj][0], acc[ai][bj][m][1] * sv[bj][1]); }
    }
};
template <int BR> struct EpiMerge {
    static constexpr bool PERM = true;
    const bf16_t* gates; bf16_t* merged;
    __device__ __forceinline__ void operator()(const f32x4 (&acc)[2][2][4][2], const GUnit& u, int wr, int wc, int fr, int fq) const {
        const int row0 = u.pm * BM + wr * 64 + fr, col0 = u.pn * BM + wc * 32 + 8 * fq;
#pragma unroll
        for (int ai = 0; ai < 2; ++ai)
#pragma unroll
            for (int m = 0; m < 4; ++m) { const size_t t = row0 + ai * HALF + m * 16;
#pragma unroll
                for (int bj = 0; bj < 2; ++bj) { const u32x4 g = *(const u32x4*)(gates + t * 2048 + BR * 1024 + col0 + bj * HALF); bf16_t* mp = merged + t * 1024 + col0 + bj * HALF;
                    f32x4 v0 = acc[ai][bj][m][0], v1 = acc[ai][bj][m][1];
                    v0 = v0 * (f32x4){bflo(g.x), bfhi(g.x), bflo(g.y), bfhi(g.y)}; v1 = v1 * (f32x4){bflo(g.z), bfhi(g.z), bflo(g.w), bfhi(g.w)};
                    if (BR) { const u32x4 p = *(const u32x4*)mp; v0 = v0 + (f32x4){bflo(p.x), bfhi(p.x), bflo(p.y), bfhi(p.y)}; v1 = v1 + (f32x4){bflo(p.z), bfhi(p.z), bflo(p.w), bfhi(p.w)}; }
                    *(u32x4*)mp = pack8(v0, v1); } }
    }
};
struct EpiResid {
    static constexpr bool PERM = false;
    const float* x; float* y;
    __device__ __forceinline__ void operator()(const f32x4 (&acc)[2][2][4][2], const GUnit& u, int wr, int wc, int fr, int fq) const {
        const int row0 = u.pm * BM + wr * 64 + fr, col0 = u.pn * BM + wc * 32 + 4 * fq;
#pragma unroll
        for (int ai = 0; ai < 2; ++ai)
#pragma unroll
            for (int m = 0; m < 4; ++m) { const size_t off = (size_t)(row0 + ai * HALF + m * 16) * 1024 + col0;
#pragma unroll
                for (int bj = 0; bj < 2; ++bj)
#pragma unroll
                    for (int n = 0; n < 2; ++n) { const f32x4 xv = *(const f32x4*)(x + off + bj * HALF + n * 16); *(f32x4*)(y + off + bj * HALF + n * 16) = xv * ALPHA + acc[ai][bj][m][n]; } }
    }
};
struct EpiGateUp {
    static constexpr bool PERM = true;
    bf16_t* h;
    __device__ __forceinline__ void operator()(const f32x4 (&acc)[2][2][4][2], const GUnit& u, int wr, int wc, int fr, int fq) const {
        const int row0 = u.pm * BM + wr * 64 + fr, col0 = u.pn * 128 + wc * 16 + 4 * fq;
#pragma unroll
        for (int ai = 0; ai < 2; ++ai)
#pragma unroll
            for (int m = 0; m < 4; ++m) { bf16_t* rowp = h + (size_t)(row0 + ai * HALF + m * 16) * 512 + col0;
#pragma unroll
                for (int bj = 0; bj < 2; ++bj) { const f32x4 g = acc[ai][bj][m][0], up = acc[ai][bj][m][1]; f32x4 o;
#pragma unroll
                    for (int j = 0; j < 4; ++j) o[j] = g[j] * sigmoidf_(g[j]) * up[j];
                    const unsigned long long w = (unsigned long long)cvt_pk_bf16(o[0], o[1]) | ((unsigned long long)cvt_pk_bf16(o[2], o[3]) << 32);
                    __hip_atomic_store((unsigned long long*)(rowp + bj * 64), w, __ATOMIC_RELAXED, __HIP_MEMORY_SCOPE_AGENT); } }
    }
};
struct EpiDown {
    static constexpr bool PERM = true;
    bf16_t* ybuf; const int* list; const float* rw; const volatile LAS unsigned* cntl;
    __device__ __forceinline__ void operator()(const f32x4 (&acc)[2][2][4][2], const GUnit& u, int wr, int wc, int fr, int fq) const {
        const int p0 = u.r0 + wr * 64 + fr, col0 = u.pn * BM + wc * 32 + 8 * fq; const int cn = (int)cntl[u.e];
#pragma unroll
        for (int ai = 0; ai < 2; ++ai)
#pragma unroll
            for (int m = 0; m < 4; ++m) { const int p = p0 + ai * HALF + m * 16;
                if (p < cn) { const int ent = list[(size_t)u.e * T + p]; const float w = rw[ent]; bf16_t* rowp = ybuf + (size_t)ent * 1024 + col0;
#pragma unroll
                    for (int bj = 0; bj < 2; ++bj) *(u32x4*)(rowp + bj * HALF) = pack8(acc[ai][bj][m][0] * w, acc[ai][bj][m][1] * w); } }
    }
};
}

namespace at2 {
using f32x16 = __attribute__((ext_vector_type(16))) float;
using s16x4  = __attribute__((ext_vector_type(4))) short;
constexpr int KB_BYTES = 8192, VB_BYTES = 16384, KSLOT = 2 * KB_BYTES, NKS = 4, NVS = 3, OFF_V = NKS * KSLOT;
constexpr int OFF_Q = OFF_V + NVS * VB_BYTES, OFF_WS = 151552;
#define AT_SBAR() __builtin_amdgcn_sched_barrier(0)
__device__ __forceinline__ int crow(int r, int hi) { return (r & 3) + 8 * (r >> 2) + 4 * hi; }
__device__ __forceinline__ int v_st(int k, int c) { const int kk = (k & ~0xC) | ((k & 4) << 1) | ((k & 8) >> 1); return ((kk >> 3) * 4 + (c >> 5)) * 512 + ((kk & 7) * 32 + (c & 31)) * 2; }
__device__ __forceinline__ int v_rd_base(int lane) { return ((lane & 3) << 3) | (((lane >> 2) & 3) << 6) | (((lane >> 4) & 1) << 5) | (((lane >> 5) & 1) << 8); }
constexpr int v_rd_off(int d0, int ks, int half) { return d0 * 512 + ks * 4096 + half * 2048; }
template <int OFF> __device__ __forceinline__ s16x4 tr_read(int vb) { s16x4 r; asm volatile("ds_read_b64_tr_b16 %0, %1 offset:%2" : "=&v"(r) : "v"(vb), "i"(OFF) : "memory"); return r; }
template <int D0> __device__ __forceinline__ void pv_one(f32x16& od, int vb, bf16x8 pa0, bf16x8 pa1, bf16x8 pa2, bf16x8 pa3) {
    const s16x4 l0 = tr_read<v_rd_off(D0, 0, 0)>(vb), h0 = tr_read<v_rd_off(D0, 0, 1)>(vb), l1 = tr_read<v_rd_off(D0, 1, 0)>(vb), h1 = tr_read<v_rd_off(D0, 1, 1)>(vb);
    const s16x4 l2 = tr_read<v_rd_off(D0, 2, 0)>(vb), h2 = tr_read<v_rd_off(D0, 2, 1)>(vb), l3 = tr_read<v_rd_off(D0, 3, 0)>(vb), h3 = tr_read<v_rd_off(D0, 3, 1)>(vb);
    asm volatile("s_waitcnt lgkmcnt(0)" ::: "memory"); AT_SBAR();
#define AT_PK(L, H) (bf16x8){L[0], L[1], L[2], L[3], H[0], H[1], H[2], H[3]}
    od = __builtin_amdgcn_mfma_f32_32x32x16_bf16(pa0, AT_PK(l0, h0), od, 0, 0, 0);
    od = __builtin_amdgcn_mfma_f32_32x32x16_bf16(pa1, AT_PK(l1, h1), od, 0, 0, 0);
    od = __builtin_amdgcn_mfma_f32_32x32x16_bf16(pa2, AT_PK(l2, h2), od, 0, 0, 0);
    od = __builtin_amdgcn_mfma_f32_32x32x16_bf16(pa3, AT_PK(l3, h3), od, 0, 0, 0);
#undef AT_PK
}
__device__ __forceinline__ void qkt(f32x16& p0, f32x16& p1, const LAS unsigned char* Ks, const bf16x8* qr, int r32, int hi) {
    p0 = f32x16{}; p1 = f32x16{};
#pragma unroll
    for (int d0 = 0; d0 < 4; ++d0) { const LAS unsigned char* kp = Ks + (2 * d0 + hi) * 1024 + r32 * 16;
        const bf16x8 b0 = *(const LAS bf16x8*)(kp), b1 = *(const LAS bf16x8*)(kp + 512);
        p0 = __builtin_amdgcn_mfma_f32_32x32x16_bf16(b0, qr[d0], p0, 0, 0, 0);
        p1 = __builtin_amdgcn_mfma_f32_32x32x16_bf16(b1, qr[d0], p1, 0, 0, 0); }
}
__device__ __forceinline__ float hswap_max(float v) { auto rr = __builtin_amdgcn_permlane32_swap(__float_as_uint(v), __float_as_uint(v), false, false); return fmaxf(__uint_as_float(rr[0]), __uint_as_float(rr[1])); }
__device__ __forceinline__ float hswap_sum(float v) { auto rr = __builtin_amdgcn_permlane32_swap(__float_as_uint(v), __float_as_uint(v), false, false); return __uint_as_float(rr[0]) + __uint_as_float(rr[1]); }

template <unsigned var> __device__ __forceinline__ void attn_unit(LAS unsigned char* lds, int b, int head, int qblk, const bf16_t* __restrict__ Q, const bf16_t* __restrict__ K, const bf16_t* __restrict__ V,
                                          bf16_t* __restrict__ O, const float lam, const float* __restrict__ gain) {
    const int tid = threadIdx.x, lane = tid & 63, r32 = lane & 31, hi = lane >> 5; const int wid = __builtin_amdgcn_readfirstlane(tid >> 6); const int mp = wid >> 2, wq = wid & 3;
    const int hm = head * 2 + mp; const size_t rowbase = (size_t)b * SEQ; const int q0 = qblk * 128;
    const int mychunk = 2 * qblk + (wq >> 1); const int NT = 2 * qblk + 2;
    LAS float* wsf = (LAS float*)(lds + OFF_WS) + wid * 64;
    LAS unsigned char* qlds = lds + OFF_Q + wid * 4096 + hi * 512 + r32 * 16;
    { const bf16_t* qp = Q + (rowbase + q0 + wq * 32 + r32) * 1024 + hm * 64 + hi * 8;
#pragma unroll
      for (int d0 = 0; d0 < 4; ++d0) *(LAS bf16x8*)(qlds + d0 * 1024) = *(const bf16x8*)(qp + d0 * 16); }
    const char* Kb = (const char*)(K + rowbase * 1024); const char* Vb = (const char*)(V + rowbase * 1024);
    unsigned kofs[2], vofs[2];
#pragma unroll
    for (int i = 0; i < 2; ++i) { const int ch = 2 * wq + i; kofs[i] = (unsigned)(lane * 2048 + hm * 128 + ch * 16);
        const int p = 2 * wid + i; const int kk = (p >> 1) * 8 + ((lane & 31) >> 2); const int k = (kk & ~0xC) | ((kk & 4) << 1) | ((kk & 8) >> 1); const int c = (2 * (p & 1) + (lane >> 5)) * 32 + (lane & 3) * 8;
        vofs[i] = (unsigned)(k * 2048 + head * 256 + c * 2); }
    const unsigned kdst = (unsigned)(mp * KB_BYTES + (2 * wq) * 1024), vdst = (unsigned)(OFF_V + (2 * wid) * 1024);
#define AT_DMA_K(j, KO) do { const char* kj_ = Kb + (size_t)(j) * 131072; \
        __builtin_amdgcn_global_load_lds((const unsigned*)(kj_ + kofs[0]), (LAS unsigned*)(lds + (KO) + kdst), 16, 0, 0); __builtin_amdgcn_global_load_lds((const unsigned*)(kj_ + kofs[1]), (LAS unsigned*)(lds + (KO) + kdst + 1024), 16, 0, 0); } while (0)
#define AT_DMA_V(j, VO) do { const char* vj_ = Vb + (size_t)(j) * 131072; \
        __builtin_amdgcn_global_load_lds((const unsigned*)(vj_ + vofs[0]), (LAS unsigned*)(lds + (VO) + vdst), 16, 0, 0); __builtin_amdgcn_global_load_lds((const unsigned*)(vj_ + vofs[1]), (LAS unsigned*)(lds + (VO) + vdst + 1024), 16, 0, 0); } while (0)
    float mhat = 0.f, l_reg = 0.f; f32x16 o[4] = {};
    const int vb0 = (int)(uintptr_t)(lds + OFF_V) + v_rd_base(lane);
    const LAS unsigned char* kb0 = lds + mp * KB_BYTES;
    constexpr float THR = 8.f;
    f32x16 pA0 = {}, pA1 = {}, pB0 = {}, pB1 = {}; float alA = 1.f, alB = 1.f; bool rsA = false, rsB = false;
    int kcur = 0, k1 = KSLOT, k2 = 2 * KSLOT;
    int vprev = 2 * VB_BYTES, vcur = 0, vnext = VB_BYTES;
#define AT_ROT() do { kcur = k1; k1 = k2; k2 = (k2 == (NKS - 1) * KSLOT) ? 0 : k2 + KSLOT; vprev = vcur; vcur = vnext; vnext = (vnext == (NVS - 1) * VB_BYTES) ? 0 : vnext + VB_BYTES; } while (0)
#define AT_QKT(P0, P1, SL) do { const LAS unsigned char* kp_ = kb0 + (SL) + hi * 1024 + r32 * 16; P0 = f32x16{}; P1 = f32x16{}; \
        _Pragma("unroll") for (int d0 = 0; d0 < 4; ++d0) { const bf16x8 b0_ = *(const LAS bf16x8*)(kp_ + d0 * 2048), b1_ = *(const LAS bf16x8*)(kp_ + d0 * 2048 + 512), q_ = *(const LAS bf16x8*)(qlds + d0 * 1024); \
            P0 = __builtin_amdgcn_mfma_f32_32x32x16_bf16(b0_, q_, P0, 0, 0, 0); P1 = __builtin_amdgcn_mfma_f32_32x32x16_bf16(b1_, q_, P1, 0, 0, 0); } } while (0)
#define AT_PSM(P0, P1, AL, RS, FIRST) do { float pm_ = P0[0]; _Pragma("unroll") for (int r = 1; r < 16; ++r) pm_ = fmaxf(pm_, P0[r]); _Pragma("unroll") for (int r = 0; r < 16; ++r) pm_ = fmaxf(pm_, P1[r]); \
        pm_ = hswap_max(pm_) - mhat; RS = (FIRST) || __any(pm_ > THR); AL = 1.f; \
        if (RS) { const float dl_ = (FIRST) ? pm_ : fmaxf(pm_, 0.f); mhat += dl_; AL = __builtin_amdgcn_exp2f(-dl_); } \
        _Pragma("unroll") for (int r = 0; r < 16; ++r) { P0[r] = __builtin_amdgcn_exp2f(P0[r] - mhat); P1[r] = __builtin_amdgcn_exp2f(P1[r] - mhat); } } while (0)
#define AT_PK4(P, BASE, OUT) do { const unsigned a0 = cvt_pk_bf16(P[BASE + 0], P[BASE + 1]), a1 = cvt_pk_bf16(P[BASE + 2], P[BASE + 3]); \
        const unsigned b0 = cvt_pk_bf16(P[BASE + 4], P[BASE + 5]), b1 = cvt_pk_bf16(P[BASE + 6], P[BASE + 7]); \
        auto r0_ = __builtin_amdgcn_permlane32_swap(a0, b0, false, false); auto r1_ = __builtin_amdgcn_permlane32_swap(a1, b1, false, false); \
        u32x4 w_ = {r0_[0], r1_[0], r0_[1], r1_[1]}; OUT = __builtin_bit_cast(bf16x8, w_); } while (0)
#define AT_FIN_PV(P0, P1, AL, SL) do { float ps_ = 0.f; _Pragma("unroll") for (int r = 0; r < 16; ++r) ps_ += P0[r]; _Pragma("unroll") for (int r = 0; r < 16; ++r) ps_ += P1[r]; \
        ps_ = hswap_sum(ps_); l_reg = l_reg * (AL) + ps_; bf16x8 pa0, pa1, pa2, pa3; AT_PK4(P0, 0, pa0); AT_PK4(P0, 8, pa1); AT_PK4(P1, 0, pa2); AT_PK4(P1, 8, pa3); const int vb_ = vb0 + (SL); \
        pv_one<0>(o[0], vb_, pa0, pa1, pa2, pa3); pv_one<1>(o[1], vb_, pa0, pa1, pa2, pa3); pv_one<2>(o[2], vb_, pa0, pa1, pa2, pa3); pv_one<3>(o[3], vb_, pa0, pa1, pa2, pa3); } while (0)
#define AT_RESC(AL, RS) do { if (RS) { if (hi == 0) wsf[r32] = (AL); asm volatile("s_waitcnt lgkmcnt(0)" ::: "memory"); \
        _Pragma("unroll") for (int r = 0; r < 16; ++r) { const float a_ = wsf[crow(r, hi)]; _Pragma("unroll") for (int d = 0; d < 4; ++d) o[d][r] *= a_; } } } while (0)
#define AT_STEP0(u, PC0, PC1, ALC, RSC, PP0, PP1, ALP) do { const bool nk_ = (u) + 2 < NT && !(var & 2u), nv_ = (u) + 1 < NT && !(var & 2u); if (nk_) AT_DMA_K((u) + 2, k2); if (nv_) AT_DMA_V((u) + 1, vnext); \
        const bool aX_ = (u) < NT && (u) <= mychunk, aF_ = (u) >= 1 && (u) - 1 <= mychunk; \
        if (aX_ && !(var & 16u)) AT_QKT(PC0, PC1, kcur); \
        if (aF_ && !(var & 4u)) AT_FIN_PV(PP0, PP1, ALP, vprev); \
        if (aX_ && !(var & 8u)) { AT_PSM(PC0, PC1, ALC, RSC, (u) == 0); AT_RESC(ALC, RSC); } \
        if (nk_) asm volatile("s_waitcnt vmcnt(4)" ::: "memory"); else if (nv_) asm volatile("s_waitcnt vmcnt(2)" ::: "memory"); else asm volatile("s_waitcnt vmcnt(0)" ::: "memory"); \
        __syncthreads(); AT_ROT(); } while (0)
    AT_DMA_K(0, 0); AT_DMA_V(0, 0); if (!(var & 2u) || true) AT_DMA_K(1, KSLOT); asm volatile("s_waitcnt vmcnt(0)" ::: "memory"); __syncthreads();
    for (int u = 0; u < NT + 2; u += 2) { AT_STEP0(u, pA0, pA1, alA, rsA, pB0, pB1, alB); AT_STEP0(u + 1, pB0, pB1, alB, rsB, pA0, pA1, alA); }
#undef AT_DMA_K
#undef AT_DMA_V
#undef AT_ROT
#undef AT_QKT
#undef AT_PSM
#undef AT_PK4
#undef AT_FIN_PV
#undef AT_RESC
#undef AT_STEP0
    if (hi == 0) wsf[r32] = 1.f / l_reg;
    asm volatile("s_waitcnt lgkmcnt(0)" ::: "memory");
    float rli[16];
#pragma unroll
    for (int r = 0; r < 16; ++r) rli[r] = wsf[crow(r, hi)];
    LAS float* xch = (LAS float*)lds + wq * 4096;
    if (mp == 1) {
#pragma unroll
        for (int d = 0; d < 4; ++d)
#pragma unroll
            for (int r = 0; r < 16; ++r) xch[(d * 16 + r) * 64 + lane] = o[d][r] * rli[r];
    }
    __syncthreads();
    if (mp == 0) {
#pragma unroll
        for (int d = 0; d < 4; ++d)
#pragma unroll
            for (int r = 0; r < 16; ++r) { const float v2 = xch[(d * 16 + r) * 64 + lane]; o[d][r] = o[d][r] * rli[r] - lam * v2; }
    }
    __syncthreads();
    LAS float* stg = (LAS float*)lds + wq * 4224;
    if (mp == 0) {
#pragma unroll
        for (int d = 0; d < 4; ++d)
#pragma unroll
            for (int r = 0; r < 16; ++r) stg[crow(r, hi) * 132 + d * 32 + r32] = o[d][r];
        asm volatile("s_waitcnt lgkmcnt(0)" ::: "memory");
        const int row = lane >> 1, ch = (lane & 1) * 64; const LAS float* sp = stg + row * 132 + ch; float vv[64]; float ss = 0.f;
#pragma unroll
        for (int i = 0; i < 16; ++i) { const f32x4 t4 = *(const LAS f32x4*)(sp + 4 * i); vv[4 * i] = t4[0]; vv[4 * i + 1] = t4[1]; vv[4 * i + 2] = t4[2]; vv[4 * i + 3] = t4[3]; ss += (t4[0] * t4[0] + t4[1] * t4[1]) + (t4[2] * t4[2] + t4[3] * t4[3]); }
        ss += __shfl_xor(ss, 1);
        const float rs = (1.0f / sqrtf(ss * (1.f / 128.f) + RMS_EPS)) * (1.f - LAMBDA_INIT);
        bf16_t* op = O + (rowbase + q0 + wq * 32 + row) * 1024 + head * 128 + ch; const float* gp = gain + ch;
#pragma unroll
        for (int i = 0; i < 8; ++i) { const f32x4 g0 = *(const f32x4*)(gp + 8 * i), g1 = *(const f32x4*)(gp + 8 * i + 4); u32x4 w;
            w.x = cvt_pk_bf16(vv[8 * i] * rs * g0[0], vv[8 * i + 1] * rs * g0[1]); w.y = cvt_pk_bf16(vv[8 * i + 2] * rs * g0[2], vv[8 * i + 3] * rs * g0[3]);
            w.z = cvt_pk_bf16(vv[8 * i + 4] * rs * g1[0], vv[8 * i + 5] * rs * g1[1]); w.w = cvt_pk_bf16(vv[8 * i + 6] * rs * g1[2], vv[8 * i + 7] * rs * g1[3]);
            *(u32x4*)(op + 8 * i) = w; }
    }
    __syncthreads();
}
template <unsigned var> __device__ __forceinline__ void attn_phase(LAS unsigned char* lds, int vcu, int ncu, const bf16_t* Q, const bf16_t* K, const bf16_t* V, bf16_t* O, const float* scal, const float* gain) {
    const float lam = scal[0];
    for (int bh = vcu >> 1; bh < NB * NHEAD; bh += (ncu >> 1)) {
        const int b = bh >> 3, head = bh & 7;
        for (int i = 0; i < 8; ++i) { const int s = (vcu & 1) + 2 * (i >> 1); const int qblk = (i & 1) ? 15 - s : s;
            attn_unit<var>(lds, b, head, qblk, Q, K, V, O, lam, gain); }
    }
}
#undef AT_SBAR
}

struct MKArgs { const void* in[21]; float* out; unsigned char* ws; unsigned mask; unsigned li; };
enum { PH_PRO = 0, PH_G1, PH_POOLA, PH_ATT, PH_POOLG, PH_G4A, PH_G4B, PH_G5, PH_ROUTER, PH_G7, PH_G8, PH_FINAL, PH_N };

template <int MODE> __device__ __forceinline__ int dest_row(int n) {
    if (MODE == 1) return n < 2048 ? (n & ~63) + qk_pos_of_d(n & 63) : n;
    if (MODE == 2) { const int nn = n >> 9, hc = n & 511; return (hc >> 7) * 256 + ((hc >> 6) & 1) * 128 + ((hc >> 4) & 3) * 32 + ((hc >> 2) & 3) * 8 + nn * 4 + (hc & 3); }
    return n;
}
template <int MODE> __device__ __forceinline__ void transpose_item(const float* __restrict__ W, int ldw, int N, bf16_t* __restrict__ WT, int ldt, int coloff, int rowoff, LAS float* scr, int item, int lane) {
    const int nblk = N / 64, kb = item / nblk, nb = item % nblk, k0 = 64 * kb, n0 = 64 * nb;
    const int lr = lane >> 4, n4 = (lane & 15) * 4;
#pragma unroll 4
    for (int i = 0; i < 16; ++i) { const int kk = 4 * i + lr; const f32x4 v = *(const f32x4*)(W + (size_t)(k0 + kk) * ldw + n0 + n4); *(LAS f32x4*)(scr + kk * 64 + (n4 ^ ((kk >> 3) << 2))) = v; }
    LDS_WAIT(); asm volatile("" ::: "memory");
    const int c = lane & 7;
#pragma unroll 2
    for (int jj = 0; jj < 8; ++jj) { const int n = 8 * jj + (lane >> 3); const LAS float* sp = scr + (8 * c) * 64 + (n ^ (c << 2));
        u32x4 o; o.x = cvt_pk_bf16(sp[0 * 64], sp[1 * 64]); o.y = cvt_pk_bf16(sp[2 * 64], sp[3 * 64]); o.z = cvt_pk_bf16(sp[4 * 64], sp[5 * 64]); o.w = cvt_pk_bf16(sp[6 * 64], sp[7 * 64]);
        *(u32x4*)(WT + (size_t)(rowoff + dest_row<MODE>(n0 + n)) * ldt + coloff + k0 + 8 * c) = o; }
    LDS_WAIT(); asm volatile("" ::: "memory");
}

__global__ void __launch_bounds__(NTHREADS, 2) mk_fwd(MKArgs args) {
    __shared__ __attribute__((aligned(16))) unsigned char lds_raw[LDS_BYTES];
    LAS unsigned char* lds = (LAS unsigned char*)lds_raw;
    volatile LAS unsigned* MISC = (volatile LAS unsigned*)(lds + MISC_OFF);
    const int tid = threadIdx.x, lane = tid & 63, wave = __builtin_amdgcn_readfirstlane(tid >> 6);
    const int G = gridDim.x; const int bx = blockIdx.x; const int vcu = (G % 8 == 0) ? (bx % 8) * (G / 8) + bx / 8 : bx;
    const unsigned mask = args.mask;
    unsigned char* const ws = args.ws; float* const out = args.out;
#define IN_F(k) ((const float*)args.in[k])
#define x_ IN_F(0)
#define positions ((const int*)args.in[1])
#define w_in IN_F(2)
#define gate_bias IN_F(3)
#define lam_vecs IN_F(4)
#define subln_gain IN_F(5)
#define w_pool IN_F(6)
#define pool_scale IN_F(7)
#define w_branch_a IN_F(8)
#define w_branch_b IN_F(9)
#define w_out IN_F(10)
#define ln1_g IN_F(11)
#define ln1_b IN_F(12)
#define wrg IN_F(13)
#define brg IN_F(14)
#define wre IN_F(15)
#define bre IN_F(16)
#define wgu IN_F(17)
#define wdn IN_F(18)
#define ln2_g IN_F(19)
#define ln2_b IN_F(20)
#define wt ((bf16_t*)(ws + WS_WT))
#define xb ((bf16_t*)(ws + WS_XB))
#define qb ((bf16_t*)(ws + WS_Q))
#define kb ((bf16_t*)(ws + WS_K))
#define vb ((bf16_t*)(ws + WS_V))
#define ub ((bf16_t*)(ws + WS_U))
#define gb ((bf16_t*)out)
#define on ((bf16_t*)(ws + WS_ON))
#define mixed ((bf16_t*)(ws + WS_MIXED))
#define merged ((bf16_t*)(ws + WS_MERGED))
#define x1b ((bf16_t*)(ws + WS_X1B))
#define hb ((bf16_t*)(ws + WS_H))
#define ybuf ((bf16_t*)(ws + WS_YBUF))
#define rope ((float*)(ws + WS_ROPE))
#define pooled ((bf16_t*)(ws + WS_POOLED))
#define misc (ws + WS_MISC)
#define ctl ((unsigned*)(misc + MS_CTL))
#define stats ((float2*)(misc + MS_STATS))
#define rw ((float*)(misc + MS_ROUTE + (size_t)T * 8))
#define list ((int*)(misc + MS_LIST))
#define scal ((float*)(misc + MS_SCAL))
#define cnt (ctl + CW_CNT)
#define wpool_bd ((bf16_t*)(misc + MS_WPOOL))

    for (int u = tid; u < (LDS_BYTES - LDS_CTL_OFF) / 4; u += NTHREADS) ((LAS unsigned*)(lds + LDS_CTL_OFF))[u] = 0u;
    __syncthreads();
    XcdBarrier bar; bar.bar = ctl + CW_BAR + (args.li & 255u) * XCD_BAR_WORDS; bar.x = 0; bar.st = nullptr;
    const bool multi = (mask & (mask - 1u)) != 0u;
    if (multi) bar = xcd_barrier_post(ctl + CW_BAR + (args.li & 255u) * XCD_BAR_WORDS, MISC + 8);
#ifndef MK_CT
#define MK_CT 0xfffu
#endif
#define HAS(p) (((MK_CT >> (p)) & 1u) && ((mask >> (p)) & 1u))
#ifndef MK_REP
#define MK_REP 0u
#endif
#define REPS(p) for (int rep_ = 0; rep_ < ((((MK_REP) >> (p)) & 1u) ? 2 : 1); ++rep_)
#define SEAM(p) do { if (multi && (mask >> ((p) + 1)) != 0u) xcd_barrier(bar); } while (0)
    const int gw = vcu * NWAVES + wave, NGW = G * NWAVES;

    if (HAS(PH_PRO)) {
        LAS float* scr = (LAS float*)(lds + wave * 16384);
        constexpr int I_IN = 16 * (INW / 64), I_A = 16 * 16, I_O = 16 * 16, I_GU = 16 * 16, I_DN = 8 * 16;
        constexpr int NITEMS = I_IN + I_A + I_O + NE * I_GU + NE * I_DN;
        for (int it = gw; it < NITEMS; it += NGW) {
            int r = it;
            if (r < I_IN) { transpose_item<1>(w_in, INW, INW, wt + WT_IN, 1024, 0, 0, scr, r, lane); continue; } r -= I_IN;
            if (r < I_A) { transpose_item<0>(w_branch_a, 1024, 1024, wt + WT_A, 1024, 0, 0, scr, r, lane); continue; } r -= I_A;
            if (r < I_O) { transpose_item<0>(w_out, 1024, 1024, wt + WT_O, 1024, 0, 0, scr, r, lane); continue; } r -= I_O;
            if (r < NE * I_GU) { const int e = r / I_GU; transpose_item<2>(wgu + (size_t)e * 1024 * 1024, 1024, 1024, wt + WT_GU + (size_t)e * 1024 * 1024, 1024, 0, 0, scr, r % I_GU, lane); continue; } r -= NE * I_GU;
            { const int e = r / I_DN; transpose_item<0>(wdn + (size_t)e * 512 * 1024, 1024, 1024, wt + WT_DN + (size_t)e * 1024 * 512, 512, 0, 0, scr, r % I_DN, lane); }
        }
        for (int it = gw; it < 64 * 16; it += NGW) { const int kc = it >> 4, n = (it & 15) * 64 + lane; const int g = kc >> 4, c0 = (kc & 15) * 8; float a8[8] = {0.f, 0.f, 0.f, 0.f, 0.f, 0.f, 0.f, 0.f};
            const float* wpg = w_pool + (size_t)(g * 128 + c0) * 128; const float* wbp = w_branch_b + (size_t)(g * 128) * 1024 + n; const float* psp = pool_scale + g * 128;
            for (int d = 0; d < 128; ++d) { const float bv = wbp[(size_t)d * 1024] * psp[d];
#pragma unroll
                for (int i = 0; i < 8; ++i) a8[i] = fmaf(wpg[i * 128 + d], bv, a8[i]); }
            u32x4 o; o.x = cvt_pk_bf16(a8[0], a8[1]); o.y = cvt_pk_bf16(a8[2], a8[3]); o.z = cvt_pk_bf16(a8[4], a8[5]); o.w = cvt_pk_bf16(a8[6], a8[7]);
            *(u32x4*)(wt + WT_B + (size_t)n * 512 + kc * 8) = o; }
        for (int m = gw; m < T; m += NGW) { const f32x4* xr = (const f32x4*)(x_ + (size_t)m * 1024) + lane; u32x2* o8 = (u32x2*)(xb + (size_t)m * 1024) + lane;
#pragma unroll
            for (int j = 0; j < 4; ++j) { const f32x4 v = xr[64 * j]; u32x2 w; w.x = cvt_pk_bf16(v[0], v[1]); w.y = cvt_pk_bf16(v[2], v[3]); o8[64 * j] = w; } }
        for (int e = gw * 64 + lane; e < T * 32; e += NGW * 64) { const int t = e >> 5, i = e & 31; const float inv = powf(10000.0f, -(float)i * (2.0f / 64.0f)); const float ang = (float)positions[t] * inv; const double a = (double)ang;
            rope[2 * e] = (float)cos(a); rope[2 * e + 1] = (float)sin(a); }
        if (gw == 0 && lane == 0) { float s01 = 0.f, s23 = 0.f; for (int i = 0; i < 64; ++i) { s01 += lam_vecs[i] * lam_vecs[64 + i]; s23 += lam_vecs[128 + i] * lam_vecs[192 + i]; } scal[0] = expf(s01) - expf(s23) + LAMBDA_INIT; }
        { f32x4* wp = (f32x4*)(misc + MS_WP);
          for (int e = gw * 64 + lane; e < 16 * 3 * 4 * 64; e += NGW * 64) { const int l = e & 63, sg = (e >> 6) & 3, ob = (e >> 8) % 3, chunk = (e >> 8) / 3; const int o = ob * 16 + (l & 15); f32x4 v = {0.f, 0.f, 0.f, 0.f};
              if (o < 36) {
#pragma unroll
                  for (int j = 0; j < 4; ++j) { const int c = chunk * 64 + (l >> 4) * 16 + 4 * sg + j; v[j] = ln1_g[c] * (o < 4 ? wrg[c * 4 + o] : wre[c * 32 + (o - 4)]); } }
              wp[e] = v; }
          float* csbw = (float*)(misc + MS_CSBW);
          if (gw < 48) { const int o = gw; float cs = 0.f, bw = 0.f;
              if (o < 36) { for (int i = 0; i < 16; ++i) { const int c = lane + 64 * i; const float w = (o < 4 ? wrg[c * 4 + o] : wre[c * 32 + (o - 4)]); cs += ln1_g[c] * w; bw += ln1_b[c] * w; }
                  cs = wave_sum(cs); bw = wave_sum(bw) + (o < 4 ? brg[o] : bre[o - 4]); }
              if (lane == 0) { csbw[o] = cs; csbw[48 + o] = bw; } } }
        __syncthreads();
        SEAM(PH_PRO);
    }
    if (HAS(PH_G1)) {
        g8::DenseOrder S; S.init(xb, wt + WT_IN, T, INW, 1024, G, bx);
        g8::EpiProj E{qb, kb, vb, ub, gb, rope, gate_bias};
        g8::gemm_phase<g8::EpiProj, g8::DenseOrder, true, false>(lds, 1024, S, E);
        SEAM(PH_G1);
    }
    if (HAS(PH_POOLA)) {
        for (int e = (gw * 64 + lane); e < T * 64; e += NGW * 64) { const int t = e >> 6, c8 = (e & 63) * 8; const int g = c8 >> 7, w = 2 << g, s = t & (SEQ - 1); const int n = (s + 1 < w) ? s + 1 : w;
            float a[8] = {0.f, 0.f, 0.f, 0.f, 0.f, 0.f, 0.f, 0.f}; float u0[8];
            for (int i = 0; i < n; ++i) { const u32x4 v = *(const u32x4*)(ub + (size_t)(t - i) * 512 + c8); const float f[8] = {bflo(v.x), bfhi(v.x), bflo(v.y), bfhi(v.y), bflo(v.z), bfhi(v.z), bflo(v.w), bfhi(v.w)};
#pragma unroll
                for (int j = 0; j < 8; ++j) { a[j] += f[j]; if (i == 0) u0[j] = f[j]; } }
            const float inv = 1.f / (float)n; u32x4 o; o.x = cvt_pk_bf16(a[0] * inv - u0[0], a[1] * inv - u0[1]); o.y = cvt_pk_bf16(a[2] * inv - u0[2], a[3] * inv - u0[3]);
            o.z = cvt_pk_bf16(a[4] * inv - u0[4], a[5] * inv - u0[5]); o.w = cvt_pk_bf16(a[6] * inv - u0[6], a[7] * inv - u0[7]);
            *(u32x4*)(pooled + (size_t)t * 512 + c8) = o; }
    }
    if (HAS(PH_ATT)) {
#ifdef MK_VAR
        if (args.li >> 8) at2::attn_phase<MK_VAR>(lds, vcu, G, qb, kb, vb, (bf16_t*)(ws + WS_POOLED), scal, subln_gain); else
#endif
        at2::attn_phase<0u>(lds, vcu, G, qb, kb, vb, on, scal, subln_gain);
        SEAM(PH_ATT); }
    else if (HAS(PH_POOLA)) { SEAM(PH_ATT); }
    if (HAS(PH_G4A)) {
        g8::DenseOrder S; S.init(on, wt + WT_A, T, 1024, 1024, G, bx);
        g8::EpiMerge<0> E{gb, merged};
        g8::gemm_phase<g8::EpiMerge<0>, g8::DenseOrder, true, false>(lds, 1024, S, E);
    }
    if (HAS(PH_G4B)) {
        g8::DenseOrder S; S.init(pooled, wt + WT_B, T, 1024, 512, G, bx);
        g8::EpiMerge<1> E{gb, merged};
        g8::gemm_phase<g8::EpiMerge<1>, g8::DenseOrder, true, false>(lds, 512, S, E);
        SEAM(PH_G4B);
    } else if (HAS(PH_G4A)) { SEAM(PH_G4B); }
    if (HAS(PH_G5)) {
        g8::DenseOrder S; S.init(merged, wt + WT_O, T, 1024, 1024, G, bx);
        g8::EpiResid E{x_, out};
        g8::gemm_phase<g8::EpiResid, g8::DenseOrder, true, false>(lds, 1024, S, E);
        SEAM(PH_G5);
    }
    if (HAS(PH_ROUTER)) {
        LAS float* lgs = (LAS float*)(lds + 0) + wave * (16 * 49);
        LAS float* tst = (LAS float*)(lds + 32768) + wave * 32;
        LAS int*   tex = (LAS int*)(lds + 36864) + wave * 64;
        LAS unsigned* lcnt = (LAS unsigned*)(lds + 40960);
        const f32x4* wp = (const f32x4*)(misc + MS_WP); const float* csbw = (const float*)(misc + MS_CSBW);
        for (int t0 = vcu * 128; t0 < T; t0 += G * 128) {
            if (tid < 64) lcnt[tid] = 0u;
            __syncthreads();
            const int tw = t0 + wave * 16; const int tk = lane & 15, q = lane >> 4;
            { const float* yr = out + (size_t)(tw + tk) * 1024 + q * 16; float s1 = 0.f, s2 = 0.f;
              f32x4 acc0 = {0.f, 0.f, 0.f, 0.f}, acc1 = {0.f, 0.f, 0.f, 0.f}, acc2 = {0.f, 0.f, 0.f, 0.f};
#pragma unroll 2
              for (int chunk = 0; chunk < 16; ++chunk) { f32x4 yv[4];
#pragma unroll
                  for (int j = 0; j < 4; ++j) yv[j] = *(const f32x4*)(yr + chunk * 64 + 4 * j);
#pragma unroll
                  for (int sg = 0; sg < 4; ++sg) { const f32x4 b0 = wp[((chunk * 3 + 0) * 4 + sg) * 64 + lane], b1 = wp[((chunk * 3 + 1) * 4 + sg) * 64 + lane], b2 = wp[((chunk * 3 + 2) * 4 + sg) * 64 + lane];
#pragma unroll
                      for (int j = 0; j < 4; ++j) { const float a = yv[sg][j]; s1 += a; s2 = fmaf(a, a, s2);
                          acc0 = __builtin_amdgcn_mfma_f32_16x16x4f32(a, b0[j], acc0, 0, 0, 0); acc1 = __builtin_amdgcn_mfma_f32_16x16x4f32(a, b1[j], acc1, 0, 0, 0); acc2 = __builtin_amdgcn_mfma_f32_16x16x4f32(a, b2[j], acc2, 0, 0, 0); } } }
              s1 += __shfl_xor(s1, 16); s1 += __shfl_xor(s1, 32); s2 += __shfl_xor(s2, 16); s2 += __shfl_xor(s2, 32);
              const float mu = s1 * (1.f / 1024.f); const float var = fmaxf(s2 * (1.f / 1024.f) - mu * mu, 0.f); const float rstd = 1.0f / sqrtf(var + LN_EPS);
              if (q == 0) { tst[2 * tk] = mu; tst[2 * tk + 1] = rstd; stats[tw + tk] = make_float2(mu, rstd); }
#pragma unroll
              for (int r = 0; r < 4; ++r) { lgs[(4 * q + r) * 49 + tk] = acc0[r]; lgs[(4 * q + r) * 49 + 16 + tk] = acc1[r]; lgs[(4 * q + r) * 49 + 32 + tk] = acc2[r]; } }
            LDS_WAIT();
            if (lane < 16) { const int t = tw + lane; const float mu = tst[2 * lane], rstd = tst[2 * lane + 1]; const LAS float* lr = lgs + lane * 49;
                float lg[4], le[32];
#pragma unroll
                for (int o = 0; o < 4; ++o) lg[o] = rstd * (lr[o] - mu * csbw[o]) + csbw[48 + o];
#pragma unroll
                for (int o = 0; o < 32; ++o) le[o] = rstd * (lr[4 + o] - mu * csbw[4 + o]) + csbw[48 + 4 + o];
                int gi = 0; float gm = lg[0];
#pragma unroll
                for (int o = 1; o < 4; ++o) if (lg[o] > gm) { gm = lg[o]; gi = o; }
                float gs = 0.f;
#pragma unroll
                for (int o = 0; o < 4; ++o) gs += expf(lg[o] - gm);
                const float gp = 1.f / gs; float ev[8];
#pragma unroll
                for (int o = 0; o < 8; ++o) { float vsel = le[o];
#pragma unroll
                    for (int g = 1; g < 4; ++g) vsel = (gi == g) ? le[g * 8 + o] : vsel;
                    ev[o] = vsel; }
                int i0 = 0; float m0v = ev[0];
#pragma unroll
                for (int o = 1; o < 8; ++o) if (ev[o] > m0v) { m0v = ev[o]; i0 = o; }
                int i1 = (i0 == 0) ? 1 : 0; float m1v = -3.4e38f;
#pragma unroll
                for (int o = 0; o < 8; ++o) if (o != i0 && ev[o] > m1v) { m1v = ev[o]; i1 = o; }
                const float e1 = expf(m1v - m0v); const float w0 = gp / (1.f + e1), w1 = gp * e1 / (1.f + e1);
                const int ex0 = gi * 8 + i0, ex1 = gi * 8 + i1;
                rw[2 * t] = w0; rw[2 * t + 1] = w1;
                const unsigned r0 = __hip_atomic_fetch_add(lcnt + ex0, 1u, __ATOMIC_RELAXED, __HIP_MEMORY_SCOPE_WORKGROUP); const unsigned r1 = __hip_atomic_fetch_add(lcnt + ex1, 1u, __ATOMIC_RELAXED, __HIP_MEMORY_SCOPE_WORKGROUP);
                tex[4 * lane] = ex0; tex[4 * lane + 1] = ex1; tex[4 * lane + 2] = (int)r0; tex[4 * lane + 3] = (int)r1; }
            __syncthreads();
            if (tid < NE) { const unsigned c = lcnt[tid]; lcnt[32 + tid] = c ? atomicAdd(cnt + tid, c) : 0u; }
            __syncthreads();
            if (lane < 16) { const int t = tw + lane; const int ex0 = tex[4 * lane], ex1 = tex[4 * lane + 1];
                list[(size_t)ex0 * T + lcnt[32 + ex0] + (unsigned)tex[4 * lane + 2]] = t * 2; list[(size_t)ex1 * T + lcnt[32 + ex1] + (unsigned)tex[4 * lane + 3]] = t * 2 + 1; }
            for (int i = 0; i < 16; ++i) { const int t = tw + i; const float mu = tst[2 * i], rstd = tst[2 * i + 1]; const float* yr = out + (size_t)t * 1024;
#pragma unroll
                for (int j = 0; j < 4; ++j) { const int c0 = j * 256 + lane * 4; const f32x4 v = *(const f32x4*)(yr + c0), gg = *(const f32x4*)(ln1_g + c0), bb = *(const f32x4*)(ln1_b + c0);
                    u32x2 w; w.x = cvt_pk_bf16((v[0] - mu) * rstd * gg[0] + bb[0], (v[1] - mu) * rstd * gg[1] + bb[1]); w.y = cvt_pk_bf16((v[2] - mu) * rstd * gg[2] + bb[2], (v[3] - mu) * rstd * gg[3] + bb[3]);
                    *(u32x2*)(x1b + (size_t)t * 1024 + c0) = w; } }
            __syncthreads();
        }
        SEAM(PH_ROUTER);
    }
    if (HAS(PH_G7) || HAS(PH_G8)) {
        if (tid < NE) MISC[64 + tid] = __hip_atomic_load(cnt + tid, RLX_AGENT);
        __syncthreads();
        if (tid == 0) { unsigned acc = 0u; for (int e = 0; e < NE; ++e) { MISC[16 + e] = acc; acc += (MISC[64 + e] + 255u) >> 8; } MISC[16 + NE] = acc; }
        __syncthreads();
        const int ntiles = (int)MISC[16 + NE];
        unsigned* tdone = ctl + CW_TDONE;
        const int nwg = ntiles * 4, r7 = nwg % G;
        if (HAS(PH_G7)) {
            g8::MoeOrder S{(const char*)x1b, (const char*)(wt + WT_GU), list, MISC + 16, MISC + 64, nwg, G, bx, 0, (size_t)1024 * 1024 * 2, (size_t)256 * 1024 * 2, 1, tdone, 1};
            g8::EpiGateUp E{hb};
            g8::gemm_phase<g8::EpiGateUp, g8::MoeOrder, true, true>(lds, 1024, S, E);
        }
        if (HAS(PH_G8)) {
            g8::MoeOrder S{(const char*)hb, (const char*)(wt + WT_DN), list, MISC + 16, MISC + 64, nwg, G, (bx - r7 + G) % G, (size_t)256 * 512 * 2, (size_t)1024 * 512 * 2, (size_t)256 * 512 * 2, 0, tdone, 2};
            g8::EpiDown E{ybuf, list, rw, MISC + 64};
            g8::gemm_phase<g8::EpiDown, g8::MoeOrder, true, false>(lds, 512, S, E);
            SEAM(PH_G8);
        } else if (HAS(PH_G7)) { SEAM(PH_G8); }
    }
    if (HAS(PH_FINAL)) {
        for (int t = gw; t < T; t += NGW) {
            float* yr = out + (size_t)t * 1024; const float2 st = stats[t]; float xv[16]; float s = 0.f;
#pragma unroll
            for (int j = 0; j < 4; ++j) { const int c0 = j * 256 + lane * 4; const f32x4 vv = *(const f32x4*)(yr + c0); const f32x4 gg = *(const f32x4*)(ln1_g + c0); const f32x4 bb = *(const f32x4*)(ln1_b + c0);
                const u32x2 a = *(const u32x2*)(ybuf + (size_t)(2 * t) * 1024 + c0); const u32x2 b = *(const u32x2*)(ybuf + (size_t)(2 * t + 1) * 1024 + c0);
                const float ya[4] = {bflo(a.x), bfhi(a.x), bflo(a.y), bfhi(a.y)}; const float yb[4] = {bflo(b.x), bfhi(b.x), bflo(b.y), bfhi(b.y)};
#pragma unroll
                for (int i = 0; i < 4; ++i) { const float x1 = (vv[i] - st.x) * st.y * gg[i] + bb[i]; const float val = ALPHA * x1 + (ya[i] + yb[i]); xv[4 * j + i] = val; s += val; } }
            const float mu = wave_sum(s) * (1.f / 1024.f); float s2 = 0.f;
#pragma unroll
            for (int i = 0; i < 16; ++i) { const float d = xv[i] - mu; s2 += d * d; }
            const float rstd = 1.0f / sqrtf(wave_sum(s2) * (1.f / 1024.f) + LN_EPS);
#pragma unroll
            for (int j = 0; j < 4; ++j) { const int c0 = j * 256 + lane * 4; const f32x4 gg = *(const f32x4*)(ln2_g + c0); const f32x4 bb = *(const f32x4*)(ln2_b + c0); f32x4 o;
#pragma unroll
                for (int i = 0; i < 4; ++i) o[i] = (xv[4 * j + i] - mu) * rstd * gg[i] + bb[i];
                *(f32x4*)(yr + c0) = o; }
        }
    }
#undef HAS
#undef SEAM
}
#undef IN_F
#undef x_
#undef positions
#undef w_in
#undef gate_bias
#undef lam_vecs
#undef subln_gain
#undef w_pool
#undef pool_scale
#undef w_branch_a
#undef w_branch_b
#undef w_out
#undef ln1_g
#undef ln1_b
#undef wrg
#undef brg
#undef wre
#undef bre
#undef wgu
#undef wdn
#undef ln2_g
#undef ln2_b
#undef wt
#undef xb
#undef qb
#undef kb
#undef vb
#undef ub
#undef gb
#undef on
#undef mixed
#undef merged
#undef x1b
#undef hb
#undef ybuf
#undef rope
#undef pooled
#undef misc
#undef ctl
#undef stats
#undef rw
#undef list
#undef scal
#undef cnt
#undef wpool_bd


#ifndef MK_OPT
#define MK_OPT 0x003u
#endif
#ifndef MK_M2A
#define MK_M2A 0xff4u
#define MK_M2B 0u
#define MK_M2C 0u
#endif
#ifndef MK_ONE
#define MK_ONE 0
#endif
constexpr unsigned OPT = MK_OPT;
#define OPTP(p) ((OPT >> (p)) & 1u)


#ifdef MK_DEBUG_HASH
__global__ void k_hash(const uint4* __restrict__ p, size_t n16, unsigned long long* __restrict__ outh) {
    unsigned long long h = 0ull;
    for (size_t i = blockIdx.x * (size_t)blockDim.x + threadIdx.x; i < n16; i += (size_t)gridDim.x * blockDim.x) { const uint4 w = p[i];
        const unsigned long long m = (unsigned long long)(i * 2654435761ull + 12345ull) | 1ull;
        h += ((unsigned long long)w.x * 0x9E3779B1ull + (unsigned long long)w.y * 0x85EBCA77ull + (unsigned long long)w.z * 0xC2B2AE3Dull + (unsigned long long)w.w * 0x27D4EB2Full) * m; }
    for (int o = 32; o > 0; o >>= 1) h += __shfl_xor(h, o);
    if ((threadIdx.x & 63) == 0) atomicAdd(outh, h);
}
__global__ void k_poison(float* __restrict__ out, const unsigned long long* __restrict__ hs) {
    float code = 0.f; for (int r = 1; r < 10; ++r) if (hs[r] != hs[0]) code = 1.f;
    if (code == 0.f) return;
    for (size_t i = blockIdx.x * (size_t)blockDim.x + threadIdx.x; i < (size_t)T * DM; i += (size_t)gridDim.x * blockDim.x) out[i] = __builtin_nanf("") * code;
}
#endif
extern "C" void kernel_launch(void* const* d_in, const int* in_sizes, int n_in, void* d_out, int out_size, void* d_ws, size_t ws_size, hipStream_t stream) {
    static int grid = 0;
    if (grid == 0) {
        if (n_in != 21 || in_sizes[0] != T * DM || out_size != T * DM || ws_size < WS_END) { fprintf(stderr, "kernel_launch: unexpected shapes (n_in %d, x %d, out %d, ws %zu)\n", n_in, n_in > 0 ? in_sizes[0] : -1, out_size, ws_size); grid = -1; return; }
        int dev = 0, cus = 0;
        if (hipGetDevice(&dev) != hipSuccess || hipDeviceGetAttribute(&cus, hipDeviceAttributeMultiprocessorCount, dev) != hipSuccess) { fprintf(stderr, "kernel_launch: device query failed\n"); grid = -1; return; }
        int per_cu = 0;
        if (hipOccupancyMaxActiveBlocksPerMultiprocessor(&per_cu, (const void*)mk_fwd, NTHREADS, 0) != hipSuccess || per_cu < 1) fprintf(stderr, "kernel_launch: note: occupancy query reports %d blocks per CU\n", per_cu);
        (void)hipGetLastError();
        grid = cus;
    }
    if (grid < 0) return;
    const float* x = (const float*)d_in[0]; const int* positions = (const int*)d_in[1]; const float* w_in = (const float*)d_in[2]; const float* gate_bias = (const float*)d_in[3];
    const float* lam_vecs = (const float*)d_in[4]; const float* subln_gain = (const float*)d_in[5]; const float* w_pool = (const float*)d_in[6]; const float* pool_scale = (const float*)d_in[7];
    const float* w_branch_a = (const float*)d_in[8]; const float* w_branch_b = (const float*)d_in[9]; const float* w_out = (const float*)d_in[10]; const float* ln1_g = (const float*)d_in[11];
    const float* ln1_b = (const float*)d_in[12]; const float* wrg = (const float*)d_in[13]; const float* brg = (const float*)d_in[14]; const float* wre = (const float*)d_in[15];
    const float* bre = (const float*)d_in[16]; const float* wgu = (const float*)d_in[17]; const float* wdn = (const float*)d_in[18]; const float* ln2_g = (const float*)d_in[19]; const float* ln2_b = (const float*)d_in[20];
    char* ws = (char*)d_ws; float* out = (float*)d_out;
    bf16_t* qb = (bf16_t*)(ws + WS_Q); bf16_t* kb = (bf16_t*)(ws + WS_K); bf16_t* vb = (bf16_t*)(ws + WS_V); bf16_t* ub = (bf16_t*)(ws + WS_U); bf16_t* gb = (bf16_t*)d_out;
    bf16_t* on = (bf16_t*)(ws + WS_ON); bf16_t* mixed = (bf16_t*)(ws + WS_MIXED); bf16_t* merged = (bf16_t*)(ws + WS_MERGED); bf16_t* x1b = (bf16_t*)(ws + WS_X1B);
    bf16_t* hb = (bf16_t*)(ws + WS_H); bf16_t* ybuf = (bf16_t*)(ws + WS_YBUF); float2* rope = (float2*)(ws + WS_ROPE); float* tmp = (float*)(ws + WS_TEMP);
    char* misc = ws + WS_MISC; unsigned* ctl = (unsigned*)(misc + MS_CTL); float2* stats = (float2*)(misc + MS_STATS); int2* rexp = (int2*)(misc + MS_ROUTE); float2* rw = (float2*)(misc + MS_ROUTE + (size_t)T * 8);
    int* list = (int*)(misc + MS_LIST); float* scal = (float*)(misc + MS_SCAL); unsigned* cnt = ctl;

    MKArgs a{}; int nlaunch = 0;
    for (int i = 0; i < 21; ++i) a.in[i] = d_in[i];
    a.out = out; a.ws = (unsigned char*)d_ws;
    if (hipMemsetAsync(ctl, 0, 65536, stream) != hipSuccess) { fprintf(stderr, "kernel_launch: memset failed\n"); return; }
#ifndef MK_REPH
#define MK_REPH 0u
#endif
#define MK(maskv) do { a.mask = (maskv); for (int rr_ = 0; rr_ < (((maskv) & (MK_REPH)) ? 2 : 1); ++rr_) { a.li = (unsigned)(nlaunch++ % 3) | (rr_ ? (1u << 8) : 0u); hipLaunchKernelGGL(mk_fwd, dim3(grid), dim3(NTHREADS), 0, stream, a); } } while (0)
    if (MK_ONE == 1) { MK((1u << PH_N) - 1u); return; }
    if (MK_ONE == 2) {
        MK(0x003u);
        for (int mh = 0; mh < 2; ++mh) { const int m0 = mh * 16384; nattn<<<(16384 / 64) * 16, 64, 0, stream>>>(qb, kb, vb, scal, tmp, m0); post_rms<<<16384 * 8 / 256, 256, 0, stream>>>(tmp, subln_gain, on, m0, 16384); }
        MK(MK_M2A); if (MK_M2B) MK(MK_M2B); if (MK_M2C) MK(MK_M2C); return; }

    constexpr int MC = 16384;
#if 0
#else
#ifdef MK_TEST_BAR
    MK(0x003u);
#else
    if (OPTP(PH_PRO)) MK(1u << PH_PRO); else k_prep<<<T * 32 / 256, 256, 0, stream>>>(positions, lam_vecs, rope, scal, ctl);
    if (OPTP(PH_G1)) MK(1u << PH_G1);
#endif
#endif
#ifndef MK_OVR
#define MK_OVR 0
#endif
    const int ovr = OPTP(PH_G1) ? MK_OVR : 15;
    for (int mh = 0; mh < 2; ++mh) {
        const int m0 = mh * MC; AL_F32 ax{x + (size_t)m0 * DM, DM, 0};
        if (ovr & 1) for (int qk = 0; qk < 2; ++qk) {
            ngemm<AL_F32><<<dim3(16, MC / 64), 256, 0, stream>>>(ax, w_in + qk * 1024, INW, tmp, 1024, MC, 1024, DM);
            post_qk<<<MC * 512 / 256, 256, 0, stream>>>(tmp, rope, qk ? kb : qb, m0, MC, qk ? 1.f : QSCALE);
        }
        if (ovr & 2) { ngemm<AL_F32><<<dim3(16, MC / 64), 256, 0, stream>>>(ax, w_in + 2048, INW, tmp, 1024, MC, 1024, DM);
        post_plain<<<MC * 1024 / 256, 256, 0, stream>>>(tmp, vb, 1024, 0, m0, MC, 1024, nullptr); }
        if (ovr & 4) { ngemm<AL_F32><<<dim3(8, MC / 64), 256, 0, stream>>>(ax, w_in + 3072, INW, tmp, 512, MC, 512, DM);
        post_plain<<<MC * 512 / 256, 256, 0, stream>>>(tmp, ub, 512, 0, m0, MC, 512, nullptr); }
        if (ovr & 8) for (int br = 0; br < 2; ++br) {
            ngemm<AL_F32><<<dim3(16, MC / 64), 256, 0, stream>>>(ax, w_in + 3584 + br * 1024, INW, tmp, 1024, MC, 1024, DM);
            post_gate<<<MC * 1024 / 256, 256, 0, stream>>>(tmp, gate_bias, gb, br * 1024, m0, MC);
        }
    }
    if (OPTP(PH_ATT)) MK(1u << PH_ATT);
    else for (int mh = 0; mh < 2; ++mh) {
        const int m0 = mh * MC;
        nattn<<<(MC / 64) * 16, 64, 0, stream>>>(qb, kb, vb, scal, tmp, m0);
        post_rms<<<MC * 8 / 256, 256, 0, stream>>>(tmp, subln_gain, on, m0, MC);
    }
    if (OPTP(PH_POOLA)) { MK(1u << PH_POOLA); MK(1u << PH_POOLG); }
    else for (int mh = 0; mh < 2; ++mh) {
        const int m0 = mh * MC;
        for (int g = 0; g < 4; ++g) { AL_POOL ap{ub + (size_t)m0 * PW, g, 0};
            ngemm<AL_POOL><<<dim3(2, MC / 64), 256, 0, stream>>>(ap, w_pool + (size_t)g * 128 * 128, 128, tmp + g * 128, 512, MC, 128, 128); }
        post_plain<<<MC * 512 / 256, 256, 0, stream>>>(tmp, mixed, 512, 0, m0, MC, 512, pool_scale);
    }
    if (OPTP(PH_G4A)) MK(1u << PH_G4A);
    else for (int mh = 0; mh < 2; ++mh) {
        const int m0 = mh * MC;
        { AL_BF16 al{on + (size_t)m0 * 1024, 1024, 0}; ngemm<AL_BF16><<<dim3(16, MC / 64), 256, 0, stream>>>(al, w_branch_a, 1024, tmp, 1024, MC, 1024, 1024); }
        post_merge<<<MC * 1024 / 256, 256, 0, stream>>>(tmp, gb, merged, 0, m0, MC);
    }
    if (OPTP(PH_G4B)) MK(1u << PH_G4B);
    else for (int mh = 0; mh < 2; ++mh) {
        const int m0 = mh * MC;
        { AL_BF16 al{mixed + (size_t)m0 * 512, 512, 0}; ngemm<AL_BF16><<<dim3(16, MC / 64), 256, 0, stream>>>(al, w_branch_b, 1024, tmp, 1024, MC, 1024, 512); }
        post_merge<<<MC * 1024 / 256, 256, 0, stream>>>(tmp, gb, merged, 1, m0, MC);
    }
    if (OPTP(PH_G5)) MK(1u << PH_G5);
    else for (int mh = 0; mh < 2; ++mh) {
        const int m0 = mh * MC;
        { AL_BF16 al{merged + (size_t)m0 * 1024, 1024, 0}; ngemm<AL_BF16><<<dim3(16, MC / 64), 256, 0, stream>>>(al, w_out, 1024, tmp, 1024, MC, 1024, 1024); }
        post_y<<<MC * 1024 / 256, 256, 0, stream>>>(tmp, x, out, m0, MC);
    }
    if (OPTP(PH_ROUTER)) MK(1u << PH_ROUTER); else k_router<<<T / 4, 256, 0, stream>>>(out, ln1_g, ln1_b, wrg, brg, wre, bre, x1b, stats, rexp, rw, list, cnt);
    if (OPTP(PH_G7)) MK(1u << PH_G7); else nmoe_gu<<<dim3(8, T / 64, NE), 256, 0, stream>>>(x1b, list, cnt, wgu, hb);
    if (OPTP(PH_G8)) MK(1u << PH_G8); else nmoe_dn<<<dim3(16, T / 64, NE), 256, 0, stream>>>(hb, list, cnt, rw, wdn, ybuf);
    if (OPTP(PH_FINAL)) MK(1u << PH_FINAL); else k_final<<<T / 4, 256, 0, stream>>>(out, stats, ln1_g, ln1_b, ybuf, ln2_g, ln2_b);
#undef MK
}
```

```cpp
#include <hip/hip_runtime.h>
#include <cstdio>
#include <cstdint>
#include <cmath>

typedef unsigned short bf16_t;
typedef float f32x4 __attribute__((ext_vector_type(4)));

constexpr int NB = 16, SEQ = 2048, DM = 1024, T = NB * SEQ;
constexpr int NHEAD = 8, HD = 64, NHM = 16;
constexpr int INW = 5632;
constexpr int PW = 512, PG = 4, PGD = 128;
constexpr int NE = 32, NGRP = 4, EPG = 8, FF = 512;
constexpr float LN_EPS = 1e-5f, RMS_EPS = 1e-5f;
constexpr float ALPHA = 1.189207115002721f;
constexpr float LAMBDA_INIT = 0.2f;
constexpr float QSCALE = 0.125f * 1.4426950408889634f;

constexpr size_t MiB = 1u << 20;
constexpr size_t WS_WT    = 0;
constexpr size_t WS_XB    = 112 * MiB;
constexpr size_t WS_ON    = 112 * MiB;
constexpr size_t WS_YBUF  = 112 * MiB;
constexpr size_t WS_Q     = 176 * MiB;
constexpr size_t WS_MERGED= 176 * MiB;
constexpr size_t WS_K     = 240 * MiB;
constexpr size_t WS_X1B   = 240 * MiB;
constexpr size_t WS_V     = 304 * MiB;
constexpr size_t WS_H     = 304 * MiB;
constexpr size_t WS_U     = 368 * MiB;
constexpr size_t WS_MIXED = 400 * MiB;
constexpr size_t WS_ROPE  = 432 * MiB;
constexpr size_t WS_MISC  = 440 * MiB;
constexpr size_t WS_TEMP  = 448 * MiB;
constexpr size_t WS_END   = 512 * MiB;
constexpr size_t MS_CTL   = 0;
constexpr size_t MS_STATS = 64 * 1024;
constexpr size_t MS_ROUTE = 512 * 1024;
constexpr size_t MS_LIST  = 1 * MiB;
constexpr size_t MS_SCAL  = 6 * MiB;

__device__ __forceinline__ float bf2f(bf16_t v) { return __uint_as_float((unsigned)v << 16); }
__device__ __forceinline__ bf16_t f2bf(float f) { unsigned u = __float_as_uint(f); return (bf16_t)((u + 0x7fffu + ((u >> 16) & 1u)) >> 16); }
__host__ __device__ __forceinline__ int qk_pos_of_d(int d) { return ((d >> 4) & 1) * 32 + ((d >> 2) & 3) * 8 + (d >> 5) * 4 + (d & 3); }

struct AL_F32  { const float* p; int ld; int pad;  __device__ __forceinline__ float operator()(int r, int k) const { return p[(size_t)r * ld + k]; } };
struct AL_BF16 { const bf16_t* p; int ld; int pad; __device__ __forceinline__ float operator()(int r, int k) const { return bf2f(p[(size_t)r * ld + k]); } };
struct AL_POOL { const bf16_t* u; int g; int pad;
    __device__ __forceinline__ float operator()(int r, int k) const {
        const int w = 2 << g, s = r & (SEQ - 1); const int n = (s + 1 < w) ? s + 1 : w; float acc = 0.f;
        for (int i = 0; i < n; ++i) acc += bf2f(u[(size_t)(r - i) * PW + g * PGD + k]);
        return acc / (float)n - bf2f(u[(size_t)r * PW + g * PGD + k]); } };

template <class AL>
__global__ __launch_bounds__(256) void ngemm(AL al, const float* __restrict__ Bm, int ldb, float* __restrict__ C, int ldc, int M, int N, int K) {
    __shared__ float As[16][68]; __shared__ float Bs[16][68];
    const int tid = threadIdx.x, tx = tid & 15, ty = tid >> 4; const int m0 = blockIdx.y * 64, n0 = blockIdx.x * 64;
    float acc[4][4] = {};
    for (int k0 = 0; k0 < K; k0 += 16) {
#pragma unroll
        for (int i = 0; i < 4; ++i) { const int e = tid + i * 256; const int r = e >> 4, kk = e & 15; As[kk][r] = (m0 + r < M) ? al(m0 + r, k0 + kk) : 0.f; }
#pragma unroll
        for (int i = 0; i < 4; ++i) { const int e = tid + i * 256; const int kk = e >> 6, c = e & 63; Bs[kk][c] = (n0 + c < N) ? Bm[(size_t)(k0 + kk) * ldb + n0 + c] : 0.f; }
        __syncthreads();
#pragma unroll
        for (int kk = 0; kk < 16; ++kk) { float a[4], b[4];
#pragma unroll
            for (int i = 0; i < 4; ++i) { a[i] = As[kk][ty * 4 + i]; b[i] = Bs[kk][tx * 4 + i]; }
#pragma unroll
            for (int i = 0; i < 4; ++i)
#pragma unroll
                for (int j = 0; j < 4; ++j) acc[i][j] = fmaf(a[i], b[j], acc[i][j]); }
        __syncthreads();
    }
#pragma unroll
    for (int i = 0; i < 4; ++i)
#pragma unroll
        for (int j = 0; j < 4; ++j) { const int r = m0 + ty * 4 + i, c = n0 + tx * 4 + j; if (r < M && c < N) C[(size_t)r * ldc + c] = acc[i][j]; }
}

__global__ void k_prep(const int* __restrict__ positions, const float* __restrict__ lam_vecs, float2* __restrict__ rope, float* __restrict__ scal, unsigned* __restrict__ ctl) {
    const int gid = blockIdx.x * blockDim.x + threadIdx.x;
    if (gid < T * 32) { const int t = gid >> 5, i = gid & 31;
        const float inv = powf(10000.0f, -(float)i * (2.0f / 64.0f)); const float ang = (float)positions[t] * inv;
        const double a = (double)ang; rope[gid] = make_float2((float)cos(a), (float)sin(a)); }
    if (gid < 16384) ctl[gid] = 0u;
    if (gid == 0) { float s01 = 0.f, s23 = 0.f; for (int i = 0; i < 64; ++i) { s01 += lam_vecs[i] * lam_vecs[64 + i]; s23 += lam_vecs[128 + i] * lam_vecs[192 + i]; }
        scal[0] = expf(s01) - expf(s23) + LAMBDA_INIT; }
}
__global__ void post_qk(const float* __restrict__ tmp, const float2* __restrict__ rope, bf16_t* __restrict__ out, int m0, int Mc, float scale) {
    const int gid = blockIdx.x * blockDim.x + threadIdx.x; if (gid >= Mc * 512) return;
    const int r = gid >> 9, p = gid & 511, hm = p >> 5, i = p & 31; const int t = m0 + r;
    const float t1 = tmp[(size_t)r * 1024 + hm * 64 + i], t2 = tmp[(size_t)r * 1024 + hm * 64 + i + 32]; const float2 cs = rope[t * 32 + i];
    out[(size_t)t * 1024 + hm * 64 + qk_pos_of_d(i)] = f2bf((t1 * cs.x - t2 * cs.y) * scale);
    out[(size_t)t * 1024 + hm * 64 + qk_pos_of_d(i + 32)] = f2bf((t2 * cs.x + t1 * cs.y) * scale);
}
__global__ void post_plain(const float* __restrict__ tmp, bf16_t* __restrict__ out, int ldo, int coloff, int m0, int Mc, int N, const float* __restrict__ colscale) {
    const int gid = blockIdx.x * blockDim.x + threadIdx.x; if (gid >= Mc * N) return;
    const int r = gid / N, c = gid % N; float v = tmp[(size_t)r * N + c]; if (colscale) v *= colscale[c];
    out[(size_t)(m0 + r) * ldo + coloff + c] = f2bf(v);
}
__global__ void post_gate(const float* __restrict__ tmp, const float* __restrict__ bias, bf16_t* __restrict__ gates, int coloff, int m0, int Mc) {
    const int gid = blockIdx.x * blockDim.x + threadIdx.x; if (gid >= Mc * 1024) return;
    const int r = gid >> 10, c = gid & 1023; const float v = tmp[(size_t)r * 1024 + c] + bias[coloff + c];
    gates[(size_t)(m0 + r) * 2048 + coloff + c] = f2bf(1.f / (1.f + expf(-v)));
}
__global__ __launch_bounds__(64) void nattn(const bf16_t* __restrict__ q, const bf16_t* __restrict__ k, const bf16_t* __restrict__ v, const float* __restrict__ scal, float* __restrict__ tmp, int m0) {
    const int lane = threadIdx.x; const int blk = blockIdx.x;
    const int half = blk & 1, head = (blk >> 1) & 7, cg = blk >> 4; const int t0 = m0 + cg * 64, t = t0 + lane; const int b = t0 / SEQ, s0 = t0 % SEQ; const int nkeys = ((s0 >> 6) + 1) * 64;
    const float lam = scal[0];
    float res[64];
    for (int mp = 0; mp < 2; ++mp) {
        const int hm = head * 2 + mp; float qv[64];
#pragma unroll
        for (int d = 0; d < 64; ++d) qv[d] = bf2f(q[(size_t)t * 1024 + hm * 64 + d]);
        float mx = -1e30f, l = 0.f; float o[64];
#pragma unroll
        for (int d = 0; d < 64; ++d) o[d] = 0.f;
        for (int j = 0; j < nkeys; ++j) { const size_t kr = (size_t)(b * SEQ + j) * 1024; float sc = 0.f;
            const uint4* kp = (const uint4*)(k + kr + hm * 64); const uint4* vp = (const uint4*)(v + kr + head * 128 + half * 64);
#pragma unroll
            for (int c = 0; c < 8; ++c) { const uint4 w = kp[c]; const unsigned ww[4] = {w.x, w.y, w.z, w.w};
#pragma unroll
                for (int e = 0; e < 4; ++e) { sc = fmaf(qv[c * 8 + 2 * e], __uint_as_float(ww[e] << 16), sc); sc = fmaf(qv[c * 8 + 2 * e + 1], __uint_as_float(ww[e] & 0xffff0000u), sc); } }
            const float mn = fmaxf(mx, sc), al = exp2f(mx - mn), p = exp2f(sc - mn); mx = mn; l = l * al + p;
#pragma unroll
            for (int c = 0; c < 8; ++c) { const uint4 w = vp[c]; const unsigned ww[4] = {w.x, w.y, w.z, w.w};
#pragma unroll
                for (int e = 0; e < 4; ++e) { o[c * 8 + 2 * e] = fmaf(p, __uint_as_float(ww[e] << 16), o[c * 8 + 2 * e] * al); o[c * 8 + 2 * e + 1] = fmaf(p, __uint_as_float(ww[e] & 0xffff0000u), o[c * 8 + 2 * e + 1] * al); } } }
        const float il = 1.f / l;
#pragma unroll
        for (int d = 0; d < 64; ++d) res[d] = (mp == 0) ? o[d] * il : res[d] - lam * o[d] * il;
    }
#pragma unroll
    for (int d = 0; d < 64; ++d) tmp[(size_t)(t - m0) * 1024 + head * 128 + half * 64 + d] = res[d];
}
__global__ void post_rms(const float* __restrict__ tmp, const float* __restrict__ gain, bf16_t* __restrict__ on, int m0, int Mc) {
    const int gid = blockIdx.x * blockDim.x + threadIdx.x; if (gid >= Mc * 8) return;
    const int r = gid >> 3, head = gid & 7; const float* p = tmp + (size_t)r * 1024 + head * 128; float ss = 0.f;
    for (int d = 0; d < 128; ++d) ss += p[d] * p[d];
    const float rs = 1.0f / sqrtf(ss * (1.f / 128.f) + RMS_EPS);
    for (int d = 0; d < 128; ++d) on[(size_t)(m0 + r) * 1024 + head * 128 + d] = f2bf(p[d] * rs * gain[d] * (1.f - LAMBDA_INIT));
}
__global__ void post_merge(const float* __restrict__ tmp, const bf16_t* __restrict__ gates, bf16_t* __restrict__ merged, int br, int m0, int Mc) {
    const int gid = blockIdx.x * blockDim.x + threadIdx.x; if (gid >= Mc * 1024) return;
    const int r = gid >> 10, c = gid & 1023; const size_t t = m0 + r; const float g = bf2f(gates[t * 2048 + br * 1024 + c]);
    float val = g * tmp[(size_t)r * 1024 + c]; if (br) val += bf2f(merged[t * 1024 + c]);
    merged[t * 1024 + c] = f2bf(val);
}
__global__ void post_y(const float* __restrict__ tmp, const float* __restrict__ x, float* __restrict__ y, int m0, int Mc) {
    const int gid = blockIdx.x * blockDim.x + threadIdx.x; if (gid >= Mc * 1024) return;
    const size_t o = (size_t)m0 * 1024 + gid; y[o] = ALPHA * x[o] + tmp[gid];
}
__device__ __forceinline__ float wave_sum(float v) {
#pragma unroll
    for (int o = 1; o < 64; o <<= 1) v += __shfl_xor(v, o);
    return v;
}
__global__ __launch_bounds__(256) void k_router(const float* __restrict__ y, const float* __restrict__ g1, const float* __restrict__ b1, const float* __restrict__ wrg, const float* __restrict__ brg,
                                                const float* __restrict__ wre, const float* __restrict__ bre, bf16_t* __restrict__ x1b, float2* __restrict__ stats, int2* __restrict__ rexp, float2* __restrict__ rw,
                                                int* __restrict__ list, unsigned* __restrict__ cnt) {
    const int lane = threadIdx.x & 63; const int t = blockIdx.x * 4 + (threadIdx.x >> 6);
    const float* yr = y + (size_t)t * 1024; float xv[16]; float s = 0.f;
#pragma unroll
    for (int j = 0; j < 4; ++j) { const f32x4 vv = *(const f32x4*)(yr + j * 256 + lane * 4); xv[4 * j] = vv.x; xv[4 * j + 1] = vv.y; xv[4 * j + 2] = vv.z; xv[4 * j + 3] = vv.w; s += (vv.x + vv.y) + (vv.z + vv.w); }
    const float mu = wave_sum(s) * (1.f / 1024.f); float s2 = 0.f;
#pragma unroll
    for (int i = 0; i < 16; ++i) { const float d = xv[i] - mu; s2 += d * d; }
    const float rstd = 1.0f / sqrtf(wave_sum(s2) * (1.f / 1024.f) + LN_EPS);
    if (lane == 0) stats[t] = make_float2(mu, rstd);
#pragma unroll
    for (int j = 0; j < 4; ++j)
#pragma unroll
        for (int i = 0; i < 4; ++i) { const int c = j * 256 + lane * 4 + i; xv[4 * j + i] = (xv[4 * j + i] - mu) * rstd * g1[c] + b1[c]; }
#pragma unroll
    for (int j = 0; j < 4; ++j) { uint2 w; w.x = (unsigned)f2bf(xv[4 * j]) | ((unsigned)f2bf(xv[4 * j + 1]) << 16); w.y = (unsigned)f2bf(xv[4 * j + 2]) | ((unsigned)f2bf(xv[4 * j + 3]) << 16);
        *(uint2*)(x1b + (size_t)t * 1024 + j * 256 + lane * 4) = w; }
    float lg[4], le[32];
#pragma unroll
    for (int o = 0; o < 4; ++o) { float a = 0.f;
#pragma unroll
        for (int j = 0; j < 4; ++j)
#pragma unroll
            for (int i = 0; i < 4; ++i) a = fmaf(xv[4 * j + i], wrg[(size_t)(j * 256 + lane * 4 + i) * 4 + o], a);
        lg[o] = wave_sum(a) + brg[o]; }
#pragma unroll
    for (int o = 0; o < 32; ++o) { float a = 0.f;
#pragma unroll
        for (int j = 0; j < 4; ++j)
#pragma unroll
            for (int i = 0; i < 4; ++i) a = fmaf(xv[4 * j + i], wre[(size_t)(j * 256 + lane * 4 + i) * 32 + o], a);
        le[o] = wave_sum(a) + bre[o]; }
    if (lane == 0) {
        int gi = 0; float gm = lg[0];
#pragma unroll
        for (int o = 1; o < 4; ++o) if (lg[o] > gm) { gm = lg[o]; gi = o; }
        float gs = 0.f;
#pragma unroll
        for (int o = 0; o < 4; ++o) gs += expf(lg[o] - gm);
        const float gp = 1.f / gs;
        float ev[8];
#pragma unroll
        for (int o = 0; o < 8; ++o) { float vsel = le[o];
#pragma unroll
            for (int g = 1; g < 4; ++g) vsel = (gi == g) ? le[g * 8 + o] : vsel;
            ev[o] = vsel; }
        int i0 = 0; float m0v = ev[0];
#pragma unroll
        for (int o = 1; o < 8; ++o) if (ev[o] > m0v) { m0v = ev[o]; i0 = o; }
        int i1 = (i0 == 0) ? 1 : 0; float m1v = -3.4e38f;
#pragma unroll
        for (int o = 0; o < 8; ++o) if (o != i0 && ev[o] > m1v) { m1v = ev[o]; i1 = o; }
        const float e1 = expf(m1v - m0v); const float w0 = gp / (1.f + e1), w1 = gp * e1 / (1.f + e1);
        const int ex0 = gi * 8 + i0, ex1 = gi * 8 + i1;
        rexp[t] = make_int2(ex0, ex1); rw[t] = make_float2(w0, w1);
        const unsigned p0 = atomicAdd(&cnt[ex0], 1u); list[(size_t)ex0 * T + p0] = t * 2;
        const unsigned p1 = atomicAdd(&cnt[ex1], 1u); list[(size_t)ex1 * T + p1] = t * 2 + 1;
    }
}
__global__ __launch_bounds__(256) void nmoe_gu(const bf16_t* __restrict__ x1b, const int* __restrict__ list, const unsigned* __restrict__ cnt, const float* __restrict__ wgu, bf16_t* __restrict__ h) {
    __shared__ float As[16][68]; __shared__ float Bg[16][68]; __shared__ float Bu[16][68]; __shared__ int toks[64];
    const int e = blockIdx.z; const int M = (int)cnt[e]; const int m0 = blockIdx.y * 64, n0 = blockIdx.x * 64; if (m0 >= M) return;
    int tb = 0; for (int i = 0; i < e; ++i) tb += ((int)cnt[i] + 255) >> 8;
    const int tid = threadIdx.x, tx = tid & 15, ty = tid >> 4;
    if (tid < 64) toks[tid] = (m0 + tid < M) ? (list[(size_t)e * T + m0 + tid] >> 1) : 0;
    __syncthreads();
    const float* W = wgu + (size_t)e * 1024 * 1024; float ag[4][4] = {}, au[4][4] = {};
    for (int k0 = 0; k0 < 1024; k0 += 16) {
#pragma unroll
        for (int i = 0; i < 4; ++i) { const int el = tid + i * 256; const int r = el >> 4, kk = el & 15; As[kk][r] = bf2f(x1b[(size_t)toks[r] * 1024 + k0 + kk]); }
#pragma unroll
        for (int i = 0; i < 4; ++i) { const int el = tid + i * 256; const int kk = el >> 6, c = el & 63; Bg[kk][c] = W[(size_t)(k0 + kk) * 1024 + n0 + c]; Bu[kk][c] = W[(size_t)(k0 + kk) * 1024 + 512 + n0 + c]; }
        __syncthreads();
#pragma unroll
        for (int kk = 0; kk < 16; ++kk) { float a[4], bg[4], bu[4];
#pragma unroll
            for (int i = 0; i < 4; ++i) { a[i] = As[kk][ty * 4 + i]; bg[i] = Bg[kk][tx * 4 + i]; bu[i] = Bu[kk][tx * 4 + i]; }
#pragma unroll
            for (int i = 0; i < 4; ++i)
#pragma unroll
                for (int j = 0; j < 4; ++j) { ag[i][j] = fmaf(a[i], bg[j], ag[i][j]); au[i][j] = fmaf(a[i], bu[j], au[i][j]); } }
        __syncthreads();
    }
#pragma unroll
    for (int i = 0; i < 4; ++i)
#pragma unroll
        for (int j = 0; j < 4; ++j) { const int r = m0 + ty * 4 + i, c = n0 + tx * 4 + j; if (r < M) { const float g = ag[i][j]; h[((size_t)tb * 256 + r) * 512 + c] = f2bf(g / (1.f + expf(-g)) * au[i][j]); } }
}
__global__ __launch_bounds__(256) void nmoe_dn(const bf16_t* __restrict__ h, const int* __restrict__ list, const unsigned* __restrict__ cnt, const float2* __restrict__ rw, const float* __restrict__ wdn, bf16_t* __restrict__ ybuf) {
    __shared__ float As[16][68]; __shared__ float Bs[16][68];
    const int e = blockIdx.z; const int M = (int)cnt[e]; const int m0 = blockIdx.y * 64, n0 = blockIdx.x * 64; if (m0 >= M) return;
    int tb = 0; for (int i = 0; i < e; ++i) tb += ((int)cnt[i] + 255) >> 8;
    const int tid = threadIdx.x, tx = tid & 15, ty = tid >> 4;
    const float* W = wdn + (size_t)e * 512 * 1024; float acc[4][4] = {};
    for (int k0 = 0; k0 < 512; k0 += 16) {
#pragma unroll
        for (int i = 0; i < 4; ++i) { const int el = tid + i * 256; const int r = el >> 4, kk = el & 15; As[kk][r] = (m0 + r < M) ? bf2f(h[((size_t)tb * 256 + m0 + r) * 512 + k0 + kk]) : 0.f; }
#pragma unroll
        for (int i = 0; i < 4; ++i) { const int el = tid + i * 256; const int kk = el >> 6, c = el & 63; Bs[kk][c] = W[(size_t)(k0 + kk) * 1024 + n0 + c]; }
        __syncthreads();
#pragma unroll
        for (int kk = 0; kk < 16; ++kk) { float a[4], b[4];
#pragma unroll
            for (int i = 0; i < 4; ++i) { a[i] = As[kk][ty * 4 + i]; b[i] = Bs[kk][tx * 4 + i]; }
#pragma unroll
            for (int i = 0; i < 4; ++i)
#pragma unroll
                for (int j = 0; j < 4; ++j) acc[i][j] = fmaf(a[i], b[j], acc[i][j]); }
        __syncthreads();
    }
#pragma unroll
    for (int i = 0; i < 4; ++i) { const int r = m0 + ty * 4 + i; if (r < M) { const int ent = list[(size_t)e * T + r]; const float2 w2 = rw[ent >> 1]; const float w = (ent & 1) ? w2.y : w2.x;
#pragma unroll
        for (int j = 0; j < 4; ++j) ybuf[(size_t)ent * 1024 + n0 + tx * 4 + j] = f2bf(w * acc[i][j]); } }
}
__global__ __launch_bounds__(256) void k_final(float* __restrict__ yout, const float2* __restrict__ stats, const float* __restrict__ g1, const float* __restrict__ b1, const bf16_t* __restrict__ ybuf,
                                               const float* __restrict__ g2, const float* __restrict__ b2) {
    const int lane = threadIdx.x & 63; const int t = blockIdx.x * 4 + (threadIdx.x >> 6);
    float* yr = yout + (size_t)t * 1024; const float2 st = stats[t]; float xv[16]; float s = 0.f;
#pragma unroll
    for (int j = 0; j < 4; ++j) { const int c0 = j * 256 + lane * 4; const f32x4 vv = *(const f32x4*)(yr + c0); const f32x4 gg = *(const f32x4*)(g1 + c0); const f32x4 bb = *(const f32x4*)(b1 + c0);
        const uint2 a = *(const uint2*)(ybuf + (size_t)(2 * t) * 1024 + c0); const uint2 b = *(const uint2*)(ybuf + (size_t)(2 * t + 1) * 1024 + c0);
        const float ya[4] = {__uint_as_float(a.x << 16), __uint_as_float(a.x & 0xffff0000u), __uint_as_float(a.y << 16), __uint_as_float(a.y & 0xffff0000u)};
        const float yb[4] = {__uint_as_float(b.x << 16), __uint_as_float(b.x & 0xffff0000u), __uint_as_float(b.y << 16), __uint_as_float(b.y & 0xffff0000u)};
#pragma unroll
        for (int i = 0; i < 4; ++i) { const float x1 = (vv[i] - st.x) * st.y * gg[i] + bb[i]; const float val = ALPHA * x1 + (ya[i] + yb[i]); xv[4 * j + i] = val; s += val; } }
    const float mu = wave_sum(s) * (1.f / 1024.f); float s2 = 0.f;
#pragma unroll
    for (int i = 0; i < 16; ++i) { const float d = xv[i] - mu; s2 += d * d; }
    const float rstd = 1.0f / sqrtf(wave_sum(s2) * (1.f / 1024.f) + LN_EPS);
#pragma unroll
    for (int j = 0; j < 4; ++j) { const int c0 = j * 256 + lane * 4; const f32x4 gg = *(const f32x4*)(g2 + c0); const f32x4 bb = *(const f32x4*)(b2 + c0); f32x4 o;
#pragma unroll
        for (int i = 0; i < 4; ++i) o[i] = (xv[4 * j + i] - mu) * rstd * gg[i] + bb[i];
        *(f32x4*)(yr + c0) = o; }
}

#define LAS __attribute__((address_space(3)))
#define GAS __attribute__((address_space(1)))
typedef short bf16x8 __attribute__((ext_vector_type(8)));
typedef unsigned u32x4 __attribute__((ext_vector_type(4)));
typedef unsigned u32x2 __attribute__((ext_vector_type(2)));
typedef GAS unsigned gu32;
#define RLX_AGENT __ATOMIC_RELAXED, __HIP_MEMORY_SCOPE_AGENT
#define LDS_WAIT() asm volatile("s_waitcnt lgkmcnt(0)" ::: "memory")
#define VM_WAIT() asm volatile("s_waitcnt vmcnt(0)" ::: "memory")

constexpr size_t WT_IN = 0;
constexpr size_t WT_A  = WT_IN + (size_t)INW * 1024;
constexpr size_t WT_B  = WT_A + 1024 * 1024;
constexpr size_t WT_O  = WT_B + 1024 * 512;
constexpr size_t WT_GU = WT_O + 1024 * 1024;
constexpr size_t WT_DN = WT_GU + (size_t)NE * 1024 * 1024;
constexpr size_t WT_END = WT_DN + (size_t)NE * 1024 * 512;
static_assert(WT_END * 2 <= 112 * MiB, "weight copies fit");
constexpr size_t MS_WPOOL = 7 * MiB;
constexpr size_t MS_WP = 7 * MiB + 512 * 1024;
constexpr size_t MS_CSBW = 6 * MiB + 1024;
constexpr size_t WS_POOLED = 448 * MiB;

constexpr int CW_CNT = 0;
constexpr int CW_BAR = 1024;
constexpr int CW_TDONE = 12288;

constexpr int NWAVES = 8, NTHREADS = 512;
constexpr int RING_BYTES = 131072, LDS_CTL_OFF = 147456, MISC_OFF = LDS_CTL_OFF + 320, LDS_BYTES = 163840;

typedef float f32x2_t __attribute__((ext_vector_type(2))); typedef __bf16 bf16x2_t __attribute__((ext_vector_type(2)));
__device__ __forceinline__ unsigned cvt_pk_bf16(float lo, float hi) { f32x2_t v = {lo, hi}; bf16x2_t b = __builtin_convertvector(v, bf16x2_t); return __builtin_bit_cast(unsigned, b); }
__device__ __forceinline__ float bflo(unsigned w) { return __uint_as_float(w << 16); }
__device__ __forceinline__ float bfhi(unsigned w) { return __uint_as_float(w & 0xffff0000u); }

#define XB_TMO      128
#define XB_XCNT(j)  (256  + 64 * (j))
#define XB_XSUB(j)  (1280 + 64 * (j))
#define XB_XGEN(j)  (2304 + 64 * (j))
#define XB_TOP      3328
#define XB_TOPGEN   3392
#define XCD_BAR_WORDS 3456
#define XB_SPIN_CAP (1u << 22)
__device__ __forceinline__ unsigned xb_ld(unsigned* p)              { return __hip_atomic_load(p, __ATOMIC_RELAXED, __HIP_MEMORY_SCOPE_AGENT); }
__device__ __forceinline__ unsigned xb_add(unsigned* p, unsigned v) { return __hip_atomic_fetch_add(p, v, __ATOMIC_RELAXED, __HIP_MEMORY_SCOPE_AGENT); }
__device__ __forceinline__ unsigned xb_xcc_id() { return (unsigned)__builtin_amdgcn_s_getreg((3 << 11) | 20) & 0xFu; }
#define XB_SPIN(cond, bar) do { unsigned _sp = 0; while (cond) { __builtin_amdgcn_s_sleep(1); \
    if ((++_sp & 255u) == 0u) { if (xb_ld(&(bar)[XB_TMO])) break; if (_sp > XB_SPIN_CAP) { atomicAdd(&(bar)[XB_TMO], 1u); break; } } } } while (0)
struct XcdBarrier { unsigned* bar; unsigned x; volatile LAS unsigned* st; };
__device__ __forceinline__ XcdBarrier xcd_barrier_post(unsigned* bar, volatile LAS unsigned* st) {
    XcdBarrier b; b.bar = bar; b.x = xb_xcc_id(); b.st = st;
    if (threadIdx.x == 0) (void)xb_add(&bar[XB_XCNT(b.x)], 1u);
    return b;
}
__device__ __forceinline__ void xcd_barrier_complete(unsigned* bar, unsigned x, unsigned& nloc, unsigned& nx) {
    const unsigned G = gridDim.x * gridDim.y * gridDim.z;
    unsigned sum, cnt, mine, sp = 0u;
    for (;;) {
        sum = 0u; cnt = 0u; mine = 0u;
#pragma unroll
        for (unsigned j = 0; j < 16; ++j) { const unsigned c = xb_ld(&bar[XB_XCNT(j)]); sum += c; cnt += (c > 0u) ? 1u : 0u; mine = (j == x) ? c : mine; }
        if (sum == G) break;
        __builtin_amdgcn_s_sleep(1);
        if ((++sp & 255u) == 0u) { if (xb_ld(&bar[XB_TMO])) break; if (sp > XB_SPIN_CAP) { atomicAdd(&bar[XB_TMO], 1u); break; } }
    }
    nloc = mine > 0u ? mine : 1u; nx = cnt > 0u ? cnt : 1u;
}
__device__ __forceinline__ void xcd_barrier(const XcdBarrier& b) {
    asm volatile("s_waitcnt vmcnt(0)" ::: "memory");
    __syncthreads();
    if (threadIdx.x == 0) {
        unsigned* bar = b.bar;
        __builtin_amdgcn_s_waitcnt(0);
        unsigned nloc = b.st[0], nx = b.st[1];
        if (nloc == 0u) { xcd_barrier_complete(bar, b.x, nloc, nx); b.st[0] = nloc; b.st[1] = nx; }
        const unsigned old = xb_add(&bar[XB_XSUB(b.x)], 1u);
        const unsigned gen = old / nloc;
        if (old + 1u == (gen + 1u) * nloc) {
            __builtin_amdgcn_fence(__ATOMIC_RELEASE, "agent");
            asm volatile("s_waitcnt vmcnt(0)" ::: "memory");
            const unsigned og = xb_add(&bar[XB_TOP], 1u);
            const unsigned tg = og / nx;
            if (og + 1u == (tg + 1u) * nx) xb_add(&bar[XB_TOPGEN], 1u);
            else XB_SPIN(xb_ld(&bar[XB_TOPGEN]) == tg, bar);
            __builtin_amdgcn_fence(__ATOMIC_ACQUIRE, "agent");
            xb_add(&bar[XB_XGEN(b.x)], 1u);
            asm volatile("s_waitcnt vmcnt(0)" ::: "memory");
        } else {
            XB_SPIN(xb_ld(&bar[XB_XGEN(b.x)]) == gen, bar);
            __builtin_amdgcn_fence(__ATOMIC_ACQUIRE, "agent");
            asm volatile("s_waitcnt vmcnt(0)" ::: "memory");
        }
    }
    __syncthreads();
}

namespace g8 {
constexpr int BM = 256, BK = 64, HALF = 128, HTB = HALF * BK * 2, NXCD = 8, WGM = 8;
__host__ __device__ __forceinline__ int lds_byte(int r, int c) { const int st = (r >> 4) * 2 + (c >> 5), rr = r & 15, cc = c & 31, ob = rr * 64 + cc * 2; return st * 1024 + (ob ^ (((ob >> 9) & 1) << 5)); }
__host__ __device__ __forceinline__ void stage_rc(int b, int& R, int& C) { const int st = b / 1024, sb = b % 1024, swz = sb ^ (((sb >> 9) & 1) << 5); R = (st >> 1) * 16 + swz / 64; C = (st & 1) * 32 + (swz % 64) / 2; }
__host__ __device__ __forceinline__ int perm32(int rho) { const int n = rho >> 4, i = rho & 15; return 8 * (i >> 2) + 4 * n + (i & 3); }

struct GUnit { const char* A; const char* B; int pm, pn, e, r0; };

struct DenseOrder {
    const char* Abase; const char* Bbase; int nM, nN, nwg, G, c; size_t tstep;
    __device__ void init(const void* A, const void* Bt, int M, int N, int K, int G_, int c_) { Abase = (const char*)A; Bbase = (const char*)Bt; nM = M / BM; nN = N / BM; nwg = nM * nN; G = G_; c = c_; tstep = (size_t)BM * K * 2; }
    __device__ bool next(int i, GUnit& u) const {
        const long L = (long)i * G + c; if (L >= nwg) return false;
        int wgid = (int)L; { const int q = nwg / NXCD, r = nwg % NXCD, xcd = wgid % NXCD, off = wgid / NXCD; wgid = (xcd < r ? xcd * (q + 1) : r * (q + 1) + (xcd - r) * q) + off; }
        const int nig = WGM * nN, gid = wgid / nig, fm = gid * WGM, gsz = (nM - fm) < WGM ? (nM - fm) : WGM;
        u.pm = fm + ((wgid % nig) % gsz); u.pn = (wgid % nig) / gsz; u.e = 0; u.r0 = 0;
        u.A = Abase + (size_t)u.pm * tstep; u.B = Bbase + (size_t)u.pn * tstep; return true;
    }
    __device__ __forceinline__ unsigned rowoff(const GUnit&, int) const { return 0u; }
    __device__ __forceinline__ void a_ready(const GUnit&) const {}
    __device__ __forceinline__ void done(const GUnit&) const {}
};
struct MoeOrder {
    const char* Abase; const char* Bbase; const int* list; const volatile LAS unsigned* tb; const volatile LAS unsigned* cntl; int nwg, G, c; size_t atile, bexp, btile; int gather;
    unsigned* tdone; int mode;
    __device__ bool next(int i, GUnit& u) const {
        const long L = (long)i * G + c; if (L >= nwg) return false;
        int wgid = (int)L; { const int q = nwg / NXCD, r = nwg % NXCD, xcd = wgid % NXCD, off = wgid / NXCD; wgid = (xcd < r ? xcd * (q + 1) : r * (q + 1) + (xcd - r) * q) + off; }
        const int tile = wgid >> 2; u.pn = wgid & 3; u.pm = tile;
        int e = 0; for (int j = 1; j < NE; ++j) e = ((int)tb[j] <= tile) ? j : e;
        e = __builtin_amdgcn_readfirstlane(e); u.e = e; u.r0 = __builtin_amdgcn_readfirstlane((tile - (int)tb[e]) * 256);
        u.A = gather ? Abase : Abase + (size_t)tile * atile; u.B = Bbase + (size_t)e * bexp + (size_t)u.pn * btile; return true;
    }
    __device__ __forceinline__ unsigned rowoff(const GUnit& u, int rr) const {
        const int p = u.r0 + rr; const int tok = (p < (int)cntl[u.e]) ? (list[(size_t)u.e * T + p] >> 1) : 0; return (unsigned)tok * 2048u; }
    __device__ __forceinline__ void done(const GUnit& u) const {
        if (mode == 1) { asm volatile("s_waitcnt vmcnt(0)" ::: "memory"); if ((threadIdx.x & 63) == 0) __hip_atomic_fetch_add(tdone + u.pm, 1u, __ATOMIC_RELAXED, __HIP_MEMORY_SCOPE_AGENT); } }
    __device__ __forceinline__ void a_ready(const GUnit& u) const {
        if (mode == 2) {
            if (threadIdx.x < 64) { unsigned sp = 0;
                while ((unsigned)__builtin_amdgcn_readfirstlane(__hip_atomic_load(tdone + u.pm, __ATOMIC_RELAXED, __HIP_MEMORY_SCOPE_AGENT)) < 32u) { __builtin_amdgcn_s_sleep(2); if (++sp > (1u << 22)) break; }
                __builtin_amdgcn_fence(__ATOMIC_ACQUIRE, "agent"); asm volatile("s_waitcnt vmcnt(0)" ::: "memory"); }
            asm volatile("" ::: "memory"); __builtin_amdgcn_s_barrier(); asm volatile("" ::: "memory"); } }
};

template <class Epi, class Sched, bool ALIGN_EPI, bool GATHER>
__device__ __forceinline__ void gemm_phase(LAS unsigned char* lds, const int K, const Sched& S, const Epi& E) {
    const int tid = threadIdx.x, wid = __builtin_amdgcn_readfirstlane(tid >> 6), lane = tid & 63, wr = wid >> 2, wc = wid & 3, fr = lane & 15, fq = lane >> 4;
    const int nt = K / BK;
    unsigned voffA[2], voffB[2]; int RA[2], CA[2];
#pragma unroll
    for (int i = 0; i < 2; ++i) { int R, C; stage_rc(tid * 16 + i * 8192, R, C); const int Rb = Epi::PERM ? ((R & ~31) + perm32(R & 31)) : R;
        voffA[i] = (unsigned)(R * K + C) * 2u; voffB[i] = (unsigned)(Rb * K + C) * 2u; RA[i] = R; CA[i] = C; }
    const size_t kstep = (size_t)(BK * 2);
    const size_t hstep = (size_t)HALF * K * 2;
    const unsigned ldsw = (unsigned)wid * 1024u;
    const int aoff = lds_byte(wr * 64 + fr, fq * 8), boff = lds_byte(wc * 32 + fr, fq * 8);
#define G8_SA(b, h) (((b) * 2 + (h)) * HTB)
#define G8_SB(b, h) ((4 + (b) * 2 + (h)) * HTB)
#define G8_STAGE(bufoff, gbase, o0, o1) do { \
        __builtin_amdgcn_global_load_lds((const unsigned*)((const char*)(gbase) + (o0)), (LAS unsigned*)(lds + (bufoff) + ldsw), 16, 0, 0); \
        __builtin_amdgcn_global_load_lds((const unsigned*)((const char*)(gbase) + (o1)), (LAS unsigned*)(lds + (bufoff) + ldsw + 8192), 16, 0, 0); } while (0)
#define G8_STAGE_B(bufoff, gbase) G8_STAGE(bufoff, gbase, voffB[0], voffB[1])
#define G8_LDA(dst, b, h) do { _Pragma("unroll") for (int m = 0; m < 4; ++m) _Pragma("unroll") for (int k = 0; k < 2; ++k) dst[m][k] = *(const LAS bf16x8*)(lds + G8_SA(b, h) + aoff + m * 2048 + k * 1024); } while (0)
#define G8_LDB(dst, b, h) do { _Pragma("unroll") for (int n = 0; n < 2; ++n) _Pragma("unroll") for (int k = 0; k < 2; ++k) dst[n][k] = *(const LAS bf16x8*)(lds + G8_SB(b, h) + boff + n * 2048 + k * 1024); } while (0)
#define G8_MMA(ai, bj, At, Bt) do { __builtin_amdgcn_s_setprio(1); _Pragma("unroll") for (int m = 0; m < 4; ++m) _Pragma("unroll") for (int n = 0; n < 2; ++n) _Pragma("unroll") for (int k = 0; k < 2; ++k) \
        acc[ai][bj][m][n] = __builtin_amdgcn_mfma_f32_16x16x32_bf16(Bt[n][k], At[m][k], acc[ai][bj][m][n], 0, 0, 0); __builtin_amdgcn_s_setprio(0); } while (0)
#ifdef G8_DRAIN
#define G8_WAIT_V(n) asm volatile("s_waitcnt vmcnt(0)" ::: "memory")
#else
#define G8_WAIT_V(n) asm volatile("s_waitcnt vmcnt(" #n ")" ::: "memory")
#endif
#define G8_WAIT_L(n) asm volatile("s_waitcnt lgkmcnt(" #n ")" ::: "memory")
#define G8_BAR __builtin_amdgcn_s_barrier()
#define G8_SCHED __builtin_amdgcn_sched_barrier(0)
    GUnit cur, nxt; int ui = 0;
    if (!S.next(0, cur)) return;
    unsigned cao[2][2], nao[2][2];
#pragma unroll
    for (int h = 0; h < 2; ++h)
#pragma unroll
        for (int i = 0; i < 2; ++i) { cao[h][i] = GATHER ? S.rowoff(cur, h * HALF + RA[i]) + (unsigned)CA[i] * 2u : voffA[i] + (unsigned)(h * hstep); nao[h][i] = cao[h][i]; }
    f32x4 acc[2][2][4][2];
#pragma unroll
    for (int a = 0; a < 2; ++a)
#pragma unroll
        for (int b = 0; b < 2; ++b)
#pragma unroll
            for (int m = 0; m < 4; ++m)
#pragma unroll
                for (int n = 0; n < 2; ++n) acc[a][b][m][n] = (f32x4){0.f, 0.f, 0.f, 0.f};
    bf16x8 At[4][2], B0[2][2], B1[2][2];
    const char* cA = cur.A; const char* cB = cur.B;
    S.a_ready(cur);
    G8_STAGE_B(G8_SB(0, 0), cB); G8_STAGE_B(G8_SB(0, 1), cB + hstep); G8_STAGE(G8_SA(0, 0), cA, cao[0][0], cao[0][1]); G8_STAGE(G8_SA(0, 1), cA, cao[1][0], cao[1][1]);
    if (wr == 1) G8_BAR;
    G8_WAIT_V(2); G8_BAR;
    G8_STAGE_B(G8_SB(1, 0), cB + kstep); G8_STAGE(G8_SA(1, 0), cA + kstep, cao[0][0], cao[0][1]); G8_STAGE_B(G8_SB(1, 1), cB + hstep + kstep);
    G8_WAIT_V(6); G8_BAR;
    for (;;) {
        const bool has_next = S.next(ui + 1, nxt);
        if (GATHER && has_next) {
#pragma unroll
            for (int h = 0; h < 2; ++h)
#pragma unroll
                for (int i = 0; i < 2; ++i) nao[h][i] = S.rowoff(nxt, h * HALF + RA[i]) + (unsigned)CA[i] * 2u;
        }
        const char* nA = has_next ? nxt.A : cA; const char* nB = has_next ? nxt.B : cB;
        for (int t = 0; t < nt; t += 2) {
            const bool last = (t == nt - 2);
            if (last && has_next) S.a_ready(nxt);
            const char* a1 = cA + (size_t)(t + 1) * kstep;
            const char* a2 = last ? nA : cA + (size_t)(t + 2) * kstep; const char* b2 = last ? nB : cB + (size_t)(t + 2) * kstep;
            const char* a3 = a2 + kstep; const char* b3 = b2 + kstep;
            asm volatile("" : "+s"(a1), "+s"(a2), "+s"(b2), "+s"(a3), "+s"(b3));
            unsigned o2[2][2];
#pragma unroll
            for (int h = 0; h < 2; ++h)
#pragma unroll
                for (int i = 0; i < 2; ++i) o2[h][i] = (GATHER && last && has_next) ? nao[h][i] : cao[h][i];
            G8_LDB(B0, 0, 0); G8_LDB(B1, 0, 1); G8_SCHED; G8_LDA(At, 0, 0); G8_STAGE(G8_SA(1, 1), a1, cao[1][0], cao[1][1]);
            G8_WAIT_V(8); G8_WAIT_L(0); G8_BAR; G8_MMA(0, 0, At, B0); G8_MMA(0, 1, At, B1); G8_BAR; G8_SCHED;
            G8_LDA(At, 0, 1); G8_STAGE_B(G8_SB(0, 0), b2); G8_STAGE_B(G8_SB(0, 1), b2 + hstep); G8_STAGE(G8_SA(0, 0), a2, o2[0][0], o2[0][1]);
            G8_WAIT_V(8); G8_WAIT_L(0); G8_BAR; G8_MMA(1, 0, At, B0); G8_MMA(1, 1, At, B1); G8_BAR; G8_SCHED;
            G8_LDB(B0, 1, 0); G8_LDB(B1, 1, 1); G8_SCHED; G8_LDA(At, 1, 0); G8_STAGE(G8_SA(0, 1), a2, o2[1][0], o2[1][1]);
            G8_WAIT_V(8); G8_WAIT_L(0); G8_BAR; G8_MMA(0, 0, At, B0); G8_MMA(0, 1, At, B1); G8_BAR; G8_SCHED;
            G8_LDA(At, 1, 1); G8_STAGE_B(G8_SB(1, 0), b3); G8_STAGE_B(G8_SB(1, 1), b3 + hstep); G8_STAGE(G8_SA(1, 0), a3, o2[0][0], o2[0][1]);
            G8_WAIT_V(8); G8_WAIT_L(0); G8_BAR; G8_MMA(1, 0, At, B0); G8_MMA(1, 1, At, B1); G8_BAR; G8_SCHED;
        }
        if constexpr (ALIGN_EPI) { if (wr == 0) G8_BAR; }
        {
          GUnit eu = cur; int fr_ = fr, fq_ = fq; asm volatile("" : "+s"(eu.pm), "+s"(eu.pn), "+s"(eu.e), "+s"(eu.r0)); asm volatile("" : "+v"(fr_), "+v"(fq_));
          E(acc, eu, wr, wc, fr_, fq_); S.done(cur); }
        if (!has_next) break;
#pragma unroll
        for (int a = 0; a < 2; ++a)
#pragma unroll
            for (int b = 0; b < 2; ++b)
#pragma unroll
                for (int m = 0; m < 4; ++m)
#pragma unroll
                    for (int n = 0; n < 2; ++n) acc[a][b][m][n] = (f32x4){0.f, 0.f, 0.f, 0.f};
        cur = nxt; cA = nA; cB = nB; ++ui;
#pragma unroll
        for (int h = 0; h < 2; ++h)
#pragma unroll
            for (int i = 0; i < 2; ++i) cao[h][i] = nao[h][i];
        if constexpr (ALIGN_EPI) { if (wr == 1) G8_BAR; }
    }
    G8_WAIT_V(0);
    if constexpr (!ALIGN_EPI) { if (wr == 0) G8_BAR; }
    G8_BAR;
#undef G8_SA
#undef G8_SB
#undef G8_STAGE
#undef G8_STAGE_B
#undef G8_LDA
#undef G8_LDB
#undef G8_MMA
#undef G8_WAIT_V
#undef G8_WAIT_L
#undef G8_BAR
#undef G8_SCHED
}

__device__ __forceinline__ u32x4 pack8(const f32x4 v0, const f32x4 v1) { u32x4 w; w.x = cvt_pk_bf16(v0[0], v0[1]); w.y = cvt_pk_bf16(v0[2], v0[3]); w.z = cvt_pk_bf16(v1[0], v1[1]); w.w = cvt_pk_bf16(v1[2], v1[3]); return w; }
__device__ __forceinline__ float sigmoidf_(float v) { return __builtin_amdgcn_rcpf(1.f + __builtin_amdgcn_exp2f(-1.4426950408889634f * v)); }

struct EpiProj {
    static constexpr bool PERM = true;
    bf16_t *qb, *kb, *vb, *ub, *gb; const float* rope; const float* gate_bias;
    __device__ __forceinline__ void operator()(const f32x4 (&acc)[2][2][4][2], const GUnit& u, int wr, int wc, int fr, int fq) const {
        const int row0 = u.pm * BM + wr * 64 + fr; const int cw = wc * 32 + 8 * fq; const int pn = u.pn;
#ifdef DBG_PLAIN_EPI
        if (pn < 8) { bf16_t* base = (pn < 4 ? qb : kb) + (pn & 3) * 256 + cw;
            for (int ai = 0; ai < 2; ++ai) for (int m = 0; m < 4; ++m) { const int t = row0 + ai * HALF + m * 16; for (int bj = 0; bj < 2; ++bj) *(u32x4*)(base + (size_t)t * 1024 + bj * HALF) = pack8(acc[ai][bj][m][0], acc[ai][bj][m][1]); } }
        else
#endif
        if (pn < 8) {
            bf16_t* base = (pn < 4 ? qb : kb) + (pn & 3) * 256 + cw; const float sc = pn < 4 ? QSCALE : 1.f; const int fi = 16 * (wc & 1) + 4 * fq;
#pragma unroll
            for (int ai = 0; ai < 2; ++ai)
#pragma unroll
                for (int m = 0; m < 4; ++m) { const int t = row0 + ai * HALF + m * 16; const f32x4 cs0 = *(const f32x4*)(rope + ((size_t)t * 32 + fi) * 2), cs1 = *(const f32x4*)(rope + ((size_t)t * 32 + fi) * 2 + 4);
                    const f32x4 c = {cs0[0], cs0[2], cs1[0], cs1[2]}, s = {cs0[1], cs0[3], cs1[1], cs1[3]};
#pragma unroll
                    for (int bj = 0; bj < 2; ++bj) { const f32x4 t1 = acc[ai][bj][m][0], t2 = acc[ai][bj][m][1]; const f32x4 o1 = (t1 * c - t2 * s) * sc, o2 = (t2 * c + t1 * s) * sc;
                        *(u32x4*)(base + (size_t)t * 1024 + bj * HALF) = pack8(o1, o2); } }
        } else if (pn < 14) {
            bf16_t* base; int ld; if (pn < 12) { base = vb + (pn - 8) * 256 + cw; ld = 1024; } else { base = ub + (pn - 12) * 256 + cw; ld = 512; }
#pragma unroll
            for (int ai = 0; ai < 2; ++ai)
#pragma unroll
                for (int m = 0; m < 4; ++m) { const int t = row0 + ai * HALF + m * 16;
#pragma unroll
                    for (int bj = 0; bj < 2; ++bj) *(u32x4*)(base + (size_t)t * ld + bj * HALF) = pack8(acc[ai][bj][m][0], acc[ai][bj][m][1]); }
        }
#ifdef DBG_PLAIN_EPI
        else { const int col0 = (pn - 14) * 256 + cw;
            for (int ai = 0; ai < 2; ++ai) for (int m = 0; m < 4; ++m) { const int t = row0 + ai * HALF + m * 16; for (int bj = 0; bj < 2; ++bj) *(u32x4*)(gb + (size_t)t * 2048 + col0 + bj * HALF) = pack8(acc[ai][bj][m][0], acc[ai][bj][m][1]); } }
#else
        else {
            const int col0 = (pn - 14) * 256 + cw; f32x4 bv[2][2];
#pragma unroll
            for (int bj = 0; bj < 2; ++bj)
#pragma unroll
                for (int n = 0; n < 2; ++n) bv[bj][n] = *(const f32x4*)(gate_bias + col0 + bj * HALF + 4 * n);
#pragma unroll
            for (int ai = 0; ai < 2; ++ai)
#pragma unroll
                for (int m = 0; m < 4; ++m) { const int t = row0 + ai * HALF + m * 16;
#pragma unroll
                    for (int bj = 0; bj < 2; ++bj) { f32x4 v0 = acc[ai][bj][m][0] + bv[bj][0], v1 = acc[ai][bj][m][1] + bv[bj][1];
#pragma unroll
                        for (int j = 0; j < 4; ++j) { v0[j] = sigmoidf_(v0[j]); v1[j] = sigmoidf_(v1[j]); }
                        *(u32x4*)(gb + (size_t)t * 2048 + col0 + bj * HALF) = pack8(v0, v1); } }
        }
#endif
    }
};
struct EpiScaleBf16 {
    static constexpr bool PERM = true;
    bf16_t* O; int ldc; const float* colscale;
    __device__ __forceinline__ void operator()(const f32x4 (&acc)[2][2][4][2], const GUnit& u, int wr, int wc, int fr, int fq) const {
        const int row0 = u.pm * BM + wr * 64 + fr, col0 = u.pn * BM + wc * 32 + 8 * fq; f32x4 sv[2][2];
#pragma unroll
        for (int bj = 0; bj < 2; ++bj)
#pragma unroll
            for (int n = 0; n < 2; ++n) sv[bj][n] = *(const f32x4*)(colscale + col0 + bj * HALF + 4 * n);
#pragma unroll
        for (int ai = 0; ai < 2; ++ai)
#pragma unroll
            for (int m = 0; m < 4; ++m) { bf16_t* rowp = O + (size_t)(row0 + ai * HALF + m * 16) * ldc + col0;
#pragma unroll
                for (int bj = 0; bj < 2; ++bj) *(u32x4*)(rowp + bj * HALF) = pack8(acc[ai][bj][m][0] * sv[bj][0], acc[ai][bj][m][1] * sv[bj][1]); }
    }
};
template <int BR> struct EpiMerge {
    static constexpr bool PERM = true;
    const bf16_t* gates; bf16_t* merged;
    __device__ __forceinline__ void operator()(const f32x4 (&acc)[2][2][4][2], const GUnit& u, int wr, int wc, int fr, int fq) const {
        const int row0 = u.pm * BM + wr * 64 + fr, col0 = u.pn * BM + wc * 32 + 8 * fq;
#pragma unroll
        for (int ai = 0; ai < 2; ++ai)
#pragma unroll
            for (int m = 0; m < 4; ++m) { const size_t t = row0 + ai * HALF + m * 16;
#pragma unroll
                for (int bj = 0; bj < 2; ++bj) { const u32x4 g = *(const u32x4*)(gates + t * 2048 + BR * 1024 + col0 + bj * HALF); bf16_t* mp = merged + t * 1024 + col0 + bj * HALF;
                    f32x4 v0 = acc[ai][bj][m][0], v1 = acc[ai][bj][m][1];
                    v0 = v0 * (f32x4){bflo(g.x), bfhi(g.x), bflo(g.y), bfhi(g.y)}; v1 = v1 * (f32x4){bflo(g.z), bfhi(g.z), bflo(g.w), bfhi(g.w)};
                    if (BR) { const u32x4 p = *(const u32x4*)mp; v0 = v0 + (f32x4){bflo(p.x), bfhi(p.x), bflo(p.y), bfhi(p.y)}; v1 = v1 + (f32x4){bflo(p.z), bfhi(p.z), bflo(p.w), bfhi(p.w)}; }
                    *(u32x4*)mp = pack8(v0, v1); } }
    }
};
struct EpiResid {
    static constexpr bool PERM = false;
    const float* x; float* y;
    __device__ __forceinline__ void operator()(const f32x4 (&acc)[2][2][4][2], const GUnit& u, int wr, int wc, int fr, int fq) const {
        const int row0 = u.pm * BM + wr * 64 + fr, col0 = u.pn * BM + wc * 32 + 4 * fq;
#pragma unroll
        for (int ai = 0; ai < 2; ++ai)
#pragma unroll
            for (int m = 0; m < 4; ++m) { const size_t off = (size_t)(row0 + ai * HALF + m * 16) * 1024 + col0;
#pragma unroll
                for (int bj = 0; bj < 2; ++bj)
#pragma unroll
                    for (int n = 0; n < 2; ++n) { const f32x4 xv = *(const f32x4*)(x + off + bj * HALF + n * 16); *(f32x4*)(y + off + bj * HALF + n * 16) = xv * ALPHA + acc[ai][bj][m][n]; } }
    }
};
struct EpiGateUp {
    static constexpr bool PERM = true;
    bf16_t* h;
    __device__ __forceinline__ void operator()(const f32x4 (&acc)[2][2][4][2], const GUnit& u, int wr, int wc, int fr, int fq) const {
        const int row0 = u.pm * BM + wr * 64 + fr, col0 = u.pn * 128 + wc * 16 + 4 * fq;
#pragma unroll
        for (int ai = 0; ai < 2; ++ai)
#pragma unroll
            for (int m = 0; m < 4; ++m) { bf16_t* rowp = h + (size_t)(row0 + ai * HALF + m * 16) * 512 + col0;
#pragma unroll
                for (int bj = 0; bj < 2; ++bj) { const f32x4 g = acc[ai][bj][m][0], up = acc[ai][bj][m][1]; f32x4 o;
#pragma unroll
                    for (int j = 0; j < 4; ++j) o[j] = g[j] * sigmoidf_(g[j]) * up[j];
                    const unsigned long long w = (unsigned long long)cvt_pk_bf16(o[0], o[1]) | ((unsigned long long)cvt_pk_bf16(o[2], o[3]) << 32);
                    __hip_atomic_store((unsigned long long*)(rowp + bj * 64), w, __ATOMIC_RELAXED, __HIP_MEMORY_SCOPE_AGENT); } }
    }
};
struct EpiDown {
    static constexpr bool PERM = true;
    bf16_t* ybuf; const int* list; const float* rw; const volatile LAS unsigned* cntl;
    __device__ __forceinline__ void operator()(const f32x4 (&acc)[2][2][4][2], const GUnit& u, int wr, int wc, int fr, int fq) const {
        const int p0 = u.r0 + wr * 64 + fr, col0 = u.pn * BM + wc * 32 + 8 * fq; const int cn = (int)cntl[u.e];
#pragma unroll
        for (int ai = 0; ai < 2; ++ai)
#pragma unroll
            for (int m = 0; m < 4; ++m) { const int p = p0 + ai * HALF + m * 16;
                if (p < cn) { const int ent = list[(size_t)u.e * T + p]; const float w = rw[ent]; bf16_t* rowp = ybuf + (size_t)ent * 1024 + col0;
#pragma unroll
                    for (int bj = 0; bj < 2; ++bj) *(u32x4*)(rowp + bj * HALF) = pack8(acc[ai][bj][m][0] * w, acc[ai][bj][m][1] * w); } }
    }
};
}

namespace at2 {
using f32x16 = __attribute__((ext_vector_type(16))) float;
using s16x4  = __attribute__((ext_vector_type(4))) short;
constexpr int KB_BYTES = 8192, VB_BYTES = 16384, KSLOT = 2 * KB_BYTES, NKS = 4, NVS = 3, OFF_V = NKS * KSLOT;
constexpr int OFF_Q = OFF_V + NVS * VB_BYTES, OFF_WS = 151552;
#define AT_SBAR() __builtin_amdgcn_sched_barrier(0)
__device__ __forceinline__ int crow(int r, int hi) { return (r & 3) + 8 * (r >> 2) + 4 * hi; }
__device__ __forceinline__ int v_st(int k, int c) { const int kk = (k & ~0xC) | ((k & 4) << 1) | ((k & 8) >> 1); return ((kk >> 3) * 4 + (c >> 5)) * 512 + ((kk & 7) * 32 + (c & 31)) * 2; }
__device__ __forceinline__ int v_rd_base(int lane) { return ((lane & 3) << 3) | (((lane >> 2) & 3) << 6) | (((lane >> 4) & 1) << 5) | (((lane >> 5) & 1) << 8); }
constexpr int v_rd_off(int d0, int ks, int half) { return d0 * 512 + ks * 4096 + half * 2048; }
template <int OFF> __device__ __forceinline__ s16x4 tr_read(int vb) { s16x4 r; asm volatile("ds_read_b64_tr_b16 %0, %1 offset:%2" : "=&v"(r) : "v"(vb), "i"(OFF) : "memory"); return r; }
template <int D0> __device__ __forceinline__ void pv_one(f32x16& od, int vb, bf16x8 pa0, bf16x8 pa1, bf16x8 pa2, bf16x8 pa3) {
    const s16x4 l0 = tr_read<v_rd_off(D0, 0, 0)>(vb), h0 = tr_read<v_rd_off(D0, 0, 1)>(vb), l1 = tr_read<v_rd_off(D0, 1, 0)>(vb), h1 = tr_read<v_rd_off(D0, 1, 1)>(vb);
    const s16x4 l2 = tr_read<v_rd_off(D0, 2, 0)>(vb), h2 = tr_read<v_rd_off(D0, 2, 1)>(vb), l3 = tr_read<v_rd_off(D0, 3, 0)>(vb), h3 = tr_read<v_rd_off(D0, 3, 1)>(vb);
    asm volatile("s_waitcnt lgkmcnt(0)" ::: "memory"); AT_SBAR();
#define AT_PK(L, H) (bf16x8){L[0], L[1], L[2], L[3], H[0], H[1], H[2], H[3]}
    od = __builtin_amdgcn_mfma_f32_32x32x16_bf16(pa0, AT_PK(l0, h0), od, 0, 0, 0);
    od = __builtin_amdgcn_mfma_f32_32x32x16_bf16(pa1, AT_PK(l1, h1), od, 0, 0, 0);
    od = __builtin_amdgcn_mfma_f32_32x32x16_bf16(pa2, AT_PK(l2, h2), od, 0, 0, 0);
    od = __builtin_amdgcn_mfma_f32_32x32x16_bf16(pa3, AT_PK(l3, h3), od, 0, 0, 0);
#undef AT_PK
}
__device__ __forceinline__ void qkt(f32x16& p0, f32x16& p1, const LAS unsigned char* Ks, const bf16x8* qr, int r32, int hi) {
    p0 = f32x16{}; p1 = f32x16{};
#pragma unroll
    for (int d0 = 0; d0 < 4; ++d0) { const LAS unsigned char* kp = Ks + (2 * d0 + hi) * 1024 + r32 * 16;
        const bf16x8 b0 = *(const LAS bf16x8*)(kp), b1 = *(const LAS bf16x8*)(kp + 512);
        p0 = __builtin_amdgcn_mfma_f32_32x32x16_bf16(b0, qr[d0], p0, 0, 0, 0);
        p1 = __builtin_amdgcn_mfma_f32_32x32x16_bf16(b1, qr[d0], p1, 0, 0, 0); }
}
__device__ __forceinline__ float hswap_max(float v) { auto rr = __builtin_amdgcn_permlane32_swap(__float_as_uint(v), __float_as_uint(v), false, false); return fmaxf(__uint_as_float(rr[0]), __uint_as_float(rr[1])); }
__device__ __forceinline__ float hswap_sum(float v) { auto rr = __builtin_amdgcn_permlane32_swap(__float_as_uint(v), __float_as_uint(v), false, false); return __uint_as_float(rr[0]) + __uint_as_float(rr[1]); }

template <unsigned var> __device__ __forceinline__ void attn_unit(LAS unsigned char* lds, int b, int head, int qblk, const bf16_t* __restrict__ Q, const bf16_t* __restrict__ K, const bf16_t* __restrict__ V,
                                          bf16_t* __restrict__ O, const float lam, const float* __restrict__ gain) {
    const int tid = threadIdx.x, lane = tid & 63, r32 = lane & 31, hi = lane >> 5; const int wid = __builtin_amdgcn_readfirstlane(tid >> 6); const int mp = wid >> 2, wq = wid & 3;
    const int hm = head * 2 + mp; const size_t rowbase = (size_t)b * SEQ; const int q0 = qblk * 128;
    const int mychunk = 2 * qblk + (wq >> 1); const int NT = 2 * qblk + 2;
    LAS float* wsf = (LAS float*)(lds + OFF_WS) + wid * 64;
    bf16x8 qr[4];
    { const bf16_t* qp = Q + (rowbase + q0 + wq * 32 + r32) * 1024 + hm * 64 + hi * 8;
#pragma unroll
      for (int d0 = 0; d0 < 4; ++d0) qr[d0] = *(const bf16x8*)(qp + d0 * 16); }
    const char* Kb = (const char*)(K + rowbase * 1024); const char* Vb = (const char*)(V + rowbase * 1024);
    unsigned kofs[2], vofs[2];
#pragma unroll
    for (int i = 0; i < 2; ++i) { const int ch = 2 * wq + i; kofs[i] = (unsigned)(lane * 2048 + hm * 128 + ch * 16);
        const int p = 2 * wid + i; const int kk = (p >> 1) * 8 + ((lane & 31) >> 2); const int k = (kk & ~0xC) | ((kk & 4) << 1) | ((kk & 8) >> 1); const int c = (2 * (p & 1) + (lane >> 5)) * 32 + (lane & 3) * 8;
        vofs[i] = (unsigned)(k * 2048 + head * 256 + c * 2); }
    const unsigned kdst = (unsigned)(mp * KB_BYTES + (2 * wq) * 1024), vdst = (unsigned)(OFF_V + (2 * wid) * 1024);
#define AT_DMA_K(j, KO) do { const char* kj_ = Kb + (size_t)(j) * 131072; \
        __builtin_amdgcn_global_load_lds((const unsigned*)(kj_ + kofs[0]), (LAS unsigned*)(lds + (KO) + kdst), 16, 0, 0); __builtin_amdgcn_global_load_lds((const unsigned*)(kj_ + kofs[1]), (LAS unsigned*)(lds + (KO) + kdst + 1024), 16, 0, 0); } while (0)
#define AT_DMA_V(j, VO) do { const char* vj_ = Vb + (size_t)(j) * 131072; \
        __builtin_amdgcn_global_load_lds((const unsigned*)(vj_ + vofs[0]), (LAS unsigned*)(lds + (VO) + vdst), 16, 0, 0); __builtin_amdgcn_global_load_lds((const unsigned*)(vj_ + vofs[1]), (LAS unsigned*)(lds + (VO) + vdst + 1024), 16, 0, 0); } while (0)
    float mhat = 0.f, l_reg = 0.f; f32x16 o[4] = {};
    const int vb0 = (int)(uintptr_t)(lds + OFF_V) + v_rd_base(lane);
    const LAS unsigned char* kb0 = lds + mp * KB_BYTES;
    constexpr float THR = 8.f;
    f32x16 pA0 = {}, pA1 = {}, pB0 = {}, pB1 = {}; float alA = 1.f, alB = 1.f; bool rsA = false, rsB = false;
    int kcur = 0, k1 = KSLOT, k2 = 2 * KSLOT;
    int vprev = 2 * VB_BYTES, vcur = 0, vnext = VB_BYTES;
#define AT_ROT() do { kcur = k1; k1 = k2; k2 = (k2 == (NKS - 1) * KSLOT) ? 0 : k2 + KSLOT; vprev = vcur; vcur = vnext; vnext = (vnext == (NVS - 1) * VB_BYTES) ? 0 : vnext + VB_BYTES; } while (0)
#define AT_QKT(P0, P1, SL) do { const LAS unsigned char* kp_ = kb0 + (SL) + hi * 1024 + r32 * 16; P0 = f32x16{}; P1 = f32x16{}; \
        _Pragma("unroll") for (int d0 = 0; d0 < 4; ++d0) { const bf16x8 b0_ = *(const LAS bf16x8*)(kp_ + d0 * 2048), b1_ = *(const LAS bf16x8*)(kp_ + d0 * 2048 + 512); const bf16x8 q_ = qr[d0]; \
            P0 = __builtin_amdgcn_mfma_f32_32x32x16_bf16(b0_, q_, P0, 0, 0, 0); P1 = __builtin_amdgcn_mfma_f32_32x32x16_bf16(b1_, q_, P1, 0, 0, 0); } } while (0)
#define AT_PSM(P0, P1, AL, RS, FIRST) do { float pm_ = P0[0]; _Pragma("unroll") for (int r = 1; r < 16; ++r) pm_ = fmaxf(pm_, P0[r]); _Pragma("unroll") for (int r = 0; r < 16; ++r) pm_ = fmaxf(pm_, P1[r]); \
        pm_ = hswap_max(pm_) - mhat; RS = (FIRST) || __any(pm_ > THR); AL = 1.f; \
        if (RS) { const float dl_ = (FIRST) ? pm_ : fmaxf(pm_, 0.f); mhat += dl_; AL = __builtin_amdgcn_exp2f(-dl_); } \
        _Pragma("unroll") for (int r = 0; r < 16; ++r) { P0[r] = __builtin_amdgcn_exp2f(P0[r] - mhat); P1[r] = __builtin_amdgcn_exp2f(P1[r] - mhat); } } while (0)
#define AT_PK4(P, BASE, OUT) do { const unsigned a0 = cvt_pk_bf16(P[BASE + 0], P[BASE + 1]), a1 = cvt_pk_bf16(P[BASE + 2], P[BASE + 3]); \
        const unsigned b0 = cvt_pk_bf16(P[BASE + 4], P[BASE + 5]), b1 = cvt_pk_bf16(P[BASE + 6], P[BASE + 7]); \
        auto r0_ = __builtin_amdgcn_permlane32_swap(a0, b0, false, false); auto r1_ = __builtin_amdgcn_permlane32_swap(a1, b1, false, false); \
        u32x4 w_ = {r0_[0], r1_[0], r0_[1], r1_[1]}; OUT = __builtin_bit_cast(bf16x8, w_); } while (0)
#define AT_FIN_PV(P0, P1, AL, SL) do { float ps_ = 0.f; _Pragma("unroll") for (int r = 0; r < 16; ++r) ps_ += P0[r]; _Pragma("unroll") for (int r = 0; r < 16; ++r) ps_ += P1[r]; \
        ps_ = hswap_sum(ps_); l_reg = l_reg * (AL) + ps_; bf16x8 pa0, pa1, pa2, pa3; AT_PK4(P0, 0, pa0); AT_PK4(P0, 8, pa1); AT_PK4(P1, 0, pa2); AT_PK4(P1, 8, pa3); const int vb_ = vb0 + (SL); \
        pv_one<0>(o[0], vb_, pa0, pa1, pa2, pa3); pv_one<1>(o[1], vb_, pa0, pa1, pa2, pa3); pv_one<2>(o[2], vb_, pa0, pa1, pa2, pa3); pv_one<3>(o[3], vb_, pa0, pa1, pa2, pa3); } while (0)
#define AT_RESC(AL, RS) do { if (RS) { if (hi == 0) wsf[r32] = (AL); asm volatile("s_waitcnt lgkmcnt(0)" ::: "memory"); \
        _Pragma("unroll") for (int r = 0; r < 16; ++r) { const float a_ = wsf[crow(r, hi)]; _Pragma("unroll") for (int d = 0; d < 4; ++d) o[d][r] *= a_; } } } while (0)
#define AT_STEP0(u, PC0, PC1, ALC, RSC, PP0, PP1, ALP) do { const bool nk_ = (u) + 2 < NT && !(var & 2u), nv_ = (u) + 1 < NT && !(var & 2u); if (nk_) AT_DMA_K((u) + 2, k2); if (nv_) AT_DMA_V((u) + 1, vnext); \
        const bool aX_ = (u) < NT && (u) <= mychunk, aF_ = (u) >= 1 && (u) - 1 <= mychunk; \
        if (aX_ && !(var & 16u)) AT_QKT(PC0, PC1, kcur); \
        if (aF_ && !(var & 4u)) AT_FIN_PV(PP0, PP1, ALP, vprev); \
        if (aX_ && !(var & 8u)) { AT_PSM(PC0, PC1, ALC, RSC, (u) == 0); AT_RESC(ALC, RSC); } \
        if (nk_) asm volatile("s_waitcnt vmcnt(4)" ::: "memory"); else if (nv_) asm volatile("s_waitcnt vmcnt(2)" ::: "memory"); else asm volatile("s_waitcnt vmcnt(0)" ::: "memory"); \
        __syncthreads(); AT_ROT(); } while (0)
    AT_DMA_K(0, 0); AT_DMA_V(0, 0); if (!(var & 2u) || true) AT_DMA_K(1, KSLOT); asm volatile("s_waitcnt vmcnt(0)" ::: "memory"); __syncthreads();
    for (int u = 0; u < NT + 2; u += 2) { AT_STEP0(u, pA0, pA1, alA, rsA, pB0, pB1, alB); AT_STEP0(u + 1, pB0, pB1, alB, rsB, pA0, pA1, alA); }
#undef AT_DMA_K
#undef AT_DMA_V
#undef AT_ROT
#undef AT_QKT
#undef AT_PSM
#undef AT_PK4
#undef AT_FIN_PV
#undef AT_RESC
#undef AT_STEP0
    if (hi == 0) wsf[r32] = 1.f / l_reg;
    asm volatile("s_waitcnt lgkmcnt(0)" ::: "memory");
    float rli[16];
#pragma unroll
    for (int r = 0; r < 16; ++r) rli[r] = wsf[crow(r, hi)];
    LAS float* xch = (LAS float*)lds + wq * 4096;
    if (mp == 1) {
#pragma unroll
        for (int d = 0; d < 4; ++d)
#pragma unroll
            for (int r = 0; r < 16; ++r) xch[(d * 16 + r) * 64 + lane] = o[d][r] * rli[r];
    }
    __syncthreads();
    if (mp == 0) {
#pragma unroll
        for (int d = 0; d < 4; ++d)
#pragma unroll
            for (int r = 0; r < 16; ++r) { const float v2 = xch[(d * 16 + r) * 64 + lane]; o[d][r] = o[d][r] * rli[r] - lam * v2; }
    }
    __syncthreads();
    LAS float* stg = (LAS float*)lds + wq * 4224;
    if (mp == 0) {
#pragma unroll
        for (int d = 0; d < 4; ++d)
#pragma unroll
            for (int r = 0; r < 16; ++r) stg[crow(r, hi) * 132 + d * 32 + r32] = o[d][r];
        asm volatile("s_waitcnt lgkmcnt(0)" ::: "memory");
        const int row = lane >> 1, ch = (lane & 1) * 64; const LAS float* sp = stg + row * 132 + ch; float vv[64]; float ss = 0.f;
#pragma unroll
        for (int i = 0; i < 16; ++i) { const f32x4 t4 = *(const LAS f32x4*)(sp + 4 * i); vv[4 * i] = t4[0]; vv[4 * i + 1] = t4[1]; vv[4 * i + 2] = t4[2]; vv[4 * i + 3] = t4[3]; ss += (t4[0] * t4[0] + t4[1] * t4[1]) + (t4[2] * t4[2] + t4[3] * t4[3]); }
        ss += __shfl_xor(ss, 1);
        const float rs = (1.0f / sqrtf(ss * (1.f / 128.f) + RMS_EPS)) * (1.f - LAMBDA_INIT);
        bf16_t* op = O + (rowbase + q0 + wq * 32 + row) * 1024 + head * 128 + ch; const float* gp = gain + ch;
#pragma unroll
        for (int i = 0; i < 8; ++i) { const f32x4 g0 = *(const f32x4*)(gp + 8 * i), g1 = *(const f32x4*)(gp + 8 * i + 4); u32x4 w;
            w.x = cvt_pk_bf16(vv[8 * i] * rs * g0[0], vv[8 * i + 1] * rs * g0[1]); w.y = cvt_pk_bf16(vv[8 * i + 2] * rs * g0[2], vv[8 * i + 3] * rs * g0[3]);
            w.z = cvt_pk_bf16(vv[8 * i + 4] * rs * g1[0], vv[8 * i + 5] * rs * g1[1]); w.w = cvt_pk_bf16(vv[8 * i + 6] * rs * g1[2], vv[8 * i + 7] * rs * g1[3]);
            *(u32x4*)(op + 8 * i) = w; }
    }
    __syncthreads();
}
template <unsigned var> __device__ __forceinline__ void attn_phase(LAS unsigned char* lds, int vcu, int ncu, const bf16_t* Q, const bf16_t* K, const bf16_t* V, bf16_t* O, const float* scal, const float* gain) {
    const float lam = scal[0];
    for (int bh = vcu >> 1; bh < NB * NHEAD; bh += (ncu >> 1)) {
        const int b = bh >> 3, head = bh & 7;
        for (int i = 0; i < 8; ++i) { const int s = (vcu & 1) + 2 * (i >> 1); const int qblk = (i & 1) ? 15 - s : s;
            attn_unit<var>(lds, b, head, qblk, Q, K, V, O, lam, gain); }
    }
}
#undef AT_SBAR
}

struct MKArgs { const void* in[21]; float* out; unsigned char* ws; unsigned mask; unsigned li; };
enum { PH_PRO = 0, PH_G1, PH_POOLA, PH_ATT, PH_POOLG, PH_G4A, PH_G4B, PH_G5, PH_ROUTER, PH_G7, PH_G8, PH_FINAL, PH_N };

template <int MODE> __device__ __forceinline__ int dest_row(int n) {
    if (MODE == 1) return n < 2048 ? (n & ~63) + qk_pos_of_d(n & 63) : n;
    if (MODE == 2) { const int nn = n >> 9, hc = n & 511; return (hc >> 7) * 256 + ((hc >> 6) & 1) * 128 + ((hc >> 4) & 3) * 32 + ((hc >> 2) & 3) * 8 + nn * 4 + (hc & 3); }
    return n;
}
template <int MODE> __device__ __forceinline__ void transpose_item(const float* __restrict__ W, int ldw, int N, bf16_t* __restrict__ WT, int ldt, int coloff, int rowoff, LAS float* scr, int item, int lane) {
    const int nblk = N / 64, kb = item / nblk, nb = item % nblk, k0 = 64 * kb, n0 = 64 * nb;
    const int lr = lane >> 4, n4 = (lane & 15) * 4;
#pragma unroll 4
    for (int i = 0; i < 16; ++i) { const int kk = 4 * i + lr; const f32x4 v = *(const f32x4*)(W + (size_t)(k0 + kk) * ldw + n0 + n4); *(LAS f32x4*)(scr + kk * 64 + (n4 ^ ((kk >> 3) << 2))) = v; }
    LDS_WAIT(); asm volatile("" ::: "memory");
    const int c = lane & 7;
#pragma unroll 2
    for (int jj = 0; jj < 8; ++jj) { const int n = 8 * jj + (lane >> 3); const LAS float* sp = scr + (8 * c) * 64 + (n ^ (c << 2));
        u32x4 o; o.x = cvt_pk_bf16(sp[0 * 64], sp[1 * 64]); o.y = cvt_pk_bf16(sp[2 * 64], sp[3 * 64]); o.z = cvt_pk_bf16(sp[4 * 64], sp[5 * 64]); o.w = cvt_pk_bf16(sp[6 * 64], sp[7 * 64]);
        *(u32x4*)(WT + (size_t)(rowoff + dest_row<MODE>(n0 + n)) * ldt + coloff + k0 + 8 * c) = o; }
    LDS_WAIT(); asm volatile("" ::: "memory");
}

__global__ void __launch_bounds__(NTHREADS, 2) mk_fwd(MKArgs args) {
    __shared__ __attribute__((aligned(16))) unsigned char lds_raw[LDS_BYTES];
    LAS unsigned char* lds = (LAS unsigned char*)lds_raw;
    volatile LAS unsigned* MISC = (volatile LAS unsigned*)(lds + MISC_OFF);
    const int tid = threadIdx.x, lane = tid & 63, wave = __builtin_amdgcn_readfirstlane(tid >> 6);
    const int G = gridDim.x; const int bx = blockIdx.x; const int vcu = (G % 8 == 0) ? (bx % 8) * (G / 8) + bx / 8 : bx;
    const unsigned mask = args.mask;
    unsigned char* const ws = args.ws; float* const out = args.out;
#define IN_F(k) ((const float*)args.in[k])
#define x_ IN_F(0)
#define positions ((const int*)args.in[1])
#define w_in IN_F(2)
#define gate_bias IN_F(3)
#define lam_vecs IN_F(4)
#define subln_gain IN_F(5)
#define w_pool IN_F(6)
#define pool_scale IN_F(7)
#define w_branch_a IN_F(8)
#define w_branch_b IN_F(9)
#define w_out IN_F(10)
#define ln1_g IN_F(11)
#define ln1_b IN_F(12)
#define wrg IN_F(13)
#define brg IN_F(14)
#define wre IN_F(15)
#define bre IN_F(16)
#define wgu IN_F(17)
#define wdn IN_F(18)
#define ln2_g IN_F(19)
#define ln2_b IN_F(20)
#define wt ((bf16_t*)(ws + WS_WT))
#define xb ((bf16_t*)(ws + WS_XB))
#define qb ((bf16_t*)(ws + WS_Q))
#define kb ((bf16_t*)(ws + WS_K))
#define vb ((bf16_t*)(ws + WS_V))
#define ub ((bf16_t*)(ws + WS_U))
#define gb ((bf16_t*)out)
#define on ((bf16_t*)(ws + WS_ON))
#define mixed ((bf16_t*)(ws + WS_MIXED))
#define merged ((bf16_t*)(ws + WS_MERGED))
#define x1b ((bf16_t*)(ws + WS_X1B))
#define hb ((bf16_t*)(ws + WS_H))
#define ybuf ((bf16_t*)(ws + WS_YBUF))
#define rope ((float*)(ws + WS_ROPE))
#define pooled ((bf16_t*)(ws + WS_POOLED))
#define misc (ws + WS_MISC)
#define ctl ((unsigned*)(misc + MS_CTL))
#define stats ((float2*)(misc + MS_STATS))
#define rw ((float*)(misc + MS_ROUTE + (size_t)T * 8))
#define list ((int*)(misc + MS_LIST))
#define scal ((float*)(misc + MS_SCAL))
#define cnt (ctl + CW_CNT)
#define wpool_bd ((bf16_t*)(misc + MS_WPOOL))

    for (int u = tid; u < (LDS_BYTES - LDS_CTL_OFF) / 4; u += NTHREADS) ((LAS unsigned*)(lds + LDS_CTL_OFF))[u] = 0u;
    __syncthreads();
    XcdBarrier bar; bar.bar = ctl + CW_BAR + (args.li & 255u) * XCD_BAR_WORDS; bar.x = 0; bar.st = nullptr;
    const bool multi = (mask & (mask - 1u)) != 0u;
    if (multi) bar = xcd_barrier_post(ctl + CW_BAR + (args.li & 255u) * XCD_BAR_WORDS, MISC + 8);
#ifndef MK_CT
#define MK_CT 0xfffu
#endif
#define HAS(p) (((MK_CT >> (p)) & 1u) && ((mask >> (p)) & 1u))
#ifndef MK_REP
#define MK_REP 0u
#endif
#define REPS(p) for (int rep_ = 0; rep_ < ((((MK_REP) >> (p)) & 1u) ? 2 : 1); ++rep_)
#define SEAM(p) do { if (multi && (mask >> ((p) + 1)) != 0u) xcd_barrier(bar); } while (0)
    const int gw = vcu * NWAVES + wave, NGW = G * NWAVES;

    if (HAS(PH_PRO)) {
        LAS float* scr = (LAS float*)(lds + wave * 16384);
        constexpr int I_IN = 16 * (INW / 64), I_A = 16 * 16, I_O = 16 * 16, I_GU = 16 * 16, I_DN = 8 * 16;
        constexpr int NITEMS = I_IN + I_A + I_O + NE * I_GU + NE * I_DN;
        for (int it = gw; it < NITEMS; it += NGW) {
            int r = it;
            if (r < I_IN) { transpose_item<1>(w_in, INW, INW, wt + WT_IN, 1024, 0, 0, scr, r, lane); continue; } r -= I_IN;
            if (r < I_A) { transpose_item<0>(w_branch_a, 1024, 1024, wt + WT_A, 1024, 0, 0, scr, r, lane); continue; } r -= I_A;
            if (r < I_O) { transpose_item<0>(w_out, 1024, 1024, wt + WT_O, 1024, 0, 0, scr, r, lane); continue; } r -= I_O;
            if (r < NE * I_GU) { const int e = r / I_GU; transpose_item<2>(wgu + (size_t)e * 1024 * 1024, 1024, 1024, wt + WT_GU + (size_t)e * 1024 * 1024, 1024, 0, 0, scr, r % I_GU, lane); continue; } r -= NE * I_GU;
            { const int e = r / I_DN; transpose_item<0>(wdn + (size_t)e * 512 * 1024, 1024, 1024, wt + WT_DN + (size_t)e * 1024 * 512, 512, 0, 0, scr, r % I_DN, lane); }
        }
        for (int it = gw; it < 64 * 16; it += NGW) { const int kc = it >> 4, n = (it & 15) * 64 + lane; const int g = kc >> 4, c0 = (kc & 15) * 8; float a8[8] = {0.f, 0.f, 0.f, 0.f, 0.f, 0.f, 0.f, 0.f};
            const float* wpg = w_pool + (size_t)(g * 128 + c0) * 128; const float* wbp = w_branch_b + (size_t)(g * 128) * 1024 + n; const float* psp = pool_scale + g * 128;
            for (int d = 0; d < 128; ++d) { const float bv = wbp[(size_t)d * 1024] * psp[d];
#pragma unroll
                for (int i = 0; i < 8; ++i) a8[i] = fmaf(wpg[i * 128 + d], bv, a8[i]); }
            u32x4 o; o.x = cvt_pk_bf16(a8[0], a8[1]); o.y = cvt_pk_bf16(a8[2], a8[3]); o.z = cvt_pk_bf16(a8[4], a8[5]); o.w = cvt_pk_bf16(a8[6], a8[7]);
            *(u32x4*)(wt + WT_B + (size_t)n * 512 + kc * 8) = o; }
        for (int m = gw; m < T; m += NGW) { const f32x4* xr = (const f32x4*)(x_ + (size_t)m * 1024) + lane; u32x2* o8 = (u32x2*)(xb + (size_t)m * 1024) + lane;
#pragma unroll
            for (int j = 0; j < 4; ++j) { const f32x4 v = xr[64 * j]; u32x2 w; w.x = cvt_pk_bf16(v[0], v[1]); w.y = cvt_pk_bf16(v[2], v[3]); o8[64 * j] = w; } }
        for (int e = gw * 64 + lane; e < T * 32; e += NGW * 64) { const int t = e >> 5, i = e & 31; const float inv = powf(10000.0f, -(float)i * (2.0f / 64.0f)); const float ang = (float)positions[t] * inv; const double a = (double)ang;
            rope[2 * e] = (float)cos(a); rope[2 * e + 1] = (float)sin(a); }
        if (gw == 0 && lane == 0) { float s01 = 0.f, s23 = 0.f; for (int i = 0; i < 64; ++i) { s01 += lam_vecs[i] * lam_vecs[64 + i]; s23 += lam_vecs[128 + i] * lam_vecs[192 + i]; } scal[0] = expf(s01) - expf(s23) + LAMBDA_INIT; }
        { f32x4* wp = (f32x4*)(misc + MS_WP);
          for (int e = gw * 64 + lane; e < 16 * 3 * 4 * 64; e += NGW * 64) { const int l = e & 63, sg = (e >> 6) & 3, ob = (e >> 8) % 3, chunk = (e >> 8) / 3; const int o = ob * 16 + (l & 15); f32x4 v = {0.f, 0.f, 0.f, 0.f};
              if (o < 36) {
#pragma unroll
                  for (int j = 0; j < 4; ++j) { const int c = chunk * 64 + (l >> 4) * 16 + 4 * sg + j; v[j] = ln1_g[c] * (o < 4 ? wrg[c * 4 + o] : wre[c * 32 + (o - 4)]); } }
              wp[e] = v; }
          float* csbw = (float*)(misc + MS_CSBW);
          if (gw < 48) { const int o = gw; float cs = 0.f, bw = 0.f;
              if (o < 36) { for (int i = 0; i < 16; ++i) { const int c = lane + 64 * i; const float w = (o < 4 ? wrg[c * 4 + o] : wre[c * 32 + (o - 4)]); cs += ln1_g[c] * w; bw += ln1_b[c] * w; }
                  cs = wave_sum(cs); bw = wave_sum(bw) + (o < 4 ? brg[o] : bre[o - 4]); }
              if (lane == 0) { csbw[o] = cs; csbw[48 + o] = bw; } } }
        __syncthreads();
        SEAM(PH_PRO);
    }
    if (HAS(PH_G1)) {
        g8::DenseOrder S; S.init(xb, wt + WT_IN, T, INW, 1024, G, bx);
        g8::EpiProj E{qb, kb, vb, ub, gb, rope, gate_bias};
        g8::gemm_phase<g8::EpiProj, g8::DenseOrder, true, false>(lds, 1024, S, E);
        SEAM(PH_G1);
    }
    if (HAS(PH_POOLA)) {
        for (int e = (gw * 64 + lane); e < T * 64; e += NGW * 64) { const int t = e >> 6, c8 = (e & 63) * 8; const int g = c8 >> 7, w = 2 << g, s = t & (SEQ - 1); const int n = (s + 1 < w) ? s + 1 : w;
            float a[8] = {0.f, 0.f, 0.f, 0.f, 0.f, 0.f, 0.f, 0.f}; float u0[8];
            for (int i = 0; i < n; ++i) { const u32x4 v = *(const u32x4*)(ub + (size_t)(t - i) * 512 + c8); const float f[8] = {bflo(v.x), bfhi(v.x), bflo(v.y), bfhi(v.y), bflo(v.z), bfhi(v.z), bflo(v.w), bfhi(v.w)};
#pragma unroll
                for (int j = 0; j < 8; ++j) { a[j] += f[j]; if (i == 0) u0[j] = f[j]; } }
            const float inv = 1.f / (float)n; u32x4 o; o.x = cvt_pk_bf16(a[0] * inv - u0[0], a[1] * inv - u0[1]); o.y = cvt_pk_bf16(a[2] * inv - u0[2], a[3] * inv - u0[3]);
            o.z = cvt_pk_bf16(a[4] * inv - u0[4], a[5] * inv - u0[5]); o.w = cvt_pk_bf16(a[6] * inv - u0[6], a[7] * inv - u0[7]);
            *(u32x4*)(pooled + (size_t)t * 512 + c8) = o; }
    }
    if (HAS(PH_ATT)) {
#ifdef MK_VAR
        if (args.li >> 8) at2::attn_phase<MK_VAR>(lds, vcu, G, qb, kb, vb, (bf16_t*)(ws + WS_POOLED), scal, subln_gain); else
#endif
        at2::attn_phase<0u>(lds, vcu, G, qb, kb, vb, on, scal, subln_gain);
        SEAM(PH_ATT); }
    else if (HAS(PH_POOLA)) { SEAM(PH_ATT); }
    if (HAS(PH_G4A)) {
        g8::DenseOrder S; S.init(on, wt + WT_A, T, 1024, 1024, G, bx);
        g8::EpiMerge<0> E{gb, merged};
        g8::gemm_phase<g8::EpiMerge<0>, g8::DenseOrder, true, false>(lds, 1024, S, E);
    }
    if (HAS(PH_G4B)) {
        g8::DenseOrder S; S.init(pooled, wt + WT_B, T, 1024, 512, G, bx);
        g8::EpiMerge<1> E{gb, merged};
        g8::gemm_phase<g8::EpiMerge<1>, g8::DenseOrder, true, false>(lds, 512, S, E);
        SEAM(PH_G4B);
    } else if (HAS(PH_G4A)) { SEAM(PH_G4B); }
    if (HAS(PH_G5)) {
        g8::DenseOrder S; S.init(merged, wt + WT_O, T, 1024, 1024, G, bx);
        g8::EpiResid E{x_, out};
        g8::gemm_phase<g8::EpiResid, g8::DenseOrder, true, false>(lds, 1024, S, E);
        SEAM(PH_G5);
    }
    if (HAS(PH_ROUTER)) {
        LAS float* lgs = (LAS float*)(lds + 0) + wave * (16 * 49);
        LAS float* tst = (LAS float*)(lds + 32768) + wave * 32;
        LAS int*   tex = (LAS int*)(lds + 36864) + wave * 64;
        LAS unsigned* lcnt = (LAS unsigned*)(lds + 40960);
        const f32x4* wp = (const f32x4*)(misc + MS_WP); const float* csbw = (const float*)(misc + MS_CSBW);
        for (int t0 = vcu * 128; t0 < T; t0 += G * 128) {
            if (tid < 64) lcnt[tid] = 0u;
            __syncthreads();
            const int tw = t0 + wave * 16; const int tk = lane & 15, q = lane >> 4;
            { const float* yr = out + (size_t)(tw + tk) * 1024 + q * 16; float s1 = 0.f, s2 = 0.f;
              f32x4 acc0 = {0.f, 0.f, 0.f, 0.f}, acc1 = {0.f, 0.f, 0.f, 0.f}, acc2 = {0.f, 0.f, 0.f, 0.f};
#pragma unroll 2
              for (int chunk = 0; chunk < 16; ++chunk) { f32x4 yv[4];
#pragma unroll
                  for (int j = 0; j < 4; ++j) yv[j] = *(const f32x4*)(yr + chunk * 64 + 4 * j);
#pragma unroll
                  for (int sg = 0; sg < 4; ++sg) { const f32x4 b0 = wp[((chunk * 3 + 0) * 4 + sg) * 64 + lane], b1 = wp[((chunk * 3 + 1) * 4 + sg) * 64 + lane], b2 = wp[((chunk * 3 + 2) * 4 + sg) * 64 + lane];
#pragma unroll
                      for (int j = 0; j < 4; ++j) { const float a = yv[sg][j]; s1 += a; s2 = fmaf(a, a, s2);
                          acc0 = __builtin_amdgcn_mfma_f32_16x16x4f32(a, b0[j], acc0, 0, 0, 0); acc1 = __builtin_amdgcn_mfma_f32_16x16x4f32(a, b1[j], acc1, 0, 0, 0); acc2 = __builtin_amdgcn_mfma_f32_16x16x4f32(a, b2[j], acc2, 0, 0, 0); } } }
              s1 += __shfl_xor(s1, 16); s1 += __shfl_xor(s1, 32); s2 += __shfl_xor(s2, 16); s2 += __shfl_xor(s2, 32);
              const float mu = s1 * (1.f / 1024.f); const float var = fmaxf(s2 * (1.f / 1024.f) - mu * mu, 0.f); const float rstd = 1.0f / sqrtf(var + LN_EPS);
              if (q == 0) { tst[2 * tk] = mu; tst[2 * tk + 1] = rstd; stats[tw + tk] = make_float2(mu, rstd); }
#pragma unroll
              for (int r = 0; r < 4; ++r) { lgs[(4 * q + r) * 49 + tk] = acc0[r]; lgs[(4 * q + r) * 49 + 16 + tk] = acc1[r]; lgs[(4 * q + r) * 49 + 32 + tk] = acc2[r]; } }
            LDS_WAIT();
            if (lane < 16) { const int t = tw + lane; const float mu = tst[2 * lane], rstd = tst[2 * lane + 1]; const LAS float* lr = lgs + lane * 49;
                float lg[4], le[32];
#pragma unroll
                for (int o = 0; o < 4; ++o) lg[o] = rstd * (lr[o] - mu * csbw[o]) + csbw[48 + o];
#pragma unroll
                for (int o = 0; o < 32; ++o) le[o] = rstd * (lr[4 + o] - mu * csbw[4 + o]) + csbw[48 + 4 + o];
                int gi = 0; float gm = lg[0];
#pragma unroll
                for (int o = 1; o < 4; ++o) if (lg[o] > gm) { gm = lg[o]; gi = o; }
                float gs = 0.f;
#pragma unroll
                for (int o = 0; o < 4; ++o) gs += expf(lg[o] - gm);
                const float gp = 1.f / gs; float ev[8];
#pragma unroll
                for (int o = 0; o < 8; ++o) { float vsel = le[o];
#pragma unroll
                    for (int g = 1; g < 4; ++g) vsel = (gi == g) ? le[g * 8 + o] : vsel;
                    ev[o] = vsel; }
                int i0 = 0; float m0v = ev[0];
#pragma unroll
                for (int o = 1; o < 8; ++o) if (ev[o] > m0v) { m0v = ev[o]; i0 = o; }
                int i1 = (i0 == 0) ? 1 : 0; float m1v = -3.4e38f;
#pragma unroll
                for (int o = 0; o < 8; ++o) if (o != i0 && ev[o] > m1v) { m1v = ev[o]; i1 = o; }
                const float e1 = expf(m1v - m0v); const float w0 = gp / (1.f + e1), w1 = gp * e1 / (1.f + e1);
                const int ex0 = gi * 8 + i0, ex1 = gi * 8 + i1;
                rw[2 * t] = w0; rw[2 * t + 1] = w1;
                const unsigned r0 = __hip_atomic_fetch_add(lcnt + ex0, 1u, __ATOMIC_RELAXED, __HIP_MEMORY_SCOPE_WORKGROUP); const unsigned r1 = __hip_atomic_fetch_add(lcnt + ex1, 1u, __ATOMIC_RELAXED, __HIP_MEMORY_SCOPE_WORKGROUP);
                tex[4 * lane] = ex0; tex[4 * lane + 1] = ex1; tex[4 * lane + 2] = (int)r0; tex[4 * lane + 3] = (int)r1; }
            __syncthreads();
            if (tid < NE) { const unsigned c = lcnt[tid]; lcnt[32 + tid] = c ? atomicAdd(cnt + tid, c) : 0u; }
            __syncthreads();
            if (lane < 16) { const int t = tw + lane; const int ex0 = tex[4 * lane], ex1 = tex[4 * lane + 1];
                list[(size_t)ex0 * T + lcnt[32 + ex0] + (unsigned)tex[4 * lane + 2]] = t * 2; list[(size_t)ex1 * T + lcnt[32 + ex1] + (unsigned)tex[4 * lane + 3]] = t * 2 + 1; }
            for (int i = 0; i < 16; ++i) { const int t = tw + i; const float mu = tst[2 * i], rstd = tst[2 * i + 1]; const float* yr = out + (size_t)t * 1024;
#pragma unroll
                for (int j = 0; j < 4; ++j) { const int c0 = j * 256 + lane * 4; const f32x4 v = *(const f32x4*)(yr + c0), gg = *(const f32x4*)(ln1_g + c0), bb = *(const f32x4*)(ln1_b + c0);
                    u32x2 w; w.x = cvt_pk_bf16((v[0] - mu) * rstd * gg[0] + bb[0], (v[1] - mu) * rstd * gg[1] + bb[1]); w.y = cvt_pk_bf16((v[2] - mu) * rstd * gg[2] + bb[2], (v[3] - mu) * rstd * gg[3] + bb[3]);
                    *(u32x2*)(x1b + (size_t)t * 1024 + c0) = w; } }
            __syncthreads();
        }
        SEAM(PH_ROUTER);
    }
    if (HAS(PH_G7) || HAS(PH_G8)) {
        if (tid < NE) MISC[64 + tid] = __hip_atomic_load(cnt + tid, RLX_AGENT);
        __syncthreads();
        if (tid == 0) { unsigned acc = 0u; for (int e = 0; e < NE; ++e) { MISC[16 + e] = acc; acc += (MISC[64 + e] + 255u) >> 8; } MISC[16 + NE] = acc; }
        __syncthreads();
        const int ntiles = (int)MISC[16 + NE];
        unsigned* tdone = ctl + CW_TDONE;
        const int nwg = ntiles * 4, r7 = nwg % G;
        if (HAS(PH_G7)) {
            g8::MoeOrder S{(const char*)x1b, (const char*)(wt + WT_GU), list, MISC + 16, MISC + 64, nwg, G, bx, 0, (size_t)1024 * 1024 * 2, (size_t)256 * 1024 * 2, 1, tdone, 1};
            g8::EpiGateUp E{hb};
            g8::gemm_phase<g8::EpiGateUp, g8::MoeOrder, true, true>(lds, 1024, S, E);
        }
        if (HAS(PH_G8)) {
            g8::MoeOrder S{(const char*)hb, (const char*)(wt + WT_DN), list, MISC + 16, MISC + 64, nwg, G, (bx - r7 + G) % G, (size_t)256 * 512 * 2, (size_t)1024 * 512 * 2, (size_t)256 * 512 * 2, 0, tdone, 2};
            g8::EpiDown E{ybuf, list, rw, MISC + 64};
            g8::gemm_phase<g8::EpiDown, g8::MoeOrder, true, false>(lds, 512, S, E);
            SEAM(PH_G8);
        } else if (HAS(PH_G7)) { SEAM(PH_G8); }
    }
    if (HAS(PH_FINAL)) {
        for (int t = gw; t < T; t += NGW) {
            float* yr = out + (size_t)t * 1024; const float2 st = stats[t]; float xv[16]; float s = 0.f;
#pragma unroll
            for (int j = 0; j < 4; ++j) { const int c0 = j * 256 + lane * 4; const f32x4 vv = *(const f32x4*)(yr + c0); const f32x4 gg = *(const f32x4*)(ln1_g + c0); const f32x4 bb = *(const f32x4*)(ln1_b + c0);
                const u32x2 a = *(const u32x2*)(ybuf + (size_t)(2 * t) * 1024 + c0); const u32x2 b = *(const u32x2*)(ybuf + (size_t)(2 * t + 1) * 1024 + c0);
                const float ya[4] = {bflo(a.x), bfhi(a.x), bflo(a.y), bfhi(a.y)}; const float yb[4] = {bflo(b.x), bfhi(b.x), bflo(b.y), bfhi(b.y)};
#pragma unroll
                for (int i = 0; i < 4; ++i) { const float x1 = (vv[i] - st.x) * st.y * gg[i] + bb[i]; const float val = ALPHA * x1 + (ya[i] + yb[i]); xv[4 * j + i] = val; s += val; } }
            const float mu = wave_sum(s) * (1.f / 1024.f); float s2 = 0.f;
#pragma unroll
            for (int i = 0; i < 16; ++i) { const float d = xv[i] - mu; s2 += d * d; }
            const float rstd = 1.0f / sqrtf(wave_sum(s2) * (1.f / 1024.f) + LN_EPS);
#pragma unroll
            for (int j = 0; j < 4; ++j) { const int c0 = j * 256 + lane * 4; const f32x4 gg = *(const f32x4*)(ln2_g + c0); const f32x4 bb = *(const f32x4*)(ln2_b + c0); f32x4 o;
#pragma unroll
                for (int i = 0; i < 4; ++i) o[i] = (xv[4 * j + i] - mu) * rstd * gg[i] + bb[i];
                *(f32x4*)(yr + c0) = o; }
        }
    }
#undef HAS
#undef SEAM
}
#undef IN_F
#undef x_
#undef positions
#undef w_in
#undef gate_bias
#undef lam_vecs
#undef subln_gain
#undef w_pool
#undef pool_scale
#undef w_branch_a
#undef w_branch_b
#undef w_out
#undef ln1_g
#undef ln1_b
#undef wrg
#undef brg
#undef wre
#undef bre
#undef wgu
#undef wdn
#undef ln2_g
#undef ln2_b
#undef wt
#undef xb
#undef qb
#undef kb
#undef vb
#undef ub
#undef gb
#undef on
#undef mixed
#undef merged
#undef x1b
#undef hb
#undef ybuf
#undef rope
#undef pooled
#undef misc
#undef ctl
#undef stats
#undef rw
#undef list
#undef scal
#undef cnt
#undef wpool_bd


#ifndef MK_OPT
#define MK_OPT 0xfffu
#endif
#ifndef MK_M2A
#define MK_M2A 0xff4u
#define MK_M2B 0u
#define MK_M2C 0u
#endif
#ifndef MK_ONE
#define MK_ONE 1
#endif
constexpr unsigned OPT = MK_OPT;
#define OPTP(p) ((OPT >> (p)) & 1u)


#ifdef MK_DEBUG_HASH
__global__ void k_hash(const uint4* __restrict__ p, size_t n16, unsigned long long* __restrict__ outh) {
    unsigned long long h = 0ull;
    for (size_t i = blockIdx.x * (size_t)blockDim.x + threadIdx.x; i < n16; i += (size_t)gridDim.x * blockDim.x) { const uint4 w = p[i];
        const unsigned long long m = (unsigned long long)(i * 2654435761ull + 12345ull) | 1ull;
        h += ((unsigned long long)w.x * 0x9E3779B1ull + (unsigned long long)w.y * 0x85EBCA77ull + (unsigned long long)w.z * 0xC2B2AE3Dull + (unsigned long long)w.w * 0x27D4EB2Full) * m; }
    for (int o = 32; o > 0; o >>= 1) h += __shfl_xor(h, o);
    if ((threadIdx.x & 63) == 0) atomicAdd(outh, h);
}
__global__ void k_poison(float* __restrict__ out, const unsigned long long* __restrict__ hs) {
    float code = 0.f; for (int r = 1; r < 10; ++r) if (hs[r] != hs[0]) code = 1.f;
    if (code == 0.f) return;
    for (size_t i = blockIdx.x * (size_t)blockDim.x + threadIdx.x; i < (size_t)T * DM; i += (size_t)gridDim.x * blockDim.x) out[i] = __builtin_nanf("") * code;
}
#endif
extern "C" void kernel_launch(void* const* d_in, const int* in_sizes, int n_in, void* d_out, int out_size, void* d_ws, size_t ws_size, hipStream_t stream) {
    static int grid = 0;
    if (grid == 0) {
        if (n_in != 21 || in_sizes[0] != T * DM || out_size != T * DM || ws_size < WS_END) { fprintf(stderr, "kernel_launch: unexpected shapes (n_in %d, x %d, out %d, ws %zu)\n", n_in, n_in > 0 ? in_sizes[0] : -1, out_size, ws_size); grid = -1; return; }
        int dev = 0, cus = 0;
        if (hipGetDevice(&dev) != hipSuccess || hipDeviceGetAttribute(&cus, hipDeviceAttributeMultiprocessorCount, dev) != hipSuccess) { fprintf(stderr, "kernel_launch: device query failed\n"); grid = -1; return; }
        int per_cu = 0;
        if (hipOccupancyMaxActiveBlocksPerMultiprocessor(&per_cu, (const void*)mk_fwd, NTHREADS, 0) != hipSuccess || per_cu < 1) fprintf(stderr, "kernel_launch: note: occupancy query reports %d blocks per CU\n", per_cu);
        (void)hipGetLastError();
        grid = cus;
    }
    if (grid < 0) return;
    const float* x = (const float*)d_in[0]; const int* positions = (const int*)d_in[1]; const float* w_in = (const float*)d_in[2]; const float* gate_bias = (const float*)d_in[3];
    const float* lam_vecs = (const float*)d_in[4]; const float* subln_gain = (const float*)d_in[5]; const float* w_pool = (const float*)d_in[6]; const float* pool_scale = (const float*)d_in[7];
    const float* w_branch_a = (const float*)d_in[8]; const float* w_branch_b = (const float*)d_in[9]; const float* w_out = (const float*)d_in[10]; const float* ln1_g = (const float*)d_in[11];
    const float* ln1_b = (const float*)d_in[12]; const float* wrg = (const float*)d_in[13]; const float* brg = (const float*)d_in[14]; const float* wre = (const float*)d_in[15];
    const float* bre = (const float*)d_in[16]; const float* wgu = (const float*)d_in[17]; const float* wdn = (const float*)d_in[18]; const float* ln2_g = (const float*)d_in[19]; const float* ln2_b = (const float*)d_in[20];
    char* ws = (char*)d_ws; float* out = (float*)d_out;
    bf16_t* qb = (bf16_t*)(ws + WS_Q); bf16_t* kb = (bf16_t*)(ws + WS_K); bf16_t* vb = (bf16_t*)(ws + WS_V); bf16_t* ub = (bf16_t*)(ws + WS_U); bf16_t* gb = (bf16_t*)d_out;
    bf16_t* on = (bf16_t*)(ws + WS_ON); bf16_t* mixed = (bf16_t*)(ws + WS_MIXED); bf16_t* merged = (bf16_t*)(ws + WS_MERGED); bf16_t* x1b = (bf16_t*)(ws + WS_X1B);
    bf16_t* hb = (bf16_t*)(ws + WS_H); bf16_t* ybuf = (bf16_t*)(ws + WS_YBUF); float2* rope = (float2*)(ws + WS_ROPE); float* tmp = (float*)(ws + WS_TEMP);
    char* misc = ws + WS_MISC; unsigned* ctl = (unsigned*)(misc + MS_CTL); float2* stats = (float2*)(misc + MS_STATS); int2* rexp = (int2*)(misc + MS_ROUTE); float2* rw = (float2*)(misc + MS_ROUTE + (size_t)T * 8);
    int* list = (int*)(misc + MS_LIST); float* scal = (float*)(misc + MS_SCAL); unsigned* cnt = ctl;

    MKArgs a{}; int nlaunch = 0;
    for (int i = 0; i < 21; ++i) a.in[i] = d_in[i];
    a.out = out; a.ws = (unsigned char*)d_ws;
    if (hipMemsetAsync(ctl, 0, 65536, stream) != hipSuccess) { fprintf(stderr, "kernel_launch: memset failed\n"); return; }
#ifndef MK_REPH
#define MK_REPH 0u
#endif
#define MK(maskv) do { a.mask = (maskv); for (int rr_ = 0; rr_ < (((maskv) & (MK_REPH)) ? 2 : 1); ++rr_) { a.li = (unsigned)(nlaunch++ % 3) | (rr_ ? (1u << 8) : 0u); hipLaunchKernelGGL(mk_fwd, dim3(grid), dim3(NTHREADS), 0, stream, a); } } while (0)
    if (MK_ONE == 1) { MK((1u << PH_N) - 1u); return; }
    if (MK_ONE == 2) {
        MK(0x003u);
        for (int mh = 0; mh < 2; ++mh) { const int m0 = mh * 16384; nattn<<<(16384 / 64) * 16, 64, 0, stream>>>(qb, kb, vb, scal, tmp, m0); post_rms<<<16384 * 8 / 256, 256, 0, stream>>>(tmp, subln_gain, on, m0, 16384); }
        MK(MK_M2A); if (MK_M2B) MK(MK_M2B); if (MK_M2C) MK(MK_M2C); return; }

    constexpr int MC = 16384;
#if 0
#else
#ifdef MK_TEST_BAR
    MK(0x003u);
#else
    if (OPTP(PH_PRO)) MK(1u << PH_PRO); else k_prep<<<T * 32 / 256, 256, 0, stream>>>(positions, lam_vecs, rope, scal, ctl);
    if (OPTP(PH_G1)) MK(1u << PH_G1);
#endif
#endif
#ifndef MK_OVR
#define MK_OVR 0
#endif
    const int ovr = OPTP(PH_G1) ? MK_OVR : 15;
    for (int mh = 0; mh < 2; ++mh) {
        const int m0 = mh * MC; AL_F32 ax{x + (size_t)m0 * DM, DM, 0};
        if (ovr & 1) for (int qk = 0; qk < 2; ++qk) {
            ngemm<AL_F32><<<dim3(16, MC / 64), 256, 0, stream>>>(ax, w_in + qk * 1024, INW, tmp, 1024, MC, 1024, DM);
            post_qk<<<MC * 512 / 256, 256, 0, stream>>>(tmp, rope, qk ? kb : qb, m0, MC, qk ? 1.f : QSCALE);
        }
        if (ovr & 2) { ngemm<AL_F32><<<dim3(16, MC / 64), 256, 0, stream>>>(ax, w_in + 2048, INW, tmp, 1024, MC, 1024, DM);
        post_plain<<<MC * 1024 / 256, 256, 0, stream>>>(tmp, vb, 1024, 0, m0, MC, 1024, nullptr); }
        if (ovr & 4) { ngemm<AL_F32><<<dim3(8, MC / 64), 256, 0, stream>>>(ax, w_in + 3072, INW, tmp, 512, MC, 512, DM);
        post_plain<<<MC * 512 / 256, 256, 0, stream>>>(tmp, ub, 512, 0, m0, MC, 512, nullptr); }
        if (ovr & 8) for (int br = 0; br < 2; ++br) {
            ngemm<AL_F32><<<dim3(16, MC / 64), 256, 0, stream>>>(ax, w_in + 3584 + br * 1024, INW, tmp, 1024, MC, 1024, DM);
            post_gate<<<MC * 1024 / 256, 256, 0, stream>>>(tmp, gate_bias, gb, br * 1024, m0, MC);
        }
    }
    if (OPTP(PH_ATT)) MK(1u << PH_ATT);
    else for (int mh = 0; mh < 2; ++mh) {
        const int m0 = mh * MC;
        nattn<<<(MC / 64) * 16, 64, 0, stream>>>(qb, kb, vb, scal, tmp, m0);
        post_rms<<<MC * 8 / 256, 256, 0, stream>>>(tmp, subln_gain, on, m0, MC);
    }
    if (OPTP(PH_POOLA)) { MK(1u << PH_POOLA); MK(1u << PH_POOLG); }
    else for (int mh = 0; mh < 2; ++mh) {
        const int m0 = mh * MC;
        for (int g = 0; g < 4; ++g) { AL_POOL ap{ub + (size_t)m0 * PW, g, 0};
            ngemm<AL_POOL><<<dim3(2, MC / 64), 256, 0, stream>>>(ap, w_pool + (size_t)g * 128 * 128, 128, tmp + g * 128, 512, MC, 128, 128); }
        post_plain<<<MC * 512 / 256, 256, 0, stream>>>(tmp, mixed, 512, 0, m0, MC, 512, pool_scale);
    }
    if (OPTP(PH_G4A)) MK(1u << PH_G4A);
    else for (int mh = 0; mh < 2; ++mh) {
        const int m0 = mh * MC;
        { AL_BF16 al{on + (size_t)m0 * 1024, 1024, 0}; ngemm<AL_BF16><<<dim3(16, MC / 64), 256, 0, stream>>>(al, w_branch_a, 1024, tmp, 1024, MC, 1024, 1024); }
        post_merge<<<MC * 1024 / 256, 256, 0, stream>>>(tmp, gb, merged, 0, m0, MC);
    }
    if (OPTP(PH_G4B)) MK(1u << PH_G4B);
    else for (int mh = 0; mh < 2; ++mh) {
        const int m0 = mh * MC;
        { AL_BF16 al{mixed + (size_t)m0 * 512, 512, 0}; ngemm<AL_BF16><<<dim3(16, MC / 64), 256, 0, stream>>>(al, w_branch_b, 1024, tmp, 1024, MC, 1024, 512); }
        post_merge<<<MC * 1024 / 256, 256, 0, stream>>>(tmp, gb, merged, 1, m0, MC);
    }
    if (OPTP(PH_G5)) MK(1u << PH_G5);
    else for (int mh = 0; mh < 2; ++mh) {
        const int m0 = mh * MC;
        { AL_BF16 al{merged + (size_t)m0 * 1024, 1024, 0}; ngemm<AL_BF16><<<dim3(16, MC / 64), 256, 0, stream>>>(al, w_out, 1024, tmp, 1024, MC, 1024, 1024); }
        post_y<<<MC * 1024 / 256, 256, 0, stream>>>(tmp, x, out, m0, MC);
    }
    if (OPTP(PH_ROUTER)) MK(1u << PH_ROUTER); else k_router<<<T / 4, 256, 0, stream>>>(out, ln1_g, ln1_b, wrg, brg, wre, bre, x1b, stats, rexp, rw, list, cnt);
    if (OPTP(PH_G7)) MK(1u << PH_G7); else nmoe_gu<<<dim3(8, T / 64, NE), 256, 0, stream>>>(x1b, list, cnt, wgu, hb);
    if (OPTP(PH_G8)) MK(1u << PH_G8); else nmoe_dn<<<dim3(16, T / 64, NE), 256, 0, stream>>>(hb, list, cnt, rw, wdn, ybuf);
    if (OPTP(PH_FINAL)) MK(1u << PH_FINAL); else k_final<<<T / 4, 256, 0, stream>>>(out, stats, ln1_g, ln1_b, ybuf, ln2_g, ln2_b);
#undef MK
}
```

```cpp
#include <hip/hip_runtime.h>
#include <cstdio>
#include <cstdint>
#include <cmath>

typedef unsigned short bf16_t;
typedef float f32x4 __attribute__((ext_vector_type(4)));

constexpr int NB = 16, SEQ = 2048, DM = 1024, T = NB * SEQ;
constexpr int NHEAD = 8, HD = 64, NHM = 16;
constexpr int INW = 5632;
constexpr int PW = 512, PG = 4, PGD = 128;
constexpr int NE = 32, NGRP = 4, EPG = 8, FF = 512;
constexpr float LN_EPS = 1e-5f, RMS_EPS = 1e-5f;
constexpr float ALPHA = 1.189207115002721f;
constexpr float LAMBDA_INIT = 0.2f;
constexpr float QSCALE = 0.125f * 1.4426950408889634f;

constexpr size_t MiB = 1u << 20;
constexpr size_t WS_WT    = 0;
constexpr size_t WS_XB    = 112 * MiB;
constexpr size_t WS_ON    = 112 * MiB;
constexpr size_t WS_YBUF  = 112 * MiB;
constexpr size_t WS_Q     = 176 * MiB;
constexpr size_t WS_MERGED= 176 * MiB;
constexpr size_t WS_K     = 240 * MiB;
constexpr size_t WS_X1B   = 240 * MiB;
constexpr size_t WS_V     = 304 * MiB;
constexpr size_t WS_H     = 304 * MiB;
constexpr size_t WS_U     = 368 * MiB;
constexpr size_t WS_MIXED = 400 * MiB;
constexpr size_t WS_ROPE  = 432 * MiB;
constexpr size_t WS_MISC  = 440 * MiB;
constexpr size_t WS_TEMP  = 448 * MiB;
constexpr size_t WS_END   = 512 * MiB;
constexpr size_t MS_CTL   = 0;
constexpr size_t MS_STATS = 64 * 1024;
constexpr size_t MS_ROUTE = 512 * 1024;
constexpr size_t MS_LIST  = 1 * MiB;
constexpr size_t MS_SCAL  = 6 * MiB;

__device__ __forceinline__ float bf2f(bf16_t v) { return __uint_as_float((unsigned)v << 16); }
__device__ __forceinline__ bf16_t f2bf(float f) { unsigned u = __float_as_uint(f); return (bf16_t)((u + 0x7fffu + ((u >> 16) & 1u)) >> 16); }
__host__ __device__ __forceinline__ int qk_pos_of_d(int d) { return ((d >> 4) & 1) * 32 + ((d >> 2) & 3) * 8 + (d >> 5) * 4 + (d & 3); }

struct AL_F32  { const float* p; int ld; int pad;  __device__ __forceinline__ float operator()(int r, int k) const { return p[(size_t)r * ld + k]; } };
struct AL_BF16 { const bf16_t* p; int ld; int pad; __device__ __forceinline__ float operator()(int r, int k) const { return bf2f(p[(size_t)r * ld + k]); } };
struct AL_POOL { const bf16_t* u; int g; int pad;
    __device__ __forceinline__ float operator()(int r, int k) const {
        const int w = 2 << g, s = r & (SEQ - 1); const int n = (s + 1 < w) ? s + 1 : w; float acc = 0.f;
        for (int i = 0; i < n; ++i) acc += bf2f(u[(size_t)(r - i) * PW + g * PGD + k]);
        return acc / (float)n - bf2f(u[(size_t)r * PW + g * PGD + k]); } };

template <class AL>
__global__ __launch_bounds__(256) void ngemm(AL al, const float* __restrict__ Bm, int ldb, float* __restrict__ C, int ldc, int M, int N, int K) {
    __shared__ float As[16][68]; __shared__ float Bs[16][68];
    const int tid = threadIdx.x, tx = tid & 15, ty = tid >> 4; const int m0 = blockIdx.y * 64, n0 = blockIdx.x * 64;
    float acc[4][4] = {};
    for (int k0 = 0; k0 < K; k0 += 16) {
#pragma unroll
        for (int i = 0; i < 4; ++i) { const int e = tid + i * 256; const int r = e >> 4, kk = e & 15; As[kk][r] = (m0 + r < M) ? al(m0 + r, k0 + kk) : 0.f; }
#pragma unroll
        for (int i = 0; i < 4; ++i) { const int e = tid + i * 256; const int kk = e >> 6, c = e & 63; Bs[kk][c] = (n0 + c < N) ? Bm[(size_t)(k0 + kk) * ldb + n0 + c] : 0.f; }
        __syncthreads();
#pragma unroll
        for (int kk = 0; kk < 16; ++kk) { float a[4], b[4];
#pragma unroll
            for (int i = 0; i < 4; ++i) { a[i] = As[kk][ty * 4 + i]; b[i] = Bs[kk][tx * 4 + i]; }
#pragma unroll
            for (int i = 0; i < 4; ++i)
#pragma unroll
                for (int j = 0; j < 4; ++j) acc[i][j] = fmaf(a[i], b[j], acc[i][j]); }
        __syncthreads();
    }
#pragma unroll
    for (int i = 0; i < 4; ++i)
#pragma unroll
        for (int j = 0; j < 4; ++j) { const int r = m0 + ty * 4 + i, c = n0 + tx * 4 + j; if (r < M && c < N) C[(size_t)r * ldc + c] = acc[i][j]; }
}

__global__ void k_prep(const int* __restrict__ positions, const float* __restrict__ lam_vecs, float2* __restrict__ rope, float* __restrict__ scal, unsigned* __restrict__ ctl) {
    const int gid = blockIdx.x * blockDim.x + threadIdx.x;
    if (gid < T * 32) { const int t = gid >> 5, i = gid & 31;
        const float inv = powf(10000.0f, -(float)i * (2.0f / 64.0f)); const float ang = (float)positions[t] * inv;
        const double a = (double)ang; rope[gid] = make_float2((float)cos(a), (float)sin(a)); }
    if (gid < 16384) ctl[gid] = 0u;
    if (gid == 0) { float s01 = 0.f, s23 = 0.f; for (int i = 0; i < 64; ++i) { s01 += lam_vecs[i] * lam_vecs[64 + i]; s23 += lam_vecs[128 + i] * lam_vecs[192 + i]; }
        scal[0] = expf(s01) - expf(s23) + LAMBDA_INIT; }
}
__global__ void post_qk(const float* __restrict__ tmp, const float2* __restrict__ rope, bf16_t* __restrict__ out, int m0, int Mc, float scale) {
    const int gid = blockIdx.x * blockDim.x + threadIdx.x; if (gid >= Mc * 512) return;
    const int r = gid >> 9, p = gid & 511, hm = p >> 5, i = p & 31; const int t = m0 + r;
    const float t1 = tmp[(size_t)r * 1024 + hm * 64 + i], t2 = tmp[(size_t)r * 1024 + hm * 64 + i + 32]; const float2 cs = rope[t * 32 + i];
    out[(size_t)t * 1024 + hm * 64 + qk_pos_of_d(i)] = f2bf((t1 * cs.x - t2 * cs.y) * scale);
    out[(size_t)t * 1024 + hm * 64 + qk_pos_of_d(i + 32)] = f2bf((t2 * cs.x + t1 * cs.y) * scale);
}
__global__ void post_plain(const float* __restrict__ tmp, bf16_t* __restrict__ out, int ldo, int coloff, int m0, int Mc, int N, const float* __restrict__ colscale) {
    const int gid = blockIdx.x * blockDim.x + threadIdx.x; if (gid >= Mc * N) return;
    const int r = gid / N, c = gid % N; float v = tmp[(size_t)r * N + c]; if (colscale) v *= colscale[c];
    out[(size_t)(m0 + r) * ldo + coloff + c] = f2bf(v);
}
__global__ void post_gate(const float* __restrict__ tmp, const float* __restrict__ bias, bf16_t* __restrict__ gates, int coloff, int m0, int Mc) {
    const int gid = blockIdx.x * blockDim.x + threadIdx.x; if (gid >= Mc * 1024) return;
    const int r = gid >> 10, c = gid & 1023; const float v = tmp[(size_t)r * 1024 + c] + bias[coloff + c];
    gates[(size_t)(m0 + r) * 2048 + coloff + c] = f2bf(1.f / (1.f + expf(-v)));
}
__global__ __launch_bounds__(64) void nattn(const bf16_t* __restrict__ q, const bf16_t* __restrict__ k, const bf16_t* __restrict__ v, const float* __restrict__ scal, float* __restrict__ tmp, int m0) {
    const int lane = threadIdx.x; const int blk = blockIdx.x;
    const int half = blk & 1, head = (blk >> 1) & 7, cg = blk >> 4; const int t0 = m0 + cg * 64, t = t0 + lane; const int b = t0 / SEQ, s0 = t0 % SEQ; const int nkeys = ((s0 >> 6) + 1) * 64;
    const float lam = scal[0];
    float res[64];
    for (int mp = 0; mp < 2; ++mp) {
        const int hm = head * 2 + mp; float qv[64];
#pragma unroll
        for (int d = 0; d < 64; ++d) qv[d] = bf2f(q[(size_t)t * 1024 + hm * 64 + d]);
        float mx = -1e30f, l = 0.f; float o[64];
#pragma unroll
        for (int d = 0; d < 64; ++d) o[d] = 0.f;
        for (int j = 0; j < nkeys; ++j) { const size_t kr = (size_t)(b * SEQ + j) * 1024; float sc = 0.f;
            const uint4* kp = (const uint4*)(k + kr + hm * 64); const uint4* vp = (const uint4*)(v + kr + head * 128 + half * 64);
#pragma unroll
            for (int c = 0; c < 8; ++c) { const uint4 w = kp[c]; const unsigned ww[4] = {w.x, w.y, w.z, w.w};
#pragma unroll
                for (int e = 0; e < 4; ++e) { sc = fmaf(qv[c * 8 + 2 * e], __uint_as_float(ww[e] << 16), sc); sc = fmaf(qv[c * 8 + 2 * e + 1], __uint_as_float(ww[e] & 0xffff0000u), sc); } }
            const float mn = fmaxf(mx, sc), al = exp2f(mx - mn), p = exp2f(sc - mn); mx = mn; l = l * al + p;
#pragma unroll
            for (int c = 0; c < 8; ++c) { const uint4 w = vp[c]; const unsigned ww[4] = {w.x, w.y, w.z, w.w};
#pragma unroll
                for (int e = 0; e < 4; ++e) { o[c * 8 + 2 * e] = fmaf(p, __uint_as_float(ww[e] << 16), o[c * 8 + 2 * e] * al); o[c * 8 + 2 * e + 1] = fmaf(p, __uint_as_float(ww[e] & 0xffff0000u), o[c * 8 + 2 * e + 1] * al); } } }
        const float il = 1.f / l;
#pragma unroll
        for (int d = 0; d < 64; ++d) res[d] = (mp == 0) ? o[d] * il : res[d] - lam * o[d] * il;
    }
#pragma unroll
    for (int d = 0; d < 64; ++d) tmp[(size_t)(t - m0) * 1024 + head * 128 + half * 64 + d] = res[d];
}
__global__ void post_rms(const float* __restrict__ tmp, const float* __restrict__ gain, bf16_t* __restrict__ on, int m0, int Mc) {
    const int gid = blockIdx.x * blockDim.x + threadIdx.x; if (gid >= Mc * 8) return;
    const int r = gid >> 3, head = gid & 7; const float* p = tmp + (size_t)r * 1024 + head * 128; float ss = 0.f;
    for (int d = 0; d < 128; ++d) ss += p[d] * p[d];
    const float rs = 1.0f / sqrtf(ss * (1.f / 128.f) + RMS_EPS);
    for (int d = 0; d < 128; ++d) on[(size_t)(m0 + r) * 1024 + head * 128 + d] = f2bf(p[d] * rs * gain[d] * (1.f - LAMBDA_INIT));
}
__global__ void post_merge(const float* __restrict__ tmp, const bf16_t* __restrict__ gates, bf16_t* __restrict__ merged, int br, int m0, int Mc) {
    const int gid = blockIdx.x * blockDim.x + threadIdx.x; if (gid >= Mc * 1024) return;
    const int r = gid >> 10, c = gid & 1023; const size_t t = m0 + r; const float g = bf2f(gates[t * 2048 + br * 1024 + c]);
    float val = g * tmp[(size_t)r * 1024 + c]; if (br) val += bf2f(merged[t * 1024 + c]);
    merged[t * 1024 + c] = f2bf(val);
}
__global__ void post_y(const float* __restrict__ tmp, const float* __restrict__ x, float* __restrict__ y, int m0, int Mc) {
    const int gid = blockIdx.x * blockDim.x + threadIdx.x; if (gid >= Mc * 1024) return;
    const size_t o = (size_t)m0 * 1024 + gid; y[o] = ALPHA * x[o] + tmp[gid];
}
__device__ __forceinline__ float wave_sum(float v) {
#pragma unroll
    for (int o = 1; o < 64; o <<= 1) v += __shfl_xor(v, o);
    return v;
}
__global__ __launch_bounds__(256) void k_router(const float* __restrict__ y, const float* __restrict__ g1, const float* __restrict__ b1, const float* __restrict__ wrg, const float* __restrict__ brg,
                                                const float* __restrict__ wre, const float* __restrict__ bre, bf16_t* __restrict__ x1b, float2* __restrict__ stats, int2* __restrict__ rexp, float2* __restrict__ rw,
                                                int* __restrict__ list, unsigned* __restrict__ cnt) {
    const int lane = threadIdx.x & 63; const int t = blockIdx.x * 4 + (threadIdx.x >> 6);
    const float* yr = y + (size_t)t * 1024; float xv[16]; float s = 0.f;
#pragma unroll
    for (int j = 0; j < 4; ++j) { const f32x4 vv = *(const f32x4*)(yr + j * 256 + lane * 4); xv[4 * j] = vv.x; xv[4 * j + 1] = vv.y; xv[4 * j + 2] = vv.z; xv[4 * j + 3] = vv.w; s += (vv.x + vv.y) + (vv.z + vv.w); }
    const float mu = wave_sum(s) * (1.f / 1024.f); float s2 = 0.f;
#pragma unroll
    for (int i = 0; i < 16; ++i) { const float d = xv[i] - mu; s2 += d * d; }
    const float rstd = 1.0f / sqrtf(wave_sum(s2) * (1.f / 1024.f) + LN_EPS);
    if (lane == 0) stats[t] = make_float2(mu, rstd);
#pragma unroll
    for (int j = 0; j < 4; ++j)
#pragma unroll
        for (int i = 0; i < 4; ++i) { const int c = j * 256 + lane * 4 + i; xv[4 * j + i] = (xv[4 * j + i] - mu) * rstd * g1[c] + b1[c]; }
#pragma unroll
    for (int j = 0; j < 4; ++j) { uint2 w; w.x = (unsigned)f2bf(xv[4 * j]) | ((unsigned)f2bf(xv[4 * j + 1]) << 16); w.y = (unsigned)f2bf(xv[4 * j + 2]) | ((unsigned)f2bf(xv[4 * j + 3]) << 16);
        *(uint2*)(x1b + (size_t)t * 1024 + j * 256 + lane * 4) = w; }
    float lg[4], le[32];
#pragma unroll
    for (int o = 0; o < 4; ++o) { float a = 0.f;
#pragma unroll
        for (int j = 0; j < 4; ++j)
#pragma unroll
            for (int i = 0; i < 4; ++i) a = fmaf(xv[4 * j + i], wrg[(size_t)(j * 256 + lane * 4 + i) * 4 + o], a);
        lg[o] = wave_sum(a) + brg[o]; }
#pragma unroll
    for (int o = 0; o < 32; ++o) { float a = 0.f;
#pragma unroll
        for (int j = 0; j < 4; ++j)
#pragma unroll
            for (int i = 0; i < 4; ++i) a = fmaf(xv[4 * j + i], wre[(size_t)(j * 256 + lane * 4 + i) * 32 + o], a);
        le[o] = wave_sum(a) + bre[o]; }
    if (lane == 0) {
        int gi = 0; float gm = lg[0];
#pragma unroll
        for (int o = 1; o < 4; ++o) if (lg[o] > gm) { gm = lg[o]; gi = o; }
        float gs = 0.f;
#pragma unroll
        for (int o = 0; o < 4; ++o) gs += expf(lg[o] - gm);
        const float gp = 1.f / gs;
        float ev[8];
#pragma unroll
        for (int o = 0; o < 8; ++o) { float vsel = le[o];
#pragma unroll
            for (int g = 1; g < 4; ++g) vsel = (gi == g) ? le[g * 8 + o] : vsel;
            ev[o] = vsel; }
        int i0 = 0; float m0v = ev[0];
#pragma unroll
        for (int o = 1; o < 8; ++o) if (ev[o] > m0v) { m0v = ev[o]; i0 = o; }
        int i1 = (i0 == 0) ? 1 : 0; float m1v = -3.4e38f;
#pragma unroll
        for (int o = 0; o < 8; ++o) if (o != i0 && ev[o] > m1v) { m1v = ev[o]; i1 = o; }
        const float e1 = expf(m1v - m0v); const float w0 = gp / (1.f + e1), w1 = gp * e1 / (1.f + e1);
        const int ex0 = gi * 8 + i0, ex1 = gi * 8 + i1;
        rexp[t] = make_int2(ex0, ex1); rw[t] = make_float2(w0, w1);
        const unsigned p0 = atomicAdd(&cnt[ex0], 1u); list[(size_t)ex0 * T + p0] = t * 2;
        const unsigned p1 = atomicAdd(&cnt[ex1], 1u); list[(size_t)ex1 * T + p1] = t * 2 + 1;
    }
}
__global__ __launch_bounds__(256) void nmoe_gu(const bf16_t* __restrict__ x1b, const int* __restrict__ list, const unsigned* __restrict__ cnt, const float* __restrict__ wgu, bf16_t* __restrict__ h) {
    __shared__ float As[16][68]; __shared__ float Bg[16][68]; __shared__ float Bu[16][68]; __shared__ int toks[64];
    const int e = blockIdx.z; const int M = (int)cnt[e]; const int m0 = blockIdx.y * 64, n0 = blockIdx.x * 64; if (m0 >= M) return;
    int tb = 0; for (int i = 0; i < e; ++i) tb += ((int)cnt[i] + 255) >> 8;
    const int tid = threadIdx.x, tx = tid & 15, ty = tid >> 4;
    if (tid < 64) toks[tid] = (m0 + tid < M) ? (list[(size_t)e * T + m0 + tid] >> 1) : 0;
    __syncthreads();
    const float* W = wgu + (size_t)e * 1024 * 1024; float ag[4][4] = {}, au[4][4] = {};
    for (int k0 = 0; k0 < 1024; k0 += 16) {
#pragma unroll
        for (int i = 0; i < 4; ++i) { const int el = tid + i * 256; const int r = el >> 4, kk = el & 15; As[kk][r] = bf2f(x1b[(size_t)toks[r] * 1024 + k0 + kk]); }
#pragma unroll
        for (int i = 0; i < 4; ++i) { const int el = tid + i * 256; const int kk = el >> 6, c = el & 63; Bg[kk][c] = W[(size_t)(k0 + kk) * 1024 + n0 + c]; Bu[kk][c] = W[(size_t)(k0 + kk) * 1024 + 512 + n0 + c]; }
        __syncthreads();
#pragma unroll
        for (int kk = 0; kk < 16; ++kk) { float a[4], bg[4], bu[4];
#pragma unroll
            for (int i = 0; i < 4; ++i) { a[i] = As[kk][ty * 4 + i]; bg[i] = Bg[kk][tx * 4 + i]; bu[i] = Bu[kk][tx * 4 + i]; }
#pragma unroll
            for (int i = 0; i < 4; ++i)
#pragma unroll
                for (int j = 0; j < 4; ++j) { ag[i][j] = fmaf(a[i], bg[j], ag[i][j]); au[i][j] = fmaf(a[i], bu[j], au[i][j]); } }
        __syncthreads();
    }
#pragma unroll
    for (int i = 0; i < 4; ++i)
#pragma unroll
        for (int j = 0; j < 4; ++j) { const int r = m0 + ty * 4 + i, c = n0 + tx * 4 + j; if (r < M) { const float g = ag[i][j]; h[((size_t)tb * 256 + r) * 512 + c] = f2bf(g / (1.f + expf(-g)) * au[i][j]); } }
}
__global__ __launch_bounds__(256) void nmoe_dn(const bf16_t* __restrict__ h, const int* __restrict__ list, const unsigned* __restrict__ cnt, const float2* __restrict__ rw, const float* __restrict__ wdn, bf16_t* __restrict__ ybuf) {
    __shared__ float As[16][68]; __shared__ float Bs[16][68];
    const int e = blockIdx.z; const int M = (int)cnt[e]; const int m0 = blockIdx.y * 64, n0 = blockIdx.x * 64; if (m0 >= M) return;
    int tb = 0; for (int i = 0; i < e; ++i) tb += ((int)cnt[i] + 255) >> 8;
    const int tid = threadIdx.x, tx = tid & 15, ty = tid >> 4;
    const float* W = wdn + (size_t)e * 512 * 1024; float acc[4][4] = {};
    for (int k0 = 0; k0 < 512; k0 += 16) {
#pragma unroll
        for (int i = 0; i < 4; ++i) { const int el = tid + i * 256; const int r = el >> 4, kk = el & 15; As[kk][r] = (m0 + r < M) ? bf2f(h[((size_t)tb * 256 + m0 + r) * 512 + k0 + kk]) : 0.f; }
#pragma unroll
        for (int i = 0; i < 4; ++i) { const int el = tid + i * 256; const int kk = el >> 6, c = el & 63; Bs[kk][c] = W[(size_t)(k0 + kk) * 1024 + n0 + c]; }
        __syncthreads();
#pragma unroll
        for (int kk = 0; kk < 16; ++kk) { float a[4], b[4];
#pragma unroll
            for (int i = 0; i < 4; ++i) { a[i] = As[kk][ty * 4 + i]; b[i] = Bs[kk][tx * 4 + i]; }
#pragma unroll
            for (int i = 0; i < 4; ++i)
#pragma unroll
                for (int j = 0; j < 4; ++j) acc[i][j] = fmaf(a[i], b[j], acc[i][j]); }
        __syncthreads();
    }
#pragma unroll
    for (int i = 0; i < 4; ++i) { const int r = m0 + ty * 4 + i; if (r < M) { const int ent = list[(size_t)e * T + r]; const float2 w2 = rw[ent >> 1]; const float w = (ent & 1) ? w2.y : w2.x;
#pragma unroll
        for (int j = 0; j < 4; ++j) ybuf[(size_t)ent * 1024 + n0 + tx * 4 + j] = f2bf(w * acc[i][j]); } }
}
__global__ __launch_bounds__(256) void k_final(float* __restrict__ yout, const float2* __restrict__ stats, const float* __restrict__ g1, const float* __restrict__ b1, const bf16_t* __restrict__ ybuf,
                                               const float* __restrict__ g2, const float* __restrict__ b2) {
    const int lane = threadIdx.x & 63; const int t = blockIdx.x * 4 + (threadIdx.x >> 6);
    float* yr = yout + (size_t)t * 1024; const float2 st = stats[t]; float xv[16]; float s = 0.f;
#pragma unroll
    for (int j = 0; j < 4; ++j) { const int c0 = j * 256 + lane * 4; const f32x4 vv = *(const f32x4*)(yr + c0); const f32x4 gg = *(const f32x4*)(g1 + c0); const f32x4 bb = *(const f32x4*)(b1 + c0);
        const uint2 a = *(const uint2*)(ybuf + (size_t)(2 * t) * 1024 + c0); const uint2 b = *(const uint2*)(ybuf + (size_t)(2 * t + 1) * 1024 + c0);
        const float ya[4] = {__uint_as_float(a.x << 16), __uint_as_float(a.x & 0xffff0000u), __uint_as_float(a.y << 16), __uint_as_float(a.y & 0xffff0000u)};
        const float yb[4] = {__uint_as_float(b.x << 16), __uint_as_float(b.x & 0xffff0000u), __uint_as_float(b.y << 16), __uint_as_float(b.y & 0xffff0000u)};
#pragma unroll
        for (int i = 0; i < 4; ++i) { const float x1 = (vv[i] - st.x) * st.y * gg[i] + bb[i]; const float val = ALPHA * x1 + (ya[i] + yb[i]); xv[4 * j + i] = val; s += val; } }
    const float mu = wave_sum(s) * (1.f / 1024.f); float s2 = 0.f;
#pragma unroll
    for (int i = 0; i < 16; ++i) { const float d = xv[i] - mu; s2 += d * d; }
    const float rstd = 1.0f / sqrtf(wave_sum(s2) * (1.f / 1024.f) + LN_EPS);
#pragma unroll
    for (int j = 0; j < 4; ++j) { const int c0 = j * 256 + lane * 4; const f32x4 gg = *(const f32x4*)(g2 + c0); const f32x4 bb = *(const f32x4*)(b2 + c0); f32x4 o;
#pragma unroll
        for (int i = 0; i < 4; ++i) o[i] = (xv[4 * j + i] - mu) * rstd * gg[i] + bb[i];
        *(f32x4*)(yr + c0) = o; }
}

#define LAS __attribute__((address_space(3)))
#define GAS __attribute__((address_space(1)))
typedef short bf16x8 __attribute__((ext_vector_type(8)));
typedef unsigned u32x4 __attribute__((ext_vector_type(4)));
typedef unsigned u32x2 __attribute__((ext_vector_type(2)));
typedef GAS unsigned gu32;
#define RLX_AGENT __ATOMIC_RELAXED, __HIP_MEMORY_SCOPE_AGENT
#define LDS_WAIT() asm volatile("s_waitcnt lgkmcnt(0)" ::: "memory")
#define VM_WAIT() asm volatile("s_waitcnt vmcnt(0)" ::: "memory")

constexpr size_t WT_IN = 0;
constexpr size_t WT_A  = WT_IN + (size_t)INW * 1024;
constexpr size_t WT_B  = WT_A + 1024 * 1024;
constexpr size_t WT_O  = WT_B + 1024 * 512;
constexpr size_t WT_GU = WT_O + 1024 * 1024;
constexpr size_t WT_DN = WT_GU + (size_t)NE * 1024 * 1024;
constexpr size_t WT_END = WT_DN + (size_t)NE * 1024 * 512;
static_assert(WT_END * 2 <= 112 * MiB, "weight copies fit");
constexpr size_t MS_WPOOL = 7 * MiB;
constexpr size_t MS_WP = 7 * MiB + 512 * 1024;
constexpr size_t MS_CSBW = 6 * MiB + 1024;
constexpr size_t WS_POOLED = 448 * MiB;

constexpr int CW_CNT = 0;
constexpr int CW_BAR = 1024;
constexpr int CW_TDONE = 12288;

constexpr int NWAVES = 8, NTHREADS = 512;
constexpr int RING_BYTES = 131072, LDS_CTL_OFF = 147456, MISC_OFF = LDS_CTL_OFF + 320, LDS_BYTES = 163840;

typedef float f32x2_t __attribute__((ext_vector_type(2))); typedef __bf16 bf16x2_t __attribute__((ext_vector_type(2)));
__device__ __forceinline__ unsigned cvt_pk_bf16(float lo, float hi) { f32x2_t v = {lo, hi}; bf16x2_t b = __builtin_convertvector(v, bf16x2_t); return __builtin_bit_cast(unsigned, b); }
__device__ __forceinline__ float bflo(unsigned w) { return __uint_as_float(w << 16); }
__device__ __forceinline__ float bfhi(unsigned w) { return __uint_as_float(w & 0xffff0000u); }

#define XB_TMO      128
#define XB_XCNT(j)  (256  + 64 * (j))
#define XB_XSUB(j)  (1280 + 64 * (j))
#define XB_XGEN(j)  (2304 + 64 * (j))
#define XB_TOP      3328
#define XB_TOPGEN   3392
#define XCD_BAR_WORDS 3456
#define XB_SPIN_CAP (1u << 22)
__device__ __forceinline__ unsigned xb_ld(unsigned* p)              { return __hip_atomic_load(p, __ATOMIC_RELAXED, __HIP_MEMORY_SCOPE_AGENT); }
__device__ __forceinline__ unsigned xb_add(unsigned* p, unsigned v) { return __hip_atomic_fetch_add(p, v, __ATOMIC_RELAXED, __HIP_MEMORY_SCOPE_AGENT); }
__device__ __forceinline__ unsigned xb_xcc_id() { return (unsigned)__builtin_amdgcn_s_getreg((3 << 11) | 20) & 0xFu; }
#define XB_SPIN(cond, bar) do { unsigned _sp = 0; while (cond) { __builtin_amdgcn_s_sleep(1); \
    if ((++_sp & 255u) == 0u) { if (xb_ld(&(bar)[XB_TMO])) break; if (_sp > XB_SPIN_CAP) { atomicAdd(&(bar)[XB_TMO], 1u); break; } } } } while (0)
struct XcdBarrier { unsigned* bar; unsigned x; volatile LAS unsigned* st; };
__device__ __forceinline__ XcdBarrier xcd_barrier_post(unsigned* bar, volatile LAS unsigned* st) {
    XcdBarrier b; b.bar = bar; b.x = xb_xcc_id(); b.st = st;
    if (threadIdx.x == 0) (void)xb_add(&bar[XB_XCNT(b.x)], 1u);
    return b;
}
__device__ __forceinline__ void xcd_barrier_complete(unsigned* bar, unsigned x, unsigned& nloc, unsigned& nx) {
    const unsigned G = gridDim.x * gridDim.y * gridDim.z;
    unsigned sum, cnt, mine, sp = 0u;
    for (;;) {
        sum = 0u; cnt = 0u; mine = 0u;
#pragma unroll
        for (unsigned j = 0; j < 16; ++j) { const unsigned c = xb_ld(&bar[XB_XCNT(j)]); sum += c; cnt += (c > 0u) ? 1u : 0u; mine = (j == x) ? c : mine; }
        if (sum == G) break;
        __builtin_amdgcn_s_sleep(1);
        if ((++sp & 255u) == 0u) { if (xb_ld(&bar[XB_TMO])) break; if (sp > XB_SPIN_CAP) { atomicAdd(&bar[XB_TMO], 1u); break; } }
    }
    nloc = mine > 0u ? mine : 1u; nx = cnt > 0u ? cnt : 1u;
}
__device__ __forceinline__ void xcd_barrier(const XcdBarrier& b) {
    asm volatile("s_waitcnt vmcnt(0)" ::: "memory");
    __syncthreads();
    if (threadIdx.x == 0) {
        unsigned* bar = b.bar;
        __builtin_amdgcn_s_waitcnt(0);
        unsigned nloc = b.st[0], nx = b.st[1];
        if (nloc == 0u) { xcd_barrier_complete(bar, b.x, nloc, nx); b.st[0] = nloc; b.st[1] = nx; }
        const unsigned old = xb_add(&bar[XB_XSUB(b.x)], 1u);
        const unsigned gen = old / nloc;
        if (old + 1u == (gen + 1u) * nloc) {
            __builtin_amdgcn_fence(__ATOMIC_RELEASE, "agent");
            asm volatile("s_waitcnt vmcnt(0)" ::: "memory");
            const unsigned og = xb_add(&bar[XB_TOP], 1u);
            const unsigned tg = og / nx;
            if (og + 1u == (tg + 1u) * nx) xb_add(&bar[XB_TOPGEN], 1u);
            else XB_SPIN(xb_ld(&bar[XB_TOPGEN]) == tg, bar);
            __builtin_amdgcn_fence(__ATOMIC_ACQUIRE, "agent");
            xb_add(&bar[XB_XGEN(b.x)], 1u);
            asm volatile("s_waitcnt vmcnt(0)" ::: "memory");
        } else {
            XB_SPIN(xb_ld(&bar[XB_XGEN(b.x)]) == gen, bar);
            __builtin_amdgcn_fence(__ATOMIC_ACQUIRE, "agent");
            asm volatile("s_waitcnt vmcnt(0)" ::: "memory");
        }
    }
    __syncthreads();
}

namespace g8 {
constexpr int BM = 256, BK = 64, HALF = 128, HTB = HALF * BK * 2, NXCD = 8, WGM = 8;
__host__ __device__ __forceinline__ int lds_byte(int r, int c) { const int st = (r >> 4) * 2 + (c >> 5), rr = r & 15, cc = c & 31, ob = rr * 64 + cc * 2; return st * 1024 + (ob ^ (((ob >> 9) & 1) << 5)); }
__host__ __device__ __forceinline__ void stage_rc(int b, int& R, int& C) { const int st = b / 1024, sb = b % 1024, swz = sb ^ (((sb >> 9) & 1) << 5); R = (st >> 1) * 16 + swz / 64; C = (st & 1) * 32 + (swz % 64) / 2; }
__host__ __device__ __forceinline__ int perm32(int rho) { const int n = rho >> 4, i = rho & 15; return 8 * (i >> 2) + 4 * n + (i & 3); }

struct GUnit { const char* A; const char* B; int pm, pn, e, r0; };

struct DenseOrder {
    const char* Abase; const char* Bbase; int nM, nN, nwg, G, c; size_t tstep;
    __device__ void init(const void* A, const void* Bt, int M, int N, int K, int G_, int c_) { Abase = (const char*)A; Bbase = (const char*)Bt; nM = M / BM; nN = N / BM; nwg = nM * nN; G = G_; c = c_; tstep = (size_t)BM * K * 2; }
    __device__ bool next(int i, GUnit& u) const {
        const long L = (long)i * G + c; if (L >= nwg) return false;
        int wgid = (int)L; { const int q = nwg / NXCD, r = nwg % NXCD, xcd = wgid % NXCD, off = wgid / NXCD; wgid = (xcd < r ? xcd * (q + 1) : r * (q + 1) + (xcd - r) * q) + off; }
        const int nig = WGM * nN, gid = wgid / nig, fm = gid * WGM, gsz = (nM - fm) < WGM ? (nM - fm) : WGM;
        u.pm = fm + ((wgid % nig) % gsz); u.pn = (wgid % nig) / gsz; u.e = 0; u.r0 = 0;
        u.A = Abase + (size_t)u.pm * tstep; u.B = Bbase + (size_t)u.pn * tstep; return true;
    }
    __device__ __forceinline__ unsigned rowoff(const GUnit&, int) const { return 0u; }
    __device__ __forceinline__ void a_ready(const GUnit&) const {}
    __device__ __forceinline__ void done(const GUnit&) const {}
};
struct MoeOrder {
    const char* Abase; const char* Bbase; const int* list; const volatile LAS unsigned* tb; const volatile LAS unsigned* cntl; int nwg, G, c; size_t atile, bexp, btile; int gather;
    unsigned* tdone; int mode;
    __device__ bool next(int i, GUnit& u) const {
        const long L = (long)i * G + c; if (L >= nwg) return false;
        int wgid = (int)L; { const int q = nwg / NXCD, r = nwg % NXCD, xcd = wgid % NXCD, off = wgid / NXCD; wgid = (xcd < r ? xcd * (q + 1) : r * (q + 1) + (xcd - r) * q) + off; }
        const int tile = wgid >> 2; u.pn = wgid & 3; u.pm = tile;
        int e = 0; for (int j = 1; j < NE; ++j) e = ((int)tb[j] <= tile) ? j : e;
        e = __builtin_amdgcn_readfirstlane(e); u.e = e; u.r0 = __builtin_amdgcn_readfirstlane((tile - (int)tb[e]) * 256);
        u.A = gather ? Abase : Abase + (size_t)tile * atile; u.B = Bbase + (size_t)e * bexp + (size_t)u.pn * btile; return true;
    }
    __device__ __forceinline__ unsigned rowoff(const GUnit& u, int rr) const {
        const int p = u.r0 + rr; const int tok = (p < (int)cntl[u.e]) ? (list[(size_t)u.e * T + p] >> 1) : 0; return (unsigned)tok * 2048u; }
    __device__ __forceinline__ void done(const GUnit& u) const {
        if (mode == 1) { asm volatile("s_waitcnt vmcnt(0)" ::: "memory"); if ((threadIdx.x & 63) == 0) __hip_atomic_fetch_add(tdone + u.pm, 1u, __ATOMIC_RELAXED, __HIP_MEMORY_SCOPE_AGENT); } }
    __device__ __forceinline__ void a_ready(const GUnit& u) const {
        if (mode == 2) {
            if (threadIdx.x < 64) { unsigned sp = 0;
                while ((unsigned)__builtin_amdgcn_readfirstlane(__hip_atomic_load(tdone + u.pm, __ATOMIC_RELAXED, __HIP_MEMORY_SCOPE_AGENT)) < 32u) { __builtin_amdgcn_s_sleep(2); if (++sp > (1u << 22)) break; }
                __builtin_amdgcn_fence(__ATOMIC_ACQUIRE, "agent"); asm volatile("s_waitcnt vmcnt(0)" ::: "memory"); }
            asm volatile("" ::: "memory"); __builtin_amdgcn_s_barrier(); asm volatile("" ::: "memory"); } }
};

template <class Epi, class Sched, bool ALIGN_EPI, bool GATHER>
__device__ __forceinline__ void gemm_phase(LAS unsigned char* lds, const int K, const Sched& S, const Epi& E) {
    const int tid = threadIdx.x, wid = __builtin_amdgcn_readfirstlane(tid >> 6), lane = tid & 63, wr = wid >> 2, wc = wid & 3, fr = lane & 15, fq = lane >> 4;
    const int nt = K / BK;
    unsigned voffA[2], voffB[2]; int RA[2], CA[2];
#pragma unroll
    for (int i = 0; i < 2; ++i) { int R, C; stage_rc(tid * 16 + i * 8192, R, C); const int Rb = Epi::PERM ? ((R & ~31) + perm32(R & 31)) : R;
        voffA[i] = (unsigned)(R * K + C) * 2u; voffB[i] = (unsigned)(Rb * K + C) * 2u; RA[i] = R; CA[i] = C; }
    const size_t kstep = (size_t)(BK * 2);
    const size_t hstep = (size_t)HALF * K * 2;
    const unsigned ldsw = (unsigned)wid * 1024u;
    const int aoff = lds_byte(wr * 64 + fr, fq * 8), boff = lds_byte(wc * 32 + fr, fq * 8);
#define G8_SA(b, h) (((b) * 2 + (h)) * HTB)
#define G8_SB(b, h) ((4 + (b) * 2 + (h)) * HTB)
#define G8_STAGE(bufoff, gbase, o0, o1) do { \
        __builtin_amdgcn_global_load_lds((const unsigned*)((const char*)(gbase) + (o0)), (LAS unsigned*)(lds + (bufoff) + ldsw), 16, 0, 0); \
        __builtin_amdgcn_global_load_lds((const unsigned*)((const char*)(gbase) + (o1)), (LAS unsigned*)(lds + (bufoff) + ldsw + 8192), 16, 0, 0); } while (0)
#define G8_STAGE_B(bufoff, gbase) G8_STAGE(bufoff, gbase, voffB[0], voffB[1])
#define G8_LDA(dst, b, h) do { _Pragma("unroll") for (int m = 0; m < 4; ++m) _Pragma("unroll") for (int k = 0; k < 2; ++k) dst[m][k] = *(const LAS bf16x8*)(lds + G8_SA(b, h) + aoff + m * 2048 + k * 1024); } while (0)
#define G8_LDB(dst, b, h) do { _Pragma("unroll") for (int n = 0; n < 2; ++n) _Pragma("unroll") for (int k = 0; k < 2; ++k) dst[n][k] = *(const LAS bf16x8*)(lds + G8_SB(b, h) + boff + n * 2048 + k * 1024); } while (0)
#define G8_MMA(ai, bj, At, Bt) do { __builtin_amdgcn_s_setprio(1); _Pragma("unroll") for (int m = 0; m < 4; ++m) _Pragma("unroll") for (int n = 0; n < 2; ++n) _Pragma("unroll") for (int k = 0; k < 2; ++k) \
        acc[ai][bj][m][n] = __builtin_amdgcn_mfma_f32_16x16x32_bf16(Bt[n][k], At[m][k], acc[ai][bj][m][n], 0, 0, 0); __builtin_amdgcn_s_setprio(0); } while (0)
#ifdef G8_DRAIN
#define G8_WAIT_V(n) asm volatile("s_waitcnt vmcnt(0)" ::: "memory")
#else
#define G8_WAIT_V(n) asm volatile("s_waitcnt vmcnt(" #n ")" ::: "memory")
#endif
#define G8_WAIT_L(n) asm volatile("s_waitcnt lgkmcnt(" #n ")" ::: "memory")
#define G8_BAR __builtin_amdgcn_s_barrier()
#define G8_SCHED __builtin_amdgcn_sched_barrier(0)
    GUnit cur, nxt; int ui = 0;
    if (!S.next(0, cur)) return;
    unsigned cao[2][2], nao[2][2];
#pragma unroll
    for (int h = 0; h < 2; ++h)
#pragma unroll
        for (int i = 0; i < 2; ++i) { cao[h][i] = GATHER ? S.rowoff(cur, h * HALF + RA[i]) + (unsigned)CA[i] * 2u : voffA[i] + (unsigned)(h * hstep); nao[h][i] = cao[h][i]; }
    f32x4 acc[2][2][4][2];
#pragma unroll
    for (int a = 0; a < 2; ++a)
#pragma unroll
        for (int b = 0; b < 2; ++b)
#pragma unroll
            for (int m = 0; m < 4; ++m)
#pragma unroll
                for (int n = 0; n < 2; ++n) acc[a][b][m][n] = (f32x4){0.f, 0.f, 0.f, 0.f};
    bf16x8 At[4][2], B0[2][2], B1[2][2];
    const char* cA = cur.A; const char* cB = cur.B;
    S.a_ready(cur);
    G8_STAGE_B(G8_SB(0, 0), cB); G8_STAGE_B(G8_SB(0, 1), cB + hstep); G8_STAGE(G8_SA(0, 0), cA, cao[0][0], cao[0][1]); G8_STAGE(G8_SA(0, 1), cA, cao[1][0], cao[1][1]);
    if (wr == 1) G8_BAR;
    G8_WAIT_V(2); G8_BAR;
    G8_STAGE_B(G8_SB(1, 0), cB + kstep); G8_STAGE(G8_SA(1, 0), cA + kstep, cao[0][0], cao[0][1]); G8_STAGE_B(G8_SB(1, 1), cB + hstep + kstep);
    G8_WAIT_V(6); G8_BAR;
    for (;;) {
        const bool has_next = S.next(ui + 1, nxt);
        if (GATHER && has_next) {
#pragma unroll
            for (int h = 0; h < 2; ++h)
#pragma unroll
                for (int i = 0; i < 2; ++i) nao[h][i] = S.rowoff(nxt, h * HALF + RA[i]) + (unsigned)CA[i] * 2u;
        }
        const char* nA = has_next ? nxt.A : cA; const char* nB = has_next ? nxt.B : cB;
        for (int t = 0; t < nt; t += 2) {
            const bool last = (t == nt - 2);
            if (last && has_next) S.a_ready(nxt);
            const char* a1 = cA + (size_t)(t + 1) * kstep;
            const char* a2 = last ? nA : cA + (size_t)(t + 2) * kstep; const char* b2 = last ? nB : cB + (size_t)(t + 2) * kstep;
            const char* a3 = a2 + kstep; const char* b3 = b2 + kstep;
            asm volatile("" : "+s"(a1), "+s"(a2), "+s"(b2), "+s"(a3), "+s"(b3));
            unsigned o2[2][2];
#pragma unroll
            for (int h = 0; h < 2; ++h)
#pragma unroll
                for (int i = 0; i < 2; ++i) o2[h][i] = (GATHER && last && has_next) ? nao[h][i] : cao[h][i];
            G8_LDB(B0, 0, 0); G8_LDB(B1, 0, 1); G8_SCHED; G8_LDA(At, 0, 0); G8_STAGE(G8_SA(1, 1), a1, cao[1][0], cao[1][1]);
            G8_WAIT_V(8); G8_WAIT_L(0); G8_BAR; G8_MMA(0, 0, At, B0); G8_MMA(0, 1, At, B1); G8_BAR; G8_SCHED;
            G8_LDA(At, 0, 1); G8_STAGE_B(G8_SB(0, 0), b2); G8_STAGE_B(G8_SB(0, 1), b2 + hstep); G8_STAGE(G8_SA(0, 0), a2, o2[0][0], o2[0][1]);
            G8_WAIT_V(8); G8_WAIT_L(0); G8_BAR; G8_MMA(1, 0, At, B0); G8_MMA(1, 1, At, B1); G8_BAR; G8_SCHED;
            G8_LDB(B0, 1, 0); G8_LDB(B1, 1, 1); G8_SCHED; G8_LDA(At, 1, 0); G8_STAGE(G8_SA(0, 1), a2, o2[1][0], o2[1][1]);
            G8_WAIT_V(8); G8_WAIT_L(0); G8_BAR; G8_MMA(0, 0, At, B0); G8_MMA(0, 1, At, B1); G8_BAR; G8_SCHED;
            G8_LDA(At, 1, 1); G8_STAGE_B(G8_SB(1, 0), b3); G8_STAGE_B(G8_SB(1, 1), b3 + hstep); G8_STAGE(G8_SA(1, 0), a3, o2[0][0], o2[0][1]);
            G8_WAIT_V(8); G8_WAIT_L(0); G8_BAR; G8_MMA(1, 0, At, B0); G8_MMA(1, 1, At, B1); G8_BAR; G8_SCHED;
        }
        if constexpr (ALIGN_EPI) { if (wr == 0) G8_BAR; }
        {
          GUnit eu = cur; int fr_ = fr, fq_ = fq; asm volatile("" : "+s"(eu.pm), "+s"(eu.pn), "+s"(eu.e), "+s"(eu.r0)); asm volatile("" : "+v"(fr_), "+v"(fq_));
          E(acc, eu, wr, wc, fr_, fq_); S.done(cur); }
        if (!has_next) break;
#pragma unroll
        for (int a = 0; a < 2; ++a)
#pragma unroll
            for (int b = 0; b < 2; ++b)
#pragma unroll
                for (int m = 0; m < 4; ++m)
#pragma unroll
                    for (int n = 0; n < 2; ++n) acc[a][b][m][n] = (f32x4){0.f, 0.f, 0.f, 0.f};
        cur = nxt; cA = nA; cB = nB; ++ui;
#pragma unroll
        for (int h = 0; h < 2; ++h)
#pragma unroll
            for (int i = 0; i < 2; ++i) cao[h][i] = nao[h][i];
        if constexpr (ALIGN_EPI) { if (wr == 1) G8_BAR; }
    }
    G8_WAIT_V(0);
    if constexpr (!ALIGN_EPI) { if (wr == 0) G8_BAR; }
    G8_BAR;
#undef G8_SA
#undef G8_SB
#undef G8_STAGE
#undef G8_STAGE_B
#undef G8_LDA
#undef G8_LDB
#undef G8_MMA
#undef G8_WAIT_V
#undef G8_WAIT_L
#undef G8_BAR
#undef G8_SCHED
}

__device__ __forceinline__ u32x4 pack8(const f32x4 v0, const f32x4 v1) { u32x4 w; w.x = cvt_pk_bf16(v0[0], v0[1]); w.y = cvt_pk_bf16(v0[2], v0[3]); w.z = cvt_pk_bf16(v1[0], v1[1]); w.w = cvt_pk_bf16(v1[2], v1[3]); return w; }
__device__ __forceinline__ float sigmoidf_(float v) { return __builtin_amdgcn_rcpf(1.f + __builtin_amdgcn_exp2f(-1.4426950408889634f * v)); }

struct EpiProj {
    static constexpr bool PERM = true;
    bf16_t *qb, *kb, *vb, *ub, *gb; const float* rope; const float* gate_bias;
    __device__ __forceinline__ void operator()(const f32x4 (&acc)[2][2][4][2], const GUnit& u, int wr, int wc, int fr, int fq) const {
        const int row0 = u.pm * BM + wr * 64 + fr; const int cw = wc * 32 + 8 * fq; const int pn = u.pn;
#ifdef DBG_PLAIN_EPI
        if (pn < 8) { bf16_t* base = (pn < 4 ? qb : kb) + (pn & 3) * 256 + cw;
            for (int ai = 0; ai < 2; ++ai) for (int m = 0; m < 4; ++m) { const int t = row0 + ai * HALF + m * 16; for (int bj = 0; bj < 2; ++bj) *(u32x4*)(base + (size_t)t * 1024 + bj * HALF) = pack8(acc[ai][bj][m][0], acc[ai][bj][m][1]); } }
        else
#endif
        if (pn < 8) {
            bf16_t* base = (pn < 4 ? qb : kb) + (pn & 3) * 256 + cw; const float sc = pn < 4 ? QSCALE : 1.f; const int fi = 16 * (wc & 1) + 4 * fq;
#pragma unroll
            for (int ai = 0; ai < 2; ++ai)
#pragma unroll
                for (int m = 0; m < 4; ++m) { const int t = row0 + ai * HALF + m * 16; const f32x4 cs0 = *(const f32x4*)(rope + ((size_t)t * 32 + fi) * 2), cs1 = *(const f32x4*)(rope + ((size_t)t * 32 + fi) * 2 + 4);
                    const f32x4 c = {cs0[0], cs0[2], cs1[0], cs1[2]}, s = {cs0[1], cs0[3], cs1[1], cs1[3]};
#pragma unroll
                    for (int bj = 0; bj < 2; ++bj) { const f32x4 t1 = acc[ai][bj][m][0], t2 = acc[ai][bj][m][1]; const f32x4 o1 = (t1 * c - t2 * s) * sc, o2 = (t2 * c + t1 * s) * sc;
                        *(u32x4*)(base + (size_t)t * 1024 + bj * HALF) = pack8(o1, o2); } }
        } else if (pn < 14) {
            bf16_t* base; int ld; if (pn < 12) { base = vb + (pn - 8) * 256 + cw; ld = 1024; } else { base = ub + (pn - 12) * 256 + cw; ld = 512; }
#pragma unroll
            for (int ai = 0; ai < 2; ++ai)
#pragma unroll
                for (int m = 0; m < 4; ++m) { const int t = row0 + ai * HALF + m * 16;
#pragma unroll
                    for (int bj = 0; bj < 2; ++bj) *(u32x4*)(base + (size_t)t * ld + bj * HALF) = pack8(acc[ai][bj][m][0], acc[ai][bj][m][1]); }
        }
#ifdef DBG_PLAIN_EPI
        else { const int col0 = (pn - 14) * 256 + cw;
            for (int ai = 0; ai < 2; ++ai) for (int m = 0; m < 4; ++m) { const int t = row0 + ai * HALF + m * 16; for (int bj = 0; bj < 2; ++bj) *(u32x4*)(gb + (size_t)t * 2048 + col0 + bj * HALF) = pack8(acc[ai][bj][m][0], acc[ai][bj][m][1]); } }
#else
        else {
            const int col0 = (pn - 14) * 256 + cw; f32x4 bv[2][2];
#pragma unroll
            for (int bj = 0; bj < 2; ++bj)
#pragma unroll
                for (int n = 0; n < 2; ++n) bv[bj][n] = *(const f32x4*)(gate_bias + col0 + bj * HALF + 4 * n);
#pragma unroll
            for (int ai = 0; ai < 2; ++ai)
#pragma unroll
                for (int m = 0; m < 4; ++m) { const int t = row0 + ai * HALF + m * 16;
#pragma unroll
                    for (int bj = 0; bj < 2; ++bj) { f32x4 v0 = acc[ai][bj][m][0] + bv[bj][0], v1 = acc[ai][bj][m][1] + bv[bj][1];
#pragma unroll
                        for (int j = 0; j < 4; ++j) { v0[j] = sigmoidf_(v0[j]); v1[j] = sigmoidf_(v1[j]); }
                        *(u32x4*)(gb + (size_t)t * 2048 + col0 + bj * HALF) = pack8(v0, v1); } }
        }
#endif
    }
};
struct EpiScaleBf16 {
    static constexpr bool PERM = true;
    bf16_t* O; int ldc; const float* colscale;
    __device__ __forceinline__ void operator()(const f32x4 (&acc)[2][2][4][2], const GUnit& u, int wr, int wc, int fr, int fq) const {
        const int row0 = u.pm * BM + wr * 64 + fr, col0 = u.pn * BM + wc * 32 + 8 * fq; f32x4 sv[2][2];
#pragma unroll
        for (int bj = 0; bj < 2; ++bj)
#pragma unroll
            for (int n = 0; n < 2; ++n) sv[bj][n] = *(const f32x4*)(colscale + col0 + bj * HALF + 4 * n);
#pragma unroll
        for (int ai = 0; ai < 2; ++ai)
#pragma unroll
            for (int m = 0; m < 4; ++m) { bf16_t* rowp = O + (size_t)(row0 + ai * HALF + m * 16) * ldc + col0;
#pragma unroll
                for (int bj = 0; bj < 2; ++bj) *(u32x4*)(rowp + bj * HALF) = pack8(acc[ai][bj][m][0] * sv[bj][0], acc[ai][bj][m][1] * sv[bj][1]); }
    }
};
template <int BR> struct EpiMerge {
    static constexpr bool PERM = true;
    const bf16_t* gates; bf16_t* merged; bf16_t* dst;
    __device__ __forceinline__ void operator()(const f32x4 (&acc)[2][2][4][2], const GUnit& u, int wr, int wc, int fr, int fq) const {
        const int row0 = u.pm * BM + wr * 64 + fr, col0 = u.pn * BM + wc * 32 + 8 * fq;
#pragma unroll
        for (int ai = 0; ai < 2; ++ai)
#pragma unroll
            for (int m = 0; m < 4; ++m) { const size_t t = row0 + ai * HALF + m * 16;
#pragma unroll
                for (int bj = 0; bj < 2; ++bj) { const u32x4 g = *(const u32x4*)(gates + t * 2048 + BR * 1024 + col0 + bj * HALF); bf16_t* mp = merged + t * 1024 + col0 + bj * HALF;
                    f32x4 v0 = acc[ai][bj][m][0], v1 = acc[ai][bj][m][1];
                    v0 = v0 * (f32x4){bflo(g.x), bfhi(g.x), bflo(g.y), bfhi(g.y)}; v1 = v1 * (f32x4){bflo(g.z), bfhi(g.z), bflo(g.w), bfhi(g.w)};
                    if (BR) { const u32x4 p = *(const u32x4*)mp; v0 = v0 + (f32x4){bflo(p.x), bfhi(p.x), bflo(p.y), bfhi(p.y)}; v1 = v1 + (f32x4){bflo(p.z), bfhi(p.z), bflo(p.w), bfhi(p.w)}; }
                    *(u32x4*)(dst + t * 1024 + col0 + bj * HALF) = pack8(v0, v1); } }
    }
};
struct EpiResid {
    static constexpr bool PERM = false;
    const float* x; float* y; float2* part;
    __device__ __forceinline__ void operator()(const f32x4 (&acc)[2][2][4][2], const GUnit& u, int wr, int wc, int fr, int fq) const {
        const int row0 = u.pm * BM + wr * 64 + fr, col0 = u.pn * BM + wc * 32 + 4 * fq;
#pragma unroll
        for (int ai = 0; ai < 2; ++ai)
#pragma unroll
            for (int m = 0; m < 4; ++m) { const size_t row = (size_t)(row0 + ai * HALF + m * 16); const size_t off = row * 1024 + col0; float s1 = 0.f, s2 = 0.f;
#pragma unroll
                for (int bj = 0; bj < 2; ++bj)
#pragma unroll
                    for (int n = 0; n < 2; ++n) { const f32x4 xv = *(const f32x4*)(x + off + bj * HALF + n * 16); const f32x4 yv = xv * ALPHA + acc[ai][bj][m][n]; *(f32x4*)(y + off + bj * HALF + n * 16) = yv;
                        s1 += (yv[0] + yv[1]) + (yv[2] + yv[3]); s2 += (yv[0] * yv[0] + yv[1] * yv[1]) + (yv[2] * yv[2] + yv[3] * yv[3]); }
                s1 += __shfl_xor(s1, 16); s1 += __shfl_xor(s1, 32); s2 += __shfl_xor(s2, 16); s2 += __shfl_xor(s2, 32);
                if (fq == 0) part[row * 16 + u.pn * 4 + wc] = make_float2(s1, s2); }
    }
};
struct EpiGateUp {
    static constexpr bool PERM = true;
    bf16_t* h;
    __device__ __forceinline__ void operator()(const f32x4 (&acc)[2][2][4][2], const GUnit& u, int wr, int wc, int fr, int fq) const {
        const int row0 = u.pm * BM + wr * 64 + fr, col0 = u.pn * 128 + wc * 16 + 4 * fq;
#pragma unroll
        for (int ai = 0; ai < 2; ++ai)
#pragma unroll
            for (int m = 0; m < 4; ++m) { bf16_t* rowp = h + (size_t)(row0 + ai * HALF + m * 16) * 512 + col0;
#pragma unroll
                for (int bj = 0; bj < 2; ++bj) { const f32x4 g = acc[ai][bj][m][0], up = acc[ai][bj][m][1]; f32x4 o;
#pragma unroll
                    for (int j = 0; j < 4; ++j) o[j] = g[j] * sigmoidf_(g[j]) * up[j];
                    const unsigned long long w = (unsigned long long)cvt_pk_bf16(o[0], o[1]) | ((unsigned long long)cvt_pk_bf16(o[2], o[3]) << 32);
                    __hip_atomic_store((unsigned long long*)(rowp + bj * 64), w, __ATOMIC_RELAXED, __HIP_MEMORY_SCOPE_AGENT); } }
    }
};
struct EpiDown {
    static constexpr bool PERM = true;
    bf16_t* ybuf; const int* list; const float* rw; const volatile LAS unsigned* cntl;
    __device__ __forceinline__ void operator()(const f32x4 (&acc)[2][2][4][2], const GUnit& u, int wr, int wc, int fr, int fq) const {
        const int p0 = u.r0 + wr * 64 + fr, col0 = u.pn * BM + wc * 32 + 8 * fq; const int cn = (int)cntl[u.e];
#pragma unroll
        for (int ai = 0; ai < 2; ++ai)
#pragma unroll
            for (int m = 0; m < 4; ++m) { const int p = p0 + ai * HALF + m * 16;
                if (p < cn) { const int ent = list[(size_t)u.e * T + p]; const float w = rw[ent]; bf16_t* rowp = ybuf + (size_t)ent * 1024 + col0;
#pragma unroll
                    for (int bj = 0; bj < 2; ++bj) *(u32x4*)(rowp + bj * HALF) = pack8(acc[ai][bj][m][0] * w, acc[ai][bj][m][1] * w); } }
    }
};
}

namespace at2 {
using f32x16 = __attribute__((ext_vector_type(16))) float;
using s16x4  = __attribute__((ext_vector_type(4))) short;
constexpr int KB_BYTES = 8192, VB_BYTES = 16384, KSLOT = 2 * KB_BYTES, NKS = 4, NVS = 3, OFF_V = NKS * KSLOT;
constexpr int OFF_Q = OFF_V + NVS * VB_BYTES, OFF_WS = 151552;
#define AT_SBAR() __builtin_amdgcn_sched_barrier(0)
__device__ __forceinline__ int crow(int r, int hi) { return (r & 3) + 8 * (r >> 2) + 4 * hi; }
__device__ __forceinline__ int v_st(int k, int c) { const int kk = (k & ~0xC) | ((k & 4) << 1) | ((k & 8) >> 1); return ((kk >> 3) * 4 + (c >> 5)) * 512 + ((kk & 7) * 32 + (c & 31)) * 2; }
__device__ __forceinline__ int v_rd_base(int lane) { return ((lane & 3) << 3) | (((lane >> 2) & 3) << 6) | (((lane >> 4) & 1) << 5) | (((lane >> 5) & 1) << 8); }
constexpr int v_rd_off(int d0, int ks, int half) { return d0 * 512 + ks * 4096 + half * 2048; }
template <int OFF> __device__ __forceinline__ s16x4 tr_read(int vb) { s16x4 r; asm volatile("ds_read_b64_tr_b16 %0, %1 offset:%2" : "=&v"(r) : "v"(vb), "i"(OFF) : "memory"); return r; }
template <int D0> __device__ __forceinline__ void pv_one(f32x16& od, int vb, bf16x8 pa0, bf16x8 pa1, bf16x8 pa2, bf16x8 pa3) {
    const s16x4 l0 = tr_read<v_rd_off(D0, 0, 0)>(vb), h0 = tr_read<v_rd_off(D0, 0, 1)>(vb), l1 = tr_read<v_rd_off(D0, 1, 0)>(vb), h1 = tr_read<v_rd_off(D0, 1, 1)>(vb);
    const s16x4 l2 = tr_read<v_rd_off(D0, 2, 0)>(vb), h2 = tr_read<v_rd_off(D0, 2, 1)>(vb), l3 = tr_read<v_rd_off(D0, 3, 0)>(vb), h3 = tr_read<v_rd_off(D0, 3, 1)>(vb);
    asm volatile("s_waitcnt lgkmcnt(0)" ::: "memory"); AT_SBAR();
#define AT_PK(L, H) (bf16x8){L[0], L[1], L[2], L[3], H[0], H[1], H[2], H[3]}
    od = __builtin_amdgcn_mfma_f32_32x32x16_bf16(pa0, AT_PK(l0, h0), od, 0, 0, 0);
    od = __builtin_amdgcn_mfma_f32_32x32x16_bf16(pa1, AT_PK(l1, h1), od, 0, 0, 0);
    od = __builtin_amdgcn_mfma_f32_32x32x16_bf16(pa2, AT_PK(l2, h2), od, 0, 0, 0);
    od = __builtin_amdgcn_mfma_f32_32x32x16_bf16(pa3, AT_PK(l3, h3), od, 0, 0, 0);
#undef AT_PK
}
__device__ __forceinline__ void qkt(f32x16& p0, f32x16& p1, const LAS unsigned char* Ks, const bf16x8* qr, int r32, int hi) {
    p0 = f32x16{}; p1 = f32x16{};
#pragma unroll
    for (int d0 = 0; d0 < 4; ++d0) { const LAS unsigned char* kp = Ks + (2 * d0 + hi) * 1024 + r32 * 16;
        const bf16x8 b0 = *(const LAS bf16x8*)(kp), b1 = *(const LAS bf16x8*)(kp + 512);
        p0 = __builtin_amdgcn_mfma_f32_32x32x16_bf16(b0, qr[d0], p0, 0, 0, 0);
        p1 = __builtin_amdgcn_mfma_f32_32x32x16_bf16(b1, qr[d0], p1, 0, 0, 0); }
}
__device__ __forceinline__ float hswap_max(float v) { auto rr = __builtin_amdgcn_permlane32_swap(__float_as_uint(v), __float_as_uint(v), false, false); return fmaxf(__uint_as_float(rr[0]), __uint_as_float(rr[1])); }
__device__ __forceinline__ float hswap_sum(float v) { auto rr = __builtin_amdgcn_permlane32_swap(__float_as_uint(v), __float_as_uint(v), false, false); return __uint_as_float(rr[0]) + __uint_as_float(rr[1]); }

struct AtUnit { int b, head, qblk; };
struct AtAddr { const char* Kb; const char* Vb; unsigned kofs0, kofs1, vofs0, vofs1; };
__device__ __forceinline__ void at_addr(AtAddr& a, const AtUnit& un, int wid, int lane, const bf16_t* __restrict__ K, const bf16_t* __restrict__ V) {
    const int mp = wid >> 2, wq = wid & 3, hm = un.head * 2 + mp; const size_t rowbase = (size_t)un.b * SEQ;
    a.Kb = (const char*)(K + rowbase * 1024); a.Vb = (const char*)(V + rowbase * 1024);
    unsigned ko[2], vo[2];
#pragma unroll
    for (int i = 0; i < 2; ++i) { const int ch = 2 * wq + i; ko[i] = (unsigned)(lane * 2048 + hm * 128 + ch * 16);
        const int p = 2 * wid + i; const int kk = (p >> 1) * 8 + ((lane & 31) >> 2); const int k = (kk & ~0xC) | ((kk & 4) << 1) | ((kk & 8) >> 1); const int c = (2 * (p & 1) + (lane >> 5)) * 32 + (lane & 3) * 8;
        vo[i] = (unsigned)(k * 2048 + un.head * 256 + c * 2); }
    a.kofs0 = ko[0]; a.kofs1 = ko[1]; a.vofs0 = vo[0]; a.vofs1 = vo[1];
}
#define AT_DMA_K(AD, j, KO) do { const char* kj_ = (AD).Kb + (size_t)(j) * 131072; \
        __builtin_amdgcn_global_load_lds((const unsigned*)(kj_ + (AD).kofs0), (LAS unsigned*)(lds + (KO) + kdst), 16, 0, 0); __builtin_amdgcn_global_load_lds((const unsigned*)(kj_ + (AD).kofs1), (LAS unsigned*)(lds + (KO) + kdst + 1024), 16, 0, 0); } while (0)
#define AT_DMA_V(AD, j, VO) do { const char* vj_ = (AD).Vb + (size_t)(j) * 131072; \
        __builtin_amdgcn_global_load_lds((const unsigned*)(vj_ + (AD).vofs0), (LAS unsigned*)(lds + (VO) + vdst), 16, 0, 0); __builtin_amdgcn_global_load_lds((const unsigned*)(vj_ + (AD).vofs1), (LAS unsigned*)(lds + (VO) + vdst + 1024), 16, 0, 0); } while (0)
__device__ __forceinline__ void at_prefetch(LAS unsigned char* lds, const AtUnit& un, const bf16_t* __restrict__ Q, const bf16_t* __restrict__ K, const bf16_t* __restrict__ V, bf16x8 (&qr)[4]) {
    const int tid = threadIdx.x, lane = tid & 63, r32 = lane & 31, hi = lane >> 5; const int wid = __builtin_amdgcn_readfirstlane(tid >> 6); const int mp = wid >> 2, wq = wid & 3;
    AtAddr ad; at_addr(ad, un, wid, lane, K, V);
    const unsigned kdst = (unsigned)(mp * KB_BYTES + (2 * wq) * 1024), vdst = (unsigned)(OFF_V + (2 * wid) * 1024);
    AT_DMA_K(ad, 0, 0); AT_DMA_V(ad, 0, 0); AT_DMA_K(ad, 1, KSLOT);
    const bf16_t* qp = Q + ((size_t)un.b * SEQ + un.qblk * 128 + wq * 32 + r32) * 1024 + (un.head * 2 + mp) * 64 + hi * 8;
#pragma unroll
    for (int d0 = 0; d0 < 4; ++d0) qr[d0] = *(const bf16x8*)(qp + d0 * 16);
    asm volatile("" ::: "memory"); AT_SBAR();
}
template <unsigned var> __device__ __forceinline__ void attn_unit(LAS unsigned char* lds, const AtUnit cu, const AtUnit nu, const bool has_next, const bool first, const bf16_t* __restrict__ Q, const bf16_t* __restrict__ K, const bf16_t* __restrict__ V,
                                          bf16_t* __restrict__ O, const float lam, const float* __restrict__ gain, bf16x8 (&qr)[4]) {
    const int tid = threadIdx.x, lane = tid & 63, r32 = lane & 31, hi = lane >> 5; const int wid = __builtin_amdgcn_readfirstlane(tid >> 6); const int mp = wid >> 2, wq = wid & 3;
    const int head = cu.head, qblk = cu.qblk; const size_t rowbase = (size_t)cu.b * SEQ; const int q0 = qblk * 128;
    const int mychunk = 2 * qblk + (wq >> 1); const int NT = 2 * qblk + 2;
    LAS float* wsf = (LAS float*)(lds + OFF_WS) + wid * 64;
    AtAddr ad; at_addr(ad, cu, wid, lane, K, V);
    const unsigned kdst = (unsigned)(mp * KB_BYTES + (2 * wq) * 1024), vdst = (unsigned)(OFF_V + (2 * wid) * 1024);
    float mhat = 0.f, l_reg = 0.f; f32x16 o[4] = {};
    const int vb0 = (int)(uintptr_t)(lds + OFF_V) + v_rd_base(lane);
    const LAS unsigned char* kb0 = lds + mp * KB_BYTES;
    constexpr float THR = 8.f;
    f32x16 pA0 = {}, pA1 = {}, pB0 = {}, pB1 = {}; float alA = 1.f, alB = 1.f; bool rsA = false, rsB = false;
    int kcur = 0, k1 = KSLOT, k2 = 2 * KSLOT;
    int vprev = 2 * VB_BYTES, vcur = 0, vnext = VB_BYTES;
#define AT_ROT() do { kcur = k1; k1 = k2; k2 = (k2 == (NKS - 1) * KSLOT) ? 0 : k2 + KSLOT; vprev = vcur; vcur = vnext; vnext = (vnext == (NVS - 1) * VB_BYTES) ? 0 : vnext + VB_BYTES; } while (0)
#define AT_QKT(P0, P1, SL) do { const LAS unsigned char* kp_ = kb0 + (SL) + hi * 1024 + r32 * 16; P0 = f32x16{}; P1 = f32x16{}; \
        _Pragma("unroll") for (int d0 = 0; d0 < 4; ++d0) { const bf16x8 b0_ = *(const LAS bf16x8*)(kp_ + d0 * 2048), b1_ = *(const LAS bf16x8*)(kp_ + d0 * 2048 + 512); const bf16x8 q_ = qr[d0]; \
            P0 = __builtin_amdgcn_mfma_f32_32x32x16_bf16(b0_, q_, P0, 0, 0, 0); P1 = __builtin_amdgcn_mfma_f32_32x32x16_bf16(b1_, q_, P1, 0, 0, 0); } } while (0)
#define AT_PSM(P0, P1, AL, RS, FIRST) do { float pm_ = P0[0]; _Pragma("unroll") for (int r = 1; r < 16; ++r) pm_ = fmaxf(pm_, P0[r]); _Pragma("unroll") for (int r = 0; r < 16; ++r) pm_ = fmaxf(pm_, P1[r]); \
        pm_ = hswap_max(pm_) - mhat; RS = (FIRST) || __any(pm_ > THR); AL = 1.f; \
        if (RS) { const float dl_ = (FIRST) ? pm_ : fmaxf(pm_, 0.f); mhat += dl_; AL = __builtin_amdgcn_exp2f(-dl_); } \
        _Pragma("unroll") for (int r = 0; r < 16; ++r) { P0[r] = __builtin_amdgcn_exp2f(P0[r] - mhat); P1[r] = __builtin_amdgcn_exp2f(P1[r] - mhat); } } while (0)
#define AT_PK4(P, BASE, OUT) do { const unsigned a0 = cvt_pk_bf16(P[BASE + 0], P[BASE + 1]), a1 = cvt_pk_bf16(P[BASE + 2], P[BASE + 3]); \
        const unsigned b0 = cvt_pk_bf16(P[BASE + 4], P[BASE + 5]), b1 = cvt_pk_bf16(P[BASE + 6], P[BASE + 7]); \
        auto r0_ = __builtin_amdgcn_permlane32_swap(a0, b0, false, false); auto r1_ = __builtin_amdgcn_permlane32_swap(a1, b1, false, false); \
        u32x4 w_ = {r0_[0], r1_[0], r0_[1], r1_[1]}; OUT = __builtin_bit_cast(bf16x8, w_); } while (0)
#define AT_FIN_PV(P0, P1, AL, SL) do { float ps_ = 0.f; _Pragma("unroll") for (int r = 0; r < 16; ++r) ps_ += P0[r]; _Pragma("unroll") for (int r = 0; r < 16; ++r) ps_ += P1[r]; \
        ps_ = hswap_sum(ps_); l_reg = l_reg * (AL) + ps_; bf16x8 pa0, pa1, pa2, pa3; AT_PK4(P0, 0, pa0); AT_PK4(P0, 8, pa1); AT_PK4(P1, 0, pa2); AT_PK4(P1, 8, pa3); const int vb_ = vb0 + (SL); \
        pv_one<0>(o[0], vb_, pa0, pa1, pa2, pa3); pv_one<1>(o[1], vb_, pa0, pa1, pa2, pa3); pv_one<2>(o[2], vb_, pa0, pa1, pa2, pa3); pv_one<3>(o[3], vb_, pa0, pa1, pa2, pa3); } while (0)
#define AT_RESC(AL, RS) do { if (RS) { if (hi == 0) wsf[r32] = (AL); asm volatile("s_waitcnt lgkmcnt(0)" ::: "memory"); \
        _Pragma("unroll") for (int r = 0; r < 16; ++r) { const float a_ = wsf[crow(r, hi)]; _Pragma("unroll") for (int d = 0; d < 4; ++d) o[d][r] *= a_; } } } while (0)
#define AT_STEP0(u, PC0, PC1, ALC, RSC, PP0, PP1, ALP) do { const bool nk_ = (u) + 2 < NT && !(var & 2u), nv_ = (u) + 1 < NT && !(var & 2u); if (nk_) AT_DMA_K(ad, (u) + 2, k2); if (nv_) AT_DMA_V(ad, (u) + 1, vnext); \
        const bool aX_ = (u) < NT && (u) <= mychunk, aF_ = (u) >= 1 && (u) - 1 <= mychunk; \
        if (aX_ && !(var & 16u)) AT_QKT(PC0, PC1, kcur); \
        if (aF_ && !(var & 4u)) AT_FIN_PV(PP0, PP1, ALP, vprev); \
        if (aX_ && !(var & 8u)) { AT_PSM(PC0, PC1, ALC, RSC, (u) == 0); AT_RESC(ALC, RSC); } \
        if (nk_) asm volatile("s_waitcnt vmcnt(4)" ::: "memory"); else if (nv_) asm volatile("s_waitcnt vmcnt(2)" ::: "memory"); else asm volatile("s_waitcnt vmcnt(0)" ::: "memory"); \
        __syncthreads(); AT_ROT(); } while (0)
    if (first || mp == 1) asm volatile("s_waitcnt vmcnt(0)" ::: "memory"); else asm volatile("s_waitcnt vmcnt(8)" ::: "memory");
    __syncthreads();
    for (int u = 0; u < NT; u += 2) { AT_STEP0(u, pA0, pA1, alA, rsA, pB0, pB1, alB); AT_STEP0(u + 1, pB0, pB1, alB, rsB, pA0, pA1, alA); }
    { const int u = NT; AT_STEP0(u, pA0, pA1, alA, rsA, pB0, pB1, alB); }
#undef AT_ROT
#undef AT_QKT
#undef AT_PSM
#undef AT_PK4
#undef AT_FIN_PV
#undef AT_RESC
#undef AT_STEP0
    if (has_next) at_prefetch(lds, nu, Q, K, V, qr);
    if (hi == 0) wsf[r32] = 1.f / l_reg;
    asm volatile("s_waitcnt lgkmcnt(0)" ::: "memory");
    float rli[16];
#pragma unroll
    for (int r = 0; r < 16; ++r) rli[r] = wsf[crow(r, hi)];
    LAS float* xch = (LAS float*)(lds + (wq < 2 ? 32768 + wq * 16384 : 81920 + (wq - 2) * 16384));
    if (mp == 1) {
#pragma unroll
        for (int d = 0; d < 4; ++d)
#pragma unroll
            for (int r4 = 0; r4 < 4; ++r4) *(LAS f32x4*)(xch + ((d * 4 + r4) * 64 + lane) * 4) = (f32x4){o[d][4 * r4] * rli[4 * r4], o[d][4 * r4 + 1] * rli[4 * r4 + 1], o[d][4 * r4 + 2] * rli[4 * r4 + 2], o[d][4 * r4 + 3] * rli[4 * r4 + 3]};
    }
    __syncthreads();
    if (mp == 0) {
#pragma unroll
        for (int d = 0; d < 4; ++d)
#pragma unroll
            for (int r4 = 0; r4 < 4; ++r4) { const f32x4 v2 = *(const LAS f32x4*)(xch + ((d * 4 + r4) * 64 + lane) * 4);
#pragma unroll
                for (int e = 0; e < 4; ++e) o[d][4 * r4 + e] = o[d][4 * r4 + e] * rli[4 * r4 + e] - lam * v2[e]; }
    }
    __syncthreads();
    LAS float* stg = (LAS float*)(lds + (wq == 0 ? 32768 : 81920 + (wq - 1) * 16896));
    if (mp == 0) {
#pragma unroll
        for (int d = 0; d < 4; ++d)
#pragma unroll
            for (int r = 0; r < 16; ++r) stg[crow(r, hi) * 132 + d * 32 + r32] = o[d][r];
        asm volatile("s_waitcnt lgkmcnt(0)" ::: "memory");
        const int row = lane >> 1, ch = (lane & 1) * 64; const LAS float* sp = stg + row * 132 + ch; float vv[64]; float ss = 0.f;
#pragma unroll
        for (int i = 0; i < 16; ++i) { const f32x4 t4 = *(const LAS f32x4*)(sp + 4 * i); vv[4 * i] = t4[0]; vv[4 * i + 1] = t4[1]; vv[4 * i + 2] = t4[2]; vv[4 * i + 3] = t4[3]; ss += (t4[0] * t4[0] + t4[1] * t4[1]) + (t4[2] * t4[2] + t4[3] * t4[3]); }
        ss += __shfl_xor(ss, 1);
        const float rs = (1.0f / sqrtf(ss * (1.f / 128.f) + RMS_EPS)) * (1.f - LAMBDA_INIT);
        bf16_t* op = O + (rowbase + q0 + wq * 32 + row) * 1024 + head * 128 + ch; const float* gp = gain + ch;
#pragma unroll
        for (int i = 0; i < 8; ++i) { const f32x4 g0 = *(const f32x4*)(gp + 8 * i), g1 = *(const f32x4*)(gp + 8 * i + 4); u32x4 w;
            w.x = cvt_pk_bf16(vv[8 * i] * rs * g0[0], vv[8 * i + 1] * rs * g0[1]); w.y = cvt_pk_bf16(vv[8 * i + 2] * rs * g0[2], vv[8 * i + 3] * rs * g0[3]);
            w.z = cvt_pk_bf16(vv[8 * i + 4] * rs * g1[0], vv[8 * i + 5] * rs * g1[1]); w.w = cvt_pk_bf16(vv[8 * i + 6] * rs * g1[2], vv[8 * i + 7] * rs * g1[3]);
            *(u32x4*)(op + 8 * i) = w; }
    }
}
template <unsigned var> __device__ __forceinline__ void attn_phase(LAS unsigned char* lds, int vcu, int ncu, const bf16_t* Q, const bf16_t* K, const bf16_t* V, bf16_t* O, const float* scal, const float* gain) {
    const float lam = scal[0];
    const int hb = ncu >> 1; const int nun = (vcu >> 1) < NB * NHEAD ? ((NB * NHEAD - 1 - (vcu >> 1)) / hb + 1) * 8 : 0;
    auto unit_of = [&](int i) { if (ncu == 256) { const int bh = (vcu >> 5) * 16 + (i >> 1) * 4 + ((vcu & 31) >> 3), s = vcu & 7; return AtUnit{bh >> 3, bh & 7, (i & 1) ? 15 - s : s}; }
        const int bh = (vcu >> 1) + (i >> 3) * hb; const int s = (vcu & 1) + 2 * ((i & 7) >> 1); return AtUnit{bh >> 3, bh & 7, (i & 1) ? 15 - s : s}; };
    if (nun == 0) return;
    bf16x8 qr[4]; AtUnit cu = unit_of(0); at_prefetch(lds, cu, Q, K, V, qr);
    for (int i = 0; i < nun; ++i) { const bool hn = i + 1 < nun; const AtUnit nu = unit_of(hn ? i + 1 : i);
        attn_unit<var>(lds, cu, nu, hn, i == 0, Q, K, V, O, lam, gain, qr); cu = nu; }
    __syncthreads();
}
#undef AT_DMA_K
#undef AT_DMA_V
#undef AT_SBAR
}

struct MKArgs { const void* in[21]; float* out; unsigned char* ws; unsigned mask; unsigned li; };
enum { PH_PRO = 0, PH_G1, PH_POOLA, PH_ATT, PH_POOLG, PH_G4A, PH_G4B, PH_G5, PH_ROUTER, PH_G7, PH_G8, PH_FINAL, PH_N };

template <int MODE> __device__ __forceinline__ int dest_row(int n) {
    if (MODE == 1) return n < 2048 ? (n & ~63) + qk_pos_of_d(n & 63) : n;
    if (MODE == 2) { const int nn = n >> 9, hc = n & 511; return (hc >> 7) * 256 + ((hc >> 6) & 1) * 128 + ((hc >> 4) & 3) * 32 + ((hc >> 2) & 3) * 8 + nn * 4 + (hc & 3); }
    return n;
}
template <int MODE> __device__ __forceinline__ void transpose_item(const float* __restrict__ W, int ldw, int N, bf16_t* __restrict__ WT, int ldt, int coloff, int rowoff, LAS float* scr, int item, int lane) {
    const int nblk = N / 64, kb = item / nblk, nb = item % nblk, k0 = 64 * kb, n0 = 64 * nb;
    const int lr = lane >> 4, n4 = (lane & 15) * 4;
#pragma unroll 4
    for (int i = 0; i < 16; ++i) { const int kk = 4 * i + lr; const f32x4 v = *(const f32x4*)(W + (size_t)(k0 + kk) * ldw + n0 + n4); *(LAS f32x4*)(scr + kk * 64 + (n4 ^ ((kk >> 3) << 2))) = v; }
    LDS_WAIT(); asm volatile("" ::: "memory");
    const int c = lane & 7;
#pragma unroll 2
    for (int jj = 0; jj < 8; ++jj) { const int n = 8 * jj + (lane >> 3); const LAS float* sp = scr + (8 * c) * 64 + (n ^ (c << 2));
        u32x4 o; o.x = cvt_pk_bf16(sp[0 * 64], sp[1 * 64]); o.y = cvt_pk_bf16(sp[2 * 64], sp[3 * 64]); o.z = cvt_pk_bf16(sp[4 * 64], sp[5 * 64]); o.w = cvt_pk_bf16(sp[6 * 64], sp[7 * 64]);
        *(u32x4*)(WT + (size_t)(rowoff + dest_row<MODE>(n0 + n)) * ldt + coloff + k0 + 8 * c) = o; }
    LDS_WAIT(); asm volatile("" ::: "memory");
}

__global__ void __launch_bounds__(NTHREADS, 2) mk_fwd(MKArgs args) {
    __shared__ __attribute__((aligned(16))) unsigned char lds_raw[LDS_BYTES];
    LAS unsigned char* lds = (LAS unsigned char*)lds_raw;
    volatile LAS unsigned* MISC = (volatile LAS unsigned*)(lds + MISC_OFF);
    const int tid = threadIdx.x, lane = tid & 63, wave = __builtin_amdgcn_readfirstlane(tid >> 6);
    const int G = gridDim.x; const int bx = blockIdx.x; const int vcu = (G % 8 == 0) ? (bx % 8) * (G / 8) + bx / 8 : bx;
    const unsigned mask = args.mask; const bool dry = ((args.li >> 8) & 1u) != 0u;
    unsigned char* const ws = args.ws; float* const out = args.out;
#define IN_F(k) ((const float*)args.in[k])
#define x_ IN_F(0)
#define positions ((const int*)args.in[1])
#define w_in IN_F(2)
#define gate_bias IN_F(3)
#define lam_vecs IN_F(4)
#define subln_gain IN_F(5)
#define w_pool IN_F(6)
#define pool_scale IN_F(7)
#define w_branch_a IN_F(8)
#define w_branch_b IN_F(9)
#define w_out IN_F(10)
#define ln1_g IN_F(11)
#define ln1_b IN_F(12)
#define wrg IN_F(13)
#define brg IN_F(14)
#define wre IN_F(15)
#define bre IN_F(16)
#define wgu IN_F(17)
#define wdn IN_F(18)
#define ln2_g IN_F(19)
#define ln2_b IN_F(20)
#define wt ((bf16_t*)(ws + WS_WT))
#define xb ((bf16_t*)(ws + WS_XB))
#define qb ((bf16_t*)(ws + WS_Q))
#define kb ((bf16_t*)(ws + WS_K))
#define vb ((bf16_t*)(ws + WS_V))
#define ub ((bf16_t*)(ws + WS_U))
#define gb ((bf16_t*)out)
#define on ((bf16_t*)(ws + WS_ON))
#define mixed ((bf16_t*)(ws + WS_MIXED))
#define merged ((bf16_t*)(ws + WS_MERGED))
#define x1b ((bf16_t*)(ws + WS_X1B))
#define hb ((bf16_t*)(ws + WS_H))
#define ybuf ((bf16_t*)(ws + WS_YBUF))
#define rope ((float*)(ws + WS_ROPE))
#define pooled ((bf16_t*)(ws + WS_POOLED))
#define misc (ws + WS_MISC)
#define ctl ((unsigned*)(misc + MS_CTL))
#define stats ((float2*)(misc + MS_STATS))
#define rw ((float*)(misc + MS_ROUTE + (size_t)T * 8))
#define list ((int*)(misc + MS_LIST))
#define scal ((float*)(misc + MS_SCAL))
#define cnt (ctl + CW_CNT)
#define wpool_bd ((bf16_t*)(misc + MS_WPOOL))

    for (int u = tid; u < (LDS_BYTES - LDS_CTL_OFF) / 4; u += NTHREADS) ((LAS unsigned*)(lds + LDS_CTL_OFF))[u] = 0u;
    __syncthreads();
    XcdBarrier bar; bar.bar = ctl + CW_BAR + (args.li & 255u) * XCD_BAR_WORDS; bar.x = 0; bar.st = nullptr;
    const bool multi = (mask & (mask - 1u)) != 0u;
    if (multi) bar = xcd_barrier_post(ctl + CW_BAR + (args.li & 255u) * XCD_BAR_WORDS, MISC + 8);
#ifndef MK_CT
#define MK_CT 0xfffu
#endif
#define HAS(p) (((MK_CT >> (p)) & 1u) && ((mask >> (p)) & 1u))
#ifndef MK_REP
#define MK_REP 0u
#endif
#define REPS(p) for (int rep_ = 0; rep_ < ((((MK_REP) >> (p)) & 1u) ? 2 : 1); ++rep_)
#ifdef MK_BAR2
#define SEAM(p) do { if (multi && (mask >> ((p) + 1)) != 0u) { xcd_barrier(bar); xcd_barrier(bar); } } while (0)
#else
#define SEAM(p) do { if (multi && (mask >> ((p) + 1)) != 0u) xcd_barrier(bar); } while (0)
#endif
    const int gw = vcu * NWAVES + wave, NGW = G * NWAVES;

    if (HAS(PH_PRO)) {
        LAS float* scr = (LAS float*)(lds + wave * 16384);
        constexpr int I_IN = 16 * (INW / 64), I_A = 16 * 16, I_O = 16 * 16, I_GU = 16 * 16, I_DN = 8 * 16;
        constexpr int NITEMS = I_IN + I_A + I_O;
        for (int it = gw; it < NITEMS; it += NGW) {
            int r = it;
            if (r < I_IN) { transpose_item<1>(w_in, INW, INW, wt + WT_IN, 1024, 0, 0, scr, r, lane); continue; } r -= I_IN;
            if (r < I_A) { transpose_item<0>(w_branch_a, 1024, 1024, wt + WT_A, 1024, 0, 0, scr, r, lane); continue; } r -= I_A;
            transpose_item<0>(w_out, 1024, 1024, wt + WT_O, 1024, 0, 0, scr, r, lane);
            (void)I_GU; (void)I_DN;
        }
        for (int it = gw; it < 64 * 16; it += NGW) { const int kc = it >> 4, n = (it & 15) * 64 + lane; const int g = kc >> 4, c0 = (kc & 15) * 8; float a8[8] = {0.f, 0.f, 0.f, 0.f, 0.f, 0.f, 0.f, 0.f};
            const float* wpg = w_pool + (size_t)(g * 128 + c0) * 128; const float* wbp = w_branch_b + (size_t)(g * 128) * 1024 + n; const float* psp = pool_scale + g * 128;
            for (int d = 0; d < 128; ++d) { const float bv = wbp[(size_t)d * 1024] * psp[d];
#pragma unroll
                for (int i = 0; i < 8; ++i) a8[i] = fmaf(wpg[i * 128 + d], bv, a8[i]); }
            u32x4 o; o.x = cvt_pk_bf16(a8[0], a8[1]); o.y = cvt_pk_bf16(a8[2], a8[3]); o.z = cvt_pk_bf16(a8[4], a8[5]); o.w = cvt_pk_bf16(a8[6], a8[7]);
            *(u32x4*)(wt + WT_B + (size_t)n * 512 + kc * 8) = o; }
        for (int m = gw; m < T; m += NGW) { const f32x4* xr = (const f32x4*)(x_ + (size_t)m * 1024) + 2 * lane; u32x4* o16 = (u32x4*)(xb + (size_t)m * 1024) + lane;
#pragma unroll
            for (int j = 0; j < 2; ++j) { const f32x4 v0 = __builtin_nontemporal_load(xr + 128 * j), v1 = __builtin_nontemporal_load(xr + 128 * j + 1); u32x4 w; w.x = cvt_pk_bf16(v0[0], v0[1]); w.y = cvt_pk_bf16(v0[2], v0[3]); w.z = cvt_pk_bf16(v1[0], v1[1]); w.w = cvt_pk_bf16(v1[2], v1[3]); o16[64 * j] = w; } }
        for (int e = gw * 64 + lane; e < T * 32; e += NGW * 64) { const int t = e >> 5, i = e & 31; const float inv = powf(10000.0f, -(float)i * (2.0f / 64.0f)); const float ang = (float)positions[t] * inv; float sn, cs; sincosf(ang, &sn, &cs);
            rope[2 * e] = cs; rope[2 * e + 1] = sn; }
        if (gw == 0 && lane == 0) { float s01 = 0.f, s23 = 0.f; for (int i = 0; i < 64; ++i) { s01 += lam_vecs[i] * lam_vecs[64 + i]; s23 += lam_vecs[128 + i] * lam_vecs[192 + i]; } scal[0] = expf(s01) - expf(s23) + LAMBDA_INIT; }
        { f32x4* wp = (f32x4*)(misc + MS_WP);
          for (int e = gw * 64 + lane; e < 16 * 3 * 4 * 64; e += NGW * 64) { const int l = e & 63, sg = (e >> 6) & 3, ob = (e >> 8) % 3, chunk = (e >> 8) / 3; const int o = ob * 16 + (l & 15); f32x4 v = {0.f, 0.f, 0.f, 0.f};
              if (o < 36) {
#pragma unroll
                  for (int j = 0; j < 4; ++j) { const int c = chunk * 64 + (l >> 4) * 16 + 4 * sg + j; v[j] = ln1_g[c] * (o < 4 ? wrg[c * 4 + o] : wre[c * 32 + (o - 4)]); } }
              wp[e] = v; }
          float* csbw = (float*)(misc + MS_CSBW);
          if (gw < 48) { const int o = gw; float cs = 0.f, bw = 0.f;
              if (o < 36) { for (int i = 0; i < 16; ++i) { const int c = lane + 64 * i; const float w = (o < 4 ? wrg[c * 4 + o] : wre[c * 32 + (o - 4)]); cs += ln1_g[c] * w; bw += ln1_b[c] * w; }
                  cs = wave_sum(cs); bw = wave_sum(bw) + (o < 4 ? brg[o] : bre[o - 4]); }
              if (lane == 0) { csbw[o] = cs; csbw[48 + o] = bw; } } }
#ifdef MK_SLEEP_TEST
        { const unsigned long long t0_ = __builtin_amdgcn_s_memrealtime(); while (__builtin_amdgcn_s_memrealtime() - t0_ < 10000ull) __builtin_amdgcn_s_sleep(32); }
#endif
        __syncthreads();
        SEAM(PH_PRO);
    }
    if (HAS(PH_G1)) {
        g8::DenseOrder S; S.init(xb, wt + WT_IN, T, INW, 1024, G, bx);
        g8::EpiProj E{qb, kb, vb, ub, gb, rope, gate_bias};
        g8::gemm_phase<g8::EpiProj, g8::DenseOrder, true, false>(lds, 1024, S, E);
        SEAM(PH_G1);
    }
    if (HAS(PH_POOLA)) {
        for (int task = gw; task < T / 16; task += NGW) { const int t0 = task * 16, s0 = t0 & (SEQ - 1); const int w = 2 << (lane >> 4); const bf16_t* up = ub + (size_t)t0 * 512 + lane * 8;
            float a[8] = {0.f, 0.f, 0.f, 0.f, 0.f, 0.f, 0.f, 0.f};
            if (s0 != 0) for (int i = 1; i < w; ++i) { const u32x4 v = *(const u32x4*)(up - (ptrdiff_t)i * 512);
                a[0] += bflo(v.x); a[1] += bfhi(v.x); a[2] += bflo(v.y); a[3] += bfhi(v.y); a[4] += bflo(v.z); a[5] += bfhi(v.z); a[6] += bflo(v.w); a[7] += bfhi(v.w); }
#pragma unroll 4
            for (int j = 0; j < 16; ++j) { const int s = s0 + j; const u32x4 v = *(const u32x4*)(up + (size_t)j * 512); const float f[8] = {bflo(v.x), bfhi(v.x), bflo(v.y), bfhi(v.y), bflo(v.z), bfhi(v.z), bflo(v.w), bfhi(v.w)};
#pragma unroll
                for (int k = 0; k < 8; ++k) a[k] += f[k];
                if (j >= 1 && s >= w) { const u32x4 o = *(const u32x4*)(up + (ptrdiff_t)(j - w) * 512);
                    a[0] -= bflo(o.x); a[1] -= bfhi(o.x); a[2] -= bflo(o.y); a[3] -= bfhi(o.y); a[4] -= bflo(o.z); a[5] -= bfhi(o.z); a[6] -= bflo(o.w); a[7] -= bfhi(o.w); }
                const float inv = 1.f / (float)((s + 1 < w) ? s + 1 : w); u32x4 r; r.x = cvt_pk_bf16(a[0] * inv - f[0], a[1] * inv - f[1]); r.y = cvt_pk_bf16(a[2] * inv - f[2], a[3] * inv - f[3]);
                r.z = cvt_pk_bf16(a[4] * inv - f[4], a[5] * inv - f[5]); r.w = cvt_pk_bf16(a[6] * inv - f[6], a[7] * inv - f[7]);
                *(u32x4*)(pooled + (size_t)(t0 + j) * 512 + lane * 8) = r; } }
    }
    if (HAS(PH_ATT)) {
#ifdef MK_VAR
        if (args.li >> 8) at2::attn_phase<MK_VAR>(lds, vcu, G, qb, kb, vb, (bf16_t*)(ws + WS_POOLED), scal, subln_gain); else
#endif
        at2::attn_phase<0u>(lds, vcu, G, qb, kb, vb, on, scal, subln_gain);
        SEAM(PH_ATT); }
    else if (HAS(PH_POOLA)) { SEAM(PH_ATT); }
    if (HAS(PH_G4A)) {
        g8::DenseOrder S; S.init(on, wt + WT_A, T, 1024, 1024, G, bx);
        g8::EpiMerge<0> E{gb, merged, merged};
        g8::gemm_phase<g8::EpiMerge<0>, g8::DenseOrder, true, false>(lds, 1024, S, E);
    }
    if (HAS(PH_G4B)) {
        g8::DenseOrder S; S.init(pooled, wt + WT_B, T, 1024, 512, G, bx);
        g8::EpiMerge<1> E{gb, merged, dry ? (bf16_t*)(ws + WS_X1B) : merged};
        g8::gemm_phase<g8::EpiMerge<1>, g8::DenseOrder, true, false>(lds, 512, S, E);
        SEAM(PH_G4B);
    } else if (HAS(PH_G4A)) { SEAM(PH_G4B); }
    if (HAS(PH_G5)) {
        g8::DenseOrder S; S.init(merged, wt + WT_O, T, 1024, 1024, G, bx);
        g8::EpiResid E{x_, out, (float2*)(ws + WS_MIXED)};
        g8::gemm_phase<g8::EpiResid, g8::DenseOrder, true, false>(lds, 1024, S, E);
        SEAM(PH_G5);
    }
    if (HAS(PH_ROUTER)) {
        LAS float* lgs = (LAS float*)(lds + 0) + wave * (16 * 49);
        LAS float* tst = (LAS float*)(lds + 32768) + wave * 32;
        LAS int*   tex = (LAS int*)(lds + 36864) + wave * 128;
        LAS unsigned* lcnt = (LAS unsigned*)(lds + 40960);
        const f32x4* wp = (const f32x4*)(misc + MS_WP); const float* csbw = (const float*)(misc + MS_CSBW);
        for (int t0 = vcu * 128; t0 < T; t0 += G * 128) {
            if (tid < 64) lcnt[tid] = 0u;
            __syncthreads();
            const int tk = lane & 15, q = lane >> 4;
            if (wave >= 4) {
                if (t0 == vcu * 128) { LAS float* scr = (LAS float*)(lds + 65536 + (wave - 4) * 16384); constexpr int I_GU = 16 * 16, I_DN = 8 * 16;
                    for (int it = vcu * 4 + (wave - 4); it < NE * (I_GU + I_DN); it += G * 4) {
                        if (it < NE * I_GU) { const int e = it / I_GU; transpose_item<2>(wgu + (size_t)e * 1024 * 1024, 1024, 1024, wt + WT_GU + (size_t)e * 1024 * 1024, 1024, 0, 0, scr, it % I_GU, lane); }
                        else { const int r2 = it - NE * I_GU; const int e = r2 / I_DN; transpose_item<0>(wdn + (size_t)e * 512 * 1024, 1024, 1024, wt + WT_DN + (size_t)e * 1024 * 512, 512, 0, 0, scr, r2 % I_DN, lane); } } }
            } else
            for (int half = 0; half < 2; ++half) { const int tw = t0 + (wave * 2 + half) * 16; LAS int* texh = tex + half * 64;
            { const float* yr = out + (size_t)(tw + tk) * 1024 + q * 16;
              float s1 = 0.f, s2 = 0.f; { const float2* pp = (const float2*)(ws + WS_MIXED) + (size_t)(tw + tk) * 16;
#pragma unroll
                  for (int i = 0; i < 16; ++i) { const float2 pv = pp[i]; s1 += pv.x; s2 += pv.y; } }
              const float mu = s1 * (1.f / 1024.f); const float var = fmaxf(s2 * (1.f / 1024.f) - mu * mu, 0.f); const float rstd = 1.0f / sqrtf(var + LN_EPS);
              if (q == 0) { tst[2 * tk] = mu; tst[2 * tk + 1] = rstd; if (!dry) stats[tw + tk] = make_float2(mu, rstd); }
              bf16_t* xo = (dry ? (bf16_t*)(ws + WS_H) : x1b) + (size_t)(tw + tk) * 1024 + q * 16; const float* gp = ln1_g + q * 16; const float* bp = ln1_b + q * 16;
              f32x4 acc0 = {0.f, 0.f, 0.f, 0.f}, acc1 = {0.f, 0.f, 0.f, 0.f}, acc2 = {0.f, 0.f, 0.f, 0.f};
#pragma unroll 4
              for (int chunk = 0; chunk < 16; ++chunk) { f32x4 yv[4];
#pragma unroll
                  for (int j = 0; j < 4; ++j) yv[j] = *(const f32x4*)(yr + chunk * 64 + 4 * j);
                  { u32x4 w0, w1; f32x4 xn[4];
#pragma unroll
                    for (int j = 0; j < 4; ++j) { const f32x4 gg = *(const f32x4*)(gp + chunk * 64 + 4 * j), bb = *(const f32x4*)(bp + chunk * 64 + 4 * j); xn[j] = (yv[j] - mu) * rstd * gg + bb; }
                    w0.x = cvt_pk_bf16(xn[0][0], xn[0][1]); w0.y = cvt_pk_bf16(xn[0][2], xn[0][3]); w0.z = cvt_pk_bf16(xn[1][0], xn[1][1]); w0.w = cvt_pk_bf16(xn[1][2], xn[1][3]);
                    w1.x = cvt_pk_bf16(xn[2][0], xn[2][1]); w1.y = cvt_pk_bf16(xn[2][2], xn[2][3]); w1.z = cvt_pk_bf16(xn[3][0], xn[3][1]); w1.w = cvt_pk_bf16(xn[3][2], xn[3][3]);
                    *(u32x4*)(xo + chunk * 64) = w0; *(u32x4*)(xo + chunk * 64 + 8) = w1; }
#pragma unroll
                  for (int sg = 0; sg < 4; ++sg) { const f32x4 b0 = wp[((chunk * 3 + 0) * 4 + sg) * 64 + lane], b1 = wp[((chunk * 3 + 1) * 4 + sg) * 64 + lane], b2 = wp[((chunk * 3 + 2) * 4 + sg) * 64 + lane];
#pragma unroll
                      for (int j = 0; j < 4; ++j) { const float a = yv[sg][j];
                          acc0 = __builtin_amdgcn_mfma_f32_16x16x4f32(a, b0[j], acc0, 0, 0, 0); acc1 = __builtin_amdgcn_mfma_f32_16x16x4f32(a, b1[j], acc1, 0, 0, 0); acc2 = __builtin_amdgcn_mfma_f32_16x16x4f32(a, b2[j], acc2, 0, 0, 0); } } }
#pragma unroll
              for (int r = 0; r < 4; ++r) { lgs[(4 * q + r) * 49 + tk] = acc0[r]; lgs[(4 * q + r) * 49 + 16 + tk] = acc1[r]; lgs[(4 * q + r) * 49 + 32 + tk] = acc2[r]; } }
            LDS_WAIT();
            if (lane < 16) { const int t = tw + lane; const float mu = tst[2 * lane], rstd = tst[2 * lane + 1]; const LAS float* lr = lgs + lane * 49;
                float lg[4], le[32];
#pragma unroll
                for (int o = 0; o < 4; ++o) lg[o] = rstd * (lr[o] - mu * csbw[o]) + csbw[48 + o];
#pragma unroll
                for (int o = 0; o < 32; ++o) le[o] = rstd * (lr[4 + o] - mu * csbw[4 + o]) + csbw[48 + 4 + o];
                int gi = 0; float gm = lg[0];
#pragma unroll
                for (int o = 1; o < 4; ++o) if (lg[o] > gm) { gm = lg[o]; gi = o; }
                float gs = 0.f;
#pragma unroll
                for (int o = 0; o < 4; ++o) gs += expf(lg[o] - gm);
                const float gp = 1.f / gs; float ev[8];
#pragma unroll
                for (int o = 0; o < 8; ++o) { float vsel = le[o];
#pragma unroll
                    for (int g = 1; g < 4; ++g) vsel = (gi == g) ? le[g * 8 + o] : vsel;
                    ev[o] = vsel; }
                int i0 = 0; float m0v = ev[0];
#pragma unroll
                for (int o = 1; o < 8; ++o) if (ev[o] > m0v) { m0v = ev[o]; i0 = o; }
                int i1 = (i0 == 0) ? 1 : 0; float m1v = -3.4e38f;
#pragma unroll
                for (int o = 0; o < 8; ++o) if (o != i0 && ev[o] > m1v) { m1v = ev[o]; i1 = o; }
                const float e1 = expf(m1v - m0v); const float w0 = gp / (1.f + e1), w1 = gp * e1 / (1.f + e1);
                const int ex0 = gi * 8 + i0, ex1 = gi * 8 + i1;
                if (!dry) { rw[2 * t] = w0; rw[2 * t + 1] = w1; }
                const unsigned r0 = __hip_atomic_fetch_add(lcnt + ex0, 1u, __ATOMIC_RELAXED, __HIP_MEMORY_SCOPE_WORKGROUP); const unsigned r1 = __hip_atomic_fetch_add(lcnt + ex1, 1u, __ATOMIC_RELAXED, __HIP_MEMORY_SCOPE_WORKGROUP);
                texh[4 * lane] = ex0; texh[4 * lane + 1] = ex1; texh[4 * lane + 2] = (int)r0; texh[4 * lane + 3] = (int)r1; }
            }
            __syncthreads();
            if (tid < NE) { const unsigned c = lcnt[tid]; lcnt[32 + tid] = (c && !dry) ? atomicAdd(cnt + tid, c) : 0u; }
            __syncthreads();
            if (wave < 4 && lane < 32 && !dry) { const int half = lane >> 4, l16 = lane & 15; const int t = t0 + (wave * 2 + half) * 16 + l16; const LAS int* te = tex + half * 64 + 4 * l16; const int ex0 = te[0], ex1 = te[1];
                list[(size_t)ex0 * T + lcnt[32 + ex0] + (unsigned)te[2]] = t * 2; list[(size_t)ex1 * T + lcnt[32 + ex1] + (unsigned)te[3]] = t * 2 + 1; }
            __syncthreads();
        }
        SEAM(PH_ROUTER);
    }
    if (HAS(PH_G7) || HAS(PH_G8)) {
        if (tid < NE) MISC[64 + tid] = __hip_atomic_load(cnt + tid, RLX_AGENT);
        __syncthreads();
        if (tid == 0) { unsigned acc = 0u; for (int e = 0; e < NE; ++e) { MISC[16 + e] = acc; acc += (MISC[64 + e] + 255u) >> 8; } MISC[16 + NE] = acc; }
        __syncthreads();
        const int ntiles = (int)MISC[16 + NE];
        unsigned* tdone = ctl + CW_TDONE;
        const int nwg = ntiles * 4, r7 = nwg % G;
        if (HAS(PH_G7)) {
            g8::MoeOrder S{(const char*)x1b, (const char*)(wt + WT_GU), list, MISC + 16, MISC + 64, nwg, G, bx, 0, (size_t)1024 * 1024 * 2, (size_t)256 * 1024 * 2, 1, tdone, 1};
            g8::EpiGateUp E{hb};
            g8::gemm_phase<g8::EpiGateUp, g8::MoeOrder, true, true>(lds, 1024, S, E);
        }
        if (HAS(PH_G8)) {
            g8::MoeOrder S{(const char*)hb, (const char*)(wt + WT_DN), list, MISC + 16, MISC + 64, nwg, G, (bx - r7 + G) % G, (size_t)256 * 512 * 2, (size_t)1024 * 512 * 2, (size_t)256 * 512 * 2, 0, tdone, 2};
            g8::EpiDown E{ybuf, list, rw, MISC + 64};
            g8::gemm_phase<g8::EpiDown, g8::MoeOrder, true, false>(lds, 512, S, E);
            SEAM(PH_G8);
        } else if (HAS(PH_G7)) { SEAM(PH_G8); }
    }
    if (HAS(PH_FINAL)) {
        for (int t = gw; t < T; t += NGW) {
            float* yr = out + (size_t)t * 1024; float* yw = dry ? (float*)(ws + WS_V) + (size_t)t * 1024 : yr; const bf16_t* x1r = x1b + (size_t)t * 1024; float xv[16]; float s = 0.f;
#pragma unroll
            for (int j = 0; j < 4; ++j) { const int c0 = j * 256 + lane * 4; const u32x2 xw = __builtin_nontemporal_load((const u32x2*)(x1r + c0)); const float x1v[4] = {bflo(xw.x), bfhi(xw.x), bflo(xw.y), bfhi(xw.y)};
                const u32x2 a = __builtin_nontemporal_load((const u32x2*)(ybuf + (size_t)(2 * t) * 1024 + c0)); const u32x2 b = __builtin_nontemporal_load((const u32x2*)(ybuf + (size_t)(2 * t + 1) * 1024 + c0));
                const float ya[4] = {bflo(a.x), bfhi(a.x), bflo(a.y), bfhi(a.y)}; const float yb[4] = {bflo(b.x), bfhi(b.x), bflo(b.y), bfhi(b.y)};
#pragma unroll
                for (int i = 0; i < 4; ++i) { const float val = ALPHA * x1v[i] + (ya[i] + yb[i]); xv[4 * j + i] = val; s += val; } }
            const float mu = wave_sum(s) * (1.f / 1024.f); float s2 = 0.f;
#pragma unroll
            for (int i = 0; i < 16; ++i) { const float d = xv[i] - mu; s2 += d * d; }
            const float rstd = 1.0f / sqrtf(wave_sum(s2) * (1.f / 1024.f) + LN_EPS);
#pragma unroll
            for (int j = 0; j < 4; ++j) { const int c0 = j * 256 + lane * 4; const f32x4 gg = *(const f32x4*)(ln2_g + c0); const f32x4 bb = *(const f32x4*)(ln2_b + c0); f32x4 o;
#pragma unroll
                for (int i = 0; i < 4; ++i) o[i] = (xv[4 * j + i] - mu) * rstd * gg[i] + bb[i];
                __builtin_nontemporal_store(o, (f32x4*)(yw + c0)); }
        }
    }
#undef HAS
#undef SEAM
}
#undef IN_F
#undef x_
#undef positions
#undef w_in
#undef gate_bias
#undef lam_vecs
#undef subln_gain
#undef w_pool
#undef pool_scale
#undef w_branch_a
#undef w_branch_b
#undef w_out
#undef ln1_g
#undef ln1_b
#undef wrg
#undef brg
#undef wre
#undef bre
#undef wgu
#undef wdn
#undef ln2_g
#undef ln2_b
#undef wt
#undef xb
#undef qb
#undef kb
#undef vb
#undef ub
#undef gb
#undef on
#undef mixed
#undef merged
#undef x1b
#undef hb
#undef ybuf
#undef rope
#undef pooled
#undef misc
#undef ctl
#undef stats
#undef rw
#undef list
#undef scal
#undef cnt
#undef wpool_bd


#ifndef MK_OPT
#define MK_OPT 0xfffu
#endif
#ifndef MK_M2A
#define MK_M2A 0xff4u
#define MK_M2B 0u
#define MK_M2C 0u
#endif
#ifndef MK_ONE
#define MK_ONE 1
#endif
constexpr unsigned OPT = MK_OPT;
#define OPTP(p) ((OPT >> (p)) & 1u)


#ifdef MK_DEBUG_HASH
__global__ void k_hash(const uint4* __restrict__ p, size_t n16, unsigned long long* __restrict__ outh) {
    unsigned long long h = 0ull;
    for (size_t i = blockIdx.x * (size_t)blockDim.x + threadIdx.x; i < n16; i += (size_t)gridDim.x * blockDim.x) { const uint4 w = p[i];
        const unsigned long long m = (unsigned long long)(i * 2654435761ull + 12345ull) | 1ull;
        h += ((unsigned long long)w.x * 0x9E3779B1ull + (unsigned long long)w.y * 0x85EBCA77ull + (unsigned long long)w.z * 0xC2B2AE3Dull + (unsigned long long)w.w * 0x27D4EB2Full) * m; }
    for (int o = 32; o > 0; o >>= 1) h += __shfl_xor(h, o);
    if ((threadIdx.x & 63) == 0) atomicAdd(outh, h);
}
__global__ void k_poison(float* __restrict__ out, const unsigned long long* __restrict__ hs) {
    float code = 0.f; for (int r = 1; r < 10; ++r) if (hs[r] != hs[0]) code = 1.f;
    if (code == 0.f) return;
    for (size_t i = blockIdx.x * (size_t)blockDim.x + threadIdx.x; i < (size_t)T * DM; i += (size_t)gridDim.x * blockDim.x) out[i] = __builtin_nanf("") * code;
}
#endif
extern "C" void kernel_launch(void* const* d_in, const int* in_sizes, int n_in, void* d_out, int out_size, void* d_ws, size_t ws_size, hipStream_t stream) {
    static int grid = 0;
    if (grid == 0) {
        if (n_in != 21 || in_sizes[0] != T * DM || out_size != T * DM || ws_size < WS_END) { fprintf(stderr, "kernel_launch: unexpected shapes (n_in %d, x %d, out %d, ws %zu)\n", n_in, n_in > 0 ? in_sizes[0] : -1, out_size, ws_size); grid = -1; return; }
        int dev = 0, cus = 0;
        if (hipGetDevice(&dev) != hipSuccess || hipDeviceGetAttribute(&cus, hipDeviceAttributeMultiprocessorCount, dev) != hipSuccess) { fprintf(stderr, "kernel_launch: device query failed\n"); grid = -1; return; }
        int per_cu = 0;
        if (hipOccupancyMaxActiveBlocksPerMultiprocessor(&per_cu, (const void*)mk_fwd, NTHREADS, 0) != hipSuccess || per_cu < 1) fprintf(stderr, "kernel_launch: note: occupancy query reports %d blocks per CU\n", per_cu);
        (void)hipGetLastError();
        grid = cus;
    }
    if (grid < 0) return;
    const float* x = (const float*)d_in[0]; const int* positions = (const int*)d_in[1]; const float* w_in = (const float*)d_in[2]; const float* gate_bias = (const float*)d_in[3];
    const float* lam_vecs = (const float*)d_in[4]; const float* subln_gain = (const float*)d_in[5]; const float* w_pool = (const float*)d_in[6]; const float* pool_scale = (const float*)d_in[7];
    const float* w_branch_a = (const float*)d_in[8]; const float* w_branch_b = (const float*)d_in[9]; const float* w_out = (const float*)d_in[10]; const float* ln1_g = (const float*)d_in[11];
    const float* ln1_b = (const float*)d_in[12]; const float* wrg = (const float*)d_in[13]; const float* brg = (const float*)d_in[14]; const float* wre = (const float*)d_in[15];
    const float* bre = (const float*)d_in[16]; const float* wgu = (const float*)d_in[17]; const float* wdn = (const float*)d_in[18]; const float* ln2_g = (const float*)d_in[19]; const float* ln2_b = (const float*)d_in[20];
    char* ws = (char*)d_ws; float* out = (float*)d_out;
    bf16_t* qb = (bf16_t*)(ws + WS_Q); bf16_t* kb = (bf16_t*)(ws + WS_K); bf16_t* vb = (bf16_t*)(ws + WS_V); bf16_t* ub = (bf16_t*)(ws + WS_U); bf16_t* gb = (bf16_t*)d_out;
    bf16_t* on = (bf16_t*)(ws + WS_ON); bf16_t* mixed = (bf16_t*)(ws + WS_MIXED); bf16_t* merged = (bf16_t*)(ws + WS_MERGED); bf16_t* x1b = (bf16_t*)(ws + WS_X1B);
    bf16_t* hb = (bf16_t*)(ws + WS_H); bf16_t* ybuf = (bf16_t*)(ws + WS_YBUF); float2* rope = (float2*)(ws + WS_ROPE); float* tmp = (float*)(ws + WS_TEMP);
    char* misc = ws + WS_MISC; unsigned* ctl = (unsigned*)(misc + MS_CTL); float2* stats = (float2*)(misc + MS_STATS); int2* rexp = (int2*)(misc + MS_ROUTE); float2* rw = (float2*)(misc + MS_ROUTE + (size_t)T * 8);
    int* list = (int*)(misc + MS_LIST); float* scal = (float*)(misc + MS_SCAL); unsigned* cnt = ctl;

    MKArgs a{}; int nlaunch = 0;
    for (int i = 0; i < 21; ++i) a.in[i] = d_in[i];
    a.out = out; a.ws = (unsigned char*)d_ws;
    if (hipMemsetAsync(ctl, 0, 65536, stream) != hipSuccess) { fprintf(stderr, "kernel_launch: memset failed\n"); return; }
#ifndef MK_REPH
#define MK_REPH 0u
#endif
#define MK(maskv) do { a.mask = (maskv); for (int rr_ = 0; rr_ < (((maskv) & (MK_REPH)) ? 2 : 1); ++rr_) { a.li = (unsigned)(nlaunch++ % 3) | (rr_ ? (1u << 8) : 0u); hipLaunchKernelGGL(mk_fwd, dim3(grid), dim3(NTHREADS), 0, stream, a); } } while (0)
    if (MK_ONE == 1) { MK((1u << PH_N) - 1u); return; }
    if (MK_ONE == 2) {
        MK(0x003u);
        for (int mh = 0; mh < 2; ++mh) { const int m0 = mh * 16384; nattn<<<(16384 / 64) * 16, 64, 0, stream>>>(qb, kb, vb, scal, tmp, m0); post_rms<<<16384 * 8 / 256, 256, 0, stream>>>(tmp, subln_gain, on, m0, 16384); }
        MK(MK_M2A); if (MK_M2B) MK(MK_M2B); if (MK_M2C) MK(MK_M2C); return; }

    constexpr int MC = 16384;
#if 0
#else
#ifdef MK_TEST_BAR
    MK(0x003u);
#else
    if (OPTP(PH_PRO)) MK(1u << PH_PRO); else k_prep<<<T * 32 / 256, 256, 0, stream>>>(positions, lam_vecs, rope, scal, ctl);
    if (OPTP(PH_G1)) MK(1u << PH_G1);
#endif
#endif
#ifndef MK_OVR
#define MK_OVR 0
#endif
    const int ovr = OPTP(PH_G1) ? MK_OVR : 15;
    for (int mh = 0; mh < 2; ++mh) {
        const int m0 = mh * MC; AL_F32 ax{x + (size_t)m0 * DM, DM, 0};
        if (ovr & 1) for (int qk = 0; qk < 2; ++qk) {
            ngemm<AL_F32><<<dim3(16, MC / 64), 256, 0, stream>>>(ax, w_in + qk * 1024, INW, tmp, 1024, MC, 1024, DM);
            post_qk<<<MC * 512 / 256, 256, 0, stream>>>(tmp, rope, qk ? kb : qb, m0, MC, qk ? 1.f : QSCALE);
        }
        if (ovr & 2) { ngemm<AL_F32><<<dim3(16, MC / 64), 256, 0, stream>>>(ax, w_in + 2048, INW, tmp, 1024, MC, 1024, DM);
        post_plain<<<MC * 1024 / 256, 256, 0, stream>>>(tmp, vb, 1024, 0, m0, MC, 1024, nullptr); }
        if (ovr & 4) { ngemm<AL_F32><<<dim3(8, MC / 64), 256, 0, stream>>>(ax, w_in + 3072, INW, tmp, 512, MC, 512, DM);
        post_plain<<<MC * 512 / 256, 256, 0, stream>>>(tmp, ub, 512, 0, m0, MC, 512, nullptr); }
        if (ovr & 8) for (int br = 0; br < 2; ++br) {
            ngemm<AL_F32><<<dim3(16, MC / 64), 256, 0, stream>>>(ax, w_in + 3584 + br * 1024, INW, tmp, 1024, MC, 1024, DM);
            post_gate<<<MC * 1024 / 256, 256, 0, stream>>>(tmp, gate_bias, gb, br * 1024, m0, MC);
        }
    }
    if (OPTP(PH_ATT)) MK(1u << PH_ATT);
    else for (int mh = 0; mh < 2; ++mh) {
        const int m0 = mh * MC;
        nattn<<<(MC / 64) * 16, 64, 0, stream>>>(qb, kb, vb, scal, tmp, m0);
        post_rms<<<MC * 8 / 256, 256, 0, stream>>>(tmp, subln_gain, on, m0, MC);
    }
    if (OPTP(PH_POOLA)) { MK(1u << PH_POOLA); MK(1u << PH_POOLG); }
    else for (int mh = 0; mh < 2; ++mh) {
        const int m0 = mh * MC;
        for (int g = 0; g < 4; ++g) { AL_POOL ap{ub + (size_t)m0 * PW, g, 0};
            ngemm<AL_POOL><<<dim3(2, MC / 64), 256, 0, stream>>>(ap, w_pool + (size_t)g * 128 * 128, 128, tmp + g * 128, 512, MC, 128, 128); }
        post_plain<<<MC * 512 / 256, 256, 0, stream>>>(tmp, mixed, 512, 0, m0, MC, 512, pool_scale);
    }
    if (OPTP(PH_G4A)) MK(1u << PH_G4A);
    else for (int mh = 0; mh < 2; ++mh) {
        const int m0 = mh * MC;
        { AL_BF16 al{on + (size_t)m0 * 1024, 1024, 0}; ngemm<AL_BF16><<<dim3(16, MC / 64), 256, 0, stream>>>(al, w_branch_a, 1024, tmp, 1024, MC, 1024, 1024); }
        post_merge<<<MC * 1024 / 256, 256, 0, stream>>>(tmp, gb, merged, 0, m0, MC);
    }
    if (OPTP(PH_G4B)) MK(1u << PH_G4B);
    else for (int mh = 0; mh < 2; ++mh) {
        const int m0 = mh * MC;
        { AL_BF16 al{mixed + (size_t)m0 * 512, 512, 0}; ngemm<AL_BF16><<<dim3(16, MC / 64), 256, 0, stream>>>(al, w_branch_b, 1024, tmp, 1024, MC, 1024, 512); }
        post_merge<<<MC * 1024 / 256, 256, 0, stream>>>(tmp, gb, merged, 1, m0, MC);
    }
    if (OPTP(PH_G5)) MK(1u << PH_G5);
    else for (int mh = 0; mh < 2; ++mh) {
        const int m0 = mh * MC;
        { AL_BF16 al{merged + (size_t)m0 * 1024, 1024, 0}; ngemm<AL_BF16><<<dim3(16, MC / 64), 256, 0, stream>>>(al, w_out, 1024, tmp, 1024, MC, 1024, 1024); }
        post_y<<<MC * 1024 / 256, 256, 0, stream>>>(tmp, x, out, m0, MC);
    }
    if (OPTP(PH_ROUTER)) MK(1u << PH_ROUTER); else k_router<<<T / 4, 256, 0, stream>>>(out, ln1_g, ln1_b, wrg, brg, wre, bre, x1b, stats, rexp, rw, list, cnt);
    if (OPTP(PH_G7)) MK(1u << PH_G7); else nmoe_gu<<<dim3(8, T / 64, NE), 256, 0, stream>>>(x1b, list, cnt, wgu, hb);
    if (OPTP(PH_G8)) MK(1u << PH_G8); else nmoe_dn<<<dim3(16, T / 64, NE), 256, 0, stream>>>(hb, list, cnt, rw, wdn, ybuf);
    if (OPTP(PH_FINAL)) MK(1u << PH_FINAL); else k_final<<<T / 4, 256, 0, stream>>>(out, stats, ln1_g, ln1_b, ybuf, ln2_g, ln2_b);
#undef MK
}
```

```cpp
#include <hip/hip_runtime.h>
#include <cstdio>
#include <cstdint>
#include <cmath>

typedef unsigned short bf16_t;
typedef float f32x4 __attribute__((ext_vector_type(4)));

constexpr int NB = 16, SEQ = 2048, DM = 1024, T = NB * SEQ;
constexpr int NHEAD = 8, HD = 64, NHM = 16;
constexpr int INW = 5632;
constexpr int PW = 512, PG = 4, PGD = 128;
constexpr int NE = 32, NGRP = 4, EPG = 8, FF = 512;
constexpr float LN_EPS = 1e-5f, RMS_EPS = 1e-5f;
constexpr float ALPHA = 1.189207115002721f;
constexpr float LAMBDA_INIT = 0.2f;
constexpr float QSCALE = 0.125f * 1.4426950408889634f;

constexpr size_t MiB = 1u << 20;
constexpr size_t WS_WT    = 0;
constexpr size_t WS_XB    = 112 * MiB;
constexpr size_t WS_ON    = 112 * MiB;
constexpr size_t WS_YBUF  = 112 * MiB;
constexpr size_t WS_Q     = 176 * MiB;
constexpr size_t WS_MERGED= 176 * MiB;
constexpr size_t WS_K     = 240 * MiB;
constexpr size_t WS_X1B   = 240 * MiB;
constexpr size_t WS_V     = 304 * MiB;
constexpr size_t WS_H     = 304 * MiB;
constexpr size_t WS_U     = 368 * MiB;
constexpr size_t WS_MIXED = 400 * MiB;
constexpr size_t WS_ROPE  = 432 * MiB;
constexpr size_t WS_MISC  = 440 * MiB;
constexpr size_t WS_TEMP  = 448 * MiB;
constexpr size_t WS_END   = 512 * MiB;
constexpr size_t MS_CTL   = 0;
constexpr size_t MS_STATS = 64 * 1024;
constexpr size_t MS_ROUTE = 512 * 1024;
constexpr size_t MS_LIST  = 1 * MiB;
constexpr size_t MS_SCAL  = 6 * MiB;

__device__ __forceinline__ float bf2f(bf16_t v) { return __uint_as_float((unsigned)v << 16); }
__device__ __forceinline__ bf16_t f2bf(float f) { unsigned u = __float_as_uint(f); return (bf16_t)((u + 0x7fffu + ((u >> 16) & 1u)) >> 16); }
__host__ __device__ __forceinline__ int qk_pos_of_d(int d) { return ((d >> 4) & 1) * 32 + ((d >> 2) & 3) * 8 + (d >> 5) * 4 + (d & 3); }

struct AL_F32  { const float* p; int ld; int pad;  __device__ __forceinline__ float operator()(int r, int k) const { return p[(size_t)r * ld + k]; } };
struct AL_BF16 { const bf16_t* p; int ld; int pad; __device__ __forceinline__ float operator()(int r, int k) const { return bf2f(p[(size_t)r * ld + k]); } };
struct AL_POOL { const bf16_t* u; int g; int pad;
    __device__ __forceinline__ float operator()(int r, int k) const {
        const int w = 2 << g, s = r & (SEQ - 1); const int n = (s + 1 < w) ? s + 1 : w; float acc = 0.f;
        for (int i = 0; i < n; ++i) acc += bf2f(u[(size_t)(r - i) * PW + g * PGD + k]);
        return acc / (float)n - bf2f(u[(size_t)r * PW + g * PGD + k]); } };

template <class AL>
__global__ __launch_bounds__(256) void ngemm(AL al, const float* __restrict__ Bm, int ldb, float* __restrict__ C, int ldc, int M, int N, int K) {
    __shared__ float As[16][68]; __shared__ float Bs[16][68];
    const int tid = threadIdx.x, tx = tid & 15, ty = tid >> 4; const int m0 = blockIdx.y * 64, n0 = blockIdx.x * 64;
    float acc[4][4] = {};
    for (int k0 = 0; k0 < K; k0 += 16) {
#pragma unroll
        for (int i = 0; i < 4; ++i) { const int e = tid + i * 256; const int r = e >> 4, kk = e & 15; As[kk][r] = (m0 + r < M) ? al(m0 + r, k0 + kk) : 0.f; }
#pragma unroll
        for (int i = 0; i < 4; ++i) { const int e = tid + i * 256; const int kk = e >> 6, c = e & 63; Bs[kk][c] = (n0 + c < N) ? Bm[(size_t)(k0 + kk) * ldb + n0 + c] : 0.f; }
        __syncthreads();
#pragma unroll
        for (int kk = 0; kk < 16; ++kk) { float a[4], b[4];
#pragma unroll
            for (int i = 0; i < 4; ++i) { a[i] = As[kk][ty * 4 + i]; b[i] = Bs[kk][tx * 4 + i]; }
#pragma unroll
            for (int i = 0; i < 4; ++i)
#pragma unroll
                for (int j = 0; j < 4; ++j) acc[i][j] = fmaf(a[i], b[j], acc[i][j]); }
        __syncthreads();
    }
#pragma unroll
    for (int i = 0; i < 4; ++i)
#pragma unroll
        for (int j = 0; j < 4; ++j) { const int r = m0 + ty * 4 + i, c = n0 + tx * 4 + j; if (r < M && c < N) C[(size_t)r * ldc + c] = acc[i][j]; }
}

__global__ void k_prep(const int* __restrict__ positions, const float* __restrict__ lam_vecs, float2* __restrict__ rope, float* __restrict__ scal, unsigned* __restrict__ ctl) {
    const int gid = blockIdx.x * blockDim.x + threadIdx.x;
    if (gid < T * 32) { const int t = gid >> 5, i = gid & 31;
        const float inv = powf(10000.0f, -(float)i * (2.0f / 64.0f)); const float ang = (float)positions[t] * inv;
        const double a = (double)ang; rope[gid] = make_float2((float)cos(a), (float)sin(a)); }
    if (gid < 16384) ctl[gid] = 0u;
    if (gid == 0) { float s01 = 0.f, s23 = 0.f; for (int i = 0; i < 64; ++i) { s01 += lam_vecs[i] * lam_vecs[64 + i]; s23 += lam_vecs[128 + i] * lam_vecs[192 + i]; }
        scal[0] = expf(s01) - expf(s23) + LAMBDA_INIT; }
}
__global__ void post_qk(const float* __restrict__ tmp, const float2* __restrict__ rope, bf16_t* __restrict__ out, int m0, int Mc, float scale) {
    const int gid = blockIdx.x * blockDim.x + threadIdx.x; if (gid >= Mc * 512) return;
    const int r = gid >> 9, p = gid & 511, hm = p >> 5, i = p & 31; const int t = m0 + r;
    const float t1 = tmp[(size_t)r * 1024 + hm * 64 + i], t2 = tmp[(size_t)r * 1024 + hm * 64 + i + 32]; const float2 cs = rope[t * 32 + i];
    out[(size_t)t * 1024 + hm * 64 + qk_pos_of_d(i)] = f2bf((t1 * cs.x - t2 * cs.y) * scale);
    out[(size_t)t * 1024 + hm * 64 + qk_pos_of_d(i + 32)] = f2bf((t2 * cs.x + t1 * cs.y) * scale);
}
__global__ void post_plain(const float* __restrict__ tmp, bf16_t* __restrict__ out, int ldo, int coloff, int m0, int Mc, int N, const float* __restrict__ colscale) {
    const int gid = blockIdx.x * blockDim.x + threadIdx.x; if (gid >= Mc * N) return;
    const int r = gid / N, c = gid % N; float v = tmp[(size_t)r * N + c]; if (colscale) v *= colscale[c];
    out[(size_t)(m0 + r) * ldo + coloff + c] = f2bf(v);
}
__global__ void post_gate(const float* __restrict__ tmp, const float* __restrict__ bias, bf16_t* __restrict__ gates, int coloff, int m0, int Mc) {
    const int gid = blockIdx.x * blockDim.x + threadIdx.x; if (gid >= Mc * 1024) return;
    const int r = gid >> 10, c = gid & 1023; const float v = tmp[(size_t)r * 1024 + c] + bias[coloff + c];
    gates[(size_t)(m0 + r) * 2048 + coloff + c] = f2bf(1.f / (1.f + expf(-v)));
}
__global__ __launch_bounds__(64) void nattn(const bf16_t* __restrict__ q, const bf16_t* __restrict__ k, const bf16_t* __restrict__ v, const float* __restrict__ scal, float* __restrict__ tmp, int m0) {
    const int lane = threadIdx.x; const int blk = blockIdx.x;
    const int half = blk & 1, head = (blk >> 1) & 7, cg = blk >> 4; const int t0 = m0 + cg * 64, t = t0 + lane; const int b = t0 / SEQ, s0 = t0 % SEQ; const int nkeys = ((s0 >> 6) + 1) * 64;
    const float lam = scal[0];
    float res[64];
    for (int mp = 0; mp < 2; ++mp) {
        const int hm = head * 2 + mp; float qv[64];
#pragma unroll
        for (int d = 0; d < 64; ++d) qv[d] = bf2f(q[(size_t)t * 1024 + hm * 64 + d]);
        float mx = -1e30f, l = 0.f; float o[64];
#pragma unroll
        for (int d = 0; d < 64; ++d) o[d] = 0.f;
        for (int j = 0; j < nkeys; ++j) { const size_t kr = (size_t)(b * SEQ + j) * 1024; float sc = 0.f;
            const uint4* kp = (const uint4*)(k + kr + hm * 64); const uint4* vp = (const uint4*)(v + kr + head * 128 + half * 64);
#pragma unroll
            for (int c = 0; c < 8; ++c) { const uint4 w = kp[c]; const unsigned ww[4] = {w.x, w.y, w.z, w.w};
#pragma unroll
                for (int e = 0; e < 4; ++e) { sc = fmaf(qv[c * 8 + 2 * e], __uint_as_float(ww[e] << 16), sc); sc = fmaf(qv[c * 8 + 2 * e + 1], __uint_as_float(ww[e] & 0xffff0000u), sc); } }
            const float mn = fmaxf(mx, sc), al = exp2f(mx - mn), p = exp2f(sc - mn); mx = mn; l = l * al + p;
#pragma unroll
            for (int c = 0; c < 8; ++c) { const uint4 w = vp[c]; const unsigned ww[4] = {w.x, w.y, w.z, w.w};
#pragma unroll
                for (int e = 0; e < 4; ++e) { o[c * 8 + 2 * e] = fmaf(p, __uint_as_float(ww[e] << 16), o[c * 8 + 2 * e] * al); o[c * 8 + 2 * e + 1] = fmaf(p, __uint_as_float(ww[e] & 0xffff0000u), o[c * 8 + 2 * e + 1] * al); } } }
        const float il = 1.f / l;
#pragma unroll
        for (int d = 0; d < 64; ++d) res[d] = (mp == 0) ? o[d] * il : res[d] - lam * o[d] * il;
    }
#pragma unroll
    for (int d = 0; d < 64; ++d) tmp[(size_t)(t - m0) * 1024 + head * 128 + half * 64 + d] = res[d];
}
__global__ void post_rms(const float* __restrict__ tmp, const float* __restrict__ gain, bf16_t* __restrict__ on, int m0, int Mc) {
    const int gid = blockIdx.x * blockDim.x + threadIdx.x; if (gid >= Mc * 8) return;
    const int r = gid >> 3, head = gid & 7; const float* p = tmp + (size_t)r * 1024 + head * 128; float ss = 0.f;
    for (int d = 0; d < 128; ++d) ss += p[d] * p[d];
    const float rs = 1.0f / sqrtf(ss * (1.f / 128.f) + RMS_EPS);
    for (int d = 0; d < 128; ++d) on[(size_t)(m0 + r) * 1024 + head * 128 + d] = f2bf(p[d] * rs * gain[d] * (1.f - LAMBDA_INIT));
}
__global__ void post_merge(const float* __restrict__ tmp, const bf16_t* __restrict__ gates, bf16_t* __restrict__ merged, int br, int m0, int Mc) {
    const int gid = blockIdx.x * blockDim.x + threadIdx.x; if (gid >= Mc * 1024) return;
    const int r = gid >> 10, c = gid & 1023; const size_t t = m0 + r; const float g = bf2f(gates[t * 2048 + br * 1024 + c]);
    float val = g * tmp[(size_t)r * 1024 + c]; if (br) val += bf2f(merged[t * 1024 + c]);
    merged[t * 1024 + c] = f2bf(val);
}
__global__ void post_y(const float* __restrict__ tmp, const float* __restrict__ x, float* __restrict__ y, int m0, int Mc) {
    const int gid = blockIdx.x * blockDim.x + threadIdx.x; if (gid >= Mc * 1024) return;
    const size_t o = (size_t)m0 * 1024 + gid; y[o] = ALPHA * x[o] + tmp[gid];
}
__device__ __forceinline__ float wave_sum(float v) {
#pragma unroll
    for (int o = 1; o < 64; o <<= 1) v += __shfl_xor(v, o);
    return v;
}
__global__ __launch_bounds__(256) void k_router(const float* __restrict__ y, const float* __restrict__ g1, const float* __restrict__ b1, const float* __restrict__ wrg, const float* __restrict__ brg,
                                                const float* __restrict__ wre, const float* __restrict__ bre, bf16_t* __restrict__ x1b, float2* __restrict__ stats, int2* __restrict__ rexp, float2* __restrict__ rw,
                                                int* __restrict__ list, unsigned* __restrict__ cnt) {
    const int lane = threadIdx.x & 63; const int t = blockIdx.x * 4 + (threadIdx.x >> 6);
    const float* yr = y + (size_t)t * 1024; float xv[16]; float s = 0.f;
#pragma unroll
    for (int j = 0; j < 4; ++j) { const f32x4 vv = *(const f32x4*)(yr + j * 256 + lane * 4); xv[4 * j] = vv.x; xv[4 * j + 1] = vv.y; xv[4 * j + 2] = vv.z; xv[4 * j + 3] = vv.w; s += (vv.x + vv.y) + (vv.z + vv.w); }
    const float mu = wave_sum(s) * (1.f / 1024.f); float s2 = 0.f;
#pragma unroll
    for (int i = 0; i < 16; ++i) { const float d = xv[i] - mu; s2 += d * d; }
    const float rstd = 1.0f / sqrtf(wave_sum(s2) * (1.f / 1024.f) + LN_EPS);
    if (lane == 0) stats[t] = make_float2(mu, rstd);
#pragma unroll
    for (int j = 0; j < 4; ++j)
#pragma unroll
        for (int i = 0; i < 4; ++i) { const int c = j * 256 + lane * 4 + i; xv[4 * j + i] = (xv[4 * j + i] - mu) * rstd * g1[c] + b1[c]; }
#pragma unroll
    for (int j = 0; j < 4; ++j) { uint2 w; w.x = (unsigned)f2bf(xv[4 * j]) | ((unsigned)f2bf(xv[4 * j + 1]) << 16); w.y = (unsigned)f2bf(xv[4 * j + 2]) | ((unsigned)f2bf(xv[4 * j + 3]) << 16);
        *(uint2*)(x1b + (size_t)t * 1024 + j * 256 + lane * 4) = w; }
    float lg[4], le[32];
#pragma unroll
    for (int o = 0; o < 4; ++o) { float a = 0.f;
#pragma unroll
        for (int j = 0; j < 4; ++j)
#pragma unroll
            for (int i = 0; i < 4; ++i) a = fmaf(xv[4 * j + i], wrg[(size_t)(j * 256 + lane * 4 + i) * 4 + o], a);
        lg[o] = wave_sum(a) + brg[o]; }
#pragma unroll
    for (int o = 0; o < 32; ++o) { float a = 0.f;
#pragma unroll
        for (int j = 0; j < 4; ++j)
#pragma unroll
            for (int i = 0; i < 4; ++i) a = fmaf(xv[4 * j + i], wre[(size_t)(j * 256 + lane * 4 + i) * 32 + o], a);
        le[o] = wave_sum(a) + bre[o]; }
    if (lane == 0) {
        int gi = 0; float gm = lg[0];
#pragma unroll
        for (int o = 1; o < 4; ++o) if (lg[o] > gm) { gm = lg[o]; gi = o; }
        float gs = 0.f;
#pragma unroll
        for (int o = 0; o < 4; ++o) gs += expf(lg[o] - gm);
        const float gp = 1.f / gs;
        float ev[8];
#pragma unroll
        for (int o = 0; o < 8; ++o) { float vsel = le[o];
#pragma unroll
            for (int g = 1; g < 4; ++g) vsel = (gi == g) ? le[g * 8 + o] : vsel;
            ev[o] = vsel; }
        int i0 = 0; float m0v = ev[0];
#pragma unroll
        for (int o = 1; o < 8; ++o) if (ev[o] > m0v) { m0v = ev[o]; i0 = o; }
        int i1 = (i0 == 0) ? 1 : 0; float m1v = -3.4e38f;
#pragma unroll
        for (int o = 0; o < 8; ++o) if (o != i0 && ev[o] > m1v) { m1v = ev[o]; i1 = o; }
        const float e1 = expf(m1v - m0v); const float w0 = gp / (1.f + e1), w1 = gp * e1 / (1.f + e1);
        const int ex0 = gi * 8 + i0, ex1 = gi * 8 + i1;
        rexp[t] = make_int2(ex0, ex1); rw[t] = make_float2(w0, w1);
        const unsigned p0 = atomicAdd(&cnt[ex0], 1u); list[(size_t)ex0 * T + p0] = t * 2;
        const unsigned p1 = atomicAdd(&cnt[ex1], 1u); list[(size_t)ex1 * T + p1] = t * 2 + 1;
    }
}
__global__ __launch_bounds__(256) void nmoe_gu(const bf16_t* __restrict__ x1b, const int* __restrict__ list, const unsigned* __restrict__ cnt, const float* __restrict__ wgu, bf16_t* __restrict__ h) {
    __shared__ float As[16][68]; __shared__ float Bg[16][68]; __shared__ float Bu[16][68]; __shared__ int toks[64];
    const int e = blockIdx.z; const int M = (int)cnt[e]; const int m0 = blockIdx.y * 64, n0 = blockIdx.x * 64; if (m0 >= M) return;
    int tb = 0; for (int i = 0; i < e; ++i) tb += ((int)cnt[i] + 255) >> 8;
    const int tid = threadIdx.x, tx = tid & 15, ty = tid >> 4;
    if (tid < 64) toks[tid] = (m0 + tid < M) ? (list[(size_t)e * T + m0 + tid] >> 1) : 0;
    __syncthreads();
    const float* W = wgu + (size_t)e * 1024 * 1024; float ag[4][4] = {}, au[4][4] = {};
    for (int k0 = 0; k0 < 1024; k0 += 16) {
#pragma unroll
        for (int i = 0; i < 4; ++i) { const int el = tid + i * 256; const int r = el >> 4, kk = el & 15; As[kk][r] = bf2f(x1b[(size_t)toks[r] * 1024 + k0 + kk]); }
#pragma unroll
        for (int i = 0; i < 4; ++i) { const int el = tid + i * 256; const int kk = el >> 6, c = el & 63; Bg[kk][c] = W[(size_t)(k0 + kk) * 1024 + n0 + c]; Bu[kk][c] = W[(size_t)(k0 + kk) * 1024 + 512 + n0 + c]; }
        __syncthreads();
#pragma unroll
        for (int kk = 0; kk < 16; ++kk) { float a[4], bg[4], bu[4];
#pragma unroll
            for (int i = 0; i < 4; ++i) { a[i] = As[kk][ty * 4 + i]; bg[i] = Bg[kk][tx * 4 + i]; bu[i] = Bu[kk][tx * 4 + i]; }
#pragma unroll
            for (int i = 0; i < 4; ++i)
#pragma unroll
                for (int j = 0; j < 4; ++j) { ag[i][j] = fmaf(a[i], bg[j], ag[i][j]); au[i][j] = fmaf(a[i], bu[j], au[i][j]); } }
        __syncthreads();
    }
#pragma unroll
    for (int i = 0; i < 4; ++i)
#pragma unroll
        for (int j = 0; j < 4; ++j) { const int r = m0 + ty * 4 + i, c = n0 + tx * 4 + j; if (r < M) { const float g = ag[i][j]; h[((size_t)tb * 256 + r) * 512 + c] = f2bf(g / (1.f + expf(-g)) * au[i][j]); } }
}
__global__ __launch_bounds__(256) void nmoe_dn(const bf16_t* __restrict__ h, const int* __restrict__ list, const unsigned* __restrict__ cnt, const float2* __restrict__ rw, const float* __restrict__ wdn, bf16_t* __restrict__ ybuf) {
    __shared__ float As[16][68]; __shared__ float Bs[16][68];
    const int e = blockIdx.z; const int M = (int)cnt[e]; const int m0 = blockIdx.y * 64, n0 = blockIdx.x * 64; if (m0 >= M) return;
    int tb = 0; for (int i = 0; i < e; ++i) tb += ((int)cnt[i] + 255) >> 8;
    const int tid = threadIdx.x, tx = tid & 15, ty = tid >> 4;
    const float* W = wdn + (size_t)e * 512 * 1024; float acc[4][4] = {};
    for (int k0 = 0; k0 < 512; k0 += 16) {
#pragma unroll
        for (int i = 0; i < 4; ++i) { const int el = tid + i * 256; const int r = el >> 4, kk = el & 15; As[kk][r] = (m0 + r < M) ? bf2f(h[((size_t)tb * 256 + m0 + r) * 512 + k0 + kk]) : 0.f; }
#pragma unroll
        for (int i = 0; i < 4; ++i) { const int el = tid + i * 256; const int kk = el >> 6, c = el & 63; Bs[kk][c] = W[(size_t)(k0 + kk) * 1024 + n0 + c]; }
        __syncthreads();
#pragma unroll
        for (int kk = 0; kk < 16; ++kk) { float a[4], b[4];
#pragma unroll
            for (int i = 0; i < 4; ++i) { a[i] = As[kk][ty * 4 + i]; b[i] = Bs[kk][tx * 4 + i]; }
#pragma unroll
            for (int i = 0; i < 4; ++i)
#pragma unroll
                for (int j = 0; j < 4; ++j) acc[i][j] = fmaf(a[i], b[j], acc[i][j]); }
        __syncthreads();
    }
#pragma unroll
    for (int i = 0; i < 4; ++i) { const int r = m0 + ty * 4 + i; if (r < M) { const int ent = list[(size_t)e * T + r]; const float2 w2 = rw[ent >> 1]; const float w = (ent & 1) ? w2.y : w2.x;
#pragma unroll
        for (int j = 0; j < 4; ++j) ybuf[(size_t)ent * 1024 + n0 + tx * 4 + j] = f2bf(w * acc[i][j]); } }
}
__global__ __launch_bounds__(256) void k_final(float* __restrict__ yout, const float2* __restrict__ stats, const float* __restrict__ g1, const float* __restrict__ b1, const bf16_t* __restrict__ ybuf,
                                               const float* __restrict__ g2, const float* __restrict__ b2) {
    const int lane = threadIdx.x & 63; const int t = blockIdx.x * 4 + (threadIdx.x >> 6);
    float* yr = yout + (size_t)t * 1024; const float2 st = stats[t]; float xv[16]; float s = 0.f;
#pragma unroll
    for (int j = 0; j < 4; ++j) { const int c0 = j * 256 + lane * 4; const f32x4 vv = *(const f32x4*)(yr + c0); const f32x4 gg = *(const f32x4*)(g1 + c0); const f32x4 bb = *(const f32x4*)(b1 + c0);
        const uint2 a = *(const uint2*)(ybuf + (size_t)(2 * t) * 1024 + c0); const uint2 b = *(const uint2*)(ybuf + (size_t)(2 * t + 1) * 1024 + c0);
        const float ya[4] = {__uint_as_float(a.x << 16), __uint_as_float(a.x & 0xffff0000u), __uint_as_float(a.y << 16), __uint_as_float(a.y & 0xffff0000u)};
        const float yb[4] = {__uint_as_float(b.x << 16), __uint_as_float(b.x & 0xffff0000u), __uint_as_float(b.y << 16), __uint_as_float(b.y & 0xffff0000u)};
#pragma unroll
        for (int i = 0; i < 4; ++i) { const float x1 = (vv[i] - st.x) * st.y * gg[i] + bb[i]; const float val = ALPHA * x1 + (ya[i] + yb[i]); xv[4 * j + i] = val; s += val; } }
    const float mu = wave_sum(s) * (1.f / 1024.f); float s2 = 0.f;
#pragma unroll
    for (int i = 0; i < 16; ++i) { const float d = xv[i] - mu; s2 += d * d; }
    const float rstd = 1.0f / sqrtf(wave_sum(s2) * (1.f / 1024.f) + LN_EPS);
#pragma unroll
    for (int j = 0; j < 4; ++j) { const int c0 = j * 256 + lane * 4; const f32x4 gg = *(const f32x4*)(g2 + c0); const f32x4 bb = *(const f32x4*)(b2 + c0); f32x4 o;
#pragma unroll
        for (int i = 0; i < 4; ++i) o[i] = (xv[4 * j + i] - mu) * rstd * gg[i] + bb[i];
        *(f32x4*)(yr + c0) = o; }
}

#define LAS __attribute__((address_space(3)))
#define GAS __attribute__((address_space(1)))
typedef short bf16x8 __attribute__((ext_vector_type(8)));
typedef unsigned u32x4 __attribute__((ext_vector_type(4)));
typedef unsigned u32x2 __attribute__((ext_vector_type(2)));
typedef GAS unsigned gu32;
#define RLX_AGENT __ATOMIC_RELAXED, __HIP_MEMORY_SCOPE_AGENT
#define LDS_WAIT() asm volatile("s_waitcnt lgkmcnt(0)" ::: "memory")
#define VM_WAIT() asm volatile("s_waitcnt vmcnt(0)" ::: "memory")

constexpr size_t WT_IN = 0;
constexpr size_t WT_A  = WT_IN + (size_t)INW * 1024;
constexpr size_t WT_B  = WT_A + 1024 * 1024;
constexpr size_t WT_O  = WT_B + 1024 * 512;
constexpr size_t WT_GU = WT_O + 1024 * 1024;
constexpr size_t WT_DN = WT_GU + (size_t)NE * 1024 * 1024;
constexpr size_t WT_END = WT_DN + (size_t)NE * 1024 * 512;
static_assert(WT_END * 2 <= 112 * MiB, "weight copies fit");
constexpr size_t MS_WPOOL = 7 * MiB;
constexpr size_t MS_WP = 7 * MiB + 512 * 1024;
constexpr size_t MS_CSBW = 6 * MiB + 1024;
constexpr size_t WS_POOLED = 448 * MiB;

constexpr int CW_CNT = 0;
constexpr int CW_BAR = 1024;
constexpr int CW_TDONE = 12288;

constexpr int NWAVES = 8, NTHREADS = 512;
constexpr int RING_BYTES = 131072, LDS_CTL_OFF = 147456, MISC_OFF = LDS_CTL_OFF + 320, LDS_BYTES = 163840;

typedef float f32x2_t __attribute__((ext_vector_type(2))); typedef __bf16 bf16x2_t __attribute__((ext_vector_type(2)));
__device__ __forceinline__ unsigned cvt_pk_bf16(float lo, float hi) { f32x2_t v = {lo, hi}; bf16x2_t b = __builtin_convertvector(v, bf16x2_t); return __builtin_bit_cast(unsigned, b); }
__device__ __forceinline__ float bflo(unsigned w) { return __uint_as_float(w << 16); }
__device__ __forceinline__ float bfhi(unsigned w) { return __uint_as_float(w & 0xffff0000u); }

#define XB_TMO      128
#define XB_XCNT(j)  (256  + 64 * (j))
#define XB_XSUB(j)  (1280 + 64 * (j))
#define XB_XGEN(j)  (2304 + 64 * (j))
#define XB_TOP      3328
#define XB_TOPGEN   3392
#define XCD_BAR_WORDS 3456
#define XB_SPIN_CAP (1u << 22)
__device__ __forceinline__ unsigned xb_ld(unsigned* p)              { return __hip_atomic_load(p, __ATOMIC_RELAXED, __HIP_MEMORY_SCOPE_AGENT); }
__device__ __forceinline__ unsigned xb_add(unsigned* p, unsigned v) { return __hip_atomic_fetch_add(p, v, __ATOMIC_RELAXED, __HIP_MEMORY_SCOPE_AGENT); }
__device__ __forceinline__ unsigned xb_xcc_id() { return (unsigned)__builtin_amdgcn_s_getreg((3 << 11) | 20) & 0xFu; }
#define XB_SPIN(cond, bar) do { unsigned _sp = 0; while (cond) { __builtin_amdgcn_s_sleep(1); \
    if ((++_sp & 255u) == 0u) { if (xb_ld(&(bar)[XB_TMO])) break; if (_sp > XB_SPIN_CAP) { atomicAdd(&(bar)[XB_TMO], 1u); break; } } } } while (0)
struct XcdBarrier { unsigned* bar; unsigned x; volatile LAS unsigned* st; };
__device__ __forceinline__ XcdBarrier xcd_barrier_post(unsigned* bar, volatile LAS unsigned* st) {
    XcdBarrier b; b.bar = bar; b.x = xb_xcc_id(); b.st = st;
    if (threadIdx.x == 0) (void)xb_add(&bar[XB_XCNT(b.x)], 1u);
    return b;
}
__device__ __forceinline__ void xcd_barrier_complete(unsigned* bar, unsigned x, unsigned& nloc, unsigned& nx) {
    const unsigned G = gridDim.x * gridDim.y * gridDim.z;
    unsigned sum, cnt, mine, sp = 0u;
    for (;;) {
        sum = 0u; cnt = 0u; mine = 0u;
#pragma unroll
        for (unsigned j = 0; j < 16; ++j) { const unsigned c = xb_ld(&bar[XB_XCNT(j)]); sum += c; cnt += (c > 0u) ? 1u : 0u; mine = (j == x) ? c : mine; }
        if (sum == G) break;
        __builtin_amdgcn_s_sleep(1);
        if ((++sp & 255u) == 0u) { if (xb_ld(&bar[XB_TMO])) break; if (sp > XB_SPIN_CAP) { atomicAdd(&bar[XB_TMO], 1u); break; } }
    }
    nloc = mine > 0u ? mine : 1u; nx = cnt > 0u ? cnt : 1u;
}
__device__ __forceinline__ void xcd_barrier(const XcdBarrier& b) {
    asm volatile("s_waitcnt vmcnt(0)" ::: "memory");
    __syncthreads();
    if (threadIdx.x == 0) {
        unsigned* bar = b.bar;
        __builtin_amdgcn_s_waitcnt(0);
        unsigned nloc = b.st[0], nx = b.st[1];
        if (nloc == 0u) { xcd_barrier_complete(bar, b.x, nloc, nx); b.st[0] = nloc; b.st[1] = nx; }
        const unsigned old = xb_add(&bar[XB_XSUB(b.x)], 1u);
        const unsigned gen = old / nloc;
        if (old + 1u == (gen + 1u) * nloc) {
            __builtin_amdgcn_fence(__ATOMIC_RELEASE, "agent");
            asm volatile("s_waitcnt vmcnt(0)" ::: "memory");
            const unsigned og = xb_add(&bar[XB_TOP], 1u);
            const unsigned tg = og / nx;
            if (og + 1u == (tg + 1u) * nx) xb_add(&bar[XB_TOPGEN], 1u);
            else XB_SPIN(xb_ld(&bar[XB_TOPGEN]) == tg, bar);
            __builtin_amdgcn_fence(__ATOMIC_ACQUIRE, "agent");
            xb_add(&bar[XB_XGEN(b.x)], 1u);
            asm volatile("s_waitcnt vmcnt(0)" ::: "memory");
        } else {
            XB_SPIN(xb_ld(&bar[XB_XGEN(b.x)]) == gen, bar);
            __builtin_amdgcn_fence(__ATOMIC_ACQUIRE, "agent");
            asm volatile("s_waitcnt vmcnt(0)" ::: "memory");
        }
    }
    __syncthreads();
}

namespace g8 {
constexpr int BM = 256, BK = 64, HALF = 128, HTB = HALF * BK * 2, NXCD = 8, WGM = 8;
__host__ __device__ __forceinline__ int lds_byte(int r, int c) { const int st = (r >> 4) * 2 + (c >> 5), rr = r & 15, cc = c & 31, ob = rr * 64 + cc * 2; return st * 1024 + (ob ^ (((ob >> 9) & 1) << 5)); }
__host__ __device__ __forceinline__ void stage_rc(int b, int& R, int& C) { const int st = b / 1024, sb = b % 1024, swz = sb ^ (((sb >> 9) & 1) << 5); R = (st >> 1) * 16 + swz / 64; C = (st & 1) * 32 + (swz % 64) / 2; }
__host__ __device__ __forceinline__ int perm32(int rho) { const int n = rho >> 4, i = rho & 15; return 8 * (i >> 2) + 4 * n + (i & 3); }

struct GUnit { const char* A; const char* B; int pm, pn, e, r0; };

struct DenseOrder {
    const char* Abase; const char* Bbase; int nM, nN, nwg, G, c; size_t tstep;
    __device__ void init(const void* A, const void* Bt, int M, int N, int K, int G_, int c_) { Abase = (const char*)A; Bbase = (const char*)Bt; nM = M / BM; nN = N / BM; nwg = nM * nN; G = G_; c = c_; tstep = (size_t)BM * K * 2; }
    __device__ bool next(int i, GUnit& u) const {
        const long L = (long)i * G + c; if (L >= nwg) return false;
        int wgid = (int)L; { const int q = nwg / NXCD, r = nwg % NXCD, xcd = wgid % NXCD, off = wgid / NXCD; wgid = (xcd < r ? xcd * (q + 1) : r * (q + 1) + (xcd - r) * q) + off; }
        const int nig = WGM * nN, gid = wgid / nig, fm = gid * WGM, gsz = (nM - fm) < WGM ? (nM - fm) : WGM;
        u.pm = fm + ((wgid % nig) % gsz); u.pn = (wgid % nig) / gsz; u.e = 0; u.r0 = 0;
        u.A = Abase + (size_t)u.pm * tstep; u.B = Bbase + (size_t)u.pn * tstep; return true;
    }
    __device__ __forceinline__ unsigned rowoff(const GUnit&, int) const { return 0u; }
    __device__ __forceinline__ void a_ready(const GUnit&) const {}
    __device__ __forceinline__ void done(const GUnit&) const {}
};
struct MoeOrder {
    const char* Abase; const char* Bbase; const int* list; const volatile LAS unsigned* tb; const volatile LAS unsigned* cntl; int nwg, G, c; size_t atile, bexp, btile; int gather;
    unsigned* tdone; int mode;
    __device__ bool next(int i, GUnit& u) const {
        const long L = (long)i * G + c; if (L >= nwg) return false;
        int wgid = (int)L; { const int q = nwg / NXCD, r = nwg % NXCD, xcd = wgid % NXCD, off = wgid / NXCD; wgid = (xcd < r ? xcd * (q + 1) : r * (q + 1) + (xcd - r) * q) + off; }
        const int tile = wgid >> 2; u.pn = wgid & 3; u.pm = tile;
        int e = 0; for (int j = 1; j < NE; ++j) e = ((int)tb[j] <= tile) ? j : e;
        e = __builtin_amdgcn_readfirstlane(e); u.e = e; u.r0 = __builtin_amdgcn_readfirstlane((tile - (int)tb[e]) * 256);
        u.A = gather ? Abase : Abase + (size_t)tile * atile; u.B = Bbase + (size_t)e * bexp + (size_t)u.pn * btile; return true;
    }
    __device__ __forceinline__ unsigned rowoff(const GUnit& u, int rr) const {
        const int p = u.r0 + rr; const int tok = (p < (int)cntl[u.e]) ? (list[(size_t)u.e * T + p] >> 1) : 0; return (unsigned)tok * 2048u; }
    __device__ __forceinline__ void done(const GUnit& u) const {
        if (mode == 1) { asm volatile("s_waitcnt vmcnt(0)" ::: "memory"); if ((threadIdx.x & 63) == 0) __hip_atomic_fetch_add(tdone + u.pm, 1u, __ATOMIC_RELAXED, __HIP_MEMORY_SCOPE_AGENT); } }
    __device__ __forceinline__ void a_ready(const GUnit& u) const {
        if (mode == 2) {
            if (threadIdx.x < 64) { unsigned sp = 0;
                while ((unsigned)__builtin_amdgcn_readfirstlane(__hip_atomic_load(tdone + u.pm, __ATOMIC_RELAXED, __HIP_MEMORY_SCOPE_AGENT)) < 32u) { __builtin_amdgcn_s_sleep(2); if (++sp > (1u << 22)) break; }
                __builtin_amdgcn_fence(__ATOMIC_ACQUIRE, "agent"); asm volatile("s_waitcnt vmcnt(0)" ::: "memory"); }
            asm volatile("" ::: "memory"); __builtin_amdgcn_s_barrier(); asm volatile("" ::: "memory"); } }
};

template <class Epi, class Sched, bool ALIGN_EPI, bool GATHER>
__device__ __forceinline__ void gemm_phase(LAS unsigned char* lds, const int K, const Sched& S, const Epi& E) {
    const int tid = threadIdx.x, wid = __builtin_amdgcn_readfirstlane(tid >> 6), lane = tid & 63, wr = wid >> 2, wc = wid & 3, fr = lane & 15, fq = lane >> 4;
    const int nt = K / BK;
    unsigned voffA[2], voffB[2]; int RA[2], CA[2];
#pragma unroll
    for (int i = 0; i < 2; ++i) { int R, C; stage_rc(tid * 16 + i * 8192, R, C); const int Rb = Epi::PERM ? ((R & ~31) + perm32(R & 31)) : R;
        voffA[i] = (unsigned)(R * K + C) * 2u; voffB[i] = (unsigned)(Rb * K + C) * 2u; RA[i] = R; CA[i] = C; }
    const size_t kstep = (size_t)(BK * 2);
    const size_t hstep = (size_t)HALF * K * 2;
    const unsigned ldsw = (unsigned)wid * 1024u;
    const int aoff = lds_byte(wr * 64 + fr, fq * 8), boff = lds_byte(wc * 32 + fr, fq * 8);
#define G8_SA(b, h) (((b) * 2 + (h)) * HTB)
#define G8_SB(b, h) ((4 + (b) * 2 + (h)) * HTB)
#define G8_STAGE(bufoff, gbase, o0, o1) do { \
        __builtin_amdgcn_global_load_lds((const unsigned*)((const char*)(gbase) + (o0)), (LAS unsigned*)(lds + (bufoff) + ldsw), 16, 0, 0); \
        __builtin_amdgcn_global_load_lds((const unsigned*)((const char*)(gbase) + (o1)), (LAS unsigned*)(lds + (bufoff) + ldsw + 8192), 16, 0, 0); } while (0)
#define G8_STAGE_B(bufoff, gbase) G8_STAGE(bufoff, gbase, voffB[0], voffB[1])
#define G8_LDA(dst, b, h) do { _Pragma("unroll") for (int m = 0; m < 4; ++m) _Pragma("unroll") for (int k = 0; k < 2; ++k) dst[m][k] = *(const LAS bf16x8*)(lds + G8_SA(b, h) + aoff + m * 2048 + k * 1024); } while (0)
#define G8_LDB(dst, b, h) do { _Pragma("unroll") for (int n = 0; n < 2; ++n) _Pragma("unroll") for (int k = 0; k < 2; ++k) dst[n][k] = *(const LAS bf16x8*)(lds + G8_SB(b, h) + boff + n * 2048 + k * 1024); } while (0)
#define G8_MMA(ai, bj, At, Bt) do { __builtin_amdgcn_s_setprio(1); _Pragma("unroll") for (int m = 0; m < 4; ++m) _Pragma("unroll") for (int n = 0; n < 2; ++n) _Pragma("unroll") for (int k = 0; k < 2; ++k) \
        acc[ai][bj][m][n] = __builtin_amdgcn_mfma_f32_16x16x32_bf16(Bt[n][k], At[m][k], acc[ai][bj][m][n], 0, 0, 0); __builtin_amdgcn_s_setprio(0); } while (0)
#ifdef G8_DRAIN
#define G8_WAIT_V(n) asm volatile("s_waitcnt vmcnt(0)" ::: "memory")
#else
#define G8_WAIT_V(n) asm volatile("s_waitcnt vmcnt(" #n ")" ::: "memory")
#endif
#define G8_WAIT_L(n) asm volatile("s_waitcnt lgkmcnt(" #n ")" ::: "memory")
#define G8_BAR __builtin_amdgcn_s_barrier()
#define G8_SCHED __builtin_amdgcn_sched_barrier(0)
    GUnit cur, nxt; int ui = 0;
    if (!S.next(0, cur)) return;
    unsigned cao[2][2], nao[2][2];
#pragma unroll
    for (int h = 0; h < 2; ++h)
#pragma unroll
        for (int i = 0; i < 2; ++i) { cao[h][i] = GATHER ? S.rowoff(cur, h * HALF + RA[i]) + (unsigned)CA[i] * 2u : voffA[i] + (unsigned)(h * hstep); nao[h][i] = cao[h][i]; }
    f32x4 acc[2][2][4][2];
#pragma unroll
    for (int a = 0; a < 2; ++a)
#pragma unroll
        for (int b = 0; b < 2; ++b)
#pragma unroll
            for (int m = 0; m < 4; ++m)
#pragma unroll
                for (int n = 0; n < 2; ++n) acc[a][b][m][n] = (f32x4){0.f, 0.f, 0.f, 0.f};
    bf16x8 At[4][2], B0[2][2], B1[2][2];
    const char* cA = cur.A; const char* cB = cur.B;
    S.a_ready(cur);
    G8_STAGE_B(G8_SB(0, 0), cB); G8_STAGE_B(G8_SB(0, 1), cB + hstep); G8_STAGE(G8_SA(0, 0), cA, cao[0][0], cao[0][1]); G8_STAGE(G8_SA(0, 1), cA, cao[1][0], cao[1][1]);
    if (wr == 1) G8_BAR;
    G8_WAIT_V(2); G8_BAR;
    G8_STAGE_B(G8_SB(1, 0), cB + kstep); G8_STAGE(G8_SA(1, 0), cA + kstep, cao[0][0], cao[0][1]); G8_STAGE_B(G8_SB(1, 1), cB + hstep + kstep);
    G8_WAIT_V(6); G8_BAR;
    for (;;) {
        const bool has_next = S.next(ui + 1, nxt);
        if (GATHER && has_next) {
#pragma unroll
            for (int h = 0; h < 2; ++h)
#pragma unroll
                for (int i = 0; i < 2; ++i) nao[h][i] = S.rowoff(nxt, h * HALF + RA[i]) + (unsigned)CA[i] * 2u;
        }
        const char* nA = has_next ? nxt.A : cA; const char* nB = has_next ? nxt.B : cB;
        asm volatile(".p2align 8" ::: "memory");
        for (int t = 0; t < nt; t += 2) {
            const bool last = (t == nt - 2);
            if (last && has_next) S.a_ready(nxt);
            const char* a1 = cA + (size_t)(t + 1) * kstep;
            const char* a2 = last ? nA : cA + (size_t)(t + 2) * kstep; const char* b2 = last ? nB : cB + (size_t)(t + 2) * kstep;
            const char* a3 = a2 + kstep; const char* b3 = b2 + kstep;
            asm volatile("" : "+s"(a1), "+s"(a2), "+s"(b2), "+s"(a3), "+s"(b3));
            unsigned o2[2][2];
#pragma unroll
            for (int h = 0; h < 2; ++h)
#pragma unroll
                for (int i = 0; i < 2; ++i) o2[h][i] = (GATHER && last && has_next) ? nao[h][i] : cao[h][i];
            G8_LDB(B0, 0, 0); G8_LDB(B1, 0, 1); G8_SCHED; G8_LDA(At, 0, 0); G8_STAGE(G8_SA(1, 1), a1, cao[1][0], cao[1][1]);
            G8_WAIT_V(8); G8_WAIT_L(0); G8_BAR; G8_MMA(0, 0, At, B0); G8_MMA(0, 1, At, B1); G8_BAR; G8_SCHED;
            G8_LDA(At, 0, 1); G8_STAGE_B(G8_SB(0, 0), b2); G8_STAGE_B(G8_SB(0, 1), b2 + hstep); G8_STAGE(G8_SA(0, 0), a2, o2[0][0], o2[0][1]);
            G8_WAIT_V(8); G8_WAIT_L(0); G8_BAR; G8_MMA(1, 0, At, B0); G8_MMA(1, 1, At, B1); G8_BAR; G8_SCHED;
            G8_LDB(B0, 1, 0); G8_LDB(B1, 1, 1); G8_SCHED; G8_LDA(At, 1, 0); G8_STAGE(G8_SA(0, 1), a2, o2[1][0], o2[1][1]);
            G8_WAIT_V(8); G8_WAIT_L(0); G8_BAR; G8_MMA(0, 0, At, B0); G8_MMA(0, 1, At, B1); G8_BAR; G8_SCHED;
            G8_LDA(At, 1, 1); G8_STAGE_B(G8_SB(1, 0), b3); G8_STAGE_B(G8_SB(1, 1), b3 + hstep); G8_STAGE(G8_SA(1, 0), a3, o2[0][0], o2[0][1]);
            G8_WAIT_V(8); G8_WAIT_L(0); G8_BAR; G8_MMA(1, 0, At, B0); G8_MMA(1, 1, At, B1); G8_BAR; G8_SCHED;
        }
        if constexpr (ALIGN_EPI) { if (wr == 0) G8_BAR; }
        {
          GUnit eu = cur; int fr_ = fr, fq_ = fq; asm volatile("" : "+s"(eu.pm), "+s"(eu.pn), "+s"(eu.e), "+s"(eu.r0)); asm volatile("" : "+v"(fr_), "+v"(fq_));
          E(acc, eu, wr, wc, fr_, fq_); S.done(cur); }
        if (!has_next) break;
#pragma unroll
        for (int a = 0; a < 2; ++a)
#pragma unroll
            for (int b = 0; b < 2; ++b)
#pragma unroll
                for (int m = 0; m < 4; ++m)
#pragma unroll
                    for (int n = 0; n < 2; ++n) acc[a][b][m][n] = (f32x4){0.f, 0.f, 0.f, 0.f};
        cur = nxt; cA = nA; cB = nB; ++ui;
#pragma unroll
        for (int h = 0; h < 2; ++h)
#pragma unroll
            for (int i = 0; i < 2; ++i) cao[h][i] = nao[h][i];
        if constexpr (ALIGN_EPI) { if (wr == 1) G8_BAR; }
    }
    G8_WAIT_V(0);
    if constexpr (!ALIGN_EPI) { if (wr == 0) G8_BAR; }
    G8_BAR;
#undef G8_SA
#undef G8_SB
#undef G8_STAGE
#undef G8_STAGE_B
#undef G8_LDA
#undef G8_LDB
#undef G8_MMA
#undef G8_WAIT_V
#undef G8_WAIT_L
#undef G8_BAR
#undef G8_SCHED
}

__device__ __forceinline__ u32x4 pack8(const f32x4 v0, const f32x4 v1) { u32x4 w; w.x = cvt_pk_bf16(v0[0], v0[1]); w.y = cvt_pk_bf16(v0[2], v0[3]); w.z = cvt_pk_bf16(v1[0], v1[1]); w.w = cvt_pk_bf16(v1[2], v1[3]); return w; }
__device__ __forceinline__ float sigmoidf_(float v) { return __builtin_amdgcn_rcpf(1.f + __builtin_amdgcn_exp2f(-1.4426950408889634f * v)); }

struct EpiProj {
    static constexpr bool PERM = true;
    bf16_t *qb, *kb, *vb, *ub, *gb; const float* rope; const float* gate_bias;
    __device__ __forceinline__ void operator()(const f32x4 (&acc)[2][2][4][2], const GUnit& u, int wr, int wc, int fr, int fq) const {
        const int row0 = u.pm * BM + wr * 64 + fr; const int cw = wc * 32 + 8 * fq; const int pn = u.pn;
#ifdef DBG_PLAIN_EPI
        if (pn < 8) { bf16_t* base = (pn < 4 ? qb : kb) + (pn & 3) * 256 + cw;
            for (int ai = 0; ai < 2; ++ai) for (int m = 0; m < 4; ++m) { const int t = row0 + ai * HALF + m * 16; for (int bj = 0; bj < 2; ++bj) *(u32x4*)(base + (size_t)t * 1024 + bj * HALF) = pack8(acc[ai][bj][m][0], acc[ai][bj][m][1]); } }
        else
#endif
        if (pn < 8) {
            bf16_t* base = (pn < 4 ? qb : kb) + (pn & 3) * 256 + cw; const float sc = pn < 4 ? QSCALE : 1.f; const int fi = 16 * (wc & 1) + 4 * fq;
#pragma unroll
            for (int ai = 0; ai < 2; ++ai)
#pragma unroll
                for (int m = 0; m < 4; ++m) { const int t = row0 + ai * HALF + m * 16; const f32x4 cs0 = *(const f32x4*)(rope + ((size_t)t * 32 + fi) * 2), cs1 = *(const f32x4*)(rope + ((size_t)t * 32 + fi) * 2 + 4);
                    const f32x4 c = {cs0[0], cs0[2], cs1[0], cs1[2]}, s = {cs0[1], cs0[3], cs1[1], cs1[3]};
#pragma unroll
                    for (int bj = 0; bj < 2; ++bj) { const f32x4 t1 = acc[ai][bj][m][0], t2 = acc[ai][bj][m][1]; const f32x4 o1 = (t1 * c - t2 * s) * sc, o2 = (t2 * c + t1 * s) * sc;
                        *(u32x4*)(base + (size_t)t * 1024 + bj * HALF) = pack8(o1, o2); } }
        } else if (pn < 14) {
            bf16_t* base; int ld; if (pn < 12) { base = vb + (pn - 8) * 256 + cw; ld = 1024; } else { base = ub + (pn - 12) * 256 + cw; ld = 512; }
#pragma unroll
            for (int ai = 0; ai < 2; ++ai)
#pragma unroll
                for (int m = 0; m < 4; ++m) { const int t = row0 + ai * HALF + m * 16;
#pragma unroll
                    for (int bj = 0; bj < 2; ++bj) *(u32x4*)(base + (size_t)t * ld + bj * HALF) = pack8(acc[ai][bj][m][0], acc[ai][bj][m][1]); }
        }
#ifdef DBG_PLAIN_EPI
        else { const int col0 = (pn - 14) * 256 + cw;
            for (int ai = 0; ai < 2; ++ai) for (int m = 0; m < 4; ++m) { const int t = row0 + ai * HALF + m * 16; for (int bj = 0; bj < 2; ++bj) *(u32x4*)(gb + (size_t)t * 2048 + col0 + bj * HALF) = pack8(acc[ai][bj][m][0], acc[ai][bj][m][1]); } }
#else
        else {
            const int col0 = (pn - 14) * 256 + cw; f32x4 bv[2][2];
#pragma unroll
            for (int bj = 0; bj < 2; ++bj)
#pragma unroll
                for (int n = 0; n < 2; ++n) bv[bj][n] = *(const f32x4*)(gate_bias + col0 + bj * HALF + 4 * n);
#pragma unroll
            for (int ai = 0; ai < 2; ++ai)
#pragma unroll
                for (int m = 0; m < 4; ++m) { const int t = row0 + ai * HALF + m * 16;
#pragma unroll
                    for (int bj = 0; bj < 2; ++bj) { f32x4 v0 = acc[ai][bj][m][0] + bv[bj][0], v1 = acc[ai][bj][m][1] + bv[bj][1];
#pragma unroll
                        for (int j = 0; j < 4; ++j) { v0[j] = sigmoidf_(v0[j]); v1[j] = sigmoidf_(v1[j]); }
                        *(u32x4*)(gb + (size_t)t * 2048 + col0 + bj * HALF) = pack8(v0, v1); } }
        }
#endif
    }
};
struct EpiScaleBf16 {
    static constexpr bool PERM = true;
    bf16_t* O; int ldc; const float* colscale;
    __device__ __forceinline__ void operator()(const f32x4 (&acc)[2][2][4][2], const GUnit& u, int wr, int wc, int fr, int fq) const {
        const int row0 = u.pm * BM + wr * 64 + fr, col0 = u.pn * BM + wc * 32 + 8 * fq; f32x4 sv[2][2];
#pragma unroll
        for (int bj = 0; bj < 2; ++bj)
#pragma unroll
            for (int n = 0; n < 2; ++n) sv[bj][n] = *(const f32x4*)(colscale + col0 + bj * HALF + 4 * n);
#pragma unroll
        for (int ai = 0; ai < 2; ++ai)
#pragma unroll
            for (int m = 0; m < 4; ++m) { bf16_t* rowp = O + (size_t)(row0 + ai * HALF + m * 16) * ldc + col0;
#pragma unroll
                for (int bj = 0; bj < 2; ++bj) *(u32x4*)(rowp + bj * HALF) = pack8(acc[ai][bj][m][0] * sv[bj][0], acc[ai][bj][m][1] * sv[bj][1]); }
    }
};
template <int BR> struct EpiMerge {
    static constexpr bool PERM = true;
    const bf16_t* gates; bf16_t* merged; bf16_t* dst;
    __device__ __forceinline__ void operator()(const f32x4 (&acc)[2][2][4][2], const GUnit& u, int wr, int wc, int fr, int fq) const {
        const int row0 = u.pm * BM + wr * 64 + fr, col0 = u.pn * BM + wc * 32 + 8 * fq;
#pragma unroll
        for (int ai = 0; ai < 2; ++ai)
#pragma unroll
            for (int m = 0; m < 4; ++m) { const size_t t = row0 + ai * HALF + m * 16;
#pragma unroll
                for (int bj = 0; bj < 2; ++bj) { const u32x4 g = *(const u32x4*)(gates + t * 2048 + BR * 1024 + col0 + bj * HALF); bf16_t* mp = merged + t * 1024 + col0 + bj * HALF;
                    f32x4 v0 = acc[ai][bj][m][0], v1 = acc[ai][bj][m][1];
                    v0 = v0 * (f32x4){bflo(g.x), bfhi(g.x), bflo(g.y), bfhi(g.y)}; v1 = v1 * (f32x4){bflo(g.z), bfhi(g.z), bflo(g.w), bfhi(g.w)};
                    if (BR) { const u32x4 p = *(const u32x4*)mp; v0 = v0 + (f32x4){bflo(p.x), bfhi(p.x), bflo(p.y), bfhi(p.y)}; v1 = v1 + (f32x4){bflo(p.z), bfhi(p.z), bflo(p.w), bfhi(p.w)}; }
                    *(u32x4*)(dst + t * 1024 + col0 + bj * HALF) = pack8(v0, v1); } }
    }
};
struct EpiResid {
    static constexpr bool PERM = false;
    const float* x; float* y; float2* part;
    __device__ __forceinline__ void operator()(const f32x4 (&acc)[2][2][4][2], const GUnit& u, int wr, int wc, int fr, int fq) const {
        const int row0 = u.pm * BM + wr * 64 + fr, col0 = u.pn * BM + wc * 32 + 4 * fq;
#pragma unroll
        for (int ai = 0; ai < 2; ++ai)
#pragma unroll
            for (int m = 0; m < 4; ++m) { const size_t row = (size_t)(row0 + ai * HALF + m * 16); const size_t off = row * 1024 + col0; float s1 = 0.f, s2 = 0.f;
#pragma unroll
                for (int bj = 0; bj < 2; ++bj)
#pragma unroll
                    for (int n = 0; n < 2; ++n) { const f32x4 xv = *(const f32x4*)(x + off + bj * HALF + n * 16); const f32x4 yv = xv * ALPHA + acc[ai][bj][m][n]; *(f32x4*)(y + off + bj * HALF + n * 16) = yv;
                        s1 += (yv[0] + yv[1]) + (yv[2] + yv[3]); s2 += (yv[0] * yv[0] + yv[1] * yv[1]) + (yv[2] * yv[2] + yv[3] * yv[3]); }
                s1 += __shfl_xor(s1, 16); s1 += __shfl_xor(s1, 32); s2 += __shfl_xor(s2, 16); s2 += __shfl_xor(s2, 32);
                if (fq == 0) part[row * 16 + u.pn * 4 + wc] = make_float2(s1, s2); }
    }
};
struct EpiGateUp {
    static constexpr bool PERM = true;
    bf16_t* h;
    __device__ __forceinline__ void operator()(const f32x4 (&acc)[2][2][4][2], const GUnit& u, int wr, int wc, int fr, int fq) const {
        const int row0 = u.pm * BM + wr * 64 + fr, col0 = u.pn * 128 + wc * 16 + 4 * fq;
#pragma unroll
        for (int ai = 0; ai < 2; ++ai)
#pragma unroll
            for (int m = 0; m < 4; ++m) { bf16_t* rowp = h + (size_t)(row0 + ai * HALF + m * 16) * 512 + col0;
#pragma unroll
                for (int bj = 0; bj < 2; ++bj) { const f32x4 g = acc[ai][bj][m][0], up = acc[ai][bj][m][1]; f32x4 o;
#pragma unroll
                    for (int j = 0; j < 4; ++j) o[j] = g[j] * sigmoidf_(g[j]) * up[j];
                    const unsigned long long w = (unsigned long long)cvt_pk_bf16(o[0], o[1]) | ((unsigned long long)cvt_pk_bf16(o[2], o[3]) << 32);
                    __hip_atomic_store((unsigned long long*)(rowp + bj * 64), w, __ATOMIC_RELAXED, __HIP_MEMORY_SCOPE_AGENT); } }
    }
};
struct EpiDown {
    static constexpr bool PERM = true;
    bf16_t* ybuf; const int* list; const float* rw; const volatile LAS unsigned* cntl;
    __device__ __forceinline__ void operator()(const f32x4 (&acc)[2][2][4][2], const GUnit& u, int wr, int wc, int fr, int fq) const {
        const int p0 = u.r0 + wr * 64 + fr, col0 = u.pn * BM + wc * 32 + 8 * fq; const int cn = (int)cntl[u.e];
#pragma unroll
        for (int ai = 0; ai < 2; ++ai)
#pragma unroll
            for (int m = 0; m < 4; ++m) { const int p = p0 + ai * HALF + m * 16;
                if (p < cn) { const int ent = list[(size_t)u.e * T + p]; const float w = rw[ent]; bf16_t* rowp = ybuf + (size_t)ent * 1024 + col0;
#pragma unroll
                    for (int bj = 0; bj < 2; ++bj) *(u32x4*)(rowp + bj * HALF) = pack8(acc[ai][bj][m][0] * w, acc[ai][bj][m][1] * w); } }
    }
};
}

namespace at2 {
using f32x16 = __attribute__((ext_vector_type(16))) float;
using s16x4  = __attribute__((ext_vector_type(4))) short;
constexpr int KB_BYTES = 8192, VB_BYTES = 16384, KSLOT = 2 * KB_BYTES, NKS = 4, NVS = 3, OFF_V = NKS * KSLOT;
constexpr int OFF_Q = OFF_V + NVS * VB_BYTES, OFF_WS = 151552;
#define AT_SBAR() __builtin_amdgcn_sched_barrier(0)
__device__ __forceinline__ int crow(int r, int hi) { return (r & 3) + 8 * (r >> 2) + 4 * hi; }
__device__ __forceinline__ int v_st(int k, int c) { const int kk = (k & ~0xC) | ((k & 4) << 1) | ((k & 8) >> 1); return ((kk >> 3) * 4 + (c >> 5)) * 512 + ((kk & 7) * 32 + (c & 31)) * 2; }
__device__ __forceinline__ int v_rd_base(int lane) { return ((lane & 3) << 3) | (((lane >> 2) & 3) << 6) | (((lane >> 4) & 1) << 5) | (((lane >> 5) & 1) << 8); }
constexpr int v_rd_off(int d0, int ks, int half) { return d0 * 512 + ks * 4096 + half * 2048; }
template <int OFF> __device__ __forceinline__ s16x4 tr_read(int vb) { s16x4 r; asm volatile("ds_read_b64_tr_b16 %0, %1 offset:%2" : "=&v"(r) : "v"(vb), "i"(OFF) : "memory"); return r; }
template <int D0> __device__ __forceinline__ void pv_one(f32x16& od, int vb, bf16x8 pa0, bf16x8 pa1, bf16x8 pa2, bf16x8 pa3) {
    const s16x4 l0 = tr_read<v_rd_off(D0, 0, 0)>(vb), h0 = tr_read<v_rd_off(D0, 0, 1)>(vb), l1 = tr_read<v_rd_off(D0, 1, 0)>(vb), h1 = tr_read<v_rd_off(D0, 1, 1)>(vb);
    const s16x4 l2 = tr_read<v_rd_off(D0, 2, 0)>(vb), h2 = tr_read<v_rd_off(D0, 2, 1)>(vb), l3 = tr_read<v_rd_off(D0, 3, 0)>(vb), h3 = tr_read<v_rd_off(D0, 3, 1)>(vb);
    asm volatile("s_waitcnt lgkmcnt(0)" ::: "memory"); AT_SBAR();
#define AT_PK(L, H) (bf16x8){L[0], L[1], L[2], L[3], H[0], H[1], H[2], H[3]}
    od = __builtin_amdgcn_mfma_f32_32x32x16_bf16(pa0, AT_PK(l0, h0), od, 0, 0, 0);
    od = __builtin_amdgcn_mfma_f32_32x32x16_bf16(pa1, AT_PK(l1, h1), od, 0, 0, 0);
    od = __builtin_amdgcn_mfma_f32_32x32x16_bf16(pa2, AT_PK(l2, h2), od, 0, 0, 0);
    od = __builtin_amdgcn_mfma_f32_32x32x16_bf16(pa3, AT_PK(l3, h3), od, 0, 0, 0);
#undef AT_PK
}
__device__ __forceinline__ void qkt(f32x16& p0, f32x16& p1, const LAS unsigned char* Ks, const bf16x8* qr, int r32, int hi) {
    p0 = f32x16{}; p1 = f32x16{};
#pragma unroll
    for (int d0 = 0; d0 < 4; ++d0) { const LAS unsigned char* kp = Ks + (2 * d0 + hi) * 1024 + r32 * 16;
        const bf16x8 b0 = *(const LAS bf16x8*)(kp), b1 = *(const LAS bf16x8*)(kp + 512);
        p0 = __builtin_amdgcn_mfma_f32_32x32x16_bf16(b0, qr[d0], p0, 0, 0, 0);
        p1 = __builtin_amdgcn_mfma_f32_32x32x16_bf16(b1, qr[d0], p1, 0, 0, 0); }
}
__device__ __forceinline__ float hswap_max(float v) { auto rr = __builtin_amdgcn_permlane32_swap(__float_as_uint(v), __float_as_uint(v), false, false); return fmaxf(__uint_as_float(rr[0]), __uint_as_float(rr[1])); }
__device__ __forceinline__ float hswap_sum(float v) { auto rr = __builtin_amdgcn_permlane32_swap(__float_as_uint(v), __float_as_uint(v), false, false); return __uint_as_float(rr[0]) + __uint_as_float(rr[1]); }

struct AtUnit { int b, head, qblk; };
struct AtAddr { const char* Kb; const char* Vb; unsigned kofs0, kofs1, vofs0, vofs1; };
__device__ __forceinline__ void at_addr(AtAddr& a, const AtUnit& un, int wid, int lane, const bf16_t* __restrict__ K, const bf16_t* __restrict__ V) {
    const int mp = wid >> 2, wq = wid & 3, hm = un.head * 2 + mp; const size_t rowbase = (size_t)un.b * SEQ;
    a.Kb = (const char*)(K + rowbase * 1024); a.Vb = (const char*)(V + rowbase * 1024);
    unsigned ko[2], vo[2];
#pragma unroll
    for (int i = 0; i < 2; ++i) { const int ch = 2 * wq + i; ko[i] = (unsigned)(lane * 2048 + hm * 128 + ch * 16);
        const int p = 2 * wid + i; const int kk = (p >> 1) * 8 + ((lane & 31) >> 2); const int k = (kk & ~0xC) | ((kk & 4) << 1) | ((kk & 8) >> 1); const int c = (2 * (p & 1) + (lane >> 5)) * 32 + (lane & 3) * 8;
        vo[i] = (unsigned)(k * 2048 + un.head * 256 + c * 2); }
    a.kofs0 = ko[0]; a.kofs1 = ko[1]; a.vofs0 = vo[0]; a.vofs1 = vo[1];
}
#define AT_DMA_K(AD, j, KO) do { const char* kj_ = (AD).Kb + (size_t)(j) * 131072; \
        __builtin_amdgcn_global_load_lds((const unsigned*)(kj_ + (AD).kofs0), (LAS unsigned*)(lds + (KO) + kdst), 16, 0, 0); __builtin_amdgcn_global_load_lds((const unsigned*)(kj_ + (AD).kofs1), (LAS unsigned*)(lds + (KO) + kdst + 1024), 16, 0, 0); } while (0)
#define AT_DMA_V(AD, j, VO) do { const char* vj_ = (AD).Vb + (size_t)(j) * 131072; \
        __builtin_amdgcn_global_load_lds((const unsigned*)(vj_ + (AD).vofs0), (LAS unsigned*)(lds + (VO) + vdst), 16, 0, 0); __builtin_amdgcn_global_load_lds((const unsigned*)(vj_ + (AD).vofs1), (LAS unsigned*)(lds + (VO) + vdst + 1024), 16, 0, 0); } while (0)
__device__ __forceinline__ void at_prefetch(LAS unsigned char* lds, const AtUnit& un, const bf16_t* __restrict__ Q, const bf16_t* __restrict__ K, const bf16_t* __restrict__ V, bf16x8 (&qr)[4]) {
    const int tid = threadIdx.x, lane = tid & 63, r32 = lane & 31, hi = lane >> 5; const int wid = __builtin_amdgcn_readfirstlane(tid >> 6); const int mp = wid >> 2, wq = wid & 3;
    AtAddr ad; at_addr(ad, un, wid, lane, K, V);
    const unsigned kdst = (unsigned)(mp * KB_BYTES + (2 * wq) * 1024), vdst = (unsigned)(OFF_V + (2 * wid) * 1024);
    AT_DMA_K(ad, 0, 0); AT_DMA_V(ad, 0, 0); AT_DMA_K(ad, 1, KSLOT);
    const bf16_t* qp = Q + ((size_t)un.b * SEQ + un.qblk * 128 + wq * 32 + r32) * 1024 + (un.head * 2 + mp) * 64 + hi * 8;
#pragma unroll
    for (int d0 = 0; d0 < 4; ++d0) qr[d0] = *(const bf16x8*)(qp + d0 * 16);
    asm volatile("" ::: "memory"); AT_SBAR();
}
template <unsigned var> __device__ __forceinline__ void attn_unit(LAS unsigned char* lds, const AtUnit cu, const AtUnit nu, const bool has_next, const bool first, const bf16_t* __restrict__ Q, const bf16_t* __restrict__ K, const bf16_t* __restrict__ V,
                                          bf16_t* __restrict__ O, const float lam, const float* __restrict__ gain, bf16x8 (&qr)[4]) {
    const int tid = threadIdx.x, lane = tid & 63, r32 = lane & 31, hi = lane >> 5; const int wid = __builtin_amdgcn_readfirstlane(tid >> 6); const int mp = wid >> 2, wq = wid & 3;
    const int head = cu.head, qblk = cu.qblk; const size_t rowbase = (size_t)cu.b * SEQ; const int q0 = qblk * 128;
    const int mychunk = 2 * qblk + (wq >> 1); const int NT = 2 * qblk + 2;
    LAS float* wsf = (LAS float*)(lds + OFF_WS) + wid * 64;
    AtAddr ad; at_addr(ad, cu, wid, lane, K, V);
    const unsigned kdst = (unsigned)(mp * KB_BYTES + (2 * wq) * 1024), vdst = (unsigned)(OFF_V + (2 * wid) * 1024);
    float mhat = 0.f, l_reg = 0.f; f32x16 o[4] = {};
    const int vb0 = (int)(uintptr_t)(lds + OFF_V) + v_rd_base(lane);
    const LAS unsigned char* kb0 = lds + mp * KB_BYTES;
    constexpr float THR = 8.f;
    f32x16 pA0 = {}, pA1 = {}, pB0 = {}, pB1 = {}; float alA = 1.f, alB = 1.f; bool rsA = false, rsB = false;
    int kcur = 0, k1 = KSLOT, k2 = 2 * KSLOT;
    int vprev = 2 * VB_BYTES, vcur = 0, vnext = VB_BYTES;
#define AT_ROT() do { kcur = k1; k1 = k2; k2 = (k2 == (NKS - 1) * KSLOT) ? 0 : k2 + KSLOT; vprev = vcur; vcur = vnext; vnext = (vnext == (NVS - 1) * VB_BYTES) ? 0 : vnext + VB_BYTES; } while (0)
#define AT_QKT(P0, P1, SL) do { const LAS unsigned char* kp_ = kb0 + (SL) + hi * 1024 + r32 * 16; P0 = f32x16{}; P1 = f32x16{}; \
        _Pragma("unroll") for (int d0 = 0; d0 < 4; ++d0) { const bf16x8 b0_ = *(const LAS bf16x8*)(kp_ + d0 * 2048), b1_ = *(const LAS bf16x8*)(kp_ + d0 * 2048 + 512); const bf16x8 q_ = qr[d0]; \
            P0 = __builtin_amdgcn_mfma_f32_32x32x16_bf16(b0_, q_, P0, 0, 0, 0); P1 = __builtin_amdgcn_mfma_f32_32x32x16_bf16(b1_, q_, P1, 0, 0, 0); } } while (0)
#define AT_PSM(P0, P1, AL, RS, FIRST) do { float pm_ = P0[0]; _Pragma("unroll") for (int r = 1; r < 16; ++r) pm_ = fmaxf(pm_, P0[r]); _Pragma("unroll") for (int r = 0; r < 16; ++r) pm_ = fmaxf(pm_, P1[r]); \
        pm_ = hswap_max(pm_) - mhat; RS = (FIRST) || __any(pm_ > THR); AL = 1.f; \
        if (RS) { const float dl_ = (FIRST) ? pm_ : fmaxf(pm_, 0.f); mhat += dl_; AL = __builtin_amdgcn_exp2f(-dl_); } \
        _Pragma("unroll") for (int r = 0; r < 16; ++r) { P0[r] = __builtin_amdgcn_exp2f(P0[r] - mhat); P1[r] = __builtin_amdgcn_exp2f(P1[r] - mhat); } } while (0)
#define AT_PK4(P, BASE, OUT) do { const unsigned a0 = cvt_pk_bf16(P[BASE + 0], P[BASE + 1]), a1 = cvt_pk_bf16(P[BASE + 2], P[BASE + 3]); \
        const unsigned b0 = cvt_pk_bf16(P[BASE + 4], P[BASE + 5]), b1 = cvt_pk_bf16(P[BASE + 6], P[BASE + 7]); \
        auto r0_ = __builtin_amdgcn_permlane32_swap(a0, b0, false, false); auto r1_ = __builtin_amdgcn_permlane32_swap(a1, b1, false, false); \
        u32x4 w_ = {r0_[0], r1_[0], r0_[1], r1_[1]}; OUT = __builtin_bit_cast(bf16x8, w_); } while (0)
#define AT_FIN_PV(P0, P1, AL, SL) do { float ps_ = 0.f; _Pragma("unroll") for (int r = 0; r < 16; ++r) ps_ += P0[r]; _Pragma("unroll") for (int r = 0; r < 16; ++r) ps_ += P1[r]; \
        ps_ = hswap_sum(ps_); l_reg = l_reg * (AL) + ps_; bf16x8 pa0, pa1, pa2, pa3; AT_PK4(P0, 0, pa0); AT_PK4(P0, 8, pa1); AT_PK4(P1, 0, pa2); AT_PK4(P1, 8, pa3); const int vb_ = vb0 + (SL); \
        pv_one<0>(o[0], vb_, pa0, pa1, pa2, pa3); pv_one<1>(o[1], vb_, pa0, pa1, pa2, pa3); pv_one<2>(o[2], vb_, pa0, pa1, pa2, pa3); pv_one<3>(o[3], vb_, pa0, pa1, pa2, pa3); } while (0)
#define AT_RESC(AL, RS) do { if (RS) { if (hi == 0) wsf[r32] = (AL); asm volatile("s_waitcnt lgkmcnt(0)" ::: "memory"); \
        _Pragma("unroll") for (int r = 0; r < 16; ++r) { const float a_ = wsf[crow(r, hi)]; _Pragma("unroll") for (int d = 0; d < 4; ++d) o[d][r] *= a_; } } } while (0)
#define AT_STEP0(u, PC0, PC1, ALC, RSC, PP0, PP1, ALP) do { const bool nk_ = (u) + 2 < NT && !(var & 2u), nv_ = (u) + 1 < NT && !(var & 2u); if (nk_) AT_DMA_K(ad, (u) + 2, k2); if (nv_) AT_DMA_V(ad, (u) + 1, vnext); \
        const bool aX_ = (u) < NT && (u) <= mychunk, aF_ = (u) >= 1 && (u) - 1 <= mychunk; \
        if (aX_ && !(var & 16u)) AT_QKT(PC0, PC1, kcur); \
        if (aF_ && !(var & 4u)) AT_FIN_PV(PP0, PP1, ALP, vprev); \
        if (aX_ && !(var & 8u)) { AT_PSM(PC0, PC1, ALC, RSC, (u) == 0); AT_RESC(ALC, RSC); } \
        if (nk_) asm volatile("s_waitcnt vmcnt(4)" ::: "memory"); else if (nv_) asm volatile("s_waitcnt vmcnt(2)" ::: "memory"); else asm volatile("s_waitcnt vmcnt(0)" ::: "memory"); \
        __syncthreads(); AT_ROT(); } while (0)
    if (first || mp == 1) asm volatile("s_waitcnt vmcnt(0)" ::: "memory"); else asm volatile("s_waitcnt vmcnt(8)" ::: "memory");
    __syncthreads();
    asm volatile(".p2align 8" ::: "memory");
    for (int u = 0; u < NT; u += 2) { AT_STEP0(u, pA0, pA1, alA, rsA, pB0, pB1, alB); AT_STEP0(u + 1, pB0, pB1, alB, rsB, pA0, pA1, alA); }
    { const int u = NT; AT_STEP0(u, pA0, pA1, alA, rsA, pB0, pB1, alB); }
#undef AT_ROT
#undef AT_QKT
#undef AT_PSM
#undef AT_PK4
#undef AT_FIN_PV
#undef AT_RESC
#undef AT_STEP0
    if (has_next) at_prefetch(lds, nu, Q, K, V, qr);
    if (hi == 0) wsf[r32] = 1.f / l_reg;
    asm volatile("s_waitcnt lgkmcnt(0)" ::: "memory");
    float rli[16];
#pragma unroll
    for (int r = 0; r < 16; ++r) rli[r] = wsf[crow(r, hi)];
    LAS float* xch = (LAS float*)(lds + (wq < 2 ? 32768 + wq * 16384 : 81920 + (wq - 2) * 16384));
    if (mp == 1) {
#pragma unroll
        for (int d = 0; d < 4; ++d)
#pragma unroll
            for (int r4 = 0; r4 < 4; ++r4) *(LAS f32x4*)(xch + ((d * 4 + r4) * 64 + lane) * 4) = (f32x4){o[d][4 * r4] * rli[4 * r4], o[d][4 * r4 + 1] * rli[4 * r4 + 1], o[d][4 * r4 + 2] * rli[4 * r4 + 2], o[d][4 * r4 + 3] * rli[4 * r4 + 3]};
    }
    __syncthreads();
    if (mp == 0) {
#pragma unroll
        for (int d = 0; d < 4; ++d)
#pragma unroll
            for (int r4 = 0; r4 < 4; ++r4) { const f32x4 v2 = *(const LAS f32x4*)(xch + ((d * 4 + r4) * 64 + lane) * 4);
#pragma unroll
                for (int e = 0; e < 4; ++e) o[d][4 * r4 + e] = o[d][4 * r4 + e] * rli[4 * r4 + e] - lam * v2[e]; }
    }
    __syncthreads();
    LAS float* stg = (LAS float*)(lds + (wq == 0 ? 32768 : 81920 + (wq - 1) * 16896));
    if (mp == 0) {
#pragma unroll
        for (int d = 0; d < 4; ++d)
#pragma unroll
            for (int r = 0; r < 16; ++r) stg[crow(r, hi) * 132 + d * 32 + r32] = o[d][r];
        asm volatile("s_waitcnt lgkmcnt(0)" ::: "memory");
        const int row = lane >> 1, ch = (lane & 1) * 64; const LAS float* sp = stg + row * 132 + ch; float vv[64]; float ss = 0.f;
#pragma unroll
        for (int i = 0; i < 16; ++i) { const f32x4 t4 = *(const LAS f32x4*)(sp + 4 * i); vv[4 * i] = t4[0]; vv[4 * i + 1] = t4[1]; vv[4 * i + 2] = t4[2]; vv[4 * i + 3] = t4[3]; ss += (t4[0] * t4[0] + t4[1] * t4[1]) + (t4[2] * t4[2] + t4[3] * t4[3]); }
        ss += __shfl_xor(ss, 1);
        const float rs = (1.0f / sqrtf(ss * (1.f / 128.f) + RMS_EPS)) * (1.f - LAMBDA_INIT);
        bf16_t* op = O + (rowbase + q0 + wq * 32 + row) * 1024 + head * 128 + ch; const float* gp = gain + ch;
#pragma unroll
        for (int i = 0; i < 8; ++i) { const f32x4 g0 = *(const f32x4*)(gp + 8 * i), g1 = *(const f32x4*)(gp + 8 * i + 4); u32x4 w;
            w.x = cvt_pk_bf16(vv[8 * i] * rs * g0[0], vv[8 * i + 1] * rs * g0[1]); w.y = cvt_pk_bf16(vv[8 * i + 2] * rs * g0[2], vv[8 * i + 3] * rs * g0[3]);
            w.z = cvt_pk_bf16(vv[8 * i + 4] * rs * g1[0], vv[8 * i + 5] * rs * g1[1]); w.w = cvt_pk_bf16(vv[8 * i + 6] * rs * g1[2], vv[8 * i + 7] * rs * g1[3]);
            *(u32x4*)(op + 8 * i) = w; }
    }
}
template <unsigned var> __device__ __forceinline__ void attn_phase(LAS unsigned char* lds, int vcu, int ncu, const bf16_t* Q, const bf16_t* K, const bf16_t* V, bf16_t* O, const float* scal, const float* gain) {
    const float lam = scal[0];
    const int hb = ncu >> 1; const int nun = (vcu >> 1) < NB * NHEAD ? ((NB * NHEAD - 1 - (vcu >> 1)) / hb + 1) * 8 : 0;
    auto unit_of = [&](int i) { if (ncu == 256) { const int bh = (vcu >> 5) * 16 + (i >> 1) * 4 + ((vcu & 31) >> 3), s = vcu & 7; return AtUnit{bh >> 3, bh & 7, (i & 1) ? 15 - s : s}; }
        const int bh = (vcu >> 1) + (i >> 3) * hb; const int s = (vcu & 1) + 2 * ((i & 7) >> 1); return AtUnit{bh >> 3, bh & 7, (i & 1) ? 15 - s : s}; };
    if (nun == 0) return;
    bf16x8 qr[4]; AtUnit cu = unit_of(0); at_prefetch(lds, cu, Q, K, V, qr);
    for (int i = 0; i < nun; ++i) { const bool hn = i + 1 < nun; const AtUnit nu = unit_of(hn ? i + 1 : i);
        attn_unit<var>(lds, cu, nu, hn, i == 0, Q, K, V, O, lam, gain, qr); cu = nu; }
    __syncthreads();
}
#undef AT_DMA_K
#undef AT_DMA_V
#undef AT_SBAR
}

struct MKArgs { const void* in[21]; float* out; unsigned char* ws; unsigned mask; unsigned li; };
enum { PH_PRO = 0, PH_G1, PH_POOLA, PH_ATT, PH_POOLG, PH_G4A, PH_G4B, PH_G5, PH_ROUTER, PH_G7, PH_G8, PH_FINAL, PH_N };

template <int MODE> __device__ __forceinline__ int dest_row(int n) {
    if (MODE == 1) return n < 2048 ? (n & ~63) + qk_pos_of_d(n & 63) : n;
    if (MODE == 2) { const int nn = n >> 9, hc = n & 511; return (hc >> 7) * 256 + ((hc >> 6) & 1) * 128 + ((hc >> 4) & 3) * 32 + ((hc >> 2) & 3) * 8 + nn * 4 + (hc & 3); }
    return n;
}
template <int MODE> __device__ __forceinline__ void transpose_item(const float* __restrict__ W, int ldw, int N, bf16_t* __restrict__ WT, int ldt, int coloff, int rowoff, LAS float* scr, int item, int lane) {
    const int nblk = N / 64, kb = item / nblk, nb = item % nblk, k0 = 64 * kb, n0 = 64 * nb;
    const int lr = lane >> 4, n4 = (lane & 15) * 4;
#pragma unroll 4
    for (int i = 0; i < 16; ++i) { const int kk = 4 * i + lr; const f32x4 v = *(const f32x4*)(W + (size_t)(k0 + kk) * ldw + n0 + n4); *(LAS f32x4*)(scr + kk * 64 + (n4 ^ ((kk >> 3) << 2))) = v; }
    LDS_WAIT(); asm volatile("" ::: "memory");
    const int c = lane & 7;
#pragma unroll 2
    for (int jj = 0; jj < 8; ++jj) { const int n = 8 * jj + (lane >> 3); const LAS float* sp = scr + (8 * c) * 64 + (n ^ (c << 2));
        u32x4 o; o.x = cvt_pk_bf16(sp[0 * 64], sp[1 * 64]); o.y = cvt_pk_bf16(sp[2 * 64], sp[3 * 64]); o.z = cvt_pk_bf16(sp[4 * 64], sp[5 * 64]); o.w = cvt_pk_bf16(sp[6 * 64], sp[7 * 64]);
        *(u32x4*)(WT + (size_t)(rowoff + dest_row<MODE>(n0 + n)) * ldt + coloff + k0 + 8 * c) = o; }
    LDS_WAIT(); asm volatile("" ::: "memory");
}

__global__ void __launch_bounds__(NTHREADS, 2) mk_fwd(MKArgs args) {
    __shared__ __attribute__((aligned(16))) unsigned char lds_raw[LDS_BYTES];
    LAS unsigned char* lds = (LAS unsigned char*)lds_raw;
    volatile LAS unsigned* MISC = (volatile LAS unsigned*)(lds + MISC_OFF);
    const int tid = threadIdx.x, lane = tid & 63, wave = __builtin_amdgcn_readfirstlane(tid >> 6);
    const int G = gridDim.x; const int bx = blockIdx.x; const int vcu = (G % 8 == 0) ? (bx % 8) * (G / 8) + bx / 8 : bx;
    const unsigned mask = args.mask; const bool dry = ((args.li >> 8) & 1u) != 0u;
    unsigned char* const ws = args.ws; float* const out = args.out;
#define IN_F(k) ((const float*)args.in[k])
#define x_ IN_F(0)
#define positions ((const int*)args.in[1])
#define w_in IN_F(2)
#define gate_bias IN_F(3)
#define lam_vecs IN_F(4)
#define subln_gain IN_F(5)
#define w_pool IN_F(6)
#define pool_scale IN_F(7)
#define w_branch_a IN_F(8)
#define w_branch_b IN_F(9)
#define w_out IN_F(10)
#define ln1_g IN_F(11)
#define ln1_b IN_F(12)
#define wrg IN_F(13)
#define brg IN_F(14)
#define wre IN_F(15)
#define bre IN_F(16)
#define wgu IN_F(17)
#define wdn IN_F(18)
#define ln2_g IN_F(19)
#define ln2_b IN_F(20)
#define wt ((bf16_t*)(ws + WS_WT))
#define xb ((bf16_t*)(ws + WS_XB))
#define qb ((bf16_t*)(ws + WS_Q))
#define kb ((bf16_t*)(ws + WS_K))
#define vb ((bf16_t*)(ws + WS_V))
#define ub ((bf16_t*)(ws + WS_U))
#define gb ((bf16_t*)out)
#define on ((bf16_t*)(ws + WS_ON))
#define mixed ((bf16_t*)(ws + WS_MIXED))
#define merged ((bf16_t*)(ws + WS_MERGED))
#define x1b ((bf16_t*)(ws + WS_X1B))
#define hb ((bf16_t*)(ws + WS_H))
#define ybuf ((bf16_t*)(ws + WS_YBUF))
#define rope ((float*)(ws + WS_ROPE))
#define pooled ((bf16_t*)(ws + WS_POOLED))
#define misc (ws + WS_MISC)
#define ctl ((unsigned*)(misc + MS_CTL))
#define stats ((float2*)(misc + MS_STATS))
#define rw ((float*)(misc + MS_ROUTE + (size_t)T * 8))
#define list ((int*)(misc + MS_LIST))
#define scal ((float*)(misc + MS_SCAL))
#define cnt (ctl + CW_CNT)
#define wpool_bd ((bf16_t*)(misc + MS_WPOOL))

    for (int u = tid; u < (LDS_BYTES - LDS_CTL_OFF) / 4; u += NTHREADS) ((LAS unsigned*)(lds + LDS_CTL_OFF))[u] = 0u;
    __syncthreads();
    XcdBarrier bar; bar.bar = ctl + CW_BAR + (args.li & 255u) * XCD_BAR_WORDS; bar.x = 0; bar.st = nullptr;
    const bool multi = (mask & (mask - 1u)) != 0u;
    if (multi) bar = xcd_barrier_post(ctl + CW_BAR + (args.li & 255u) * XCD_BAR_WORDS, MISC + 8);
#ifndef MK_CT
#define MK_CT 0xfffu
#endif
#define HAS(p) (((MK_CT >> (p)) & 1u) && ((mask >> (p)) & 1u))
#ifndef MK_REP
#define MK_REP 0u
#endif
#define REPS(p) for (int rep_ = 0; rep_ < ((((MK_REP) >> (p)) & 1u) ? 2 : 1); ++rep_)
#ifdef MK_BAR2
#define SEAM(p) do { if (multi && (mask >> ((p) + 1)) != 0u) { xcd_barrier(bar); xcd_barrier(bar); } } while (0)
#else
#define SEAM(p) do { if (multi && (mask >> ((p) + 1)) != 0u) xcd_barrier(bar); } while (0)
#endif
    const int gw = vcu * NWAVES + wave, NGW = G * NWAVES;

    if (HAS(PH_PRO)) {
        LAS float* scr = (LAS float*)(lds + wave * 16384);
        constexpr int I_IN = 16 * (INW / 64), I_A = 16 * 16, I_O = 16 * 16, I_GU = 16 * 16, I_DN = 8 * 16;
        constexpr int NITEMS = I_IN + I_A + I_O;
        for (int it = gw; it < NITEMS; it += NGW) {
            int r = it;
            if (r < I_IN) { transpose_item<1>(w_in, INW, INW, wt + WT_IN, 1024, 0, 0, scr, r, lane); continue; } r -= I_IN;
            if (r < I_A) { transpose_item<0>(w_branch_a, 1024, 1024, wt + WT_A, 1024, 0, 0, scr, r, lane); continue; } r -= I_A;
            transpose_item<0>(w_out, 1024, 1024, wt + WT_O, 1024, 0, 0, scr, r, lane);
            (void)I_GU; (void)I_DN;
        }
        for (int it = gw; it < 64 * 16; it += NGW) { const int kc = it >> 4, n = (it & 15) * 64 + lane; const int g = kc >> 4, c0 = (kc & 15) * 8; float a8[8] = {0.f, 0.f, 0.f, 0.f, 0.f, 0.f, 0.f, 0.f};
            const float* wpg = w_pool + (size_t)(g * 128 + c0) * 128; const float* wbp = w_branch_b + (size_t)(g * 128) * 1024 + n; const float* psp = pool_scale + g * 128;
            for (int d = 0; d < 128; ++d) { const float bv = wbp[(size_t)d * 1024] * psp[d];
#pragma unroll
                for (int i = 0; i < 8; ++i) a8[i] = fmaf(wpg[i * 128 + d], bv, a8[i]); }
            u32x4 o; o.x = cvt_pk_bf16(a8[0], a8[1]); o.y = cvt_pk_bf16(a8[2], a8[3]); o.z = cvt_pk_bf16(a8[4], a8[5]); o.w = cvt_pk_bf16(a8[6], a8[7]);
            *(u32x4*)(wt + WT_B + (size_t)n * 512 + kc * 8) = o; }
        for (int m = gw; m < T; m += NGW) { const f32x4* xr = (const f32x4*)(x_ + (size_t)m * 1024) + 2 * lane; u32x4* o16 = (u32x4*)(xb + (size_t)m * 1024) + lane;
#pragma unroll
            for (int j = 0; j < 2; ++j) { const f32x4 v0 = __builtin_nontemporal_load(xr + 128 * j), v1 = __builtin_nontemporal_load(xr + 128 * j + 1); u32x4 w; w.x = cvt_pk_bf16(v0[0], v0[1]); w.y = cvt_pk_bf16(v0[2], v0[3]); w.z = cvt_pk_bf16(v1[0], v1[1]); w.w = cvt_pk_bf16(v1[2], v1[3]); o16[64 * j] = w; } }
        for (int e = gw * 64 + lane; e < T * 32; e += NGW * 64) { const int t = e >> 5, i = e & 31; const float inv = powf(10000.0f, -(float)i * (2.0f / 64.0f)); const float ang = (float)positions[t] * inv; float sn, cs; sincosf(ang, &sn, &cs);
            rope[2 * e] = cs; rope[2 * e + 1] = sn; }
        if (gw == 0 && lane == 0) { float s01 = 0.f, s23 = 0.f; for (int i = 0; i < 64; ++i) { s01 += lam_vecs[i] * lam_vecs[64 + i]; s23 += lam_vecs[128 + i] * lam_vecs[192 + i]; } scal[0] = expf(s01) - expf(s23) + LAMBDA_INIT; }
        { f32x4* wp = (f32x4*)(misc + MS_WP);
          for (int e = gw * 64 + lane; e < 16 * 3 * 4 * 64; e += NGW * 64) { const int l = e & 63, sg = (e >> 6) & 3, ob = (e >> 8) % 3, chunk = (e >> 8) / 3; const int o = ob * 16 + (l & 15); f32x4 v = {0.f, 0.f, 0.f, 0.f};
              if (o < 36) {
#pragma unroll
                  for (int j = 0; j < 4; ++j) { const int c = chunk * 64 + (l >> 4) * 16 + 4 * sg + j; v[j] = ln1_g[c] * (o < 4 ? wrg[c * 4 + o] : wre[c * 32 + (o - 4)]); } }
              wp[e] = v; }
          float* csbw = (float*)(misc + MS_CSBW);
          if (gw < 48) { const int o = gw; float cs = 0.f, bw = 0.f;
              if (o < 36) { for (int i = 0; i < 16; ++i) { const int c = lane + 64 * i; const float w = (o < 4 ? wrg[c * 4 + o] : wre[c * 32 + (o - 4)]); cs += ln1_g[c] * w; bw += ln1_b[c] * w; }
                  cs = wave_sum(cs); bw = wave_sum(bw) + (o < 4 ? brg[o] : bre[o - 4]); }
              if (lane == 0) { csbw[o] = cs; csbw[48 + o] = bw; } } }
#ifdef MK_SLEEP_TEST
        { const unsigned long long t0_ = __builtin_amdgcn_s_memrealtime(); while (__builtin_amdgcn_s_memrealtime() - t0_ < 10000ull) __builtin_amdgcn_s_sleep(32); }
#endif
        __syncthreads();
        SEAM(PH_PRO);
    }
    if (HAS(PH_G1)) {
        g8::DenseOrder S; S.init(xb, wt + WT_IN, T, INW, 1024, G, bx);
        g8::EpiProj E{qb, kb, vb, ub, gb, rope, gate_bias};
        g8::gemm_phase<g8::EpiProj, g8::DenseOrder, true, false>(lds, 1024, S, E);
        SEAM(PH_G1);
    }
    if (HAS(PH_POOLA)) {
        for (int task = gw; task < T / 16; task += NGW) { const int t0 = task * 16, s0 = t0 & (SEQ - 1); const int w = 2 << (lane >> 4); const bf16_t* up = ub + (size_t)t0 * 512 + lane * 8;
            float a[8] = {0.f, 0.f, 0.f, 0.f, 0.f, 0.f, 0.f, 0.f};
            if (s0 != 0) for (int i = 1; i < w; ++i) { const u32x4 v = *(const u32x4*)(up - (ptrdiff_t)i * 512);
                a[0] += bflo(v.x); a[1] += bfhi(v.x); a[2] += bflo(v.y); a[3] += bfhi(v.y); a[4] += bflo(v.z); a[5] += bfhi(v.z); a[6] += bflo(v.w); a[7] += bfhi(v.w); }
#pragma unroll 4
            for (int j = 0; j < 16; ++j) { const int s = s0 + j; const u32x4 v = *(const u32x4*)(up + (size_t)j * 512); const float f[8] = {bflo(v.x), bfhi(v.x), bflo(v.y), bfhi(v.y), bflo(v.z), bfhi(v.z), bflo(v.w), bfhi(v.w)};
#pragma unroll
                for (int k = 0; k < 8; ++k) a[k] += f[k];
                if (j >= 1 && s >= w) { const u32x4 o = *(const u32x4*)(up + (ptrdiff_t)(j - w) * 512);
                    a[0] -= bflo(o.x); a[1] -= bfhi(o.x); a[2] -= bflo(o.y); a[3] -= bfhi(o.y); a[4] -= bflo(o.z); a[5] -= bfhi(o.z); a[6] -= bflo(o.w); a[7] -= bfhi(o.w); }
                const float inv = 1.f / (float)((s + 1 < w) ? s + 1 : w); u32x4 r; r.x = cvt_pk_bf16(a[0] * inv - f[0], a[1] * inv - f[1]); r.y = cvt_pk_bf16(a[2] * inv - f[2], a[3] * inv - f[3]);
                r.z = cvt_pk_bf16(a[4] * inv - f[4], a[5] * inv - f[5]); r.w = cvt_pk_bf16(a[6] * inv - f[6], a[7] * inv - f[7]);
                *(u32x4*)(pooled + (size_t)(t0 + j) * 512 + lane * 8) = r; } }
    }
    if (HAS(PH_ATT)) {
#ifdef MK_VAR
        if (args.li >> 8) at2::attn_phase<MK_VAR>(lds, vcu, G, qb, kb, vb, (bf16_t*)(ws + WS_POOLED), scal, subln_gain); else
#endif
        at2::attn_phase<0u>(lds, vcu, G, qb, kb, vb, on, scal, subln_gain);
        SEAM(PH_ATT); }
    else if (HAS(PH_POOLA)) { SEAM(PH_ATT); }
    if (HAS(PH_G4A)) {
        g8::DenseOrder S; S.init(on, wt + WT_A, T, 1024, 1024, G, bx);
        g8::EpiMerge<0> E{gb, merged, merged};
        g8::gemm_phase<g8::EpiMerge<0>, g8::DenseOrder, true, false>(lds, 1024, S, E);
    }
    if (HAS(PH_G4B)) {
        g8::DenseOrder S; S.init(pooled, wt + WT_B, T, 1024, 512, G, bx);
        g8::EpiMerge<1> E{gb, merged, dry ? (bf16_t*)(ws + WS_X1B) : merged};
        g8::gemm_phase<g8::EpiMerge<1>, g8::DenseOrder, true, false>(lds, 512, S, E);
        SEAM(PH_G4B);
    } else if (HAS(PH_G4A)) { SEAM(PH_G4B); }
    if (HAS(PH_G5)) {
        g8::DenseOrder S; S.init(merged, wt + WT_O, T, 1024, 1024, G, bx);
        g8::EpiResid E{x_, out, (float2*)(ws + WS_MIXED)};
        g8::gemm_phase<g8::EpiResid, g8::DenseOrder, true, false>(lds, 1024, S, E);
        SEAM(PH_G5);
    }
    if (HAS(PH_ROUTER)) {
        LAS float* lgs = (LAS float*)(lds + 0) + wave * (16 * 49);
        LAS float* tst = (LAS float*)(lds + 32768) + wave * 32;
        LAS int*   tex = (LAS int*)(lds + 36864) + wave * 128;
        LAS unsigned* lcnt = (LAS unsigned*)(lds + 40960);
        const f32x4* wp = (const f32x4*)(misc + MS_WP); const float* csbw = (const float*)(misc + MS_CSBW);
        for (int t0 = vcu * 128; t0 < T; t0 += G * 128) {
            if (tid < 64) lcnt[tid] = 0u;
            __syncthreads();
            const int tk = lane & 15, q = lane >> 4;
            if (wave >= 4) {
                if (t0 == vcu * 128) { LAS float* scr = (LAS float*)(lds + 65536 + (wave - 4) * 16384); constexpr int I_GU = 16 * 16, I_DN = 8 * 16;
                    for (int it = vcu * 4 + (wave - 4); it < NE * (I_GU + I_DN); it += G * 4) {
                        if (it < NE * I_GU) { const int e = it / I_GU; transpose_item<2>(wgu + (size_t)e * 1024 * 1024, 1024, 1024, wt + WT_GU + (size_t)e * 1024 * 1024, 1024, 0, 0, scr, it % I_GU, lane); }
                        else { const int r2 = it - NE * I_GU; const int e = r2 / I_DN; transpose_item<0>(wdn + (size_t)e * 512 * 1024, 1024, 1024, wt + WT_DN + (size_t)e * 1024 * 512, 512, 0, 0, scr, r2 % I_DN, lane); } } }
            } else
            for (int half = 0; half < 2; ++half) { const int tw = t0 + (wave * 2 + half) * 16; LAS int* texh = tex + half * 64;
            { const float* yr = out + (size_t)(tw + tk) * 1024 + q * 16;
              float s1 = 0.f, s2 = 0.f; { const float2* pp = (const float2*)(ws + WS_MIXED) + (size_t)(tw + tk) * 16;
#pragma unroll
                  for (int i = 0; i < 16; ++i) { const float2 pv = pp[i]; s1 += pv.x; s2 += pv.y; } }
              const float mu = s1 * (1.f / 1024.f); const float var = fmaxf(s2 * (1.f / 1024.f) - mu * mu, 0.f); const float rstd = 1.0f / sqrtf(var + LN_EPS);
              if (q == 0) { tst[2 * tk] = mu; tst[2 * tk + 1] = rstd; if (!dry) stats[tw + tk] = make_float2(mu, rstd); }
              bf16_t* xo = (dry ? (bf16_t*)(ws + WS_H) : x1b) + (size_t)(tw + tk) * 1024 + q * 16; const float* gp = ln1_g + q * 16; const float* bp = ln1_b + q * 16;
              f32x4 acc0 = {0.f, 0.f, 0.f, 0.f}, acc1 = {0.f, 0.f, 0.f, 0.f}, acc2 = {0.f, 0.f, 0.f, 0.f};
#pragma unroll 2
              for (int chunk = 0; chunk < 16; ++chunk) { f32x4 yv[4];
#pragma unroll
                  for (int j = 0; j < 4; ++j) yv[j] = *(const f32x4*)(yr + chunk * 64 + 4 * j);
                  { u32x4 w0, w1; f32x4 xn[4];
#pragma unroll
                    for (int j = 0; j < 4; ++j) { const f32x4 gg = *(const f32x4*)(gp + chunk * 64 + 4 * j), bb = *(const f32x4*)(bp + chunk * 64 + 4 * j); xn[j] = (yv[j] - mu) * rstd * gg + bb; }
                    w0.x = cvt_pk_bf16(xn[0][0], xn[0][1]); w0.y = cvt_pk_bf16(xn[0][2], xn[0][3]); w0.z = cvt_pk_bf16(xn[1][0], xn[1][1]); w0.w = cvt_pk_bf16(xn[1][2], xn[1][3]);
                    w1.x = cvt_pk_bf16(xn[2][0], xn[2][1]); w1.y = cvt_pk_bf16(xn[2][2], xn[2][3]); w1.z = cvt_pk_bf16(xn[3][0], xn[3][1]); w1.w = cvt_pk_bf16(xn[3][2], xn[3][3]);
                    *(u32x4*)(xo + chunk * 64) = w0; *(u32x4*)(xo + chunk * 64 + 8) = w1; }
#pragma unroll
                  for (int sg = 0; sg < 4; ++sg) { const f32x4 b0 = wp[((chunk * 3 + 0) * 4 + sg) * 64 + lane], b1 = wp[((chunk * 3 + 1) * 4 + sg) * 64 + lane], b2 = wp[((chunk * 3 + 2) * 4 + sg) * 64 + lane];
#pragma unroll
                      for (int j = 0; j < 4; ++j) { const float a = yv[sg][j];
                          acc0 = __builtin_amdgcn_mfma_f32_16x16x4f32(a, b0[j], acc0, 0, 0, 0); acc1 = __builtin_amdgcn_mfma_f32_16x16x4f32(a, b1[j], acc1, 0, 0, 0); acc2 = __builtin_amdgcn_mfma_f32_16x16x4f32(a, b2[j], acc2, 0, 0, 0); } } }
#pragma unroll
              for (int r = 0; r < 4; ++r) { lgs[(4 * q + r) * 49 + tk] = acc0[r]; lgs[(4 * q + r) * 49 + 16 + tk] = acc1[r]; lgs[(4 * q + r) * 49 + 32 + tk] = acc2[r]; } }
            LDS_WAIT();
            if (lane < 16) { const int t = tw + lane; const float mu = tst[2 * lane], rstd = tst[2 * lane + 1]; const LAS float* lr = lgs + lane * 49;
                float lg[4], le[32];
#pragma unroll
                for (int o = 0; o < 4; ++o) lg[o] = rstd * (lr[o] - mu * csbw[o]) + csbw[48 + o];
#pragma unroll
                for (int o = 0; o < 32; ++o) le[o] = rstd * (lr[4 + o] - mu * csbw[4 + o]) + csbw[48 + 4 + o];
                int gi = 0; float gm = lg[0];
#pragma unroll
                for (int o = 1; o < 4; ++o) if (lg[o] > gm) { gm = lg[o]; gi = o; }
                float gs = 0.f;
#pragma unroll
                for (int o = 0; o < 4; ++o) gs += expf(lg[o] - gm);
                const float gp = 1.f / gs; float ev[8];
#pragma unroll
                for (int o = 0; o < 8; ++o) { float vsel = le[o];
#pragma unroll
                    for (int g = 1; g < 4; ++g) vsel = (gi == g) ? le[g * 8 + o] : vsel;
                    ev[o] = vsel; }
                int i0 = 0; float m0v = ev[0];
#pragma unroll
                for (int o = 1; o < 8; ++o) if (ev[o] > m0v) { m0v = ev[o]; i0 = o; }
                int i1 = (i0 == 0) ? 1 : 0; float m1v = -3.4e38f;
#pragma unroll
                for (int o = 0; o < 8; ++o) if (o != i0 && ev[o] > m1v) { m1v = ev[o]; i1 = o; }
                const float e1 = expf(m1v - m0v); const float w0 = gp / (1.f + e1), w1 = gp * e1 / (1.f + e1);
                const int ex0 = gi * 8 + i0, ex1 = gi * 8 + i1;
                if (!dry) { rw[2 * t] = w0; rw[2 * t + 1] = w1; }
                const unsigned r0 = __hip_atomic_fetch_add(lcnt + ex0, 1u, __ATOMIC_RELAXED, __HIP_MEMORY_SCOPE_WORKGROUP); const unsigned r1 = __hip_atomic_fetch_add(lcnt + ex1, 1u, __ATOMIC_RELAXED, __HIP_MEMORY_SCOPE_WORKGROUP);
                texh[4 * lane] = ex0; texh[4 * lane + 1] = ex1; texh[4 * lane + 2] = (int)r0; texh[4 * lane + 3] = (int)r1; }
            }
            __syncthreads();
            if (tid < NE) { const unsigned c = lcnt[tid]; lcnt[32 + tid] = (c && !dry) ? atomicAdd(cnt + tid, c) : 0u; }
            __syncthreads();
            if (wave < 4 && lane < 32 && !dry) { const int half = lane >> 4, l16 = lane & 15; const int t = t0 + (wave * 2 + half) * 16 + l16; const LAS int* te = tex + half * 64 + 4 * l16; const int ex0 = te[0], ex1 = te[1];
                list[(size_t)ex0 * T + lcnt[32 + ex0] + (unsigned)te[2]] = t * 2; list[(size_t)ex1 * T + lcnt[32 + ex1] + (unsigned)te[3]] = t * 2 + 1; }
            __syncthreads();
        }
        SEAM(PH_ROUTER);
    }
    if (HAS(PH_G7) || HAS(PH_G8)) {
        if (tid < NE) MISC[64 + tid] = __hip_atomic_load(cnt + tid, RLX_AGENT);
        __syncthreads();
        if (tid == 0) { unsigned acc = 0u; for (int e = 0; e < NE; ++e) { MISC[16 + e] = acc; acc += (MISC[64 + e] + 255u) >> 8; } MISC[16 + NE] = acc; }
        __syncthreads();
        const int ntiles = (int)MISC[16 + NE];
        unsigned* tdone = ctl + CW_TDONE;
        const int nwg = ntiles * 4, r7 = nwg % G;
        if (HAS(PH_G7)) {
            g8::MoeOrder S{(const char*)x1b, (const char*)(wt + WT_GU), list, MISC + 16, MISC + 64, nwg, G, bx, 0, (size_t)1024 * 1024 * 2, (size_t)256 * 1024 * 2, 1, tdone, 1};
            g8::EpiGateUp E{hb};
            g8::gemm_phase<g8::EpiGateUp, g8::MoeOrder, true, true>(lds, 1024, S, E);
        }
        if (HAS(PH_G8)) {
            g8::MoeOrder S{(const char*)hb, (const char*)(wt + WT_DN), list, MISC + 16, MISC + 64, nwg, G, (bx - r7 + G) % G, (size_t)256 * 512 * 2, (size_t)1024 * 512 * 2, (size_t)256 * 512 * 2, 0, tdone, 2};
            g8::EpiDown E{ybuf, list, rw, MISC + 64};
            g8::gemm_phase<g8::EpiDown, g8::MoeOrder, true, false>(lds, 512, S, E);
            SEAM(PH_G8);
        } else if (HAS(PH_G7)) { SEAM(PH_G8); }
    }
    if (HAS(PH_FINAL)) {
        for (int t = gw; t < T; t += NGW) {
            float* yr = out + (size_t)t * 1024; float* yw = dry ? (float*)(ws + WS_V) + (size_t)t * 1024 : yr; const bf16_t* x1r = x1b + (size_t)t * 1024; float xv[16]; float s = 0.f;
#pragma unroll
            for (int j = 0; j < 4; ++j) { const int c0 = j * 256 + lane * 4; const u32x2 xw = __builtin_nontemporal_load((const u32x2*)(x1r + c0)); const float x1v[4] = {bflo(xw.x), bfhi(xw.x), bflo(xw.y), bfhi(xw.y)};
                const u32x2 a = __builtin_nontemporal_load((const u32x2*)(ybuf + (size_t)(2 * t) * 1024 + c0)); const u32x2 b = __builtin_nontemporal_load((const u32x2*)(ybuf + (size_t)(2 * t + 1) * 1024 + c0));
                const float ya[4] = {bflo(a.x), bfhi(a.x), bflo(a.y), bfhi(a.y)}; const float yb[4] = {bflo(b.x), bfhi(b.x), bflo(b.y), bfhi(b.y)};
#pragma unroll
                for (int i = 0; i < 4; ++i) { const float val = ALPHA * x1v[i] + (ya[i] + yb[i]); xv[4 * j + i] = val; s += val; } }
            const float mu = wave_sum(s) * (1.f / 1024.f); float s2 = 0.f;
#pragma unroll
            for (int i = 0; i < 16; ++i) { const float d = xv[i] - mu; s2 += d * d; }
            const float rstd = 1.0f / sqrtf(wave_sum(s2) * (1.f / 1024.f) + LN_EPS);
#pragma unroll
            for (int j = 0; j < 4; ++j) { const int c0 = j * 256 + lane * 4; const f32x4 gg = *(const f32x4*)(ln2_g + c0); const f32x4 bb = *(const f32x4*)(ln2_b + c0); f32x4 o;
#pragma unroll
                for (int i = 0; i < 4; ++i) o[i] = (xv[4 * j + i] - mu) * rstd * gg[i] + bb[i];
                __builtin_nontemporal_store(o, (f32x4*)(yw + c0)); }
        }
    }
#undef HAS
#undef SEAM
}
#undef IN_F
#undef x_
#undef positions
#undef w_in
#undef gate_bias
#undef lam_vecs
#undef subln_gain
#undef w_pool
#undef pool_scale
#undef w_branch_a
#undef w_branch_b
#undef w_out
#undef ln1_g
#undef ln1_b
#undef wrg
#undef brg
#undef wre
#undef bre
#undef wgu
#undef wdn
#undef ln2_g
#undef ln2_b
#undef wt
#undef xb
#undef qb
#undef kb
#undef vb
#undef ub
#undef gb
#undef on
#undef mixed
#undef merged
#undef x1b
#undef hb
#undef ybuf
#undef rope
#undef pooled
#undef misc
#undef ctl
#undef stats
#undef rw
#undef list
#undef scal
#undef cnt
#undef wpool_bd


#ifndef MK_OPT
#define MK_OPT 0xfffu
#endif
#ifndef MK_M2A
#define MK_M2A 0xff4u
#define MK_M2B 0u
#define MK_M2C 0u
#endif
#ifndef MK_ONE
#define MK_ONE 1
#endif
constexpr unsigned OPT = MK_OPT;
#define OPTP(p) ((OPT >> (p)) & 1u)


#ifdef MK_DEBUG_HASH
__global__ void k_hash(const uint4* __restrict__ p, size_t n16, unsigned long long* __restrict__ outh) {
    unsigned long long h = 0ull;
    for (size_t i = blockIdx.x * (size_t)blockDim.x + threadIdx.x; i < n16; i += (size_t)gridDim.x * blockDim.x) { const uint4 w = p[i];
        const unsigned long long m = (unsigned long long)(i * 2654435761ull + 12345ull) | 1ull;
        h += ((unsigned long long)w.x * 0x9E3779B1ull + (unsigned long long)w.y * 0x85EBCA77ull + (unsigned long long)w.z * 0xC2B2AE3Dull + (unsigned long long)w.w * 0x27D4EB2Full) * m; }
    for (int o = 32; o > 0; o >>= 1) h += __shfl_xor(h, o);
    if ((threadIdx.x & 63) == 0) atomicAdd(outh, h);
}
__global__ void k_poison(float* __restrict__ out, const unsigned long long* __restrict__ hs) {
    float code = 0.f; for (int r = 1; r < 10; ++r) if (hs[r] != hs[0]) code = 1.f;
    if (code == 0.f) return;
    for (size_t i = blockIdx.x * (size_t)blockDim.x + threadIdx.x; i < (size_t)T * DM; i += (size_t)gridDim.x * blockDim.x) out[i] = __builtin_nanf("") * code;
}
#endif
extern "C" void kernel_launch(void* const* d_in, const int* in_sizes, int n_in, void* d_out, int out_size, void* d_ws, size_t ws_size, hipStream_t stream) {
    static int grid = 0;
    if (grid == 0) {
        if (n_in != 21 || in_sizes[0] != T * DM || out_size != T * DM || ws_size < WS_END) { fprintf(stderr, "kernel_launch: unexpected shapes (n_in %d, x %d, out %d, ws %zu)\n", n_in, n_in > 0 ? in_sizes[0] : -1, out_size, ws_size); grid = -1; return; }
        int dev = 0, cus = 0;
        if (hipGetDevice(&dev) != hipSuccess || hipDeviceGetAttribute(&cus, hipDeviceAttributeMultiprocessorCount, dev) != hipSuccess) { fprintf(stderr, "kernel_launch: device query failed\n"); grid = -1; return; }
        int per_cu = 0;
        if (hipOccupancyMaxActiveBlocksPerMultiprocessor(&per_cu, (const void*)mk_fwd, NTHREADS, 0) != hipSuccess || per_cu < 1) fprintf(stderr, "kernel_launch: note: occupancy query reports %d blocks per CU\n", per_cu);
        (void)hipGetLastError();
        grid = cus;
    }
    if (grid < 0) return;
    const float* x = (const float*)d_in[0]; const int* positions = (const int*)d_in[1]; const float* w_in = (const float*)d_in[2]; const float* gate_bias = (const float*)d_in[3];
    const float* lam_vecs = (const float*)d_in[4]; const float* subln_gain = (const float*)d_in[5]; const float* w_pool = (const float*)d_in[6]; const float* pool_scale = (const float*)d_in[7];
    const float* w_branch_a = (const float*)d_in[8]; const float* w_branch_b = (const float*)d_in[9]; const float* w_out = (const float*)d_in[10]; const float* ln1_g = (const float*)d_in[11];
    const float* ln1_b = (const float*)d_in[12]; const float* wrg = (const float*)d_in[13]; const float* brg = (const float*)d_in[14]; const float* wre = (const float*)d_in[15];
    const float* bre = (const float*)d_in[16]; const float* wgu = (const float*)d_in[17]; const float* wdn = (const float*)d_in[18]; const float* ln2_g = (const float*)d_in[19]; const float* ln2_b = (const float*)d_in[20];
    char* ws = (char*)d_ws; float* out = (float*)d_out;
    bf16_t* qb = (bf16_t*)(ws + WS_Q); bf16_t* kb = (bf16_t*)(ws + WS_K); bf16_t* vb = (bf16_t*)(ws + WS_V); bf16_t* ub = (bf16_t*)(ws + WS_U); bf16_t* gb = (bf16_t*)d_out;
    bf16_t* on = (bf16_t*)(ws + WS_ON); bf16_t* mixed = (bf16_t*)(ws + WS_MIXED); bf16_t* merged = (bf16_t*)(ws + WS_MERGED); bf16_t* x1b = (bf16_t*)(ws + WS_X1B);
    bf16_t* hb = (bf16_t*)(ws + WS_H); bf16_t* ybuf = (bf16_t*)(ws + WS_YBUF); float2* rope = (float2*)(ws + WS_ROPE); float* tmp = (float*)(ws + WS_TEMP);
    char* misc = ws + WS_MISC; unsigned* ctl = (unsigned*)(misc + MS_CTL); float2* stats = (float2*)(misc + MS_STATS); int2* rexp = (int2*)(misc + MS_ROUTE); float2* rw = (float2*)(misc + MS_ROUTE + (size_t)T * 8);
    int* list = (int*)(misc + MS_LIST); float* scal = (float*)(misc + MS_SCAL); unsigned* cnt = ctl;

    MKArgs a{}; int nlaunch = 0;
    for (int i = 0; i < 21; ++i) a.in[i] = d_in[i];
    a.out = out; a.ws = (unsigned char*)d_ws;
    if (hipMemsetAsync(ctl, 0, 65536, stream) != hipSuccess) { fprintf(stderr, "kernel_launch: memset failed\n"); return; }
#ifndef MK_REPH
#define MK_REPH 0u
#endif
#define MK(maskv) do { a.mask = (maskv); for (int rr_ = 0; rr_ < (((maskv) & (MK_REPH)) ? 2 : 1); ++rr_) { a.li = (unsigned)(nlaunch++ % 3) | (rr_ ? (1u << 8) : 0u); hipLaunchKernelGGL(mk_fwd, dim3(grid), dim3(NTHREADS), 0, stream, a); } } while (0)
    if (MK_ONE == 1) { MK((1u << PH_N) - 1u); return; }
    if (MK_ONE == 2) {
        MK(0x003u);
        for (int mh = 0; mh < 2; ++mh) { const int m0 = mh * 16384; nattn<<<(16384 / 64) * 16, 64, 0, stream>>>(qb, kb, vb, scal, tmp, m0); post_rms<<<16384 * 8 / 256, 256, 0, stream>>>(tmp, subln_gain, on, m0, 16384); }
        MK(MK_M2A); if (MK_M2B) MK(MK_M2B); if (MK_M2C) MK(MK_M2C); return; }

    constexpr int MC = 16384;
#if 0
#else
#ifdef MK_TEST_BAR
    MK(0x003u);
#else
    if (OPTP(PH_PRO)) MK(1u << PH_PRO); else k_prep<<<T * 32 / 256, 256, 0, stream>>>(positions, lam_vecs, rope, scal, ctl);
    if (OPTP(PH_G1)) MK(1u << PH_G1);
#endif
#endif
#ifndef MK_OVR
#define MK_OVR 0
#endif
    const int ovr = OPTP(PH_G1) ? MK_OVR : 15;
    for (int mh = 0; mh < 2; ++mh) {
        const int m0 = mh * MC; AL_F32 ax{x + (size_t)m0 * DM, DM, 0};
        if (ovr & 1) for (int qk = 0; qk < 2; ++qk) {
            ngemm<AL_F32><<<dim3(16, MC / 64), 256, 0, stream>>>(ax, w_in + qk * 1024, INW, tmp, 1024, MC, 1024, DM);
            post_qk<<<MC * 512 / 256, 256, 0, stream>>>(tmp, rope, qk ? kb : qb, m0, MC, qk ? 1.f : QSCALE);
        }
        if (ovr & 2) { ngemm<AL_F32><<<dim3(16, MC / 64), 256, 0, stream>>>(ax, w_in + 2048, INW, tmp, 1024, MC, 1024, DM);
        post_plain<<<MC * 1024 / 256, 256, 0, stream>>>(tmp, vb, 1024, 0, m0, MC, 1024, nullptr); }
        if (ovr & 4) { ngemm<AL_F32><<<dim3(8, MC / 64), 256, 0, stream>>>(ax, w_in + 3072, INW, tmp, 512, MC, 512, DM);
        post_plain<<<MC * 512 / 256, 256, 0, stream>>>(tmp, ub, 512, 0, m0, MC, 512, nullptr); }
        if (ovr & 8) for (int br = 0; br < 2; ++br) {
            ngemm<AL_F32><<<dim3(16, MC / 64), 256, 0, stream>>>(ax, w_in + 3584 + br * 1024, INW, tmp, 1024, MC, 1024, DM);
            post_gate<<<MC * 1024 / 256, 256, 0, stream>>>(tmp, gate_bias, gb, br * 1024, m0, MC);
        }
    }
    if (OPTP(PH_ATT)) MK(1u << PH_ATT);
    else for (int mh = 0; mh < 2; ++mh) {
        const int m0 = mh * MC;
        nattn<<<(MC / 64) * 16, 64, 0, stream>>>(qb, kb, vb, scal, tmp, m0);
        post_rms<<<MC * 8 / 256, 256, 0, stream>>>(tmp, subln_gain, on, m0, MC);
    }
    if (OPTP(PH_POOLA)) { MK(1u << PH_POOLA); MK(1u << PH_POOLG); }
    else for (int mh = 0; mh < 2; ++mh) {
        const int m0 = mh * MC;
        for (int g = 0; g < 4; ++g) { AL_POOL ap{ub + (size_t)m0 * PW, g, 0};
            ngemm<AL_POOL><<<dim3(2, MC / 64), 256, 0, stream>>>(ap, w_pool + (size_t)g * 128 * 128, 128, tmp + g * 128, 512, MC, 128, 128); }
        post_plain<<<MC * 512 / 256, 256, 0, stream>>>(tmp, mixed, 512, 0, m0, MC, 512, pool_scale);
    }
    if (OPTP(PH_G4A)) MK(1u << PH_G4A);
    else for (int mh = 0; mh < 2; ++mh) {
        const int m0 = mh * MC;
        { AL_BF16 al{on + (size_t)m0 * 1024, 1024, 0}; ngemm<AL_BF16><<<dim3(16, MC / 64), 256, 0, stream>>>(al, w_branch_a, 1024, tmp, 1024, MC, 1024, 1024); }
        post_merge<<<MC * 1024 / 256, 256, 0, stream>>>(tmp, gb, merged, 0, m0, MC);
    }
    if (OPTP(PH_G4B)) MK(1u << PH_G4B);
    else for (int mh = 0; mh < 2; ++mh) {
        const int m0 = mh * MC;
        { AL_BF16 al{mixed + (size_t)m0 * 512, 512, 0}; ngemm<AL_BF16><<<dim3(16, MC / 64), 256, 0, stream>>>(al, w_branch_b, 1024, tmp, 1024, MC, 1024, 512); }
        post_merge<<<MC * 1024 / 256, 256, 0, stream>>>(tmp, gb, merged, 1, m0, MC);
    }
    if (OPTP(PH_G5)) MK(1u << PH_G5);
    else for (int mh = 0; mh < 2; ++mh) {
        const int m0 = mh * MC;
        { AL_BF16 al{merged + (size_t)m0 * 1024, 1024, 0}; ngemm<AL_BF16><<<dim3(16, MC / 64), 256, 0, stream>>>(al, w_out, 1024, tmp, 1024, MC, 1024, 1024); }
        post_y<<<MC * 1024 / 256, 256, 0, stream>>>(tmp, x, out, m0, MC);
    }
    if (OPTP(PH_ROUTER)) MK(1u << PH_ROUTER); else k_router<<<T / 4, 256, 0, stream>>>(out, ln1_g, ln1_b, wrg, brg, wre, bre, x1b, stats, rexp, rw, list, cnt);
    if (OPTP(PH_G7)) MK(1u << PH_G7); else nmoe_gu<<<dim3(8, T / 64, NE), 256, 0, stream>>>(x1b, list, cnt, wgu, hb);
    if (OPTP(PH_G8)) MK(1u << PH_G8); else nmoe_dn<<<dim3(16, T / 64, NE), 256, 0, stream>>>(hb, list, cnt, rw, wdn, ybuf);
    if (OPTP(PH_FINAL)) MK(1u << PH_FINAL); else k_final<<<T / 4, 256, 0, stream>>>(out, stats, ln1_g, ln1_b, ybuf, ln2_g, ln2_b);
#undef MK
}
```

```cpp
#define AN_G1 9
#define AN_ATT 4
#define AN_G4A 10
#define AN_G4B 4
#define AN_G5 15
#define AN_RT 8
#define AN_G7 10
#define AN_G8 1
#include <hip/hip_runtime.h>
#include <cstdio>
#include <cstdint>
#include <cmath>

typedef unsigned short bf16_t;
typedef float f32x4 __attribute__((ext_vector_type(4)));

constexpr int NB = 16, SEQ = 2048, DM = 1024, T = NB * SEQ;
constexpr int NHEAD = 8, HD = 64, NHM = 16;
constexpr int INW = 5632;
constexpr int PW = 512, PG = 4, PGD = 128;
constexpr int NE = 32, NGRP = 4, EPG = 8, FF = 512;
constexpr float LN_EPS = 1e-5f, RMS_EPS = 1e-5f;
constexpr float ALPHA = 1.189207115002721f;
constexpr float LAMBDA_INIT = 0.2f;
constexpr float QSCALE = 0.125f * 1.4426950408889634f;

constexpr size_t MiB = 1u << 20;
constexpr size_t WS_WT    = 0;
constexpr size_t WS_XB    = 112 * MiB;
constexpr size_t WS_ON    = 112 * MiB;
constexpr size_t WS_YBUF  = 112 * MiB;
constexpr size_t WS_Q     = 176 * MiB;
constexpr size_t WS_MERGED= 176 * MiB;
constexpr size_t WS_K     = 240 * MiB;
constexpr size_t WS_X1B   = 240 * MiB;
constexpr size_t WS_V     = 304 * MiB;
constexpr size_t WS_H     = 304 * MiB;
constexpr size_t WS_U     = 368 * MiB;
constexpr size_t WS_MIXED = 400 * MiB;
constexpr size_t WS_ROPE  = 432 * MiB;
constexpr size_t WS_MISC  = 440 * MiB;
constexpr size_t WS_TEMP  = 448 * MiB;
constexpr size_t WS_END   = 512 * MiB;
constexpr size_t MS_CTL   = 0;
constexpr size_t MS_STATS = 64 * 1024;
constexpr size_t MS_ROUTE = 512 * 1024;
constexpr size_t MS_LIST  = 1 * MiB;
constexpr size_t MS_SCAL  = 6 * MiB;

__device__ __forceinline__ float bf2f(bf16_t v) { return __uint_as_float((unsigned)v << 16); }
__device__ __forceinline__ bf16_t f2bf(float f) { unsigned u = __float_as_uint(f); return (bf16_t)((u + 0x7fffu + ((u >> 16) & 1u)) >> 16); }
__host__ __device__ __forceinline__ int qk_pos_of_d(int d) { return ((d >> 4) & 1) * 32 + ((d >> 2) & 3) * 8 + (d >> 5) * 4 + (d & 3); }

struct AL_F32  { const float* p; int ld; int pad;  __device__ __forceinline__ float operator()(int r, int k) const { return p[(size_t)r * ld + k]; } };
struct AL_BF16 { const bf16_t* p; int ld; int pad; __device__ __forceinline__ float operator()(int r, int k) const { return bf2f(p[(size_t)r * ld + k]); } };
struct AL_POOL { const bf16_t* u; int g; int pad;
    __device__ __forceinline__ float operator()(int r, int k) const {
        const int w = 2 << g, s = r & (SEQ - 1); const int n = (s + 1 < w) ? s + 1 : w; float acc = 0.f;
        for (int i = 0; i < n; ++i) acc += bf2f(u[(size_t)(r - i) * PW + g * PGD + k]);
        return acc / (float)n - bf2f(u[(size_t)r * PW + g * PGD + k]); } };

template <class AL>
__global__ __launch_bounds__(256) void ngemm(AL al, const float* __restrict__ Bm, int ldb, float* __restrict__ C, int ldc, int M, int N, int K) {
    __shared__ float As[16][68]; __shared__ float Bs[16][68];
    const int tid = threadIdx.x, tx = tid & 15, ty = tid >> 4; const int m0 = blockIdx.y * 64, n0 = blockIdx.x * 64;
    float acc[4][4] = {};
    for (int k0 = 0; k0 < K; k0 += 16) {
#pragma unroll
        for (int i = 0; i < 4; ++i) { const int e = tid + i * 256; const int r = e >> 4, kk = e & 15; As[kk][r] = (m0 + r < M) ? al(m0 + r, k0 + kk) : 0.f; }
#pragma unroll
        for (int i = 0; i < 4; ++i) { const int e = tid + i * 256; const int kk = e >> 6, c = e & 63; Bs[kk][c] = (n0 + c < N) ? Bm[(size_t)(k0 + kk) * ldb + n0 + c] : 0.f; }
        __syncthreads();
#pragma unroll
        for (int kk = 0; kk < 16; ++kk) { float a[4], b[4];
#pragma unroll
            for (int i = 0; i < 4; ++i) { a[i] = As[kk][ty * 4 + i]; b[i] = Bs[kk][tx * 4 + i]; }
#pragma unroll
            for (int i = 0; i < 4; ++i)
#pragma unroll
                for (int j = 0; j < 4; ++j) acc[i][j] = fmaf(a[i], b[j], acc[i][j]); }
        __syncthreads();
    }
#pragma unroll
    for (int i = 0; i < 4; ++i)
#pragma unroll
        for (int j = 0; j < 4; ++j) { const int r = m0 + ty * 4 + i, c = n0 + tx * 4 + j; if (r < M && c < N) C[(size_t)r * ldc + c] = acc[i][j]; }
}

__global__ void k_prep(const int* __restrict__ positions, const float* __restrict__ lam_vecs, float2* __restrict__ rope, float* __restrict__ scal, unsigned* __restrict__ ctl) {
    const int gid = blockIdx.x * blockDim.x + threadIdx.x;
    if (gid < T * 32) { const int t = gid >> 5, i = gid & 31;
        const float inv = powf(10000.0f, -(float)i * (2.0f / 64.0f)); const float ang = (float)positions[t] * inv;
        const double a = (double)ang; rope[gid] = make_float2((float)cos(a), (float)sin(a)); }
    if (gid < 16384) ctl[gid] = 0u;
    if (gid == 0) { float s01 = 0.f, s23 = 0.f; for (int i = 0; i < 64; ++i) { s01 += lam_vecs[i] * lam_vecs[64 + i]; s23 += lam_vecs[128 + i] * lam_vecs[192 + i]; }
        scal[0] = expf(s01) - expf(s23) + LAMBDA_INIT; }
}
__global__ void post_qk(const float* __restrict__ tmp, const float2* __restrict__ rope, bf16_t* __restrict__ out, int m0, int Mc, float scale) {
    const int gid = blockIdx.x * blockDim.x + threadIdx.x; if (gid >= Mc * 512) return;
    const int r = gid >> 9, p = gid & 511, hm = p >> 5, i = p & 31; const int t = m0 + r;
    const float t1 = tmp[(size_t)r * 1024 + hm * 64 + i], t2 = tmp[(size_t)r * 1024 + hm * 64 + i + 32]; const float2 cs = rope[t * 32 + i];
    out[(size_t)t * 1024 + hm * 64 + qk_pos_of_d(i)] = f2bf((t1 * cs.x - t2 * cs.y) * scale);
    out[(size_t)t * 1024 + hm * 64 + qk_pos_of_d(i + 32)] = f2bf((t2 * cs.x + t1 * cs.y) * scale);
}
__global__ void post_plain(const float* __restrict__ tmp, bf16_t* __restrict__ out, int ldo, int coloff, int m0, int Mc, int N, const float* __restrict__ colscale) {
    const int gid = blockIdx.x * blockDim.x + threadIdx.x; if (gid >= Mc * N) return;
    const int r = gid / N, c = gid % N; float v = tmp[(size_t)r * N + c]; if (colscale) v *= colscale[c];
    out[(size_t)(m0 + r) * ldo + coloff + c] = f2bf(v);
}
__global__ void post_gate(const float* __restrict__ tmp, const float* __restrict__ bias, bf16_t* __restrict__ gates, int coloff, int m0, int Mc) {
    const int gid = blockIdx.x * blockDim.x + threadIdx.x; if (gid >= Mc * 1024) return;
    const int r = gid >> 10, c = gid & 1023; const float v = tmp[(size_t)r * 1024 + c] + bias[coloff + c];
    gates[(size_t)(m0 + r) * 2048 + coloff + c] = f2bf(1.f / (1.f + expf(-v)));
}
__global__ __launch_bounds__(64) void nattn(const bf16_t* __restrict__ q, const bf16_t* __restrict__ k, const bf16_t* __restrict__ v, const float* __restrict__ scal, float* __restrict__ tmp, int m0) {
    const int lane = threadIdx.x; const int blk = blockIdx.x;
    const int half = blk & 1, head = (blk >> 1) & 7, cg = blk >> 4; const int t0 = m0 + cg * 64, t = t0 + lane; const int b = t0 / SEQ, s0 = t0 % SEQ; const int nkeys = ((s0 >> 6) + 1) * 64;
    const float lam = scal[0];
    float res[64];
    for (int mp = 0; mp < 2; ++mp) {
        const int hm = head * 2 + mp; float qv[64];
#pragma unroll
        for (int d = 0; d < 64; ++d) qv[d] = bf2f(q[(size_t)t * 1024 + hm * 64 + d]);
        float mx = -1e30f, l = 0.f; float o[64];
#pragma unroll
        for (int d = 0; d < 64; ++d) o[d] = 0.f;
        for (int j = 0; j < nkeys; ++j) { const size_t kr = (size_t)(b * SEQ + j) * 1024; float sc = 0.f;
            const uint4* kp = (const uint4*)(k + kr + hm * 64); const uint4* vp = (const uint4*)(v + kr + head * 128 + half * 64);
#pragma unroll
            for (int c = 0; c < 8; ++c) { const uint4 w = kp[c]; const unsigned ww[4] = {w.x, w.y, w.z, w.w};
#pragma unroll
                for (int e = 0; e < 4; ++e) { sc = fmaf(qv[c * 8 + 2 * e], __uint_as_float(ww[e] << 16), sc); sc = fmaf(qv[c * 8 + 2 * e + 1], __uint_as_float(ww[e] & 0xffff0000u), sc); } }
            const float mn = fmaxf(mx, sc), al = exp2f(mx - mn), p = exp2f(sc - mn); mx = mn; l = l * al + p;
#pragma unroll
            for (int c = 0; c < 8; ++c) { const uint4 w = vp[c]; const unsigned ww[4] = {w.x, w.y, w.z, w.w};
#pragma unroll
                for (int e = 0; e < 4; ++e) { o[c * 8 + 2 * e] = fmaf(p, __uint_as_float(ww[e] << 16), o[c * 8 + 2 * e] * al); o[c * 8 + 2 * e + 1] = fmaf(p, __uint_as_float(ww[e] & 0xffff0000u), o[c * 8 + 2 * e + 1] * al); } } }
        const float il = 1.f / l;
#pragma unroll
        for (int d = 0; d < 64; ++d) res[d] = (mp == 0) ? o[d] * il : res[d] - lam * o[d] * il;
    }
#pragma unroll
    for (int d = 0; d < 64; ++d) tmp[(size_t)(t - m0) * 1024 + head * 128 + half * 64 + d] = res[d];
}
__global__ void post_rms(const float* __restrict__ tmp, const float* __restrict__ gain, bf16_t* __restrict__ on, int m0, int Mc) {
    const int gid = blockIdx.x * blockDim.x + threadIdx.x; if (gid >= Mc * 8) return;
    const int r = gid >> 3, head = gid & 7; const float* p = tmp + (size_t)r * 1024 + head * 128; float ss = 0.f;
    for (int d = 0; d < 128; ++d) ss += p[d] * p[d];
    const float rs = 1.0f / sqrtf(ss * (1.f / 128.f) + RMS_EPS);
    for (int d = 0; d < 128; ++d) on[(size_t)(m0 + r) * 1024 + head * 128 + d] = f2bf(p[d] * rs * gain[d] * (1.f - LAMBDA_INIT));
}
__global__ void post_merge(const float* __restrict__ tmp, const bf16_t* __restrict__ gates, bf16_t* __restrict__ merged, int br, int m0, int Mc) {
    const int gid = blockIdx.x * blockDim.x + threadIdx.x; if (gid >= Mc * 1024) return;
    const int r = gid >> 10, c = gid & 1023; const size_t t = m0 + r; const float g = bf2f(gates[t * 2048 + br * 1024 + c]);
    float val = g * tmp[(size_t)r * 1024 + c]; if (br) val += bf2f(merged[t * 1024 + c]);
    merged[t * 1024 + c] = f2bf(val);
}
__global__ void post_y(const float* __restrict__ tmp, const float* __restrict__ x, float* __restrict__ y, int m0, int Mc) {
    const int gid = blockIdx.x * blockDim.x + threadIdx.x; if (gid >= Mc * 1024) return;
    const size_t o = (size_t)m0 * 1024 + gid; y[o] = ALPHA * x[o] + tmp[gid];
}
__device__ __forceinline__ float wave_sum(float v) {
#pragma unroll
    for (int o = 1; o < 64; o <<= 1) v += __shfl_xor(v, o);
    return v;
}
__global__ __launch_bounds__(256) void k_router(const float* __restrict__ y, const float* __restrict__ g1, const float* __restrict__ b1, const float* __restrict__ wrg, const float* __restrict__ brg,
                                                const float* __restrict__ wre, const float* __restrict__ bre, bf16_t* __restrict__ x1b, float2* __restrict__ stats, int2* __restrict__ rexp, float2* __restrict__ rw,
                                                int* __restrict__ list, unsigned* __restrict__ cnt) {
    const int lane = threadIdx.x & 63; const int t = blockIdx.x * 4 + (threadIdx.x >> 6);
    const float* yr = y + (size_t)t * 1024; float xv[16]; float s = 0.f;
#pragma unroll
    for (int j = 0; j < 4; ++j) { const f32x4 vv = *(const f32x4*)(yr + j * 256 + lane * 4); xv[4 * j] = vv.x; xv[4 * j + 1] = vv.y; xv[4 * j + 2] = vv.z; xv[4 * j + 3] = vv.w; s += (vv.x + vv.y) + (vv.z + vv.w); }
    const float mu = wave_sum(s) * (1.f / 1024.f); float s2 = 0.f;
#pragma unroll
    for (int i = 0; i < 16; ++i) { const float d = xv[i] - mu; s2 += d * d; }
    const float rstd = 1.0f / sqrtf(wave_sum(s2) * (1.f / 1024.f) + LN_EPS);
    if (lane == 0) stats[t] = make_float2(mu, rstd);
#pragma unroll
    for (int j = 0; j < 4; ++j)
#pragma unroll
        for (int i = 0; i < 4; ++i) { const int c = j * 256 + lane * 4 + i; xv[4 * j + i] = (xv[4 * j + i] - mu) * rstd * g1[c] + b1[c]; }
#pragma unroll
    for (int j = 0; j < 4; ++j) { uint2 w; w.x = (unsigned)f2bf(xv[4 * j]) | ((unsigned)f2bf(xv[4 * j + 1]) << 16); w.y = (unsigned)f2bf(xv[4 * j + 2]) | ((unsigned)f2bf(xv[4 * j + 3]) << 16);
        *(uint2*)(x1b + (size_t)t * 1024 + j * 256 + lane * 4) = w; }
    float lg[4], le[32];
#pragma unroll
    for (int o = 0; o < 4; ++o) { float a = 0.f;
#pragma unroll
        for (int j = 0; j < 4; ++j)
#pragma unroll
            for (int i = 0; i < 4; ++i) a = fmaf(xv[4 * j + i], wrg[(size_t)(j * 256 + lane * 4 + i) * 4 + o], a);
        lg[o] = wave_sum(a) + brg[o]; }
#pragma unroll
    for (int o = 0; o < 32; ++o) { float a = 0.f;
#pragma unroll
        for (int j = 0; j < 4; ++j)
#pragma unroll
            for (int i = 0; i < 4; ++i) a = fmaf(xv[4 * j + i], wre[(size_t)(j * 256 + lane * 4 + i) * 32 + o], a);
        le[o] = wave_sum(a) + bre[o]; }
    if (lane == 0) {
        int gi = 0; float gm = lg[0];
#pragma unroll
        for (int o = 1; o < 4; ++o) if (lg[o] > gm) { gm = lg[o]; gi = o; }
        float gs = 0.f;
#pragma unroll
        for (int o = 0; o < 4; ++o) gs += expf(lg[o] - gm);
        const float gp = 1.f / gs;
        float ev[8];
#pragma unroll
        for (int o = 0; o < 8; ++o) { float vsel = le[o];
#pragma unroll
            for (int g = 1; g < 4; ++g) vsel = (gi == g) ? le[g * 8 + o] : vsel;
            ev[o] = vsel; }
        int i0 = 0; float m0v = ev[0];
#pragma unroll
        for (int o = 1; o < 8; ++o) if (ev[o] > m0v) { m0v = ev[o]; i0 = o; }
        int i1 = (i0 == 0) ? 1 : 0; float m1v = -3.4e38f;
#pragma unroll
        for (int o = 0; o < 8; ++o) if (o != i0 && ev[o] > m1v) { m1v = ev[o]; i1 = o; }
        const float e1 = expf(m1v - m0v); const float w0 = gp / (1.f + e1), w1 = gp * e1 / (1.f + e1);
        const int ex0 = gi * 8 + i0, ex1 = gi * 8 + i1;
        rexp[t] = make_int2(ex0, ex1); rw[t] = make_float2(w0, w1);
        const unsigned p0 = atomicAdd(&cnt[ex0], 1u); list[(size_t)ex0 * T + p0] = t * 2;
        const unsigned p1 = atomicAdd(&cnt[ex1], 1u); list[(size_t)ex1 * T + p1] = t * 2 + 1;
    }
}
__global__ __launch_bounds__(256) void nmoe_gu(const bf16_t* __restrict__ x1b, const int* __restrict__ list, const unsigned* __restrict__ cnt, const float* __restrict__ wgu, bf16_t* __restrict__ h) {
    __shared__ float As[16][68]; __shared__ float Bg[16][68]; __shared__ float Bu[16][68]; __shared__ int toks[64];
    const int e = blockIdx.z; const int M = (int)cnt[e]; const int m0 = blockIdx.y * 64, n0 = blockIdx.x * 64; if (m0 >= M) return;
    int tb = 0; for (int i = 0; i < e; ++i) tb += ((int)cnt[i] + 255) >> 8;
    const int tid = threadIdx.x, tx = tid & 15, ty = tid >> 4;
    if (tid < 64) toks[tid] = (m0 + tid < M) ? (list[(size_t)e * T + m0 + tid] >> 1) : 0;
    __syncthreads();
    const float* W = wgu + (size_t)e * 1024 * 1024; float ag[4][4] = {}, au[4][4] = {};
    for (int k0 = 0; k0 < 1024; k0 += 16) {
#pragma unroll
        for (int i = 0; i < 4; ++i) { const int el = tid + i * 256; const int r = el >> 4, kk = el & 15; As[kk][r] = bf2f(x1b[(size_t)toks[r] * 1024 + k0 + kk]); }
#pragma unroll
        for (int i = 0; i < 4; ++i) { const int el = tid + i * 256; const int kk = el >> 6, c = el & 63; Bg[kk][c] = W[(size_t)(k0 + kk) * 1024 + n0 + c]; Bu[kk][c] = W[(size_t)(k0 + kk) * 1024 + 512 + n0 + c]; }
        __syncthreads();
#pragma unroll
        for (int kk = 0; kk < 16; ++kk) { float a[4], bg[4], bu[4];
#pragma unroll
            for (int i = 0; i < 4; ++i) { a[i] = As[kk][ty * 4 + i]; bg[i] = Bg[kk][tx * 4 + i]; bu[i] = Bu[kk][tx * 4 + i]; }
#pragma unroll
            for (int i = 0; i < 4; ++i)
#pragma unroll
                for (int j = 0; j < 4; ++j) { ag[i][j] = fmaf(a[i], bg[j], ag[i][j]); au[i][j] = fmaf(a[i], bu[j], au[i][j]); } }
        __syncthreads();
    }
#pragma unroll
    for (int i = 0; i < 4; ++i)
#pragma unroll
        for (int j = 0; j < 4; ++j) { const int r = m0 + ty * 4 + i, c = n0 + tx * 4 + j; if (r < M) { const float g = ag[i][j]; h[((size_t)tb * 256 + r) * 512 + c] = f2bf(g / (1.f + expf(-g)) * au[i][j]); } }
}
__global__ __launch_bounds__(256) void nmoe_dn(const bf16_t* __restrict__ h, const int* __restrict__ list, const unsigned* __restrict__ cnt, const float2* __restrict__ rw, const float* __restrict__ wdn, bf16_t* __restrict__ ybuf) {
    __shared__ float As[16][68]; __shared__ float Bs[16][68];
    const int e = blockIdx.z; const int M = (int)cnt[e]; const int m0 = blockIdx.y * 64, n0 = blockIdx.x * 64; if (m0 >= M) return;
    int tb = 0; for (int i = 0; i < e; ++i) tb += ((int)cnt[i] + 255) >> 8;
    const int tid = threadIdx.x, tx = tid & 15, ty = tid >> 4;
    const float* W = wdn + (size_t)e * 512 * 1024; float acc[4][4] = {};
    for (int k0 = 0; k0 < 512; k0 += 16) {
#pragma unroll
        for (int i = 0; i < 4; ++i) { const int el = tid + i * 256; const int r = el >> 4, kk = el & 15; As[kk][r] = (m0 + r < M) ? bf2f(h[((size_t)tb * 256 + m0 + r) * 512 + k0 + kk]) : 0.f; }
#pragma unroll
        for (int i = 0; i < 4; ++i) { const int el = tid + i * 256; const int kk = el >> 6, c = el & 63; Bs[kk][c] = W[(size_t)(k0 + kk) * 1024 + n0 + c]; }
        __syncthreads();
#pragma unroll
        for (int kk = 0; kk < 16; ++kk) { float a[4], b[4];
#pragma unroll
            for (int i = 0; i < 4; ++i) { a[i] = As[kk][ty * 4 + i]; b[i] = Bs[kk][tx * 4 + i]; }
#pragma unroll
            for (int i = 0; i < 4; ++i)
#pragma unroll
                for (int j = 0; j < 4; ++j) acc[i][j] = fmaf(a[i], b[j], acc[i][j]); }
        __syncthreads();
    }
#pragma unroll
    for (int i = 0; i < 4; ++i) { const int r = m0 + ty * 4 + i; if (r < M) { const int ent = list[(size_t)e * T + r]; const float2 w2 = rw[ent >> 1]; const float w = (ent & 1) ? w2.y : w2.x;
#pragma unroll
        for (int j = 0; j < 4; ++j) ybuf[(size_t)ent * 1024 + n0 + tx * 4 + j] = f2bf(w * acc[i][j]); } }
}
__global__ __launch_bounds__(256) void k_final(float* __restrict__ yout, const float2* __restrict__ stats, const float* __restrict__ g1, const float* __restrict__ b1, const bf16_t* __restrict__ ybuf,
                                               const float* __restrict__ g2, const float* __restrict__ b2) {
    const int lane = threadIdx.x & 63; const int t = blockIdx.x * 4 + (threadIdx.x >> 6);
    float* yr = yout + (size_t)t * 1024; const float2 st = stats[t]; float xv[16]; float s = 0.f;
#pragma unroll
    for (int j = 0; j < 4; ++j) { const int c0 = j * 256 + lane * 4; const f32x4 vv = *(const f32x4*)(yr + c0); const f32x4 gg = *(const f32x4*)(g1 + c0); const f32x4 bb = *(const f32x4*)(b1 + c0);
        const uint2 a = *(const uint2*)(ybuf + (size_t)(2 * t) * 1024 + c0); const uint2 b = *(const uint2*)(ybuf + (size_t)(2 * t + 1) * 1024 + c0);
        const float ya[4] = {__uint_as_float(a.x << 16), __uint_as_float(a.x & 0xffff0000u), __uint_as_float(a.y << 16), __uint_as_float(a.y & 0xffff0000u)};
        const float yb[4] = {__uint_as_float(b.x << 16), __uint_as_float(b.x & 0xffff0000u), __uint_as_float(b.y << 16), __uint_as_float(b.y & 0xffff0000u)};
#pragma unroll
        for (int i = 0; i < 4; ++i) { const float x1 = (vv[i] - st.x) * st.y * gg[i] + bb[i]; const float val = ALPHA * x1 + (ya[i] + yb[i]); xv[4 * j + i] = val; s += val; } }
    const float mu = wave_sum(s) * (1.f / 1024.f); float s2 = 0.f;
#pragma unroll
    for (int i = 0; i < 16; ++i) { const float d = xv[i] - mu; s2 += d * d; }
    const float rstd = 1.0f / sqrtf(wave_sum(s2) * (1.f / 1024.f) + LN_EPS);
#pragma unroll
    for (int j = 0; j < 4; ++j) { const int c0 = j * 256 + lane * 4; const f32x4 gg = *(const f32x4*)(g2 + c0); const f32x4 bb = *(const f32x4*)(b2 + c0); f32x4 o;
#pragma unroll
        for (int i = 0; i < 4; ++i) o[i] = (xv[4 * j + i] - mu) * rstd * gg[i] + bb[i];
        *(f32x4*)(yr + c0) = o; }
}

#define LAS __attribute__((address_space(3)))
#define GAS __attribute__((address_space(1)))
typedef short bf16x8 __attribute__((ext_vector_type(8)));
typedef unsigned u32x4 __attribute__((ext_vector_type(4)));
typedef unsigned u32x2 __attribute__((ext_vector_type(2)));
typedef GAS unsigned gu32;
#define RLX_AGENT __ATOMIC_RELAXED, __HIP_MEMORY_SCOPE_AGENT
#define LDS_WAIT() asm volatile("s_waitcnt lgkmcnt(0)" ::: "memory")
#define VM_WAIT() asm volatile("s_waitcnt vmcnt(0)" ::: "memory")

constexpr size_t WT_IN = 0;
constexpr size_t WT_A  = WT_IN + (size_t)INW * 1024;
constexpr size_t WT_B  = WT_A + 1024 * 1024;
constexpr size_t WT_O  = WT_B + 1024 * 512;
constexpr size_t WT_GU = WT_O + 1024 * 1024;
constexpr size_t WT_DN = WT_GU + (size_t)NE * 1024 * 1024;
constexpr size_t WT_END = WT_DN + (size_t)NE * 1024 * 512;
static_assert(WT_END * 2 <= 112 * MiB, "weight copies fit");
constexpr size_t MS_WPOOL = 7 * MiB;
constexpr size_t MS_WP = 7 * MiB + 512 * 1024;
constexpr size_t MS_CSBW = 6 * MiB + 1024;
constexpr size_t WS_POOLED = 448 * MiB;

constexpr int CW_CNT = 0;
constexpr int CW_BAR = 1024;
constexpr int CW_TDONE = 12288;

constexpr int NWAVES = 8, NTHREADS = 512;
constexpr int RING_BYTES = 131072, LDS_CTL_OFF = 147456, MISC_OFF = LDS_CTL_OFF + 320, LDS_BYTES = 163840;

typedef float f32x2_t __attribute__((ext_vector_type(2))); typedef __bf16 bf16x2_t __attribute__((ext_vector_type(2)));
__device__ __forceinline__ unsigned cvt_pk_bf16(float lo, float hi) { f32x2_t v = {lo, hi}; bf16x2_t b = __builtin_convertvector(v, bf16x2_t); return __builtin_bit_cast(unsigned, b); }
__device__ __forceinline__ float bflo(unsigned w) { return __uint_as_float(w << 16); }
__device__ __forceinline__ float bfhi(unsigned w) { return __uint_as_float(w & 0xffff0000u); }

#define XB_TMO      128
#define XB_XCNT(j)  (256  + 64 * (j))
#define XB_XSUB(j)  (1280 + 64 * (j))
#define XB_XGEN(j)  (2304 + 64 * (j))
#define XB_TOP      3328
#define XB_TOPGEN   3392
#define XCD_BAR_WORDS 3456
#define XB_SPIN_CAP (1u << 22)
__device__ __forceinline__ unsigned xb_ld(unsigned* p)              { return __hip_atomic_load(p, __ATOMIC_RELAXED, __HIP_MEMORY_SCOPE_AGENT); }
__device__ __forceinline__ unsigned xb_add(unsigned* p, unsigned v) { return __hip_atomic_fetch_add(p, v, __ATOMIC_RELAXED, __HIP_MEMORY_SCOPE_AGENT); }
__device__ __forceinline__ unsigned xb_xcc_id() { return (unsigned)__builtin_amdgcn_s_getreg((3 << 11) | 20) & 0xFu; }
#define XB_SPIN(cond, bar) do { unsigned _sp = 0; while (cond) { __builtin_amdgcn_s_sleep(1); \
    if ((++_sp & 255u) == 0u) { if (xb_ld(&(bar)[XB_TMO])) break; if (_sp > XB_SPIN_CAP) { atomicAdd(&(bar)[XB_TMO], 1u); break; } } } } while (0)
struct XcdBarrier { unsigned* bar; unsigned x; volatile LAS unsigned* st; };
__device__ __forceinline__ XcdBarrier xcd_barrier_post(unsigned* bar, volatile LAS unsigned* st) {
    XcdBarrier b; b.bar = bar; b.x = xb_xcc_id(); b.st = st;
    if (threadIdx.x == 0) (void)xb_add(&bar[XB_XCNT(b.x)], 1u);
    return b;
}
__device__ __forceinline__ void xcd_barrier_complete(unsigned* bar, unsigned x, unsigned& nloc, unsigned& nx) {
    const unsigned G = gridDim.x * gridDim.y * gridDim.z;
    unsigned sum, cnt, mine, sp = 0u;
    for (;;) {
        sum = 0u; cnt = 0u; mine = 0u;
#pragma unroll
        for (unsigned j = 0; j < 16; ++j) { const unsigned c = xb_ld(&bar[XB_XCNT(j)]); sum += c; cnt += (c > 0u) ? 1u : 0u; mine = (j == x) ? c : mine; }
        if (sum == G) break;
        __builtin_amdgcn_s_sleep(1);
        if ((++sp & 255u) == 0u) { if (xb_ld(&bar[XB_TMO])) break; if (sp > XB_SPIN_CAP) { atomicAdd(&bar[XB_TMO], 1u); break; } }
    }
    nloc = mine > 0u ? mine : 1u; nx = cnt > 0u ? cnt : 1u;
}
__device__ __forceinline__ void xcd_barrier(const XcdBarrier& b) {
    asm volatile("s_waitcnt vmcnt(0)" ::: "memory");
    __syncthreads();
    if (threadIdx.x == 0) {
        unsigned* bar = b.bar;
        __builtin_amdgcn_s_waitcnt(0);
        unsigned nloc = b.st[0], nx = b.st[1];
        if (nloc == 0u) { xcd_barrier_complete(bar, b.x, nloc, nx); b.st[0] = nloc; b.st[1] = nx; }
        const unsigned old = xb_add(&bar[XB_XSUB(b.x)], 1u);
        const unsigned gen = old / nloc;
        if (old + 1u == (gen + 1u) * nloc) {
            __builtin_amdgcn_fence(__ATOMIC_RELEASE, "agent");
            asm volatile("s_waitcnt vmcnt(0)" ::: "memory");
            const unsigned og = xb_add(&bar[XB_TOP], 1u);
            const unsigned tg = og / nx;
            if (og + 1u == (tg + 1u) * nx) xb_add(&bar[XB_TOPGEN], 1u);
            else XB_SPIN(xb_ld(&bar[XB_TOPGEN]) == tg, bar);
            __builtin_amdgcn_fence(__ATOMIC_ACQUIRE, "agent");
            xb_add(&bar[XB_XGEN(b.x)], 1u);
            asm volatile("s_waitcnt vmcnt(0)" ::: "memory");
        } else {
            XB_SPIN(xb_ld(&bar[XB_XGEN(b.x)]) == gen, bar);
            __builtin_amdgcn_fence(__ATOMIC_ACQUIRE, "agent");
            asm volatile("s_waitcnt vmcnt(0)" ::: "memory");
        }
    }
    __syncthreads();
}

namespace g8 {
constexpr int BM = 256, BK = 64, HALF = 128, HTB = HALF * BK * 2, NXCD = 8, WGM = 8;
__host__ __device__ __forceinline__ int lds_byte(int r, int c) { const int st = (r >> 4) * 2 + (c >> 5), rr = r & 15, cc = c & 31, ob = rr * 64 + cc * 2; return st * 1024 + (ob ^ (((ob >> 9) & 1) << 5)); }
__host__ __device__ __forceinline__ void stage_rc(int b, int& R, int& C) { const int st = b / 1024, sb = b % 1024, swz = sb ^ (((sb >> 9) & 1) << 5); R = (st >> 1) * 16 + swz / 64; C = (st & 1) * 32 + (swz % 64) / 2; }
__host__ __device__ __forceinline__ int perm32(int rho) { const int n = rho >> 4, i = rho & 15; return 8 * (i >> 2) + 4 * n + (i & 3); }

struct GUnit { const char* A; const char* B; int pm, pn, e, r0; };

struct DenseOrder {
    const char* Abase; const char* Bbase; int nM, nN, nwg, G, c; size_t tstep;
    __device__ void init(const void* A, const void* Bt, int M, int N, int K, int G_, int c_) { Abase = (const char*)A; Bbase = (const char*)Bt; nM = M / BM; nN = N / BM; nwg = nM * nN; G = G_; c = c_; tstep = (size_t)BM * K * 2; }
    __device__ bool next(int i, GUnit& u) const {
        const long L = (long)i * G + c; if (L >= nwg) return false;
        int wgid = (int)L; { const int q = nwg / NXCD, r = nwg % NXCD, xcd = wgid % NXCD, off = wgid / NXCD; wgid = (xcd < r ? xcd * (q + 1) : r * (q + 1) + (xcd - r) * q) + off; }
        const int nig = WGM * nN, gid = wgid / nig, fm = gid * WGM, gsz = (nM - fm) < WGM ? (nM - fm) : WGM;
        u.pm = fm + ((wgid % nig) % gsz); u.pn = (wgid % nig) / gsz; u.e = 0; u.r0 = 0;
        u.A = Abase + (size_t)u.pm * tstep; u.B = Bbase + (size_t)u.pn * tstep; return true;
    }
    __device__ __forceinline__ unsigned rowoff(const GUnit&, int) const { return 0u; }
    __device__ __forceinline__ void a_ready(const GUnit&) const {}
    __device__ __forceinline__ void done(const GUnit&) const {}
};
struct MoeOrder {
    const char* Abase; const char* Bbase; const int* list; const volatile LAS unsigned* tb; const volatile LAS unsigned* cntl; int nwg, G, c; size_t atile, bexp, btile; int gather;
    unsigned* tdone; int mode;
    __device__ bool next(int i, GUnit& u) const {
        const long L = (long)i * G + c; if (L >= nwg) return false;
        int wgid = (int)L; { const int q = nwg / NXCD, r = nwg % NXCD, xcd = wgid % NXCD, off = wgid / NXCD; wgid = (xcd < r ? xcd * (q + 1) : r * (q + 1) + (xcd - r) * q) + off; }
        const int tile = wgid >> 2; u.pn = wgid & 3; u.pm = tile;
        int e = 0; for (int j = 1; j < NE; ++j) e = ((int)tb[j] <= tile) ? j : e;
        e = __builtin_amdgcn_readfirstlane(e); u.e = e; u.r0 = __builtin_amdgcn_readfirstlane((tile - (int)tb[e]) * 256);
        u.A = gather ? Abase : Abase + (size_t)tile * atile; u.B = Bbase + (size_t)e * bexp + (size_t)u.pn * btile; return true;
    }
    __device__ __forceinline__ unsigned rowoff(const GUnit& u, int rr) const {
        const int p = u.r0 + rr; const int tok = (p < (int)cntl[u.e]) ? (list[(size_t)u.e * T + p] >> 1) : 0; return (unsigned)tok * 2048u; }
    __device__ __forceinline__ void done(const GUnit& u) const {
        if (mode == 1) { asm volatile("s_waitcnt vmcnt(0)" ::: "memory"); if ((threadIdx.x & 63) == 0) __hip_atomic_fetch_add(tdone + u.pm, 1u, __ATOMIC_RELAXED, __HIP_MEMORY_SCOPE_AGENT); } }
    __device__ __forceinline__ void a_ready(const GUnit& u) const {
        if (mode == 2) {
            if (threadIdx.x < 64) { unsigned sp = 0;
                while ((unsigned)__builtin_amdgcn_readfirstlane(__hip_atomic_load(tdone + u.pm, __ATOMIC_RELAXED, __HIP_MEMORY_SCOPE_AGENT)) < 32u) { __builtin_amdgcn_s_sleep(2); if (++sp > (1u << 22)) break; }
                __builtin_amdgcn_fence(__ATOMIC_ACQUIRE, "agent"); asm volatile("s_waitcnt vmcnt(0)" ::: "memory"); }
            asm volatile("" ::: "memory"); __builtin_amdgcn_s_barrier(); asm volatile("" ::: "memory"); } }
};

template <class Epi, class Sched, bool ALIGN_EPI, bool GATHER>
__device__ __forceinline__ void gemm_phase(LAS unsigned char* lds, const int K, const Sched& S, const Epi& E) {
    const int tid = threadIdx.x, wid = __builtin_amdgcn_readfirstlane(tid >> 6), lane = tid & 63, wr = wid >> 2, wc = wid & 3, fr = lane & 15, fq = lane >> 4;
    const int nt = K / BK;
    unsigned voffA[2], voffB[2]; int RA[2], CA[2];
#pragma unroll
    for (int i = 0; i < 2; ++i) { int R, C; stage_rc(tid * 16 + i * 8192, R, C); const int Rb = Epi::PERM ? ((R & ~31) + perm32(R & 31)) : R;
        voffA[i] = (unsigned)(R * K + C) * 2u; voffB[i] = (unsigned)(Rb * K + C) * 2u; RA[i] = R; CA[i] = C; }
    const size_t kstep = (size_t)(BK * 2);
    const size_t hstep = (size_t)HALF * K * 2;
    const unsigned ldsw = (unsigned)wid * 1024u;
    const int aoff = lds_byte(wr * 64 + fr, fq * 8), boff = lds_byte(wc * 32 + fr, fq * 8);
#define G8_SA(b, h) (((b) * 2 + (h)) * HTB)
#define G8_SB(b, h) ((4 + (b) * 2 + (h)) * HTB)
#define G8_STAGE(bufoff, gbase, o0, o1) do { \
        __builtin_amdgcn_global_load_lds((const unsigned*)((const char*)(gbase) + (o0)), (LAS unsigned*)(lds + (bufoff) + ldsw), 16, 0, 0); \
        __builtin_amdgcn_global_load_lds((const unsigned*)((const char*)(gbase) + (o1)), (LAS unsigned*)(lds + (bufoff) + ldsw + 8192), 16, 0, 0); } while (0)
#define G8_STAGE_B(bufoff, gbase) G8_STAGE(bufoff, gbase, voffB[0], voffB[1])
#define G8_LDA(dst, b, h) do { _Pragma("unroll") for (int m = 0; m < 4; ++m) _Pragma("unroll") for (int k = 0; k < 2; ++k) dst[m][k] = *(const LAS bf16x8*)(lds + G8_SA(b, h) + aoff + m * 2048 + k * 1024); } while (0)
#define G8_LDB(dst, b, h) do { _Pragma("unroll") for (int n = 0; n < 2; ++n) _Pragma("unroll") for (int k = 0; k < 2; ++k) dst[n][k] = *(const LAS bf16x8*)(lds + G8_SB(b, h) + boff + n * 2048 + k * 1024); } while (0)
#define G8_MMA(ai, bj, At, Bt) do { __builtin_amdgcn_s_setprio(1); _Pragma("unroll") for (int m = 0; m < 4; ++m) _Pragma("unroll") for (int n = 0; n < 2; ++n) _Pragma("unroll") for (int k = 0; k < 2; ++k) \
        acc[ai][bj][m][n] = __builtin_amdgcn_mfma_f32_16x16x32_bf16(Bt[n][k], At[m][k], acc[ai][bj][m][n], 0, 0, 0); __builtin_amdgcn_s_setprio(0); } while (0)
#ifdef G8_DRAIN
#define G8_WAIT_V(n) asm volatile("s_waitcnt vmcnt(0)" ::: "memory")
#else
#define G8_WAIT_V(n) asm volatile("s_waitcnt vmcnt(" #n ")" ::: "memory")
#endif
#define G8_WAIT_L(n) asm volatile("s_waitcnt lgkmcnt(" #n ")" ::: "memory")
#define G8_BAR __builtin_amdgcn_s_barrier()
#define G8_SCHED __builtin_amdgcn_sched_barrier(0)
    GUnit cur, nxt; int ui = 0;
    if (!S.next(0, cur)) return;
    unsigned cao[2][2], nao[2][2];
#pragma unroll
    for (int h = 0; h < 2; ++h)
#pragma unroll
        for (int i = 0; i < 2; ++i) { cao[h][i] = GATHER ? S.rowoff(cur, h * HALF + RA[i]) + (unsigned)CA[i] * 2u : voffA[i] + (unsigned)(h * hstep); nao[h][i] = cao[h][i]; }
    f32x4 acc[2][2][4][2];
#pragma unroll
    for (int a = 0; a < 2; ++a)
#pragma unroll
        for (int b = 0; b < 2; ++b)
#pragma unroll
            for (int m = 0; m < 4; ++m)
#pragma unroll
                for (int n = 0; n < 2; ++n) acc[a][b][m][n] = (f32x4){0.f, 0.f, 0.f, 0.f};
    bf16x8 At[4][2], B0[2][2], B1[2][2];
    const char* cA = cur.A; const char* cB = cur.B;
    S.a_ready(cur);
    G8_STAGE_B(G8_SB(0, 0), cB); G8_STAGE_B(G8_SB(0, 1), cB + hstep); G8_STAGE(G8_SA(0, 0), cA, cao[0][0], cao[0][1]); G8_STAGE(G8_SA(0, 1), cA, cao[1][0], cao[1][1]);
    if (wr == 1) G8_BAR;
    G8_WAIT_V(2); G8_BAR;
    G8_STAGE_B(G8_SB(1, 0), cB + kstep); G8_STAGE(G8_SA(1, 0), cA + kstep, cao[0][0], cao[0][1]); G8_STAGE_B(G8_SB(1, 1), cB + hstep + kstep);
    G8_WAIT_V(6); G8_BAR;
    for (;;) {
        const bool has_next = S.next(ui + 1, nxt);
        if (GATHER && has_next) {
#pragma unroll
            for (int h = 0; h < 2; ++h)
#pragma unroll
                for (int i = 0; i < 2; ++i) nao[h][i] = S.rowoff(nxt, h * HALF + RA[i]) + (unsigned)CA[i] * 2u;
        }
        const char* nA = has_next ? nxt.A : cA; const char* nB = has_next ? nxt.B : cB;
        for (int t = 0; t < nt; t += 2) {
            const bool last = (t == nt - 2);
            if (last && has_next) S.a_ready(nxt);
            const char* a1 = cA + (size_t)(t + 1) * kstep;
            const char* a2 = last ? nA : cA + (size_t)(t + 2) * kstep; const char* b2 = last ? nB : cB + (size_t)(t + 2) * kstep;
            const char* a3 = a2 + kstep; const char* b3 = b2 + kstep;
            asm volatile("" : "+s"(a1), "+s"(a2), "+s"(b2), "+s"(a3), "+s"(b3));
            unsigned o2[2][2];
#pragma unroll
            for (int h = 0; h < 2; ++h)
#pragma unroll
                for (int i = 0; i < 2; ++i) o2[h][i] = (GATHER && last && has_next) ? nao[h][i] : cao[h][i];
            G8_LDB(B0, 0, 0); G8_LDB(B1, 0, 1); G8_SCHED; G8_LDA(At, 0, 0); G8_STAGE(G8_SA(1, 1), a1, cao[1][0], cao[1][1]);
            G8_WAIT_V(8); G8_WAIT_L(0); G8_BAR; G8_MMA(0, 0, At, B0); G8_MMA(0, 1, At, B1); G8_BAR; G8_SCHED;
            G8_LDA(At, 0, 1); G8_STAGE_B(G8_SB(0, 0), b2); G8_STAGE_B(G8_SB(0, 1), b2 + hstep); G8_STAGE(G8_SA(0, 0), a2, o2[0][0], o2[0][1]);
            G8_WAIT_V(8); G8_WAIT_L(0); G8_BAR; G8_MMA(1, 0, At, B0); G8_MMA(1, 1, At, B1); G8_BAR; G8_SCHED;
            G8_LDB(B0, 1, 0); G8_LDB(B1, 1, 1); G8_SCHED; G8_LDA(At, 1, 0); G8_STAGE(G8_SA(0, 1), a2, o2[1][0], o2[1][1]);
            G8_WAIT_V(8); G8_WAIT_L(0); G8_BAR; G8_MMA(0, 0, At, B0); G8_MMA(0, 1, At, B1); G8_BAR; G8_SCHED;
            G8_LDA(At, 1, 1); G8_STAGE_B(G8_SB(1, 0), b3); G8_STAGE_B(G8_SB(1, 1), b3 + hstep); G8_STAGE(G8_SA(1, 0), a3, o2[0][0], o2[0][1]);
            G8_WAIT_V(8); G8_WAIT_L(0); G8_BAR; G8_MMA(1, 0, At, B0); G8_MMA(1, 1, At, B1); G8_BAR; G8_SCHED;
        }
        if constexpr (ALIGN_EPI) { if (wr == 0) G8_BAR; }
        {
          GUnit eu = cur; int fr_ = fr, fq_ = fq; asm volatile("" : "+s"(eu.pm), "+s"(eu.pn), "+s"(eu.e), "+s"(eu.r0)); asm volatile("" : "+v"(fr_), "+v"(fq_));
          E(acc, eu, wr, wc, fr_, fq_); S.done(cur); }
        if (!has_next) break;
#pragma unroll
        for (int a = 0; a < 2; ++a)
#pragma unroll
            for (int b = 0; b < 2; ++b)
#pragma unroll
                for (int m = 0; m < 4; ++m)
#pragma unroll
                    for (int n = 0; n < 2; ++n) acc[a][b][m][n] = (f32x4){0.f, 0.f, 0.f, 0.f};
        cur = nxt; cA = nA; cB = nB; ++ui;
#pragma unroll
        for (int h = 0; h < 2; ++h)
#pragma unroll
            for (int i = 0; i < 2; ++i) cao[h][i] = nao[h][i];
        if constexpr (ALIGN_EPI) { if (wr == 1) G8_BAR; }
    }
    G8_WAIT_V(0);
    if constexpr (!ALIGN_EPI) { if (wr == 0) G8_BAR; }
    G8_BAR;
#undef G8_SA
#undef G8_SB
#undef G8_STAGE
#undef G8_STAGE_B
#undef G8_LDA
#undef G8_LDB
#undef G8_MMA
#undef G8_WAIT_V
#undef G8_WAIT_L
#undef G8_BAR
#undef G8_SCHED
}

__device__ __forceinline__ u32x4 pack8(const f32x4 v0, const f32x4 v1) { u32x4 w; w.x = cvt_pk_bf16(v0[0], v0[1]); w.y = cvt_pk_bf16(v0[2], v0[3]); w.z = cvt_pk_bf16(v1[0], v1[1]); w.w = cvt_pk_bf16(v1[2], v1[3]); return w; }
__device__ __forceinline__ float sigmoidf_(float v) { return __builtin_amdgcn_rcpf(1.f + __builtin_amdgcn_exp2f(-1.4426950408889634f * v)); }

struct EpiProj {
    static constexpr bool PERM = true;
    bf16_t *qb, *kb, *vb, *ub, *gb; const float* rope; const float* gate_bias;
    __device__ __forceinline__ void operator()(const f32x4 (&acc)[2][2][4][2], const GUnit& u, int wr, int wc, int fr, int fq) const {
        const int row0 = u.pm * BM + wr * 64 + fr; const int cw = wc * 32 + 8 * fq; const int pn = u.pn;
#ifdef DBG_PLAIN_EPI
        if (pn < 8) { bf16_t* base = (pn < 4 ? qb : kb) + (pn & 3) * 256 + cw;
            for (int ai = 0; ai < 2; ++ai) for (int m = 0; m < 4; ++m) { const int t = row0 + ai * HALF + m * 16; for (int bj = 0; bj < 2; ++bj) *(u32x4*)(base + (size_t)t * 1024 + bj * HALF) = pack8(acc[ai][bj][m][0], acc[ai][bj][m][1]); } }
        else
#endif
        if (pn < 8) {
            bf16_t* base = (pn < 4 ? qb : kb) + (pn & 3) * 256 + cw; const float sc = pn < 4 ? QSCALE : 1.f; const int fi = 16 * (wc & 1) + 4 * fq;
#pragma unroll
            for (int ai = 0; ai < 2; ++ai)
#pragma unroll
                for (int m = 0; m < 4; ++m) { const int t = row0 + ai * HALF + m * 16; const f32x4 cs0 = *(const f32x4*)(rope + ((size_t)t * 32 + fi) * 2), cs1 = *(const f32x4*)(rope + ((size_t)t * 32 + fi) * 2 + 4);
                    const f32x4 c = {cs0[0], cs0[2], cs1[0], cs1[2]}, s = {cs0[1], cs0[3], cs1[1], cs1[3]};
#pragma unroll
                    for (int bj = 0; bj < 2; ++bj) { const f32x4 t1 = acc[ai][bj][m][0], t2 = acc[ai][bj][m][1]; const f32x4 o1 = (t1 * c - t2 * s) * sc, o2 = (t2 * c + t1 * s) * sc;
                        *(u32x4*)(base + (size_t)t * 1024 + bj * HALF) = pack8(o1, o2); } }
        } else if (pn < 14) {
            bf16_t* base; int ld; if (pn < 12) { base = vb + (pn - 8) * 256 + cw; ld = 1024; } else { base = ub + (pn - 12) * 256 + cw; ld = 512; }
#pragma unroll
            for (int ai = 0; ai < 2; ++ai)
#pragma unroll
                for (int m = 0; m < 4; ++m) { const int t = row0 + ai * HALF + m * 16;
#pragma unroll
                    for (int bj = 0; bj < 2; ++bj) *(u32x4*)(base + (size_t)t * ld + bj * HALF) = pack8(acc[ai][bj][m][0], acc[ai][bj][m][1]); }
        }
#ifdef DBG_PLAIN_EPI
        else { const int col0 = (pn - 14) * 256 + cw;
            for (int ai = 0; ai < 2; ++ai) for (int m = 0; m < 4; ++m) { const int t = row0 + ai * HALF + m * 16; for (int bj = 0; bj < 2; ++bj) *(u32x4*)(gb + (size_t)t * 2048 + col0 + bj * HALF) = pack8(acc[ai][bj][m][0], acc[ai][bj][m][1]); } }
#else
        else {
            const int col0 = (pn - 14) * 256 + cw; f32x4 bv[2][2];
#pragma unroll
            for (int bj = 0; bj < 2; ++bj)
#pragma unroll
                for (int n = 0; n < 2; ++n) bv[bj][n] = *(const f32x4*)(gate_bias + col0 + bj * HALF + 4 * n);
#pragma unroll
            for (int ai = 0; ai < 2; ++ai)
#pragma unroll
                for (int m = 0; m < 4; ++m) { const int t = row0 + ai * HALF + m * 16;
#pragma unroll
                    for (int bj = 0; bj < 2; ++bj) { f32x4 v0 = acc[ai][bj][m][0] + bv[bj][0], v1 = acc[ai][bj][m][1] + bv[bj][1];
#pragma unroll
                        for (int j = 0; j < 4; ++j) { v0[j] = sigmoidf_(v0[j]); v1[j] = sigmoidf_(v1[j]); }
                        *(u32x4*)(gb + (size_t)t * 2048 + col0 + bj * HALF) = pack8(v0, v1); } }
        }
#endif
    }
};
struct EpiScaleBf16 {
    static constexpr bool PERM = true;
    bf16_t* O; int ldc; const float* colscale;
    __device__ __forceinline__ void operator()(const f32x4 (&acc)[2][2][4][2], const GUnit& u, int wr, int wc, int fr, int fq) const {
        const int row0 = u.pm * BM + wr * 64 + fr, col0 = u.pn * BM + wc * 32 + 8 * fq; f32x4 sv[2][2];
#pragma unroll
        for (int bj = 0; bj < 2; ++bj)
#pragma unroll
            for (int n = 0; n < 2; ++n) sv[bj][n] = *(const f32x4*)(colscale + col0 + bj * HALF + 4 * n);
#pragma unroll
        for (int ai = 0; ai < 2; ++ai)
#pragma unroll
            for (int m = 0; m < 4; ++m) { bf16_t* rowp = O + (size_t)(row0 + ai * HALF + m * 16) * ldc + col0;
#pragma unroll
                for (int bj = 0; bj < 2; ++bj) *(u32x4*)(rowp + bj * HALF) = pack8(acc[ai][bj][m][0] * sv[bj][0], acc[ai][bj][m][1] * sv[bj][1]); }
    }
};
template <int BR> struct EpiMerge {
    static constexpr bool PERM = true;
    const bf16_t* gates; bf16_t* merged; bf16_t* dst;
    __device__ __forceinline__ void operator()(const f32x4 (&acc)[2][2][4][2], const GUnit& u, int wr, int wc, int fr, int fq) const {
        const int row0 = u.pm * BM + wr * 64 + fr, col0 = u.pn * BM + wc * 32 + 8 * fq;
#pragma unroll
        for (int ai = 0; ai < 2; ++ai)
#pragma unroll
            for (int m = 0; m < 4; ++m) { const size_t t = row0 + ai * HALF + m * 16;
#pragma unroll
                for (int bj = 0; bj < 2; ++bj) { const u32x4 g = *(const u32x4*)(gates + t * 2048 + BR * 1024 + col0 + bj * HALF); bf16_t* mp = merged + t * 1024 + col0 + bj * HALF;
                    f32x4 v0 = acc[ai][bj][m][0], v1 = acc[ai][bj][m][1];
                    v0 = v0 * (f32x4){bflo(g.x), bfhi(g.x), bflo(g.y), bfhi(g.y)}; v1 = v1 * (f32x4){bflo(g.z), bfhi(g.z), bflo(g.w), bfhi(g.w)};
                    if (BR) { const u32x4 p = *(const u32x4*)mp; v0 = v0 + (f32x4){bflo(p.x), bfhi(p.x), bflo(p.y), bfhi(p.y)}; v1 = v1 + (f32x4){bflo(p.z), bfhi(p.z), bflo(p.w), bfhi(p.w)}; }
                    *(u32x4*)(dst + t * 1024 + col0 + bj * HALF) = pack8(v0, v1); } }
    }
};
struct EpiResid {
    static constexpr bool PERM = false;
    const float* x; float* y; float2* part;
    __device__ __forceinline__ void operator()(const f32x4 (&acc)[2][2][4][2], const GUnit& u, int wr, int wc, int fr, int fq) const {
        const int row0 = u.pm * BM + wr * 64 + fr, col0 = u.pn * BM + wc * 32 + 4 * fq;
#pragma unroll
        for (int ai = 0; ai < 2; ++ai)
#pragma unroll
            for (int m = 0; m < 4; ++m) { const size_t row = (size_t)(row0 + ai * HALF + m * 16); const size_t off = row * 1024 + col0; float s1 = 0.f, s2 = 0.f;
#pragma unroll
                for (int bj = 0; bj < 2; ++bj)
#pragma unroll
                    for (int n = 0; n < 2; ++n) { const f32x4 xv = *(const f32x4*)(x + off + bj * HALF + n * 16); const f32x4 yv = xv * ALPHA + acc[ai][bj][m][n]; *(f32x4*)(y + off + bj * HALF + n * 16) = yv;
                        s1 += (yv[0] + yv[1]) + (yv[2] + yv[3]); s2 += (yv[0] * yv[0] + yv[1] * yv[1]) + (yv[2] * yv[2] + yv[3] * yv[3]); }
                s1 += __shfl_xor(s1, 16); s1 += __shfl_xor(s1, 32); s2 += __shfl_xor(s2, 16); s2 += __shfl_xor(s2, 32);
                if (fq == 0) part[row * 16 + u.pn * 4 + wc] = make_float2(s1, s2); }
    }
};
struct EpiGateUp {
    static constexpr bool PERM = true;
    bf16_t* h;
    __device__ __forceinline__ void operator()(const f32x4 (&acc)[2][2][4][2], const GUnit& u, int wr, int wc, int fr, int fq) const {
        const int row0 = u.pm * BM + wr * 64 + fr, col0 = u.pn * 128 + wc * 16 + 4 * fq;
#pragma unroll
        for (int ai = 0; ai < 2; ++ai)
#pragma unroll
            for (int m = 0; m < 4; ++m) { bf16_t* rowp = h + (size_t)(row0 + ai * HALF + m * 16) * 512 + col0;
#pragma unroll
                for (int bj = 0; bj < 2; ++bj) { const f32x4 g = acc[ai][bj][m][0], up = acc[ai][bj][m][1]; f32x4 o;
#pragma unroll
                    for (int j = 0; j < 4; ++j) o[j] = g[j] * sigmoidf_(g[j]) * up[j];
                    const unsigned long long w = (unsigned long long)cvt_pk_bf16(o[0], o[1]) | ((unsigned long long)cvt_pk_bf16(o[2], o[3]) << 32);
                    __hip_atomic_store((unsigned long long*)(rowp + bj * 64), w, __ATOMIC_RELAXED, __HIP_MEMORY_SCOPE_AGENT); } }
    }
};
struct EpiDown {
    static constexpr bool PERM = true;
    bf16_t* ybuf; const int* list; const float* rw; const volatile LAS unsigned* cntl;
    __device__ __forceinline__ void operator()(const f32x4 (&acc)[2][2][4][2], const GUnit& u, int wr, int wc, int fr, int fq) const {
        const int p0 = u.r0 + wr * 64 + fr, col0 = u.pn * BM + wc * 32 + 8 * fq; const int cn = (int)cntl[u.e];
#pragma unroll
        for (int ai = 0; ai < 2; ++ai)
#pragma unroll
            for (int m = 0; m < 4; ++m) { const int p = p0 + ai * HALF + m * 16;
                if (p < cn) { const int ent = list[(size_t)u.e * T + p]; const float w = rw[ent]; bf16_t* rowp = ybuf + (size_t)ent * 1024 + col0;
#pragma unroll
                    for (int bj = 0; bj < 2; ++bj) *(u32x4*)(rowp + bj * HALF) = pack8(acc[ai][bj][m][0] * w, acc[ai][bj][m][1] * w); } }
    }
};
}

namespace at2 {
using f32x16 = __attribute__((ext_vector_type(16))) float;
using s16x4  = __attribute__((ext_vector_type(4))) short;
constexpr int KB_BYTES = 8192, VB_BYTES = 16384, KSLOT = 2 * KB_BYTES, NKS = 4, NVS = 3, OFF_V = NKS * KSLOT;
constexpr int OFF_Q = OFF_V + NVS * VB_BYTES, OFF_WS = 151552;
#define AT_SBAR() __builtin_amdgcn_sched_barrier(0)
__device__ __forceinline__ int crow(int r, int hi) { return (r & 3) + 8 * (r >> 2) + 4 * hi; }
__device__ __forceinline__ int v_st(int k, int c) { const int kk = (k & ~0xC) | ((k & 4) << 1) | ((k & 8) >> 1); return ((kk >> 3) * 4 + (c >> 5)) * 512 + ((kk & 7) * 32 + (c & 31)) * 2; }
__device__ __forceinline__ int v_rd_base(int lane) { return ((lane & 3) << 3) | (((lane >> 2) & 3) << 6) | (((lane >> 4) & 1) << 5) | (((lane >> 5) & 1) << 8); }
constexpr int v_rd_off(int d0, int ks, int half) { return d0 * 512 + ks * 4096 + half * 2048; }
template <int OFF> __device__ __forceinline__ s16x4 tr_read(int vb) { s16x4 r; asm volatile("ds_read_b64_tr_b16 %0, %1 offset:%2" : "=&v"(r) : "v"(vb), "i"(OFF) : "memory"); return r; }
template <int D0> __device__ __forceinline__ void pv_one(f32x16& od, int vb, bf16x8 pa0, bf16x8 pa1, bf16x8 pa2, bf16x8 pa3) {
    const s16x4 l0 = tr_read<v_rd_off(D0, 0, 0)>(vb), h0 = tr_read<v_rd_off(D0, 0, 1)>(vb), l1 = tr_read<v_rd_off(D0, 1, 0)>(vb), h1 = tr_read<v_rd_off(D0, 1, 1)>(vb);
    const s16x4 l2 = tr_read<v_rd_off(D0, 2, 0)>(vb), h2 = tr_read<v_rd_off(D0, 2, 1)>(vb), l3 = tr_read<v_rd_off(D0, 3, 0)>(vb), h3 = tr_read<v_rd_off(D0, 3, 1)>(vb);
    asm volatile("s_waitcnt lgkmcnt(0)" ::: "memory"); AT_SBAR();
#define AT_PK(L, H) (bf16x8){L[0], L[1], L[2], L[3], H[0], H[1], H[2], H[3]}
    od = __builtin_amdgcn_mfma_f32_32x32x16_bf16(pa0, AT_PK(l0, h0), od, 0, 0, 0);
    od = __builtin_amdgcn_mfma_f32_32x32x16_bf16(pa1, AT_PK(l1, h1), od, 0, 0, 0);
    od = __builtin_amdgcn_mfma_f32_32x32x16_bf16(pa2, AT_PK(l2, h2), od, 0, 0, 0);
    od = __builtin_amdgcn_mfma_f32_32x32x16_bf16(pa3, AT_PK(l3, h3), od, 0, 0, 0);
#undef AT_PK
}
__device__ __forceinline__ void qkt(f32x16& p0, f32x16& p1, const LAS unsigned char* Ks, const bf16x8* qr, int r32, int hi) {
    p0 = f32x16{}; p1 = f32x16{};
#pragma unroll
    for (int d0 = 0; d0 < 4; ++d0) { const LAS unsigned char* kp = Ks + (2 * d0 + hi) * 1024 + r32 * 16;
        const bf16x8 b0 = *(const LAS bf16x8*)(kp), b1 = *(const LAS bf16x8*)(kp + 512);
        p0 = __builtin_amdgcn_mfma_f32_32x32x16_bf16(b0, qr[d0], p0, 0, 0, 0);
        p1 = __builtin_amdgcn_mfma_f32_32x32x16_bf16(b1, qr[d0], p1, 0, 0, 0); }
}
__device__ __forceinline__ float hswap_max(float v) { auto rr = __builtin_amdgcn_permlane32_swap(__float_as_uint(v), __float_as_uint(v), false, false); return fmaxf(__uint_as_float(rr[0]), __uint_as_float(rr[1])); }
__device__ __forceinline__ float hswap_sum(float v) { auto rr = __builtin_amdgcn_permlane32_swap(__float_as_uint(v), __float_as_uint(v), false, false); return __uint_as_float(rr[0]) + __uint_as_float(rr[1]); }

struct AtUnit { int b, head, qblk; };
struct AtAddr { const char* Kb; const char* Vb; unsigned kofs0, kofs1, vofs0, vofs1; };
__device__ __forceinline__ void at_addr(AtAddr& a, const AtUnit& un, int wid, int lane, const bf16_t* __restrict__ K, const bf16_t* __restrict__ V) {
    const int mp = wid >> 2, wq = wid & 3, hm = un.head * 2 + mp; const size_t rowbase = (size_t)un.b * SEQ;
    a.Kb = (const char*)(K + rowbase * 1024); a.Vb = (const char*)(V + rowbase * 1024);
    unsigned ko[2], vo[2];
#pragma unroll
    for (int i = 0; i < 2; ++i) { const int ch = 2 * wq + i; ko[i] = (unsigned)(lane * 2048 + hm * 128 + ch * 16);
        const int p = 2 * wid + i; const int kk = (p >> 1) * 8 + ((lane & 31) >> 2); const int k = (kk & ~0xC) | ((kk & 4) << 1) | ((kk & 8) >> 1); const int c = (2 * (p & 1) + (lane >> 5)) * 32 + (lane & 3) * 8;
        vo[i] = (unsigned)(k * 2048 + un.head * 256 + c * 2); }
    a.kofs0 = ko[0]; a.kofs1 = ko[1]; a.vofs0 = vo[0]; a.vofs1 = vo[1];
}
#define AT_DMA_K(AD, j, KO) do { const char* kj_ = (AD).Kb + (size_t)(j) * 131072; \
        __builtin_amdgcn_global_load_lds((const unsigned*)(kj_ + (AD).kofs0), (LAS unsigned*)(lds + (KO) + kdst), 16, 0, 0); __builtin_amdgcn_global_load_lds((const unsigned*)(kj_ + (AD).kofs1), (LAS unsigned*)(lds + (KO) + kdst + 1024), 16, 0, 0); } while (0)
#define AT_DMA_V(AD, j, VO) do { const char* vj_ = (AD).Vb + (size_t)(j) * 131072; \
        __builtin_amdgcn_global_load_lds((const unsigned*)(vj_ + (AD).vofs0), (LAS unsigned*)(lds + (VO) + vdst), 16, 0, 0); __builtin_amdgcn_global_load_lds((const unsigned*)(vj_ + (AD).vofs1), (LAS unsigned*)(lds + (VO) + vdst + 1024), 16, 0, 0); } while (0)
__device__ __forceinline__ void at_prefetch(LAS unsigned char* lds, const AtUnit& un, const bf16_t* __restrict__ Q, const bf16_t* __restrict__ K, const bf16_t* __restrict__ V, bf16x8 (&qr)[4]) {
    const int tid = threadIdx.x, lane = tid & 63, r32 = lane & 31, hi = lane >> 5; const int wid = __builtin_amdgcn_readfirstlane(tid >> 6); const int mp = wid >> 2, wq = wid & 3;
    AtAddr ad; at_addr(ad, un, wid, lane, K, V);
    const unsigned kdst = (unsigned)(mp * KB_BYTES + (2 * wq) * 1024), vdst = (unsigned)(OFF_V + (2 * wid) * 1024);
    AT_DMA_K(ad, 0, 0); AT_DMA_V(ad, 0, 0); AT_DMA_K(ad, 1, KSLOT);
    const bf16_t* qp = Q + ((size_t)un.b * SEQ + un.qblk * 128 + wq * 32 + r32) * 1024 + (un.head * 2 + mp) * 64 + hi * 8;
#pragma unroll
    for (int d0 = 0; d0 < 4; ++d0) qr[d0] = *(const bf16x8*)(qp + d0 * 16);
    asm volatile("" ::: "memory"); AT_SBAR();
}
template <unsigned var> __device__ __forceinline__ void attn_unit(LAS unsigned char* lds, const AtUnit cu, const AtUnit nu, const bool has_next, const bool first, const bf16_t* __restrict__ Q, const bf16_t* __restrict__ K, const bf16_t* __restrict__ V,
                                          bf16_t* __restrict__ O, const float lam, const float* __restrict__ gain, bf16x8 (&qr)[4]) {
    const int tid = threadIdx.x, lane = tid & 63, r32 = lane & 31, hi = lane >> 5; const int wid = __builtin_amdgcn_readfirstlane(tid >> 6); const int mp = wid >> 2, wq = wid & 3;
    const int head = cu.head, qblk = cu.qblk; const size_t rowbase = (size_t)cu.b * SEQ; const int q0 = qblk * 128;
    const int mychunk = 2 * qblk + (wq >> 1); const int NT = 2 * qblk + 2;
    LAS float* wsf = (LAS float*)(lds + OFF_WS) + wid * 64;
    AtAddr ad; at_addr(ad, cu, wid, lane, K, V);
    const unsigned kdst = (unsigned)(mp * KB_BYTES + (2 * wq) * 1024), vdst = (unsigned)(OFF_V + (2 * wid) * 1024);
    float mhat = 0.f, l_reg = 0.f; f32x16 o[4] = {};
    const int vb0 = (int)(uintptr_t)(lds + OFF_V) + v_rd_base(lane);
    const LAS unsigned char* kb0 = lds + mp * KB_BYTES;
    constexpr float THR = 8.f;
    f32x16 pA0 = {}, pA1 = {}, pB0 = {}, pB1 = {}; float alA = 1.f, alB = 1.f; bool rsA = false, rsB = false;
    int kcur = 0, k1 = KSLOT, k2 = 2 * KSLOT;
    int vprev = 2 * VB_BYTES, vcur = 0, vnext = VB_BYTES;
#define AT_ROT() do { kcur = k1; k1 = k2; k2 = (k2 == (NKS - 1) * KSLOT) ? 0 : k2 + KSLOT; vprev = vcur; vcur = vnext; vnext = (vnext == (NVS - 1) * VB_BYTES) ? 0 : vnext + VB_BYTES; } while (0)
#define AT_QKT(P0, P1, SL) do { const LAS unsigned char* kp_ = kb0 + (SL) + hi * 1024 + r32 * 16; P0 = f32x16{}; P1 = f32x16{}; \
        _Pragma("unroll") for (int d0 = 0; d0 < 4; ++d0) { const bf16x8 b0_ = *(const LAS bf16x8*)(kp_ + d0 * 2048), b1_ = *(const LAS bf16x8*)(kp_ + d0 * 2048 + 512); const bf16x8 q_ = qr[d0]; \
            P0 = __builtin_amdgcn_mfma_f32_32x32x16_bf16(b0_, q_, P0, 0, 0, 0); P1 = __builtin_amdgcn_mfma_f32_32x32x16_bf16(b1_, q_, P1, 0, 0, 0); } } while (0)
#define AT_PSM(P0, P1, AL, RS, FIRST) do { float pm_ = P0[0]; _Pragma("unroll") for (int r = 1; r < 16; ++r) pm_ = fmaxf(pm_, P0[r]); _Pragma("unroll") for (int r = 0; r < 16; ++r) pm_ = fmaxf(pm_, P1[r]); \
        pm_ = hswap_max(pm_) - mhat; RS = (FIRST) || __any(pm_ > THR); AL = 1.f; \
        if (RS) { const float dl_ = (FIRST) ? pm_ : fmaxf(pm_, 0.f); mhat += dl_; AL = __builtin_amdgcn_exp2f(-dl_); } \
        _Pragma("unroll") for (int r = 0; r < 16; ++r) { P0[r] = __builtin_amdgcn_exp2f(P0[r] - mhat); P1[r] = __builtin_amdgcn_exp2f(P1[r] - mhat); } } while (0)
#define AT_PK4(P, BASE, OUT) do { const unsigned a0 = cvt_pk_bf16(P[BASE + 0], P[BASE + 1]), a1 = cvt_pk_bf16(P[BASE + 2], P[BASE + 3]); \
        const unsigned b0 = cvt_pk_bf16(P[BASE + 4], P[BASE + 5]), b1 = cvt_pk_bf16(P[BASE + 6], P[BASE + 7]); \
        auto r0_ = __builtin_amdgcn_permlane32_swap(a0, b0, false, false); auto r1_ = __builtin_amdgcn_permlane32_swap(a1, b1, false, false); \
        u32x4 w_ = {r0_[0], r1_[0], r0_[1], r1_[1]}; OUT = __builtin_bit_cast(bf16x8, w_); } while (0)
#define AT_FIN_PV(P0, P1, AL, SL) do { float ps_ = 0.f; _Pragma("unroll") for (int r = 0; r < 16; ++r) ps_ += P0[r]; _Pragma("unroll") for (int r = 0; r < 16; ++r) ps_ += P1[r]; \
        ps_ = hswap_sum(ps_); l_reg = l_reg * (AL) + ps_; bf16x8 pa0, pa1, pa2, pa3; AT_PK4(P0, 0, pa0); AT_PK4(P0, 8, pa1); AT_PK4(P1, 0, pa2); AT_PK4(P1, 8, pa3); const int vb_ = vb0 + (SL); \
        pv_one<0>(o[0], vb_, pa0, pa1, pa2, pa3); pv_one<1>(o[1], vb_, pa0, pa1, pa2, pa3); pv_one<2>(o[2], vb_, pa0, pa1, pa2, pa3); pv_one<3>(o[3], vb_, pa0, pa1, pa2, pa3); } while (0)
#define AT_RESC(AL, RS) do { if (RS) { if (hi == 0) wsf[r32] = (AL); asm volatile("s_waitcnt lgkmcnt(0)" ::: "memory"); \
        _Pragma("unroll") for (int r = 0; r < 16; ++r) { const float a_ = wsf[crow(r, hi)]; _Pragma("unroll") for (int d = 0; d < 4; ++d) o[d][r] *= a_; } } } while (0)
#define AT_STEP0(u, PC0, PC1, ALC, RSC, PP0, PP1, ALP) do { const bool nk_ = (u) + 2 < NT && !(var & 2u), nv_ = (u) + 1 < NT && !(var & 2u); if (nk_) AT_DMA_K(ad, (u) + 2, k2); if (nv_) AT_DMA_V(ad, (u) + 1, vnext); \
        const bool aX_ = (u) < NT && (u) <= mychunk, aF_ = (u) >= 1 && (u) - 1 <= mychunk; \
        if (aX_ && !(var & 16u)) AT_QKT(PC0, PC1, kcur); \
        if (aF_ && !(var & 4u)) AT_FIN_PV(PP0, PP1, ALP, vprev); \
        if (aX_ && !(var & 8u)) { AT_PSM(PC0, PC1, ALC, RSC, (u) == 0); AT_RESC(ALC, RSC); } \
        if (nk_) asm volatile("s_waitcnt vmcnt(4)" ::: "memory"); else if (nv_) asm volatile("s_waitcnt vmcnt(2)" ::: "memory"); else asm volatile("s_waitcnt vmcnt(0)" ::: "memory"); \
        __syncthreads(); AT_ROT(); } while (0)
    if (first || mp == 1) asm volatile("s_waitcnt vmcnt(0)" ::: "memory"); else asm volatile("s_waitcnt vmcnt(8)" ::: "memory");
    __syncthreads();
    for (int u = 0; u < NT; u += 2) { AT_STEP0(u, pA0, pA1, alA, rsA, pB0, pB1, alB); AT_STEP0(u + 1, pB0, pB1, alB, rsB, pA0, pA1, alA); }
    { const int u = NT; AT_STEP0(u, pA0, pA1, alA, rsA, pB0, pB1, alB); }
#undef AT_ROT
#undef AT_QKT
#undef AT_PSM
#undef AT_PK4
#undef AT_FIN_PV
#undef AT_RESC
#undef AT_STEP0
    if (has_next) at_prefetch(lds, nu, Q, K, V, qr);
    if (hi == 0) wsf[r32] = 1.f / l_reg;
    asm volatile("s_waitcnt lgkmcnt(0)" ::: "memory");
    float rli[16];
#pragma unroll
    for (int r = 0; r < 16; ++r) rli[r] = wsf[crow(r, hi)];
    LAS float* xch = (LAS float*)(lds + (wq < 2 ? 32768 + wq * 16384 : 81920 + (wq - 2) * 16384));
    if (mp == 1) {
#pragma unroll
        for (int d = 0; d < 4; ++d)
#pragma unroll
            for (int r4 = 0; r4 < 4; ++r4) *(LAS f32x4*)(xch + ((d * 4 + r4) * 64 + lane) * 4) = (f32x4){o[d][4 * r4] * rli[4 * r4], o[d][4 * r4 + 1] * rli[4 * r4 + 1], o[d][4 * r4 + 2] * rli[4 * r4 + 2], o[d][4 * r4 + 3] * rli[4 * r4 + 3]};
    }
    __syncthreads();
    if (mp == 0) {
#pragma unroll
        for (int d = 0; d < 4; ++d)
#pragma unroll
            for (int r4 = 0; r4 < 4; ++r4) { const f32x4 v2 = *(const LAS f32x4*)(xch + ((d * 4 + r4) * 64 + lane) * 4);
#pragma unroll
                for (int e = 0; e < 4; ++e) o[d][4 * r4 + e] = o[d][4 * r4 + e] * rli[4 * r4 + e] - lam * v2[e]; }
    }
    __syncthreads();
    LAS float* stg = (LAS float*)(lds + (wq == 0 ? 32768 : 81920 + (wq - 1) * 16896));
    if (mp == 0) {
#pragma unroll
        for (int d = 0; d < 4; ++d)
#pragma unroll
            for (int r = 0; r < 16; ++r) stg[crow(r, hi) * 132 + d * 32 + r32] = o[d][r];
        asm volatile("s_waitcnt lgkmcnt(0)" ::: "memory");
        const int row = lane >> 1, ch = (lane & 1) * 64; const LAS float* sp = stg + row * 132 + ch; float vv[64]; float ss = 0.f;
#pragma unroll
        for (int i = 0; i < 16; ++i) { const f32x4 t4 = *(const LAS f32x4*)(sp + 4 * i); vv[4 * i] = t4[0]; vv[4 * i + 1] = t4[1]; vv[4 * i + 2] = t4[2]; vv[4 * i + 3] = t4[3]; ss += (t4[0] * t4[0] + t4[1] * t4[1]) + (t4[2] * t4[2] + t4[3] * t4[3]); }
        ss += __shfl_xor(ss, 1);
        const float rs = (1.0f / sqrtf(ss * (1.f / 128.f) + RMS_EPS)) * (1.f - LAMBDA_INIT);
        bf16_t* op = O + (rowbase + q0 + wq * 32 + row) * 1024 + head * 128 + ch; const float* gp = gain + ch;
#pragma unroll
        for (int i = 0; i < 8; ++i) { const f32x4 g0 = *(const f32x4*)(gp + 8 * i), g1 = *(const f32x4*)(gp + 8 * i + 4); u32x4 w;
            w.x = cvt_pk_bf16(vv[8 * i] * rs * g0[0], vv[8 * i + 1] * rs * g0[1]); w.y = cvt_pk_bf16(vv[8 * i + 2] * rs * g0[2], vv[8 * i + 3] * rs * g0[3]);
            w.z = cvt_pk_bf16(vv[8 * i + 4] * rs * g1[0], vv[8 * i + 5] * rs * g1[1]); w.w = cvt_pk_bf16(vv[8 * i + 6] * rs * g1[2], vv[8 * i + 7] * rs * g1[3]);
            *(u32x4*)(op + 8 * i) = w; }
    }
}
template <unsigned var> __device__ __forceinline__ void attn_phase(LAS unsigned char* lds, int vcu, int ncu, const bf16_t* Q, const bf16_t* K, const bf16_t* V, bf16_t* O, const float* scal, const float* gain) {
    const float lam = scal[0];
    const int hb = ncu >> 1; const int nun = (vcu >> 1) < NB * NHEAD ? ((NB * NHEAD - 1 - (vcu >> 1)) / hb + 1) * 8 : 0;
    auto unit_of = [&](int i) { if (ncu == 256) { const int bh = (vcu >> 5) * 16 + (i >> 1) * 4 + ((vcu & 31) >> 3), s = vcu & 7; return AtUnit{bh >> 3, bh & 7, (i & 1) ? 15 - s : s}; }
        const int bh = (vcu >> 1) + (i >> 3) * hb; const int s = (vcu & 1) + 2 * ((i & 7) >> 1); return AtUnit{bh >> 3, bh & 7, (i & 1) ? 15 - s : s}; };
    if (nun == 0) return;
    bf16x8 qr[4]; AtUnit cu = unit_of(0); at_prefetch(lds, cu, Q, K, V, qr);
    for (int i = 0; i < nun; ++i) { const bool hn = i + 1 < nun; const AtUnit nu = unit_of(hn ? i + 1 : i);
        attn_unit<var>(lds, cu, nu, hn, i == 0, Q, K, V, O, lam, gain, qr); cu = nu; }
    __syncthreads();
}
#undef AT_DMA_K
#undef AT_DMA_V
#undef AT_SBAR
}

struct MKArgs { const void* in[21]; float* out; unsigned char* ws; unsigned mask; unsigned li; };
enum { PH_PRO = 0, PH_G1, PH_POOLA, PH_ATT, PH_POOLG, PH_G4A, PH_G4B, PH_G5, PH_ROUTER, PH_G7, PH_G8, PH_FINAL, PH_N };

template <int MODE> __device__ __forceinline__ int dest_row(int n) {
    if (MODE == 1) return n < 2048 ? (n & ~63) + qk_pos_of_d(n & 63) : n;
    if (MODE == 2) { const int nn = n >> 9, hc = n & 511; return (hc >> 7) * 256 + ((hc >> 6) & 1) * 128 + ((hc >> 4) & 3) * 32 + ((hc >> 2) & 3) * 8 + nn * 4 + (hc & 3); }
    return n;
}
template <int MODE> __device__ __forceinline__ void transpose_item(const float* __restrict__ W, int ldw, int N, bf16_t* __restrict__ WT, int ldt, int coloff, int rowoff, LAS float* scr, int item, int lane) {
    const int nblk = N / 64, kb = item / nblk, nb = item % nblk, k0 = 64 * kb, n0 = 64 * nb;
    const int lr = lane >> 4, n4 = (lane & 15) * 4;
#pragma unroll 4
    for (int i = 0; i < 16; ++i) { const int kk = 4 * i + lr; const f32x4 v = *(const f32x4*)(W + (size_t)(k0 + kk) * ldw + n0 + n4); *(LAS f32x4*)(scr + kk * 64 + (n4 ^ ((kk >> 3) << 2))) = v; }
    LDS_WAIT(); asm volatile("" ::: "memory");
    const int c = lane & 7;
#pragma unroll 2
    for (int jj = 0; jj < 8; ++jj) { const int n = 8 * jj + (lane >> 3); const LAS float* sp = scr + (8 * c) * 64 + (n ^ (c << 2));
        u32x4 o; o.x = cvt_pk_bf16(sp[0 * 64], sp[1 * 64]); o.y = cvt_pk_bf16(sp[2 * 64], sp[3 * 64]); o.z = cvt_pk_bf16(sp[4 * 64], sp[5 * 64]); o.w = cvt_pk_bf16(sp[6 * 64], sp[7 * 64]);
        *(u32x4*)(WT + (size_t)(rowoff + dest_row<MODE>(n0 + n)) * ldt + coloff + k0 + 8 * c) = o; }
    LDS_WAIT(); asm volatile("" ::: "memory");
}

__global__ void __launch_bounds__(NTHREADS, 2) mk_fwd(MKArgs args) {
    __shared__ __attribute__((aligned(16))) unsigned char lds_raw[LDS_BYTES];
    LAS unsigned char* lds = (LAS unsigned char*)lds_raw;
    volatile LAS unsigned* MISC = (volatile LAS unsigned*)(lds + MISC_OFF);
    const int tid = threadIdx.x, lane = tid & 63, wave = __builtin_amdgcn_readfirstlane(tid >> 6);
    const int G = gridDim.x; const int bx = blockIdx.x; const int vcu = (G % 8 == 0) ? (bx % 8) * (G / 8) + bx / 8 : bx;
    const unsigned mask = args.mask; const bool dry = ((args.li >> 8) & 1u) != 0u;
    unsigned char* const ws = args.ws; float* const out = args.out;
#define IN_F(k) ((const float*)args.in[k])
#define x_ IN_F(0)
#define positions ((const int*)args.in[1])
#define w_in IN_F(2)
#define gate_bias IN_F(3)
#define lam_vecs IN_F(4)
#define subln_gain IN_F(5)
#define w_pool IN_F(6)
#define pool_scale IN_F(7)
#define w_branch_a IN_F(8)
#define w_branch_b IN_F(9)
#define w_out IN_F(10)
#define ln1_g IN_F(11)
#define ln1_b IN_F(12)
#define wrg IN_F(13)
#define brg IN_F(14)
#define wre IN_F(15)
#define bre IN_F(16)
#define wgu IN_F(17)
#define wdn IN_F(18)
#define ln2_g IN_F(19)
#define ln2_b IN_F(20)
#define wt ((bf16_t*)(ws + WS_WT))
#define xb ((bf16_t*)(ws + WS_XB))
#define qb ((bf16_t*)(ws + WS_Q))
#define kb ((bf16_t*)(ws + WS_K))
#define vb ((bf16_t*)(ws + WS_V))
#define ub ((bf16_t*)(ws + WS_U))
#define gb ((bf16_t*)out)
#define on ((bf16_t*)(ws + WS_ON))
#define mixed ((bf16_t*)(ws + WS_MIXED))
#define merged ((bf16_t*)(ws + WS_MERGED))
#define x1b ((bf16_t*)(ws + WS_X1B))
#define hb ((bf16_t*)(ws + WS_H))
#define ybuf ((bf16_t*)(ws + WS_YBUF))
#define rope ((float*)(ws + WS_ROPE))
#define pooled ((bf16_t*)(ws + WS_POOLED))
#define misc (ws + WS_MISC)
#define ctl ((unsigned*)(misc + MS_CTL))
#define stats ((float2*)(misc + MS_STATS))
#define rw ((float*)(misc + MS_ROUTE + (size_t)T * 8))
#define list ((int*)(misc + MS_LIST))
#define scal ((float*)(misc + MS_SCAL))
#define cnt (ctl + CW_CNT)
#define wpool_bd ((bf16_t*)(misc + MS_WPOOL))

    for (int u = tid; u < (LDS_BYTES - LDS_CTL_OFF) / 4; u += NTHREADS) ((LAS unsigned*)(lds + LDS_CTL_OFF))[u] = 0u;
    __syncthreads();
    XcdBarrier bar; bar.bar = ctl + CW_BAR + (args.li & 255u) * XCD_BAR_WORDS; bar.x = 0; bar.st = nullptr;
    const bool multi = (mask & (mask - 1u)) != 0u;
    if (multi) bar = xcd_barrier_post(ctl + CW_BAR + (args.li & 255u) * XCD_BAR_WORDS, MISC + 8);
#ifndef MK_CT
#define MK_CT 0xfffu
#endif
#define HAS(p) (((MK_CT >> (p)) & 1u) && ((mask >> (p)) & 1u))
#ifndef MK_REP
#define MK_REP 0u
#endif
#define REPS(p) for (int rep_ = 0; rep_ < ((((MK_REP) >> (p)) & 1u) ? 2 : 1); ++rep_)
#ifdef MK_BAR2
#define SEAM(p) do { if (multi && (mask >> ((p) + 1)) != 0u) { xcd_barrier(bar); xcd_barrier(bar); } } while (0)
#else
#define SEAM(p) do { if (multi && (mask >> ((p) + 1)) != 0u) xcd_barrier(bar); } while (0)
#endif
#define AN_STR2(x) #x
#define AN_STR(x) AN_STR2(x)
#define ANCHOR(n) asm volatile(".p2align 6\n\t.rept " AN_STR(n) "\n\ts_nop 0\n\t.endr" ::: "memory")
#ifndef AN_G1
#define AN_G1 0
#endif
#ifndef AN_ATT
#define AN_ATT 0
#endif
#ifndef AN_G4A
#define AN_G4A 0
#endif
#ifndef AN_G4B
#define AN_G4B 0
#endif
#ifndef AN_G5
#define AN_G5 0
#endif
#ifndef AN_RT
#define AN_RT 0
#endif
#ifndef AN_G7
#define AN_G7 0
#endif
#ifndef AN_G8
#define AN_G8 0
#endif
    const int gw = vcu * NWAVES + wave, NGW = G * NWAVES;

    if (HAS(PH_PRO)) {
        LAS float* scr = (LAS float*)(lds + wave * 16384);
        constexpr int I_IN = 16 * (INW / 64), I_A = 16 * 16, I_O = 16 * 16, I_GU = 16 * 16, I_DN = 8 * 16;
        constexpr int NITEMS = I_IN + I_A + I_O;
        for (int it = gw; it < NITEMS; it += NGW) {
            int r = it;
            if (r < I_IN) { transpose_item<1>(w_in, INW, INW, wt + WT_IN, 1024, 0, 0, scr, r, lane); continue; } r -= I_IN;
            if (r < I_A) { transpose_item<0>(w_branch_a, 1024, 1024, wt + WT_A, 1024, 0, 0, scr, r, lane); continue; } r -= I_A;
            transpose_item<0>(w_out, 1024, 1024, wt + WT_O, 1024, 0, 0, scr, r, lane);
            (void)I_GU; (void)I_DN;
        }
        for (int it = gw; it < 64 * 16; it += NGW) { const int kc = it >> 4, n = (it & 15) * 64 + lane; const int g = kc >> 4, c0 = (kc & 15) * 8; float a8[8] = {0.f, 0.f, 0.f, 0.f, 0.f, 0.f, 0.f, 0.f};
            const float* wpg = w_pool + (size_t)(g * 128 + c0) * 128; const float* wbp = w_branch_b + (size_t)(g * 128) * 1024 + n; const float* psp = pool_scale + g * 128;
            for (int d = 0; d < 128; ++d) { const float bv = wbp[(size_t)d * 1024] * psp[d];
#pragma unroll
                for (int i = 0; i < 8; ++i) a8[i] = fmaf(wpg[i * 128 + d], bv, a8[i]); }
            u32x4 o; o.x = cvt_pk_bf16(a8[0], a8[1]); o.y = cvt_pk_bf16(a8[2], a8[3]); o.z = cvt_pk_bf16(a8[4], a8[5]); o.w = cvt_pk_bf16(a8[6], a8[7]);
            *(u32x4*)(wt + WT_B + (size_t)n * 512 + kc * 8) = o; }
        for (int m = gw; m < T; m += NGW) { const f32x4* xr = (const f32x4*)(x_ + (size_t)m * 1024) + 2 * lane; u32x4* o16 = (u32x4*)(xb + (size_t)m * 1024) + lane;
#pragma unroll
            for (int j = 0; j < 2; ++j) { const f32x4 v0 = __builtin_nontemporal_load(xr + 128 * j), v1 = __builtin_nontemporal_load(xr + 128 * j + 1); u32x4 w; w.x = cvt_pk_bf16(v0[0], v0[1]); w.y = cvt_pk_bf16(v0[2], v0[3]); w.z = cvt_pk_bf16(v1[0], v1[1]); w.w = cvt_pk_bf16(v1[2], v1[3]); o16[64 * j] = w; } }
        for (int e = gw * 64 + lane; e < T * 32; e += NGW * 64) { const int t = e >> 5, i = e & 31; const float inv = powf(10000.0f, -(float)i * (2.0f / 64.0f)); const float ang = (float)positions[t] * inv; float sn, cs; sincosf(ang, &sn, &cs);
            rope[2 * e] = cs; rope[2 * e + 1] = sn; }
        if (gw == 0 && lane == 0) { float s01 = 0.f, s23 = 0.f; for (int i = 0; i < 64; ++i) { s01 += lam_vecs[i] * lam_vecs[64 + i]; s23 += lam_vecs[128 + i] * lam_vecs[192 + i]; } scal[0] = expf(s01) - expf(s23) + LAMBDA_INIT; }
        { f32x4* wp = (f32x4*)(misc + MS_WP);
          for (int e = gw * 64 + lane; e < 16 * 3 * 4 * 64; e += NGW * 64) { const int l = e & 63, sg = (e >> 6) & 3, ob = (e >> 8) % 3, chunk = (e >> 8) / 3; const int o = ob * 16 + (l & 15); f32x4 v = {0.f, 0.f, 0.f, 0.f};
              if (o < 36) {
#pragma unroll
                  for (int j = 0; j < 4; ++j) { const int c = chunk * 64 + (l >> 4) * 16 + 4 * sg + j; v[j] = ln1_g[c] * (o < 4 ? wrg[c * 4 + o] : wre[c * 32 + (o - 4)]); } }
              wp[e] = v; }
          float* csbw = (float*)(misc + MS_CSBW);
          if (gw < 48) { const int o = gw; float cs = 0.f, bw = 0.f;
              if (o < 36) { for (int i = 0; i < 16; ++i) { const int c = lane + 64 * i; const float w = (o < 4 ? wrg[c * 4 + o] : wre[c * 32 + (o - 4)]); cs += ln1_g[c] * w; bw += ln1_b[c] * w; }
                  cs = wave_sum(cs); bw = wave_sum(bw) + (o < 4 ? brg[o] : bre[o - 4]); }
              if (lane == 0) { csbw[o] = cs; csbw[48 + o] = bw; } } }
#ifdef MK_SLEEP_TEST
        { const unsigned long long t0_ = __builtin_amdgcn_s_memrealtime(); while (__builtin_amdgcn_s_memrealtime() - t0_ < 10000ull) __builtin_amdgcn_s_sleep(32); }
#endif
        __syncthreads();
        SEAM(PH_PRO);
    }
    if (HAS(PH_G1)) {
        ANCHOR(AN_G1);
        g8::DenseOrder S; S.init(xb, wt + WT_IN, T, INW, 1024, G, bx);
        g8::EpiProj E{qb, kb, vb, ub, gb, rope, gate_bias};
        g8::gemm_phase<g8::EpiProj, g8::DenseOrder, true, false>(lds, 1024, S, E);
        SEAM(PH_G1);
    }
    if (HAS(PH_POOLA)) {
        for (int task = gw; task < T / 16; task += NGW) { const int t0 = task * 16, s0 = t0 & (SEQ - 1); const int w = 2 << (lane >> 4); const bf16_t* up = ub + (size_t)t0 * 512 + lane * 8;
            float a[8] = {0.f, 0.f, 0.f, 0.f, 0.f, 0.f, 0.f, 0.f};
            if (s0 != 0) for (int i = 1; i < w; ++i) { const u32x4 v = *(const u32x4*)(up - (ptrdiff_t)i * 512);
                a[0] += bflo(v.x); a[1] += bfhi(v.x); a[2] += bflo(v.y); a[3] += bfhi(v.y); a[4] += bflo(v.z); a[5] += bfhi(v.z); a[6] += bflo(v.w); a[7] += bfhi(v.w); }
#pragma unroll 4
            for (int j = 0; j < 16; ++j) { const int s = s0 + j; const u32x4 v = *(const u32x4*)(up + (size_t)j * 512); const float f[8] = {bflo(v.x), bfhi(v.x), bflo(v.y), bfhi(v.y), bflo(v.z), bfhi(v.z), bflo(v.w), bfhi(v.w)};
#pragma unroll
                for (int k = 0; k < 8; ++k) a[k] += f[k];
                if (j >= 1 && s >= w) { const u32x4 o = *(const u32x4*)(up + (ptrdiff_t)(j - w) * 512);
                    a[0] -= bflo(o.x); a[1] -= bfhi(o.x); a[2] -= bflo(o.y); a[3] -= bfhi(o.y); a[4] -= bflo(o.z); a[5] -= bfhi(o.z); a[6] -= bflo(o.w); a[7] -= bfhi(o.w); }
                const float inv = 1.f / (float)((s + 1 < w) ? s + 1 : w); u32x4 r; r.x = cvt_pk_bf16(a[0] * inv - f[0], a[1] * inv - f[1]); r.y = cvt_pk_bf16(a[2] * inv - f[2], a[3] * inv - f[3]);
                r.z = cvt_pk_bf16(a[4] * inv - f[4], a[5] * inv - f[5]); r.w = cvt_pk_bf16(a[6] * inv - f[6], a[7] * inv - f[7]);
                *(u32x4*)(pooled + (size_t)(t0 + j) * 512 + lane * 8) = r; } }
    }
    if (HAS(PH_ATT)) {
        ANCHOR(AN_ATT);
#ifdef MK_VAR
        if (args.li >> 8) at2::attn_phase<MK_VAR>(lds, vcu, G, qb, kb, vb, (bf16_t*)(ws + WS_POOLED), scal, subln_gain); else
#endif
        at2::attn_phase<0u>(lds, vcu, G, qb, kb, vb, on, scal, subln_gain);
        SEAM(PH_ATT); }
    else if (HAS(PH_POOLA)) { SEAM(PH_ATT); }
    if (HAS(PH_G4A)) {
        ANCHOR(AN_G4A);
        g8::DenseOrder S; S.init(on, wt + WT_A, T, 1024, 1024, G, bx);
        g8::EpiMerge<0> E{gb, merged, merged};
        g8::gemm_phase<g8::EpiMerge<0>, g8::DenseOrder, true, false>(lds, 1024, S, E);
    }
    if (HAS(PH_G4B)) {
        ANCHOR(AN_G4B);
        g8::DenseOrder S; S.init(pooled, wt + WT_B, T, 1024, 512, G, bx);
        g8::EpiMerge<1> E{gb, merged, dry ? (bf16_t*)(ws + WS_X1B) : merged};
        g8::gemm_phase<g8::EpiMerge<1>, g8::DenseOrder, true, false>(lds, 512, S, E);
        SEAM(PH_G4B);
    } else if (HAS(PH_G4A)) { SEAM(PH_G4B); }
    if (HAS(PH_G5)) {
        ANCHOR(AN_G5);
        g8::DenseOrder S; S.init(merged, wt + WT_O, T, 1024, 1024, G, bx);
        g8::EpiResid E{x_, out, (float2*)(ws + WS_MIXED)};
        g8::gemm_phase<g8::EpiResid, g8::DenseOrder, true, false>(lds, 1024, S, E);
        SEAM(PH_G5);
    }
    if (HAS(PH_ROUTER)) {
        ANCHOR(AN_RT);
        LAS float* lgs = (LAS float*)(lds + 0) + wave * (16 * 49);
        LAS float* tst = (LAS float*)(lds + 32768) + wave * 32;
        LAS int*   tex = (LAS int*)(lds + 36864) + wave * 128;
        LAS unsigned* lcnt = (LAS unsigned*)(lds + 40960);
        const f32x4* wp = (const f32x4*)(misc + MS_WP); const float* csbw = (const float*)(misc + MS_CSBW);
        for (int t0 = vcu * 128; t0 < T; t0 += G * 128) {
            if (tid < 64) lcnt[tid] = 0u;
            __syncthreads();
            const int tk = lane & 15, q = lane >> 4;
            if (wave >= 4) {
                if (t0 == vcu * 128) { LAS float* scr = (LAS float*)(lds + 65536 + (wave - 4) * 16384); constexpr int I_GU = 16 * 16, I_DN = 8 * 16;
                    for (int it = vcu * 4 + (wave - 4); it < NE * (I_GU + I_DN); it += G * 4) {
                        if (it < NE * I_GU) { const int e = it / I_GU; transpose_item<2>(wgu + (size_t)e * 1024 * 1024, 1024, 1024, wt + WT_GU + (size_t)e * 1024 * 1024, 1024, 0, 0, scr, it % I_GU, lane); }
                        else { const int r2 = it - NE * I_GU; const int e = r2 / I_DN; transpose_item<0>(wdn + (size_t)e * 512 * 1024, 1024, 1024, wt + WT_DN + (size_t)e * 1024 * 512, 512, 0, 0, scr, r2 % I_DN, lane); } } }
            } else
            for (int half = 0; half < 2; ++half) { const int tw = t0 + (wave * 2 + half) * 16; LAS int* texh = tex + half * 64;
            { const float* yr = out + (size_t)(tw + tk) * 1024 + q * 16;
              float s1 = 0.f, s2 = 0.f; { const float2* pp = (const float2*)(ws + WS_MIXED) + (size_t)(tw + tk) * 16;
#pragma unroll
                  for (int i = 0; i < 16; ++i) { const float2 pv = pp[i]; s1 += pv.x; s2 += pv.y; } }
              const float mu = s1 * (1.f / 1024.f); const float var = fmaxf(s2 * (1.f / 1024.f) - mu * mu, 0.f); const float rstd = 1.0f / sqrtf(var + LN_EPS);
              if (q == 0) { tst[2 * tk] = mu; tst[2 * tk + 1] = rstd; if (!dry) stats[tw + tk] = make_float2(mu, rstd); }
              bf16_t* xo = (dry ? (bf16_t*)(ws + WS_H) : x1b) + (size_t)(tw + tk) * 1024 + q * 16; const float* gp = ln1_g + q * 16; const float* bp = ln1_b + q * 16;
              f32x4 acc0 = {0.f, 0.f, 0.f, 0.f}, acc1 = {0.f, 0.f, 0.f, 0.f}, acc2 = {0.f, 0.f, 0.f, 0.f};
#pragma unroll 2
              for (int chunk = 0; chunk < 16; ++chunk) { f32x4 yv[4];
#pragma unroll
                  for (int j = 0; j < 4; ++j) yv[j] = *(const f32x4*)(yr + chunk * 64 + 4 * j);
                  { u32x4 w0, w1; f32x4 xn[4];
#pragma unroll
                    for (int j = 0; j < 4; ++j) { const f32x4 gg = *(const f32x4*)(gp + chunk * 64 + 4 * j), bb = *(const f32x4*)(bp + chunk * 64 + 4 * j); xn[j] = (yv[j] - mu) * rstd * gg + bb; }
                    w0.x = cvt_pk_bf16(xn[0][0], xn[0][1]); w0.y = cvt_pk_bf16(xn[0][2], xn[0][3]); w0.z = cvt_pk_bf16(xn[1][0], xn[1][1]); w0.w = cvt_pk_bf16(xn[1][2], xn[1][3]);
                    w1.x = cvt_pk_bf16(xn[2][0], xn[2][1]); w1.y = cvt_pk_bf16(xn[2][2], xn[2][3]); w1.z = cvt_pk_bf16(xn[3][0], xn[3][1]); w1.w = cvt_pk_bf16(xn[3][2], xn[3][3]);
                    *(u32x4*)(xo + chunk * 64) = w0; *(u32x4*)(xo + chunk * 64 + 8) = w1; }
#pragma unroll
                  for (int sg = 0; sg < 4; ++sg) { const f32x4 b0 = wp[((chunk * 3 + 0) * 4 + sg) * 64 + lane], b1 = wp[((chunk * 3 + 1) * 4 + sg) * 64 + lane], b2 = wp[((chunk * 3 + 2) * 4 + sg) * 64 + lane];
#pragma unroll
                      for (int j = 0; j < 4; ++j) { const float a = yv[sg][j];
                          acc0 = __builtin_amdgcn_mfma_f32_16x16x4f32(a, b0[j], acc0, 0, 0, 0); acc1 = __builtin_amdgcn_mfma_f32_16x16x4f32(a, b1[j], acc1, 0, 0, 0); acc2 = __builtin_amdgcn_mfma_f32_16x16x4f32(a, b2[j], acc2, 0, 0, 0); } } }
#pragma unroll
              for (int r = 0; r < 4; ++r) { lgs[(4 * q + r) * 49 + tk] = acc0[r]; lgs[(4 * q + r) * 49 + 16 + tk] = acc1[r]; lgs[(4 * q + r) * 49 + 32 + tk] = acc2[r]; } }
            LDS_WAIT();
            if (lane < 16) { const int t = tw + lane; const float mu = tst[2 * lane], rstd = tst[2 * lane + 1]; const LAS float* lr = lgs + lane * 49;
                float lg[4], le[32];
#pragma unroll
                for (int o = 0; o < 4; ++o) lg[o] = rstd * (lr[o] - mu * csbw[o]) + csbw[48 + o];
#pragma unroll
                for (int o = 0; o < 32; ++o) le[o] = rstd * (lr[4 + o] - mu * csbw[4 + o]) + csbw[48 + 4 + o];
                int gi = 0; float gm = lg[0];
#pragma unroll
                for (int o = 1; o < 4; ++o) if (lg[o] > gm) { gm = lg[o]; gi = o; }
                float gs = 0.f;
#pragma unroll
                for (int o = 0; o < 4; ++o) gs += expf(lg[o] - gm);
                const float gp = 1.f / gs; float ev[8];
#pragma unroll
                for (int o = 0; o < 8; ++o) { float vsel = le[o];
#pragma unroll
                    for (int g = 1; g < 4; ++g) vsel = (gi == g) ? le[g * 8 + o] : vsel;
                    ev[o] = vsel; }
                int i0 = 0; float m0v = ev[0];
#pragma unroll
                for (int o = 1; o < 8; ++o) if (ev[o] > m0v) { m0v = ev[o]; i0 = o; }
                int i1 = (i0 == 0) ? 1 : 0; float m1v = -3.4e38f;
#pragma unroll
                for (int o = 0; o < 8; ++o) if (o != i0 && ev[o] > m1v) { m1v = ev[o]; i1 = o; }
                const float e1 = expf(m1v - m0v); const float w0 = gp / (1.f + e1), w1 = gp * e1 / (1.f + e1);
                const int ex0 = gi * 8 + i0, ex1 = gi * 8 + i1;
                if (!dry) { rw[2 * t] = w0; rw[2 * t + 1] = w1; }
                const unsigned r0 = __hip_atomic_fetch_add(lcnt + ex0, 1u, __ATOMIC_RELAXED, __HIP_MEMORY_SCOPE_WORKGROUP); const unsigned r1 = __hip_atomic_fetch_add(lcnt + ex1, 1u, __ATOMIC_RELAXED, __HIP_MEMORY_SCOPE_WORKGROUP);
                texh[4 * lane] = ex0; texh[4 * lane + 1] = ex1; texh[4 * lane + 2] = (int)r0; texh[4 * lane + 3] = (int)r1; }
            }
            __syncthreads();
            if (tid < NE) { const unsigned c = lcnt[tid]; lcnt[32 + tid] = (c && !dry) ? atomicAdd(cnt + tid, c) : 0u; }
            __syncthreads();
            if (wave < 4 && lane < 32 && !dry) { const int half = lane >> 4, l16 = lane & 15; const int t = t0 + (wave * 2 + half) * 16 + l16; const LAS int* te = tex + half * 64 + 4 * l16; const int ex0 = te[0], ex1 = te[1];
                list[(size_t)ex0 * T + lcnt[32 + ex0] + (unsigned)te[2]] = t * 2; list[(size_t)ex1 * T + lcnt[32 + ex1] + (unsigned)te[3]] = t * 2 + 1; }
            __syncthreads();
        }
        SEAM(PH_ROUTER);
    }
    if (HAS(PH_G7) || HAS(PH_G8)) {
        if (tid < NE) MISC[64 + tid] = __hip_atomic_load(cnt + tid, RLX_AGENT);
        __syncthreads();
        if (tid == 0) { unsigned acc = 0u; for (int e = 0; e < NE; ++e) { MISC[16 + e] = acc; acc += (MISC[64 + e] + 255u) >> 8; } MISC[16 + NE] = acc; }
        __syncthreads();
        const int ntiles = (int)MISC[16 + NE];
        unsigned* tdone = ctl + CW_TDONE;
        const int nwg = ntiles * 4, r7 = nwg % G;
        if (HAS(PH_G7)) {
            ANCHOR(AN_G7);
            g8::MoeOrder S{(const char*)x1b, (const char*)(wt + WT_GU), list, MISC + 16, MISC + 64, nwg, G, bx, 0, (size_t)1024 * 1024 * 2, (size_t)256 * 1024 * 2, 1, tdone, 1};
            g8::EpiGateUp E{hb};
            g8::gemm_phase<g8::EpiGateUp, g8::MoeOrder, true, true>(lds, 1024, S, E);
        }
        if (HAS(PH_G8)) {
            ANCHOR(AN_G8);
            g8::MoeOrder S{(const char*)hb, (const char*)(wt + WT_DN), list, MISC + 16, MISC + 64, nwg, G, (bx - r7 + G) % G, (size_t)256 * 512 * 2, (size_t)1024 * 512 * 2, (size_t)256 * 512 * 2, 0, tdone, 2};
            g8::EpiDown E{ybuf, list, rw, MISC + 64};
            g8::gemm_phase<g8::EpiDown, g8::MoeOrder, true, false>(lds, 512, S, E);
            SEAM(PH_G8);
        } else if (HAS(PH_G7)) { SEAM(PH_G8); }
    }
    if (HAS(PH_FINAL)) {
        for (int t = gw; t < T; t += NGW) {
            float* yr = out + (size_t)t * 1024; float* yw = dry ? (float*)(ws + WS_V) + (size_t)t * 1024 : yr; const bf16_t* x1r = x1b + (size_t)t * 1024; float xv[16]; float s = 0.f;
#pragma unroll
            for (int j = 0; j < 4; ++j) { const int c0 = j * 256 + lane * 4; const u32x2 xw = __builtin_nontemporal_load((const u32x2*)(x1r + c0)); const float x1v[4] = {bflo(xw.x), bfhi(xw.x), bflo(xw.y), bfhi(xw.y)};
                const u32x2 a = __builtin_nontemporal_load((const u32x2*)(ybuf + (size_t)(2 * t) * 1024 + c0)); const u32x2 b = __builtin_nontemporal_load((const u32x2*)(ybuf + (size_t)(2 * t + 1) * 1024 + c0));
                const float ya[4] = {bflo(a.x), bfhi(a.x), bflo(a.y), bfhi(a.y)}; const float yb[4] = {bflo(b.x), bfhi(b.x), bflo(b.y), bfhi(b.y)};
#pragma unroll
                for (int i = 0; i < 4; ++i) { const float val = ALPHA * x1v[i] + (ya[i] + yb[i]); xv[4 * j + i] = val; s += val; } }
            const float mu = wave_sum(s) * (1.f / 1024.f); float s2 = 0.f;
#pragma unroll
            for (int i = 0; i < 16; ++i) { const float d = xv[i] - mu; s2 += d * d; }
            const float rstd = 1.0f / sqrtf(wave_sum(s2) * (1.f / 1024.f) + LN_EPS);
#pragma unroll
            for (int j = 0; j < 4; ++j) { const int c0 = j * 256 + lane * 4; const f32x4 gg = *(const f32x4*)(ln2_g + c0); const f32x4 bb = *(const f32x4*)(ln2_b + c0); f32x4 o;
#pragma unroll
                for (int i = 0; i < 4; ++i) o[i] = (xv[4 * j + i] - mu) * rstd * gg[i] + bb[i];
                __builtin_nontemporal_store(o, (f32x4*)(yw + c0)); }
        }
    }
#undef HAS
#undef SEAM
}
#undef IN_F
#undef x_
#undef positions
#undef w_in
#undef gate_bias
#undef lam_vecs
#undef subln_gain
#undef w_pool
#undef pool_scale
#undef w_branch_a
#undef w_branch_b
#undef w_out
#undef ln1_g
#undef ln1_b
#undef wrg
#undef brg
#undef wre
#undef bre
#undef wgu
#undef wdn
#undef ln2_g
#undef ln2_b
#undef wt
#undef xb
#undef qb
#undef kb
#undef vb
#undef ub
#undef gb
#undef on
#undef mixed
#undef merged
#undef x1b
#undef hb
#undef ybuf
#undef rope
#undef pooled
#undef misc
#undef ctl
#undef stats
#undef rw
#undef list
#undef scal
#undef cnt
#undef wpool_bd


#ifndef MK_OPT
#define MK_OPT 0xfffu
#endif
#ifndef MK_M2A
#define MK_M2A 0xff4u
#define MK_M2B 0u
#define MK_M2C 0u
#endif
#ifndef MK_ONE
#define MK_ONE 1
#endif
constexpr unsigned OPT = MK_OPT;
#define OPTP(p) ((OPT >> (p)) & 1u)


#ifdef MK_DEBUG_HASH
__global__ void k_hash(const uint4* __restrict__ p, size_t n16, unsigned long long* __restrict__ outh) {
    unsigned long long h = 0ull;
    for (size_t i = blockIdx.x * (size_t)blockDim.x + threadIdx.x; i < n16; i += (size_t)gridDim.x * blockDim.x) { const uint4 w = p[i];
        const unsigned long long m = (unsigned long long)(i * 2654435761ull + 12345ull) | 1ull;
        h += ((unsigned long long)w.x * 0x9E3779B1ull + (unsigned long long)w.y * 0x85EBCA77ull + (unsigned long long)w.z * 0xC2B2AE3Dull + (unsigned long long)w.w * 0x27D4EB2Full) * m; }
    for (int o = 32; o > 0; o >>= 1) h += __shfl_xor(h, o);
    if ((threadIdx.x & 63) == 0) atomicAdd(outh, h);
}
__global__ void k_poison(float* __restrict__ out, const unsigned long long* __restrict__ hs) {
    float code = 0.f; for (int r = 1; r < 10; ++r) if (hs[r] != hs[0]) code = 1.f;
    if (code == 0.f) return;
    for (size_t i = blockIdx.x * (size_t)blockDim.x + threadIdx.x; i < (size_t)T * DM; i += (size_t)gridDim.x * blockDim.x) out[i] = __builtin_nanf("") * code;
}
#endif
extern "C" void kernel_launch(void* const* d_in, const int* in_sizes, int n_in, void* d_out, int out_size, void* d_ws, size_t ws_size, hipStream_t stream) {
    static int grid = 0;
    if (grid == 0) {
        if (n_in != 21 || in_sizes[0] != T * DM || out_size != T * DM || ws_size < WS_END) { fprintf(stderr, "kernel_launch: unexpected shapes (n_in %d, x %d, out %d, ws %zu)\n", n_in, n_in > 0 ? in_sizes[0] : -1, out_size, ws_size); grid = -1; return; }
        int dev = 0, cus = 0;
        if (hipGetDevice(&dev) != hipSuccess || hipDeviceGetAttribute(&cus, hipDeviceAttributeMultiprocessorCount, dev) != hipSuccess) { fprintf(stderr, "kernel_launch: device query failed\n"); grid = -1; return; }
        int per_cu = 0;
        if (hipOccupancyMaxActiveBlocksPerMultiprocessor(&per_cu, (const void*)mk_fwd, NTHREADS, 0) != hipSuccess || per_cu < 1) fprintf(stderr, "kernel_launch: note: occupancy query reports %d blocks per CU\n", per_cu);
        (void)hipGetLastError();
        grid = cus;
    }
    if (grid < 0) return;
    const float* x = (const float*)d_in[0]; const int* positions = (const int*)d_in[1]; const float* w_in = (const float*)d_in[2]; const float* gate_bias = (const float*)d_in[3];
    const float* lam_vecs = (const float*)d_in[4]; const float* subln_gain = (const float*)d_in[5]; const float* w_pool = (const float*)d_in[6]; const float* pool_scale = (const float*)d_in[7];
    const float* w_branch_a = (const float*)d_in[8]; const float* w_branch_b = (const float*)d_in[9]; const float* w_out = (const float*)d_in[10]; const float* ln1_g = (const float*)d_in[11];
    const float* ln1_b = (const float*)d_in[12]; const float* wrg = (const float*)d_in[13]; const float* brg = (const float*)d_in[14]; const float* wre = (const float*)d_in[15];
    const float* bre = (const float*)d_in[16]; const float* wgu = (const float*)d_in[17]; const float* wdn = (const float*)d_in[18]; const float* ln2_g = (const float*)d_in[19]; const float* ln2_b = (const float*)d_in[20];
    char* ws = (char*)d_ws; float* out = (float*)d_out;
    bf16_t* qb = (bf16_t*)(ws + WS_Q); bf16_t* kb = (bf16_t*)(ws + WS_K); bf16_t* vb = (bf16_t*)(ws + WS_V); bf16_t* ub = (bf16_t*)(ws + WS_U); bf16_t* gb = (bf16_t*)d_out;
    bf16_t* on = (bf16_t*)(ws + WS_ON); bf16_t* mixed = (bf16_t*)(ws + WS_MIXED); bf16_t* merged = (bf16_t*)(ws + WS_MERGED); bf16_t* x1b = (bf16_t*)(ws + WS_X1B);
    bf16_t* hb = (bf16_t*)(ws + WS_H); bf16_t* ybuf = (bf16_t*)(ws + WS_YBUF); float2* rope = (float2*)(ws + WS_ROPE); float* tmp = (float*)(ws + WS_TEMP);
    char* misc = ws + WS_MISC; unsigned* ctl = (unsigned*)(misc + MS_CTL); float2* stats = (float2*)(misc + MS_STATS); int2* rexp = (int2*)(misc + MS_ROUTE); float2* rw = (float2*)(misc + MS_ROUTE + (size_t)T * 8);
    int* list = (int*)(misc + MS_LIST); float* scal = (float*)(misc + MS_SCAL); unsigned* cnt = ctl;

    MKArgs a{}; int nlaunch = 0;
    for (int i = 0; i < 21; ++i) a.in[i] = d_in[i];
    a.out = out; a.ws = (unsigned char*)d_ws;
    if (hipMemsetAsync(ctl, 0, 65536, stream) != hipSuccess) { fprintf(stderr, "kernel_launch: memset failed\n"); return; }
#ifndef MK_REPH
#define MK_REPH 0u
#endif
#define MK(maskv) do { a.mask = (maskv); for (int rr_ = 0; rr_ < (((maskv) & (MK_REPH)) ? 2 : 1); ++rr_) { a.li = (unsigned)(nlaunch++ % 3) | (rr_ ? (1u << 8) : 0u); hipLaunchKernelGGL(mk_fwd, dim3(grid), dim3(NTHREADS), 0, stream, a); } } while (0)
    if (MK_ONE == 1) { MK((1u << PH_N) - 1u); return; }
    if (MK_ONE == 2) {
        MK(0x003u);
        for (int mh = 0; mh < 2; ++mh) { const int m0 = mh * 16384; nattn<<<(16384 / 64) * 16, 64, 0, stream>>>(qb, kb, vb, scal, tmp, m0); post_rms<<<16384 * 8 / 256, 256, 0, stream>>>(tmp, subln_gain, on, m0, 16384); }
        MK(MK_M2A); if (MK_M2B) MK(MK_M2B); if (MK_M2C) MK(MK_M2C); return; }

    constexpr int MC = 16384;
#if 0
#else
#ifdef MK_TEST_BAR
    MK(0x003u);
#else
    if (OPTP(PH_PRO)) MK(1u << PH_PRO); else k_prep<<<T * 32 / 256, 256, 0, stream>>>(positions, lam_vecs, rope, scal, ctl);
    if (OPTP(PH_G1)) MK(1u << PH_G1);
#endif
#endif
#ifndef MK_OVR
#define MK_OVR 0
#endif
    const int ovr = OPTP(PH_G1) ? MK_OVR : 15;
    for (int mh = 0; mh < 2; ++mh) {
        const int m0 = mh * MC; AL_F32 ax{x + (size_t)m0 * DM, DM, 0};
        if (ovr & 1) for (int qk = 0; qk < 2; ++qk) {
            ngemm<AL_F32><<<dim3(16, MC / 64), 256, 0, stream>>>(ax, w_in + qk * 1024, INW, tmp, 1024, MC, 1024, DM);
            post_qk<<<MC * 512 / 256, 256, 0, stream>>>(tmp, rope, qk ? kb : qb, m0, MC, qk ? 1.f : QSCALE);
        }
        if (ovr & 2) { ngemm<AL_F32><<<dim3(16, MC / 64), 256, 0, stream>>>(ax, w_in + 2048, INW, tmp, 1024, MC, 1024, DM);
        post_plain<<<MC * 1024 / 256, 256, 0, stream>>>(tmp, vb, 1024, 0, m0, MC, 1024, nullptr); }
        if (ovr & 4) { ngemm<AL_F32><<<dim3(8, MC / 64), 256, 0, stream>>>(ax, w_in + 3072, INW, tmp, 512, MC, 512, DM);
        post_plain<<<MC * 512 / 256, 256, 0, stream>>>(tmp, ub, 512, 0, m0, MC, 512, nullptr); }
        if (ovr & 8) for (int br = 0; br < 2; ++br) {
            ngemm<AL_F32><<<dim3(16, MC / 64), 256, 0, stream>>>(ax, w_in + 3584 + br * 1024, INW, tmp, 1024, MC, 1024, DM);
            post_gate<<<MC * 1024 / 256, 256, 0, stream>>>(tmp, gate_bias, gb, br * 1024, m0, MC);
        }
    }
    if (OPTP(PH_ATT)) MK(1u << PH_ATT);
    else for (int mh = 0; mh < 2; ++mh) {
        const int m0 = mh * MC;
        nattn<<<(MC / 64) * 16, 64, 0, stream>>>(qb, kb, vb, scal, tmp, m0);
        post_rms<<<MC * 8 / 256, 256, 0, stream>>>(tmp, subln_gain, on, m0, MC);
    }
    if (OPTP(PH_POOLA)) { MK(1u << PH_POOLA); MK(1u << PH_POOLG); }
    else for (int mh = 0; mh < 2; ++mh) {
        const int m0 = mh * MC;
        for (int g = 0; g < 4; ++g) { AL_POOL ap{ub + (size_t)m0 * PW, g, 0};
            ngemm<AL_POOL><<<dim3(2, MC / 64), 256, 0, stream>>>(ap, w_pool + (size_t)g * 128 * 128, 128, tmp + g * 128, 512, MC, 128, 128); }
        post_plain<<<MC * 512 / 256, 256, 0, stream>>>(tmp, mixed, 512, 0, m0, MC, 512, pool_scale);
    }
    if (OPTP(PH_G4A)) MK(1u << PH_G4A);
    else for (int mh = 0; mh < 2; ++mh) {
        const int m0 = mh * MC;
        { AL_BF16 al{on + (size_t)m0 * 1024, 1024, 0}; ngemm<AL_BF16><<<dim3(16, MC / 64), 256, 0, stream>>>(al, w_branch_a, 1024, tmp, 1024, MC, 1024, 1024); }
        post_merge<<<MC * 1024 / 256, 256, 0, stream>>>(tmp, gb, merged, 0, m0, MC);
    }
    if (OPTP(PH_G4B)) MK(1u << PH_G4B);
    else for (int mh = 0; mh < 2; ++mh) {
        const int m0 = mh * MC;
        { AL_BF16 al{mixed + (size_t)m0 * 512, 512, 0}; ngemm<AL_BF16><<<dim3(16, MC / 64), 256, 0, stream>>>(al, w_branch_b, 1024, tmp, 1024, MC, 1024, 512); }
        post_merge<<<MC * 1024 / 256, 256, 0, stream>>>(tmp, gb, merged, 1, m0, MC);
    }
    if (OPTP(PH_G5)) MK(1u << PH_G5);
    else for (int mh = 0; mh < 2; ++mh) {
        const int m0 = mh * MC;
        { AL_BF16 al{merged + (size_t)m0 * 1024, 1024, 0}; ngemm<AL_BF16><<<dim3(16, MC / 64), 256, 0, stream>>>(al, w_out, 1024, tmp, 1024, MC, 1024, 1024); }
        post_y<<<MC * 1024 / 256, 256, 0, stream>>>(tmp, x, out, m0, MC);
    }
    if (OPTP(PH_ROUTER)) MK(1u << PH_ROUTER); else k_router<<<T / 4, 256, 0, stream>>>(out, ln1_g, ln1_b, wrg, brg, wre, bre, x1b, stats, rexp, rw, list, cnt);
    if (OPTP(PH_G7)) MK(1u << PH_G7); else nmoe_gu<<<dim3(8, T / 64, NE), 256, 0, stream>>>(x1b, list, cnt, wgu, hb);
    if (OPTP(PH_G8)) MK(1u << PH_G8); else nmoe_dn<<<dim3(16, T / 64, NE), 256, 0, stream>>>(hb, list, cnt, rw, wdn, ybuf);
    if (OPTP(PH_FINAL)) MK(1u << PH_FINAL); else k_final<<<T / 4, 256, 0, stream>>>(out, stats, ln1_g, ln1_b, ybuf, ln2_g, ln2_b);
#undef MK
}
```

```cpp
#define AN_G1 13
#define AN_ATT 5
#define AN_G4A 0
#define AN_G4B 7
#define AN_G5 9
#define AN_RT 8
#define AN_G7 10
#define AN_G8 1
#include <hip/hip_runtime.h>
#include <cstdio>
#include <cstdint>
#include <cmath>

typedef unsigned short bf16_t;
typedef float f32x4 __attribute__((ext_vector_type(4)));

constexpr int NB = 16, SEQ = 2048, DM = 1024, T = NB * SEQ;
constexpr int NHEAD = 8, HD = 64, NHM = 16;
constexpr int INW = 5632;
constexpr int PW = 512, PG = 4, PGD = 128;
constexpr int NE = 32, NGRP = 4, EPG = 8, FF = 512;
constexpr float LN_EPS = 1e-5f, RMS_EPS = 1e-5f;
constexpr float ALPHA = 1.189207115002721f;
constexpr float LAMBDA_INIT = 0.2f;
constexpr float QSCALE = 0.125f * 1.4426950408889634f;

constexpr size_t MiB = 1u << 20;
constexpr size_t WS_WT    = 0;
constexpr size_t WS_XB    = 112 * MiB;
constexpr size_t WS_ON    = 112 * MiB;
constexpr size_t WS_YBUF  = 112 * MiB;
constexpr size_t WS_Q     = 176 * MiB;
constexpr size_t WS_MERGED= 176 * MiB;
constexpr size_t WS_K     = 240 * MiB;
constexpr size_t WS_X1B   = 240 * MiB;
constexpr size_t WS_V     = 304 * MiB;
constexpr size_t WS_H     = 304 * MiB;
constexpr size_t WS_U     = 368 * MiB;
constexpr size_t WS_MIXED = 400 * MiB;
constexpr size_t WS_ROPE  = 432 * MiB;
constexpr size_t WS_MISC  = 440 * MiB;
constexpr size_t WS_TEMP  = 448 * MiB;
constexpr size_t WS_END   = 512 * MiB;
constexpr size_t MS_CTL   = 0;
constexpr size_t MS_STATS = 64 * 1024;
constexpr size_t MS_ROUTE = 512 * 1024;
constexpr size_t MS_LIST  = 1 * MiB;
constexpr size_t MS_SCAL  = 6 * MiB;

__device__ __forceinline__ float bf2f(bf16_t v) { return __uint_as_float((unsigned)v << 16); }
__device__ __forceinline__ bf16_t f2bf(float f) { unsigned u = __float_as_uint(f); return (bf16_t)((u + 0x7fffu + ((u >> 16) & 1u)) >> 16); }
__host__ __device__ __forceinline__ int qk_pos_of_d(int d) { return ((d >> 4) & 1) * 32 + ((d >> 2) & 3) * 8 + (d >> 5) * 4 + (d & 3); }

struct AL_F32  { const float* p; int ld; int pad;  __device__ __forceinline__ float operator()(int r, int k) const { return p[(size_t)r * ld + k]; } };
struct AL_BF16 { const bf16_t* p; int ld; int pad; __device__ __forceinline__ float operator()(int r, int k) const { return bf2f(p[(size_t)r * ld + k]); } };
struct AL_POOL { const bf16_t* u; int g; int pad;
    __device__ __forceinline__ float operator()(int r, int k) const {
        const int w = 2 << g, s = r & (SEQ - 1); const int n = (s + 1 < w) ? s + 1 : w; float acc = 0.f;
        for (int i = 0; i < n; ++i) acc += bf2f(u[(size_t)(r - i) * PW + g * PGD + k]);
        return acc / (float)n - bf2f(u[(size_t)r * PW + g * PGD + k]); } };

template <class AL>
__global__ __launch_bounds__(256) void ngemm(AL al, const float* __restrict__ Bm, int ldb, float* __restrict__ C, int ldc, int M, int N, int K) {
    __shared__ float As[16][68]; __shared__ float Bs[16][68];
    const int tid = threadIdx.x, tx = tid & 15, ty = tid >> 4; const int m0 = blockIdx.y * 64, n0 = blockIdx.x * 64;
    float acc[4][4] = {};
    for (int k0 = 0; k0 < K; k0 += 16) {
#pragma unroll
        for (int i = 0; i < 4; ++i) { const int e = tid + i * 256; const int r = e >> 4, kk = e & 15; As[kk][r] = (m0 + r < M) ? al(m0 + r, k0 + kk) : 0.f; }
#pragma unroll
        for (int i = 0; i < 4; ++i) { const int e = tid + i * 256; const int kk = e >> 6, c = e & 63; Bs[kk][c] = (n0 + c < N) ? Bm[(size_t)(k0 + kk) * ldb + n0 + c] : 0.f; }
        __syncthreads();
#pragma unroll
        for (int kk = 0; kk < 16; ++kk) { float a[4], b[4];
#pragma unroll
            for (int i = 0; i < 4; ++i) { a[i] = As[kk][ty * 4 + i]; b[i] = Bs[kk][tx * 4 + i]; }
#pragma unroll
            for (int i = 0; i < 4; ++i)
#pragma unroll
                for (int j = 0; j < 4; ++j) acc[i][j] = fmaf(a[i], b[j], acc[i][j]); }
        __syncthreads();
    }
#pragma unroll
    for (int i = 0; i < 4; ++i)
#pragma unroll
        for (int j = 0; j < 4; ++j) { const int r = m0 + ty * 4 + i, c = n0 + tx * 4 + j; if (r < M && c < N) C[(size_t)r * ldc + c] = acc[i][j]; }
}

__global__ void k_prep(const int* __restrict__ positions, const float* __restrict__ lam_vecs, float2* __restrict__ rope, float* __restrict__ scal, unsigned* __restrict__ ctl) {
    const int gid = blockIdx.x * blockDim.x + threadIdx.x;
    if (gid < T * 32) { const int t = gid >> 5, i = gid & 31;
        const float inv = powf(10000.0f, -(float)i * (2.0f / 64.0f)); const float ang = (float)positions[t] * inv;
        const double a = (double)ang; rope[gid] = make_float2((float)cos(a), (float)sin(a)); }
    if (gid < 16384) ctl[gid] = 0u;
    if (gid == 0) { float s01 = 0.f, s23 = 0.f; for (int i = 0; i < 64; ++i) { s01 += lam_vecs[i] * lam_vecs[64 + i]; s23 += lam_vecs[128 + i] * lam_vecs[192 + i]; }
        scal[0] = expf(s01) - expf(s23) + LAMBDA_INIT; }
}
__global__ void post_qk(const float* __restrict__ tmp, const float2* __restrict__ rope, bf16_t* __restrict__ out, int m0, int Mc, float scale) {
    const int gid = blockIdx.x * blockDim.x + threadIdx.x; if (gid >= Mc * 512) return;
    const int r = gid >> 9, p = gid & 511, hm = p >> 5, i = p & 31; const int t = m0 + r;
    const float t1 = tmp[(size_t)r * 1024 + hm * 64 + i], t2 = tmp[(size_t)r * 1024 + hm * 64 + i + 32]; const float2 cs = rope[t * 32 + i];
    out[(size_t)t * 1024 + hm * 64 + qk_pos_of_d(i)] = f2bf((t1 * cs.x - t2 * cs.y) * scale);
    out[(size_t)t * 1024 + hm * 64 + qk_pos_of_d(i + 32)] = f2bf((t2 * cs.x + t1 * cs.y) * scale);
}
__global__ void post_plain(const float* __restrict__ tmp, bf16_t* __restrict__ out, int ldo, int coloff, int m0, int Mc, int N, const float* __restrict__ colscale) {
    const int gid = blockIdx.x * blockDim.x + threadIdx.x; if (gid >= Mc * N) return;
    const int r = gid / N, c = gid % N; float v = tmp[(size_t)r * N + c]; if (colscale) v *= colscale[c];
    out[(size_t)(m0 + r) * ldo + coloff + c] = f2bf(v);
}
__global__ void post_gate(const float* __restrict__ tmp, const float* __restrict__ bias, bf16_t* __restrict__ gates, int coloff, int m0, int Mc) {
    const int gid = blockIdx.x * blockDim.x + threadIdx.x; if (gid >= Mc * 1024) return;
    const int r = gid >> 10, c = gid & 1023; const float v = tmp[(size_t)r * 1024 + c] + bias[coloff + c];
    gates[(size_t)(m0 + r) * 2048 + coloff + c] = f2bf(1.f / (1.f + expf(-v)));
}
__global__ __launch_bounds__(64) void nattn(const bf16_t* __restrict__ q, const bf16_t* __restrict__ k, const bf16_t* __restrict__ v, const float* __restrict__ scal, float* __restrict__ tmp, int m0) {
    const int lane = threadIdx.x; const int blk = blockIdx.x;
    const int half = blk & 1, head = (blk >> 1) & 7, cg = blk >> 4; const int t0 = m0 + cg * 64, t = t0 + lane; const int b = t0 / SEQ, s0 = t0 % SEQ; const int nkeys = ((s0 >> 6) + 1) * 64;
    const float lam = scal[0];
    float res[64];
    for (int mp = 0; mp < 2; ++mp) {
        const int hm = head * 2 + mp; float qv[64];
#pragma unroll
        for (int d = 0; d < 64; ++d) qv[d] = bf2f(q[(size_t)t * 1024 + hm * 64 + d]);
        float mx = -1e30f, l = 0.f; float o[64];
#pragma unroll
        for (int d = 0; d < 64; ++d) o[d] = 0.f;
        for (int j = 0; j < nkeys; ++j) { const size_t kr = (size_t)(b * SEQ + j) * 1024; float sc = 0.f;
            const uint4* kp = (const uint4*)(k + kr + hm * 64); const uint4* vp = (const uint4*)(v + kr + head * 128 + half * 64);
#pragma unroll
            for (int c = 0; c < 8; ++c) { const uint4 w = kp[c]; const unsigned ww[4] = {w.x, w.y, w.z, w.w};
#pragma unroll
                for (int e = 0; e < 4; ++e) { sc = fmaf(qv[c * 8 + 2 * e], __uint_as_float(ww[e] << 16), sc); sc = fmaf(qv[c * 8 + 2 * e + 1], __uint_as_float(ww[e] & 0xffff0000u), sc); } }
            const float mn = fmaxf(mx, sc), al = exp2f(mx - mn), p = exp2f(sc - mn); mx = mn; l = l * al + p;
#pragma unroll
            for (int c = 0; c < 8; ++c) { const uint4 w = vp[c]; const unsigned ww[4] = {w.x, w.y, w.z, w.w};
#pragma unroll
                for (int e = 0; e < 4; ++e) { o[c * 8 + 2 * e] = fmaf(p, __uint_as_float(ww[e] << 16), o[c * 8 + 2 * e] * al); o[c * 8 + 2 * e + 1] = fmaf(p, __uint_as_float(ww[e] & 0xffff0000u), o[c * 8 + 2 * e + 1] * al); } } }
        const float il = 1.f / l;
#pragma unroll
        for (int d = 0; d < 64; ++d) res[d] = (mp == 0) ? o[d] * il : res[d] - lam * o[d] * il;
    }
#pragma unroll
    for (int d = 0; d < 64; ++d) tmp[(size_t)(t - m0) * 1024 + head * 128 + half * 64 + d] = res[d];
}
__global__ void post_rms(const float* __restrict__ tmp, const float* __restrict__ gain, bf16_t* __restrict__ on, int m0, int Mc) {
    const int gid = blockIdx.x * blockDim.x + threadIdx.x; if (gid >= Mc * 8) return;
    const int r = gid >> 3, head = gid & 7; const float* p = tmp + (size_t)r * 1024 + head * 128; float ss = 0.f;
    for (int d = 0; d < 128; ++d) ss += p[d] * p[d];
    const float rs = 1.0f / sqrtf(ss * (1.f / 128.f) + RMS_EPS);
    for (int d = 0; d < 128; ++d) on[(size_t)(m0 + r) * 1024 + head * 128 + d] = f2bf(p[d] * rs * gain[d] * (1.f - LAMBDA_INIT));
}
__global__ void post_merge(const float* __restrict__ tmp, const bf16_t* __restrict__ gates, bf16_t* __restrict__ merged, int br, int m0, int Mc) {
    const int gid = blockIdx.x * blockDim.x + threadIdx.x; if (gid >= Mc * 1024) return;
    const int r = gid >> 10, c = gid & 1023; const size_t t = m0 + r; const float g = bf2f(gates[t * 2048 + br * 1024 + c]);
    float val = g * tmp[(size_t)r * 1024 + c]; if (br) val += bf2f(merged[t * 1024 + c]);
    merged[t * 1024 + c] = f2bf(val);
}
__global__ void post_y(const float* __restrict__ tmp, const float* __restrict__ x, float* __restrict__ y, int m0, int Mc) {
    const int gid = blockIdx.x * blockDim.x + threadIdx.x; if (gid >= Mc * 1024) return;
    const size_t o = (size_t)m0 * 1024 + gid; y[o] = ALPHA * x[o] + tmp[gid];
}
__device__ __forceinline__ float wave_sum(float v) {
#pragma unroll
    for (int o = 1; o < 64; o <<= 1) v += __shfl_xor(v, o);
    return v;
}
__global__ __launch_bounds__(256) void k_router(const float* __restrict__ y, const float* __restrict__ g1, const float* __restrict__ b1, const float* __restrict__ wrg, const float* __restrict__ brg,
                                                const float* __restrict__ wre, const float* __restrict__ bre, bf16_t* __restrict__ x1b, float2* __restrict__ stats, int2* __restrict__ rexp, float2* __restrict__ rw,
                                                int* __restrict__ list, unsigned* __restrict__ cnt) {
    const int lane = threadIdx.x & 63; const int t = blockIdx.x * 4 + (threadIdx.x >> 6);
    const float* yr = y + (size_t)t * 1024; float xv[16]; float s = 0.f;
#pragma unroll
    for (int j = 0; j < 4; ++j) { const f32x4 vv = *(const f32x4*)(yr + j * 256 + lane * 4); xv[4 * j] = vv.x; xv[4 * j + 1] = vv.y; xv[4 * j + 2] = vv.z; xv[4 * j + 3] = vv.w; s += (vv.x + vv.y) + (vv.z + vv.w); }
    const float mu = wave_sum(s) * (1.f / 1024.f); float s2 = 0.f;
#pragma unroll
    for (int i = 0; i < 16; ++i) { const float d = xv[i] - mu; s2 += d * d; }
    const float rstd = 1.0f / sqrtf(wave_sum(s2) * (1.f / 1024.f) + LN_EPS);
    if (lane == 0) stats[t] = make_float2(mu, rstd);
#pragma unroll
    for (int j = 0; j < 4; ++j)
#pragma unroll
        for (int i = 0; i < 4; ++i) { const int c = j * 256 + lane * 4 + i; xv[4 * j + i] = (xv[4 * j + i] - mu) * rstd * g1[c] + b1[c]; }
#pragma unroll
    for (int j = 0; j < 4; ++j) { uint2 w; w.x = (unsigned)f2bf(xv[4 * j]) | ((unsigned)f2bf(xv[4 * j + 1]) << 16); w.y = (unsigned)f2bf(xv[4 * j + 2]) | ((unsigned)f2bf(xv[4 * j + 3]) << 16);
        *(uint2*)(x1b + (size_t)t * 1024 + j * 256 + lane * 4) = w; }
    float lg[4], le[32];
#pragma unroll
    for (int o = 0; o < 4; ++o) { float a = 0.f;
#pragma unroll
        for (int j = 0; j < 4; ++j)
#pragma unroll
            for (int i = 0; i < 4; ++i) a = fmaf(xv[4 * j + i], wrg[(size_t)(j * 256 + lane * 4 + i) * 4 + o], a);
        lg[o] = wave_sum(a) + brg[o]; }
#pragma unroll
    for (int o = 0; o < 32; ++o) { float a = 0.f;
#pragma unroll
        for (int j = 0; j < 4; ++j)
#pragma unroll
            for (int i = 0; i < 4; ++i) a = fmaf(xv[4 * j + i], wre[(size_t)(j * 256 + lane * 4 + i) * 32 + o], a);
        le[o] = wave_sum(a) + bre[o]; }
    if (lane == 0) {
        int gi = 0; float gm = lg[0];
#pragma unroll
        for (int o = 1; o < 4; ++o) if (lg[o] > gm) { gm = lg[o]; gi = o; }
        float gs = 0.f;
#pragma unroll
        for (int o = 0; o < 4; ++o) gs += expf(lg[o] - gm);
        const float gp = 1.f / gs;
        float ev[8];
#pragma unroll
        for (int o = 0; o < 8; ++o) { float vsel = le[o];
#pragma unroll
            for (int g = 1; g < 4; ++g) vsel = (gi == g) ? le[g * 8 + o] : vsel;
            ev[o] = vsel; }
        int i0 = 0; float m0v = ev[0];
#pragma unroll
        for (int o = 1; o < 8; ++o) if (ev[o] > m0v) { m0v = ev[o]; i0 = o; }
        int i1 = (i0 == 0) ? 1 : 0; float m1v = -3.4e38f;
#pragma unroll
        for (int o = 0; o < 8; ++o) if (o != i0 && ev[o] > m1v) { m1v = ev[o]; i1 = o; }
        const float e1 = expf(m1v - m0v); const float w0 = gp / (1.f + e1), w1 = gp * e1 / (1.f + e1);
        const int ex0 = gi * 8 + i0, ex1 = gi * 8 + i1;
        rexp[t] = make_int2(ex0, ex1); rw[t] = make_float2(w0, w1);
        const unsigned p0 = atomicAdd(&cnt[ex0], 1u); list[(size_t)ex0 * T + p0] = t * 2;
        const unsigned p1 = atomicAdd(&cnt[ex1], 1u); list[(size_t)ex1 * T + p1] = t * 2 + 1;
    }
}
__global__ __launch_bounds__(256) void nmoe_gu(const bf16_t* __restrict__ x1b, const int* __restrict__ list, const unsigned* __restrict__ cnt, const float* __restrict__ wgu, bf16_t* __restrict__ h) {
    __shared__ float As[16][68]; __shared__ float Bg[16][68]; __shared__ float Bu[16][68]; __shared__ int toks[64];
    const int e = blockIdx.z; const int M = (int)cnt[e]; const int m0 = blockIdx.y * 64, n0 = blockIdx.x * 64; if (m0 >= M) return;
    int tb = 0; for (int i = 0; i < e; ++i) tb += ((int)cnt[i] + 255) >> 8;
    const int tid = threadIdx.x, tx = tid & 15, ty = tid >> 4;
    if (tid < 64) toks[tid] = (m0 + tid < M) ? (list[(size_t)e * T + m0 + tid] >> 1) : 0;
    __syncthreads();
    const float* W = wgu + (size_t)e * 1024 * 1024; float ag[4][4] = {}, au[4][4] = {};
    for (int k0 = 0; k0 < 1024; k0 += 16) {
#pragma unroll
        for (int i = 0; i < 4; ++i) { const int el = tid + i * 256; const int r = el >> 4, kk = el & 15; As[kk][r] = bf2f(x1b[(size_t)toks[r] * 1024 + k0 + kk]); }
#pragma unroll
        for (int i = 0; i < 4; ++i) { const int el = tid + i * 256; const int kk = el >> 6, c = el & 63; Bg[kk][c] = W[(size_t)(k0 + kk) * 1024 + n0 + c]; Bu[kk][c] = W[(size_t)(k0 + kk) * 1024 + 512 + n0 + c]; }
        __syncthreads();
#pragma unroll
        for (int kk = 0; kk < 16; ++kk) { float a[4], bg[4], bu[4];
#pragma unroll
            for (int i = 0; i < 4; ++i) { a[i] = As[kk][ty * 4 + i]; bg[i] = Bg[kk][tx * 4 + i]; bu[i] = Bu[kk][tx * 4 + i]; }
#pragma unroll
            for (int i = 0; i < 4; ++i)
#pragma unroll
                for (int j = 0; j < 4; ++j) { ag[i][j] = fmaf(a[i], bg[j], ag[i][j]); au[i][j] = fmaf(a[i], bu[j], au[i][j]); } }
        __syncthreads();
    }
#pragma unroll
    for (int i = 0; i < 4; ++i)
#pragma unroll
        for (int j = 0; j < 4; ++j) { const int r = m0 + ty * 4 + i, c = n0 + tx * 4 + j; if (r < M) { const float g = ag[i][j]; h[((size_t)tb * 256 + r) * 512 + c] = f2bf(g / (1.f + expf(-g)) * au[i][j]); } }
}
__global__ __launch_bounds__(256) void nmoe_dn(const bf16_t* __restrict__ h, const int* __restrict__ list, const unsigned* __restrict__ cnt, const float2* __restrict__ rw, const float* __restrict__ wdn, bf16_t* __restrict__ ybuf) {
    __shared__ float As[16][68]; __shared__ float Bs[16][68];
    const int e = blockIdx.z; const int M = (int)cnt[e]; const int m0 = blockIdx.y * 64, n0 = blockIdx.x * 64; if (m0 >= M) return;
    int tb = 0; for (int i = 0; i < e; ++i) tb += ((int)cnt[i] + 255) >> 8;
    const int tid = threadIdx.x, tx = tid & 15, ty = tid >> 4;
    const float* W = wdn + (size_t)e * 512 * 1024; float acc[4][4] = {};
    for (int k0 = 0; k0 < 512; k0 += 16) {
#pragma unroll
        for (int i = 0; i < 4; ++i) { const int el = tid + i * 256; const int r = el >> 4, kk = el & 15; As[kk][r] = (m0 + r < M) ? bf2f(h[((size_t)tb * 256 + m0 + r) * 512 + k0 + kk]) : 0.f; }
#pragma unroll
        for (int i = 0; i < 4; ++i) { const int el = tid + i * 256; const int kk = el >> 6, c = el & 63; Bs[kk][c] = W[(size_t)(k0 + kk) * 1024 + n0 + c]; }
        __syncthreads();
#pragma unroll
        for (int kk = 0; kk < 16; ++kk) { float a[4], b[4];
#pragma unroll
            for (int i = 0; i < 4; ++i) { a[i] = As[kk][ty * 4 + i]; b[i] = Bs[kk][tx * 4 + i]; }
#pragma unroll
            for (int i = 0; i < 4; ++i)
#pragma unroll
                for (int j = 0; j < 4; ++j) acc[i][j] = fmaf(a[i], b[j], acc[i][j]); }
        __syncthreads();
    }
#pragma unroll
    for (int i = 0; i < 4; ++i) { const int r = m0 + ty * 4 + i; if (r < M) { const int ent = list[(size_t)e * T + r]; const float2 w2 = rw[ent >> 1]; const float w = (ent & 1) ? w2.y : w2.x;
#pragma unroll
        for (int j = 0; j < 4; ++j) ybuf[(size_t)ent * 1024 + n0 + tx * 4 + j] = f2bf(w * acc[i][j]); } }
}
__global__ __launch_bounds__(256) void k_final(float* __restrict__ yout, const float2* __restrict__ stats, const float* __restrict__ g1, const float* __restrict__ b1, const bf16_t* __restrict__ ybuf,
                                               const float* __restrict__ g2, const float* __restrict__ b2) {
    const int lane = threadIdx.x & 63; const int t = blockIdx.x * 4 + (threadIdx.x >> 6);
    float* yr = yout + (size_t)t * 1024; const float2 st = stats[t]; float xv[16]; float s = 0.f;
#pragma unroll
    for (int j = 0; j < 4; ++j) { const int c0 = j * 256 + lane * 4; const f32x4 vv = *(const f32x4*)(yr + c0); const f32x4 gg = *(const f32x4*)(g1 + c0); const f32x4 bb = *(const f32x4*)(b1 + c0);
        const uint2 a = *(const uint2*)(ybuf + (size_t)(2 * t) * 1024 + c0); const uint2 b = *(const uint2*)(ybuf + (size_t)(2 * t + 1) * 1024 + c0);
        const float ya[4] = {__uint_as_float(a.x << 16), __uint_as_float(a.x & 0xffff0000u), __uint_as_float(a.y << 16), __uint_as_float(a.y & 0xffff0000u)};
        const float yb[4] = {__uint_as_float(b.x << 16), __uint_as_float(b.x & 0xffff0000u), __uint_as_float(b.y << 16), __uint_as_float(b.y & 0xffff0000u)};
#pragma unroll
        for (int i = 0; i < 4; ++i) { const float x1 = (vv[i] - st.x) * st.y * gg[i] + bb[i]; const float val = ALPHA * x1 + (ya[i] + yb[i]); xv[4 * j + i] = val; s += val; } }
    const float mu = wave_sum(s) * (1.f / 1024.f); float s2 = 0.f;
#pragma unroll
    for (int i = 0; i < 16; ++i) { const float d = xv[i] - mu; s2 += d * d; }
    const float rstd = 1.0f / sqrtf(wave_sum(s2) * (1.f / 1024.f) + LN_EPS);
#pragma unroll
    for (int j = 0; j < 4; ++j) { const int c0 = j * 256 + lane * 4; const f32x4 gg = *(const f32x4*)(g2 + c0); const f32x4 bb = *(const f32x4*)(b2 + c0); f32x4 o;
#pragma unroll
        for (int i = 0; i < 4; ++i) o[i] = (xv[4 * j + i] - mu) * rstd * gg[i] + bb[i];
        *(f32x4*)(yr + c0) = o; }
}

#define LAS __attribute__((address_space(3)))
#define GAS __attribute__((address_space(1)))
typedef short bf16x8 __attribute__((ext_vector_type(8)));
typedef unsigned u32x4 __attribute__((ext_vector_type(4)));
typedef unsigned u32x2 __attribute__((ext_vector_type(2)));
typedef GAS unsigned gu32;
#define RLX_AGENT __ATOMIC_RELAXED, __HIP_MEMORY_SCOPE_AGENT
#define LDS_WAIT() asm volatile("s_waitcnt lgkmcnt(0)" ::: "memory")
#define VM_WAIT() asm volatile("s_waitcnt vmcnt(0)" ::: "memory")

constexpr size_t WT_IN = 0;
constexpr size_t WT_A  = WT_IN + (size_t)INW * 1024;
constexpr size_t WT_B  = WT_A + 1024 * 1024;
constexpr size_t WT_O  = WT_B + 1024 * 512;
constexpr size_t WT_GU = WT_O + 1024 * 1024;
constexpr size_t WT_DN = WT_GU + (size_t)NE * 1024 * 1024;
constexpr size_t WT_END = WT_DN + (size_t)NE * 1024 * 512;
static_assert(WT_END * 2 <= 112 * MiB, "weight copies fit");
constexpr size_t MS_WPOOL = 7 * MiB;
constexpr size_t MS_WP = 7 * MiB + 512 * 1024;
constexpr size_t MS_CSBW = 6 * MiB + 1024;
constexpr size_t WS_POOLED = 448 * MiB;

constexpr int CW_CNT = 0;
constexpr int CW_BAR = 1024;
constexpr int CW_TDONE = 12288;

constexpr int NWAVES = 8, NTHREADS = 512;
constexpr int RING_BYTES = 131072, LDS_CTL_OFF = 147456, MISC_OFF = LDS_CTL_OFF + 320, LDS_BYTES = 163840;

typedef float f32x2_t __attribute__((ext_vector_type(2))); typedef __bf16 bf16x2_t __attribute__((ext_vector_type(2)));
__device__ __forceinline__ unsigned cvt_pk_bf16(float lo, float hi) { f32x2_t v = {lo, hi}; bf16x2_t b = __builtin_convertvector(v, bf16x2_t); return __builtin_bit_cast(unsigned, b); }
__device__ __forceinline__ float bflo(unsigned w) { return __uint_as_float(w << 16); }
__device__ __forceinline__ float bfhi(unsigned w) { return __uint_as_float(w & 0xffff0000u); }

#define XB_TMO      128
#define XB_XCNT(j)  (256  + 64 * (j))
#define XB_XSUB(j)  (1280 + 64 * (j))
#define XB_XGEN(j)  (2304 + 64 * (j))
#define XB_TOP      3328
#define XB_TOPGEN   3392
#define XCD_BAR_WORDS 3456
#define XB_SPIN_CAP (1u << 22)
__device__ __forceinline__ unsigned xb_ld(unsigned* p)              { return __hip_atomic_load(p, __ATOMIC_RELAXED, __HIP_MEMORY_SCOPE_AGENT); }
__device__ __forceinline__ unsigned xb_add(unsigned* p, unsigned v) { return __hip_atomic_fetch_add(p, v, __ATOMIC_RELAXED, __HIP_MEMORY_SCOPE_AGENT); }
__device__ __forceinline__ unsigned xb_xcc_id() { return (unsigned)__builtin_amdgcn_s_getreg((3 << 11) | 20) & 0xFu; }
#define XB_SPIN(cond, bar) do { unsigned _sp = 0; while (cond) { __builtin_amdgcn_s_sleep(1); \
    if ((++_sp & 255u) == 0u) { if (xb_ld(&(bar)[XB_TMO])) break; if (_sp > XB_SPIN_CAP) { atomicAdd(&(bar)[XB_TMO], 1u); break; } } } } while (0)
struct XcdBarrier { unsigned* bar; unsigned x; volatile LAS unsigned* st; };
__device__ __forceinline__ XcdBarrier xcd_barrier_post(unsigned* bar, volatile LAS unsigned* st) {
    XcdBarrier b; b.bar = bar; b.x = xb_xcc_id(); b.st = st;
    if (threadIdx.x == 0) (void)xb_add(&bar[XB_XCNT(b.x)], 1u);
    return b;
}
__device__ __forceinline__ void xcd_barrier_complete(unsigned* bar, unsigned x, unsigned& nloc, unsigned& nx) {
    const unsigned G = gridDim.x * gridDim.y * gridDim.z;
    unsigned sum, cnt, mine, sp = 0u;
    for (;;) {
        sum = 0u; cnt = 0u; mine = 0u;
#pragma unroll
        for (unsigned j = 0; j < 16; ++j) { const unsigned c = xb_ld(&bar[XB_XCNT(j)]); sum += c; cnt += (c > 0u) ? 1u : 0u; mine = (j == x) ? c : mine; }
        if (sum == G) break;
        __builtin_amdgcn_s_sleep(1);
        if ((++sp & 255u) == 0u) { if (xb_ld(&bar[XB_TMO])) break; if (sp > XB_SPIN_CAP) { atomicAdd(&bar[XB_TMO], 1u); break; } }
    }
    nloc = mine > 0u ? mine : 1u; nx = cnt > 0u ? cnt : 1u;
}
__device__ __forceinline__ void xcd_barrier(const XcdBarrier& b) {
    asm volatile("s_waitcnt vmcnt(0)" ::: "memory");
    __syncthreads();
    if (threadIdx.x == 0) {
        unsigned* bar = b.bar;
        __builtin_amdgcn_s_waitcnt(0);
        unsigned nloc = b.st[0], nx = b.st[1];
        if (nloc == 0u) { xcd_barrier_complete(bar, b.x, nloc, nx); b.st[0] = nloc; b.st[1] = nx; }
        const unsigned old = xb_add(&bar[XB_XSUB(b.x)], 1u);
        const unsigned gen = old / nloc;
        if (old + 1u == (gen + 1u) * nloc) {
            __builtin_amdgcn_fence(__ATOMIC_RELEASE, "agent");
            asm volatile("s_waitcnt vmcnt(0)" ::: "memory");
            const unsigned og = xb_add(&bar[XB_TOP], 1u);
            const unsigned tg = og / nx;
            if (og + 1u == (tg + 1u) * nx) xb_add(&bar[XB_TOPGEN], 1u);
            else XB_SPIN(xb_ld(&bar[XB_TOPGEN]) == tg, bar);
            __builtin_amdgcn_fence(__ATOMIC_ACQUIRE, "agent");
            xb_add(&bar[XB_XGEN(b.x)], 1u);
            asm volatile("s_waitcnt vmcnt(0)" ::: "memory");
        } else {
            XB_SPIN(xb_ld(&bar[XB_XGEN(b.x)]) == gen, bar);
            __builtin_amdgcn_fence(__ATOMIC_ACQUIRE, "agent");
            asm volatile("s_waitcnt vmcnt(0)" ::: "memory");
        }
    }
    __syncthreads();
}

namespace g8 {
constexpr int BM = 256, BK = 64, HALF = 128, HTB = HALF * BK * 2, NXCD = 8, WGM = 8;
__host__ __device__ __forceinline__ int lds_byte(int r, int c) { const int st = (r >> 4) * 2 + (c >> 5), rr = r & 15, cc = c & 31, ob = rr * 64 + cc * 2; return st * 1024 + (ob ^ (((ob >> 9) & 1) << 5)); }
__host__ __device__ __forceinline__ void stage_rc(int b, int& R, int& C) { const int st = b / 1024, sb = b % 1024, swz = sb ^ (((sb >> 9) & 1) << 5); R = (st >> 1) * 16 + swz / 64; C = (st & 1) * 32 + (swz % 64) / 2; }
__host__ __device__ __forceinline__ int perm32(int rho) { const int n = rho >> 4, i = rho & 15; return 8 * (i >> 2) + 4 * n + (i & 3); }

struct GUnit { const char* A; const char* B; int pm, pn, e, r0; };

struct DenseOrder {
    const char* Abase; const char* Bbase; int nM, nN, nwg, G, c; size_t tstep;
    __device__ void init(const void* A, const void* Bt, int M, int N, int K, int G_, int c_) { Abase = (const char*)A; Bbase = (const char*)Bt; nM = M / BM; nN = N / BM; nwg = nM * nN; G = G_; c = c_; tstep = (size_t)BM * K * 2; }
    __device__ bool next(int i, GUnit& u) const {
        const long L = (long)i * G + c; if (L >= nwg) return false;
        int wgid = (int)L; { const int q = nwg / NXCD, r = nwg % NXCD, xcd = wgid % NXCD, off = wgid / NXCD; wgid = (xcd < r ? xcd * (q + 1) : r * (q + 1) + (xcd - r) * q) + off; }
        const int nig = WGM * nN, gid = wgid / nig, fm = gid * WGM, gsz = (nM - fm) < WGM ? (nM - fm) : WGM;
        u.pm = fm + ((wgid % nig) % gsz); u.pn = (wgid % nig) / gsz; u.e = 0; u.r0 = 0;
        u.A = Abase + (size_t)u.pm * tstep; u.B = Bbase + (size_t)u.pn * tstep; return true;
    }
    __device__ __forceinline__ unsigned rowoff(const GUnit&, int) const { return 0u; }
    __device__ __forceinline__ void a_ready(const GUnit&) const {}
    __device__ __forceinline__ void done(const GUnit&) const {}
};
struct MoeOrder {
    const char* Abase; const char* Bbase; const int* list; const volatile LAS unsigned* tb; const volatile LAS unsigned* cntl; int nwg, G, c; size_t atile, bexp, btile; int gather;
    unsigned* tdone; int mode;
    __device__ bool next(int i, GUnit& u) const {
        const long L = (long)i * G + c; if (L >= nwg) return false;
        int wgid = (int)L; { const int q = nwg / NXCD, r = nwg % NXCD, xcd = wgid % NXCD, off = wgid / NXCD; wgid = (xcd < r ? xcd * (q + 1) : r * (q + 1) + (xcd - r) * q) + off; }
        const int tile = wgid >> 2; u.pn = wgid & 3; u.pm = tile;
        int e = 0; for (int j = 1; j < NE; ++j) e = ((int)tb[j] <= tile) ? j : e;
        e = __builtin_amdgcn_readfirstlane(e); u.e = e; u.r0 = __builtin_amdgcn_readfirstlane((tile - (int)tb[e]) * 256);
        u.A = gather ? Abase : Abase + (size_t)tile * atile; u.B = Bbase + (size_t)e * bexp + (size_t)u.pn * btile; return true;
    }
    __device__ __forceinline__ unsigned rowoff(const GUnit& u, int rr) const {
        const int p = u.r0 + rr; const int tok = (p < (int)cntl[u.e]) ? (list[(size_t)u.e * T + p] >> 1) : 0; return (unsigned)tok * 2048u; }
    __device__ __forceinline__ void done(const GUnit& u) const {
        if (mode == 1) { asm volatile("s_waitcnt vmcnt(0)" ::: "memory"); if ((threadIdx.x & 63) == 0) __hip_atomic_fetch_add(tdone + u.pm, 1u, __ATOMIC_RELAXED, __HIP_MEMORY_SCOPE_AGENT); } }
    __device__ __forceinline__ void a_ready(const GUnit& u) const {
        if (mode == 2) {
            if (threadIdx.x < 64) { unsigned sp = 0;
                while ((unsigned)__builtin_amdgcn_readfirstlane(__hip_atomic_load(tdone + u.pm, __ATOMIC_RELAXED, __HIP_MEMORY_SCOPE_AGENT)) < 32u) { __builtin_amdgcn_s_sleep(2); if (++sp > (1u << 22)) break; }
                __builtin_amdgcn_fence(__ATOMIC_ACQUIRE, "agent"); asm volatile("s_waitcnt vmcnt(0)" ::: "memory"); }
            asm volatile("" ::: "memory"); __builtin_amdgcn_s_barrier(); asm volatile("" ::: "memory"); } }
};

template <class Epi, class Sched, bool ALIGN_EPI, bool GATHER>
__device__ __forceinline__ void gemm_phase(LAS unsigned char* lds, const int K, const Sched& S, const Epi& E) {
    const int tid = threadIdx.x, wid = __builtin_amdgcn_readfirstlane(tid >> 6), lane = tid & 63, wr = wid >> 2, wc = wid & 3, fr = lane & 15, fq = lane >> 4;
    const int nt = K / BK;
    unsigned voffA[2], voffB[2]; int RA[2], CA[2];
#pragma unroll
    for (int i = 0; i < 2; ++i) { int R, C; stage_rc(tid * 16 + i * 8192, R, C); const int Rb = Epi::PERM ? ((R & ~31) + perm32(R & 31)) : R;
        voffA[i] = (unsigned)(R * K + C) * 2u; voffB[i] = (unsigned)(Rb * K + C) * 2u; RA[i] = R; CA[i] = C; }
    const size_t kstep = (size_t)(BK * 2);
    const size_t hstep = (size_t)HALF * K * 2;
    const unsigned ldsw = (unsigned)wid * 1024u;
    const int aoff = lds_byte(wr * 64 + fr, fq * 8), boff = lds_byte(wc * 32 + fr, fq * 8);
#define G8_SA(b, h) (((b) * 2 + (h)) * HTB)
#define G8_SB(b, h) ((4 + (b) * 2 + (h)) * HTB)
#define G8_STAGE(bufoff, gbase, o0, o1) do { \
        __builtin_amdgcn_global_load_lds((const unsigned*)((const char*)(gbase) + (o0)), (LAS unsigned*)(lds + (bufoff) + ldsw), 16, 0, 0); \
        __builtin_amdgcn_global_load_lds((const unsigned*)((const char*)(gbase) + (o1)), (LAS unsigned*)(lds + (bufoff) + ldsw + 8192), 16, 0, 0); } while (0)
#define G8_STAGE_B(bufoff, gbase) G8_STAGE(bufoff, gbase, voffB[0], voffB[1])
#define G8_LDA(dst, b, h) do { _Pragma("unroll") for (int m = 0; m < 4; ++m) _Pragma("unroll") for (int k = 0; k < 2; ++k) dst[m][k] = *(const LAS bf16x8*)(lds + G8_SA(b, h) + aoff + m * 2048 + k * 1024); } while (0)
#define G8_LDB(dst, b, h) do { _Pragma("unroll") for (int n = 0; n < 2; ++n) _Pragma("unroll") for (int k = 0; k < 2; ++k) dst[n][k] = *(const LAS bf16x8*)(lds + G8_SB(b, h) + boff + n * 2048 + k * 1024); } while (0)
#define G8_MMA(ai, bj, At, Bt) do { __builtin_amdgcn_s_setprio(1); _Pragma("unroll") for (int m = 0; m < 4; ++m) _Pragma("unroll") for (int n = 0; n < 2; ++n) _Pragma("unroll") for (int k = 0; k < 2; ++k) \
        acc[ai][bj][m][n] = __builtin_amdgcn_mfma_f32_16x16x32_bf16(Bt[n][k], At[m][k], acc[ai][bj][m][n], 0, 0, 0); __builtin_amdgcn_s_setprio(0); } while (0)
#ifdef G8_DRAIN
#define G8_WAIT_V(n) asm volatile("s_waitcnt vmcnt(0)" ::: "memory")
#else
#define G8_WAIT_V(n) asm volatile("s_waitcnt vmcnt(" #n ")" ::: "memory")
#endif
#define G8_WAIT_L(n) asm volatile("s_waitcnt lgkmcnt(" #n ")" ::: "memory")
#define G8_BAR __builtin_amdgcn_s_barrier()
#define G8_SCHED __builtin_amdgcn_sched_barrier(0)
    GUnit cur, nxt; int ui = 0;
    if (!S.next(0, cur)) return;
    unsigned cao[2][2], nao[2][2];
#pragma unroll
    for (int h = 0; h < 2; ++h)
#pragma unroll
        for (int i = 0; i < 2; ++i) { cao[h][i] = GATHER ? S.rowoff(cur, h * HALF + RA[i]) + (unsigned)CA[i] * 2u : voffA[i] + (unsigned)(h * hstep); nao[h][i] = cao[h][i]; }
    f32x4 acc[2][2][4][2];
#pragma unroll
    for (int a = 0; a < 2; ++a)
#pragma unroll
        for (int b = 0; b < 2; ++b)
#pragma unroll
            for (int m = 0; m < 4; ++m)
#pragma unroll
                for (int n = 0; n < 2; ++n) acc[a][b][m][n] = (f32x4){0.f, 0.f, 0.f, 0.f};
    bf16x8 At[4][2], B0[2][2], B1[2][2];
    const char* cA = cur.A; const char* cB = cur.B;
    S.a_ready(cur);
    G8_STAGE_B(G8_SB(0, 0), cB); G8_STAGE_B(G8_SB(0, 1), cB + hstep); G8_STAGE(G8_SA(0, 0), cA, cao[0][0], cao[0][1]); G8_STAGE(G8_SA(0, 1), cA, cao[1][0], cao[1][1]);
    if (wr == 1) G8_BAR;
    G8_WAIT_V(2); G8_BAR;
    G8_STAGE_B(G8_SB(1, 0), cB + kstep); G8_STAGE(G8_SA(1, 0), cA + kstep, cao[0][0], cao[0][1]); G8_STAGE_B(G8_SB(1, 1), cB + hstep + kstep);
    G8_WAIT_V(6); G8_BAR;
    for (;;) {
        const bool has_next = S.next(ui + 1, nxt);
        if (GATHER && has_next) {
#pragma unroll
            for (int h = 0; h < 2; ++h)
#pragma unroll
                for (int i = 0; i < 2; ++i) nao[h][i] = S.rowoff(nxt, h * HALF + RA[i]) + (unsigned)CA[i] * 2u;
        }
        const char* nA = has_next ? nxt.A : cA; const char* nB = has_next ? nxt.B : cB;
        for (int t = 0; t < nt; t += 2) {
            const bool last = (t == nt - 2);
            if (last && has_next) S.a_ready(nxt);
            const char* a1 = cA + (size_t)(t + 1) * kstep;
            const char* a2 = last ? nA : cA + (size_t)(t + 2) * kstep; const char* b2 = last ? nB : cB + (size_t)(t + 2) * kstep;
            const char* a3 = a2 + kstep; const char* b3 = b2 + kstep;
            asm volatile("" : "+s"(a1), "+s"(a2), "+s"(b2), "+s"(a3), "+s"(b3));
            unsigned o2[2][2];
#pragma unroll
            for (int h = 0; h < 2; ++h)
#pragma unroll
                for (int i = 0; i < 2; ++i) o2[h][i] = (GATHER && last && has_next) ? nao[h][i] : cao[h][i];
            G8_LDB(B0, 0, 0); G8_LDB(B1, 0, 1); G8_SCHED; G8_LDA(At, 0, 0); G8_STAGE(G8_SA(1, 1), a1, cao[1][0], cao[1][1]);
            G8_WAIT_V(8); G8_WAIT_L(0); G8_BAR; G8_MMA(0, 0, At, B0); G8_MMA(0, 1, At, B1); G8_BAR; G8_SCHED;
            G8_LDA(At, 0, 1); G8_STAGE_B(G8_SB(0, 0), b2); G8_STAGE_B(G8_SB(0, 1), b2 + hstep); G8_STAGE(G8_SA(0, 0), a2, o2[0][0], o2[0][1]);
            G8_WAIT_V(8); G8_WAIT_L(0); G8_BAR; G8_MMA(1, 0, At, B0); G8_MMA(1, 1, At, B1); G8_BAR; G8_SCHED;
            G8_LDB(B0, 1, 0); G8_LDB(B1, 1, 1); G8_SCHED; G8_LDA(At, 1, 0); G8_STAGE(G8_SA(0, 1), a2, o2[1][0], o2[1][1]);
            G8_WAIT_V(8); G8_WAIT_L(0); G8_BAR; G8_MMA(0, 0, At, B0); G8_MMA(0, 1, At, B1); G8_BAR; G8_SCHED;
            G8_LDA(At, 1, 1); G8_STAGE_B(G8_SB(1, 0), b3); G8_STAGE_B(G8_SB(1, 1), b3 + hstep); G8_STAGE(G8_SA(1, 0), a3, o2[0][0], o2[0][1]);
            G8_WAIT_V(8); G8_WAIT_L(0); G8_BAR; G8_MMA(1, 0, At, B0); G8_MMA(1, 1, At, B1); G8_BAR; G8_SCHED;
        }
        if constexpr (ALIGN_EPI) { if (wr == 0) G8_BAR; }
        {
          GUnit eu = cur; int fr_ = fr, fq_ = fq; asm volatile("" : "+s"(eu.pm), "+s"(eu.pn), "+s"(eu.e), "+s"(eu.r0)); asm volatile("" : "+v"(fr_), "+v"(fq_));
          E(acc, eu, wr, wc, fr_, fq_); S.done(cur); }
        if (!has_next) break;
#pragma unroll
        for (int a = 0; a < 2; ++a)
#pragma unroll
            for (int b = 0; b < 2; ++b)
#pragma unroll
                for (int m = 0; m < 4; ++m)
#pragma unroll
                    for (int n = 0; n < 2; ++n) acc[a][b][m][n] = (f32x4){0.f, 0.f, 0.f, 0.f};
        cur = nxt; cA = nA; cB = nB; ++ui;
#pragma unroll
        for (int h = 0; h < 2; ++h)
#pragma unroll
            for (int i = 0; i < 2; ++i) cao[h][i] = nao[h][i];
        if constexpr (ALIGN_EPI) { if (wr == 1) G8_BAR; }
    }
    G8_WAIT_V(0);
    if constexpr (!ALIGN_EPI) { if (wr == 0) G8_BAR; }
    G8_BAR;
#undef G8_SA
#undef G8_SB
#undef G8_STAGE
#undef G8_STAGE_B
#undef G8_LDA
#undef G8_LDB
#undef G8_MMA
#undef G8_WAIT_V
#undef G8_WAIT_L
#undef G8_BAR
#undef G8_SCHED
}

__device__ __forceinline__ u32x4 pack8(const f32x4 v0, const f32x4 v1) { u32x4 w; w.x = cvt_pk_bf16(v0[0], v0[1]); w.y = cvt_pk_bf16(v0[2], v0[3]); w.z = cvt_pk_bf16(v1[0], v1[1]); w.w = cvt_pk_bf16(v1[2], v1[3]); return w; }
__device__ __forceinline__ float sigmoidf_(float v) { return __builtin_amdgcn_rcpf(1.f + __builtin_amdgcn_exp2f(-1.4426950408889634f * v)); }

struct EpiProj {
    static constexpr bool PERM = true;
    bf16_t *qb, *kb, *vb, *ub, *gb; const float* rope; const float* gate_bias;
    __device__ __forceinline__ void operator()(const f32x4 (&acc)[2][2][4][2], const GUnit& u, int wr, int wc, int fr, int fq) const {
        const int row0 = u.pm * BM + wr * 64 + fr; const int cw = wc * 32 + 8 * fq; const int pn = u.pn;
#ifdef DBG_PLAIN_EPI
        if (pn < 8) { bf16_t* base = (pn < 4 ? qb : kb) + (pn & 3) * 256 + cw;
            for (int ai = 0; ai < 2; ++ai) for (int m = 0; m < 4; ++m) { const int t = row0 + ai * HALF + m * 16; for (int bj = 0; bj < 2; ++bj) *(u32x4*)(base + (size_t)t * 1024 + bj * HALF) = pack8(acc[ai][bj][m][0], acc[ai][bj][m][1]); } }
        else
#endif
        if (pn < 8) {
            bf16_t* base = (pn < 4 ? qb : kb) + (pn & 3) * 256 + cw; const float sc = pn < 4 ? QSCALE : 1.f; const int fi = 16 * (wc & 1) + 4 * fq;
#pragma unroll
            for (int ai = 0; ai < 2; ++ai)
#pragma unroll
                for (int m = 0; m < 4; ++m) { const int t = row0 + ai * HALF + m * 16; const f32x4 cs0 = *(const f32x4*)(rope + ((size_t)t * 32 + fi) * 2), cs1 = *(const f32x4*)(rope + ((size_t)t * 32 + fi) * 2 + 4);
                    const f32x4 c = {cs0[0], cs0[2], cs1[0], cs1[2]}, s = {cs0[1], cs0[3], cs1[1], cs1[3]};
#pragma unroll
                    for (int bj = 0; bj < 2; ++bj) { const f32x4 t1 = acc[ai][bj][m][0], t2 = acc[ai][bj][m][1]; const f32x4 o1 = (t1 * c - t2 * s) * sc, o2 = (t2 * c + t1 * s) * sc;
                        *(u32x4*)(base + (size_t)t * 1024 + bj * HALF) = pack8(o1, o2); } }
        } else if (pn < 14) {
            bf16_t* base; int ld; if (pn < 12) { base = vb + (pn - 8) * 256 + cw; ld = 1024; } else { base = ub + (pn - 12) * 256 + cw; ld = 512; }
#pragma unroll
            for (int ai = 0; ai < 2; ++ai)
#pragma unroll
                for (int m = 0; m < 4; ++m) { const int t = row0 + ai * HALF + m * 16;
#pragma unroll
                    for (int bj = 0; bj < 2; ++bj) *(u32x4*)(base + (size_t)t * ld + bj * HALF) = pack8(acc[ai][bj][m][0], acc[ai][bj][m][1]); }
        }
#ifdef DBG_PLAIN_EPI
        else { const int col0 = (pn - 14) * 256 + cw;
            for (int ai = 0; ai < 2; ++ai) for (int m = 0; m < 4; ++m) { const int t = row0 + ai * HALF + m * 16; for (int bj = 0; bj < 2; ++bj) *(u32x4*)(gb + (size_t)t * 2048 + col0 + bj * HALF) = pack8(acc[ai][bj][m][0], acc[ai][bj][m][1]); } }
#else
        else {
            const int col0 = (pn - 14) * 256 + cw; f32x4 bv[2][2];
#pragma unroll
            for (int bj = 0; bj < 2; ++bj)
#pragma unroll
                for (int n = 0; n < 2; ++n) bv[bj][n] = *(const f32x4*)(gate_bias + col0 + bj * HALF + 4 * n);
#pragma unroll
            for (int ai = 0; ai < 2; ++ai)
#pragma unroll
                for (int m = 0; m < 4; ++m) { const int t = row0 + ai * HALF + m * 16;
#pragma unroll
                    for (int bj = 0; bj < 2; ++bj) { f32x4 v0 = acc[ai][bj][m][0] + bv[bj][0], v1 = acc[ai][bj][m][1] + bv[bj][1];
#pragma unroll
                        for (int j = 0; j < 4; ++j) { v0[j] = sigmoidf_(v0[j]); v1[j] = sigmoidf_(v1[j]); }
                        *(u32x4*)(gb + (size_t)t * 2048 + col0 + bj * HALF) = pack8(v0, v1); } }
        }
#endif
    }
};
struct EpiScaleBf16 {
    static constexpr bool PERM = true;
    bf16_t* O; int ldc; const float* colscale;
    __device__ __forceinline__ void operator()(const f32x4 (&acc)[2][2][4][2], const GUnit& u, int wr, int wc, int fr, int fq) const {
        const int row0 = u.pm * BM + wr * 64 + fr, col0 = u.pn * BM + wc * 32 + 8 * fq; f32x4 sv[2][2];
#pragma unroll
        for (int bj = 0; bj < 2; ++bj)
#pragma unroll
            for (int n = 0; n < 2; ++n) sv[bj][n] = *(const f32x4*)(colscale + col0 + bj * HALF + 4 * n);
#pragma unroll
        for (int ai = 0; ai < 2; ++ai)
#pragma unroll
            for (int m = 0; m < 4; ++m) { bf16_t* rowp = O + (size_t)(row0 + ai * HALF + m * 16) * ldc + col0;
#pragma unroll
                for (int bj = 0; bj < 2; ++bj) *(u32x4*)(rowp + bj * HALF) = pack8(acc[ai][bj][m][0] * sv[bj][0], acc[ai][bj][m][1] * sv[bj][1]); }
    }
};
template <int BR> struct EpiMerge {
    static constexpr bool PERM = true;
    const bf16_t* gates; bf16_t* merged; bf16_t* dst;
    __device__ __forceinline__ void operator()(const f32x4 (&acc)[2][2][4][2], const GUnit& u, int wr, int wc, int fr, int fq) const {
        const int row0 = u.pm * BM + wr * 64 + fr, col0 = u.pn * BM + wc * 32 + 8 * fq;
#pragma unroll
        for (int ai = 0; ai < 2; ++ai)
#pragma unroll
            for (int m = 0; m < 4; ++m) { const size_t t = row0 + ai * HALF + m * 16;
#pragma unroll
                for (int bj = 0; bj < 2; ++bj) { const u32x4 g = *(const u32x4*)(gates + t * 2048 + BR * 1024 + col0 + bj * HALF); bf16_t* mp = merged + t * 1024 + col0 + bj * HALF;
                    f32x4 v0 = acc[ai][bj][m][0], v1 = acc[ai][bj][m][1];
                    v0 = v0 * (f32x4){bflo(g.x), bfhi(g.x), bflo(g.y), bfhi(g.y)}; v1 = v1 * (f32x4){bflo(g.z), bfhi(g.z), bflo(g.w), bfhi(g.w)};
                    if (BR) { const u32x4 p = *(const u32x4*)mp; v0 = v0 + (f32x4){bflo(p.x), bfhi(p.x), bflo(p.y), bfhi(p.y)}; v1 = v1 + (f32x4){bflo(p.z), bfhi(p.z), bflo(p.w), bfhi(p.w)}; }
                    *(u32x4*)(dst + t * 1024 + col0 + bj * HALF) = pack8(v0, v1); } }
    }
};
struct EpiResid {
    static constexpr bool PERM = false;
    const float* x; float* y; float2* part;
    __device__ __forceinline__ void operator()(const f32x4 (&acc)[2][2][4][2], const GUnit& u, int wr, int wc, int fr, int fq) const {
        const int row0 = u.pm * BM + wr * 64 + fr, col0 = u.pn * BM + wc * 32 + 4 * fq;
#pragma unroll
        for (int ai = 0; ai < 2; ++ai)
#pragma unroll
            for (int m = 0; m < 4; ++m) { const size_t row = (size_t)(row0 + ai * HALF + m * 16); const size_t off = row * 1024 + col0; float s1 = 0.f, s2 = 0.f;
#pragma unroll
                for (int bj = 0; bj < 2; ++bj)
#pragma unroll
                    for (int n = 0; n < 2; ++n) { const f32x4 xv = *(const f32x4*)(x + off + bj * HALF + n * 16); const f32x4 yv = xv * ALPHA + acc[ai][bj][m][n]; *(f32x4*)(y + off + bj * HALF + n * 16) = yv;
                        s1 += (yv[0] + yv[1]) + (yv[2] + yv[3]); s2 += (yv[0] * yv[0] + yv[1] * yv[1]) + (yv[2] * yv[2] + yv[3] * yv[3]); }
                s1 += __shfl_xor(s1, 16); s1 += __shfl_xor(s1, 32); s2 += __shfl_xor(s2, 16); s2 += __shfl_xor(s2, 32);
                if (fq == 0) part[row * 16 + u.pn * 4 + wc] = make_float2(s1, s2); }
    }
};
struct EpiGateUp {
    static constexpr bool PERM = true;
    bf16_t* h;
    __device__ __forceinline__ void operator()(const f32x4 (&acc)[2][2][4][2], const GUnit& u, int wr, int wc, int fr, int fq) const {
        const int row0 = u.pm * BM + wr * 64 + fr, col0 = u.pn * 128 + wc * 16 + 4 * fq;
#pragma unroll
        for (int ai = 0; ai < 2; ++ai)
#pragma unroll
            for (int m = 0; m < 4; ++m) { bf16_t* rowp = h + (size_t)(row0 + ai * HALF + m * 16) * 512 + col0;
#pragma unroll
                for (int bj = 0; bj < 2; ++bj) { const f32x4 g = acc[ai][bj][m][0], up = acc[ai][bj][m][1]; f32x4 o;
#pragma unroll
                    for (int j = 0; j < 4; ++j) o[j] = g[j] * sigmoidf_(g[j]) * up[j];
                    const unsigned long long w = (unsigned long long)cvt_pk_bf16(o[0], o[1]) | ((unsigned long long)cvt_pk_bf16(o[2], o[3]) << 32);
                    __hip_atomic_store((unsigned long long*)(rowp + bj * 64), w, __ATOMIC_RELAXED, __HIP_MEMORY_SCOPE_AGENT); } }
    }
};
struct EpiDown {
    static constexpr bool PERM = true;
    bf16_t* ybuf; const int* list; const float* rw; const volatile LAS unsigned* cntl;
    __device__ __forceinline__ void operator()(const f32x4 (&acc)[2][2][4][2], const GUnit& u, int wr, int wc, int fr, int fq) const {
        const int p0 = u.r0 + wr * 64 + fr, col0 = u.pn * BM + wc * 32 + 8 * fq; const int cn = (int)cntl[u.e];
#pragma unroll
        for (int ai = 0; ai < 2; ++ai)
#pragma unroll
            for (int m = 0; m < 4; ++m) { const int p = p0 + ai * HALF + m * 16;
                if (p < cn) { const int ent = list[(size_t)u.e * T + p]; const float w = rw[ent]; bf16_t* rowp = ybuf + (size_t)ent * 1024 + col0;
#pragma unroll
                    for (int bj = 0; bj < 2; ++bj) *(u32x4*)(rowp + bj * HALF) = pack8(acc[ai][bj][m][0] * w, acc[ai][bj][m][1] * w); } }
    }
};
}

namespace at2 {
using f32x16 = __attribute__((ext_vector_type(16))) float;
using s16x4  = __attribute__((ext_vector_type(4))) short;
constexpr int KB_BYTES = 8192, VB_BYTES = 16384, KSLOT = 2 * KB_BYTES, NKS = 4, NVS = 3, OFF_V = NKS * KSLOT;
constexpr int OFF_Q = OFF_V + NVS * VB_BYTES, OFF_WS = 151552;
#define AT_SBAR() __builtin_amdgcn_sched_barrier(0)
__device__ __forceinline__ int crow(int r, int hi) { return (r & 3) + 8 * (r >> 2) + 4 * hi; }
__device__ __forceinline__ int v_st(int k, int c) { const int kk = (k & ~0xC) | ((k & 4) << 1) | ((k & 8) >> 1); return ((kk >> 3) * 4 + (c >> 5)) * 512 + ((kk & 7) * 32 + (c & 31)) * 2; }
__device__ __forceinline__ int v_rd_base(int lane) { return ((lane & 3) << 3) | (((lane >> 2) & 3) << 6) | (((lane >> 4) & 1) << 5) | (((lane >> 5) & 1) << 8); }
constexpr int v_rd_off(int d0, int ks, int half) { return d0 * 512 + ks * 4096 + half * 2048; }
template <int OFF> __device__ __forceinline__ s16x4 tr_read(int vb) { s16x4 r; asm volatile("ds_read_b64_tr_b16 %0, %1 offset:%2" : "=&v"(r) : "v"(vb), "i"(OFF) : "memory"); return r; }
template <int D0> __device__ __forceinline__ void pv_one(f32x16& od, int vb, bf16x8 pa0, bf16x8 pa1, bf16x8 pa2, bf16x8 pa3) {
    const s16x4 l0 = tr_read<v_rd_off(D0, 0, 0)>(vb), h0 = tr_read<v_rd_off(D0, 0, 1)>(vb), l1 = tr_read<v_rd_off(D0, 1, 0)>(vb), h1 = tr_read<v_rd_off(D0, 1, 1)>(vb);
    const s16x4 l2 = tr_read<v_rd_off(D0, 2, 0)>(vb), h2 = tr_read<v_rd_off(D0, 2, 1)>(vb), l3 = tr_read<v_rd_off(D0, 3, 0)>(vb), h3 = tr_read<v_rd_off(D0, 3, 1)>(vb);
    asm volatile("s_waitcnt lgkmcnt(0)" ::: "memory"); AT_SBAR();
#define AT_PK(L, H) (bf16x8){L[0], L[1], L[2], L[3], H[0], H[1], H[2], H[3]}
    od = __builtin_amdgcn_mfma_f32_32x32x16_bf16(pa0, AT_PK(l0, h0), od, 0, 0, 0);
    od = __builtin_amdgcn_mfma_f32_32x32x16_bf16(pa1, AT_PK(l1, h1), od, 0, 0, 0);
    od = __builtin_amdgcn_mfma_f32_32x32x16_bf16(pa2, AT_PK(l2, h2), od, 0, 0, 0);
    od = __builtin_amdgcn_mfma_f32_32x32x16_bf16(pa3, AT_PK(l3, h3), od, 0, 0, 0);
#undef AT_PK
}
__device__ __forceinline__ void qkt(f32x16& p0, f32x16& p1, const LAS unsigned char* Ks, const bf16x8* qr, int r32, int hi) {
    p0 = f32x16{}; p1 = f32x16{};
#pragma unroll
    for (int d0 = 0; d0 < 4; ++d0) { const LAS unsigned char* kp = Ks + (2 * d0 + hi) * 1024 + r32 * 16;
        const bf16x8 b0 = *(const LAS bf16x8*)(kp), b1 = *(const LAS bf16x8*)(kp + 512);
        p0 = __builtin_amdgcn_mfma_f32_32x32x16_bf16(b0, qr[d0], p0, 0, 0, 0);
        p1 = __builtin_amdgcn_mfma_f32_32x32x16_bf16(b1, qr[d0], p1, 0, 0, 0); }
}
__device__ __forceinline__ float hswap_max(float v) { auto rr = __builtin_amdgcn_permlane32_swap(__float_as_uint(v), __float_as_uint(v), false, false); return fmaxf(__uint_as_float(rr[0]), __uint_as_float(rr[1])); }
__device__ __forceinline__ float hswap_sum(float v) { auto rr = __builtin_amdgcn_permlane32_swap(__float_as_uint(v), __float_as_uint(v), false, false); return __uint_as_float(rr[0]) + __uint_as_float(rr[1]); }

struct AtUnit { int b, head, qblk; };
struct AtAddr { const char* Kb; const char* Vb; unsigned kofs0, kofs1, vofs0, vofs1; };
__device__ __forceinline__ void at_addr(AtAddr& a, const AtUnit& un, int wid, int lane, const bf16_t* __restrict__ K, const bf16_t* __restrict__ V) {
    const int mp = wid >> 2, wq = wid & 3, hm = un.head * 2 + mp; const size_t rowbase = (size_t)un.b * SEQ;
    a.Kb = (const char*)(K + rowbase * 1024); a.Vb = (const char*)(V + rowbase * 1024);
    unsigned ko[2], vo[2];
#pragma unroll
    for (int i = 0; i < 2; ++i) { const int ch = 2 * wq + i; ko[i] = (unsigned)(lane * 2048 + hm * 128 + ch * 16);
        const int p = 2 * wid + i; const int kk = (p >> 1) * 8 + ((lane & 31) >> 2); const int k = (kk & ~0xC) | ((kk & 4) << 1) | ((kk & 8) >> 1); const int c = (2 * (p & 1) + (lane >> 5)) * 32 + (lane & 3) * 8;
        vo[i] = (unsigned)(k * 2048 + un.head * 256 + c * 2); }
    a.kofs0 = ko[0]; a.kofs1 = ko[1]; a.vofs0 = vo[0]; a.vofs1 = vo[1];
}
#define AT_DMA_K(AD, j, KO) do { const char* kj_ = (AD).Kb + (size_t)(j) * 131072; \
        __builtin_amdgcn_global_load_lds((const unsigned*)(kj_ + (AD).kofs0), (LAS unsigned*)(lds + (KO) + kdst), 16, 0, 0); __builtin_amdgcn_global_load_lds((const unsigned*)(kj_ + (AD).kofs1), (LAS unsigned*)(lds + (KO) + kdst + 1024), 16, 0, 0); } while (0)
#define AT_DMA_V(AD, j, VO) do { const char* vj_ = (AD).Vb + (size_t)(j) * 131072; \
        __builtin_amdgcn_global_load_lds((const unsigned*)(vj_ + (AD).vofs0), (LAS unsigned*)(lds + (VO) + vdst), 16, 0, 0); __builtin_amdgcn_global_load_lds((const unsigned*)(vj_ + (AD).vofs1), (LAS unsigned*)(lds + (VO) + vdst + 1024), 16, 0, 0); } while (0)
__device__ __forceinline__ void at_prefetch(LAS unsigned char* lds, const AtUnit& un, const bf16_t* __restrict__ Q, const bf16_t* __restrict__ K, const bf16_t* __restrict__ V, bf16x8 (&qr)[4]) {
    const int tid = threadIdx.x, lane = tid & 63, r32 = lane & 31, hi = lane >> 5; const int wid = __builtin_amdgcn_readfirstlane(tid >> 6); const int mp = wid >> 2, wq = wid & 3;
    AtAddr ad; at_addr(ad, un, wid, lane, K, V);
    const unsigned kdst = (unsigned)(mp * KB_BYTES + (2 * wq) * 1024), vdst = (unsigned)(OFF_V + (2 * wid) * 1024);
    AT_DMA_K(ad, 0, 0); AT_DMA_V(ad, 0, 0); AT_DMA_K(ad, 1, KSLOT);
    const bf16_t* qp = Q + ((size_t)un.b * SEQ + un.qblk * 128 + wq * 32 + r32) * 1024 + (un.head * 2 + mp) * 64 + hi * 8;
#pragma unroll
    for (int d0 = 0; d0 < 4; ++d0) qr[d0] = *(const bf16x8*)(qp + d0 * 16);
    asm volatile("" ::: "memory"); AT_SBAR();
}
template <unsigned var> __device__ __forceinline__ void attn_unit(LAS unsigned char* lds, const AtUnit cu, const AtUnit nu, const bool has_next, const bool first, const bf16_t* __restrict__ Q, const bf16_t* __restrict__ K, const bf16_t* __restrict__ V,
                                          bf16_t* __restrict__ O, const float lam, const float* __restrict__ gain, bf16x8 (&qr)[4]) {
    const int tid = threadIdx.x, lane = tid & 63, r32 = lane & 31, hi = lane >> 5; const int wid = __builtin_amdgcn_readfirstlane(tid >> 6); const int mp = wid >> 2, wq = wid & 3;
    const int head = cu.head, qblk = cu.qblk; const size_t rowbase = (size_t)cu.b * SEQ; const int q0 = qblk * 128;
    const int mychunk = 2 * qblk + (wq >> 1); const int NT = 2 * qblk + 2;
    LAS float* wsf = (LAS float*)(lds + OFF_WS) + wid * 64;
    AtAddr ad; at_addr(ad, cu, wid, lane, K, V);
    const unsigned kdst = (unsigned)(mp * KB_BYTES + (2 * wq) * 1024), vdst = (unsigned)(OFF_V + (2 * wid) * 1024);
    float mhat = 0.f, l_reg = 0.f; f32x16 o[4] = {};
    const int vb0 = (int)(uintptr_t)(lds + OFF_V) + v_rd_base(lane);
    const LAS unsigned char* kb0 = lds + mp * KB_BYTES;
    constexpr float THR = 8.f;
    f32x16 pA0 = {}, pA1 = {}, pB0 = {}, pB1 = {}; float alA = 1.f, alB = 1.f; bool rsA = false, rsB = false;
    int kcur = 0, k1 = KSLOT, k2 = 2 * KSLOT;
    int vprev = 2 * VB_BYTES, vcur = 0, vnext = VB_BYTES;
#define AT_ROT() do { kcur = k1; k1 = k2; k2 = (k2 == (NKS - 1) * KSLOT) ? 0 : k2 + KSLOT; vprev = vcur; vcur = vnext; vnext = (vnext == (NVS - 1) * VB_BYTES) ? 0 : vnext + VB_BYTES; } while (0)
#define AT_QKT(P0, P1, SL) do { const LAS unsigned char* kp_ = kb0 + (SL) + hi * 1024 + r32 * 16; P0 = f32x16{}; P1 = f32x16{}; \
        _Pragma("unroll") for (int d0 = 0; d0 < 4; ++d0) { const bf16x8 b0_ = *(const LAS bf16x8*)(kp_ + d0 * 2048), b1_ = *(const LAS bf16x8*)(kp_ + d0 * 2048 + 512); const bf16x8 q_ = qr[d0]; \
            P0 = __builtin_amdgcn_mfma_f32_32x32x16_bf16(b0_, q_, P0, 0, 0, 0); P1 = __builtin_amdgcn_mfma_f32_32x32x16_bf16(b1_, q_, P1, 0, 0, 0); } } while (0)
#define AT_PSM(P0, P1, AL, RS, FIRST) do { float pm_ = P0[0]; _Pragma("unroll") for (int r = 1; r < 16; ++r) pm_ = fmaxf(pm_, P0[r]); _Pragma("unroll") for (int r = 0; r < 16; ++r) pm_ = fmaxf(pm_, P1[r]); \
        pm_ = hswap_max(pm_) - mhat; RS = (FIRST) || __any(pm_ > THR); AL = 1.f; \
        if (RS) { const float dl_ = (FIRST) ? pm_ : fmaxf(pm_, 0.f); mhat += dl_; AL = __builtin_amdgcn_exp2f(-dl_); } \
        _Pragma("unroll") for (int r = 0; r < 16; ++r) { P0[r] = __builtin_amdgcn_exp2f(P0[r] - mhat); P1[r] = __builtin_amdgcn_exp2f(P1[r] - mhat); } } while (0)
#define AT_PK4(P, BASE, OUT) do { const unsigned a0 = cvt_pk_bf16(P[BASE + 0], P[BASE + 1]), a1 = cvt_pk_bf16(P[BASE + 2], P[BASE + 3]); \
        const unsigned b0 = cvt_pk_bf16(P[BASE + 4], P[BASE + 5]), b1 = cvt_pk_bf16(P[BASE + 6], P[BASE + 7]); \
        auto r0_ = __builtin_amdgcn_permlane32_swap(a0, b0, false, false); auto r1_ = __builtin_amdgcn_permlane32_swap(a1, b1, false, false); \
        u32x4 w_ = {r0_[0], r1_[0], r0_[1], r1_[1]}; OUT = __builtin_bit_cast(bf16x8, w_); } while (0)
#define AT_FIN_PV(P0, P1, AL, SL) do { float ps_ = 0.f; _Pragma("unroll") for (int r = 0; r < 16; ++r) ps_ += P0[r]; _Pragma("unroll") for (int r = 0; r < 16; ++r) ps_ += P1[r]; \
        ps_ = hswap_sum(ps_); l_reg = l_reg * (AL) + ps_; bf16x8 pa0, pa1, pa2, pa3; AT_PK4(P0, 0, pa0); AT_PK4(P0, 8, pa1); AT_PK4(P1, 0, pa2); AT_PK4(P1, 8, pa3); const int vb_ = vb0 + (SL); \
        pv_one<0>(o[0], vb_, pa0, pa1, pa2, pa3); pv_one<1>(o[1], vb_, pa0, pa1, pa2, pa3); pv_one<2>(o[2], vb_, pa0, pa1, pa2, pa3); pv_one<3>(o[3], vb_, pa0, pa1, pa2, pa3); } while (0)
#define AT_RESC(AL, RS) do { if (RS) { if (hi == 0) wsf[r32] = (AL); asm volatile("s_waitcnt lgkmcnt(0)" ::: "memory"); \
        _Pragma("unroll") for (int r = 0; r < 16; ++r) { const float a_ = wsf[crow(r, hi)]; _Pragma("unroll") for (int d = 0; d < 4; ++d) o[d][r] *= a_; } } } while (0)
#define AT_STEP0(u, PC0, PC1, ALC, RSC, PP0, PP1, ALP) do { const bool nk_ = (u) + 2 < NT && !(var & 2u), nv_ = (u) + 1 < NT && !(var & 2u); if (nk_) AT_DMA_K(ad, (u) + 2, k2); if (nv_) AT_DMA_V(ad, (u) + 1, vnext); \
        const bool aX_ = (u) < NT && (u) <= mychunk, aF_ = (u) >= 1 && (u) - 1 <= mychunk; \
        if (aX_ && !(var & 16u)) AT_QKT(PC0, PC1, kcur); \
        if (aF_ && !(var & 4u)) AT_FIN_PV(PP0, PP1, ALP, vprev); \
        if (aX_ && !(var & 8u)) { AT_PSM(PC0, PC1, ALC, RSC, (u) == 0); AT_RESC(ALC, RSC); } \
        if (nk_) asm volatile("s_waitcnt vmcnt(4)" ::: "memory"); else if (nv_) asm volatile("s_waitcnt vmcnt(2)" ::: "memory"); else asm volatile("s_waitcnt vmcnt(0)" ::: "memory"); \
        __syncthreads(); AT_ROT(); } while (0)
    if (first || mp == 1) asm volatile("s_waitcnt vmcnt(0)" ::: "memory"); else asm volatile("s_waitcnt vmcnt(8)" ::: "memory");
    __syncthreads();
    for (int u = 0; u < NT; u += 2) { AT_STEP0(u, pA0, pA1, alA, rsA, pB0, pB1, alB); AT_STEP0(u + 1, pB0, pB1, alB, rsB, pA0, pA1, alA); }
    { const int u = NT; AT_STEP0(u, pA0, pA1, alA, rsA, pB0, pB1, alB); }
#undef AT_ROT
#undef AT_QKT
#undef AT_PSM
#undef AT_PK4
#undef AT_FIN_PV
#undef AT_RESC
#undef AT_STEP0
    if (has_next) at_prefetch(lds, nu, Q, K, V, qr);
    if (hi == 0) wsf[r32] = 1.f / l_reg;
    asm volatile("s_waitcnt lgkmcnt(0)" ::: "memory");
    float rli[16];
#pragma unroll
    for (int r = 0; r < 16; ++r) rli[r] = wsf[crow(r, hi)];
    LAS float* xch = (LAS float*)(lds + (wq < 2 ? 32768 + wq * 16384 : 81920 + (wq - 2) * 16384));
    if (mp == 1) {
#pragma unroll
        for (int d = 0; d < 4; ++d)
#pragma unroll
            for (int r4 = 0; r4 < 4; ++r4) *(LAS f32x4*)(xch + ((d * 4 + r4) * 64 + lane) * 4) = (f32x4){o[d][4 * r4] * rli[4 * r4], o[d][4 * r4 + 1] * rli[4 * r4 + 1], o[d][4 * r4 + 2] * rli[4 * r4 + 2], o[d][4 * r4 + 3] * rli[4 * r4 + 3]};
    }
    __syncthreads();
    if (mp == 0) {
#pragma unroll
        for (int d = 0; d < 4; ++d)
#pragma unroll
            for (int r4 = 0; r4 < 4; ++r4) { const f32x4 v2 = *(const LAS f32x4*)(xch + ((d * 4 + r4) * 64 + lane) * 4);
#pragma unroll
                for (int e = 0; e < 4; ++e) o[d][4 * r4 + e] = o[d][4 * r4 + e] * rli[4 * r4 + e] - lam * v2[e]; }
    }
    __syncthreads();
    LAS float* stg = (LAS float*)(lds + (wq == 0 ? 32768 : 81920 + (wq - 1) * 16896));
    if (mp == 0) {
#pragma unroll
        for (int d = 0; d < 4; ++d)
#pragma unroll
            for (int r = 0; r < 16; ++r) stg[crow(r, hi) * 132 + d * 32 + r32] = o[d][r];
        asm volatile("s_waitcnt lgkmcnt(0)" ::: "memory");
        const int row = lane >> 1, ch = (lane & 1) * 64; const LAS float* sp = stg + row * 132 + ch; float vv[64]; float ss = 0.f;
#pragma unroll
        for (int i = 0; i < 16; ++i) { const f32x4 t4 = *(const LAS f32x4*)(sp + 4 * i); vv[4 * i] = t4[0]; vv[4 * i + 1] = t4[1]; vv[4 * i + 2] = t4[2]; vv[4 * i + 3] = t4[3]; ss += (t4[0] * t4[0] + t4[1] * t4[1]) + (t4[2] * t4[2] + t4[3] * t4[3]); }
        ss += __shfl_xor(ss, 1);
        const float rs = (1.0f / sqrtf(ss * (1.f / 128.f) + RMS_EPS)) * (1.f - LAMBDA_INIT);
        bf16_t* op = O + (rowbase + q0 + wq * 32 + row) * 1024 + head * 128 + ch; const float* gp = gain + ch;
#pragma unroll
        for (int i = 0; i < 8; ++i) { const f32x4 g0 = *(const f32x4*)(gp + 8 * i), g1 = *(const f32x4*)(gp + 8 * i + 4); u32x4 w;
            w.x = cvt_pk_bf16(vv[8 * i] * rs * g0[0], vv[8 * i + 1] * rs * g0[1]); w.y = cvt_pk_bf16(vv[8 * i + 2] * rs * g0[2], vv[8 * i + 3] * rs * g0[3]);
            w.z = cvt_pk_bf16(vv[8 * i + 4] * rs * g1[0], vv[8 * i + 5] * rs * g1[1]); w.w = cvt_pk_bf16(vv[8 * i + 6] * rs * g1[2], vv[8 * i + 7] * rs * g1[3]);
            *(u32x4*)(op + 8 * i) = w; }
    }
}
template <unsigned var> __device__ __forceinline__ void attn_phase(LAS unsigned char* lds, int vcu, int ncu, const bf16_t* Q, const bf16_t* K, const bf16_t* V, bf16_t* O, const float* scal, const float* gain) {
    const float lam = scal[0];
    const int hb = ncu >> 1; const int nun = (vcu >> 1) < NB * NHEAD ? ((NB * NHEAD - 1 - (vcu >> 1)) / hb + 1) * 8 : 0;
    auto unit_of = [&](int i) { if (ncu == 256) { const int bh = (vcu >> 5) * 16 + (i >> 1) * 4 + ((vcu & 31) >> 3), s = vcu & 7; return AtUnit{bh >> 3, bh & 7, (i & 1) ? 15 - s : s}; }
        const int bh = (vcu >> 1) + (i >> 3) * hb; const int s = (vcu & 1) + 2 * ((i & 7) >> 1); return AtUnit{bh >> 3, bh & 7, (i & 1) ? 15 - s : s}; };
    if (nun == 0) return;
    bf16x8 qr[4]; AtUnit cu = unit_of(0); at_prefetch(lds, cu, Q, K, V, qr);
    for (int i = 0; i < nun; ++i) { const bool hn = i + 1 < nun; const AtUnit nu = unit_of(hn ? i + 1 : i);
        attn_unit<var>(lds, cu, nu, hn, i == 0, Q, K, V, O, lam, gain, qr); cu = nu; }
    __syncthreads();
}
#undef AT_DMA_K
#undef AT_DMA_V
#undef AT_SBAR
}

struct MKArgs { const void* in[21]; float* out; unsigned char* ws; unsigned mask; unsigned li; };
enum { PH_PRO = 0, PH_G1, PH_POOLA, PH_ATT, PH_POOLG, PH_G4A, PH_G4B, PH_G5, PH_ROUTER, PH_G7, PH_G8, PH_FINAL, PH_N };

template <int MODE> __device__ __forceinline__ int dest_row(int n) {
    if (MODE == 1) return n < 2048 ? (n & ~63) + qk_pos_of_d(n & 63) : n;
    if (MODE == 2) { const int nn = n >> 9, hc = n & 511; return (hc >> 7) * 256 + ((hc >> 6) & 1) * 128 + ((hc >> 4) & 3) * 32 + ((hc >> 2) & 3) * 8 + nn * 4 + (hc & 3); }
    return n;
}
template <int MODE> __device__ __forceinline__ void transpose_item(const float* __restrict__ W, int ldw, int N, bf16_t* __restrict__ WT, int ldt, int coloff, int rowoff, LAS float* scr, int item, int lane) {
    const int nblk = N / 64, kb = item / nblk, nb = item % nblk, k0 = 64 * kb, n0 = 64 * nb;
    const int lr = lane >> 4, n4 = (lane & 15) * 4;
#pragma unroll 4
    for (int i = 0; i < 16; ++i) { const int kk = 4 * i + lr; const f32x4 v = *(const f32x4*)(W + (size_t)(k0 + kk) * ldw + n0 + n4); *(LAS f32x4*)(scr + kk * 64 + (n4 ^ ((kk >> 3) << 2))) = v; }
    LDS_WAIT(); asm volatile("" ::: "memory");
    const int c = lane & 7;
#pragma unroll 2
    for (int jj = 0; jj < 8; ++jj) { const int n = 8 * jj + (lane >> 3); const LAS float* sp = scr + (8 * c) * 64 + (n ^ (c << 2));
        u32x4 o; o.x = cvt_pk_bf16(sp[0 * 64], sp[1 * 64]); o.y = cvt_pk_bf16(sp[2 * 64], sp[3 * 64]); o.z = cvt_pk_bf16(sp[4 * 64], sp[5 * 64]); o.w = cvt_pk_bf16(sp[6 * 64], sp[7 * 64]);
        *(u32x4*)(WT + (size_t)(rowoff + dest_row<MODE>(n0 + n)) * ldt + coloff + k0 + 8 * c) = o; }
    LDS_WAIT(); asm volatile("" ::: "memory");
}

__global__ void __launch_bounds__(NTHREADS, 2) mk_fwd(MKArgs args) {
    __shared__ __attribute__((aligned(16))) unsigned char lds_raw[LDS_BYTES];
    LAS unsigned char* lds = (LAS unsigned char*)lds_raw;
    volatile LAS unsigned* MISC = (volatile LAS unsigned*)(lds + MISC_OFF);
    const int tid = threadIdx.x, lane = tid & 63, wave = __builtin_amdgcn_readfirstlane(tid >> 6);
    const int G = gridDim.x; const int bx = blockIdx.x; const int vcu = (G % 8 == 0) ? (bx % 8) * (G / 8) + bx / 8 : bx;
    const unsigned mask = args.mask; const bool dry = ((args.li >> 8) & 1u) != 0u;
    unsigned char* const ws = args.ws; float* const out = args.out;
#define IN_F(k) ((const float*)args.in[k])
#define x_ IN_F(0)
#define positions ((const int*)args.in[1])
#define w_in IN_F(2)
#define gate_bias IN_F(3)
#define lam_vecs IN_F(4)
#define subln_gain IN_F(5)
#define w_pool IN_F(6)
#define pool_scale IN_F(7)
#define w_branch_a IN_F(8)
#define w_branch_b IN_F(9)
#define w_out IN_F(10)
#define ln1_g IN_F(11)
#define ln1_b IN_F(12)
#define wrg IN_F(13)
#define brg IN_F(14)
#define wre IN_F(15)
#define bre IN_F(16)
#define wgu IN_F(17)
#define wdn IN_F(18)
#define ln2_g IN_F(19)
#define ln2_b IN_F(20)
#define wt ((bf16_t*)(ws + WS_WT))
#define xb ((bf16_t*)(ws + WS_XB))
#define qb ((bf16_t*)(ws + WS_Q))
#define kb ((bf16_t*)(ws + WS_K))
#define vb ((bf16_t*)(ws + WS_V))
#define ub ((bf16_t*)(ws + WS_U))
#define gb ((bf16_t*)out)
#define on ((bf16_t*)(ws + WS_ON))
#define mixed ((bf16_t*)(ws + WS_MIXED))
#define merged ((bf16_t*)(ws + WS_MERGED))
#define x1b ((bf16_t*)(ws + WS_X1B))
#define hb ((bf16_t*)(ws + WS_H))
#define ybuf ((bf16_t*)(ws + WS_YBUF))
#define rope ((float*)(ws + WS_ROPE))
#define pooled ((bf16_t*)(ws + WS_POOLED))
#define misc (ws + WS_MISC)
#define ctl ((unsigned*)(misc + MS_CTL))
#define stats ((float2*)(misc + MS_STATS))
#define rw ((float*)(misc + MS_ROUTE + (size_t)T * 8))
#define list ((int*)(misc + MS_LIST))
#define scal ((float*)(misc + MS_SCAL))
#define cnt (ctl + CW_CNT)
#define wpool_bd ((bf16_t*)(misc + MS_WPOOL))

    for (int u = tid; u < (LDS_BYTES - LDS_CTL_OFF) / 4; u += NTHREADS) ((LAS unsigned*)(lds + LDS_CTL_OFF))[u] = 0u;
    __syncthreads();
    XcdBarrier bar; bar.bar = ctl + CW_BAR + (args.li & 255u) * XCD_BAR_WORDS; bar.x = 0; bar.st = nullptr;
    const bool multi = (mask & (mask - 1u)) != 0u;
    if (multi) bar = xcd_barrier_post(ctl + CW_BAR + (args.li & 255u) * XCD_BAR_WORDS, MISC + 8);
#ifndef MK_CT
#define MK_CT 0xfffu
#endif
#define HAS(p) (((MK_CT >> (p)) & 1u) && ((mask >> (p)) & 1u))
#ifndef MK_REP
#define MK_REP 0u
#endif
#define REPS(p) for (int rep_ = 0; rep_ < ((((MK_REP) >> (p)) & 1u) ? 2 : 1); ++rep_)
#ifdef MK_BAR2
#define SEAM(p) do { if (multi && (mask >> ((p) + 1)) != 0u) { xcd_barrier(bar); xcd_barrier(bar); } } while (0)
#else
#define SEAM(p) do { if (multi && (mask >> ((p) + 1)) != 0u) xcd_barrier(bar); } while (0)
#endif
#define AN_STR2(x) #x
#define AN_STR(x) AN_STR2(x)
#define ANCHOR(n) asm volatile(".p2align 6\n\t.rept " AN_STR(n) "\n\ts_nop 0\n\t.endr" ::: "memory")
#ifndef AN_G1
#define AN_G1 0
#endif
#ifndef AN_ATT
#define AN_ATT 0
#endif
#ifndef AN_G4A
#define AN_G4A 0
#endif
#ifndef AN_G4B
#define AN_G4B 0
#endif
#ifndef AN_G5
#define AN_G5 0
#endif
#ifndef AN_RT
#define AN_RT 0
#endif
#ifndef AN_G7
#define AN_G7 0
#endif
#ifndef AN_G8
#define AN_G8 0
#endif
    const int gw = vcu * NWAVES + wave, NGW = G * NWAVES;

    if (HAS(PH_PRO)) {
        LAS float* scr = (LAS float*)(lds + wave * 16384);
        constexpr int I_IN = 16 * (INW / 64), I_A = 16 * 16, I_O = 16 * 16, I_GU = 16 * 16, I_DN = 8 * 16;
        constexpr int NITEMS = I_IN + I_A + I_O;
        for (int it = gw; it < NITEMS; it += NGW) {
            int r = it;
            if (r < I_IN) { transpose_item<1>(w_in, INW, INW, wt + WT_IN, 1024, 0, 0, scr, r, lane); continue; } r -= I_IN;
            if (r < I_A) { transpose_item<0>(w_branch_a, 1024, 1024, wt + WT_A, 1024, 0, 0, scr, r, lane); continue; } r -= I_A;
            transpose_item<0>(w_out, 1024, 1024, wt + WT_O, 1024, 0, 0, scr, r, lane);
            (void)I_GU; (void)I_DN;
        }
        for (int it = gw; it < 64 * 16; it += NGW) { const int kc = it >> 4, n = (it & 15) * 64 + lane; const int g = kc >> 4, c0 = (kc & 15) * 8; float a8[8] = {0.f, 0.f, 0.f, 0.f, 0.f, 0.f, 0.f, 0.f};
            const float* wpg = w_pool + (size_t)(g * 128 + c0) * 128; const float* wbp = w_branch_b + (size_t)(g * 128) * 1024 + n; const float* psp = pool_scale + g * 128;
            for (int d = 0; d < 128; ++d) { const float bv = wbp[(size_t)d * 1024] * psp[d];
#pragma unroll
                for (int i = 0; i < 8; ++i) a8[i] = fmaf(wpg[i * 128 + d], bv, a8[i]); }
            u32x4 o; o.x = cvt_pk_bf16(a8[0], a8[1]); o.y = cvt_pk_bf16(a8[2], a8[3]); o.z = cvt_pk_bf16(a8[4], a8[5]); o.w = cvt_pk_bf16(a8[6], a8[7]);
            *(u32x4*)(wt + WT_B + (size_t)n * 512 + kc * 8) = o; }
        for (int m = gw; m < T; m += NGW) { const f32x4* xr = (const f32x4*)(x_ + (size_t)m * 1024) + 2 * lane; u32x4* o16 = (u32x4*)(xb + (size_t)m * 1024) + lane;
#pragma unroll
            for (int j = 0; j < 2; ++j) { const f32x4 v0 = __builtin_nontemporal_load(xr + 128 * j), v1 = __builtin_nontemporal_load(xr + 128 * j + 1); u32x4 w; w.x = cvt_pk_bf16(v0[0], v0[1]); w.y = cvt_pk_bf16(v0[2], v0[3]); w.z = cvt_pk_bf16(v1[0], v1[1]); w.w = cvt_pk_bf16(v1[2], v1[3]); o16[64 * j] = w; } }
        for (int e = gw * 64 + lane; e < T * 32; e += NGW * 64) { const int t = e >> 5, i = e & 31; const float inv = powf(10000.0f, -(float)i * (2.0f / 64.0f)); const float ang = (float)positions[t] * inv; float sn, cs; sincosf(ang, &sn, &cs);
            rope[2 * e] = cs; rope[2 * e + 1] = sn; }
        if (gw == 0 && lane == 0) { float s01 = 0.f, s23 = 0.f; for (int i = 0; i < 64; ++i) { s01 += lam_vecs[i] * lam_vecs[64 + i]; s23 += lam_vecs[128 + i] * lam_vecs[192 + i]; } scal[0] = expf(s01) - expf(s23) + LAMBDA_INIT; }
        { f32x4* wp = (f32x4*)(misc + MS_WP);
          for (int e = gw * 64 + lane; e < 16 * 3 * 4 * 64; e += NGW * 64) { const int l = e & 63, sg = (e >> 6) & 3, ob = (e >> 8) % 3, chunk = (e >> 8) / 3; const int o = ob * 16 + (l & 15); f32x4 v = {0.f, 0.f, 0.f, 0.f};
              if (o < 36) {
#pragma unroll
                  for (int j = 0; j < 4; ++j) { const int c = chunk * 64 + (l >> 4) * 16 + 4 * sg + j; v[j] = ln1_g[c] * (o < 4 ? wrg[c * 4 + o] : wre[c * 32 + (o - 4)]); } }
              wp[e] = v; }
          float* csbw = (float*)(misc + MS_CSBW);
          if (gw < 48) { const int o = gw; float cs = 0.f, bw = 0.f;
              if (o < 36) { for (int i = 0; i < 16; ++i) { const int c = lane + 64 * i; const float w = (o < 4 ? wrg[c * 4 + o] : wre[c * 32 + (o - 4)]); cs += ln1_g[c] * w; bw += ln1_b[c] * w; }
                  cs = wave_sum(cs); bw = wave_sum(bw) + (o < 4 ? brg[o] : bre[o - 4]); }
              if (lane == 0) { csbw[o] = cs; csbw[48 + o] = bw; } } }
#ifdef MK_SLEEP_TEST
        { const unsigned long long t0_ = __builtin_amdgcn_s_memrealtime(); while (__builtin_amdgcn_s_memrealtime() - t0_ < 10000ull) __builtin_amdgcn_s_sleep(32); }
#endif
        __syncthreads();
        SEAM(PH_PRO);
    }
    if (HAS(PH_G1)) {
        ANCHOR(AN_G1);
        g8::DenseOrder S; S.init(xb, wt + WT_IN, T, INW, 1024, G, bx);
        g8::EpiProj E{qb, kb, vb, ub, gb, rope, gate_bias};
        g8::gemm_phase<g8::EpiProj, g8::DenseOrder, true, false>(lds, 1024, S, E);
        SEAM(PH_G1);
    }
    if (HAS(PH_POOLA)) {
        for (int task = gw; task < T / 16; task += NGW) { const int t0 = task * 16, s0 = t0 & (SEQ - 1); const int w = 2 << (lane >> 4); const bf16_t* up = ub + (size_t)t0 * 512 + lane * 8;
            float a[8] = {0.f, 0.f, 0.f, 0.f, 0.f, 0.f, 0.f, 0.f};
            if (s0 != 0) for (int i = 1; i < w; ++i) { const u32x4 v = *(const u32x4*)(up - (ptrdiff_t)i * 512);
                a[0] += bflo(v.x); a[1] += bfhi(v.x); a[2] += bflo(v.y); a[3] += bfhi(v.y); a[4] += bflo(v.z); a[5] += bfhi(v.z); a[6] += bflo(v.w); a[7] += bfhi(v.w); }
#pragma unroll 4
            for (int j = 0; j < 16; ++j) { const int s = s0 + j; const u32x4 v = *(const u32x4*)(up + (size_t)j * 512); const float f[8] = {bflo(v.x), bfhi(v.x), bflo(v.y), bfhi(v.y), bflo(v.z), bfhi(v.z), bflo(v.w), bfhi(v.w)};
#pragma unroll
                for (int k = 0; k < 8; ++k) a[k] += f[k];
                if (j >= 1 && s >= w) { const u32x4 o = *(const u32x4*)(up + (ptrdiff_t)(j - w) * 512);
                    a[0] -= bflo(o.x); a[1] -= bfhi(o.x); a[2] -= bflo(o.y); a[3] -= bfhi(o.y); a[4] -= bflo(o.z); a[5] -= bfhi(o.z); a[6] -= bflo(o.w); a[7] -= bfhi(o.w); }
                const float inv = 1.f / (float)((s + 1 < w) ? s + 1 : w); u32x4 r; r.x = cvt_pk_bf16(a[0] * inv - f[0], a[1] * inv - f[1]); r.y = cvt_pk_bf16(a[2] * inv - f[2], a[3] * inv - f[3]);
                r.z = cvt_pk_bf16(a[4] * inv - f[4], a[5] * inv - f[5]); r.w = cvt_pk_bf16(a[6] * inv - f[6], a[7] * inv - f[7]);
                *(u32x4*)(pooled + (size_t)(t0 + j) * 512 + lane * 8) = r; } }
    }
    if (HAS(PH_ATT)) {
        ANCHOR(AN_ATT);
#ifdef MK_VAR
        if (args.li >> 8) at2::attn_phase<MK_VAR>(lds, vcu, G, qb, kb, vb, (bf16_t*)(ws + WS_POOLED), scal, subln_gain); else
#endif
        at2::attn_phase<0u>(lds, vcu, G, qb, kb, vb, on, scal, subln_gain);
        SEAM(PH_ATT); }
    else if (HAS(PH_POOLA)) { SEAM(PH_ATT); }
    if (HAS(PH_G4A)) {
        ANCHOR(AN_G4A);
        g8::DenseOrder S; S.init(on, wt + WT_A, T, 1024, 1024, G, bx);
        g8::EpiMerge<0> E{gb, merged, merged};
        g8::gemm_phase<g8::EpiMerge<0>, g8::DenseOrder, true, false>(lds, 1024, S, E);
    }
    if (HAS(PH_G4B)) {
        ANCHOR(AN_G4B);
        g8::DenseOrder S; S.init(pooled, wt + WT_B, T, 1024, 512, G, bx);
        g8::EpiMerge<1> E{gb, merged, dry ? (bf16_t*)(ws + WS_X1B) : merged};
        g8::gemm_phase<g8::EpiMerge<1>, g8::DenseOrder, true, false>(lds, 512, S, E);
        SEAM(PH_G4B);
    } else if (HAS(PH_G4A)) { SEAM(PH_G4B); }
    if (HAS(PH_G5)) {
        ANCHOR(AN_G5);
        g8::DenseOrder S; S.init(merged, wt + WT_O, T, 1024, 1024, G, bx);
        g8::EpiResid E{x_, out, (float2*)(ws + WS_MIXED)};
        g8::gemm_phase<g8::EpiResid, g8::DenseOrder, true, false>(lds, 1024, S, E);
        SEAM(PH_G5);
    }
    if (HAS(PH_ROUTER)) {
        ANCHOR(AN_RT);
        LAS float* lgs = (LAS float*)(lds + 0) + wave * (16 * 49);
        LAS float* tst = (LAS float*)(lds + 32768) + wave * 32;
        LAS int*   tex = (LAS int*)(lds + 36864) + wave * 128;
        LAS unsigned* lcnt = (LAS unsigned*)(lds + 40960);
        const f32x4* wp = (const f32x4*)(misc + MS_WP); const float* csbw = (const float*)(misc + MS_CSBW);
        for (int t0 = vcu * 128; t0 < T; t0 += G * 128) {
            if (tid < 64) lcnt[tid] = 0u;
            __syncthreads();
            const int tk = lane & 15, q = lane >> 4;
            if (wave >= 4) {
                if (t0 == vcu * 128) { LAS float* scr = (LAS float*)(lds + 65536 + (wave - 4) * 16384); constexpr int I_GU = 16 * 16, I_DN = 8 * 16;
                    for (int it = vcu * 4 + (wave - 4); it < NE * (I_GU + I_DN); it += G * 4) {
                        if (it < NE * I_GU) { const int e = it / I_GU; transpose_item<2>(wgu + (size_t)e * 1024 * 1024, 1024, 1024, wt + WT_GU + (size_t)e * 1024 * 1024, 1024, 0, 0, scr, it % I_GU, lane); }
                        else { const int r2 = it - NE * I_GU; const int e = r2 / I_DN; transpose_item<0>(wdn + (size_t)e * 512 * 1024, 1024, 1024, wt + WT_DN + (size_t)e * 1024 * 512, 512, 0, 0, scr, r2 % I_DN, lane); } } }
            } else
            for (int half = 0; half < 2; ++half) { const int tw = t0 + (wave * 2 + half) * 16; LAS int* texh = tex + half * 64;
            { const float* yr = out + (size_t)(tw + tk) * 1024 + q * 16;
              float s1 = 0.f, s2 = 0.f; { const float2* pp = (const float2*)(ws + WS_MIXED) + (size_t)(tw + tk) * 16;
#pragma unroll
                  for (int i = 0; i < 16; ++i) { const float2 pv = pp[i]; s1 += pv.x; s2 += pv.y; } }
              const float mu = s1 * (1.f / 1024.f); const float var = fmaxf(s2 * (1.f / 1024.f) - mu * mu, 0.f); const float rstd = 1.0f / sqrtf(var + LN_EPS);
              if (q == 0) { tst[2 * tk] = mu; tst[2 * tk + 1] = rstd; if (!dry) stats[tw + tk] = make_float2(mu, rstd); }
              bf16_t* xo = (dry ? (bf16_t*)(ws + WS_H) : x1b) + (size_t)(tw + tk) * 1024 + q * 16; const float* gp = ln1_g + q * 16; const float* bp = ln1_b + q * 16;
              f32x4 acc0 = {0.f, 0.f, 0.f, 0.f}, acc1 = {0.f, 0.f, 0.f, 0.f}, acc2 = {0.f, 0.f, 0.f, 0.f};
#pragma unroll 2
              for (int chunk = 0; chunk < 16; ++chunk) { f32x4 yv[4];
#pragma unroll
                  for (int j = 0; j < 4; ++j) yv[j] = *(const f32x4*)(yr + chunk * 64 + 4 * j);
                  { u32x4 w0, w1; f32x4 xn[4];
#pragma unroll
                    for (int j = 0; j < 4; ++j) { const f32x4 gg = *(const f32x4*)(gp + chunk * 64 + 4 * j), bb = *(const f32x4*)(bp + chunk * 64 + 4 * j); xn[j] = (yv[j] - mu) * rstd * gg + bb; }
                    w0.x = cvt_pk_bf16(xn[0][0], xn[0][1]); w0.y = cvt_pk_bf16(xn[0][2], xn[0][3]); w0.z = cvt_pk_bf16(xn[1][0], xn[1][1]); w0.w = cvt_pk_bf16(xn[1][2], xn[1][3]);
                    w1.x = cvt_pk_bf16(xn[2][0], xn[2][1]); w1.y = cvt_pk_bf16(xn[2][2], xn[2][3]); w1.z = cvt_pk_bf16(xn[3][0], xn[3][1]); w1.w = cvt_pk_bf16(xn[3][2], xn[3][3]);
                    *(u32x4*)(xo + chunk * 64) = w0; *(u32x4*)(xo + chunk * 64 + 8) = w1; }
#pragma unroll
                  for (int sg = 0; sg < 4; ++sg) { const f32x4 b0 = wp[((chunk * 3 + 0) * 4 + sg) * 64 + lane], b1 = wp[((chunk * 3 + 1) * 4 + sg) * 64 + lane], b2 = wp[((chunk * 3 + 2) * 4 + sg) * 64 + lane];
#pragma unroll
                      for (int j = 0; j < 4; ++j) { const float a = yv[sg][j];
                          acc0 = __builtin_amdgcn_mfma_f32_16x16x4f32(a, b0[j], acc0, 0, 0, 0); acc1 = __builtin_amdgcn_mfma_f32_16x16x4f32(a, b1[j], acc1, 0, 0, 0); acc2 = __builtin_amdgcn_mfma_f32_16x16x4f32(a, b2[j], acc2, 0, 0, 0); } } }
#pragma unroll
              for (int r = 0; r < 4; ++r) { lgs[(4 * q + r) * 49 + tk] = acc0[r]; lgs[(4 * q + r) * 49 + 16 + tk] = acc1[r]; lgs[(4 * q + r) * 49 + 32 + tk] = acc2[r]; } }
            LDS_WAIT();
            if (lane < 16) { const int t = tw + lane; const float mu = tst[2 * lane], rstd = tst[2 * lane + 1]; const LAS float* lr = lgs + lane * 49;
                float lg[4], le[32];
#pragma unroll
                for (int o = 0; o < 4; ++o) lg[o] = rstd * (lr[o] - mu * csbw[o]) + csbw[48 + o];
#pragma unroll
                for (int o = 0; o < 32; ++o) le[o] = rstd * (lr[4 + o] - mu * csbw[4 + o]) + csbw[48 + 4 + o];
                int gi = 0; float gm = lg[0];
#pragma unroll
                for (int o = 1; o < 4; ++o) if (lg[o] > gm) { gm = lg[o]; gi = o; }
                float gs = 0.f;
#pragma unroll
                for (int o = 0; o < 4; ++o) gs += expf(lg[o] - gm);
                const float gp = 1.f / gs; float ev[8];
#pragma unroll
                for (int o = 0; o < 8; ++o) { float vsel = le[o];
#pragma unroll
                    for (int g = 1; g < 4; ++g) vsel = (gi == g) ? le[g * 8 + o] : vsel;
                    ev[o] = vsel; }
                int i0 = 0; float m0v = ev[0];
#pragma unroll
                for (int o = 1; o < 8; ++o) if (ev[o] > m0v) { m0v = ev[o]; i0 = o; }
                int i1 = (i0 == 0) ? 1 : 0; float m1v = -3.4e38f;
#pragma unroll
                for (int o = 0; o < 8; ++o) if (o != i0 && ev[o] > m1v) { m1v = ev[o]; i1 = o; }
                const float e1 = expf(m1v - m0v); const float w0 = gp / (1.f + e1), w1 = gp * e1 / (1.f + e1);
                const int ex0 = gi * 8 + i0, ex1 = gi * 8 + i1;
                if (!dry) { rw[2 * t] = w0; rw[2 * t + 1] = w1; }
                const unsigned r0 = __hip_atomic_fetch_add(lcnt + ex0, 1u, __ATOMIC_RELAXED, __HIP_MEMORY_SCOPE_WORKGROUP); const unsigned r1 = __hip_atomic_fetch_add(lcnt + ex1, 1u, __ATOMIC_RELAXED, __HIP_MEMORY_SCOPE_WORKGROUP);
                texh[4 * lane] = ex0; texh[4 * lane + 1] = ex1; texh[4 * lane + 2] = (int)r0; texh[4 * lane + 3] = (int)r1; }
            }
            __syncthreads();
            if (tid < NE) { const unsigned c = lcnt[tid]; lcnt[32 + tid] = (c && !dry) ? atomicAdd(cnt + tid, c) : 0u; }
            __syncthreads();
            if (wave < 4 && lane < 32 && !dry) { const int half = lane >> 4, l16 = lane & 15; const int t = t0 + (wave * 2 + half) * 16 + l16; const LAS int* te = tex + half * 64 + 4 * l16; const int ex0 = te[0], ex1 = te[1];
                list[(size_t)ex0 * T + lcnt[32 + ex0] + (unsigned)te[2]] = t * 2; list[(size_t)ex1 * T + lcnt[32 + ex1] + (unsigned)te[3]] = t * 2 + 1; }
            __syncthreads();
        }
        SEAM(PH_ROUTER);
    }
    if (HAS(PH_G7) || HAS(PH_G8)) {
        if (tid < NE) MISC[64 + tid] = __hip_atomic_load(cnt + tid, RLX_AGENT);
        __syncthreads();
        if (tid == 0) { unsigned acc = 0u; for (int e = 0; e < NE; ++e) { MISC[16 + e] = acc; acc += (MISC[64 + e] + 255u) >> 8; } MISC[16 + NE] = acc; }
        __syncthreads();
        const int ntiles = (int)MISC[16 + NE];
        unsigned* tdone = ctl + CW_TDONE;
        const int nwg = ntiles * 4, r7 = nwg % G;
        if (HAS(PH_G7)) {
            ANCHOR(AN_G7);
            g8::MoeOrder S{(const char*)x1b, (const char*)(wt + WT_GU), list, MISC + 16, MISC + 64, nwg, G, bx, 0, (size_t)1024 * 1024 * 2, (size_t)256 * 1024 * 2, 1, tdone, 1};
            g8::EpiGateUp E{hb};
            g8::gemm_phase<g8::EpiGateUp, g8::MoeOrder, true, true>(lds, 1024, S, E);
        }
        if (HAS(PH_G8)) {
            ANCHOR(AN_G8);
            g8::MoeOrder S{(const char*)hb, (const char*)(wt + WT_DN), list, MISC + 16, MISC + 64, nwg, G, (bx - r7 + G) % G, (size_t)256 * 512 * 2, (size_t)1024 * 512 * 2, (size_t)256 * 512 * 2, 0, tdone, 2};
            g8::EpiDown E{ybuf, list, rw, MISC + 64};
            g8::gemm_phase<g8::EpiDown, g8::MoeOrder, true, false>(lds, 512, S, E);
            SEAM(PH_G8);
        } else if (HAS(PH_G7)) { SEAM(PH_G8); }
    }
    if (HAS(PH_FINAL)) {
        for (int t = gw; t < T; t += NGW) {
            float* yr = out + (size_t)t * 1024; float* yw = dry ? (float*)(ws + WS_V) + (size_t)t * 1024 : yr; const bf16_t* x1r = x1b + (size_t)t * 1024; float xv[16]; float s = 0.f;
#pragma unroll
            for (int j = 0; j < 4; ++j) { const int c0 = j * 256 + lane * 4; const u32x2 xw = __builtin_nontemporal_load((const u32x2*)(x1r + c0)); const float x1v[4] = {bflo(xw.x), bfhi(xw.x), bflo(xw.y), bfhi(xw.y)};
                const u32x2 a = __builtin_nontemporal_load((const u32x2*)(ybuf + (size_t)(2 * t) * 1024 + c0)); const u32x2 b = __builtin_nontemporal_load((const u32x2*)(ybuf + (size_t)(2 * t + 1) * 1024 + c0));
                const float ya[4] = {bflo(a.x), bfhi(a.x), bflo(a.y), bfhi(a.y)}; const float yb[4] = {bflo(b.x), bfhi(b.x), bflo(b.y), bfhi(b.y)};
#pragma unroll
                for (int i = 0; i < 4; ++i) { const float val = ALPHA * x1v[i] + (ya[i] + yb[i]); xv[4 * j + i] = val; s += val; } }
            const float mu = wave_sum(s) * (1.f / 1024.f); float s2 = 0.f;
#pragma unroll
            for (int i = 0; i < 16; ++i) { const float d = xv[i] - mu; s2 += d * d; }
            const float rstd = 1.0f / sqrtf(wave_sum(s2) * (1.f / 1024.f) + LN_EPS);
#pragma unroll
            for (int j = 0; j < 4; ++j) { const int c0 = j * 256 + lane * 4; const f32x4 gg = *(const f32x4*)(ln2_g + c0); const f32x4 bb = *(const f32x4*)(ln2_b + c0); f32x4 o;
#pragma unroll
                for (int i = 0; i < 4; ++i) o[i] = (xv[4 * j + i] - mu) * rstd * gg[i] + bb[i];
                __builtin_nontemporal_store(o, (f32x4*)(yw + c0)); }
        }
    }
#undef HAS
#undef SEAM
}
#undef IN_F
#undef x_
#undef positions
#undef w_in
#undef gate_bias
#undef lam_vecs
#undef subln_gain
#undef w_pool
#undef pool_scale
#undef w_branch_a
#undef w_branch_b
#undef w_out
#undef ln1_g
#undef ln1_b
#undef wrg
#undef brg
#undef wre
#undef bre
#undef wgu
#undef wdn
#undef ln2_g
#undef ln2_b
#undef wt
#undef xb
#undef qb
#undef kb
#undef vb
#undef ub
#undef gb
#undef on
#undef mixed
#undef merged
#undef x1b
#undef hb
#undef ybuf
#undef rope
#undef pooled
#undef misc
#undef ctl
#undef stats
#undef rw
#undef list
#undef scal
#undef cnt
#undef wpool_bd


#ifndef MK_OPT
#define MK_OPT 0xfffu
#endif
#ifndef MK_M2A
#define MK_M2A 0xff4u
#define MK_M2B 0u
#define MK_M2C 0u
#endif
#ifndef MK_ONE
#define MK_ONE 1
#endif
constexpr unsigned OPT = MK_OPT;
#define OPTP(p) ((OPT >> (p)) & 1u)


#ifdef MK_DEBUG_HASH
__global__ void k_hash(const uint4* __restrict__ p, size_t n16, unsigned long long* __restrict__ outh) {
    unsigned long long h = 0ull;
    for (size_t i = blockIdx.x * (size_t)blockDim.x + threadIdx.x; i < n16; i += (size_t)gridDim.x * blockDim.x) { const uint4 w = p[i];
        const unsigned long long m = (unsigned long long)(i * 2654435761ull + 12345ull) | 1ull;
        h += ((unsigned long long)w.x * 0x9E3779B1ull + (unsigned long long)w.y * 0x85EBCA77ull + (unsigned long long)w.z * 0xC2B2AE3Dull + (unsigned long long)w.w * 0x27D4EB2Full) * m; }
    for (int o = 32; o > 0; o >>= 1) h += __shfl_xor(h, o);
    if ((threadIdx.x & 63) == 0) atomicAdd(outh, h);
}
__global__ void k_poison(float* __restrict__ out, const unsigned long long* __restrict__ hs) {
    float code = 0.f; for (int r = 1; r < 10; ++r) if (hs[r] != hs[0]) code = 1.f;
    if (code == 0.f) return;
    for (size_t i = blockIdx.x * (size_t)blockDim.x + threadIdx.x; i < (size_t)T * DM; i += (size_t)gridDim.x * blockDim.x) out[i] = __builtin_nanf("") * code;
}
#endif
extern "C" void kernel_launch(void* const* d_in, const int* in_sizes, int n_in, void* d_out, int out_size, void* d_ws, size_t ws_size, hipStream_t stream) {
    static int grid = 0;
    if (grid == 0) {
        if (n_in != 21 || in_sizes[0] != T * DM || out_size != T * DM || ws_size < WS_END) { fprintf(stderr, "kernel_launch: unexpected shapes (n_in %d, x %d, out %d, ws %zu)\n", n_in, n_in > 0 ? in_sizes[0] : -1, out_size, ws_size); grid = -1; return; }
        int dev = 0, cus = 0;
        if (hipGetDevice(&dev) != hipSuccess || hipDeviceGetAttribute(&cus, hipDeviceAttributeMultiprocessorCount, dev) != hipSuccess) { fprintf(stderr, "kernel_launch: device query failed\n"); grid = -1; return; }
        int per_cu = 0;
        if (hipOccupancyMaxActiveBlocksPerMultiprocessor(&per_cu, (const void*)mk_fwd, NTHREADS, 0) != hipSuccess || per_cu < 1) fprintf(stderr, "kernel_launch: note: occupancy query reports %d blocks per CU\n", per_cu);
        (void)hipGetLastError();
        grid = cus;
    }
    if (grid < 0) return;
    const float* x = (const float*)d_in[0]; const int* positions = (const int*)d_in[1]; const float* w_in = (const float*)d_in[2]; const float* gate_bias = (const float*)d_in[3];
    const float* lam_vecs = (const float*)d_in[4]; const float* subln_gain = (const float*)d_in[5]; const float* w_pool = (const float*)d_in[6]; const float* pool_scale = (const float*)d_in[7];
    const float* w_branch_a = (const float*)d_in[8]; const float* w_branch_b = (const float*)d_in[9]; const float* w_out = (const float*)d_in[10]; const float* ln1_g = (const float*)d_in[11];
    const float* ln1_b = (const float*)d_in[12]; const float* wrg = (const float*)d_in[13]; const float* brg = (const float*)d_in[14]; const float* wre = (const float*)d_in[15];
    const float* bre = (const float*)d_in[16]; const float* wgu = (const float*)d_in[17]; const float* wdn = (const float*)d_in[18]; const float* ln2_g = (const float*)d_in[19]; const float* ln2_b = (const float*)d_in[20];
    char* ws = (char*)d_ws; float* out = (float*)d_out;
    bf16_t* qb = (bf16_t*)(ws + WS_Q); bf16_t* kb = (bf16_t*)(ws + WS_K); bf16_t* vb = (bf16_t*)(ws + WS_V); bf16_t* ub = (bf16_t*)(ws + WS_U); bf16_t* gb = (bf16_t*)d_out;
    bf16_t* on = (bf16_t*)(ws + WS_ON); bf16_t* mixed = (bf16_t*)(ws + WS_MIXED); bf16_t* merged = (bf16_t*)(ws + WS_MERGED); bf16_t* x1b = (bf16_t*)(ws + WS_X1B);
    bf16_t* hb = (bf16_t*)(ws + WS_H); bf16_t* ybuf = (bf16_t*)(ws + WS_YBUF); float2* rope = (float2*)(ws + WS_ROPE); float* tmp = (float*)(ws + WS_TEMP);
    char* misc = ws + WS_MISC; unsigned* ctl = (unsigned*)(misc + MS_CTL); float2* stats = (float2*)(misc + MS_STATS); int2* rexp = (int2*)(misc + MS_ROUTE); float2* rw = (float2*)(misc + MS_ROUTE + (size_t)T * 8);
    int* list = (int*)(misc + MS_LIST); float* scal = (float*)(misc + MS_SCAL); unsigned* cnt = ctl;

    MKArgs a{}; int nlaunch = 0;
    for (int i = 0; i < 21; ++i) a.in[i] = d_in[i];
    a.out = out; a.ws = (unsigned char*)d_ws;
    if (hipMemsetAsync(ctl, 0, 65536, stream) != hipSuccess) { fprintf(stderr, "kernel_launch: memset failed\n"); return; }
#ifndef MK_REPH
#define MK_REPH 0u
#endif
#define MK(maskv) do { a.mask = (maskv); for (int rr_ = 0; rr_ < (((maskv) & (MK_REPH)) ? 2 : 1); ++rr_) { a.li = (unsigned)(nlaunch++ % 3) | (rr_ ? (1u << 8) : 0u); hipLaunchKernelGGL(mk_fwd, dim3(grid), dim3(NTHREADS), 0, stream, a); } } while (0)
    if (MK_ONE == 1) { MK((1u << PH_N) - 1u); return; }
    if (MK_ONE == 2) {
        MK(0x003u);
        for (int mh = 0; mh < 2; ++mh) { const int m0 = mh * 16384; nattn<<<(16384 / 64) * 16, 64, 0, stream>>>(qb, kb, vb, scal, tmp, m0); post_rms<<<16384 * 8 / 256, 256, 0, stream>>>(tmp, subln_gain, on, m0, 16384); }
        MK(MK_M2A); if (MK_M2B) MK(MK_M2B); if (MK_M2C) MK(MK_M2C); return; }

    constexpr int MC = 16384;
#if 0
#else
#ifdef MK_TEST_BAR
    MK(0x003u);
#else
    if (OPTP(PH_PRO)) MK(1u << PH_PRO); else k_prep<<<T * 32 / 256, 256, 0, stream>>>(positions, lam_vecs, rope, scal, ctl);
    if (OPTP(PH_G1)) MK(1u << PH_G1);
#endif
#endif
#ifndef MK_OVR
#define MK_OVR 0
#endif
    const int ovr = OPTP(PH_G1) ? MK_OVR : 15;
    for (int mh = 0; mh < 2; ++mh) {
        const int m0 = mh * MC; AL_F32 ax{x + (size_t)m0 * DM, DM, 0};
        if (ovr & 1) for (int qk = 0; qk < 2; ++qk) {
            ngemm<AL_F32><<<dim3(16, MC / 64), 256, 0, stream>>>(ax, w_in + qk * 1024, INW, tmp, 1024, MC, 1024, DM);
            post_qk<<<MC * 512 / 256, 256, 0, stream>>>(tmp, rope, qk ? kb : qb, m0, MC, qk ? 1.f : QSCALE);
        }
        if (ovr & 2) { ngemm<AL_F32><<<dim3(16, MC / 64), 256, 0, stream>>>(ax, w_in + 2048, INW, tmp, 1024, MC, 1024, DM);
        post_plain<<<MC * 1024 / 256, 256, 0, stream>>>(tmp, vb, 1024, 0, m0, MC, 1024, nullptr); }
        if (ovr & 4) { ngemm<AL_F32><<<dim3(8, MC / 64), 256, 0, stream>>>(ax, w_in + 3072, INW, tmp, 512, MC, 512, DM);
        post_plain<<<MC * 512 / 256, 256, 0, stream>>>(tmp, ub, 512, 0, m0, MC, 512, nullptr); }
        if (ovr & 8) for (int br = 0; br < 2; ++br) {
            ngemm<AL_F32><<<dim3(16, MC / 64), 256, 0, stream>>>(ax, w_in + 3584 + br * 1024, INW, tmp, 1024, MC, 1024, DM);
            post_gate<<<MC * 1024 / 256, 256, 0, stream>>>(tmp, gate_bias, gb, br * 1024, m0, MC);
        }
    }
    if (OPTP(PH_ATT)) MK(1u << PH_ATT);
    else for (int mh = 0; mh < 2; ++mh) {
        const int m0 = mh * MC;
        nattn<<<(MC / 64) * 16, 64, 0, stream>>>(qb, kb, vb, scal, tmp, m0);
        post_rms<<<MC * 8 / 256, 256, 0, stream>>>(tmp, subln_gain, on, m0, MC);
    }
    if (OPTP(PH_POOLA)) { MK(1u << PH_POOLA); MK(1u << PH_POOLG); }
    else for (int mh = 0; mh < 2; ++mh) {
        const int m0 = mh * MC;
        for (int g = 0; g < 4; ++g) { AL_POOL ap{ub + (size_t)m0 * PW, g, 0};
            ngemm<AL_POOL><<<dim3(2, MC / 64), 256, 0, stream>>>(ap, w_pool + (size_t)g * 128 * 128, 128, tmp + g * 128, 512, MC, 128, 128); }
        post_plain<<<MC * 512 / 256, 256, 0, stream>>>(tmp, mixed, 512, 0, m0, MC, 512, pool_scale);
    }
    if (OPTP(PH_G4A)) MK(1u << PH_G4A);
    else for (int mh = 0; mh < 2; ++mh) {
        const int m0 = mh * MC;
        { AL_BF16 al{on + (size_t)m0 * 1024, 1024, 0}; ngemm<AL_BF16><<<dim3(16, MC / 64), 256, 0, stream>>>(al, w_branch_a, 1024, tmp, 1024, MC, 1024, 1024); }
        post_merge<<<MC * 1024 / 256, 256, 0, stream>>>(tmp, gb, merged, 0, m0, MC);
    }
    if (OPTP(PH_G4B)) MK(1u << PH_G4B);
    else for (int mh = 0; mh < 2; ++mh) {
        const int m0 = mh * MC;
        { AL_BF16 al{mixed + (size_t)m0 * 512, 512, 0}; ngemm<AL_BF16><<<dim3(16, MC / 64), 256, 0, stream>>>(al, w_branch_b, 1024, tmp, 1024, MC, 1024, 512); }
        post_merge<<<MC * 1024 / 256, 256, 0, stream>>>(tmp, gb, merged, 1, m0, MC);
    }
    if (OPTP(PH_G5)) MK(1u << PH_G5);
    else for (int mh = 0; mh < 2; ++mh) {
        const int m0 = mh * MC;
        { AL_BF16 al{merged + (size_t)m0 * 1024, 1024, 0}; ngemm<AL_BF16><<<dim3(16, MC / 64), 256, 0, stream>>>(al, w_out, 1024, tmp, 1024, MC, 1024, 1024); }
        post_y<<<MC * 1024 / 256, 256, 0, stream>>>(tmp, x, out, m0, MC);
    }
    if (OPTP(PH_ROUTER)) MK(1u << PH_ROUTER); else k_router<<<T / 4, 256, 0, stream>>>(out, ln1_g, ln1_b, wrg, brg, wre, bre, x1b, stats, rexp, rw, list, cnt);
    if (OPTP(PH_G7)) MK(1u << PH_G7); else nmoe_gu<<<dim3(8, T / 64, NE), 256, 0, stream>>>(x1b, list, cnt, wgu, hb);
    if (OPTP(PH_G8)) MK(1u << PH_G8); else nmoe_dn<<<dim3(16, T / 64, NE), 256, 0, stream>>>(hb, list, cnt, rw, wdn, ybuf);
    if (OPTP(PH_FINAL)) MK(1u << PH_FINAL); else k_final<<<T / 4, 256, 0, stream>>>(out, stats, ln1_g, ln1_b, ybuf, ln2_g, ln2_b);
#undef MK
}
```

```cpp
#include <hip/hip_runtime.h>
#include <cstdio>
#include <cstdint>
#include <cmath>

typedef unsigned short bf16_t;
typedef float f32x4 __attribute__((ext_vector_type(4)));

constexpr int NB = 16, SEQ = 2048, DM = 1024, T = NB * SEQ;
constexpr int NHEAD = 8, HD = 64, NHM = 16;
constexpr int INW = 5632;
constexpr int PW = 512, PG = 4, PGD = 128;
constexpr int NE = 32, NGRP = 4, EPG = 8, FF = 512;
constexpr float LN_EPS = 1e-5f, RMS_EPS = 1e-5f;
constexpr float ALPHA = 1.189207115002721f;
constexpr float LAMBDA_INIT = 0.2f;
constexpr float QSCALE = 0.125f * 1.4426950408889634f;

constexpr size_t MiB = 1u << 20;
constexpr size_t WS_WT    = 0;
constexpr size_t WS_XB    = 112 * MiB;
constexpr size_t WS_ON    = 112 * MiB;
constexpr size_t WS_YBUF  = 112 * MiB;
constexpr size_t WS_Q     = 176 * MiB;
constexpr size_t WS_MERGED= 176 * MiB;
constexpr size_t WS_K     = 240 * MiB;
constexpr size_t WS_X1B   = 240 * MiB;
constexpr size_t WS_V     = 304 * MiB;
constexpr size_t WS_H     = 304 * MiB;
constexpr size_t WS_U     = 368 * MiB;
constexpr size_t WS_MIXED = 400 * MiB;
constexpr size_t WS_ROPE  = 432 * MiB;
constexpr size_t WS_MISC  = 440 * MiB;
constexpr size_t WS_TEMP  = 448 * MiB;
constexpr size_t WS_END   = 512 * MiB;
constexpr size_t MS_CTL   = 0;
constexpr size_t MS_STATS = 64 * 1024;
constexpr size_t MS_ROUTE = 512 * 1024;
constexpr size_t MS_LIST  = 1 * MiB;
constexpr size_t MS_SCAL  = 6 * MiB;

__device__ __forceinline__ float bf2f(bf16_t v) { return __uint_as_float((unsigned)v << 16); }
__device__ __forceinline__ bf16_t f2bf(float f) { unsigned u = __float_as_uint(f); return (bf16_t)((u + 0x7fffu + ((u >> 16) & 1u)) >> 16); }
__host__ __device__ __forceinline__ int qk_pos_of_d(int d) { return ((d >> 4) & 1) * 32 + ((d >> 2) & 3) * 8 + (d >> 5) * 4 + (d & 3); }

struct AL_F32  { const float* p; int ld; int pad;  __device__ __forceinline__ float operator()(int r, int k) const { return p[(size_t)r * ld + k]; } };
struct AL_BF16 { const bf16_t* p; int ld; int pad; __device__ __forceinline__ float operator()(int r, int k) const { return bf2f(p[(size_t)r * ld + k]); } };
struct AL_POOL { const bf16_t* u; int g; int pad;
    __device__ __forceinline__ float operator()(int r, int k) const {
        const int w = 2 << g, s = r & (SEQ - 1); const int n = (s + 1 < w) ? s + 1 : w; float acc = 0.f;
        for (int i = 0; i < n; ++i) acc += bf2f(u[(size_t)(r - i) * PW + g * PGD + k]);
        return acc / (float)n - bf2f(u[(size_t)r * PW + g * PGD + k]); } };

template <class AL>
__global__ __launch_bounds__(256) void ngemm(AL al, const float* __restrict__ Bm, int ldb, float* __restrict__ C, int ldc, int M, int N, int K) {
    __shared__ float As[16][68]; __shared__ float Bs[16][68];
    const int tid = threadIdx.x, tx = tid & 15, ty = tid >> 4; const int m0 = blockIdx.y * 64, n0 = blockIdx.x * 64;
    float acc[4][4] = {};
    for (int k0 = 0; k0 < K; k0 += 16) {
#pragma unroll
        for (int i = 0; i < 4; ++i) { const int e = tid + i * 256; const int r = e >> 4, kk = e & 15; As[kk][r] = (m0 + r < M) ? al(m0 + r, k0 + kk) : 0.f; }
#pragma unroll
        for (int i = 0; i < 4; ++i) { const int e = tid + i * 256; const int kk = e >> 6, c = e & 63; Bs[kk][c] = (n0 + c < N) ? Bm[(size_t)(k0 + kk) * ldb + n0 + c] : 0.f; }
        __syncthreads();
#pragma unroll
        for (int kk = 0; kk < 16; ++kk) { float a[4], b[4];
#pragma unroll
            for (int i = 0; i < 4; ++i) { a[i] = As[kk][ty * 4 + i]; b[i] = Bs[kk][tx * 4 + i]; }
#pragma unroll
            for (int i = 0; i < 4; ++i)
#pragma unroll
                for (int j = 0; j < 4; ++j) acc[i][j] = fmaf(a[i], b[j], acc[i][j]); }
        __syncthreads();
    }
#pragma unroll
    for (int i = 0; i < 4; ++i)
#pragma unroll
        for (int j = 0; j < 4; ++j) { const int r = m0 + ty * 4 + i, c = n0 + tx * 4 + j; if (r < M && c < N) C[(size_t)r * ldc + c] = acc[i][j]; }
}

__global__ void k_prep(const int* __restrict__ positions, const float* __restrict__ lam_vecs, float2* __restrict__ rope, float* __restrict__ scal, unsigned* __restrict__ ctl) {
    const int gid = blockIdx.x * blockDim.x + threadIdx.x;
    if (gid < T * 32) { const int t = gid >> 5, i = gid & 31;
        const float inv = powf(10000.0f, -(float)i * (2.0f / 64.0f)); const float ang = (float)positions[t] * inv;
        const double a = (double)ang; rope[gid] = make_float2((float)cos(a), (float)sin(a)); }
    if (gid < 16384) ctl[gid] = 0u;
    if (gid == 0) { float s01 = 0.f, s23 = 0.f; for (int i = 0; i < 64; ++i) { s01 += lam_vecs[i] * lam_vecs[64 + i]; s23 += lam_vecs[128 + i] * lam_vecs[192 + i]; }
        scal[0] = expf(s01) - expf(s23) + LAMBDA_INIT; }
}
__global__ void post_qk(const float* __restrict__ tmp, const float2* __restrict__ rope, bf16_t* __restrict__ out, int m0, int Mc, float scale) {
    const int gid = blockIdx.x * blockDim.x + threadIdx.x; if (gid >= Mc * 512) return;
    const int r = gid >> 9, p = gid & 511, hm = p >> 5, i = p & 31; const int t = m0 + r;
    const float t1 = tmp[(size_t)r * 1024 + hm * 64 + i], t2 = tmp[(size_t)r * 1024 + hm * 64 + i + 32]; const float2 cs = rope[t * 32 + i];
    out[(size_t)t * 1024 + hm * 64 + qk_pos_of_d(i)] = f2bf((t1 * cs.x - t2 * cs.y) * scale);
    out[(size_t)t * 1024 + hm * 64 + qk_pos_of_d(i + 32)] = f2bf((t2 * cs.x + t1 * cs.y) * scale);
}
__global__ void post_plain(const float* __restrict__ tmp, bf16_t* __restrict__ out, int ldo, int coloff, int m0, int Mc, int N, const float* __restrict__ colscale) {
    const int gid = blockIdx.x * blockDim.x + threadIdx.x; if (gid >= Mc * N) return;
    const int r = gid / N, c = gid % N; float v = tmp[(size_t)r * N + c]; if (colscale) v *= colscale[c];
    out[(size_t)(m0 + r) * ldo + coloff + c] = f2bf(v);
}
__global__ void post_gate(const float* __restrict__ tmp, const float* __restrict__ bias, bf16_t* __restrict__ gates, int coloff, int m0, int Mc) {
    const int gid = blockIdx.x * blockDim.x + threadIdx.x; if (gid >= Mc * 1024) return;
    const int r = gid >> 10, c = gid & 1023; const float v = tmp[(size_t)r * 1024 + c] + bias[coloff + c];
    gates[(size_t)(m0 + r) * 2048 + coloff + c] = f2bf(1.f / (1.f + expf(-v)));
}
__global__ __launch_bounds__(64) void nattn(const bf16_t* __restrict__ q, const bf16_t* __restrict__ k, const bf16_t* __restrict__ v, const float* __restrict__ scal, float* __restrict__ tmp, int m0) {
    const int lane = threadIdx.x; const int blk = blockIdx.x;
    const int half = blk & 1, head = (blk >> 1) & 7, cg = blk >> 4; const int t0 = m0 + cg * 64, t = t0 + lane; const int b = t0 / SEQ, s0 = t0 % SEQ; const int nkeys = ((s0 >> 6) + 1) * 64;
    const float lam = scal[0];
    float res[64];
    for (int mp = 0; mp < 2; ++mp) {
        const int hm = head * 2 + mp; float qv[64];
#pragma unroll
        for (int d = 0; d < 64; ++d) qv[d] = bf2f(q[(size_t)t * 1024 + hm * 64 + d]);
        float mx = -1e30f, l = 0.f; float o[64];
#pragma unroll
        for (int d = 0; d < 64; ++d) o[d] = 0.f;
        for (int j = 0; j < nkeys; ++j) { const size_t kr = (size_t)(b * SEQ + j) * 1024; float sc = 0.f;
            const uint4* kp = (const uint4*)(k + kr + hm * 64); const uint4* vp = (const uint4*)(v + kr + head * 128 + half * 64);
#pragma unroll
            for (int c = 0; c < 8; ++c) { const uint4 w = kp[c]; const unsigned ww[4] = {w.x, w.y, w.z, w.w};
#pragma unroll
                for (int e = 0; e < 4; ++e) { sc = fmaf(qv[c * 8 + 2 * e], __uint_as_float(ww[e] << 16), sc); sc = fmaf(qv[c * 8 + 2 * e + 1], __uint_as_float(ww[e] & 0xffff0000u), sc); } }
            const float mn = fmaxf(mx, sc), al = exp2f(mx - mn), p = exp2f(sc - mn); mx = mn; l = l * al + p;
#pragma unroll
            for (int c = 0; c < 8; ++c) { const uint4 w = vp[c]; const unsigned ww[4] = {w.x, w.y, w.z, w.w};
#pragma unroll
                for (int e = 0; e < 4; ++e) { o[c * 8 + 2 * e] = fmaf(p, __uint_as_float(ww[e] << 16), o[c * 8 + 2 * e] * al); o[c * 8 + 2 * e + 1] = fmaf(p, __uint_as_float(ww[e] & 0xffff0000u), o[c * 8 + 2 * e + 1] * al); } } }
        const float il = 1.f / l;
#pragma unroll
        for (int d = 0; d < 64; ++d) res[d] = (mp == 0) ? o[d] * il : res[d] - lam * o[d] * il;
    }
#pragma unroll
    for (int d = 0; d < 64; ++d) tmp[(size_t)(t - m0) * 1024 + head * 128 + half * 64 + d] = res[d];
}
__global__ void post_rms(const float* __restrict__ tmp, const float* __restrict__ gain, bf16_t* __restrict__ on, int m0, int Mc) {
    const int gid = blockIdx.x * blockDim.x + threadIdx.x; if (gid >= Mc * 8) return;
    const int r = gid >> 3, head = gid & 7; const float* p = tmp + (size_t)r * 1024 + head * 128; float ss = 0.f;
    for (int d = 0; d < 128; ++d) ss += p[d] * p[d];
    const float rs = 1.0f / sqrtf(ss * (1.f / 128.f) + RMS_EPS);
    for (int d = 0; d < 128; ++d) on[(size_t)(m0 + r) * 1024 + head * 128 + d] = f2bf(p[d] * rs * gain[d] * (1.f - LAMBDA_INIT));
}
__global__ void post_merge(const float* __restrict__ tmp, const bf16_t* __restrict__ gates, bf16_t* __restrict__ merged, int br, int m0, int Mc) {
    const int gid = blockIdx.x * blockDim.x + threadIdx.x; if (gid >= Mc * 1024) return;
    const int r = gid >> 10, c = gid & 1023; const size_t t = m0 + r; const float g = bf2f(gates[t * 2048 + br * 1024 + c]);
    float val = g * tmp[(size_t)r * 1024 + c]; if (br) val += bf2f(merged[t * 1024 + c]);
    merged[t * 1024 + c] = f2bf(val);
}
__global__ void post_y(const float* __restrict__ tmp, const float* __restrict__ x, float* __restrict__ y, int m0, int Mc) {
    const int gid = blockIdx.x * blockDim.x + threadIdx.x; if (gid >= Mc * 1024) return;
    const size_t o = (size_t)m0 * 1024 + gid; y[o] = ALPHA * x[o] + tmp[gid];
}
__device__ __forceinline__ float wave_sum(float v) {
#pragma unroll
    for (int o = 1; o < 64; o <<= 1) v += __shfl_xor(v, o);
    return v;
}
__global__ __launch_bounds__(256) void k_router(const float* __restrict__ y, const float* __restrict__ g1, const float* __restrict__ b1, const float* __restrict__ wrg, const float* __restrict__ brg,
                                                const float* __restrict__ wre, const float* __restrict__ bre, bf16_t* __restrict__ x1b, float2* __restrict__ stats, int2* __restrict__ rexp, float2* __restrict__ rw,
                                                int* __restrict__ list, unsigned* __restrict__ cnt) {
    const int lane = threadIdx.x & 63; const int t = blockIdx.x * 4 + (threadIdx.x >> 6);
    const float* yr = y + (size_t)t * 1024; float xv[16]; float s = 0.f;
#pragma unroll
    for (int j = 0; j < 4; ++j) { const f32x4 vv = *(const f32x4*)(yr + j * 256 + lane * 4); xv[4 * j] = vv.x; xv[4 * j + 1] = vv.y; xv[4 * j + 2] = vv.z; xv[4 * j + 3] = vv.w; s += (vv.x + vv.y) + (vv.z + vv.w); }
    const float mu = wave_sum(s) * (1.f / 1024.f); float s2 = 0.f;
#pragma unroll
    for (int i = 0; i < 16; ++i) { const float d = xv[i] - mu; s2 += d * d; }
    const float rstd = 1.0f / sqrtf(wave_sum(s2) * (1.f / 1024.f) + LN_EPS);
    if (lane == 0) stats[t] = make_float2(mu, rstd);
#pragma unroll
    for (int j = 0; j < 4; ++j)
#pragma unroll
        for (int i = 0; i < 4; ++i) { const int c = j * 256 + lane * 4 + i; xv[4 * j + i] = (xv[4 * j + i] - mu) * rstd * g1[c] + b1[c]; }
#pragma unroll
    for (int j = 0; j < 4; ++j) { uint2 w; w.x = (unsigned)f2bf(xv[4 * j]) | ((unsigned)f2bf(xv[4 * j + 1]) << 16); w.y = (unsigned)f2bf(xv[4 * j + 2]) | ((unsigned)f2bf(xv[4 * j + 3]) << 16);
        *(uint2*)(x1b + (size_t)t * 1024 + j * 256 + lane * 4) = w; }
    float lg[4], le[32];
#pragma unroll
    for (int o = 0; o < 4; ++o) { float a = 0.f;
#pragma unroll
        for (int j = 0; j < 4; ++j)
#pragma unroll
            for (int i = 0; i < 4; ++i) a = fmaf(xv[4 * j + i], wrg[(size_t)(j * 256 + lane * 4 + i) * 4 + o], a);
        lg[o] = wave_sum(a) + brg[o]; }
#pragma unroll
    for (int o = 0; o < 32; ++o) { float a = 0.f;
#pragma unroll
        for (int j = 0; j < 4; ++j)
#pragma unroll
            for (int i = 0; i < 4; ++i) a = fmaf(xv[4 * j + i], wre[(size_t)(j * 256 + lane * 4 + i) * 32 + o], a);
        le[o] = wave_sum(a) + bre[o]; }
    if (lane == 0) {
        int gi = 0; float gm = lg[0];
#pragma unroll
        for (int o = 1; o < 4; ++o) if (lg[o] > gm) { gm = lg[o]; gi = o; }
        float gs = 0.f;
#pragma unroll
        for (int o = 0; o < 4; ++o) gs += expf(lg[o] - gm);
        const float gp = 1.f / gs;
        float ev[8];
#pragma unroll
        for (int o = 0; o < 8; ++o) { float vsel = le[o];
#pragma unroll
            for (int g = 1; g < 4; ++g) vsel = (gi == g) ? le[g * 8 + o] : vsel;
            ev[o] = vsel; }
        int i0 = 0; float m0v = ev[0];
#pragma unroll
        for (int o = 1; o < 8; ++o) if (ev[o] > m0v) { m0v = ev[o]; i0 = o; }
        int i1 = (i0 == 0) ? 1 : 0; float m1v = -3.4e38f;
#pragma unroll
        for (int o = 0; o < 8; ++o) if (o != i0 && ev[o] > m1v) { m1v = ev[o]; i1 = o; }
        const float e1 = expf(m1v - m0v); const float w0 = gp / (1.f + e1), w1 = gp * e1 / (1.f + e1);
        const int ex0 = gi * 8 + i0, ex1 = gi * 8 + i1;
        rexp[t] = make_int2(ex0, ex1); rw[t] = make_float2(w0, w1);
        const unsigned p0 = atomicAdd(&cnt[ex0], 1u); list[(size_t)ex0 * T + p0] = t * 2;
        const unsigned p1 = atomicAdd(&cnt[ex1], 1u); list[(size_t)ex1 * T + p1] = t * 2 + 1;
    }
}
__global__ __launch_bounds__(256) void nmoe_gu(const bf16_t* __restrict__ x1b, const int* __restrict__ list, const unsigned* __restrict__ cnt, const float* __restrict__ wgu, bf16_t* __restrict__ h) {
    __shared__ float As[16][68]; __shared__ float Bg[16][68]; __shared__ float Bu[16][68]; __shared__ int toks[64];
    const int e = blockIdx.z; const int M = (int)cnt[e]; const int m0 = blockIdx.y * 64, n0 = blockIdx.x * 64; if (m0 >= M) return;
    int tb = 0; for (int i = 0; i < e; ++i) tb += ((int)cnt[i] + 255) >> 8;
    const int tid = threadIdx.x, tx = tid & 15, ty = tid >> 4;
    if (tid < 64) toks[tid] = (m0 + tid < M) ? (list[(size_t)e * T + m0 + tid] >> 1) : 0;
    __syncthreads();
    const float* W = wgu + (size_t)e * 1024 * 1024; float ag[4][4] = {}, au[4][4] = {};
    for (int k0 = 0; k0 < 1024; k0 += 16) {
#pragma unroll
        for (int i = 0; i < 4; ++i) { const int el = tid + i * 256; const int r = el >> 4, kk = el & 15; As[kk][r] = bf2f(x1b[(size_t)toks[r] * 1024 + k0 + kk]); }
#pragma unroll
        for (int i = 0; i < 4; ++i) { const int el = tid + i * 256; const int kk = el >> 6, c = el & 63; Bg[kk][c] = W[(size_t)(k0 + kk) * 1024 + n0 + c]; Bu[kk][c] = W[(size_t)(k0 + kk) * 1024 + 512 + n0 + c]; }
        __syncthreads();
#pragma unroll
        for (int kk = 0; kk < 16; ++kk) { float a[4], bg[4], bu[4];
#pragma unroll
            for (int i = 0; i < 4; ++i) { a[i] = As[kk][ty * 4 + i]; bg[i] = Bg[kk][tx * 4 + i]; bu[i] = Bu[kk][tx * 4 + i]; }
#pragma unroll
            for (int i = 0; i < 4; ++i)
#pragma unroll
                for (int j = 0; j < 4; ++j) { ag[i][j] = fmaf(a[i], bg[j], ag[i][j]); au[i][j] = fmaf(a[i], bu[j], au[i][j]); } }
        __syncthreads();
    }
#pragma unroll
    for (int i = 0; i < 4; ++i)
#pragma unroll
        for (int j = 0; j < 4; ++j) { const int r = m0 + ty * 4 + i, c = n0 + tx * 4 + j; if (r < M) { const float g = ag[i][j]; h[((size_t)tb * 256 + r) * 512 + c] = f2bf(g / (1.f + expf(-g)) * au[i][j]); } }
}
__global__ __launch_bounds__(256) void nmoe_dn(const bf16_t* __restrict__ h, const int* __restrict__ list, const unsigned* __restrict__ cnt, const float2* __restrict__ rw, const float* __restrict__ wdn, bf16_t* __restrict__ ybuf) {
    __shared__ float As[16][68]; __shared__ float Bs[16][68];
    const int e = blockIdx.z; const int M = (int)cnt[e]; const int m0 = blockIdx.y * 64, n0 = blockIdx.x * 64; if (m0 >= M) return;
    int tb = 0; for (int i = 0; i < e; ++i) tb += ((int)cnt[i] + 255) >> 8;
    const int tid = threadIdx.x, tx = tid & 15, ty = tid >> 4;
    const float* W = wdn + (size_t)e * 512 * 1024; float acc[4][4] = {};
    for (int k0 = 0; k0 < 512; k0 += 16) {
#pragma unroll
        for (int i = 0; i < 4; ++i) { const int el = tid + i * 256; const int r = el >> 4, kk = el & 15; As[kk][r] = (m0 + r < M) ? bf2f(h[((size_t)tb * 256 + m0 + r) * 512 + k0 + kk]) : 0.f; }
#pragma unroll
        for (int i = 0; i < 4; ++i) { const int el = tid + i * 256; const int kk = el >> 6, c = el & 63; Bs[kk][c] = W[(size_t)(k0 + kk) * 1024 + n0 + c]; }
        __syncthreads();
#pragma unroll
        for (int kk = 0; kk < 16; ++kk) { float a[4], b[4];
#pragma unroll
            for (int i = 0; i < 4; ++i) { a[i] = As[kk][ty * 4 + i]; b[i] = Bs[kk][tx * 4 + i]; }
#pragma unroll
            for (int i = 0; i < 4; ++i)
#pragma unroll
                for (int j = 0; j < 4; ++j) acc[i][j] = fmaf(a[i], b[j], acc[i][j]); }
        __syncthreads();
    }
#pragma unroll
    for (int i = 0; i < 4; ++i) { const int r = m0 + ty * 4 + i; if (r < M) { const int ent = list[(size_t)e * T + r]; const float2 w2 = rw[ent >> 1]; const float w = (ent & 1) ? w2.y : w2.x;
#pragma unroll
        for (int j = 0; j < 4; ++j) ybuf[(size_t)ent * 1024 + n0 + tx * 4 + j] = f2bf(w * acc[i][j]); } }
}
__global__ __launch_bounds__(256) void k_final(float* __restrict__ yout, const float2* __restrict__ stats, const float* __restrict__ g1, const float* __restrict__ b1, const bf16_t* __restrict__ ybuf,
                                               const float* __restrict__ g2, const float* __restrict__ b2) {
    const int lane = threadIdx.x & 63; const int t = blockIdx.x * 4 + (threadIdx.x >> 6);
    float* yr = yout + (size_t)t * 1024; const float2 st = stats[t]; float xv[16]; float s = 0.f;
#pragma unroll
    for (int j = 0; j < 4; ++j) { const int c0 = j * 256 + lane * 4; const f32x4 vv = *(const f32x4*)(yr + c0); const f32x4 gg = *(const f32x4*)(g1 + c0); const f32x4 bb = *(const f32x4*)(b1 + c0);
        const uint2 a = *(const uint2*)(ybuf + (size_t)(2 * t) * 1024 + c0); const uint2 b = *(const uint2*)(ybuf + (size_t)(2 * t + 1) * 1024 + c0);
        const float ya[4] = {__uint_as_float(a.x << 16), __uint_as_float(a.x & 0xffff0000u), __uint_as_float(a.y << 16), __uint_as_float(a.y & 0xffff0000u)};
        const float yb[4] = {__uint_as_float(b.x << 16), __uint_as_float(b.x & 0xffff0000u), __uint_as_float(b.y << 16), __uint_as_float(b.y & 0xffff0000u)};
#pragma unroll
        for (int i = 0; i < 4; ++i) { const float x1 = (vv[i] - st.x) * st.y * gg[i] + bb[i]; const float val = ALPHA * x1 + (ya[i] + yb[i]); xv[4 * j + i] = val; s += val; } }
    const float mu = wave_sum(s) * (1.f / 1024.f); float s2 = 0.f;
#pragma unroll
    for (int i = 0; i < 16; ++i) { const float d = xv[i] - mu; s2 += d * d; }
    const float rstd = 1.0f / sqrtf(wave_sum(s2) * (1.f / 1024.f) + LN_EPS);
#pragma unroll
    for (int j = 0; j < 4; ++j) { const int c0 = j * 256 + lane * 4; const f32x4 gg = *(const f32x4*)(g2 + c0); const f32x4 bb = *(const f32x4*)(b2 + c0); f32x4 o;
#pragma unroll
        for (int i = 0; i < 4; ++i) o[i] = (xv[4 * j + i] - mu) * rstd * gg[i] + bb[i];
        *(f32x4*)(yr + c0) = o; }
}

#define LAS __attribute__((address_space(3)))
#define GAS __attribute__((address_space(1)))
typedef short bf16x8 __attribute__((ext_vector_type(8)));
typedef unsigned u32x4 __attribute__((ext_vector_type(4)));
typedef unsigned u32x2 __attribute__((ext_vector_type(2)));
typedef GAS unsigned gu32;
#define RLX_AGENT __ATOMIC_RELAXED, __HIP_MEMORY_SCOPE_AGENT
#define LDS_WAIT() asm volatile("s_waitcnt lgkmcnt(0)" ::: "memory")
#define VM_WAIT() asm volatile("s_waitcnt vmcnt(0)" ::: "memory")

constexpr size_t WT_IN = 0;
constexpr size_t WT_A  = WT_IN + (size_t)INW * 1024;
constexpr size_t WT_B  = WT_A + 1024 * 1024;
constexpr size_t WT_O  = WT_B + 1024 * 512;
constexpr size_t WT_GU = WT_O + 1024 * 1024;
constexpr size_t WT_DN = WT_GU + (size_t)NE * 1024 * 1024;
constexpr size_t WT_END = WT_DN + (size_t)NE * 1024 * 512;
static_assert(WT_END * 2 <= 112 * MiB, "weight copies fit");
constexpr size_t MS_WPOOL = 7 * MiB;
constexpr size_t MS_WP = 7 * MiB + 512 * 1024;
constexpr size_t MS_CSBW = 6 * MiB + 1024;
constexpr size_t WS_POOLED = 448 * MiB;

constexpr int CW_CNT = 0;
constexpr int CW_BAR = 1024;
constexpr int CW_TDONE = 12288;

constexpr int NWAVES = 8, NTHREADS = 512;
constexpr int RING_BYTES = 131072, LDS_CTL_OFF = 147456, MISC_OFF = LDS_CTL_OFF + 320, LDS_BYTES = 163840;

typedef float f32x2_t __attribute__((ext_vector_type(2))); typedef __bf16 bf16x2_t __attribute__((ext_vector_type(2)));
__device__ __forceinline__ unsigned cvt_pk_bf16(float lo, float hi) { f32x2_t v = {lo, hi}; bf16x2_t b = __builtin_convertvector(v, bf16x2_t); return __builtin_bit_cast(unsigned, b); }
__device__ __forceinline__ float bflo(unsigned w) { return __uint_as_float(w << 16); }
__device__ __forceinline__ float bfhi(unsigned w) { return __uint_as_float(w & 0xffff0000u); }

#define XB_TMO      128
#define XB_XCNT(j)  (256  + 64 * (j))
#define XB_XSUB(j)  (1280 + 64 * (j))
#define XB_XGEN(j)  (2304 + 64 * (j))
#define XB_TOP      3328
#define XB_TOPGEN   3392
#define XCD_BAR_WORDS 3456
#define XB_SPIN_CAP (1u << 22)
__device__ __forceinline__ unsigned xb_ld(unsigned* p)              { return __hip_atomic_load(p, __ATOMIC_RELAXED, __HIP_MEMORY_SCOPE_AGENT); }
__device__ __forceinline__ unsigned xb_add(unsigned* p, unsigned v) { return __hip_atomic_fetch_add(p, v, __ATOMIC_RELAXED, __HIP_MEMORY_SCOPE_AGENT); }
__device__ __forceinline__ unsigned xb_xcc_id() { return (unsigned)__builtin_amdgcn_s_getreg((3 << 11) | 20) & 0xFu; }
#define XB_SPIN(cond, bar) do { unsigned _sp = 0; while (cond) { __builtin_amdgcn_s_sleep(1); \
    if ((++_sp & 255u) == 0u) { if (xb_ld(&(bar)[XB_TMO])) break; if (_sp > XB_SPIN_CAP) { atomicAdd(&(bar)[XB_TMO], 1u); break; } } } } while (0)
struct XcdBarrier { unsigned* bar; unsigned x; volatile LAS unsigned* st; };
__device__ __forceinline__ XcdBarrier xcd_barrier_post(unsigned* bar, volatile LAS unsigned* st) {
    XcdBarrier b; b.bar = bar; b.x = xb_xcc_id(); b.st = st;
    if (threadIdx.x == 0) (void)xb_add(&bar[XB_XCNT(b.x)], 1u);
    return b;
}
__device__ __forceinline__ void xcd_barrier_complete(unsigned* bar, unsigned x, unsigned& nloc, unsigned& nx) {
    const unsigned G = gridDim.x * gridDim.y * gridDim.z;
    unsigned sum, cnt, mine, sp = 0u;
    for (;;) {
        sum = 0u; cnt = 0u; mine = 0u;
#pragma unroll
        for (unsigned j = 0; j < 16; ++j) { const unsigned c = xb_ld(&bar[XB_XCNT(j)]); sum += c; cnt += (c > 0u) ? 1u : 0u; mine = (j == x) ? c : mine; }
        if (sum == G) break;
        __builtin_amdgcn_s_sleep(1);
        if ((++sp & 255u) == 0u) { if (xb_ld(&bar[XB_TMO])) break; if (sp > XB_SPIN_CAP) { atomicAdd(&bar[XB_TMO], 1u); break; } }
    }
    nloc = mine > 0u ? mine : 1u; nx = cnt > 0u ? cnt : 1u;
}
__device__ __forceinline__ void xcd_barrier(const XcdBarrier& b) {
    asm volatile("s_waitcnt vmcnt(0)" ::: "memory");
    __syncthreads();
    if (threadIdx.x == 0) {
        unsigned* bar = b.bar;
        __builtin_amdgcn_s_waitcnt(0);
        unsigned nloc = b.st[0], nx = b.st[1];
        if (nloc == 0u) { xcd_barrier_complete(bar, b.x, nloc, nx); b.st[0] = nloc; b.st[1] = nx; }
        const unsigned old = xb_add(&bar[XB_XSUB(b.x)], 1u);
        const unsigned gen = old / nloc;
        if (old + 1u == (gen + 1u) * nloc) {
            __builtin_amdgcn_fence(__ATOMIC_RELEASE, "agent");
            asm volatile("s_waitcnt vmcnt(0)" ::: "memory");
            const unsigned og = xb_add(&bar[XB_TOP], 1u);
            const unsigned tg = og / nx;
            if (og + 1u == (tg + 1u) * nx) xb_add(&bar[XB_TOPGEN], 1u);
            else XB_SPIN(xb_ld(&bar[XB_TOPGEN]) == tg, bar);
            __builtin_amdgcn_fence(__ATOMIC_ACQUIRE, "agent");
            xb_add(&bar[XB_XGEN(b.x)], 1u);
            asm volatile("s_waitcnt vmcnt(0)" ::: "memory");
        } else {
            XB_SPIN(xb_ld(&bar[XB_XGEN(b.x)]) == gen, bar);
            __builtin_amdgcn_fence(__ATOMIC_ACQUIRE, "agent");
            asm volatile("s_waitcnt vmcnt(0)" ::: "memory");
        }
    }
    __syncthreads();
}

typedef int i32x8 __attribute__((ext_vector_type(8)));
typedef int i32x4 __attribute__((ext_vector_type(4)));
namespace g8 {
constexpr int BM = 256, BK = 64, HALF = 128, HTB = HALF * BK * 2, NXCD = 8, WGM = 8;
__host__ __device__ __forceinline__ int lds_byte(int r, int c) { const int st = (r >> 4) * 2 + (c >> 5), rr = r & 15, cc = c & 31, ob = rr * 64 + cc * 2; return st * 1024 + (ob ^ (((ob >> 9) & 1) << 5)); }
__host__ __device__ __forceinline__ void stage_rc(int b, int& R, int& C) { const int st = b / 1024, sb = b % 1024, swz = sb ^ (((sb >> 9) & 1) << 5); R = (st >> 1) * 16 + swz / 64; C = (st & 1) * 32 + (swz % 64) / 2; }
__host__ __device__ __forceinline__ int perm32(int rho) { const int n = rho >> 4, i = rho & 15; return 8 * (i >> 2) + 4 * n + (i & 3); }

struct GUnit { const char* A; const char* B; int pm, pn, e, r0; };

struct DenseOrder {
    const char* Abase; const char* Bbase; int nM, nN, nwg, G, c; size_t tstep;
    __device__ void init(const void* A, const void* Bt, int M, int N, int K, int G_, int c_) { Abase = (const char*)A; Bbase = (const char*)Bt; nM = M / BM; nN = N / BM; nwg = nM * nN; G = G_; c = c_; tstep = (size_t)BM * K * 2; }
    __device__ bool next(int i, GUnit& u) const {
        const long L = (long)i * G + c; if (L >= nwg) return false;
        int wgid = (int)L; { const int q = nwg / NXCD, r = nwg % NXCD, xcd = wgid % NXCD, off = wgid / NXCD; wgid = (xcd < r ? xcd * (q + 1) : r * (q + 1) + (xcd - r) * q) + off; }
        const int nig = WGM * nN, gid = wgid / nig, fm = gid * WGM, gsz = (nM - fm) < WGM ? (nM - fm) : WGM;
        u.pm = fm + ((wgid % nig) % gsz); u.pn = (wgid % nig) / gsz; u.e = 0; u.r0 = 0;
        u.A = Abase + (size_t)u.pm * tstep; u.B = Bbase + (size_t)u.pn * tstep; return true;
    }
    __device__ __forceinline__ unsigned rowoff(const GUnit&, int) const { return 0u; }
    __device__ __forceinline__ void a_ready(const GUnit&) const {}
    __device__ __forceinline__ void done(const GUnit&) const {}
};
struct MoeOrder {
    const char* Abase; const char* Bbase; const int* list; const volatile LAS unsigned* tb; const volatile LAS unsigned* cntl; int nwg, G, c; size_t atile, bexp, btile; int gather;
    unsigned* tdone; int mode;
    __device__ bool next(int i, GUnit& u) const {
        const long L = (long)i * G + c; if (L >= nwg) return false;
        int wgid = (int)L; { const int q = nwg / NXCD, r = nwg % NXCD, xcd = wgid % NXCD, off = wgid / NXCD; wgid = (xcd < r ? xcd * (q + 1) : r * (q + 1) + (xcd - r) * q) + off; }
        const int tile = wgid >> 2; u.pn = wgid & 3; u.pm = tile;
        int e = 0; for (int j = 1; j < NE; ++j) e = ((int)tb[j] <= tile) ? j : e;
        e = __builtin_amdgcn_readfirstlane(e); u.e = e; u.r0 = __builtin_amdgcn_readfirstlane((tile - (int)tb[e]) * 256);
        u.A = gather ? Abase : Abase + (size_t)tile * atile; u.B = Bbase + (size_t)e * bexp + (size_t)u.pn * btile; return true;
    }
    __device__ __forceinline__ unsigned rowoff(const GUnit& u, int rr) const {
        const int p = u.r0 + rr; const int tok = (p < (int)cntl[u.e]) ? (list[(size_t)u.e * T + p] >> 1) : 0; return (unsigned)tok * 2048u; }
    __device__ __forceinline__ void done(const GUnit& u) const {
        if (mode == 1) { asm volatile("s_waitcnt vmcnt(0)" ::: "memory"); if ((threadIdx.x & 63) == 0) __hip_atomic_fetch_add(tdone + u.pm, 1u, __ATOMIC_RELAXED, __HIP_MEMORY_SCOPE_AGENT); } }
    __device__ __forceinline__ void a_ready(const GUnit& u) const {
        if (mode == 2) {
            if (threadIdx.x < 64) { unsigned sp = 0;
                while ((unsigned)__builtin_amdgcn_readfirstlane(__hip_atomic_load(tdone + u.pm, __ATOMIC_RELAXED, __HIP_MEMORY_SCOPE_AGENT)) < 32u) { __builtin_amdgcn_s_sleep(2); if (++sp > (1u << 22)) break; }
                __builtin_amdgcn_fence(__ATOMIC_ACQUIRE, "agent"); asm volatile("s_waitcnt vmcnt(0)" ::: "memory"); }
            asm volatile("" ::: "memory"); __builtin_amdgcn_s_barrier(); asm volatile("" ::: "memory"); } }
};

template <class Epi, class Sched, bool ALIGN_EPI, bool GATHER, bool F8 = false>
__device__ __forceinline__ void gemm_phase(LAS unsigned char* lds, const int K, const Sched& S, const Epi& E) {
    int tid = threadIdx.x; asm volatile("" : "+v"(tid));
    const int wid = __builtin_amdgcn_readfirstlane(tid >> 6), lane = tid & 63, wr = wid >> 2, wc = wid & 3, fr = lane & 15, fq = lane >> 4;
    const int nt = K / BK;
    unsigned voffA[2], voffB[2]; int RA[2], CA[2];
#pragma unroll
    for (int i = 0; i < 2; ++i) { int R, C; stage_rc(tid * 16 + i * 8192, R, C); const int Rb = Epi::PERM ? ((R & ~31) + perm32(R & 31)) : R;
        voffA[i] = (unsigned)(R * K + C) * 2u; voffB[i] = (unsigned)(Rb * K + C) * 2u; RA[i] = R; CA[i] = C; }
    const size_t kstep = (size_t)(BK * 2);
    const size_t hstep = (size_t)HALF * K * 2;
    const unsigned ldsw = (unsigned)wid * 1024u;
    const int aoff = lds_byte(wr * 64 + fr, fq * 8), boff = lds_byte(wc * 32 + fr, fq * 8);
#define G8_SA(b, h) (((b) * 2 + (h)) * HTB)
#define G8_SB(b, h) ((4 + (b) * 2 + (h)) * HTB)
#define G8_STAGE(bufoff, gbase, o0, o1) do { \
        __builtin_amdgcn_global_load_lds((const unsigned*)((const char*)(gbase) + (o0)), (LAS unsigned*)(lds + (bufoff) + ldsw), 16, 0, 0); \
        __builtin_amdgcn_global_load_lds((const unsigned*)((const char*)(gbase) + (o1)), (LAS unsigned*)(lds + (bufoff) + ldsw + 8192), 16, 0, 0); } while (0)
#define G8_STAGE_B(bufoff, gbase) G8_STAGE(bufoff, gbase, voffB[0], voffB[1])
#define G8_LDA(dst, b, h) do { _Pragma("unroll") for (int m = 0; m < 4; ++m) _Pragma("unroll") for (int k = 0; k < 2; ++k) dst[m][k] = *(const LAS bf16x8*)(lds + G8_SA(b, h) + aoff + m * 2048 + k * 1024); } while (0)
#define G8_LDB(dst, b, h) do { _Pragma("unroll") for (int n = 0; n < 2; ++n) _Pragma("unroll") for (int k = 0; k < 2; ++k) dst[n][k] = *(const LAS bf16x8*)(lds + G8_SB(b, h) + boff + n * 2048 + k * 1024); } while (0)
#define G8_MMA(ai, bj, At, Bt) do { __builtin_amdgcn_s_setprio(1); _Pragma("unroll") for (int m = 0; m < 4; ++m) _Pragma("unroll") for (int n = 0; n < 2; ++n) { \
        if constexpr (F8) { const i32x8 b8_ = __builtin_shufflevector(__builtin_bit_cast(i32x4, Bt[n][0]), __builtin_bit_cast(i32x4, Bt[n][1]), 0, 1, 2, 3, 4, 5, 6, 7); \
            const i32x8 a8_ = __builtin_shufflevector(__builtin_bit_cast(i32x4, At[m][0]), __builtin_bit_cast(i32x4, At[m][1]), 0, 1, 2, 3, 4, 5, 6, 7); \
            asm volatile("v_mfma_scale_f32_16x16x128_f8f6f4 %0, %1, %2, %0, %3, %4 op_sel_hi:[0,0,0]" : "+v"(acc[ai][bj][m][n]) : "v"(b8_), "v"(a8_), "v"(sc_w_), "v"(sc_x_)); } \
        else { _Pragma("unroll") for (int k = 0; k < 2; ++k) acc[ai][bj][m][n] = __builtin_amdgcn_mfma_f32_16x16x32_bf16(Bt[n][k], At[m][k], acc[ai][bj][m][n], 0, 0, 0); } } __builtin_amdgcn_s_setprio(0); } while (0)
#ifdef G8_DRAIN
#define G8_WAIT_V(n) asm volatile("s_waitcnt vmcnt(0)" ::: "memory")
#else
#define G8_WAIT_V(n) asm volatile("s_waitcnt vmcnt(" #n ")" ::: "memory")
#endif
#define G8_WAIT_L(n) asm volatile("s_waitcnt lgkmcnt(" #n ")" ::: "memory")
#define G8_BAR __builtin_amdgcn_s_barrier()
#define G8_SCHED __builtin_amdgcn_sched_barrier(0)
    GUnit cur, nxt; int ui = 0;
    if (!S.next(0, cur)) return;
    unsigned cao[2][2], nao[2][2];
#pragma unroll
    for (int h = 0; h < 2; ++h)
#pragma unroll
        for (int i = 0; i < 2; ++i) { cao[h][i] = GATHER ? S.rowoff(cur, h * HALF + RA[i]) + (unsigned)CA[i] * 2u : voffA[i] + (unsigned)(h * hstep); nao[h][i] = cao[h][i]; }
    f32x4 acc[2][2][4][2];
#pragma unroll
    for (int a = 0; a < 2; ++a)
#pragma unroll
        for (int b = 0; b < 2; ++b)
#pragma unroll
            for (int m = 0; m < 4; ++m)
#pragma unroll
                for (int n = 0; n < 2; ++n) acc[a][b][m][n] = (f32x4){0.f, 0.f, 0.f, 0.f};
    bf16x8 At[4][2], B0[2][2], B1[2][2];
    int sc_w_ = 0x7B7B7B7B, sc_x_ = 0x7F7F7F7F; if constexpr (F8) asm volatile("" : "+v"(sc_w_), "+v"(sc_x_));
    const char* cA = cur.A; const char* cB = cur.B;
    S.a_ready(cur);
    G8_STAGE_B(G8_SB(0, 0), cB); G8_STAGE_B(G8_SB(0, 1), cB + hstep); G8_STAGE(G8_SA(0, 0), cA, cao[0][0], cao[0][1]); G8_STAGE(G8_SA(0, 1), cA, cao[1][0], cao[1][1]);
    if (wr == 1) G8_BAR;
    G8_WAIT_V(2); G8_BAR;
    G8_STAGE_B(G8_SB(1, 0), cB + kstep); G8_STAGE(G8_SA(1, 0), cA + kstep, cao[0][0], cao[0][1]); G8_STAGE_B(G8_SB(1, 1), cB + hstep + kstep);
    G8_WAIT_V(6); G8_BAR;
    for (;;) {
        const bool has_next = S.next(ui + 1, nxt);
        if (GATHER && has_next) {
#pragma unroll
            for (int h = 0; h < 2; ++h)
#pragma unroll
                for (int i = 0; i < 2; ++i) nao[h][i] = S.rowoff(nxt, h * HALF + RA[i]) + (unsigned)CA[i] * 2u;
        }
        const char* nA = has_next ? nxt.A : cA; const char* nB = has_next ? nxt.B : cB;
#pragma unroll 1
        for (int t = 0; t < nt; t += 2) {
            const bool last = (t == nt - 2);
            if (last && has_next) S.a_ready(nxt);
            const char* a1 = cA + (size_t)(t + 1) * kstep;
            const char* a2 = last ? nA : cA + (size_t)(t + 2) * kstep; const char* b2 = last ? nB : cB + (size_t)(t + 2) * kstep;
            const char* a3 = a2 + kstep; const char* b3 = b2 + kstep;
            asm volatile("" : "+s"(a1), "+s"(a2), "+s"(b2), "+s"(a3), "+s"(b3));
            unsigned o2[2][2];
#pragma unroll
            for (int h = 0; h < 2; ++h)
#pragma unroll
                for (int i = 0; i < 2; ++i) o2[h][i] = (GATHER && last && has_next) ? nao[h][i] : cao[h][i];
            G8_LDB(B0, 0, 0); G8_LDB(B1, 0, 1); G8_SCHED; G8_LDA(At, 0, 0); G8_STAGE(G8_SA(1, 1), a1, cao[1][0], cao[1][1]);
            G8_WAIT_V(8); G8_WAIT_L(0); G8_BAR; G8_MMA(0, 0, At, B0); G8_MMA(0, 1, At, B1); G8_BAR; G8_SCHED;
            G8_LDA(At, 0, 1); G8_STAGE_B(G8_SB(0, 0), b2); G8_STAGE_B(G8_SB(0, 1), b2 + hstep); G8_STAGE(G8_SA(0, 0), a2, o2[0][0], o2[0][1]);
            G8_WAIT_V(8); G8_WAIT_L(0); G8_BAR; G8_MMA(1, 0, At, B0); G8_MMA(1, 1, At, B1); G8_BAR; G8_SCHED;
            G8_LDB(B0, 1, 0); G8_LDB(B1, 1, 1); G8_SCHED; G8_LDA(At, 1, 0); G8_STAGE(G8_SA(0, 1), a2, o2[1][0], o2[1][1]);
            G8_WAIT_V(8); G8_WAIT_L(0); G8_BAR; G8_MMA(0, 0, At, B0); G8_MMA(0, 1, At, B1); G8_BAR; G8_SCHED;
            G8_LDA(At, 1, 1); G8_STAGE_B(G8_SB(1, 0), b3); G8_STAGE_B(G8_SB(1, 1), b3 + hstep); G8_STAGE(G8_SA(1, 0), a3, o2[0][0], o2[0][1]);
            G8_WAIT_V(8); G8_WAIT_L(0); G8_BAR; G8_MMA(1, 0, At, B0); G8_MMA(1, 1, At, B1); G8_BAR; G8_SCHED;
        }
        if constexpr (F8) asm volatile("s_nop 15\n\ts_nop 15" ::: "memory");
        if constexpr (ALIGN_EPI) { if (wr == 0) G8_BAR; }
        {
          GUnit eu = cur; int fr_ = fr, fq_ = fq; asm volatile("" : "+s"(eu.pm), "+s"(eu.pn), "+s"(eu.e), "+s"(eu.r0)); asm volatile("" : "+v"(fr_), "+v"(fq_));
          E(acc, eu, wr, wc, fr_, fq_); S.done(cur); }
        if (!has_next) break;
#pragma unroll
        for (int a = 0; a < 2; ++a)
#pragma unroll
            for (int b = 0; b < 2; ++b)
#pragma unroll
                for (int m = 0; m < 4; ++m)
#pragma unroll
                    for (int n = 0; n < 2; ++n) acc[a][b][m][n] = (f32x4){0.f, 0.f, 0.f, 0.f};
        cur = nxt; cA = nA; cB = nB; ++ui;
#pragma unroll
        for (int h = 0; h < 2; ++h)
#pragma unroll
            for (int i = 0; i < 2; ++i) cao[h][i] = nao[h][i];
        if constexpr (ALIGN_EPI) { if (wr == 1) G8_BAR; }
    }
    G8_WAIT_V(0);
    if constexpr (!ALIGN_EPI) { if (wr == 0) G8_BAR; }
    G8_BAR;
#undef G8_SA
#undef G8_SB
#undef G8_STAGE
#undef G8_STAGE_B
#undef G8_LDA
#undef G8_LDB
#undef G8_MMA
#undef G8_WAIT_V
#undef G8_WAIT_L
#undef G8_BAR
#undef G8_SCHED
}

__device__ __forceinline__ u32x4 pack8(const f32x4 v0, const f32x4 v1) { u32x4 w; w.x = cvt_pk_bf16(v0[0], v0[1]); w.y = cvt_pk_bf16(v0[2], v0[3]); w.z = cvt_pk_bf16(v1[0], v1[1]); w.w = cvt_pk_bf16(v1[2], v1[3]); return w; }
__device__ __forceinline__ float sigmoidf_(float v) { return __builtin_amdgcn_rcpf(1.f + __builtin_amdgcn_exp2f(-1.4426950408889634f * v)); }

struct EpiProj {
    static constexpr bool PERM = true;
    bf16_t *qb, *kb, *vb, *ub, *gb; const float* rope; const float* gate_bias;
    __device__ __forceinline__ void operator()(const f32x4 (&acc)[2][2][4][2], const GUnit& u, int wr, int wc, int fr, int fq) const {
        const int row0 = u.pm * BM + wr * 64 + fr; const int cw = wc * 32 + 8 * fq; const int pn = u.pn;
#ifdef DBG_PLAIN_EPI
        if (pn < 8) { bf16_t* base = (pn < 4 ? qb : kb) + (pn & 3) * 256 + cw;
            for (int ai = 0; ai < 2; ++ai) for (int m = 0; m < 4; ++m) { const int t = row0 + ai * HALF + m * 16; for (int bj = 0; bj < 2; ++bj) *(u32x4*)(base + (size_t)t * 1024 + bj * HALF) = pack8(acc[ai][bj][m][0], acc[ai][bj][m][1]); } }
        else
#endif
        if (pn < 8) {
            bf16_t* base = (pn < 4 ? qb : kb) + (pn & 3) * 256 + cw; const float sc = pn < 4 ? QSCALE : 1.f; const int fi = 16 * (wc & 1) + 4 * fq;
#pragma unroll
            for (int ai = 0; ai < 2; ++ai)
#pragma unroll
                for (int m = 0; m < 4; ++m) { const int t = row0 + ai * HALF + m * 16; const f32x4 cs0 = *(const f32x4*)(rope + ((size_t)t * 32 + fi) * 2), cs1 = *(const f32x4*)(rope + ((size_t)t * 32 + fi) * 2 + 4);
                    const f32x4 c = {cs0[0], cs0[2], cs1[0], cs1[2]}, s = {cs0[1], cs0[3], cs1[1], cs1[3]};
#pragma unroll
                    for (int bj = 0; bj < 2; ++bj) { const f32x4 t1 = acc[ai][bj][m][0], t2 = acc[ai][bj][m][1]; const f32x4 o1 = (t1 * c - t2 * s) * sc, o2 = (t2 * c + t1 * s) * sc;
                        *(u32x4*)(base + (size_t)t * 1024 + bj * HALF) = pack8(o1, o2); } }
        } else if (pn < 14) {
            bf16_t* base; int ld; if (pn < 12) { base = vb + (pn - 8) * 256 + cw; ld = 1024; } else { base = ub + (pn - 12) * 256 + cw; ld = 512; }
#pragma unroll
            for (int ai = 0; ai < 2; ++ai)
#pragma unroll
                for (int m = 0; m < 4; ++m) { const int t = row0 + ai * HALF + m * 16;
#pragma unroll
                    for (int bj = 0; bj < 2; ++bj) *(u32x4*)(base + (size_t)t * ld + bj * HALF) = pack8(acc[ai][bj][m][0], acc[ai][bj][m][1]); }
        }
#ifdef DBG_PLAIN_EPI
        else { const int col0 = (pn - 14) * 256 + cw;
            for (int ai = 0; ai < 2; ++ai) for (int m = 0; m < 4; ++m) { const int t = row0 + ai * HALF + m * 16; for (int bj = 0; bj < 2; ++bj) *(u32x4*)(gb + (size_t)t * 2048 + col0 + bj * HALF) = pack8(acc[ai][bj][m][0], acc[ai][bj][m][1]); } }
#else
        else {
            const int col0 = (pn - 14) * 256 + cw; f32x4 bv[2][2];
#pragma unroll
            for (int bj = 0; bj < 2; ++bj)
#pragma unroll
                for (int n = 0; n < 2; ++n) bv[bj][n] = *(const f32x4*)(gate_bias + col0 + bj * HALF + 4 * n);
#pragma unroll
            for (int ai = 0; ai < 2; ++ai)
#pragma unroll
                for (int m = 0; m < 4; ++m) { const int t = row0 + ai * HALF + m * 16;
#pragma unroll
                    for (int bj = 0; bj < 2; ++bj) { f32x4 v0 = acc[ai][bj][m][0] + bv[bj][0], v1 = acc[ai][bj][m][1] + bv[bj][1];
#pragma unroll
                        for (int j = 0; j < 4; ++j) { v0[j] = sigmoidf_(v0[j]); v1[j] = sigmoidf_(v1[j]); }
                        *(u32x4*)(gb + (size_t)t * 2048 + col0 + bj * HALF) = pack8(v0, v1); } }
        }
#endif
    }
};
struct EpiScaleBf16 {
    static constexpr bool PERM = true;
    bf16_t* O; int ldc; const float* colscale;
    __device__ __forceinline__ void operator()(const f32x4 (&acc)[2][2][4][2], const GUnit& u, int wr, int wc, int fr, int fq) const {
        const int row0 = u.pm * BM + wr * 64 + fr, col0 = u.pn * BM + wc * 32 + 8 * fq; f32x4 sv[2][2];
#pragma unroll
        for (int bj = 0; bj < 2; ++bj)
#pragma unroll
            for (int n = 0; n < 2; ++n) sv[bj][n] = *(const f32x4*)(colscale + col0 + bj * HALF + 4 * n);
#pragma unroll
        for (int ai = 0; ai < 2; ++ai)
#pragma unroll
            for (int m = 0; m < 4; ++m) { bf16_t* rowp = O + (size_t)(row0 + ai * HALF + m * 16) * ldc + col0;
#pragma unroll
                for (int bj = 0; bj < 2; ++bj) *(u32x4*)(rowp + bj * HALF) = pack8(acc[ai][bj][m][0] * sv[bj][0], acc[ai][bj][m][1] * sv[bj][1]); }
    }
};
struct EpiGates {
    static constexpr bool PERM = true;
    unsigned char* gb; const float* gate_bias;
    __device__ __forceinline__ void operator()(const f32x4 (&acc)[2][2][4][2], const GUnit& u, int wr, int wc, int fr, int fq) const {
        const int row0 = u.pm * BM + wr * 64 + fr; const int col0 = u.pn * 256 + wc * 32 + 8 * fq; f32x4 bv[2][2];
#pragma unroll
        for (int bj = 0; bj < 2; ++bj)
#pragma unroll
            for (int n = 0; n < 2; ++n) bv[bj][n] = *(const f32x4*)(gate_bias + col0 + bj * HALF + 4 * n);
#pragma unroll
        for (int ai = 0; ai < 2; ++ai)
#pragma unroll
            for (int m = 0; m < 4; ++m) { const int t = row0 + ai * HALF + m * 16; unsigned lo[2], hi[2];
#pragma unroll
                for (int bj = 0; bj < 2; ++bj) { const f32x4 v0 = acc[ai][bj][m][0] + bv[bj][0], v1 = acc[ai][bj][m][1] + bv[bj][1]; unsigned a = 0u, b = 0u;
                    a = __builtin_amdgcn_cvt_pk_u8_f32(255.f * sigmoidf_(v0[0]), 0, a); a = __builtin_amdgcn_cvt_pk_u8_f32(255.f * sigmoidf_(v0[1]), 1, a); a = __builtin_amdgcn_cvt_pk_u8_f32(255.f * sigmoidf_(v0[2]), 2, a); a = __builtin_amdgcn_cvt_pk_u8_f32(255.f * sigmoidf_(v0[3]), 3, a);
                    b = __builtin_amdgcn_cvt_pk_u8_f32(255.f * sigmoidf_(v1[0]), 0, b); b = __builtin_amdgcn_cvt_pk_u8_f32(255.f * sigmoidf_(v1[1]), 1, b); b = __builtin_amdgcn_cvt_pk_u8_f32(255.f * sigmoidf_(v1[2]), 2, b); b = __builtin_amdgcn_cvt_pk_u8_f32(255.f * sigmoidf_(v1[3]), 3, b);
                    lo[bj] = a; hi[bj] = b; }
                const auto sl = __builtin_amdgcn_permlane16_swap(lo[0], lo[1], false, false); const auto sh = __builtin_amdgcn_permlane16_swap(hi[0], hi[1], false, false);
                const u32x4 w = {sl[0], sh[0], sl[1], sh[1]};
                *(u32x4*)(gb + (size_t)t * 2048 + col0 + ((fq & 1) ? HALF - 8 : 0)) = w; }
    }
};
template <int BR> struct EpiMerge {
    static constexpr bool PERM = true;
    const unsigned char* gates; bf16_t* merged; bf16_t* dst;
    __device__ __forceinline__ void operator()(const f32x4 (&acc)[2][2][4][2], const GUnit& u, int wr, int wc, int fr, int fq) const {
        const int row0 = u.pm * BM + wr * 64 + fr, col0 = u.pn * BM + wc * 32 + 8 * fq;
#pragma unroll
        for (int ai = 0; ai < 2; ++ai)
#pragma unroll
            for (int m = 0; m < 4; ++m) { const size_t t = row0 + ai * HALF + m * 16;
#pragma unroll
                for (int bj = 0; bj < 2; ++bj) { const u32x2 g = *(const u32x2*)(gates + t * 2048 + BR * 1024 + col0 + bj * HALF); bf16_t* mp = merged + t * 1024 + col0 + bj * HALF;
                    f32x4 v0 = acc[ai][bj][m][0], v1 = acc[ai][bj][m][1]; constexpr float I255 = 1.f / 255.f;
                    v0 = v0 * ((f32x4){(float)(g.x & 0xffu), (float)((g.x >> 8) & 0xffu), (float)((g.x >> 16) & 0xffu), (float)(g.x >> 24)} * I255);
                    v1 = v1 * ((f32x4){(float)(g.y & 0xffu), (float)((g.y >> 8) & 0xffu), (float)((g.y >> 16) & 0xffu), (float)(g.y >> 24)} * I255);
                    if (BR) { const u32x4 p = *(const u32x4*)mp; v0 = v0 + (f32x4){bflo(p.x), bfhi(p.x), bflo(p.y), bfhi(p.y)}; v1 = v1 + (f32x4){bflo(p.z), bfhi(p.z), bflo(p.w), bfhi(p.w)}; }
                    *(u32x4*)(dst + t * 1024 + col0 + bj * HALF) = pack8(v0, v1); } }
    }
};
struct EpiResid {
    static constexpr bool PERM = true;
    const bf16_t* x; bf16_t* y; float2* part;
    __device__ __forceinline__ void operator()(const f32x4 (&acc)[2][2][4][2], const GUnit& u, int wr, int wc, int fr, int fq) const {
        const int row0 = u.pm * BM + wr * 64 + fr, col0 = u.pn * BM + wc * 32 + 8 * fq;
#pragma unroll
        for (int ai = 0; ai < 2; ++ai)
#pragma unroll
            for (int m = 0; m < 4; ++m) { const size_t row = (size_t)(row0 + ai * HALF + m * 16); const size_t off = row * 1024 + col0; float s1 = 0.f, s2 = 0.f;
#pragma unroll
                for (int bj = 0; bj < 2; ++bj) { const u32x4 xw = *(const u32x4*)(x + off + bj * HALF); const f32x4 x0 = {bflo(xw.x), bfhi(xw.x), bflo(xw.y), bfhi(xw.y)}, x1 = {bflo(xw.z), bfhi(xw.z), bflo(xw.w), bfhi(xw.w)};
                    const f32x4 y0 = x0 * ALPHA + acc[ai][bj][m][0], y1 = x1 * ALPHA + acc[ai][bj][m][1]; *(u32x4*)(y + off + bj * HALF) = pack8(y0, y1);
                    s1 += ((y0[0] + y0[1]) + (y0[2] + y0[3])) + ((y1[0] + y1[1]) + (y1[2] + y1[3]));
                    s2 += ((y0[0] * y0[0] + y0[1] * y0[1]) + (y0[2] * y0[2] + y0[3] * y0[3])) + ((y1[0] * y1[0] + y1[1] * y1[1]) + (y1[2] * y1[2] + y1[3] * y1[3])); }
                s1 += __shfl_xor(s1, 16); s1 += __shfl_xor(s1, 32); s2 += __shfl_xor(s2, 16); s2 += __shfl_xor(s2, 32);
                if (fq == 0) part[row * 16 + u.pn * 4 + wc] = make_float2(s1, s2); }
    }
};
struct EpiGateUp {
    static constexpr bool PERM = true;
    bf16_t* h;
    __device__ __forceinline__ void operator()(const f32x4 (&acc)[2][2][4][2], const GUnit& u, int wr, int wc, int fr, int fq) const {
        const int row0 = u.pm * BM + wr * 64 + fr, col0 = u.pn * 128 + wc * 16 + 4 * fq;
#pragma unroll
        for (int ai = 0; ai < 2; ++ai)
#pragma unroll
            for (int m = 0; m < 4; ++m) { bf16_t* rowp = h + (size_t)(row0 + ai * HALF + m * 16) * 512 + col0;
#pragma unroll
                for (int bj = 0; bj < 2; ++bj) { const f32x4 g = acc[ai][bj][m][0], up = acc[ai][bj][m][1]; f32x4 o;
#pragma unroll
                    for (int j = 0; j < 4; ++j) o[j] = g[j] * sigmoidf_(g[j]) * up[j];
                    const unsigned long long w = (unsigned long long)cvt_pk_bf16(o[0], o[1]) | ((unsigned long long)cvt_pk_bf16(o[2], o[3]) << 32);
                    __hip_atomic_store((unsigned long long*)(rowp + bj * 64), w, __ATOMIC_RELAXED, __HIP_MEMORY_SCOPE_AGENT); } }
    }
};
struct EpiDown {
    static constexpr bool PERM = true;
    bf16_t* ybuf; const int* list; const float* rw; const volatile LAS unsigned* cntl;
    __device__ __forceinline__ void operator()(const f32x4 (&acc)[2][2][4][2], const GUnit& u, int wr, int wc, int fr, int fq) const {
        const int p0 = u.r0 + wr * 64 + fr, col0 = u.pn * BM + wc * 32 + 8 * fq; const int cn = (int)cntl[u.e];
#pragma unroll
        for (int ai = 0; ai < 2; ++ai)
#pragma unroll
            for (int m = 0; m < 4; ++m) { const int p = p0 + ai * HALF + m * 16;
                if (p < cn) { const int ent = list[(size_t)u.e * T + p]; const float w = rw[ent]; bf16_t* rowp = ybuf + (size_t)ent * 1024 + col0;
#pragma unroll
                    for (int bj = 0; bj < 2; ++bj) *(u32x4*)(rowp + bj * HALF) = pack8(acc[ai][bj][m][0] * w, acc[ai][bj][m][1] * w); } }
    }
};
}

namespace at2 {
using f32x16 = __attribute__((ext_vector_type(16))) float;
using s16x4  = __attribute__((ext_vector_type(4))) short;
constexpr int KB_BYTES = 8192, VB_BYTES = 16384, KSLOT = 2 * KB_BYTES, NKS = 4, NVS = 3, OFF_V = NKS * KSLOT;
constexpr int OFF_Q = OFF_V + NVS * VB_BYTES, OFF_WS = 151552;
#define AT_SBAR() __builtin_amdgcn_sched_barrier(0)
__device__ __forceinline__ int crow(int r, int hi) { return (r & 3) + 8 * (r >> 2) + 4 * hi; }
__device__ __forceinline__ int v_st(int k, int c) { const int kk = (k & ~0xC) | ((k & 4) << 1) | ((k & 8) >> 1); return ((kk >> 3) * 4 + (c >> 5)) * 512 + ((kk & 7) * 32 + (c & 31)) * 2; }
__device__ __forceinline__ int v_rd_base(int lane) { return ((lane & 3) << 3) | (((lane >> 2) & 3) << 6) | (((lane >> 4) & 1) << 5) | (((lane >> 5) & 1) << 8); }
constexpr int v_rd_off(int d0, int ks, int half) { return d0 * 512 + ks * 4096 + half * 2048; }
template <int OFF> __device__ __forceinline__ s16x4 tr_read(int vb) { s16x4 r; asm volatile("ds_read_b64_tr_b16 %0, %1 offset:%2" : "=&v"(r) : "v"(vb), "i"(OFF) : "memory"); return r; }
template <int D0> __device__ __forceinline__ void pv_one(f32x16& od, int vb, bf16x8 pa0, bf16x8 pa1, bf16x8 pa2, bf16x8 pa3) {
    const s16x4 l0 = tr_read<v_rd_off(D0, 0, 0)>(vb), h0 = tr_read<v_rd_off(D0, 0, 1)>(vb), l1 = tr_read<v_rd_off(D0, 1, 0)>(vb), h1 = tr_read<v_rd_off(D0, 1, 1)>(vb);
    const s16x4 l2 = tr_read<v_rd_off(D0, 2, 0)>(vb), h2 = tr_read<v_rd_off(D0, 2, 1)>(vb), l3 = tr_read<v_rd_off(D0, 3, 0)>(vb), h3 = tr_read<v_rd_off(D0, 3, 1)>(vb);
    asm volatile("s_waitcnt lgkmcnt(0)" ::: "memory"); AT_SBAR();
#define AT_PK(L, H) (bf16x8){L[0], L[1], L[2], L[3], H[0], H[1], H[2], H[3]}
    __builtin_amdgcn_s_setprio(1);
    od = __builtin_amdgcn_mfma_f32_32x32x16_bf16(pa0, AT_PK(l0, h0), od, 0, 0, 0);
    od = __builtin_amdgcn_mfma_f32_32x32x16_bf16(pa1, AT_PK(l1, h1), od, 0, 0, 0);
    od = __builtin_amdgcn_mfma_f32_32x32x16_bf16(pa2, AT_PK(l2, h2), od, 0, 0, 0);
    od = __builtin_amdgcn_mfma_f32_32x32x16_bf16(pa3, AT_PK(l3, h3), od, 0, 0, 0);
    __builtin_amdgcn_s_setprio(0);
#undef AT_PK
}
__device__ __forceinline__ void qkt(f32x16& p0, f32x16& p1, const LAS unsigned char* Ks, const bf16x8* qr, int r32, int hi) {
    p0 = f32x16{}; p1 = f32x16{};
#pragma unroll
    for (int d0 = 0; d0 < 4; ++d0) { const LAS unsigned char* kp = Ks + (2 * d0 + hi) * 1024 + r32 * 16;
        const bf16x8 b0 = *(const LAS bf16x8*)(kp), b1 = *(const LAS bf16x8*)(kp + 512);
        p0 = __builtin_amdgcn_mfma_f32_32x32x16_bf16(b0, qr[d0], p0, 0, 0, 0);
        p1 = __builtin_amdgcn_mfma_f32_32x32x16_bf16(b1, qr[d0], p1, 0, 0, 0); }
}
__device__ __forceinline__ float hswap_max(float v) { auto rr = __builtin_amdgcn_permlane32_swap(__float_as_uint(v), __float_as_uint(v), false, false); return fmaxf(__uint_as_float(rr[0]), __uint_as_float(rr[1])); }
__device__ __forceinline__ float hswap_sum(float v) { auto rr = __builtin_amdgcn_permlane32_swap(__float_as_uint(v), __float_as_uint(v), false, false); return __uint_as_float(rr[0]) + __uint_as_float(rr[1]); }

struct AtUnit { int b, head, qblk; };
struct AtAddr { const char* Kb; const char* Vb; unsigned kofs0, kofs1, vofs0, vofs1; };
__device__ __forceinline__ void at_addr(AtAddr& a, const AtUnit& un, int wid, int lane, const bf16_t* __restrict__ K, const bf16_t* __restrict__ V) {
    const int mp = wid >> 2, wq = wid & 3, hm = un.head * 2 + mp; const size_t rowbase = (size_t)un.b * SEQ;
    a.Kb = (const char*)(K + rowbase * 1024); a.Vb = (const char*)(V + rowbase * 1024);
    unsigned ko[2], vo[2];
#pragma unroll
    for (int i = 0; i < 2; ++i) { const int ch = 2 * wq + i; ko[i] = (unsigned)(lane * 2048 + hm * 128 + ch * 16);
        const int p = 2 * wid + i; const int kk = (p >> 1) * 8 + ((lane & 31) >> 2); const int k = (kk & ~0xC) | ((kk & 4) << 1) | ((kk & 8) >> 1); const int c = (2 * (p & 1) + (lane >> 5)) * 32 + (lane & 3) * 8;
        vo[i] = (unsigned)(k * 2048 + un.head * 256 + c * 2); }
    a.kofs0 = ko[0]; a.kofs1 = ko[1]; a.vofs0 = vo[0]; a.vofs1 = vo[1];
}
#define AT_DMA_K(AD, j, KO) do { const char* kj_ = (AD).Kb + (size_t)(j) * 131072; \
        __builtin_amdgcn_global_load_lds((const unsigned*)(kj_ + (AD).kofs0), (LAS unsigned*)(lds + (KO) + kdst), 16, 0, 0); __builtin_amdgcn_global_load_lds((const unsigned*)(kj_ + (AD).kofs1), (LAS unsigned*)(lds + (KO) + kdst + 1024), 16, 0, 0); } while (0)
#define AT_DMA_V(AD, j, VO) do { const char* vj_ = (AD).Vb + (size_t)(j) * 131072; \
        __builtin_amdgcn_global_load_lds((const unsigned*)(vj_ + (AD).vofs0), (LAS unsigned*)(lds + (VO) + vdst), 16, 0, 0); __builtin_amdgcn_global_load_lds((const unsigned*)(vj_ + (AD).vofs1), (LAS unsigned*)(lds + (VO) + vdst + 1024), 16, 0, 0); } while (0)
__device__ __forceinline__ void at_prefetch(LAS unsigned char* lds, const AtUnit& un, const bf16_t* __restrict__ Q, const bf16_t* __restrict__ K, const bf16_t* __restrict__ V, bf16x8 (&qr)[4]) {
    const int tid = threadIdx.x, lane = tid & 63, r32 = lane & 31, hi = lane >> 5; const int wid = __builtin_amdgcn_readfirstlane(tid >> 6); const int mp = wid >> 2, wq = wid & 3;
    AtAddr ad; at_addr(ad, un, wid, lane, K, V);
    const unsigned kdst = (unsigned)(mp * KB_BYTES + (2 * wq) * 1024), vdst = (unsigned)(OFF_V + (2 * wid) * 1024);
    AT_DMA_K(ad, 0, 0); AT_DMA_V(ad, 0, 0); AT_DMA_K(ad, 1, KSLOT);
    const bf16_t* qp = Q + ((size_t)un.b * SEQ + un.qblk * 128 + wq * 32 + r32) * 1024 + (un.head * 2 + mp) * 64 + hi * 8;
#pragma unroll
    for (int d0 = 0; d0 < 4; ++d0) qr[d0] = *(const bf16x8*)(qp + d0 * 16);
    asm volatile("" ::: "memory"); AT_SBAR();
}
template <unsigned var> __device__ __forceinline__ void attn_unit(LAS unsigned char* lds, const AtUnit cu, const AtUnit nu, const bool has_next, const bool first, const bf16_t* __restrict__ Q, const bf16_t* __restrict__ K, const bf16_t* __restrict__ V,
                                          bf16_t* __restrict__ O, const float lam, const float* __restrict__ gain, bf16x8 (&qr)[4]) {
    const int tid = threadIdx.x, lane = tid & 63, r32 = lane & 31, hi = lane >> 5; const int wid = __builtin_amdgcn_readfirstlane(tid >> 6); const int mp = wid >> 2, wq = wid & 3;
    const int head = cu.head, qblk = cu.qblk; const size_t rowbase = (size_t)cu.b * SEQ; const int q0 = qblk * 128;
    const int mychunk = 2 * qblk + (wq >> 1); const int NT = 2 * qblk + 2;
    LAS float* wsf = (LAS float*)(lds + OFF_WS) + wid * 64;
    AtAddr ad; at_addr(ad, cu, wid, lane, K, V);
    const unsigned kdst = (unsigned)(mp * KB_BYTES + (2 * wq) * 1024), vdst = (unsigned)(OFF_V + (2 * wid) * 1024);
    float mhat = 0.f, l_reg = 0.f; f32x16 o[4] = {};
    const int vb0 = (int)(uintptr_t)(lds + OFF_V) + v_rd_base(lane);
    const LAS unsigned char* kb0 = lds + mp * KB_BYTES;
    constexpr float THR = 8.f;
    f32x16 pA0 = {}, pA1 = {}, pB0 = {}, pB1 = {}; float alA = 1.f, alB = 1.f; bool rsA = false, rsB = false;
    int kcur = 0, k1 = KSLOT, k2 = 2 * KSLOT;
    int vprev = 2 * VB_BYTES, vcur = 0, vnext = VB_BYTES;
#define AT_ROT() do { kcur = k1; k1 = k2; k2 = (k2 == (NKS - 1) * KSLOT) ? 0 : k2 + KSLOT; vprev = vcur; vcur = vnext; vnext = (vnext == (NVS - 1) * VB_BYTES) ? 0 : vnext + VB_BYTES; } while (0)
#define AT_QKT(P0, P1, SL) do { const LAS unsigned char* kp_ = kb0 + (SL) + hi * 1024 + r32 * 16; P0 = f32x16{}; P1 = f32x16{}; __builtin_amdgcn_s_setprio(1); \
        _Pragma("unroll") for (int d0 = 0; d0 < 4; ++d0) { const bf16x8 b0_ = *(const LAS bf16x8*)(kp_ + d0 * 2048), b1_ = *(const LAS bf16x8*)(kp_ + d0 * 2048 + 512); const bf16x8 q_ = qr[d0]; \
            P0 = __builtin_amdgcn_mfma_f32_32x32x16_bf16(b0_, q_, P0, 0, 0, 0); P1 = __builtin_amdgcn_mfma_f32_32x32x16_bf16(b1_, q_, P1, 0, 0, 0); } __builtin_amdgcn_s_setprio(0); } while (0)
#define AT_PSM(P0, P1, AL, RS, FIRST) do { float pm_ = P0[0]; _Pragma("unroll") for (int r = 1; r < 16; ++r) pm_ = fmaxf(pm_, P0[r]); _Pragma("unroll") for (int r = 0; r < 16; ++r) pm_ = fmaxf(pm_, P1[r]); \
        pm_ = hswap_max(pm_) - mhat; RS = (FIRST) || __any(pm_ > THR); AL = 1.f; \
        if (RS) { const float dl_ = (FIRST) ? pm_ : fmaxf(pm_, 0.f); mhat += dl_; AL = __builtin_amdgcn_exp2f(-dl_); } \
        _Pragma("unroll") for (int r = 0; r < 16; ++r) { P0[r] = __builtin_amdgcn_exp2f(P0[r] - mhat); P1[r] = __builtin_amdgcn_exp2f(P1[r] - mhat); } } while (0)
#define AT_PK4(P, BASE, OUT) do { const unsigned a0 = cvt_pk_bf16(P[BASE + 0], P[BASE + 1]), a1 = cvt_pk_bf16(P[BASE + 2], P[BASE + 3]); \
        const unsigned b0 = cvt_pk_bf16(P[BASE + 4], P[BASE + 5]), b1 = cvt_pk_bf16(P[BASE + 6], P[BASE + 7]); \
        auto r0_ = __builtin_amdgcn_permlane32_swap(a0, b0, false, false); auto r1_ = __builtin_amdgcn_permlane32_swap(a1, b1, false, false); \
        u32x4 w_ = {r0_[0], r1_[0], r0_[1], r1_[1]}; OUT = __builtin_bit_cast(bf16x8, w_); } while (0)
#define AT_FIN_PV(P0, P1, AL, SL) do { float ps_ = 0.f; _Pragma("unroll") for (int r = 0; r < 16; ++r) ps_ += P0[r]; _Pragma("unroll") for (int r = 0; r < 16; ++r) ps_ += P1[r]; \
        ps_ = hswap_sum(ps_); l_reg = l_reg * (AL) + ps_; bf16x8 pa0, pa1, pa2, pa3; AT_PK4(P0, 0, pa0); AT_PK4(P0, 8, pa1); AT_PK4(P1, 0, pa2); AT_PK4(P1, 8, pa3); const int vb_ = vb0 + (SL); \
        pv_one<0>(o[0], vb_, pa0, pa1, pa2, pa3); pv_one<1>(o[1], vb_, pa0, pa1, pa2, pa3); pv_one<2>(o[2], vb_, pa0, pa1, pa2, pa3); pv_one<3>(o[3], vb_, pa0, pa1, pa2, pa3); } while (0)
#define AT_RESC(AL, RS) do { if (RS) { if (hi == 0) wsf[r32] = (AL); asm volatile("s_waitcnt lgkmcnt(0)" ::: "memory"); \
        _Pragma("unroll") for (int r = 0; r < 16; ++r) { const float a_ = wsf[crow(r, hi)]; _Pragma("unroll") for (int d = 0; d < 4; ++d) o[d][r] *= a_; } } } while (0)
#define AT_STEP0(u, PC0, PC1, ALC, RSC, PP0, PP1, ALP) do { const bool nk_ = (u) + 2 < NT && !(var & 2u), nv_ = (u) + 1 < NT && !(var & 2u); if (nk_) AT_DMA_K(ad, (u) + 2, k2); if (nv_) AT_DMA_V(ad, (u) + 1, vnext); \
        const bool aX_ = (u) < NT && (u) <= mychunk, aF_ = (u) >= 1 && (u) - 1 <= mychunk; \
        if (aX_ && !(var & 16u)) AT_QKT(PC0, PC1, kcur); \
        if (aF_ && !(var & 4u)) AT_FIN_PV(PP0, PP1, ALP, vprev); \
        if (aX_ && !(var & 8u)) { AT_PSM(PC0, PC1, ALC, RSC, (u) == 0); AT_RESC(ALC, RSC); } \
        if (nk_) asm volatile("s_waitcnt vmcnt(4)" ::: "memory"); else if (nv_) asm volatile("s_waitcnt vmcnt(2)" ::: "memory"); else asm volatile("s_waitcnt vmcnt(0)" ::: "memory"); \
        __syncthreads(); AT_ROT(); } while (0)
    if (first || mp == 1) asm volatile("s_waitcnt vmcnt(0)" ::: "memory"); else asm volatile("s_waitcnt vmcnt(8)" ::: "memory");
    __syncthreads();
    for (int u = 0; u < NT; u += 2) { AT_STEP0(u, pA0, pA1, alA, rsA, pB0, pB1, alB); AT_STEP0(u + 1, pB0, pB1, alB, rsB, pA0, pA1, alA); }
    { const int u = NT; AT_STEP0(u, pA0, pA1, alA, rsA, pB0, pB1, alB); }
#undef AT_ROT
#undef AT_QKT
#undef AT_PSM
#undef AT_PK4
#undef AT_FIN_PV
#undef AT_RESC
#undef AT_STEP0
    if (has_next) at_prefetch(lds, nu, Q, K, V, qr);
    if (hi == 0) wsf[r32] = 1.f / l_reg;
    asm volatile("s_waitcnt lgkmcnt(0)" ::: "memory");
    float rli[16];
#pragma unroll
    for (int r = 0; r < 16; ++r) rli[r] = wsf[crow(r, hi)];
    LAS float* xch = (LAS float*)(lds + (wq < 2 ? 32768 + wq * 16384 : 81920 + (wq - 2) * 16384));
    if (mp == 1) {
#pragma unroll
        for (int d = 0; d < 4; ++d)
#pragma unroll
            for (int r4 = 0; r4 < 4; ++r4) *(LAS f32x4*)(xch + ((d * 4 + r4) * 64 + lane) * 4) = (f32x4){o[d][4 * r4] * rli[4 * r4], o[d][4 * r4 + 1] * rli[4 * r4 + 1], o[d][4 * r4 + 2] * rli[4 * r4 + 2], o[d][4 * r4 + 3] * rli[4 * r4 + 3]};
    }
    __syncthreads();
    if (mp == 0) {
#pragma unroll
        for (int d = 0; d < 4; ++d)
#pragma unroll
            for (int r4 = 0; r4 < 4; ++r4) { const f32x4 v2 = *(const LAS f32x4*)(xch + ((d * 4 + r4) * 64 + lane) * 4);
#pragma unroll
                for (int e = 0; e < 4; ++e) o[d][4 * r4 + e] = o[d][4 * r4 + e] * rli[4 * r4 + e] - lam * v2[e]; }
    }
    __syncthreads();
    LAS float* stg = (LAS float*)(lds + (wq == 0 ? 32768 : 81920 + (wq - 1) * 16896));
    if (mp == 0) {
#pragma unroll
        for (int d = 0; d < 4; ++d)
#pragma unroll
            for (int r = 0; r < 16; ++r) stg[crow(r, hi) * 132 + d * 32 + r32] = o[d][r];
        asm volatile("s_waitcnt lgkmcnt(0)" ::: "memory");
        const int row = lane >> 1, ch = (lane & 1) * 64; const LAS float* sp = stg + row * 132 + ch; float vv[64]; float ss = 0.f;
#pragma unroll
        for (int i = 0; i < 16; ++i) { const f32x4 t4 = *(const LAS f32x4*)(sp + 4 * i); vv[4 * i] = t4[0]; vv[4 * i + 1] = t4[1]; vv[4 * i + 2] = t4[2]; vv[4 * i + 3] = t4[3]; ss += (t4[0] * t4[0] + t4[1] * t4[1]) + (t4[2] * t4[2] + t4[3] * t4[3]); }
        ss += __shfl_xor(ss, 1);
        const float rs = (1.0f / sqrtf(ss * (1.f / 128.f) + RMS_EPS)) * (1.f - LAMBDA_INIT);
        bf16_t* op = O + (rowbase + q0 + wq * 32 + row) * 1024 + head * 128 + ch; const float* gp = gain + ch;
#pragma unroll
        for (int i = 0; i < 8; ++i) { const f32x4 g0 = *(const f32x4*)(gp + 8 * i), g1 = *(const f32x4*)(gp + 8 * i + 4); u32x4 w;
            w.x = cvt_pk_bf16(vv[8 * i] * rs * g0[0], vv[8 * i + 1] * rs * g0[1]); w.y = cvt_pk_bf16(vv[8 * i + 2] * rs * g0[2], vv[8 * i + 3] * rs * g0[3]);
            w.z = cvt_pk_bf16(vv[8 * i + 4] * rs * g1[0], vv[8 * i + 5] * rs * g1[1]); w.w = cvt_pk_bf16(vv[8 * i + 6] * rs * g1[2], vv[8 * i + 7] * rs * g1[3]);
            *(u32x4*)(op + 8 * i) = w; }
    }
}
template <unsigned var> __device__ __forceinline__ void attn_phase(LAS unsigned char* lds, int vcu, int ncu, const bf16_t* Q, const bf16_t* K, const bf16_t* V, bf16_t* O, const float* scal, const float* gain) {
    const float lam = scal[0];
    const int hb = ncu >> 1; const int nun = (vcu >> 1) < NB * NHEAD ? ((NB * NHEAD - 1 - (vcu >> 1)) / hb + 1) * 8 : 0;
    auto unit_of = [&](int i) { if (ncu == 256) { const int j = vcu & 15; const int bh = (vcu >> 5) * 16 + i * 2 + ((vcu >> 4) & 1); return AtUnit{bh >> 3, bh & 7, (i & 1) ? 15 - j : j}; }
        const int bh = (vcu >> 1) + (i >> 3) * hb; const int s = (vcu & 1) + 2 * ((i & 7) >> 1); return AtUnit{bh >> 3, bh & 7, (i & 1) ? 15 - s : s}; };
    if (nun == 0) return;
    bf16x8 qr[4]; AtUnit cu = unit_of(0); at_prefetch(lds, cu, Q, K, V, qr);
    for (int i = 0; i < nun; ++i) { const bool hn = i + 1 < nun; const AtUnit nu = unit_of(hn ? i + 1 : i);
        attn_unit<var>(lds, cu, nu, hn, i == 0, Q, K, V, O, lam, gain, qr); cu = nu; }
    __syncthreads();
}
#undef AT_DMA_K
#undef AT_DMA_V
#undef AT_SBAR
}

struct MKArgs { const void* in[21]; float* out; unsigned char* ws; unsigned mask; unsigned li; };
enum { PH_PRO = 0, PH_G1, PH_POOLA, PH_ATT, PH_POOLG, PH_G4A, PH_G4B, PH_G5, PH_ROUTER, PH_G7, PH_G8, PH_FINAL, PH_N };

template <int MODE> __device__ __forceinline__ int dest_row(int n) {
    if (MODE == 1) return n < 2048 ? (n & ~63) + qk_pos_of_d(n & 63) : n;
    if (MODE == 2) { const int nn = n >> 9, hc = n & 511; return (hc >> 7) * 256 + ((hc >> 6) & 1) * 128 + ((hc >> 4) & 3) * 32 + ((hc >> 2) & 3) * 8 + nn * 4 + (hc & 3); }
    return n;
}
template <int MODE> __device__ __forceinline__ void transpose_item(const float* __restrict__ W, int ldw, int N, bf16_t* __restrict__ WT, int ldt, int coloff, int rowoff, LAS float* scr, int item, int lane) {
    const int nblk = N / 64, kb = item / nblk, nb = item % nblk, k0 = 64 * kb, n0 = 64 * nb;
    const int lr = lane >> 4, n4 = (lane & 15) * 4;
#pragma unroll 4
    for (int i = 0; i < 16; ++i) { const int kk = 4 * i + lr; const f32x4 v = *(const f32x4*)(W + (size_t)(k0 + kk) * ldw + n0 + n4); *(LAS f32x4*)(scr + kk * 64 + (n4 ^ ((kk >> 3) << 2))) = v; }
    LDS_WAIT(); asm volatile("" ::: "memory");
    const int c = lane & 7;
#pragma unroll 4
    for (int jj = 0; jj < 8; ++jj) { const int n = 8 * jj + (lane >> 3); const LAS float* sp = scr + (8 * c) * 64 + (n ^ (c << 2));
        if (MODE == 3) {
            int w0 = __builtin_amdgcn_cvt_pk_fp8_f32(sp[0 * 64] * 16.f, sp[1 * 64] * 16.f, 0, false); w0 = __builtin_amdgcn_cvt_pk_fp8_f32(sp[2 * 64] * 16.f, sp[3 * 64] * 16.f, w0, true);
            int w1 = __builtin_amdgcn_cvt_pk_fp8_f32(sp[4 * 64] * 16.f, sp[5 * 64] * 16.f, 0, false); w1 = __builtin_amdgcn_cvt_pk_fp8_f32(sp[6 * 64] * 16.f, sp[7 * 64] * 16.f, w1, true);
            u32x2 o8; o8.x = (unsigned)w0; o8.y = (unsigned)w1; *(u32x2*)((unsigned char*)WT + (size_t)(rowoff + n0 + n) * ldt + coloff + k0 + 8 * c) = o8; continue; }
        u32x4 o; o.x = cvt_pk_bf16(sp[0 * 64], sp[1 * 64]); o.y = cvt_pk_bf16(sp[2 * 64], sp[3 * 64]); o.z = cvt_pk_bf16(sp[4 * 64], sp[5 * 64]); o.w = cvt_pk_bf16(sp[6 * 64], sp[7 * 64]);
        *(u32x4*)(WT + (size_t)(rowoff + dest_row<MODE>(n0 + n)) * ldt + coloff + k0 + 8 * c) = o; }
    LDS_WAIT(); asm volatile("" ::: "memory");
}

__global__ void __launch_bounds__(NTHREADS, 2) mk_fwd(MKArgs args) {
    __shared__ __attribute__((aligned(16))) unsigned char lds_raw[LDS_BYTES];
    LAS unsigned char* lds = (LAS unsigned char*)lds_raw;
    volatile LAS unsigned* MISC = (volatile LAS unsigned*)(lds + MISC_OFF);
    const int tid = threadIdx.x, lane = tid & 63, wave = __builtin_amdgcn_readfirstlane(tid >> 6);
    const int G = gridDim.x; const int bx = blockIdx.x; const int vcu = (G % 8 == 0) ? (bx % 8) * (G / 8) + bx / 8 : bx;
    const unsigned mask = args.mask; const bool dry = ((args.li >> 8) & 1u) != 0u;
    unsigned char* const ws = args.ws; float* const out = args.out;
#define IN_F(k) ((const float*)args.in[k])
#define x_ IN_F(0)
#define positions ((const int*)args.in[1])
#define w_in IN_F(2)
#define gate_bias IN_F(3)
#define lam_vecs IN_F(4)
#define subln_gain IN_F(5)
#define w_pool IN_F(6)
#define pool_scale IN_F(7)
#define w_branch_a IN_F(8)
#define w_branch_b IN_F(9)
#define w_out IN_F(10)
#define ln1_g IN_F(11)
#define ln1_b IN_F(12)
#define wrg IN_F(13)
#define brg IN_F(14)
#define wre IN_F(15)
#define bre IN_F(16)
#define wgu IN_F(17)
#define wdn IN_F(18)
#define ln2_g IN_F(19)
#define ln2_b IN_F(20)
#define wt ((bf16_t*)(ws + WS_WT))
#define xb ((bf16_t*)((unsigned char*)out + 64 * MiB))
#define qb ((bf16_t*)(ws + WS_Q))
#define kb ((bf16_t*)(ws + WS_K))
#define vb ((bf16_t*)(ws + WS_V))
#define ub ((bf16_t*)(ws + WS_U))
#define gb ((bf16_t*)out)
#define gb8 ((unsigned char*)out)
#define on ((bf16_t*)(ws + WS_ON))
#define y16 ((bf16_t*)(ws + WS_ON))
#define xf8 ((unsigned char*)(ws + WS_POOLED + 32 * MiB))
#define mixed ((bf16_t*)(ws + WS_MIXED))
#define merged ((bf16_t*)(ws + WS_MERGED))
#define x1b ((bf16_t*)(ws + WS_X1B))
#define hb ((bf16_t*)(ws + WS_H))
#define ybuf ((bf16_t*)(ws + WS_YBUF))
#define rope ((float*)(ws + WS_ROPE))
#define pooled ((bf16_t*)(ws + WS_POOLED))
#define misc (ws + WS_MISC)
#define ctl ((unsigned*)(misc + MS_CTL))
#define stats ((float2*)(misc + MS_STATS))
#define rw ((float*)(misc + MS_ROUTE + (size_t)T * 8))
#define list ((int*)(misc + MS_LIST))
#define scal ((float*)(misc + MS_SCAL))
#define cnt (ctl + CW_CNT)
#define wpool_bd ((bf16_t*)(misc + MS_WPOOL))

    for (int u = tid; u < (LDS_BYTES - LDS_CTL_OFF) / 4; u += NTHREADS) ((LAS unsigned*)(lds + LDS_CTL_OFF))[u] = 0u;
    __syncthreads();
    XcdBarrier bar; bar.bar = ctl + CW_BAR + (args.li & 255u) * XCD_BAR_WORDS; bar.x = 0; bar.st = nullptr;
    const bool multi = (mask & (mask - 1u)) != 0u;
    if (multi) bar = xcd_barrier_post(ctl + CW_BAR + (args.li & 255u) * XCD_BAR_WORDS, MISC + 8);
#ifndef MK_CT
#define MK_CT 0xfffu
#endif
#define HAS(p) (((MK_CT >> (p)) & 1u) && ((mask >> (p)) & 1u))
#ifndef MK_REP
#define MK_REP 0u
#endif
#define REPS(p) for (int rep_ = 0; rep_ < ((((MK_REP) >> (p)) & 1u) ? 2 : 1); ++rep_)
#ifdef MK_BAR2
#define SEAM(p) do { if (multi && (mask >> ((p) + 1)) != 0u) { xcd_barrier(bar); xcd_barrier(bar); } } while (0)
#else
#define SEAM(p) do { if (multi && (mask >> ((p) + 1)) != 0u) xcd_barrier(bar); } while (0)
#endif
#define AN_STR2(x) #x
#define AN_STR(x) AN_STR2(x)
#define ANCHOR(n) asm volatile(".p2align 6\n\t.rept " AN_STR(n) "\n\ts_nop 0\n\t.endr" ::: "memory")
#ifndef AN_G1
#define AN_G1 13
#endif
#ifndef AN_ATT
#define AN_ATT 5
#endif
#ifndef AN_G4A
#define AN_G4A 0
#endif
#ifndef AN_G4B
#define AN_G4B 7
#endif
#ifndef AN_G5
#define AN_G5 9
#endif
#ifndef AN_RT
#define AN_RT 8
#endif
#ifndef AN_G7
#define AN_G7 10
#endif
#ifndef AN_G8
#define AN_G8 1
#endif
    const int gw = vcu * NWAVES + wave, NGW = G * NWAVES;

    if (HAS(PH_PRO)) {
        LAS float* scr = (LAS float*)(lds + wave * 16384);
        constexpr int I_INA = 16 * (3584 / 64), I_ING = 16 * (2048 / 64), I_A = 16 * 16, I_O = 16 * 16, I_GU = 16 * 16, I_DN = 8 * 16;
        constexpr int NITEMS = I_INA + I_ING + I_A + I_O;
        for (int it = gw; it < NITEMS; it += NGW) {
            int r = it;
            if (r < I_INA) { transpose_item<1>(w_in, INW, 3584, wt + WT_IN, 1024, 0, 0, scr, r, lane); continue; } r -= I_INA;
            if (r < I_ING) { transpose_item<3>(w_in + 3584, INW, 2048, wt + WT_IN + (size_t)3584 * 1024, 1024, 0, 0, scr, r, lane); continue; } r -= I_ING;
            if (r < I_A) { transpose_item<0>(w_branch_a, 1024, 1024, wt + WT_A, 1024, 0, 0, scr, r, lane); continue; } r -= I_A;
            transpose_item<0>(w_out, 1024, 1024, wt + WT_O, 1024, 0, 0, scr, r, lane);
            (void)I_GU; (void)I_DN;
        }
        for (int it = gw; it < 64 * 16; it += NGW) { const int kc = it >> 4, n = (it & 15) * 64 + lane; const int g = kc >> 4, c0 = (kc & 15) * 8; float a8[8] = {0.f, 0.f, 0.f, 0.f, 0.f, 0.f, 0.f, 0.f};
            const float* wpg = w_pool + (size_t)(g * 128 + c0) * 128; const float* wbp = w_branch_b + (size_t)(g * 128) * 1024 + n; const float* psp = pool_scale + g * 128;
            for (int d = 0; d < 128; ++d) { const float bv = wbp[(size_t)d * 1024] * psp[d];
#pragma unroll
                for (int i = 0; i < 8; ++i) a8[i] = fmaf(wpg[i * 128 + d], bv, a8[i]); }
            u32x4 o; o.x = cvt_pk_bf16(a8[0], a8[1]); o.y = cvt_pk_bf16(a8[2], a8[3]); o.z = cvt_pk_bf16(a8[4], a8[5]); o.w = cvt_pk_bf16(a8[6], a8[7]);
            *(u32x4*)(wt + WT_B + (size_t)n * 512 + kc * 8) = o; }
        for (int m = gw; m < T; m += NGW) { const f32x4* xr = (const f32x4*)(x_ + (size_t)m * 1024) + 2 * lane; u32x4* o16 = (u32x4*)(xb + (size_t)m * 1024) + lane;
#pragma unroll
            for (int j = 0; j < 2; ++j) { const f32x4 v0 = __builtin_nontemporal_load(xr + 128 * j), v1 = __builtin_nontemporal_load(xr + 128 * j + 1); u32x4 w; w.x = cvt_pk_bf16(v0[0], v0[1]); w.y = cvt_pk_bf16(v0[2], v0[3]); w.z = cvt_pk_bf16(v1[0], v1[1]); w.w = cvt_pk_bf16(v1[2], v1[3]); o16[64 * j] = w;
                int f0 = __builtin_amdgcn_cvt_pk_fp8_f32(v0[0], v0[1], 0, false); f0 = __builtin_amdgcn_cvt_pk_fp8_f32(v0[2], v0[3], f0, true); int f1 = __builtin_amdgcn_cvt_pk_fp8_f32(v1[0], v1[1], 0, false); f1 = __builtin_amdgcn_cvt_pk_fp8_f32(v1[2], v1[3], f1, true);
                u32x2 f8; f8.x = (unsigned)f0; f8.y = (unsigned)f1; *((u32x2*)(xf8 + (size_t)m * 1024) + 64 * j + lane) = f8; } }
        for (int e = gw * 64 + lane; e < T * 32; e += NGW * 64) { const int t = e >> 5, i = e & 31; const float inv = powf(10000.0f, -(float)i * (2.0f / 64.0f)); const float ang = (float)positions[t] * inv; float sn, cs; sincosf(ang, &sn, &cs);
            rope[2 * e] = cs; rope[2 * e + 1] = sn; }
        if (gw == 0 && lane == 0) { float s01 = 0.f, s23 = 0.f; for (int i = 0; i < 64; ++i) { s01 += lam_vecs[i] * lam_vecs[64 + i]; s23 += lam_vecs[128 + i] * lam_vecs[192 + i]; } scal[0] = expf(s01) - expf(s23) + LAMBDA_INIT; }
        { f32x4* wp = (f32x4*)(misc + MS_WP);
          for (int e = gw * 64 + lane; e < 16 * 3 * 4 * 64; e += NGW * 64) { const int l = e & 63, sg = (e >> 6) & 3, ob = (e >> 8) % 3, chunk = (e >> 8) / 3; const int o = ob * 16 + (l & 15); f32x4 v = {0.f, 0.f, 0.f, 0.f};
              if (o < 36) {
#pragma unroll
                  for (int j = 0; j < 4; ++j) { const int c = chunk * 64 + (l >> 4) * 16 + 4 * sg + j; v[j] = ln1_g[c] * (o < 4 ? wrg[c * 4 + o] : wre[c * 32 + (o - 4)]); } }
              wp[e] = v; }
          float* csbw = (float*)(misc + MS_CSBW);
          if (gw < 48) { const int o = gw; float cs = 0.f, bw = 0.f;
              if (o < 36) { for (int i = 0; i < 16; ++i) { const int c = lane + 64 * i; const float w = (o < 4 ? wrg[c * 4 + o] : wre[c * 32 + (o - 4)]); cs += ln1_g[c] * w; bw += ln1_b[c] * w; }
                  cs = wave_sum(cs); bw = wave_sum(bw) + (o < 4 ? brg[o] : bre[o - 4]); }
              if (lane == 0) { csbw[o] = cs; csbw[48 + o] = bw; } } }
#ifdef MK_SLEEP_TEST
        { const unsigned long long t0_ = __builtin_amdgcn_s_memrealtime(); while (__builtin_amdgcn_s_memrealtime() - t0_ < 10000ull) __builtin_amdgcn_s_sleep(32); }
#endif
        __syncthreads();
        SEAM(PH_PRO);
    }
    if (HAS(PH_G1)) {
        ANCHOR(AN_G1);
        { g8::DenseOrder S; S.init(xb, wt + WT_IN, T, 3584, 1024, G, bx);
          g8::EpiProj E{qb, kb, vb, ub, gb, rope, gate_bias};
          g8::gemm_phase<g8::EpiProj, g8::DenseOrder, true, false>(lds, 1024, S, E); }
        SEAM(PH_G1);
    }
    if (HAS(PH_POOLA)) {
        for (int task = gw; task < T / 16; task += NGW) { const int t0 = task * 16, s0 = t0 & (SEQ - 1); const int w = 2 << (lane >> 4); const bf16_t* up = ub + (size_t)t0 * 512 + lane * 8;
            float a[8] = {0.f, 0.f, 0.f, 0.f, 0.f, 0.f, 0.f, 0.f};
            if (s0 != 0) for (int i = 1; i < w; ++i) { const u32x4 v = *(const u32x4*)(up - (ptrdiff_t)i * 512);
                a[0] += bflo(v.x); a[1] += bfhi(v.x); a[2] += bflo(v.y); a[3] += bfhi(v.y); a[4] += bflo(v.z); a[5] += bfhi(v.z); a[6] += bflo(v.w); a[7] += bfhi(v.w); }
#pragma unroll 4
            for (int j = 0; j < 16; ++j) { const int s = s0 + j; const u32x4 v = *(const u32x4*)(up + (size_t)j * 512); const float f[8] = {bflo(v.x), bfhi(v.x), bflo(v.y), bfhi(v.y), bflo(v.z), bfhi(v.z), bflo(v.w), bfhi(v.w)};
#pragma unroll
                for (int k = 0; k < 8; ++k) a[k] += f[k];
                if (j >= 1 && s >= w) { const u32x4 o = *(const u32x4*)(up + (ptrdiff_t)(j - w) * 512);
                    a[0] -= bflo(o.x); a[1] -= bfhi(o.x); a[2] -= bflo(o.y); a[3] -= bfhi(o.y); a[4] -= bflo(o.z); a[5] -= bfhi(o.z); a[6] -= bflo(o.w); a[7] -= bfhi(o.w); }
                const float inv = 1.f / (float)((s + 1 < w) ? s + 1 : w); u32x4 r; r.x = cvt_pk_bf16(a[0] * inv - f[0], a[1] * inv - f[1]); r.y = cvt_pk_bf16(a[2] * inv - f[2], a[3] * inv - f[3]);
                r.z = cvt_pk_bf16(a[4] * inv - f[4], a[5] * inv - f[5]); r.w = cvt_pk_bf16(a[6] * inv - f[6], a[7] * inv - f[7]);
                *(u32x4*)(pooled + (size_t)(t0 + j) * 512 + lane * 8) = r; } }
    }
    if (HAS(PH_ATT)) {
        ANCHOR(AN_ATT);
#ifdef MK_VAR
        if (args.li >> 8) at2::attn_phase<MK_VAR>(lds, vcu, G, qb, kb, vb, (bf16_t*)(ws + WS_POOLED), scal, subln_gain); else
#endif
        at2::attn_phase<0u>(lds, vcu, G, qb, kb, vb, on, scal, subln_gain);
        { g8::DenseOrder S; S.init(xf8, wt + WT_IN + (size_t)3584 * 1024, T, 2048, 512, G, bx);
          g8::EpiGates E{gb8, gate_bias};
          g8::gemm_phase<g8::EpiGates, g8::DenseOrder, true, false, true>(lds, 512, S, E); }
        SEAM(PH_ATT); }
    else if (HAS(PH_POOLA)) { SEAM(PH_ATT); }
    if (HAS(PH_G4A)) {
        ANCHOR(AN_G4A);
        g8::DenseOrder S; S.init(on, wt + WT_A, T, 1024, 1024, G, bx);
        g8::EpiMerge<0> E{gb8, merged, merged};
        g8::gemm_phase<g8::EpiMerge<0>, g8::DenseOrder, true, false>(lds, 1024, S, E);
    }
    if (HAS(PH_G4B)) {
        ANCHOR(AN_G4B);
        g8::DenseOrder S; S.init(pooled, wt + WT_B, T, 1024, 512, G, bx);
        g8::EpiMerge<1> E{gb8, merged, dry ? (bf16_t*)(ws + WS_X1B) : merged};
        g8::gemm_phase<g8::EpiMerge<1>, g8::DenseOrder, true, false>(lds, 512, S, E);
        SEAM(PH_G4B);
    } else if (HAS(PH_G4A)) { SEAM(PH_G4B); }
    if (HAS(PH_G5)) {
        ANCHOR(AN_G5);
        g8::DenseOrder S; S.init(merged, wt + WT_O, T, 1024, 1024, G, bx);
        g8::EpiResid E{xb, y16, (float2*)(ws + WS_MIXED)};
        g8::gemm_phase<g8::EpiResid, g8::DenseOrder, true, false>(lds, 1024, S, E);
        SEAM(PH_G5);
    }
    if (HAS(PH_ROUTER)) {
        ANCHOR(AN_RT);
        LAS float* lgs = (LAS float*)(lds + 0) + wave * (16 * 49);
        LAS float* tst = (LAS float*)(lds + 32768) + wave * 32;
        LAS int*   tex = (LAS int*)(lds + 36864) + wave * 128;
        LAS unsigned* lcnt = (LAS unsigned*)(lds + 40960);
        const f32x4* wp = (const f32x4*)(misc + MS_WP); const float* csbw = (const float*)(misc + MS_CSBW);
        if (wave >= 4) __builtin_amdgcn_s_setprio(1);
        for (int t0 = vcu * 128; t0 < T; t0 += G * 128) {
            if (tid < 64) lcnt[tid] = 0u;
            __syncthreads();
            const int tk = lane & 15, q = lane >> 4;
            if (wave >= 4) {
                if (t0 == vcu * 128) { LAS float* scr = (LAS float*)(lds + 65536 + (wave - 4) * 16384); constexpr int I_GU = 16 * 16, I_DN = 8 * 16;
                    for (int it = vcu * 4 + (wave - 4); it < NE * (I_GU + I_DN); it += G * 4) {
                        if (it < NE * I_GU) { const int e = it / I_GU; transpose_item<2>(wgu + (size_t)e * 1024 * 1024, 1024, 1024, wt + WT_GU + (size_t)e * 1024 * 1024, 1024, 0, 0, scr, it % I_GU, lane); }
                        else { const int r2 = it - NE * I_GU; const int e = r2 / I_DN; transpose_item<0>(wdn + (size_t)e * 512 * 1024, 1024, 1024, wt + WT_DN + (size_t)e * 1024 * 512, 512, 0, 0, scr, r2 % I_DN, lane); } } }
            } else
            {
              const int tw0 = t0 + (wave * 2) * 16;
              const bf16_t* yr0 = y16 + (size_t)(tw0 + tk) * 1024 + q * 16;
              float mu_[2], rs_[2];
#pragma unroll
              for (int h = 0; h < 2; ++h) { float s1 = 0.f, s2 = 0.f; const float2* pp = (const float2*)(ws + WS_MIXED) + (size_t)(tw0 + 16 * h + tk) * 16;
#pragma unroll
                  for (int i = 0; i < 16; ++i) { const float2 pv = pp[i]; s1 += pv.x; s2 += pv.y; }
                  const float mu = s1 * (1.f / 1024.f); const float var = fmaxf(s2 * (1.f / 1024.f) - mu * mu, 0.f); const float rstd = 1.0f / sqrtf(var + LN_EPS); mu_[h] = mu; rs_[h] = rstd;
                  if (q == 0) { tst[h * 128 + 2 * tk] = mu; tst[h * 128 + 2 * tk + 1] = rstd; if (!dry) stats[tw0 + 16 * h + tk] = make_float2(mu, rstd); } }
              bf16_t* xo0 = (dry ? (bf16_t*)(ws + WS_H) : x1b) + (size_t)(tw0 + tk) * 1024 + q * 16; const float* gp = ln1_g + q * 16; const float* bp = ln1_b + q * 16;
              f32x4 acc[2][3];
#pragma unroll
              for (int h = 0; h < 2; ++h)
#pragma unroll
                  for (int o = 0; o < 3; ++o) acc[h][o] = (f32x4){0.f, 0.f, 0.f, 0.f};
#pragma unroll 1
              for (int chunk = 0; chunk < 16; ++chunk) { f32x4 yv[2][4]; f32x4 gg[4], bb[4];
#pragma unroll
                  for (int j = 0; j < 4; ++j) { gg[j] = *(const f32x4*)(gp + chunk * 64 + 4 * j); bb[j] = *(const f32x4*)(bp + chunk * 64 + 4 * j); }
#pragma unroll
                  for (int h = 0; h < 2; ++h) { const bf16_t* yr = yr0 + (size_t)h * 16 * 1024;
#pragma unroll
                      for (int j = 0; j < 2; ++j) { const u32x4 rw_ = *(const u32x4*)(yr + chunk * 64 + 8 * j); yv[h][2 * j] = (f32x4){bflo(rw_.x), bfhi(rw_.x), bflo(rw_.y), bfhi(rw_.y)}; yv[h][2 * j + 1] = (f32x4){bflo(rw_.z), bfhi(rw_.z), bflo(rw_.w), bfhi(rw_.w)}; }
                      u32x4 w0, w1; f32x4 xn[4];
#pragma unroll
                      for (int j = 0; j < 4; ++j) xn[j] = (yv[h][j] - mu_[h]) * rs_[h] * gg[j] + bb[j];
                      w0.x = cvt_pk_bf16(xn[0][0], xn[0][1]); w0.y = cvt_pk_bf16(xn[0][2], xn[0][3]); w0.z = cvt_pk_bf16(xn[1][0], xn[1][1]); w0.w = cvt_pk_bf16(xn[1][2], xn[1][3]);
                      w1.x = cvt_pk_bf16(xn[2][0], xn[2][1]); w1.y = cvt_pk_bf16(xn[2][2], xn[2][3]); w1.z = cvt_pk_bf16(xn[3][0], xn[3][1]); w1.w = cvt_pk_bf16(xn[3][2], xn[3][3]);
                      bf16_t* xo = xo0 + (size_t)h * 16 * 1024; *(u32x4*)(xo + chunk * 64) = w0; *(u32x4*)(xo + chunk * 64 + 8) = w1; }
#pragma unroll
                  for (int sg = 0; sg < 4; ++sg) { const f32x4 b0 = wp[((chunk * 3 + 0) * 4 + sg) * 64 + lane], b1 = wp[((chunk * 3 + 1) * 4 + sg) * 64 + lane], b2 = wp[((chunk * 3 + 2) * 4 + sg) * 64 + lane];
#pragma unroll
                      for (int h = 0; h < 2; ++h)
#pragma unroll
                          for (int j = 0; j < 4; ++j) { const float a = yv[h][sg][j];
                              acc[h][0] = __builtin_amdgcn_mfma_f32_16x16x4f32(a, b0[j], acc[h][0], 0, 0, 0); acc[h][1] = __builtin_amdgcn_mfma_f32_16x16x4f32(a, b1[j], acc[h][1], 0, 0, 0); acc[h][2] = __builtin_amdgcn_mfma_f32_16x16x4f32(a, b2[j], acc[h][2], 0, 0, 0); } } }
#pragma unroll
              for (int h = 0; h < 2; ++h) { LAS float* lgh = lgs + h * 4 * (16 * 49);
#pragma unroll
                  for (int r = 0; r < 4; ++r) { lgh[(4 * q + r) * 49 + tk] = acc[h][0][r]; lgh[(4 * q + r) * 49 + 16 + tk] = acc[h][1][r]; lgh[(4 * q + r) * 49 + 32 + tk] = acc[h][2][r]; } } }
            LDS_WAIT();
            if (wave < 4 && lane < 32) { const int hh = lane >> 4, l16 = lane & 15; const int t = t0 + (wave * 2 + hh) * 16 + l16; const float mu = tst[hh * 128 + 2 * l16], rstd = tst[hh * 128 + 2 * l16 + 1]; const LAS float* lr = lgs + hh * 4 * (16 * 49) + l16 * 49; LAS int* texh = tex + hh * 64;
                float lg[4], le[32];
#pragma unroll
                for (int o = 0; o < 4; ++o) lg[o] = rstd * (lr[o] - mu * csbw[o]) + csbw[48 + o];
#pragma unroll
                for (int o = 0; o < 32; ++o) le[o] = rstd * (lr[4 + o] - mu * csbw[4 + o]) + csbw[48 + 4 + o];
                int gi = 0; float gm = lg[0];
#pragma unroll
                for (int o = 1; o < 4; ++o) if (lg[o] > gm) { gm = lg[o]; gi = o; }
                float gs = 0.f;
#pragma unroll
                for (int o = 0; o < 4; ++o) gs += expf(lg[o] - gm);
                const float gp = 1.f / gs; float ev[8];
#pragma unroll
                for (int o = 0; o < 8; ++o) { float vsel = le[o];
#pragma unroll
                    for (int g = 1; g < 4; ++g) vsel = (gi == g) ? le[g * 8 + o] : vsel;
                    ev[o] = vsel; }
                int i0 = 0; float m0v = ev[0];
#pragma unroll
                for (int o = 1; o < 8; ++o) if (ev[o] > m0v) { m0v = ev[o]; i0 = o; }
                int i1 = (i0 == 0) ? 1 : 0; float m1v = -3.4e38f;
#pragma unroll
                for (int o = 0; o < 8; ++o) if (o != i0 && ev[o] > m1v) { m1v = ev[o]; i1 = o; }
                const float e1 = expf(m1v - m0v); const float w0 = gp / (1.f + e1), w1 = gp * e1 / (1.f + e1);
                const int ex0 = gi * 8 + i0, ex1 = gi * 8 + i1;
                if (!dry) { rw[2 * t] = w0; rw[2 * t + 1] = w1; }
                const unsigned r0 = __hip_atomic_fetch_add(lcnt + ex0, 1u, __ATOMIC_RELAXED, __HIP_MEMORY_SCOPE_WORKGROUP); const unsigned r1 = __hip_atomic_fetch_add(lcnt + ex1, 1u, __ATOMIC_RELAXED, __HIP_MEMORY_SCOPE_WORKGROUP);
                texh[4 * l16] = ex0; texh[4 * l16 + 1] = ex1; texh[4 * l16 + 2] = (int)r0; texh[4 * l16 + 3] = (int)r1; }
            __syncthreads();
            if (tid < NE) { const unsigned c = lcnt[tid]; lcnt[32 + tid] = (c && !dry) ? atomicAdd(cnt + tid, c) : 0u; }
            __syncthreads();
            if (wave < 4 && lane < 32 && !dry) { const int half = lane >> 4, l16 = lane & 15; const int t = t0 + (wave * 2 + half) * 16 + l16; const LAS int* te = tex + half * 64 + 4 * l16; const int ex0 = te[0], ex1 = te[1];
                list[(size_t)ex0 * T + lcnt[32 + ex0] + (unsigned)te[2]] = t * 2; list[(size_t)ex1 * T + lcnt[32 + ex1] + (unsigned)te[3]] = t * 2 + 1; }
            __syncthreads();
        }
        __builtin_amdgcn_s_setprio(0);
        SEAM(PH_ROUTER);
    }
    if (HAS(PH_G7) || HAS(PH_G8)) {
        if (tid < NE) MISC[64 + tid] = __hip_atomic_load(cnt + tid, RLX_AGENT);
        __syncthreads();
        if (tid == 0) { unsigned acc = 0u; for (int e = 0; e < NE; ++e) { MISC[16 + e] = acc; acc += (MISC[64 + e] + 255u) >> 8; } MISC[16 + NE] = acc; }
        __syncthreads();
        const int ntiles = (int)MISC[16 + NE];
        unsigned* tdone = ctl + CW_TDONE;
        const int nwg = ntiles * 4, r7 = nwg % G;
        if (HAS(PH_G7)) {
            ANCHOR(AN_G7);
            g8::MoeOrder S{(const char*)x1b, (const char*)(wt + WT_GU), list, MISC + 16, MISC + 64, nwg, G, bx, 0, (size_t)1024 * 1024 * 2, (size_t)256 * 1024 * 2, 1, tdone, 1};
            g8::EpiGateUp E{hb};
            g8::gemm_phase<g8::EpiGateUp, g8::MoeOrder, true, true>(lds, 1024, S, E);
        }
        if (HAS(PH_G8)) {
            ANCHOR(AN_G8);
            g8::MoeOrder S{(const char*)hb, (const char*)(wt + WT_DN), list, MISC + 16, MISC + 64, nwg, G, (bx - r7 + G) % G, (size_t)256 * 512 * 2, (size_t)1024 * 512 * 2, (size_t)256 * 512 * 2, 0, tdone, 2};
            g8::EpiDown E{ybuf, list, rw, MISC + 64};
            g8::gemm_phase<g8::EpiDown, g8::MoeOrder, true, false>(lds, 512, S, E);
            SEAM(PH_G8);
        } else if (HAS(PH_G7)) { SEAM(PH_G8); }
    }
    if (HAS(PH_FINAL)) {
        f32x4 g2[4], b2[4];
#pragma unroll
        for (int j = 0; j < 4; ++j) { g2[j] = *(const f32x4*)(ln2_g + j * 256 + lane * 4); b2[j] = *(const f32x4*)(ln2_b + j * 256 + lane * 4); }
        for (int t0 = gw; t0 < T; t0 += 2 * NGW) {
            u32x2 xw[2][4], ya[2][4], yb[2][4];
#pragma unroll
            for (int r = 0; r < 2; ++r) { const int t = t0 + r * NGW; const bool ok = t < T; const size_t tt = ok ? (size_t)t : (size_t)t0;
#pragma unroll
                for (int j = 0; j < 4; ++j) { const int c0 = j * 256 + lane * 4;
                    xw[r][j] = __builtin_nontemporal_load((const u32x2*)(x1b + tt * 1024 + c0));
                    ya[r][j] = __builtin_nontemporal_load((const u32x2*)(ybuf + (2 * tt) * 1024 + c0)); yb[r][j] = __builtin_nontemporal_load((const u32x2*)(ybuf + (2 * tt + 1) * 1024 + c0)); } }
#pragma unroll
            for (int r = 0; r < 2; ++r) { const int t = t0 + r * NGW; if (t >= T) break;
                float* yw = (dry ? (float*)(ws + WS_V) : out) + (size_t)t * 1024; float xv[16]; float s = 0.f;
#pragma unroll
                for (int j = 0; j < 4; ++j) { const float x1v[4] = {bflo(xw[r][j].x), bfhi(xw[r][j].x), bflo(xw[r][j].y), bfhi(xw[r][j].y)};
                    const float fa[4] = {bflo(ya[r][j].x), bfhi(ya[r][j].x), bflo(ya[r][j].y), bfhi(ya[r][j].y)}; const float fb[4] = {bflo(yb[r][j].x), bfhi(yb[r][j].x), bflo(yb[r][j].y), bfhi(yb[r][j].y)};
#pragma unroll
                    for (int i = 0; i < 4; ++i) { const float val = ALPHA * x1v[i] + (fa[i] + fb[i]); xv[4 * j + i] = val; s += val; } }
                const float mu = wave_sum(s) * (1.f / 1024.f); float s2 = 0.f;
#pragma unroll
                for (int i = 0; i < 16; ++i) { const float d = xv[i] - mu; s2 += d * d; }
                const float rstd = 1.0f / sqrtf(wave_sum(s2) * (1.f / 1024.f) + LN_EPS);
#pragma unroll
                for (int j = 0; j < 4; ++j) { f32x4 o;
#pragma unroll
                    for (int i = 0; i < 4; ++i) o[i] = (xv[4 * j + i] - mu) * rstd * g2[j][i] + b2[j][i];
                    __builtin_nontemporal_store(o, (f32x4*)(yw + j * 256 + lane * 4)); } }
        }
    }
#undef HAS
#undef SEAM
}
#undef IN_F
#undef x_
#undef positions
#undef w_in
#undef gate_bias
#undef lam_vecs
#undef subln_gain
#undef w_pool
#undef pool_scale
#undef w_branch_a
#undef w_branch_b
#undef w_out
#undef ln1_g
#undef ln1_b
#undef wrg
#undef brg
#undef wre
#undef bre
#undef wgu
#undef wdn
#undef ln2_g
#undef ln2_b
#undef wt
#undef xb
#undef qb
#undef kb
#undef vb
#undef ub
#undef gb
#undef gb8
#undef on
#undef y16
#undef xf8
#undef mixed
#undef merged
#undef x1b
#undef hb
#undef ybuf
#undef rope
#undef pooled
#undef misc
#undef ctl
#undef stats
#undef rw
#undef list
#undef scal
#undef cnt
#undef wpool_bd


#ifndef MK_OPT
#define MK_OPT 0xfffu
#endif
#ifndef MK_M2A
#define MK_M2A 0xff4u
#define MK_M2B 0u
#define MK_M2C 0u
#endif
#ifndef MK_ONE
#define MK_ONE 1
#endif
constexpr unsigned OPT = MK_OPT;
#define OPTP(p) ((OPT >> (p)) & 1u)


#ifdef MK_DEBUG_HASH
__global__ void k_hash(const uint4* __restrict__ p, size_t n16, unsigned long long* __restrict__ outh) {
    unsigned long long h = 0ull;
    for (size_t i = blockIdx.x * (size_t)blockDim.x + threadIdx.x; i < n16; i += (size_t)gridDim.x * blockDim.x) { const uint4 w = p[i];
        const unsigned long long m = (unsigned long long)(i * 2654435761ull + 12345ull) | 1ull;
        h += ((unsigned long long)w.x * 0x9E3779B1ull + (unsigned long long)w.y * 0x85EBCA77ull + (unsigned long long)w.z * 0xC2B2AE3Dull + (unsigned long long)w.w * 0x27D4EB2Full) * m; }
    for (int o = 32; o > 0; o >>= 1) h += __shfl_xor(h, o);
    if ((threadIdx.x & 63) == 0) atomicAdd(outh, h);
}
__global__ void k_poison(float* __restrict__ out, const unsigned long long* __restrict__ hs) {
    float code = 0.f; for (int r = 1; r < 10; ++r) if (hs[r] != hs[0]) code = 1.f;
    if (code == 0.f) return;
    for (size_t i = blockIdx.x * (size_t)blockDim.x + threadIdx.x; i < (size_t)T * DM; i += (size_t)gridDim.x * blockDim.x) out[i] = __builtin_nanf("") * code;
}
#endif
extern "C" void kernel_launch(void* const* d_in, const int* in_sizes, int n_in, void* d_out, int out_size, void* d_ws, size_t ws_size, hipStream_t stream) {
    static int grid = 0;
    if (grid == 0) {
        if (n_in != 21 || in_sizes[0] != T * DM || out_size != T * DM || ws_size < WS_END) { fprintf(stderr, "kernel_launch: unexpected shapes (n_in %d, x %d, out %d, ws %zu)\n", n_in, n_in > 0 ? in_sizes[0] : -1, out_size, ws_size); grid = -1; return; }
        int dev = 0, cus = 0;
        if (hipGetDevice(&dev) != hipSuccess || hipDeviceGetAttribute(&cus, hipDeviceAttributeMultiprocessorCount, dev) != hipSuccess) { fprintf(stderr, "kernel_launch: device query failed\n"); grid = -1; return; }
        int per_cu = 0;
        if (hipOccupancyMaxActiveBlocksPerMultiprocessor(&per_cu, (const void*)mk_fwd, NTHREADS, 0) != hipSuccess || per_cu < 1) fprintf(stderr, "kernel_launch: note: occupancy query reports %d blocks per CU\n", per_cu);
        (void)hipGetLastError();
        grid = cus;
    }
    if (grid < 0) return;
    const float* x = (const float*)d_in[0]; const int* positions = (const int*)d_in[1]; const float* w_in = (const float*)d_in[2]; const float* gate_bias = (const float*)d_in[3];
    const float* lam_vecs = (const float*)d_in[4]; const float* subln_gain = (const float*)d_in[5]; const float* w_pool = (const float*)d_in[6]; const float* pool_scale = (const float*)d_in[7];
    const float* w_branch_a = (const float*)d_in[8]; const float* w_branch_b = (const float*)d_in[9]; const float* w_out = (const float*)d_in[10]; const float* ln1_g = (const float*)d_in[11];
    const float* ln1_b = (const float*)d_in[12]; const float* wrg = (const float*)d_in[13]; const float* brg = (const float*)d_in[14]; const float* wre = (const float*)d_in[15];
    const float* bre = (const float*)d_in[16]; const float* wgu = (const float*)d_in[17]; const float* wdn = (const float*)d_in[18]; const float* ln2_g = (const float*)d_in[19]; const float* ln2_b = (const float*)d_in[20];
    char* ws = (char*)d_ws; float* out = (float*)d_out;
    bf16_t* qb = (bf16_t*)(ws + WS_Q); bf16_t* kb = (bf16_t*)(ws + WS_K); bf16_t* vb = (bf16_t*)(ws + WS_V); bf16_t* ub = (bf16_t*)(ws + WS_U); bf16_t* gb = (bf16_t*)d_out;
    bf16_t* on = (bf16_t*)(ws + WS_ON); bf16_t* mixed = (bf16_t*)(ws + WS_MIXED); bf16_t* merged = (bf16_t*)(ws + WS_MERGED); bf16_t* x1b = (bf16_t*)(ws + WS_X1B);
    bf16_t* hb = (bf16_t*)(ws + WS_H); bf16_t* ybuf = (bf16_t*)(ws + WS_YBUF); float2* rope = (float2*)(ws + WS_ROPE); float* tmp = (float*)(ws + WS_TEMP);
    char* misc = ws + WS_MISC; unsigned* ctl = (unsigned*)(misc + MS_CTL); float2* stats = (float2*)(misc + MS_STATS); int2* rexp = (int2*)(misc + MS_ROUTE); float2* rw = (float2*)(misc + MS_ROUTE + (size_t)T * 8);
    int* list = (int*)(misc + MS_LIST); float* scal = (float*)(misc + MS_SCAL); unsigned* cnt = ctl;

    MKArgs a{}; int nlaunch = 0;
    for (int i = 0; i < 21; ++i) a.in[i] = d_in[i];
    a.out = out; a.ws = (unsigned char*)d_ws;
    if (hipMemsetAsync(ctl, 0, 65536, stream) != hipSuccess) { fprintf(stderr, "kernel_launch: memset failed\n"); return; }
#ifndef MK_REPH
#define MK_REPH 0u
#endif
#define MK(maskv) do { a.mask = (maskv); for (int rr_ = 0; rr_ < (((maskv) & (MK_REPH)) ? 2 : 1); ++rr_) { a.li = (unsigned)(nlaunch++ % 3) | (rr_ ? (1u << 8) : 0u); hipLaunchKernelGGL(mk_fwd, dim3(grid), dim3(NTHREADS), 0, stream, a); } } while (0)
    if (MK_ONE == 1) { MK((1u << PH_N) - 1u); return; }
    if (MK_ONE == 2) {
        MK(0x003u);
        for (int mh = 0; mh < 2; ++mh) { const int m0 = mh * 16384; nattn<<<(16384 / 64) * 16, 64, 0, stream>>>(qb, kb, vb, scal, tmp, m0); post_rms<<<16384 * 8 / 256, 256, 0, stream>>>(tmp, subln_gain, on, m0, 16384); }
        MK(MK_M2A); if (MK_M2B) MK(MK_M2B); if (MK_M2C) MK(MK_M2C); return; }

    constexpr int MC = 16384;
#if 0
#else
#ifdef MK_TEST_BAR
    MK(0x003u);
#else
    if (OPTP(PH_PRO)) MK(1u << PH_PRO); else k_prep<<<T * 32 / 256, 256, 0, stream>>>(positions, lam_vecs, rope, scal, ctl);
    if (OPTP(PH_G1)) MK(1u << PH_G1);
#endif
#endif
#ifndef MK_OVR
#define MK_OVR 0
#endif
    const int ovr = OPTP(PH_G1) ? MK_OVR : 15;
    for (int mh = 0; mh < 2; ++mh) {
        const int m0 = mh * MC; AL_F32 ax{x + (size_t)m0 * DM, DM, 0};
        if (ovr & 1) for (int qk = 0; qk < 2; ++qk) {
            ngemm<AL_F32><<<dim3(16, MC / 64), 256, 0, stream>>>(ax, w_in + qk * 1024, INW, tmp, 1024, MC, 1024, DM);
            post_qk<<<MC * 512 / 256, 256, 0, stream>>>(tmp, rope, qk ? kb : qb, m0, MC, qk ? 1.f : QSCALE);
        }
        if (ovr & 2) { ngemm<AL_F32><<<dim3(16, MC / 64), 256, 0, stream>>>(ax, w_in + 2048, INW, tmp, 1024, MC, 1024, DM);
        post_plain<<<MC * 1024 / 256, 256, 0, stream>>>(tmp, vb, 1024, 0, m0, MC, 1024, nullptr); }
        if (ovr & 4) { ngemm<AL_F32><<<dim3(8, MC / 64), 256, 0, stream>>>(ax, w_in + 3072, INW, tmp, 512, MC, 512, DM);
        post_plain<<<MC * 512 / 256, 256, 0, stream>>>(tmp, ub, 512, 0, m0, MC, 512, nullptr); }
        if (ovr & 8) for (int br = 0; br < 2; ++br) {
            ngemm<AL_F32><<<dim3(16, MC / 64), 256, 0, stream>>>(ax, w_in + 3584 + br * 1024, INW, tmp, 1024, MC, 1024, DM);
            post_gate<<<MC * 1024 / 256, 256, 0, stream>>>(tmp, gate_bias, gb, br * 1024, m0, MC);
        }
    }
    if (OPTP(PH_ATT)) MK(1u << PH_ATT);
    else for (int mh = 0; mh < 2; ++mh) {
        const int m0 = mh * MC;
        nattn<<<(MC / 64) * 16, 64, 0, stream>>>(qb, kb, vb, scal, tmp, m0);
        post_rms<<<MC * 8 / 256, 256, 0, stream>>>(tmp, subln_gain, on, m0, MC);
    }
    if (OPTP(PH_POOLA)) { MK(1u << PH_POOLA); MK(1u << PH_POOLG); }
    else for (int mh = 0; mh < 2; ++mh) {
        const int m0 = mh * MC;
        for (int g = 0; g < 4; ++g) { AL_POOL ap{ub + (size_t)m0 * PW, g, 0};
            ngemm<AL_POOL><<<dim3(2, MC / 64), 256, 0, stream>>>(ap, w_pool + (size_t)g * 128 * 128, 128, tmp + g * 128, 512, MC, 128, 128); }
        post_plain<<<MC * 512 / 256, 256, 0, stream>>>(tmp, mixed, 512, 0, m0, MC, 512, pool_scale);
    }
    if (OPTP(PH_G4A)) MK(1u << PH_G4A);
    else for (int mh = 0; mh < 2; ++mh) {
        const int m0 = mh * MC;
        { AL_BF16 al{on + (size_t)m0 * 1024, 1024, 0}; ngemm<AL_BF16><<<dim3(16, MC / 64), 256, 0, stream>>>(al, w_branch_a, 1024, tmp, 1024, MC, 1024, 1024); }
        post_merge<<<MC * 1024 / 256, 256, 0, stream>>>(tmp, gb, merged, 0, m0, MC);
    }
    if (OPTP(PH_G4B)) MK(1u << PH_G4B);
    else for (int mh = 0; mh < 2; ++mh) {
        const int m0 = mh * MC;
        { AL_BF16 al{mixed + (size_t)m0 * 512, 512, 0}; ngemm<AL_BF16><<<dim3(16, MC / 64), 256, 0, stream>>>(al, w_branch_b, 1024, tmp, 1024, MC, 1024, 512); }
        post_merge<<<MC * 1024 / 256, 256, 0, stream>>>(tmp, gb, merged, 1, m0, MC);
    }
    if (OPTP(PH_G5)) MK(1u << PH_G5);
    else for (int mh = 0; mh < 2; ++mh) {
        const int m0 = mh * MC;
        { AL_BF16 al{merged + (size_t)m0 * 1024, 1024, 0}; ngemm<AL_BF16><<<dim3(16, MC / 64), 256, 0, stream>>>(al, w_out, 1024, tmp, 1024, MC, 1024, 1024); }
        post_y<<<MC * 1024 / 256, 256, 0, stream>>>(tmp, x, out, m0, MC);
    }
    if (OPTP(PH_ROUTER)) MK(1u << PH_ROUTER); else k_router<<<T / 4, 256, 0, stream>>>(out, ln1_g, ln1_b, wrg, brg, wre, bre, x1b, stats, rexp, rw, list, cnt);
    if (OPTP(PH_G7)) MK(1u << PH_G7); else nmoe_gu<<<dim3(8, T / 64, NE), 256, 0, stream>>>(x1b, list, cnt, wgu, hb);
    if (OPTP(PH_G8)) MK(1u << PH_G8); else nmoe_dn<<<dim3(16, T / 64, NE), 256, 0, stream>>>(hb, list, cnt, rw, wdn, ybuf);
    if (OPTP(PH_FINAL)) MK(1u << PH_FINAL); else k_final<<<T / 4, 256, 0, stream>>>(out, stats, ln1_g, ln1_b, ybuf, ln2_g, ln2_b);
#undef MK
}
```
